# Optimizing an MI355X kernel written in HIP

```python
import numpy as np
import jax
import jax.numpy as jnp
from jax import lax

D_MODEL = 1024
BATCH = 8
SEQ = 8192
DEPTH = 1

GLA_HEADS = 4
GLA_DK = D_MODEL // 2
GLA_DV = D_MODEL
GLA_HEAD_DK = GLA_DK // GLA_HEADS
GLA_HEAD_DV = GLA_DV // GLA_HEADS
GLA_RANK = 16
GLA_TAU = 16.0
GLA_CHUNK = 64

LRU_WIDTH = D_MODEL
LRU_BLOCKS = 8
LRU_BLOCK_W = LRU_WIDTH // LRU_BLOCKS
CONV_WIDTH = 4
LRU_C = 8.0

PEER_HEADS = 8
PEER_NKEYS = 128
PEER_EXPERTS = PEER_NKEYS * PEER_NKEYS
PEER_DKEY = 256
PEER_HALF = PEER_DKEY // 2
PEER_TOPK = 16
PEER_TOKEN_BLOCK = 128

EPS = 1e-6

SPLIT_SIZES = (GLA_DK, GLA_DK, GLA_DV, GLA_DV, GLA_RANK, LRU_WIDTH, LRU_WIDTH, D_MODEL, D_MODEL)
D_IN = 2 * GLA_DK + 2 * GLA_DV + GLA_RANK + 2 * LRU_WIDTH + 2 * D_MODEL

kernel_name = 'hybrid_gla_rglru_peer_block'


def rms_norm(x, gain):
    xf = x.astype(jnp.float32)
    y = xf * lax.rsqrt(jnp.mean(xf * xf, axis=-1, keepdims=True) + EPS)
    return y * gain.astype(jnp.float32)


def gla_branch(q, k, v, r, a_low, w_alpha, b_alpha, gla_norm):
    f32 = jnp.float32
    B, S, _ = q.shape
    n_chunks = S // GLA_CHUNK
    log_alpha = jax.nn.log_sigmoid((a_low @ w_alpha + b_alpha).astype(f32)) / GLA_TAU

    def to_chunks(t, d):
        return t.astype(f32).reshape(B, n_chunks, GLA_CHUNK, GLA_HEADS, d).transpose(1, 0, 3, 2, 4)

    qc = to_chunks(q, GLA_HEAD_DK) * (GLA_HEAD_DK ** -0.5)
    kc = to_chunks(k, GLA_HEAD_DK)
    vc = to_chunks(v, GLA_HEAD_DV)
    gc = to_chunks(log_alpha, GLA_HEAD_DK)
    causal = jnp.tril(jnp.ones((GLA_CHUNK, GLA_CHUNK), dtype=bool))[:, :, None]

    def chunk_step(state, inp):
        qb, kb, vb, gb = inp
        cum = jnp.cumsum(gb, axis=2)
        cum_last = cum[:, :, -1:, :]
        o_inter = jnp.einsum('bhtk,bhkv->bhtv', qb * jnp.exp(cum), state)
        rel = cum[:, :, :, None, :] - cum[:, :, None, :, :]
        decay = jnp.exp(jnp.where(causal, rel, -jnp.inf))
        scores = jnp.einsum('bhtk,bhsk,bhtsk->bhts', qb, kb, decay)
        o_intra = jnp.einsum('bhts,bhsv->bhtv', scores, vb)
        k_dec = kb * jnp.exp(cum_last - cum)
        state = jnp.exp(cum_last[:, :, 0, :])[..., None] * state + jnp.einsum('bhsk,bhsv->bhkv', k_dec, vb)
        return state, o_inter + o_intra

    state0 = jnp.zeros((B, GLA_HEADS, GLA_HEAD_DK, GLA_HEAD_DV), f32)
    _, o = lax.scan(chunk_step, state0, (qc, kc, vc, gc))
    o = o.transpose(1, 0, 3, 2, 4).reshape(B, S, GLA_HEADS, GLA_HEAD_DV)
    o = rms_norm(o, gla_norm.reshape(GLA_HEADS, GLA_HEAD_DV)).reshape(B, S, GLA_DV)
    return o * jax.nn.silu(r.astype(f32))


def rg_lru_branch(xl, xg, conv_w, conv_b, lru_w_a, lru_b_a, lru_w_x, lru_b_x, lru_lambda):
    f32 = jnp.float32
    B, S, W = xl.shape
    xc = lax.conv_general_dilated(
        xl.astype(f32), conv_w.astype(f32)[:, None, :], window_strides=(1,),
        padding=[(CONV_WIDTH - 1, 0)], dimension_numbers=('NWC', 'WIO', 'NWC'),
        feature_group_count=W) + conv_b.astype(f32)
    xb = xc.reshape(B, S, LRU_BLOCKS, LRU_BLOCK_W)
    gate_r = jax.nn.sigmoid(jnp.einsum('bsni,nij->bsnj', xb, lru_w_a.astype(f32)) + lru_b_a.astype(f32)).reshape(B, S, W)
    gate_i = jax.nn.sigmoid(jnp.einsum('bsni,nij->bsnj', xb, lru_w_x.astype(f32)) + lru_b_x.astype(f32)).reshape(B, S, W)
    log_a = -LRU_C * gate_r * jax.nn.softplus(-lru_lambda.astype(f32))
    a = jnp.exp(log_a)
    u = jnp.sqrt(jnp.maximum(-jnp.expm1(2.0 * log_a), 0.0)) * (gate_i * xc)

    def combine(left, right):
        a_l, h_l = left
        a_r, h_r = right
        return a_l * a_r, a_r * h_l + h_r

    _, h = lax.associative_scan(combine, (a, u), axis=1)
    return h * jax.nn.gelu(xg.astype(f32))


def token_mixers(h, w_in, w_alpha, b_alpha, gla_norm, conv_w, conv_b, lru_w_a, lru_b_a,
                 lru_w_x, lru_b_x, lru_lambda, w_out):
    proj = h @ w_in
    offsets = np.cumsum(SPLIT_SIZES)[:-1].tolist()
    q, k, v, r, a_low, xl, xg, g_a, g_b = jnp.split(proj, offsets, axis=-1)
    y_gla = gla_branch(q, k, v, r, a_low, w_alpha, b_alpha, gla_norm)
    y_lru = rg_lru_branch(xl, xg, conv_w, conv_b, lru_w_a, lru_b_a, lru_w_x, lru_b_x, lru_lambda)
    merged = (jax.nn.sigmoid(g_a.astype(jnp.float32)) * y_gla
              + jax.nn.sigmoid(g_b.astype(jnp.float32)) * y_lru)
    return merged.astype(h.dtype) @ w_out


def peer_tokens(xt, w_query, sub_keys, u_table, v_table):
    f32 = jnp.float32
    T = xt.shape[0]
    qry = (xt @ w_query).astype(f32).reshape(T, PEER_HEADS, 2, PEER_HALF)
    sub_scores = jnp.einsum('thpd,hpnd->thpn', qry, sub_keys.astype(f32))
    top_s, top_i = lax.top_k(sub_scores, PEER_TOPK)
    cand_s = (top_s[:, :, 0, :, None] + top_s[:, :, 1, None, :]).reshape(T, PEER_HEADS, PEER_TOPK * PEER_TOPK)
    cand_i = (top_i[:, :, 0, :, None] * PEER_NKEYS + top_i[:, :, 1, None, :]).reshape(T, PEER_HEADS, PEER_TOPK * PEER_TOPK)
    best_s, best_pos = lax.top_k(cand_s, PEER_TOPK)
    expert_idx = jnp.take_along_axis(cand_i, best_pos, axis=-1)
    gates = jax.nn.softmax(best_s, axis=-1)
    u_sel = jnp.take(u_table, expert_idx, axis=0)
    act = jax.nn.gelu(jnp.einsum('td,thkd->thk', xt, u_sel).astype(f32))
    v_sel = jnp.take(v_table, expert_idx, axis=0)
    return jnp.einsum('thk,thkd->td', (gates * act).astype(v_sel.dtype), v_sel)


def peer_ffn(h, w_query, sub_keys, u_table, v_table):
    B, S, D = h.shape
    blocks = h.reshape(-1, PEER_TOKEN_BLOCK, D)
    out = lax.map(lambda xt: peer_tokens(xt, w_query, sub_keys, u_table, v_table), blocks)
    return out.reshape(B, S, D)


def hybrid_layer(x, c, w_ada, b_ada, norm_pre_mix, norm_post_mix, w_in, w_alpha, b_alpha, gla_norm,
                 conv_w, conv_b, lru_w_a, lru_b_a, lru_w_x, lru_b_x, lru_lambda, w_out,
                 norm_pre_ffn, norm_post_ffn, peer_w_query, peer_sub_keys, peer_u, peer_v):
    f32 = jnp.float32
    mod = jax.nn.silu(c.astype(f32)) @ w_ada.astype(f32) + b_ada.astype(f32)
    shift1, scale1, gate1, shift2, scale2, gate2 = jnp.split(mod[:, None, :], 6, axis=-1)
    h = rms_norm(x, norm_pre_mix) * (1.0 + scale1) + shift1
    y = token_mixers(h, w_in, w_alpha, b_alpha, gla_norm, conv_w, conv_b, lru_w_a, lru_b_a,
                     lru_w_x, lru_b_x, lru_lambda, w_out)
    x = x + (gate1 * rms_norm(y, norm_post_mix)).astype(x.dtype)
    h = rms_norm(x, norm_pre_ffn) * (1.0 + scale2) + shift2
    y = peer_ffn(h, peer_w_query, peer_sub_keys, peer_u, peer_v)
    x = x + (gate2 * rms_norm(y, norm_post_ffn)).astype(x.dtype)
    return x


def setup_inputs(seed: int = 0) -> dict:
    key = jax.random.key(seed)
    ks = jax.random.split(key, 26)
    D = D_MODEL
    nrm = jax.random.normal

    def gain(k, n):
        return 1.0 + 0.05 * nrm(k, (DEPTH, n), jnp.float32)

    lam_u = jax.random.uniform(ks[17], (DEPTH, LRU_WIDTH), jnp.float32, minval=0.9, maxval=0.999)
    lam_p = lam_u ** (1.0 / LRU_C)
    return {
        'x': nrm(ks[0], (BATCH, SEQ, D), jnp.float32),
        'c': nrm(ks[1], (BATCH, D), jnp.float32),
        'w_ada': 0.5 * D ** -0.5 * nrm(ks[2], (DEPTH, D, 6 * D), jnp.float32),
        'b_ada': 0.02 * nrm(ks[3], (DEPTH, 6 * D), jnp.float32),
        'norm_pre_mix': gain(ks[4], D),
        'norm_post_mix': gain(ks[5], D),
        'w_in': D ** -0.5 * nrm(ks[6], (DEPTH, D, D_IN), jnp.float32),
        'w_alpha': GLA_RANK ** -0.5 * nrm(ks[7], (DEPTH, GLA_RANK, GLA_DK), jnp.float32),
        'b_alpha': 0.1 * nrm(ks[8], (DEPTH, GLA_DK), jnp.float32),
        'gla_norm': gain(ks[9], GLA_DV),
        'conv_w': CONV_WIDTH ** -0.5 * nrm(ks[10], (DEPTH, CONV_WIDTH, LRU_WIDTH), jnp.float32),
        'conv_b': 0.02 * nrm(ks[11], (DEPTH, LRU_WIDTH), jnp.float32),
        'lru_w_a': LRU_BLOCK_W ** -0.5 * nrm(ks[12], (DEPTH, LRU_BLOCKS, LRU_BLOCK_W, LRU_BLOCK_W), jnp.float32),
        'lru_b_a': 0.02 * nrm(ks[13], (DEPTH, LRU_BLOCKS, LRU_BLOCK_W), jnp.float32),
        'lru_w_x': LRU_BLOCK_W ** -0.5 * nrm(ks[14], (DEPTH, LRU_BLOCKS, LRU_BLOCK_W, LRU_BLOCK_W), jnp.float32),
        'lru_b_x': 0.02 * nrm(ks[15], (DEPTH, LRU_BLOCKS, LRU_BLOCK_W), jnp.float32),
        'lru_lambda': jnp.log(lam_p) - jnp.log1p(-lam_p),
        'w_out': D ** -0.5 * nrm(ks[16], (DEPTH, D, D), jnp.float32),
        'norm_pre_ffn': gain(ks[18], D),
        'norm_post_ffn': gain(ks[19], D),
        'peer_w_query': D ** -0.5 * nrm(ks[20], (DEPTH, D, PEER_HEADS * PEER_DKEY), jnp.float32),
        'peer_sub_keys': PEER_HALF ** -0.5 * nrm(ks[21], (DEPTH, PEER_HEADS, 2, PEER_NKEYS, PEER_HALF), jnp.float32),
        'peer_u': D ** -0.5 * nrm(ks[22], (DEPTH, PEER_EXPERTS, D), jnp.float32),
        'peer_v': D ** -0.5 * nrm(ks[23], (DEPTH, PEER_EXPERTS, D), jnp.float32),
    }


def reference(x, c, w_ada, b_ada, norm_pre_mix, norm_post_mix, w_in, w_alpha, b_alpha, gla_norm,
              conv_w, conv_b, lru_w_a, lru_b_a, lru_w_x, lru_b_x, lru_lambda, w_out,
              norm_pre_ffn, norm_post_ffn, peer_w_query, peer_sub_keys, peer_u, peer_v):
    for l in range(DEPTH):
        x = hybrid_layer(x, c, w_ada[l], b_ada[l], norm_pre_mix[l], norm_post_mix[l], w_in[l],
                         w_alpha[l], b_alpha[l], gla_norm[l], conv_w[l], conv_b[l], lru_w_a[l],
                         lru_b_a[l], lru_w_x[l], lru_b_x[l], lru_lambda[l], w_out[l],
                         norm_pre_ffn[l], norm_post_ffn[l], peer_w_query[l], peer_sub_keys[l],
                         peer_u[l], peer_v[l])
    return x
```

```cpp
#include <hip/hip_runtime.h>
#include <hip/hip_cooperative_groups.h>
#include <cstdio>
#include <cstdint>
#include <utility>
namespace cg = cooperative_groups;

namespace pg8 {
#define PG8_LAS __attribute__((address_space(3)))
typedef unsigned short bf16_t;
typedef short bf16x8 __attribute__((ext_vector_type(8)));
typedef float f32x4 __attribute__((ext_vector_type(4)));
typedef unsigned u32x4 __attribute__((ext_vector_type(4)));
constexpr int BM = 256, BK = 64, HALF = 128, HTB = HALF * BK * 2  , STAGE_BYTES = 8 * HTB, NXCD = 8, WGM = 8;

__host__ __device__ __forceinline__ int lds_byte(int r, int c) { const int st = (r >> 4) * 2 + (c >> 5), rr = r & 15, cc = c & 31, ob = rr * 64 + cc * 2; return st * 1024 + (ob ^ (((ob >> 9) & 1) << 5)); }
__host__ __device__ __forceinline__ void stage_rc(int b, int& R, int& C) { const int st = b / 1024, sb = b % 1024, swz = sb ^ (((sb >> 9) & 1) << 5); R = (st >> 1) * 16 + swz / 64; C = (st & 1) * 32 + (swz % 64) / 2; }
__host__ __device__ __forceinline__ int perm32(int rho) { const int n = rho >> 4, i = rho & 15; return 8 * (i >> 2) + 4 * n + (i & 3); }

struct Unit { int pm, pn; };
struct Gemm { const bf16_t* A; const bf16_t* Bt; int M, N, K, lda; };
template <int AMODE> __device__ __forceinline__ size_t a_off_bytes(const Gemm& g, const Unit& u) {
    const int ac = AMODE == 0 ? 0 : (AMODE == 1 ? 128 * (u.pn < 6 ? u.pn : 6) : 256 * u.pn);
    return ((size_t)u.pm * BM * (size_t)g.lda + (size_t)ac) * 2;
}

struct StaticOrder {
    int nM, nN, nwg, G, c;
    __host__ __device__ void init(int M, int N, int G_, int c_) { nM = M / BM; nN = N / BM; nwg = nM * nN; G = G_; c = c_; }
    __host__ __device__ bool next(int i, Unit& u) const {
        const long L = (long)i * G + c; if (L >= nwg) return false;
        int wgid = (int)L; { const int q = nwg / NXCD, r = nwg % NXCD, xcd = wgid % NXCD, off = wgid / NXCD; wgid = (xcd < r ? xcd * (q + 1) : r * (q + 1) + (xcd - r) * q) + off; }
        const int nig = WGM * nN, gid = wgid / nig, fm = gid * WGM, gsz = (nM - fm) < WGM ? (nM - fm) : WGM;
        u.pm = fm + ((wgid % nig) % gsz); u.pn = (wgid % nig) / gsz; return true;
    }
    __device__ __forceinline__ void a_ready(const Unit&) const {}
    __device__ __forceinline__ void done(const Unit&) const {}
};

__device__ __forceinline__ unsigned cvt_pk_bf16(float lo, float hi) { unsigned r; asm volatile("v_cvt_pk_bf16_f32 %0, %1, %2" : "=v"(r) : "v"(lo), "v"(hi)); return r; }

template <class Epi, class Sched, bool ALIGN_EPI = false, bool SP2 = false, int AMODE = 0, int KC = 0, int LDAC = 0>
__device__ __forceinline__ void gemm_phase(PG8_LAS unsigned char* lds, const Gemm g, const Sched& S, const Epi& E) {
    const int tid = threadIdx.x, wid = __builtin_amdgcn_readfirstlane(tid >> 6), lane = tid & 63, wr = wid >> 2, wc = wid & 3, fr = lane & 15, fq = lane >> 4;
    const int K = KC ? KC : g.K, nt = K / BK; const int lda = LDAC ? LDAC : g.lda;
    unsigned voffA[2], voffB[2];
#pragma unroll
    for (int i = 0; i < 2; ++i) { int R, C; stage_rc(tid * 16 + i * 8192, R, C); const int Rb = Epi::PERM ? ((R & ~31) + perm32(R & 31)) : R;
        voffA[i] = (unsigned)(R * lda + C) * 2u; voffB[i] = (unsigned)(Rb * K + C) * 2u; }
    const size_t kstep = (size_t)(BK * 2);
    const size_t hstepA = (size_t)HALF * lda * 2;
    const size_t hstepB = (size_t)HALF * K * 2;
    const size_t tstepB = 2 * hstepB;
    const unsigned ldsw = (unsigned)wid * 1024u;
    const int aoff = lds_byte(wr * 64 + fr, fq * 8), boff = lds_byte(wc * 32 + fr, fq * 8);
#define PG8_SA(b, h) (((b) * 2 + (h)) * HTB)
#define PG8_SB(b, h) ((4 + (b) * 2 + (h)) * HTB)
#define PG8_STAGE(bufoff, gbase, voff) do { _Pragma("unroll") for (int _i = 0; _i < 2; ++_i) \
        __builtin_amdgcn_global_load_lds((const unsigned*)((const char*)(gbase) + (voff)[_i]), (PG8_LAS unsigned*)(lds + (bufoff) + ldsw + _i * 8192), 16, 0, 0); } while (0)
#define PG8_LDA(dst, b, h) do { _Pragma("unroll") for (int m = 0; m < 4; ++m) _Pragma("unroll") for (int k = 0; k < 2; ++k) dst[m][k] = *(const PG8_LAS bf16x8*)(lds + PG8_SA(b, h) + aoff + m * 2048 + k * 1024); } while (0)
#define PG8_LDB(dst, b, h) do { _Pragma("unroll") for (int n = 0; n < 2; ++n) _Pragma("unroll") for (int k = 0; k < 2; ++k) dst[n][k] = *(const PG8_LAS bf16x8*)(lds + PG8_SB(b, h) + boff + n * 2048 + k * 1024); } while (0)
#define PG8_MMA(ai, bj, At, Bt) do { __builtin_amdgcn_s_setprio(1); _Pragma("unroll") for (int m = 0; m < 4; ++m) _Pragma("unroll") for (int n = 0; n < 2; ++n) _Pragma("unroll") for (int k = 0; k < 2; ++k) \
        acc[ai][bj][m][n] = __builtin_amdgcn_mfma_f32_16x16x32_bf16(Bt[n][k], At[m][k], acc[ai][bj][m][n], 0, 0, 0); __builtin_amdgcn_s_setprio(0); } while (0)
#define PG8_WAIT_V(n) asm volatile("s_waitcnt vmcnt(" #n ")" ::: "memory")
#define PG8_WAIT_L(n) asm volatile("s_waitcnt lgkmcnt(" #n ")" ::: "memory")
#define PG8_BAR __builtin_amdgcn_s_barrier()
#define PG8_SCHED __builtin_amdgcn_sched_barrier(0)
    Unit cur, nxt; int ui = 0;
    if (!S.next(0, cur)) return;
    f32x4 acc[2][2][4][2];
#pragma unroll
    for (int a = 0; a < 2; ++a)
#pragma unroll
        for (int b = 0; b < 2; ++b)
#pragma unroll
            for (int m = 0; m < 4; ++m)
#pragma unroll
                for (int n = 0; n < 2; ++n) acc[a][b][m][n] = (f32x4){0.f, 0.f, 0.f, 0.f};
    bf16x8 At[4][2], B0[2][2], B1[2][2];
    const char* cA = (const char*)g.A + a_off_bytes<AMODE>(g, cur); const char* cB = (const char*)g.Bt + (size_t)cur.pn * tstepB;
    S.a_ready(cur);
    if constexpr (SP2) {
        PG8_STAGE(PG8_SB(0, 0), cB, voffB); PG8_STAGE(PG8_SB(0, 1), cB + hstepB, voffB); PG8_STAGE(PG8_SA(0, 0), cA, voffA); PG8_STAGE(PG8_SA(0, 1), cA + hstepA, voffA);
        if (wr == 1) PG8_BAR;
        PG8_WAIT_V(2); PG8_BAR;
        PG8_STAGE(PG8_SB(1, 0), cB + kstep, voffB); PG8_STAGE(PG8_SA(1, 0), cA + kstep, voffA); PG8_STAGE(PG8_SB(1, 1), cB + hstepB + kstep, voffB);
        PG8_WAIT_V(6); PG8_BAR;
    } else {
        PG8_STAGE(PG8_SB(0, 0), cB, voffB); PG8_STAGE(PG8_SA(0, 0), cA, voffA); PG8_STAGE(PG8_SB(0, 1), cB + hstepB, voffB); PG8_STAGE(PG8_SA(0, 1), cA + hstepA, voffA);
        if (wr == 1) PG8_BAR;
        PG8_WAIT_V(4); PG8_BAR;
        PG8_STAGE(PG8_SB(1, 0), cB + kstep, voffB); PG8_STAGE(PG8_SA(1, 0), cA + kstep, voffA); PG8_STAGE(PG8_SB(1, 1), cB + hstepB + kstep, voffB);
        PG8_WAIT_V(6); PG8_BAR;
    }
    for (;;) {
        const bool has_next = S.next(ui + 1, nxt);
        const char* nA = has_next ? (const char*)g.A + a_off_bytes<AMODE>(g, nxt) : cA; const char* nB = has_next ? (const char*)g.Bt + (size_t)nxt.pn * tstepB : cB;
#pragma unroll 1
        for (int t = 0; t < nt; t += 2) {
            const bool last = (t == nt - 2);
            const char* a1 = cA + (size_t)(t + 1) * kstep;
            const char* a2 = last ? nA : cA + (size_t)(t + 2) * kstep; const char* b2 = last ? nB : cB + (size_t)(t + 2) * kstep;
            const char* a3 = a2 + kstep; const char* b3 = b2 + kstep;
            if (last && has_next) S.a_ready(nxt);
            if constexpr (SP2) {
            PG8_LDB(B0, 0, 0); PG8_LDB(B1, 0, 1); PG8_SCHED; PG8_LDA(At, 0, 0); PG8_STAGE(PG8_SA(1, 1), a1 + hstepA, voffA);
            PG8_WAIT_V(8); PG8_WAIT_L(0); PG8_BAR; PG8_MMA(0, 0, At, B0); PG8_MMA(0, 1, At, B1); PG8_BAR; PG8_SCHED;
            PG8_LDA(At, 0, 1); PG8_STAGE(PG8_SB(0, 0), b2, voffB); PG8_STAGE(PG8_SB(0, 1), b2 + hstepB, voffB); PG8_STAGE(PG8_SA(0, 0), a2, voffA);
            PG8_WAIT_V(8); PG8_WAIT_L(0); PG8_BAR; PG8_MMA(1, 0, At, B0); PG8_MMA(1, 1, At, B1); PG8_BAR; PG8_SCHED;
            PG8_LDB(B0, 1, 0); PG8_LDB(B1, 1, 1); PG8_SCHED; PG8_LDA(At, 1, 0); PG8_STAGE(PG8_SA(0, 1), a2 + hstepA, voffA);
            PG8_WAIT_V(8); PG8_WAIT_L(0); PG8_BAR; PG8_MMA(0, 0, At, B0); PG8_MMA(0, 1, At, B1); PG8_BAR; PG8_SCHED;
            PG8_LDA(At, 1, 1); PG8_STAGE(PG8_SB(1, 0), b3, voffB); PG8_STAGE(PG8_SB(1, 1), b3 + hstepB, voffB); PG8_STAGE(PG8_SA(1, 0), a3, voffA);
            PG8_WAIT_V(8); PG8_WAIT_L(0); PG8_BAR; PG8_MMA(1, 0, At, B0); PG8_MMA(1, 1, At, B1); PG8_BAR; PG8_SCHED;
            } else {
            PG8_LDB(B0, 0, 0); PG8_SCHED; PG8_LDA(At, 0, 0); PG8_STAGE(PG8_SA(1, 1), a1 + hstepA, voffA);
            PG8_WAIT_L(8); PG8_BAR; PG8_WAIT_L(0); PG8_MMA(0, 0, At, B0); PG8_BAR; PG8_SCHED;
            PG8_LDB(B1, 0, 1); PG8_STAGE(PG8_SB(0, 0), b2, voffB);
            PG8_BAR; PG8_WAIT_L(0); PG8_MMA(0, 1, At, B1); PG8_BAR;
            PG8_LDA(At, 0, 1); PG8_STAGE(PG8_SA(0, 0), a2, voffA);
            PG8_BAR; PG8_WAIT_L(0); PG8_MMA(1, 0, At, B0); PG8_BAR; PG8_SCHED;
            PG8_STAGE(PG8_SB(0, 1), b2 + hstepB, voffB);
            PG8_WAIT_V(6); PG8_BAR; PG8_MMA(1, 1, At, B1); PG8_BAR;
            PG8_LDB(B0, 1, 0); PG8_SCHED; PG8_LDA(At, 1, 0); PG8_STAGE(PG8_SA(0, 1), a2 + hstepA, voffA);
            PG8_WAIT_L(8); PG8_BAR; PG8_WAIT_L(0); PG8_MMA(0, 0, At, B0); PG8_BAR; PG8_SCHED;
            PG8_LDB(B1, 1, 1); PG8_STAGE(PG8_SB(1, 0), b3, voffB);
            PG8_BAR; PG8_WAIT_L(0); PG8_MMA(0, 1, At, B1); PG8_BAR;
            PG8_LDA(At, 1, 1); PG8_STAGE(PG8_SA(1, 0), a3, voffA);
            PG8_BAR; PG8_WAIT_L(0); PG8_MMA(1, 0, At, B0); PG8_BAR; PG8_SCHED;
            PG8_STAGE(PG8_SB(1, 1), b3 + hstepB, voffB);
            PG8_WAIT_V(6); PG8_BAR; PG8_MMA(1, 1, At, B1); PG8_BAR;
            }
        }
        if constexpr (ALIGN_EPI) { if (wr == 0) PG8_BAR; }
        E(acc, cur, wr, wc, fr, fq); S.done(cur);
        if (!has_next) break;
#pragma unroll
        for (int a = 0; a < 2; ++a)
#pragma unroll
            for (int b = 0; b < 2; ++b)
#pragma unroll
                for (int m = 0; m < 4; ++m)
#pragma unroll
                    for (int n = 0; n < 2; ++n) acc[a][b][m][n] = (f32x4){0.f, 0.f, 0.f, 0.f};
        cur = nxt; cA = nA; cB = nB; ++ui;
        if constexpr (ALIGN_EPI) { if (wr == 1) PG8_BAR; }
    }
    PG8_WAIT_V(0);
    if constexpr (!ALIGN_EPI) { if (wr == 0) PG8_BAR; }
    PG8_BAR;
#undef PG8_SA
#undef PG8_SB
#undef PG8_STAGE
#undef PG8_LDA
#undef PG8_LDB
#undef PG8_MMA
#undef PG8_WAIT_V
#undef PG8_WAIT_L
#undef PG8_BAR
#undef PG8_SCHED
}
}

constexpr int NB = 8, SEQ = 8192, DM = 1024, T = NB * SEQ;
constexpr int NPAD = 7424;
constexpr int NWAVES = 8, NTHR = 512;
constexpr int LDS_BYTES = 147456;
constexpr int N_PHASES = 15;

constexpr size_t MiB = 1ull << 20;
constexpr size_t WS_CTL = 0;
constexpr size_t WS_MODP = 1 * MiB;
constexpr size_t WS_WIN = 3 * MiB;
constexpr size_t WS_WOUT = 18 * MiB;
constexpr size_t WS_WQ = 20 * MiB;
constexpr size_t WS_LRUB = 24 * MiB;
constexpr size_t WS_SUBK = 25 * MiB;
constexpr size_t WS_LRUC = 26 * MiB;
constexpr size_t WS_U = 32 * MiB;
constexpr size_t WS_V = 64 * MiB;
constexpr size_t WS_QKV = 96 * MiB;
constexpr size_t WS_R = 352 * MiB;
constexpr size_t WS_XLXG = 480 * MiB;
constexpr size_t WS_GAGB = 736 * MiB;
constexpr size_t WS_ALOW = 992 * MiB;
constexpr size_t WS_END = 994 * MiB;
constexpr size_t WS_Y = WS_QKV;
constexpr size_t WS_H2 = WS_QKV + 128 * MiB;
constexpr size_t WS_QRY = WS_XLXG;
constexpr size_t WS_SC = WS_GAGB;
constexpr size_t WS_TOPK = WS_R;

#define LAS __attribute__((address_space(3)))
typedef unsigned short bf16;
typedef float f32x4 __attribute__((ext_vector_type(4)));
typedef float f32x2 __attribute__((ext_vector_type(2)));
typedef unsigned u32x4 __attribute__((ext_vector_type(4)));
typedef unsigned u32x2 __attribute__((ext_vector_type(2)));

struct Params {
    const float *x, *c, *w_ada, *b_ada, *npm, *npo, *w_in, *w_alpha, *b_alpha, *gla_norm, *conv_w, *conv_b,
        *lwa, *lba, *lwx, *lbx, *lam, *w_out, *npf, *npof, *wq, *subk, *pu, *pv;
    float* out; unsigned char* ws;
    int ph_lo, ph_hi;
};

__device__ __forceinline__ unsigned f2bf(float f) { unsigned u = __builtin_bit_cast(unsigned, f); return (u + 0x7fffu + ((u >> 16) & 1u)) >> 16; }
__device__ __forceinline__ unsigned pk2(float lo, float hi) { return f2bf(lo) | (f2bf(hi) << 16); }
__device__ __forceinline__ float bflo(unsigned u) { return __builtin_bit_cast(float, u << 16); }
__device__ __forceinline__ float bfhi(unsigned u) { return __builtin_bit_cast(float, u & 0xffff0000u); }
__device__ __forceinline__ float bf2f(bf16 h) { return __builtin_bit_cast(float, (unsigned)h << 16); }
__device__ __forceinline__ float sigmoid_f(float x) { return 1.f / (1.f + __expf(-x)); }
__device__ __forceinline__ float silu_f(float x) { return x / (1.f + __expf(-x)); }
__device__ __forceinline__ float gelu_f(float x) { const float u = 0.7978845608028654f * (x + 0.044715f * x * x * x); return x / (1.f + __expf(-2.f * u)); }
__device__ __forceinline__ float softplus_f(float x) { return fmaxf(x, 0.f) + log1pf(__expf(-fabsf(x))); }
__device__ __forceinline__ float wave_sum(float v) {
#pragma unroll
    for (int o = 1; o < 64; o <<= 1) v += __shfl_xor(v, o);
    return v;
}
#define LDS_WAIT() asm volatile("s_waitcnt lgkmcnt(0)" ::: "memory")

struct EpiSeg {
    static constexpr bool PERM = true;
    unsigned char* ws;
    __device__ __forceinline__ void operator()(const pg8::f32x4 (&acc)[2][2][4][2], const pg8::Unit& u, int wr, int wc, int fr, int fq) const {
        const int pn = u.pn; bf16* base; int ldc, colt;
        if (pn < 8) { base = (bf16*)(ws + WS_QKV); ldc = 2048; colt = pn * 256; }
        else if (pn < 12) { base = (bf16*)(ws + WS_R); ldc = 1024; colt = (pn - 8) * 256; }
        else if (pn < 20) { base = (bf16*)(ws + WS_XLXG); ldc = 2048; colt = (pn - 12) * 256; }
        else if (pn < 28) { base = (bf16*)(ws + WS_GAGB); ldc = 2048; colt = (pn - 20) * 256; }
        else { base = (bf16*)(ws + WS_ALOW); ldc = 16; colt = 0; }
        const int row0 = u.pm * 256 + wr * 64 + fr, col0 = colt + wc * 32 + 8 * fq;
        const bool tail = (pn == 28);
#pragma unroll
        for (int ai = 0; ai < 2; ++ai)
#pragma unroll
            for (int m = 0; m < 4; ++m) { bf16* rowp = base + (size_t)(row0 + ai * 128 + m * 16) * ldc + col0;
#pragma unroll
                for (int bj = 0; bj < 2; ++bj) { const pg8::f32x4 v0 = acc[ai][bj][m][0], v1 = acc[ai][bj][m][1];
                    u32x4 w; w.x = pg8::cvt_pk_bf16(v0[0], v0[1]); w.y = pg8::cvt_pk_bf16(v0[2], v0[3]); w.z = pg8::cvt_pk_bf16(v1[0], v1[1]); w.w = pg8::cvt_pk_bf16(v1[2], v1[3]);
                    if (!tail || (bj == 0 && wc == 0 && fq < 2)) *(u32x4*)(rowp + bj * 128) = w; } }
    }
};
struct EpiPlain {
    static constexpr bool PERM = true;
    bf16* O; int ldc;
    __device__ __forceinline__ void operator()(const pg8::f32x4 (&acc)[2][2][4][2], const pg8::Unit& u, int wr, int wc, int fr, int fq) const {
        const int row0 = u.pm * 256 + wr * 64 + fr, col0 = u.pn * 256 + wc * 32 + 8 * fq;
#pragma unroll
        for (int ai = 0; ai < 2; ++ai)
#pragma unroll
            for (int m = 0; m < 4; ++m) { bf16* rowp = O + (size_t)(row0 + ai * 128 + m * 16) * ldc + col0;
#pragma unroll
                for (int bj = 0; bj < 2; ++bj) { const pg8::f32x4 v0 = acc[ai][bj][m][0], v1 = acc[ai][bj][m][1];
                    u32x4 w; w.x = pg8::cvt_pk_bf16(v0[0], v0[1]); w.y = pg8::cvt_pk_bf16(v0[2], v0[3]); w.z = pg8::cvt_pk_bf16(v1[0], v1[1]); w.w = pg8::cvt_pk_bf16(v1[2], v1[3]);
                    *(u32x4*)(rowp + bj * 128) = w; } }
    }
};
typedef _Float16 h16x2 __attribute__((ext_vector_type(2)));
__device__ __forceinline__ unsigned pkh(float a, float b) { return __builtin_bit_cast(unsigned, __builtin_amdgcn_cvt_pkrtz(a, b)); }
struct EpiF16 {
    static constexpr bool PERM = true;
    unsigned short* O; int ldc;
    __device__ __forceinline__ void operator()(const pg8::f32x4 (&acc)[2][2][4][2], const pg8::Unit& u, int wr, int wc, int fr, int fq) const {
        const int row0 = u.pm * 256 + wr * 64 + fr, col0 = u.pn * 256 + wc * 32 + 8 * fq;
#pragma unroll
        for (int ai = 0; ai < 2; ++ai)
#pragma unroll
            for (int m = 0; m < 4; ++m) { unsigned short* rowp = O + (size_t)(row0 + ai * 128 + m * 16) * ldc + col0;
#pragma unroll
                for (int bj = 0; bj < 2; ++bj) { const pg8::f32x4 v0 = acc[ai][bj][m][0], v1 = acc[ai][bj][m][1];
                    u32x4 w; w.x = pkh(v0[0], v0[1]); w.y = pkh(v0[2], v0[3]); w.z = pkh(v1[0], v1[1]); w.w = pkh(v1[2], v1[3]);
                    *(u32x4*)(rowp + bj * 128) = w; } }
    }
};
struct EpiLru {
    static constexpr bool PERM = true;
    bf16* LA;   bf16* XCU;   const float *lba, *lbx, *lam;
    __device__ __forceinline__ void operator()(const pg8::f32x4 (&acc)[2][2][4][2], const pg8::Unit& u, int wr, int wc, int fr, int fq) const {
        const int row0 = u.pm * 256 + wr * 64 + fr, ch0 = u.pn * 128 + wc * 32 + 8 * fq;
        float ba[8], bx[8], sp[8];
#pragma unroll
        for (int j = 0; j < 8; ++j) { ba[j] = lba[ch0 + j]; bx[j] = lbx[ch0 + j]; sp[j] = -8.f * softplus_f(-lam[ch0 + j]); }
#pragma unroll
        for (int ai = 0; ai < 2; ++ai)
#pragma unroll
            for (int m = 0; m < 4; ++m) { const size_t row = (size_t)(row0 + ai * 128 + m * 16);
                const u32x4 xw = *(const u32x4*)(XCU + row * 1024 + ch0);
                float xc[8] = {bflo(xw.x), bfhi(xw.x), bflo(xw.y), bfhi(xw.y), bflo(xw.z), bfhi(xw.z), bflo(xw.w), bfhi(xw.w)};
                float la[8], uu[8];
#pragma unroll
                for (int j = 0; j < 8; ++j) { const float pr = acc[ai][0][m][j >> 2][j & 3] + ba[j], pi = acc[ai][1][m][j >> 2][j & 3] + bx[j];
                    const float gr = sigmoid_f(pr), gi = sigmoid_f(pi);
                    la[j] = sp[j] * gr; const float a2 = __expf(2.f * la[j]);
                    uu[j] = sqrtf(fmaxf(1.f - a2, 0.f)) * gi * xc[j]; }
                u32x4 w1, w2; w1.x = pk2(la[0], la[1]); w1.y = pk2(la[2], la[3]); w1.z = pk2(la[4], la[5]); w1.w = pk2(la[6], la[7]);
                w2.x = pk2(uu[0], uu[1]); w2.y = pk2(uu[2], uu[3]); w2.z = pk2(uu[4], uu[5]); w2.w = pk2(uu[6], uu[7]);
                *(u32x4*)(LA + row * 2048 + ch0) = w1; *(u32x4*)(XCU + row * 1024 + ch0) = w2; }
    }
};

__device__ __forceinline__ void p0_transpose_item(const float* W, int ldw, int k0, int n0, int nvalid, bf16* WT, int ldk, int row0, int kc0, LAS float* scr, int lane) {
#pragma unroll 8
    for (int i = 0; i < 32; ++i) { const int kk = 2 * i + (lane >> 5), cc = lane & 31; scr[kk * 33 + cc] = (cc < nvalid) ? W[(size_t)(k0 + kk) * ldw + n0 + cc] : 0.f; }
    LDS_WAIT(); asm volatile("" ::: "memory");
    const int c = lane & 7;
#pragma unroll
    for (int j = 0; j < 4; ++j) { const int n = (lane >> 3) + 8 * j; const LAS float* s = scr + (8 * c) * 33 + n;
        u32x4 o; o.x = pk2(s[0 * 33], s[1 * 33]); o.y = pk2(s[2 * 33], s[3 * 33]); o.z = pk2(s[4 * 33], s[5 * 33]); o.w = pk2(s[6 * 33], s[7 * 33]);
        *(u32x4*)(WT + (size_t)(row0 + n) * ldk + kc0 + k0 + 8 * c) = o; }
    LDS_WAIT(); asm volatile("" ::: "memory");
}
__device__ __forceinline__ void phase0(const Params& p, LAS unsigned char* lds, int G) {
    const int tid = threadIdx.x, lane = tid & 63, wave = __builtin_amdgcn_readfirstlane(tid >> 6);
    unsigned char* ws = p.ws;
    {
        LAS float* sc = (LAS float*)lds;
        LAS float* red = (LAS float*)(lds + 4096);
        float* modp = (float*)(ws + WS_MODP);
        for (int it = blockIdx.x; it < 24 * 8; it += G) {
            const int nb = it % 24, kc = it / 24;
            for (int i = tid; i < 1024; i += NTHR) { const int b = i >> 7, k = i & 127; sc[i] = silu_f(p.c[b * 1024 + kc * 128 + k]); }
            __syncthreads();
            const int col = tid & 255, kh = tid >> 8;
            float acc[8];
#pragma unroll
            for (int b = 0; b < 8; ++b) acc[b] = 0.f;
            const float* wp = p.w_ada + (size_t)(kc * 128 + kh * 64) * 6144 + nb * 256 + col;
#pragma unroll 8
            for (int kk = 0; kk < 64; ++kk) { const float w = wp[(size_t)kk * 6144];
#pragma unroll
                for (int b = 0; b < 8; ++b) acc[b] += sc[b * 128 + kh * 64 + kk] * w; }
            if (kh == 1) {
#pragma unroll
                for (int b = 0; b < 8; ++b) red[b * 256 + col] = acc[b]; }
            __syncthreads();
            if (kh == 0) { const int n = nb * 256 + col; const float bias = (kc == 0) ? p.b_ada[n] : 0.f;
#pragma unroll
                for (int b = 0; b < 8; ++b) modp[(size_t)(kc * 8 + b) * 6144 + n] = acc[b] + red[b * 256 + col] + bias; }
            __syncthreads();
        }
    }
    LAS float* scr = (LAS float*)(lds + 16384 + wave * 8448);
    const int gw = blockIdx.x * NWAVES + wave, NGW = G * NWAVES;
    bf16* WinT = (bf16*)(ws + WS_WIN); bf16* WoutT = (bf16*)(ws + WS_WOUT); bf16* WqT = (bf16*)(ws + WS_WQ);
    bf16* LruB = (bf16*)(ws + WS_LRUB); bf16* SubK = (bf16*)(ws + WS_SUBK);
    constexpr int I_IN = 16 * (NPAD / 32), I_OUT = 16 * 32, I_Q = 16 * 64, I_LRU = 16 * 8, I_SUB = 2048, I_TAB = 2 * 16384;
    constexpr int NIT = I_IN + I_OUT + I_Q + I_LRU + I_SUB + I_TAB;
    for (int it = gw; it < NIT; it += NGW) {
        int r = it;
        if (r < I_IN) { const int nb = r % (NPAD / 32), kb = r / (NPAD / 32), nq = nb * 32; int n0, nv;
            if (nq < 3072) { n0 = nq; nv = 32; } else if (nq < 7168) { n0 = nq + 16; nv = 32; } else if (nq == 7168) { n0 = 3072; nv = 16; } else { n0 = 0; nv = 0; }
            p0_transpose_item(p.w_in, 7184, kb * 64, n0, nv, WinT, 1024, nq, 0, scr, lane); continue; } r -= I_IN;
        if (r < I_OUT) { const int nb = r % 32, kb = r / 32; p0_transpose_item(p.w_out, 1024, kb * 64, nb * 32, 32, WoutT, 1024, nb * 32, 0, scr, lane); continue; } r -= I_OUT;
        if (r < I_Q) { const int nb = r % 64, kb = r / 64; p0_transpose_item(p.wq, 2048, kb * 64, nb * 32, 32, WqT, 1024, nb * 32, 0, scr, lane); continue; } r -= I_Q;
        if (r < I_LRU) {
            const int mat = r >> 3, sub = r & 7, g = mat >> 3, n = mat & 7, kb = sub >> 2, nb = sub & 3;
            const int np = n < 6 ? n : 6, half = n - np;
            const float* W = (g ? p.lwx : p.lwa) + (size_t)n * 128 * 128;
            bf16* dst = LruB + (size_t)n * 256 * 256;
            p0_transpose_item(W, 128, kb * 64, nb * 32, 32, dst, 256, g * 128 + nb * 32, half * 128, scr, lane);
            p0_transpose_item(W, 128, kb * 64, 0, 0, dst, 256, g * 128 + nb * 32, (1 - half) * 128, scr, lane);
            continue; } r -= I_LRU;
        if (r < I_SUB) {
            const int h = r >> 8, pp = (r >> 7) & 1, n = r & 127;
            const float* src = p.subk + (size_t)r * 128; bf16* dst = SubK + ((size_t)h * 256 + pp * 128 + n) * 256;
            const f32x2 v = *(const f32x2*)(src + 2 * lane);
            *(unsigned*)(dst + pp * 128 + 2 * lane) = pk2(v.x, v.y);
            *(unsigned*)(dst + (1 - pp) * 128 + 2 * lane) = 0u;
            continue; } r -= I_SUB;
        {
            const int tb = r >> 14, row = r & 16383;
            const float* src = (tb ? p.pv : p.pu) + (size_t)row * 1024; bf16* dst = (bf16*)(ws + (tb ? WS_V : WS_U)) + (size_t)row * 1024;
#pragma unroll
            for (int j = 0; j < 2; ++j) { const f32x4 a = *(const f32x4*)(src + j * 512 + lane * 8), b = *(const f32x4*)(src + j * 512 + lane * 8 + 4);
                u32x4 o; o.x = pk2(a.x, a.y); o.y = pk2(a.z, a.w); o.z = pk2(b.x, b.y); o.w = pk2(b.z, b.w);
                *(u32x4*)(dst + j * 512 + lane * 8) = o; }
        }
    }
}

__device__ __forceinline__ float mod_at(const float* modp, int b, int n) {
    float s = 0.f;
#pragma unroll
    for (int kc = 0; kc < 8; ++kc) s += modp[(size_t)(kc * 8 + b) * 6144 + n];
    return s;
}

__device__ __forceinline__ void phase1(const Params& p, LAS unsigned char* lds, int G) {
    const int tid = threadIdx.x, lane = tid & 63, wave = __builtin_amdgcn_readfirstlane(tid >> 6);
    const float* modp = (const float*)(p.ws + WS_MODP);
    LAS float* gs = (LAS float*)lds; LAS float* sh = gs + 1024;
    bf16* H = (bf16*)p.out;
    for (int tile = blockIdx.x; tile < T / 256; tile += G) {
        const int b = tile / 32;
        __syncthreads();
        for (int k = tid; k < 1024; k += NTHR) { gs[k] = p.npm[k] * (1.f + mod_at(modp, b, 1024 + k)); sh[k] = mod_at(modp, b, k); }
        __syncthreads();
        for (int rr = 0; rr < 32; ++rr) {
            const size_t row = (size_t)tile * 256 + wave * 32 + rr;
            const f32x4* xr = (const f32x4*)(p.x + row * 1024) + lane;
            f32x4 v[4]; float s = 0.f;
#pragma unroll
            for (int j = 0; j < 4; ++j) { v[j] = xr[64 * j]; s += (v[j].x * v[j].x + v[j].y * v[j].y) + (v[j].z * v[j].z + v[j].w * v[j].w); }
            const float rstd = 1.f / sqrtf(wave_sum(s) * (1.f / 1024.f) + 1e-6f);
            u32x2* o8 = (u32x2*)(H + row * 1024) + lane;
#pragma unroll
            for (int j = 0; j < 4; ++j) { const int k = 256 * j + 4 * lane; const f32x4 g4 = *(const LAS f32x4*)(gs + k), s4 = *(const LAS f32x4*)(sh + k);
                u32x2 w; w.x = pk2(v[j].x * rstd * g4.x + s4.x, v[j].y * rstd * g4.y + s4.y); w.y = pk2(v[j].z * rstd * g4.z + s4.z, v[j].w * rstd * g4.w + s4.w);
                o8[64 * j] = w; }
        }
    }
}

__device__ __forceinline__ void phase_conv(const Params& p, int G) {
    const int tid = threadIdx.x, lane = tid & 63, wave = __builtin_amdgcn_readfirstlane(tid >> 6);
    const int gw = blockIdx.x * NWAVES + wave, NGW = G * NWAVES;
    const bf16* XL = (const bf16*)(p.ws + WS_XLXG); bf16* XC = (bf16*)p.out;
    for (int it = gw; it < (T / 64) * 2; it += NGW) {
        const int rt = it >> 1, c0 = (it & 1) * 512 + lane * 8;
        float w[4][8], cb[8];
#pragma unroll
        for (int j = 0; j < 8; ++j) { cb[j] = p.conv_b[c0 + j];
#pragma unroll
            for (int q = 0; q < 4; ++q) w[q][j] = p.conv_w[q * 1024 + c0 + j]; }
        float x1[8], x2[8], x3[8];
        const int t0 = rt * 64; const bool first = (t0 % SEQ) == 0;
#pragma unroll
        for (int j = 0; j < 8; ++j) { x1[j] = 0.f; x2[j] = 0.f; x3[j] = 0.f; }
        if (!first) {
            const u32x4 a = *(const u32x4*)(XL + (size_t)(t0 - 1) * 2048 + c0), b = *(const u32x4*)(XL + (size_t)(t0 - 2) * 2048 + c0), c = *(const u32x4*)(XL + (size_t)(t0 - 3) * 2048 + c0);
            x1[0] = bflo(a.x); x1[1] = bfhi(a.x); x1[2] = bflo(a.y); x1[3] = bfhi(a.y); x1[4] = bflo(a.z); x1[5] = bfhi(a.z); x1[6] = bflo(a.w); x1[7] = bfhi(a.w);
            x2[0] = bflo(b.x); x2[1] = bfhi(b.x); x2[2] = bflo(b.y); x2[3] = bfhi(b.y); x2[4] = bflo(b.z); x2[5] = bfhi(b.z); x2[6] = bflo(b.w); x2[7] = bfhi(b.w);
            x3[0] = bflo(c.x); x3[1] = bfhi(c.x); x3[2] = bflo(c.y); x3[3] = bfhi(c.y); x3[4] = bflo(c.z); x3[5] = bfhi(c.z); x3[6] = bflo(c.w); x3[7] = bfhi(c.w);
        }
#pragma unroll 4
        for (int i = 0; i < 64; ++i) {
            const u32x4 a = *(const u32x4*)(XL + (size_t)(t0 + i) * 2048 + c0);
            float x0[8] = {bflo(a.x), bfhi(a.x), bflo(a.y), bfhi(a.y), bflo(a.z), bfhi(a.z), bflo(a.w), bfhi(a.w)};
            float o[8];
#pragma unroll
            for (int j = 0; j < 8; ++j) { o[j] = cb[j] + w[0][j] * x3[j] + w[1][j] * x2[j] + w[2][j] * x1[j] + w[3][j] * x0[j]; x3[j] = x2[j]; x2[j] = x1[j]; x1[j] = x0[j]; }
            u32x4 wv; wv.x = pk2(o[0], o[1]); wv.y = pk2(o[2], o[3]); wv.z = pk2(o[4], o[5]); wv.w = pk2(o[6], o[7]);
            *(u32x4*)(XC + (size_t)(t0 + i) * 1024 + c0) = wv;
        }
    }
}

template <bool FINAL>
__device__ __forceinline__ void phase_lru_scan(const Params& p, int G) {
    const int tid = threadIdx.x;
    const bf16* LA = (const bf16*)(p.ws + WS_XLXG); const bf16* U = (const bf16*)p.out;
    const bf16* XG = (const bf16*)(p.ws + WS_XLXG) + 1024; bf16* GB = (bf16*)(p.ws + WS_GAGB) + 1024;
    f32x2* car = (f32x2*)(p.ws + WS_LRUC);
    for (int it = blockIdx.x; it < 8 * 32 * 2; it += G) {
        const int cg_ = it & 1, j = (it >> 1) & 31, b = it >> 6, ch = cg_ * 512 + tid;
        const size_t t0 = (size_t)b * SEQ + j * 256;
        if (!FINAL) {
            float h = 0.f, ls = 0.f;
#pragma unroll 8
            for (int i = 0; i < 256; ++i) { const float la = bf2f(LA[(t0 + i) * 2048 + ch]), u = bf2f(U[(t0 + i) * 1024 + ch]);
                h = __expf(la) * h + u; ls += la; }
            car[(size_t)(b * 32 + j) * 1024 + ch] = (f32x2){__expf(ls), h};
        } else {
            float h = 0.f;
            for (int i = 0; i < j; ++i) { const f32x2 c = car[(size_t)(b * 32 + i) * 1024 + ch]; h = c.x * h + c.y; }
#pragma unroll 8
            for (int i = 0; i < 256; ++i) { const float la = bf2f(LA[(t0 + i) * 2048 + ch]), u = bf2f(U[(t0 + i) * 1024 + ch]);
                h = __expf(la) * h + u;
                const float xg = bf2f(XG[(t0 + i) * 2048 + ch]), gb = bf2f(GB[(t0 + i) * 2048 + ch]);
                GB[(t0 + i) * 2048 + ch] = (bf16)f2bf(h * gelu_f(xg) * sigmoid_f(gb)); }
        }
    }
}

__device__ __forceinline__ void phase_gla_naive(const Params& p, LAS unsigned char* lds, int G) {
    const int tid = threadIdx.x;
    constexpr int TB = 32;
    LAS float* sA = (LAS float*)lds;
    LAS float* sK = sA + TB * 128;
    LAS float* sQ = sK + TB * 128;
    LAS float* sV = sQ + TB * 128;
    LAS float* sO = sV + TB * 64;
    const bf16* QKV = (const bf16*)(p.ws + WS_QKV); bf16* VO = (bf16*)(p.ws + WS_QKV);
    const bf16* AL = (const bf16*)(p.ws + WS_ALOW);
    for (int it = blockIdx.x; it < 8 * 4 * 4; it += G) {
        const int vs = it & 3, h = (it >> 2) & 3, b = it >> 4;
        const int vv = tid >> 3, kg = tid & 7;
        const int kp = tid & 127;
        float wa[16];
#pragma unroll
        for (int r = 0; r < 16; ++r) wa[r] = p.w_alpha[r * 512 + h * 128 + kp];
        const float balpha = p.b_alpha[h * 128 + kp];
        float S[16];
#pragma unroll
        for (int j = 0; j < 16; ++j) S[j] = 0.f;
        for (int tb = 0; tb < SEQ / TB; ++tb) {
            const size_t t0 = (size_t)b * SEQ + tb * TB;
            __syncthreads();
#pragma unroll
            for (int ps = 0; ps < TB / 4; ++ps) { const int tt = ps * 4 + (tid >> 7); const size_t t = t0 + tt;
                const u32x4 a0 = *(const u32x4*)(AL + t * 16), a1 = *(const u32x4*)(AL + t * 16 + 8);
                float z = balpha;
                z += bflo(a0.x) * wa[0] + bfhi(a0.x) * wa[1] + bflo(a0.y) * wa[2] + bfhi(a0.y) * wa[3] + bflo(a0.z) * wa[4] + bfhi(a0.z) * wa[5] + bflo(a0.w) * wa[6] + bfhi(a0.w) * wa[7];
                z += bflo(a1.x) * wa[8] + bfhi(a1.x) * wa[9] + bflo(a1.y) * wa[10] + bfhi(a1.y) * wa[11] + bflo(a1.z) * wa[12] + bfhi(a1.z) * wa[13] + bflo(a1.w) * wa[14] + bfhi(a1.w) * wa[15];
                const float ls = fminf(z, 0.f) - log1pf(__expf(-fabsf(z)));
                sA[tt * 128 + kp] = __expf(ls * (1.f / 16.f));
                sQ[tt * 128 + kp] = bf2f(QKV[t * 2048 + h * 128 + kp]) * 0.08838834764831845f;
                sK[tt * 128 + kp] = bf2f(QKV[t * 2048 + 512 + h * 128 + kp]); }
#pragma unroll
            for (int ps = 0; ps < TB * 64 / NTHR; ++ps) { const int e = ps * NTHR + tid, tt = e >> 6, v = e & 63;
                sV[e] = bf2f(QKV[(t0 + tt) * 2048 + 1024 + h * 256 + vs * 64 + v]); }
            __syncthreads();
            for (int tt = 0; tt < TB; ++tt) {
                const float vx = sV[tt * 64 + vv];
                float o = 0.f;
#pragma unroll
                for (int q4 = 0; q4 < 4; ++q4) {
                    const f32x4 a = *(const LAS f32x4*)(sA + tt * 128 + kg * 16 + q4 * 4), kk = *(const LAS f32x4*)(sK + tt * 128 + kg * 16 + q4 * 4), qq = *(const LAS f32x4*)(sQ + tt * 128 + kg * 16 + q4 * 4);
                    S[q4 * 4 + 0] = a.x * S[q4 * 4 + 0] + kk.x * vx; o += qq.x * S[q4 * 4 + 0];
                    S[q4 * 4 + 1] = a.y * S[q4 * 4 + 1] + kk.y * vx; o += qq.y * S[q4 * 4 + 1];
                    S[q4 * 4 + 2] = a.z * S[q4 * 4 + 2] + kk.z * vx; o += qq.z * S[q4 * 4 + 2];
                    S[q4 * 4 + 3] = a.w * S[q4 * 4 + 3] + kk.w * vx; o += qq.w * S[q4 * 4 + 3];
                }
                o += __shfl_xor(o, 1); o += __shfl_xor(o, 2); o += __shfl_xor(o, 4);
                if (kg == 0) sO[tt * 64 + vv] = o;
            }
            __syncthreads();
#pragma unroll
            for (int ps = 0; ps < TB * 64 / NTHR; ++ps) { const int e = ps * NTHR + tid, tt = e >> 6, v = e & 63;
                VO[(t0 + tt) * 2048 + 1024 + h * 256 + vs * 64 + v] = (bf16)f2bf(sO[e]); }
        }
    }
}

__device__ __forceinline__ void phase_gla_final(const Params& p, int G) {
    const int tid = threadIdx.x, lane = tid & 63, wave = __builtin_amdgcn_readfirstlane(tid >> 6);
    const int gw = blockIdx.x * NWAVES + wave, NGW = G * NWAVES;
    const bf16* O = (const bf16*)(p.ws + WS_QKV) + 1024; const bf16* R = (const bf16*)(p.ws + WS_R); bf16* GA = (bf16*)(p.ws + WS_GAGB);
    for (int row = gw; row < T; row += NGW) {
#pragma unroll
        for (int h = 0; h < 4; ++h) { const int c0 = h * 256 + lane * 4;
            const u32x2 ov = *(const u32x2*)(O + (size_t)row * 2048 + c0), rv = *(const u32x2*)(R + (size_t)row * 1024 + c0);
            const u32x2 gav = *(const u32x2*)(GA + (size_t)row * 2048 + c0), tv = *(const u32x2*)(GA + (size_t)row * 2048 + 1024 + c0);
            const float o[4] = {bflo(ov.x), bfhi(ov.x), bflo(ov.y), bfhi(ov.y)}, r[4] = {bflo(rv.x), bfhi(rv.x), bflo(rv.y), bfhi(rv.y)};
            const float ga[4] = {bflo(gav.x), bfhi(gav.x), bflo(gav.y), bfhi(gav.y)}, tm[4] = {bflo(tv.x), bfhi(tv.x), bflo(tv.y), bfhi(tv.y)};
            const float ss = wave_sum((o[0] * o[0] + o[1] * o[1]) + (o[2] * o[2] + o[3] * o[3]));
            const float rstd = 1.f / sqrtf(ss * (1.f / 256.f) + 1e-6f);
            const f32x4 gn = *(const f32x4*)(p.gla_norm + c0);
            float m[4];
#pragma unroll
            for (int j = 0; j < 4; ++j) m[j] = sigmoid_f(ga[j]) * (o[j] * rstd * gn[j] * silu_f(r[j])) + tm[j];
            u32x2 w; w.x = pk2(m[0], m[1]); w.y = pk2(m[2], m[3]);
            *(u32x2*)(GA + (size_t)row * 2048 + c0) = w; }
    }
}

__device__ __forceinline__ void phase_norm2(const Params& p, LAS unsigned char* lds, int G) {
    const int tid = threadIdx.x, lane = tid & 63, wave = __builtin_amdgcn_readfirstlane(tid >> 6);
    const float* modp = (const float*)(p.ws + WS_MODP);
    LAS float* g1 = (LAS float*)lds; LAS float* gs = g1 + 1024; LAS float* sh = gs + 1024;
    const bf16* Y = (const bf16*)(p.ws + WS_Y); bf16* H2 = (bf16*)(p.ws + WS_H2);
    for (int tile = blockIdx.x; tile < T / 256; tile += G) {
        const int b = tile / 32;
        __syncthreads();
        for (int k = tid; k < 1024; k += NTHR) { g1[k] = mod_at(modp, b, 2048 + k) * p.npo[k]; gs[k] = p.npf[k] * (1.f + mod_at(modp, b, 4096 + k)); sh[k] = mod_at(modp, b, 3072 + k); }
        __syncthreads();
        for (int rr = 0; rr < 32; ++rr) {
            const size_t row = (size_t)tile * 256 + wave * 32 + rr;
            const f32x4* xr = (const f32x4*)(p.x + row * 1024) + lane; const u32x2* yr = (const u32x2*)(Y + row * 1024) + lane;
            f32x4 xv[4], yv[4]; float s = 0.f;
#pragma unroll
            for (int j = 0; j < 4; ++j) { xv[j] = xr[64 * j]; const u32x2 yw = yr[64 * j]; yv[j] = (f32x4){bflo(yw.x), bfhi(yw.x), bflo(yw.y), bfhi(yw.y)};
                s += (yv[j].x * yv[j].x + yv[j].y * yv[j].y) + (yv[j].z * yv[j].z + yv[j].w * yv[j].w); }
            const float rstd = 1.f / sqrtf(wave_sum(s) * (1.f / 1024.f) + 1e-6f);
            float s2 = 0.f;
            f32x4* orow = (f32x4*)(p.out + row * 1024) + lane;
#pragma unroll
            for (int j = 0; j < 4; ++j) { const int k = 256 * j + 4 * lane; const f32x4 g4 = *(const LAS f32x4*)(g1 + k);
                xv[j] = xv[j] + yv[j] * rstd * g4; orow[64 * j] = xv[j];
                s2 += (xv[j].x * xv[j].x + xv[j].y * xv[j].y) + (xv[j].z * xv[j].z + xv[j].w * xv[j].w); }
            const float rstd2 = 1.f / sqrtf(wave_sum(s2) * (1.f / 1024.f) + 1e-6f);
            u32x2* o8 = (u32x2*)(H2 + row * 1024) + lane;
#pragma unroll
            for (int j = 0; j < 4; ++j) { const int k = 256 * j + 4 * lane; const f32x4 g4 = *(const LAS f32x4*)(gs + k), s4 = *(const LAS f32x4*)(sh + k);
                u32x2 w; w.x = pk2(xv[j].x * rstd2 * g4.x + s4.x, xv[j].y * rstd2 * g4.y + s4.y); w.y = pk2(xv[j].z * rstd2 * g4.z + s4.z, xv[j].w * rstd2 * g4.w + s4.w);
                o8[64 * j] = w; }
        }
    }
}

__device__ __forceinline__ unsigned h16_key(unsigned b) { return (b & 0x8000u) ? (~b & 0xffffu) : (b | 0x8000u); }
__device__ __forceinline__ float h16_key_val(unsigned s) { const unsigned b = (s & 0x8000u) ? (s & 0x7fffu) : (~s & 0xffffu); return (float)__builtin_bit_cast(_Float16, (unsigned short)b); }
#define INS16(top, x) do { _Pragma("unroll") for (int _j = 0; _j < 16; ++_j) { const unsigned _hi = max(top[_j], x), _lo = min(top[_j], x); top[_j] = _hi; x = _lo; } } while (0)
__device__ __forceinline__ void phase_topk(const Params& p, LAS unsigned char* lds, int G) {
    const int tid = threadIdx.x;
    const unsigned short* SC = (const unsigned short*)(p.ws + WS_SC); unsigned* TK = (unsigned*)(p.ws + WS_TOPK);
    LAS unsigned* my = (LAS unsigned*)lds + tid * 33;
    for (int blk = blockIdx.x; blk < T * 8 / NTHR; blk += G) {
        const int item = blk * NTHR + tid, t = item >> 3, h = item & 7;
        unsigned topA[16], topB[16];
#pragma unroll
        for (int j = 0; j < 16; ++j) { topA[j] = 0u; topB[j] = 0u; }
        const u32x4* src = (const u32x4*)(SC + (size_t)t * 2048 + h * 256);
#pragma unroll 1
        for (int c8 = 0; c8 < 16; ++c8) { const u32x4 w = src[c8];
            const unsigned ww[4] = {w.x, w.y, w.z, w.w};
#pragma unroll
            for (int q = 0; q < 4; ++q) { unsigned k0 = (h16_key(ww[q] & 0xffffu) << 16) | (unsigned)(127 - (c8 * 8 + q * 2)), k1 = (h16_key(ww[q] >> 16) << 16) | (unsigned)(127 - (c8 * 8 + q * 2 + 1));
                INS16(topA, k0); INS16(topA, k1); } }
#pragma unroll 1
        for (int c8 = 0; c8 < 16; ++c8) { const u32x4 w = src[16 + c8];
            const unsigned ww[4] = {w.x, w.y, w.z, w.w};
#pragma unroll
            for (int q = 0; q < 4; ++q) { unsigned k0 = (h16_key(ww[q] & 0xffffu) << 16) | (unsigned)(127 - (c8 * 8 + q * 2)), k1 = (h16_key(ww[q] >> 16) << 16) | (unsigned)(127 - (c8 * 8 + q * 2 + 1));
                INS16(topB, k0); INS16(topB, k1); } }
        float fa[16], fb[16];
#pragma unroll
        for (int j = 0; j < 16; ++j) { fa[j] = h16_key_val(topA[j] >> 16); fb[j] = h16_key_val(topB[j] >> 16); my[j] = 127u - (topA[j] & 127u); my[16 + j] = 127u - (topB[j] & 127u); }
        unsigned ct[16];
#pragma unroll
        for (int j = 0; j < 16; ++j) ct[j] = 0u;
#pragma unroll
        for (int i = 0; i < 16; ++i)
#pragma unroll
            for (int j = 0; j < 16; ++j) if ((i + 1) * (j + 1) <= 16) {
                const float s = fa[i] + fb[j]; unsigned u = __builtin_bit_cast(unsigned, s); u ^= (u >> 31) ? 0xffffffffu : 0x80000000u;
                unsigned key = (u & 0xffffff00u) | (unsigned)(255 - (i * 16 + j));
                INS16(ct, key); }
        float val[16], mx, sum = 0.f;
#pragma unroll
        for (int m = 0; m < 16; ++m) { unsigned u = ct[m] & 0xffffff00u; u ^= (u >> 31) ? 0x80000000u : 0xffffffffu; val[m] = __builtin_bit_cast(float, u); }
        mx = val[0];
#pragma unroll
        for (int m = 0; m < 16; ++m) { val[m] = __expf(val[m] - mx); sum += val[m]; }
        const float inv = 1.f / sum;
        LDS_WAIT();
        unsigned outw[16];
#pragma unroll
        for (int m = 0; m < 16; ++m) { const unsigned pos = 255u - (ct[m] & 255u), i = pos >> 4, j = pos & 15u;
            const unsigned e = my[i] * 128u + my[16 + j];
            outw[m] = (e << 16) | f2bf(val[m] * inv); }
        u32x4* dst = (u32x4*)(TK + (size_t)item * 16);
#pragma unroll
        for (int q = 0; q < 4; ++q) dst[q] = (u32x4){outw[4 * q], outw[4 * q + 1], outw[4 * q + 2], outw[4 * q + 3]};
    }
}

__device__ __forceinline__ void phase_gather(const Params& p, LAS unsigned char* lds, int G) {
    const int tid = threadIdx.x, lane = tid & 63, wave = __builtin_amdgcn_readfirstlane(tid >> 6);
    const float* modp = (const float*)(p.ws + WS_MODP);
    LAS float* g2 = (LAS float*)lds;
    const bf16* H2 = (const bf16*)(p.ws + WS_H2); const unsigned* TK = (const unsigned*)(p.ws + WS_TOPK);
    const bf16* UT = (const bf16*)(p.ws + WS_U); const bf16* VT = (const bf16*)(p.ws + WS_V);
    for (int tile = blockIdx.x; tile < T / 256; tile += G) {
        const int b = tile / 32;
        __syncthreads();
        for (int k = tid; k < 1024; k += NTHR) g2[k] = mod_at(modp, b, 5120 + k) * p.npof[k];
        __syncthreads();
        for (int rr = 0; rr < 32; ++rr) {
            const size_t row = (size_t)tile * 256 + wave * 32 + rr;
            float xt[16];
            { const u32x4 a = *(const u32x4*)(H2 + row * 1024 + lane * 8), c = *(const u32x4*)(H2 + row * 1024 + 512 + lane * 8);
              xt[0] = bflo(a.x); xt[1] = bfhi(a.x); xt[2] = bflo(a.y); xt[3] = bfhi(a.y); xt[4] = bflo(a.z); xt[5] = bfhi(a.z); xt[6] = bflo(a.w); xt[7] = bfhi(a.w);
              xt[8] = bflo(c.x); xt[9] = bfhi(c.x); xt[10] = bflo(c.y); xt[11] = bfhi(c.y); xt[12] = bflo(c.z); xt[13] = bfhi(c.z); xt[14] = bflo(c.w); xt[15] = bfhi(c.w); }
            const unsigned tk0 = TK[row * 128 + lane], tk1 = TK[row * 128 + 64 + lane];
            float acc[16];
#pragma unroll
            for (int j = 0; j < 16; ++j) acc[j] = 0.f;
#pragma unroll 1
            for (int g = 0; g < 32; ++g) {
                unsigned ew[4]; u32x4 ua[4], ub[4], va[4], vb[4];
#pragma unroll
                for (int q = 0; q < 4; ++q) { const int e = g * 4 + q; ew[q] = (unsigned)__shfl((int)(e < 64 ? tk0 : tk1), e & 63);
                    const size_t er = (size_t)(ew[q] >> 16) * 1024;
                    ua[q] = *(const u32x4*)(UT + er + lane * 8); ub[q] = *(const u32x4*)(UT + er + 512 + lane * 8);
                    va[q] = *(const u32x4*)(VT + er + lane * 8); vb[q] = *(const u32x4*)(VT + er + 512 + lane * 8); }
#pragma unroll
                for (int q = 0; q < 4; ++q) {
                    float d = 0.f;
                    d += xt[0] * bflo(ua[q].x) + xt[1] * bfhi(ua[q].x) + xt[2] * bflo(ua[q].y) + xt[3] * bfhi(ua[q].y) + xt[4] * bflo(ua[q].z) + xt[5] * bfhi(ua[q].z) + xt[6] * bflo(ua[q].w) + xt[7] * bfhi(ua[q].w);
                    d += xt[8] * bflo(ub[q].x) + xt[9] * bfhi(ub[q].x) + xt[10] * bflo(ub[q].y) + xt[11] * bfhi(ub[q].y) + xt[12] * bflo(ub[q].z) + xt[13] * bfhi(ub[q].z) + xt[14] * bflo(ub[q].w) + xt[15] * bfhi(ub[q].w);
                    d = wave_sum(d);
                    const float coef = bflo(ew[q]) * gelu_f(d);
                    acc[0] += coef * bflo(va[q].x); acc[1] += coef * bfhi(va[q].x); acc[2] += coef * bflo(va[q].y); acc[3] += coef * bfhi(va[q].y);
                    acc[4] += coef * bflo(va[q].z); acc[5] += coef * bfhi(va[q].z); acc[6] += coef * bflo(va[q].w); acc[7] += coef * bfhi(va[q].w);
                    acc[8] += coef * bflo(vb[q].x); acc[9] += coef * bfhi(vb[q].x); acc[10] += coef * bflo(vb[q].y); acc[11] += coef * bfhi(vb[q].y);
                    acc[12] += coef * bflo(vb[q].z); acc[13] += coef * bfhi(vb[q].z); acc[14] += coef * bflo(vb[q].w); acc[15] += coef * bfhi(vb[q].w);
                }
            }
            float s = 0.f;
#pragma unroll
            for (int j = 0; j < 16; ++j) s += acc[j] * acc[j];
            const float rstd = 1.f / sqrtf(wave_sum(s) * (1.f / 1024.f) + 1e-6f);
            float* orow = p.out + row * 1024;
#pragma unroll
            for (int hh = 0; hh < 2; ++hh) { const int k = hh * 512 + lane * 8;
                f32x4 o0 = *(const f32x4*)(orow + k), o1 = *(const f32x4*)(orow + k + 4);
                const f32x4 ga = *(const LAS f32x4*)(g2 + k), gb = *(const LAS f32x4*)(g2 + k + 4);
                o0.x += ga.x * acc[hh * 8 + 0] * rstd; o0.y += ga.y * acc[hh * 8 + 1] * rstd; o0.z += ga.z * acc[hh * 8 + 2] * rstd; o0.w += ga.w * acc[hh * 8 + 3] * rstd;
                o1.x += gb.x * acc[hh * 8 + 4] * rstd; o1.y += gb.y * acc[hh * 8 + 5] * rstd; o1.z += gb.z * acc[hh * 8 + 6] * rstd; o1.w += gb.w * acc[hh * 8 + 7] * rstd;
                *(f32x4*)(orow + k) = o0; *(f32x4*)(orow + k + 4) = o1; }
        }
    }
}

template <int PH>
__device__ __forceinline__ void run_phase(const Params& p, LAS unsigned char* lds, int G) {
    unsigned char* ws = p.ws;
    if constexpr (PH == 0) phase0(p, lds, G);
    else if constexpr (PH == 1) phase1(p, lds, G);
    else if constexpr (PH == 2) { pg8::Gemm g{(const bf16*)p.out, (const bf16*)(ws + WS_WIN), T, NPAD, 1024, 1024}; pg8::StaticOrder S; S.init(T, NPAD, G, (int)blockIdx.x);
        EpiSeg E{ws}; pg8::gemm_phase<EpiSeg, pg8::StaticOrder, true, true, 0, 1024, 1024>(lds, g, S, E); }
    else if constexpr (PH == 3) phase_conv(p, G);
    else if constexpr (PH == 4) { pg8::Gemm g{(const bf16*)p.out, (const bf16*)(ws + WS_LRUB), T, 2048, 256, 1024}; pg8::StaticOrder S; S.init(T, 2048, G, (int)blockIdx.x);
        EpiLru E{(bf16*)(ws + WS_XLXG), (bf16*)p.out, p.lba, p.lbx, p.lam}; pg8::gemm_phase<EpiLru, pg8::StaticOrder, true, true, 1, 256, 1024>(lds, g, S, E); }
    else if constexpr (PH == 5) phase_lru_scan<false>(p, G);
    else if constexpr (PH == 6) phase_lru_scan<true>(p, G);
    else if constexpr (PH == 7) phase_gla_naive(p, lds, G);
    else if constexpr (PH == 8) phase_gla_final(p, G);
    else if constexpr (PH == 9) { pg8::Gemm g{(const bf16*)(ws + WS_GAGB), (const bf16*)(ws + WS_WOUT), T, 1024, 1024, 2048}; pg8::StaticOrder S; S.init(T, 1024, G, (int)blockIdx.x);
        EpiPlain E{(bf16*)(ws + WS_Y), 1024}; pg8::gemm_phase<EpiPlain, pg8::StaticOrder, true, true, 0, 1024, 2048>(lds, g, S, E); }
    else if constexpr (PH == 10) phase_norm2(p, lds, G);
    else if constexpr (PH == 11) { pg8::Gemm g{(const bf16*)(ws + WS_H2), (const bf16*)(ws + WS_WQ), T, 2048, 1024, 1024}; pg8::StaticOrder S; S.init(T, 2048, G, (int)blockIdx.x);
        EpiPlain E{(bf16*)(ws + WS_QRY), 2048}; pg8::gemm_phase<EpiPlain, pg8::StaticOrder, true, true, 0, 1024, 1024>(lds, g, S, E); }
    else if constexpr (PH == 12) { pg8::Gemm g{(const bf16*)(ws + WS_QRY), (const bf16*)(ws + WS_SUBK), T, 2048, 256, 2048}; pg8::StaticOrder S; S.init(T, 2048, G, (int)blockIdx.x);
        EpiF16 E{(unsigned short*)(ws + WS_SC), 2048}; pg8::gemm_phase<EpiF16, pg8::StaticOrder, true, true, 2, 256, 2048>(lds, g, S, E); }
    else if constexpr (PH == 13) phase_topk(p, lds, G);
    else if constexpr (PH == 14) phase_gather(p, lds, G);
}
template <int PH>
__global__ void __launch_bounds__(NTHR, 2) k_phase(Params p) {
    extern __shared__ __attribute__((aligned(16))) unsigned char lds_raw[];
    run_phase<PH>(p, (LAS unsigned char*)lds_raw, (int)gridDim.x);
}
template <int PH>
__device__ __forceinline__ void run_from(const Params& p, LAS unsigned char* lds, int G) {
    run_phase<PH>(p, lds, G);
    if constexpr (PH + 1 < N_PHASES) { cg::this_grid().sync(); run_from<PH + 1>(p, lds, G); }
}
__global__ void __launch_bounds__(NTHR, 2) k_mega(Params p) {
    extern __shared__ __attribute__((aligned(16))) unsigned char lds_raw[];
    run_from<0>(p, (LAS unsigned char*)lds_raw, (int)gridDim.x);
}

extern "C" void kernel_launch(void* const* d_in, const int* in_sizes, int n_in, void* d_out, int out_size, void* d_ws, size_t ws_size, hipStream_t stream) {
    static int grid = 0;
    if (grid == 0) {
        if (n_in != 24 || in_sizes[0] != T * DM || out_size != T * DM || ws_size < WS_END) {
            fprintf(stderr, "kernel_launch: unexpected shapes: n_in %d in0 %d out %d ws %zu\n", n_in, n_in > 0 ? in_sizes[0] : -1, out_size, ws_size); grid = -1; return; }
        int dev = 0, cus = 0, per_cu = 0;
        if (hipGetDevice(&dev) != hipSuccess || hipDeviceGetAttribute(&cus, hipDeviceAttributeMultiprocessorCount, dev) != hipSuccess) { grid = -1; return; }
        if (hipFuncSetAttribute((const void*)k_mega, hipFuncAttributeMaxDynamicSharedMemorySize, LDS_BYTES) != hipSuccess) { fprintf(stderr, "kernel_launch: hipFuncSetAttribute failed\n"); grid = -1; return; }
        if (hipOccupancyMaxActiveBlocksPerMultiprocessor(&per_cu, (const void*)k_mega, NTHR, LDS_BYTES) != hipSuccess || per_cu < 1) { fprintf(stderr, "kernel_launch: occupancy query says %d blocks per CU\n", per_cu); grid = -1; return; }
        (void)hipGetLastError();
        grid = cus;
    }
    if (grid < 0) return;
    Params p{};
    const float** pp = (const float**)&p;
    for (int i = 0; i < 24; ++i) pp[i] = (const float*)d_in[i];
    p.out = (float*)d_out; p.ws = (unsigned char*)d_ws;
    void* args[] = {&p};
    hipError_t e = hipLaunchCooperativeKernel((const void*)k_mega, dim3(grid), dim3(NTHR), args, LDS_BYTES, stream);
    if (e != hipSuccess) fprintf(stderr, "kernel_launch: cooperative launch failed: %s (grid %d)\n", hipGetErrorString(e), grid);
}
```

```cpp
#include <hip/hip_runtime.h>
#include <hip/hip_cooperative_groups.h>
#include <cstdio>
#include <cstdint>
#include <utility>
namespace cg = cooperative_groups;

namespace pg8 {
#define PG8_LAS __attribute__((address_space(3)))
typedef unsigned short bf16_t;
typedef short bf16x8 __attribute__((ext_vector_type(8)));
typedef float f32x4 __attribute__((ext_vector_type(4)));
typedef unsigned u32x4 __attribute__((ext_vector_type(4)));
constexpr int BM = 256, BK = 64, HALF = 128, HTB = HALF * BK * 2  , STAGE_BYTES = 8 * HTB, NXCD = 8, WGM = 8;

__host__ __device__ __forceinline__ int lds_byte(int r, int c) { const int st = (r >> 4) * 2 + (c >> 5), rr = r & 15, cc = c & 31, ob = rr * 64 + cc * 2; return st * 1024 + (ob ^ (((ob >> 9) & 1) << 5)); }
__host__ __device__ __forceinline__ void stage_rc(int b, int& R, int& C) { const int st = b / 1024, sb = b % 1024, swz = sb ^ (((sb >> 9) & 1) << 5); R = (st >> 1) * 16 + swz / 64; C = (st & 1) * 32 + (swz % 64) / 2; }
__host__ __device__ __forceinline__ int perm32(int rho) { const int n = rho >> 4, i = rho & 15; return 8 * (i >> 2) + 4 * n + (i & 3); }

struct Unit { int pm, pn; };
struct Gemm { const bf16_t* A; const bf16_t* Bt; int M, N, K, lda; };
template <int AMODE> __device__ __forceinline__ size_t a_off_bytes(const Gemm& g, const Unit& u) {
    const int ac = AMODE == 0 ? 0 : (AMODE == 1 ? 128 * (u.pn < 6 ? u.pn : 6) : 256 * u.pn);
    return ((size_t)u.pm * BM * (size_t)g.lda + (size_t)ac) * 2;
}

struct StaticOrder {
    int nM, nN, nwg, G, c;
    __host__ __device__ void init(int M, int N, int G_, int c_) { nM = M / BM; nN = N / BM; nwg = nM * nN; G = G_; c = c_; }
    __host__ __device__ bool next(int i, Unit& u) const {
        const long L = (long)i * G + c; if (L >= nwg) return false;
        int wgid = (int)L; { const int q = nwg / NXCD, r = nwg % NXCD, xcd = wgid % NXCD, off = wgid / NXCD; wgid = (xcd < r ? xcd * (q + 1) : r * (q + 1) + (xcd - r) * q) + off; }
        const int nig = WGM * nN, gid = wgid / nig, fm = gid * WGM, gsz = (nM - fm) < WGM ? (nM - fm) : WGM;
        u.pm = fm + ((wgid % nig) % gsz); u.pn = (wgid % nig) / gsz; return true;
    }
    __device__ __forceinline__ void a_ready(const Unit&) const {}
    __device__ __forceinline__ void done(const Unit&) const {}
};

__device__ __forceinline__ unsigned cvt_pk_bf16(float lo, float hi) { unsigned r; asm volatile("v_cvt_pk_bf16_f32 %0, %1, %2" : "=v"(r) : "v"(lo), "v"(hi)); return r; }

template <class Epi, class Sched, bool ALIGN_EPI = false, bool SP2 = false, int AMODE = 0, int KC = 0, int LDAC = 0>
__device__ __forceinline__ void gemm_phase(PG8_LAS unsigned char* lds, const Gemm g, const Sched& S, const Epi& E) {
    const int tid = threadIdx.x, wid = __builtin_amdgcn_readfirstlane(tid >> 6), lane = tid & 63, wr = wid >> 2, wc = wid & 3, fr = lane & 15, fq = lane >> 4;
    const int K = KC ? KC : g.K, nt = K / BK; const int lda = LDAC ? LDAC : g.lda;
    unsigned voffA[2], voffB[2];
#pragma unroll
    for (int i = 0; i < 2; ++i) { int R, C; stage_rc(tid * 16 + i * 8192, R, C); const int Rb = Epi::PERM ? ((R & ~31) + perm32(R & 31)) : R;
        voffA[i] = (unsigned)(R * lda + C) * 2u; voffB[i] = (unsigned)(Rb * K + C) * 2u; }
    const size_t kstep = (size_t)(BK * 2);
    const size_t hstepA = (size_t)HALF * lda * 2;
    const size_t hstepB = (size_t)HALF * K * 2;
    const size_t tstepB = 2 * hstepB;
    const unsigned ldsw = (unsigned)wid * 1024u;
    const int aoff = lds_byte(wr * 64 + fr, fq * 8), boff = lds_byte(wc * 32 + fr, fq * 8);
#define PG8_SA(b, h) (((b) * 2 + (h)) * HTB)
#define PG8_SB(b, h) ((4 + (b) * 2 + (h)) * HTB)
#define PG8_STAGE(bufoff, gbase, voff) do { _Pragma("unroll") for (int _i = 0; _i < 2; ++_i) \
        __builtin_amdgcn_global_load_lds((const unsigned*)((const char*)(gbase) + (voff)[_i]), (PG8_LAS unsigned*)(lds + (bufoff) + ldsw + _i * 8192), 16, 0, 0); } while (0)
#define PG8_LDA(dst, b, h) do { _Pragma("unroll") for (int m = 0; m < 4; ++m) _Pragma("unroll") for (int k = 0; k < 2; ++k) dst[m][k] = *(const PG8_LAS bf16x8*)(lds + PG8_SA(b, h) + aoff + m * 2048 + k * 1024); } while (0)
#define PG8_LDB(dst, b, h) do { _Pragma("unroll") for (int n = 0; n < 2; ++n) _Pragma("unroll") for (int k = 0; k < 2; ++k) dst[n][k] = *(const PG8_LAS bf16x8*)(lds + PG8_SB(b, h) + boff + n * 2048 + k * 1024); } while (0)
#define PG8_MMA(ai, bj, At, Bt) do { __builtin_amdgcn_s_setprio(1); _Pragma("unroll") for (int m = 0; m < 4; ++m) _Pragma("unroll") for (int n = 0; n < 2; ++n) _Pragma("unroll") for (int k = 0; k < 2; ++k) \
        acc[ai][bj][m][n] = __builtin_amdgcn_mfma_f32_16x16x32_bf16(Bt[n][k], At[m][k], acc[ai][bj][m][n], 0, 0, 0); __builtin_amdgcn_s_setprio(0); } while (0)
#define PG8_WAIT_V(n) asm volatile("s_waitcnt vmcnt(" #n ")" ::: "memory")
#define PG8_WAIT_L(n) asm volatile("s_waitcnt lgkmcnt(" #n ")" ::: "memory")
#define PG8_BAR __builtin_amdgcn_s_barrier()
#define PG8_SCHED __builtin_amdgcn_sched_barrier(0)
    Unit cur, nxt; int ui = 0;
    if (!S.next(0, cur)) return;
    f32x4 acc[2][2][4][2];
#pragma unroll
    for (int a = 0; a < 2; ++a)
#pragma unroll
        for (int b = 0; b < 2; ++b)
#pragma unroll
            for (int m = 0; m < 4; ++m)
#pragma unroll
                for (int n = 0; n < 2; ++n) acc[a][b][m][n] = (f32x4){0.f, 0.f, 0.f, 0.f};
    bf16x8 At[4][2], B0[2][2], B1[2][2];
    const char* cA = (const char*)g.A + a_off_bytes<AMODE>(g, cur); const char* cB = (const char*)g.Bt + (size_t)cur.pn * tstepB;
    S.a_ready(cur);
    if constexpr (SP2) {
        PG8_STAGE(PG8_SB(0, 0), cB, voffB); PG8_STAGE(PG8_SB(0, 1), cB + hstepB, voffB); PG8_STAGE(PG8_SA(0, 0), cA, voffA); PG8_STAGE(PG8_SA(0, 1), cA + hstepA, voffA);
        if (wr == 1) PG8_BAR;
        PG8_WAIT_V(2); PG8_BAR;
        PG8_STAGE(PG8_SB(1, 0), cB + kstep, voffB); PG8_STAGE(PG8_SA(1, 0), cA + kstep, voffA); PG8_STAGE(PG8_SB(1, 1), cB + hstepB + kstep, voffB);
        PG8_WAIT_V(6); PG8_BAR;
    } else {
        PG8_STAGE(PG8_SB(0, 0), cB, voffB); PG8_STAGE(PG8_SA(0, 0), cA, voffA); PG8_STAGE(PG8_SB(0, 1), cB + hstepB, voffB); PG8_STAGE(PG8_SA(0, 1), cA + hstepA, voffA);
        if (wr == 1) PG8_BAR;
        PG8_WAIT_V(4); PG8_BAR;
        PG8_STAGE(PG8_SB(1, 0), cB + kstep, voffB); PG8_STAGE(PG8_SA(1, 0), cA + kstep, voffA); PG8_STAGE(PG8_SB(1, 1), cB + hstepB + kstep, voffB);
        PG8_WAIT_V(6); PG8_BAR;
    }
    for (;;) {
        const bool has_next = S.next(ui + 1, nxt);
        const char* nA = has_next ? (const char*)g.A + a_off_bytes<AMODE>(g, nxt) : cA; const char* nB = has_next ? (const char*)g.Bt + (size_t)nxt.pn * tstepB : cB;
#pragma unroll 1
        for (int t = 0; t < nt; t += 2) {
            const bool last = (t == nt - 2);
            const char* a1 = cA + (size_t)(t + 1) * kstep;
            const char* a2 = last ? nA : cA + (size_t)(t + 2) * kstep; const char* b2 = last ? nB : cB + (size_t)(t + 2) * kstep;
            const char* a3 = a2 + kstep; const char* b3 = b2 + kstep;
            if (last && has_next) S.a_ready(nxt);
            if constexpr (SP2) {
            PG8_LDB(B0, 0, 0); PG8_LDB(B1, 0, 1); PG8_SCHED; PG8_LDA(At, 0, 0); PG8_STAGE(PG8_SA(1, 1), a1 + hstepA, voffA);
            PG8_WAIT_V(8); PG8_WAIT_L(0); PG8_BAR; PG8_MMA(0, 0, At, B0); PG8_MMA(0, 1, At, B1); PG8_BAR; PG8_SCHED;
            PG8_LDA(At, 0, 1); PG8_STAGE(PG8_SB(0, 0), b2, voffB); PG8_STAGE(PG8_SB(0, 1), b2 + hstepB, voffB); PG8_STAGE(PG8_SA(0, 0), a2, voffA);
            PG8_WAIT_V(8); PG8_WAIT_L(0); PG8_BAR; PG8_MMA(1, 0, At, B0); PG8_MMA(1, 1, At, B1); PG8_BAR; PG8_SCHED;
            PG8_LDB(B0, 1, 0); PG8_LDB(B1, 1, 1); PG8_SCHED; PG8_LDA(At, 1, 0); PG8_STAGE(PG8_SA(0, 1), a2 + hstepA, voffA);
            PG8_WAIT_V(8); PG8_WAIT_L(0); PG8_BAR; PG8_MMA(0, 0, At, B0); PG8_MMA(0, 1, At, B1); PG8_BAR; PG8_SCHED;
            PG8_LDA(At, 1, 1); PG8_STAGE(PG8_SB(1, 0), b3, voffB); PG8_STAGE(PG8_SB(1, 1), b3 + hstepB, voffB); PG8_STAGE(PG8_SA(1, 0), a3, voffA);
            PG8_WAIT_V(8); PG8_WAIT_L(0); PG8_BAR; PG8_MMA(1, 0, At, B0); PG8_MMA(1, 1, At, B1); PG8_BAR; PG8_SCHED;
            } else {
            PG8_LDB(B0, 0, 0); PG8_SCHED; PG8_LDA(At, 0, 0); PG8_STAGE(PG8_SA(1, 1), a1 + hstepA, voffA);
            PG8_WAIT_L(8); PG8_BAR; PG8_WAIT_L(0); PG8_MMA(0, 0, At, B0); PG8_BAR; PG8_SCHED;
            PG8_LDB(B1, 0, 1); PG8_STAGE(PG8_SB(0, 0), b2, voffB);
            PG8_BAR; PG8_WAIT_L(0); PG8_MMA(0, 1, At, B1); PG8_BAR;
            PG8_LDA(At, 0, 1); PG8_STAGE(PG8_SA(0, 0), a2, voffA);
            PG8_BAR; PG8_WAIT_L(0); PG8_MMA(1, 0, At, B0); PG8_BAR; PG8_SCHED;
            PG8_STAGE(PG8_SB(0, 1), b2 + hstepB, voffB);
            PG8_WAIT_V(6); PG8_BAR; PG8_MMA(1, 1, At, B1); PG8_BAR;
            PG8_LDB(B0, 1, 0); PG8_SCHED; PG8_LDA(At, 1, 0); PG8_STAGE(PG8_SA(0, 1), a2 + hstepA, voffA);
            PG8_WAIT_L(8); PG8_BAR; PG8_WAIT_L(0); PG8_MMA(0, 0, At, B0); PG8_BAR; PG8_SCHED;
            PG8_LDB(B1, 1, 1); PG8_STAGE(PG8_SB(1, 0), b3, voffB);
            PG8_BAR; PG8_WAIT_L(0); PG8_MMA(0, 1, At, B1); PG8_BAR;
            PG8_LDA(At, 1, 1); PG8_STAGE(PG8_SA(1, 0), a3, voffA);
            PG8_BAR; PG8_WAIT_L(0); PG8_MMA(1, 0, At, B0); PG8_BAR; PG8_SCHED;
            PG8_STAGE(PG8_SB(1, 1), b3 + hstepB, voffB);
            PG8_WAIT_V(6); PG8_BAR; PG8_MMA(1, 1, At, B1); PG8_BAR;
            }
        }
        if constexpr (ALIGN_EPI) { if (wr == 0) PG8_BAR; }
        E(acc, cur, wr, wc, fr, fq); S.done(cur);
        if (!has_next) break;
#pragma unroll
        for (int a = 0; a < 2; ++a)
#pragma unroll
            for (int b = 0; b < 2; ++b)
#pragma unroll
                for (int m = 0; m < 4; ++m)
#pragma unroll
                    for (int n = 0; n < 2; ++n) acc[a][b][m][n] = (f32x4){0.f, 0.f, 0.f, 0.f};
        cur = nxt; cA = nA; cB = nB; ++ui;
        if constexpr (ALIGN_EPI) { if (wr == 1) PG8_BAR; }
    }
    PG8_WAIT_V(0);
    if constexpr (!ALIGN_EPI) { if (wr == 0) PG8_BAR; }
    PG8_BAR;
#undef PG8_SA
#undef PG8_SB
#undef PG8_STAGE
#undef PG8_LDA
#undef PG8_LDB
#undef PG8_MMA
#undef PG8_WAIT_V
#undef PG8_WAIT_L
#undef PG8_BAR
#undef PG8_SCHED
}
}

constexpr int NB = 8, SEQ = 8192, DM = 1024, T = NB * SEQ;
constexpr int NPAD = 7424;
constexpr int NWAVES = 8, NTHR = 512;
constexpr int LDS_BYTES = 147456;
constexpr int N_PHASES = 15;

constexpr size_t MiB = 1ull << 20;
constexpr size_t WS_CTL = 0;
constexpr size_t WS_MODP = 1 * MiB;
constexpr size_t WS_WIN = 3 * MiB;
constexpr size_t WS_WOUT = 18 * MiB;
constexpr size_t WS_WQ = 20 * MiB;
constexpr size_t WS_LRUB = 24 * MiB;
constexpr size_t WS_SUBK = 25 * MiB;
constexpr size_t WS_LRUC = 26 * MiB;
constexpr size_t WS_U = 32 * MiB;
constexpr size_t WS_V = 48 * MiB;
constexpr size_t WS_SU = 64 * MiB;
constexpr size_t WS_SV = 65 * MiB;
constexpr size_t WS_QKV = 96 * MiB;
constexpr size_t WS_R = 352 * MiB;
constexpr size_t WS_XLXG = 480 * MiB;
constexpr size_t WS_GAGB = 736 * MiB;
constexpr size_t WS_ALOW = 992 * MiB;
constexpr size_t WS_END = 994 * MiB;
constexpr size_t WS_Y = WS_QKV;
constexpr size_t WS_H2 = WS_QKV + 128 * MiB;
constexpr size_t WS_QRY = WS_XLXG;
constexpr size_t WS_SC = WS_GAGB;
constexpr size_t WS_TOPK = WS_R;
constexpr size_t WS_TOPK2 = WS_R + 32 * MiB;

#define LAS __attribute__((address_space(3)))
typedef unsigned short bf16;
typedef float f32x4 __attribute__((ext_vector_type(4)));
typedef float f32x2 __attribute__((ext_vector_type(2)));
typedef unsigned u32x4 __attribute__((ext_vector_type(4)));
typedef unsigned u32x2 __attribute__((ext_vector_type(2)));

struct Params {
    const float *x, *c, *w_ada, *b_ada, *npm, *npo, *w_in, *w_alpha, *b_alpha, *gla_norm, *conv_w, *conv_b,
        *lwa, *lba, *lwx, *lbx, *lam, *w_out, *npf, *npof, *wq, *subk, *pu, *pv;
    float* out; unsigned char* ws;
    int ph_lo, ph_hi;
};

__device__ __forceinline__ unsigned f2bf(float f) { unsigned u = __builtin_bit_cast(unsigned, f); return (u + 0x7fffu + ((u >> 16) & 1u)) >> 16; }
__device__ __forceinline__ unsigned pk2(float lo, float hi) { return f2bf(lo) | (f2bf(hi) << 16); }
__device__ __forceinline__ float bflo(unsigned u) { return __builtin_bit_cast(float, u << 16); }
__device__ __forceinline__ float bfhi(unsigned u) { return __builtin_bit_cast(float, u & 0xffff0000u); }
__device__ __forceinline__ float bf2f(bf16 h) { return __builtin_bit_cast(float, (unsigned)h << 16); }
__device__ __forceinline__ float sigmoid_f(float x) { return 1.f / (1.f + __expf(-x)); }
__device__ __forceinline__ float silu_f(float x) { return x / (1.f + __expf(-x)); }
__device__ __forceinline__ float gelu_f(float x) { const float u = 0.7978845608028654f * (x + 0.044715f * x * x * x); return x / (1.f + __expf(-2.f * u)); }
__device__ __forceinline__ float softplus_f(float x) { return fmaxf(x, 0.f) + log1pf(__expf(-fabsf(x))); }
__device__ __forceinline__ float wave_sum(float v) {
#pragma unroll
    for (int o = 1; o < 64; o <<= 1) v += __shfl_xor(v, o);
    return v;
}
#define LDS_WAIT() asm volatile("s_waitcnt lgkmcnt(0)" ::: "memory")

struct EpiSeg {
    static constexpr bool PERM = true;
    unsigned char* ws;
    __device__ __forceinline__ void operator()(const pg8::f32x4 (&acc)[2][2][4][2], const pg8::Unit& u, int wr, int wc, int fr, int fq) const {
        const int pn = u.pn; bf16* base; int ldc, colt;
        if (pn < 8) { base = (bf16*)(ws + WS_QKV); ldc = 2048; colt = pn * 256; }
        else if (pn < 12) { base = (bf16*)(ws + WS_R); ldc = 1024; colt = (pn - 8) * 256; }
        else if (pn < 20) { base = (bf16*)(ws + WS_XLXG); ldc = 2048; colt = (pn - 12) * 256; }
        else if (pn < 28) { base = (bf16*)(ws + WS_GAGB); ldc = 2048; colt = (pn - 20) * 256; }
        else { base = (bf16*)(ws + WS_ALOW); ldc = 16; colt = 0; }
        const int row0 = u.pm * 256 + wr * 64 + fr, col0 = colt + wc * 32 + 8 * fq;
        const bool tail = (pn == 28);
#pragma unroll
        for (int ai = 0; ai < 2; ++ai)
#pragma unroll
            for (int m = 0; m < 4; ++m) { bf16* rowp = base + (size_t)(row0 + ai * 128 + m * 16) * ldc + col0;
#pragma unroll
                for (int bj = 0; bj < 2; ++bj) { const pg8::f32x4 v0 = acc[ai][bj][m][0], v1 = acc[ai][bj][m][1];
                    u32x4 w; w.x = pg8::cvt_pk_bf16(v0[0], v0[1]); w.y = pg8::cvt_pk_bf16(v0[2], v0[3]); w.z = pg8::cvt_pk_bf16(v1[0], v1[1]); w.w = pg8::cvt_pk_bf16(v1[2], v1[3]);
                    if (!tail || (bj == 0 && wc == 0 && fq < 2)) *(u32x4*)(rowp + bj * 128) = w; } }
    }
};
struct EpiPlain {
    static constexpr bool PERM = true;
    bf16* O; int ldc;
    __device__ __forceinline__ void operator()(const pg8::f32x4 (&acc)[2][2][4][2], const pg8::Unit& u, int wr, int wc, int fr, int fq) const {
        const int row0 = u.pm * 256 + wr * 64 + fr, col0 = u.pn * 256 + wc * 32 + 8 * fq;
#pragma unroll
        for (int ai = 0; ai < 2; ++ai)
#pragma unroll
            for (int m = 0; m < 4; ++m) { bf16* rowp = O + (size_t)(row0 + ai * 128 + m * 16) * ldc + col0;
#pragma unroll
                for (int bj = 0; bj < 2; ++bj) { const pg8::f32x4 v0 = acc[ai][bj][m][0], v1 = acc[ai][bj][m][1];
                    u32x4 w; w.x = pg8::cvt_pk_bf16(v0[0], v0[1]); w.y = pg8::cvt_pk_bf16(v0[2], v0[3]); w.z = pg8::cvt_pk_bf16(v1[0], v1[1]); w.w = pg8::cvt_pk_bf16(v1[2], v1[3]);
                    *(u32x4*)(rowp + bj * 128) = w; } }
    }
};
typedef _Float16 h16x2 __attribute__((ext_vector_type(2)));
__device__ __forceinline__ unsigned pkh(float a, float b) { return __builtin_bit_cast(unsigned, __builtin_amdgcn_cvt_pkrtz(a, b)); }
struct EpiF16 {
    static constexpr bool PERM = true;
    unsigned short* O; int ldc;
    __device__ __forceinline__ void operator()(const pg8::f32x4 (&acc)[2][2][4][2], const pg8::Unit& u, int wr, int wc, int fr, int fq) const {
        const int row0 = u.pm * 256 + wr * 64 + fr, col0 = u.pn * 256 + wc * 32 + 8 * fq;
#pragma unroll
        for (int ai = 0; ai < 2; ++ai)
#pragma unroll
            for (int m = 0; m < 4; ++m) { unsigned short* rowp = O + (size_t)(row0 + ai * 128 + m * 16) * ldc + col0;
#pragma unroll
                for (int bj = 0; bj < 2; ++bj) { const pg8::f32x4 v0 = acc[ai][bj][m][0], v1 = acc[ai][bj][m][1];
                    u32x4 w; w.x = pkh(v0[0], v0[1]); w.y = pkh(v0[2], v0[3]); w.z = pkh(v1[0], v1[1]); w.w = pkh(v1[2], v1[3]);
                    *(u32x4*)(rowp + bj * 128) = w; } }
    }
};
struct EpiLru {
    static constexpr bool PERM = true;
    bf16* LA;   bf16* XCU;   const float *lba, *lbx, *lam;
    __device__ __forceinline__ void operator()(const pg8::f32x4 (&acc)[2][2][4][2], const pg8::Unit& u, int wr, int wc, int fr, int fq) const {
        const int row0 = u.pm * 256 + wr * 64 + fr, ch0 = u.pn * 128 + wc * 32 + 8 * fq;
        float ba[8], bx[8], sp[8];
#pragma unroll
        for (int j = 0; j < 8; ++j) { ba[j] = lba[ch0 + j]; bx[j] = lbx[ch0 + j]; sp[j] = -8.f * softplus_f(-lam[ch0 + j]); }
#pragma unroll
        for (int ai = 0; ai < 2; ++ai)
#pragma unroll
            for (int m = 0; m < 4; ++m) { const size_t row = (size_t)(row0 + ai * 128 + m * 16);
                const u32x4 xw = *(const u32x4*)(XCU + row * 1024 + ch0);
                float xc[8] = {bflo(xw.x), bfhi(xw.x), bflo(xw.y), bfhi(xw.y), bflo(xw.z), bfhi(xw.z), bflo(xw.w), bfhi(xw.w)};
                float la[8], uu[8];
#pragma unroll
                for (int j = 0; j < 8; ++j) { const float pr = acc[ai][0][m][j >> 2][j & 3] + ba[j], pi = acc[ai][1][m][j >> 2][j & 3] + bx[j];
                    const float gr = sigmoid_f(pr), gi = sigmoid_f(pi);
                    la[j] = sp[j] * gr; const float a2 = __expf(2.f * la[j]);
                    uu[j] = sqrtf(fmaxf(1.f - a2, 0.f)) * gi * xc[j]; }
                u32x4 w1, w2; w1.x = pk2(la[0], la[1]); w1.y = pk2(la[2], la[3]); w1.z = pk2(la[4], la[5]); w1.w = pk2(la[6], la[7]);
                w2.x = pk2(uu[0], uu[1]); w2.y = pk2(uu[2], uu[3]); w2.z = pk2(uu[4], uu[5]); w2.w = pk2(uu[6], uu[7]);
                *(u32x4*)(LA + row * 2048 + ch0) = w1; *(u32x4*)(XCU + row * 1024 + ch0) = w2; }
    }
};

__device__ __forceinline__ void p0_transpose_item(const float* W, int ldw, int k0, int n0, int nvalid, bf16* WT, int ldk, int row0, int kc0, LAS float* scr, int lane) {
#pragma unroll 8
    for (int i = 0; i < 32; ++i) { const int kk = 2 * i + (lane >> 5), cc = lane & 31; scr[kk * 33 + cc] = (cc < nvalid) ? W[(size_t)(k0 + kk) * ldw + n0 + cc] : 0.f; }
    LDS_WAIT(); asm volatile("" ::: "memory");
    const int c = lane & 7;
#pragma unroll
    for (int j = 0; j < 4; ++j) { const int n = (lane >> 3) + 8 * j; const LAS float* s = scr + (8 * c) * 33 + n;
        u32x4 o; o.x = pk2(s[0 * 33], s[1 * 33]); o.y = pk2(s[2 * 33], s[3 * 33]); o.z = pk2(s[4 * 33], s[5 * 33]); o.w = pk2(s[6 * 33], s[7 * 33]);
        *(u32x4*)(WT + (size_t)(row0 + n) * ldk + kc0 + k0 + 8 * c) = o; }
    LDS_WAIT(); asm volatile("" ::: "memory");
}
__device__ __forceinline__ void phase0(const Params& p, LAS unsigned char* lds, int G) {
    const int tid = threadIdx.x, lane = tid & 63, wave = __builtin_amdgcn_readfirstlane(tid >> 6);
    unsigned char* ws = p.ws;
    {
        LAS float* sc = (LAS float*)lds;
        LAS float* red = (LAS float*)(lds + 4096);
        float* modp = (float*)(ws + WS_MODP);
        for (int it = blockIdx.x; it < 24 * 8; it += G) {
            const int nb = it % 24, kc = it / 24;
            for (int i = tid; i < 1024; i += NTHR) { const int b = i >> 7, k = i & 127; sc[i] = silu_f(p.c[b * 1024 + kc * 128 + k]); }
            __syncthreads();
            const int col = tid & 255, kh = tid >> 8;
            float acc[8];
#pragma unroll
            for (int b = 0; b < 8; ++b) acc[b] = 0.f;
            const float* wp = p.w_ada + (size_t)(kc * 128 + kh * 64) * 6144 + nb * 256 + col;
#pragma unroll 8
            for (int kk = 0; kk < 64; ++kk) { const float w = wp[(size_t)kk * 6144];
#pragma unroll
                for (int b = 0; b < 8; ++b) acc[b] += sc[b * 128 + kh * 64 + kk] * w; }
            if (kh == 1) {
#pragma unroll
                for (int b = 0; b < 8; ++b) red[b * 256 + col] = acc[b]; }
            __syncthreads();
            if (kh == 0) { const int n = nb * 256 + col; const float bias = (kc == 0) ? p.b_ada[n] : 0.f;
#pragma unroll
                for (int b = 0; b < 8; ++b) modp[(size_t)(kc * 8 + b) * 6144 + n] = acc[b] + red[b * 256 + col] + bias; }
            __syncthreads();
        }
    }
    LAS float* scr = (LAS float*)(lds + 16384 + wave * 8448);
    const int gw = blockIdx.x * NWAVES + wave, NGW = G * NWAVES;
    bf16* WinT = (bf16*)(ws + WS_WIN); bf16* WoutT = (bf16*)(ws + WS_WOUT); bf16* WqT = (bf16*)(ws + WS_WQ);
    bf16* LruB = (bf16*)(ws + WS_LRUB); bf16* SubK = (bf16*)(ws + WS_SUBK);
    constexpr int I_IN = 16 * (NPAD / 32), I_OUT = 16 * 32, I_Q = 16 * 64, I_LRU = 16 * 8, I_SUB = 2048, I_TAB = 2 * 16384;
    constexpr int NIT = I_IN + I_OUT + I_Q + I_LRU + I_SUB + I_TAB;
    for (int it = gw; it < NIT; it += NGW) {
        int r = it;
        if (r < I_IN) { const int nb = r % (NPAD / 32), kb = r / (NPAD / 32), nq = nb * 32; int n0, nv;
            if (nq < 3072) { n0 = nq; nv = 32; } else if (nq < 7168) { n0 = nq + 16; nv = 32; } else if (nq == 7168) { n0 = 3072; nv = 16; } else { n0 = 0; nv = 0; }
            p0_transpose_item(p.w_in, 7184, kb * 64, n0, nv, WinT, 1024, nq, 0, scr, lane); continue; } r -= I_IN;
        if (r < I_OUT) { const int nb = r % 32, kb = r / 32; p0_transpose_item(p.w_out, 1024, kb * 64, nb * 32, 32, WoutT, 1024, nb * 32, 0, scr, lane); continue; } r -= I_OUT;
        if (r < I_Q) { const int nb = r % 64, kb = r / 64; p0_transpose_item(p.wq, 2048, kb * 64, nb * 32, 32, WqT, 1024, nb * 32, 0, scr, lane); continue; } r -= I_Q;
        if (r < I_LRU) {
            const int mat = r >> 3, sub = r & 7, g = mat >> 3, n = mat & 7, kb = sub >> 2, nb = sub & 3;
            const int np = n < 6 ? n : 6, half = n - np;
            const float* W = (g ? p.lwx : p.lwa) + (size_t)n * 128 * 128;
            bf16* dst = LruB + (size_t)n * 256 * 256;
            p0_transpose_item(W, 128, kb * 64, nb * 32, 32, dst, 256, g * 128 + nb * 32, half * 128, scr, lane);
            p0_transpose_item(W, 128, kb * 64, 0, 0, dst, 256, g * 128 + nb * 32, (1 - half) * 128, scr, lane);
            continue; } r -= I_LRU;
        if (r < I_SUB) {
            const int h = r >> 8, pp = (r >> 7) & 1, n = r & 127;
            const float* src = p.subk + (size_t)r * 128; bf16* dst = SubK + ((size_t)h * 256 + pp * 128 + n) * 256;
            const f32x2 v = *(const f32x2*)(src + 2 * lane);
            *(unsigned*)(dst + pp * 128 + 2 * lane) = pk2(v.x, v.y);
            *(unsigned*)(dst + (1 - pp) * 128 + 2 * lane) = 0u;
            continue; } r -= I_SUB;
        {
            const int tb = r >> 14, row = r & 16383;
            const float* src = (tb ? p.pv : p.pu) + (size_t)row * 1024 + lane * 16;
            f32x4 v[4]; float am = 0.f;
#pragma unroll
            for (int j = 0; j < 4; ++j) { v[j] = *(const f32x4*)(src + 4 * j); am = fmaxf(am, fmaxf(fmaxf(fabsf(v[j].x), fabsf(v[j].y)), fmaxf(fabsf(v[j].z), fabsf(v[j].w)))); }
#pragma unroll
            for (int o = 1; o < 64; o <<= 1) am = fmaxf(am, __shfl_xor(am, o));
            const float inv = am > 0.f ? 416.f / am : 0.f;
            u32x4 o;
            { int w = 0; w = __builtin_amdgcn_cvt_pk_fp8_f32(v[0].x * inv, v[0].y * inv, w, false); w = __builtin_amdgcn_cvt_pk_fp8_f32(v[0].z * inv, v[0].w * inv, w, true); o.x = (unsigned)w; }
            { int w = 0; w = __builtin_amdgcn_cvt_pk_fp8_f32(v[1].x * inv, v[1].y * inv, w, false); w = __builtin_amdgcn_cvt_pk_fp8_f32(v[1].z * inv, v[1].w * inv, w, true); o.y = (unsigned)w; }
            { int w = 0; w = __builtin_amdgcn_cvt_pk_fp8_f32(v[2].x * inv, v[2].y * inv, w, false); w = __builtin_amdgcn_cvt_pk_fp8_f32(v[2].z * inv, v[2].w * inv, w, true); o.z = (unsigned)w; }
            { int w = 0; w = __builtin_amdgcn_cvt_pk_fp8_f32(v[3].x * inv, v[3].y * inv, w, false); w = __builtin_amdgcn_cvt_pk_fp8_f32(v[3].z * inv, v[3].w * inv, w, true); o.w = (unsigned)w; }
            *(u32x4*)(ws + (tb ? WS_V : WS_U) + (size_t)row * 1024 + lane * 16) = o;
            if (lane == 0) ((float*)(ws + (tb ? WS_SV : WS_SU)))[row] = am * (1.f / 416.f);
        }
    }
}

__device__ __forceinline__ float mod_at(const float* modp, int b, int n) {
    float s = 0.f;
#pragma unroll
    for (int kc = 0; kc < 8; ++kc) s += modp[(size_t)(kc * 8 + b) * 6144 + n];
    return s;
}

__device__ __forceinline__ void phase1(const Params& p, LAS unsigned char* lds, int G) {
    const int tid = threadIdx.x, lane = tid & 63, wave = __builtin_amdgcn_readfirstlane(tid >> 6);
    const float* modp = (const float*)(p.ws + WS_MODP);
    LAS float* gs = (LAS float*)lds; LAS float* sh = gs + 1024;
    bf16* H = (bf16*)p.out;
    for (int tile = blockIdx.x; tile < T / 256; tile += G) {
        const int b = tile / 32;
        __syncthreads();
        for (int k = tid; k < 1024; k += NTHR) { gs[k] = p.npm[k] * (1.f + mod_at(modp, b, 1024 + k)); sh[k] = mod_at(modp, b, k); }
        __syncthreads();
        for (int rr = 0; rr < 32; ++rr) {
            const size_t row = (size_t)tile * 256 + wave * 32 + rr;
            const f32x4* xr = (const f32x4*)(p.x + row * 1024) + lane;
            f32x4 v[4]; float s = 0.f;
#pragma unroll
            for (int j = 0; j < 4; ++j) { v[j] = xr[64 * j]; s += (v[j].x * v[j].x + v[j].y * v[j].y) + (v[j].z * v[j].z + v[j].w * v[j].w); }
            const float rstd = 1.f / sqrtf(wave_sum(s) * (1.f / 1024.f) + 1e-6f);
            u32x2* o8 = (u32x2*)(H + row * 1024) + lane;
#pragma unroll
            for (int j = 0; j < 4; ++j) { const int k = 256 * j + 4 * lane; const f32x4 g4 = *(const LAS f32x4*)(gs + k), s4 = *(const LAS f32x4*)(sh + k);
                u32x2 w; w.x = pk2(v[j].x * rstd * g4.x + s4.x, v[j].y * rstd * g4.y + s4.y); w.y = pk2(v[j].z * rstd * g4.z + s4.z, v[j].w * rstd * g4.w + s4.w);
                o8[64 * j] = w; }
        }
    }
}

__device__ __forceinline__ void phase_conv(const Params& p, int G) {
    const int tid = threadIdx.x, lane = tid & 63, wave = __builtin_amdgcn_readfirstlane(tid >> 6);
    const int gw = blockIdx.x * NWAVES + wave, NGW = G * NWAVES;
    const bf16* XL = (const bf16*)(p.ws + WS_XLXG); bf16* XC = (bf16*)p.out;
    for (int it = gw; it < (T / 64) * 2; it += NGW) {
        const int rt = it >> 1, c0 = (it & 1) * 512 + lane * 8;
        float w[4][8], cb[8];
#pragma unroll
        for (int j = 0; j < 8; ++j) { cb[j] = p.conv_b[c0 + j];
#pragma unroll
            for (int q = 0; q < 4; ++q) w[q][j] = p.conv_w[q * 1024 + c0 + j]; }
        float x1[8], x2[8], x3[8];
        const int t0 = rt * 64; const bool first = (t0 % SEQ) == 0;
#pragma unroll
        for (int j = 0; j < 8; ++j) { x1[j] = 0.f; x2[j] = 0.f; x3[j] = 0.f; }
        if (!first) {
            const u32x4 a = *(const u32x4*)(XL + (size_t)(t0 - 1) * 2048 + c0), b = *(const u32x4*)(XL + (size_t)(t0 - 2) * 2048 + c0), c = *(const u32x4*)(XL + (size_t)(t0 - 3) * 2048 + c0);
            x1[0] = bflo(a.x); x1[1] = bfhi(a.x); x1[2] = bflo(a.y); x1[3] = bfhi(a.y); x1[4] = bflo(a.z); x1[5] = bfhi(a.z); x1[6] = bflo(a.w); x1[7] = bfhi(a.w);
            x2[0] = bflo(b.x); x2[1] = bfhi(b.x); x2[2] = bflo(b.y); x2[3] = bfhi(b.y); x2[4] = bflo(b.z); x2[5] = bfhi(b.z); x2[6] = bflo(b.w); x2[7] = bfhi(b.w);
            x3[0] = bflo(c.x); x3[1] = bfhi(c.x); x3[2] = bflo(c.y); x3[3] = bfhi(c.y); x3[4] = bflo(c.z); x3[5] = bfhi(c.z); x3[6] = bflo(c.w); x3[7] = bfhi(c.w);
        }
#pragma unroll 4
        for (int i = 0; i < 64; ++i) {
            const u32x4 a = *(const u32x4*)(XL + (size_t)(t0 + i) * 2048 + c0);
            float x0[8] = {bflo(a.x), bfhi(a.x), bflo(a.y), bfhi(a.y), bflo(a.z), bfhi(a.z), bflo(a.w), bfhi(a.w)};
            float o[8];
#pragma unroll
            for (int j = 0; j < 8; ++j) { o[j] = cb[j] + w[0][j] * x3[j] + w[1][j] * x2[j] + w[2][j] * x1[j] + w[3][j] * x0[j]; x3[j] = x2[j]; x2[j] = x1[j]; x1[j] = x0[j]; }
            u32x4 wv; wv.x = pk2(o[0], o[1]); wv.y = pk2(o[2], o[3]); wv.z = pk2(o[4], o[5]); wv.w = pk2(o[6], o[7]);
            *(u32x4*)(XC + (size_t)(t0 + i) * 1024 + c0) = wv;
        }
    }
}

template <bool FINAL>
__device__ __forceinline__ void phase_lru_scan(const Params& p, int G) {
    const int tid = threadIdx.x;
    const bf16* LA = (const bf16*)(p.ws + WS_XLXG); const bf16* U = (const bf16*)p.out;
    const bf16* XG = (const bf16*)(p.ws + WS_XLXG) + 1024; bf16* GB = (bf16*)(p.ws + WS_GAGB) + 1024;
    f32x2* car = (f32x2*)(p.ws + WS_LRUC);
    for (int it = blockIdx.x; it < 8 * 32 * 2; it += G) {
        const int cg_ = it & 1, j = (it >> 1) & 31, b = it >> 6, ch = cg_ * 512 + tid;
        const size_t t0 = (size_t)b * SEQ + j * 256;
        if (!FINAL) {
            float h = 0.f, ls = 0.f;
#pragma unroll 8
            for (int i = 0; i < 256; ++i) { const float la = bf2f(LA[(t0 + i) * 2048 + ch]), u = bf2f(U[(t0 + i) * 1024 + ch]);
                h = __expf(la) * h + u; ls += la; }
            car[(size_t)(b * 32 + j) * 1024 + ch] = (f32x2){__expf(ls), h};
        } else {
            float h = 0.f;
            for (int i = 0; i < j; ++i) { const f32x2 c = car[(size_t)(b * 32 + i) * 1024 + ch]; h = c.x * h + c.y; }
#pragma unroll 8
            for (int i = 0; i < 256; ++i) { const float la = bf2f(LA[(t0 + i) * 2048 + ch]), u = bf2f(U[(t0 + i) * 1024 + ch]);
                h = __expf(la) * h + u;
                const float xg = bf2f(XG[(t0 + i) * 2048 + ch]), gb = bf2f(GB[(t0 + i) * 2048 + ch]);
                GB[(t0 + i) * 2048 + ch] = (bf16)f2bf(h * gelu_f(xg) * sigmoid_f(gb)); }
        }
    }
}

__device__ __forceinline__ void phase_gla_naive(const Params& p, LAS unsigned char* lds, int G) {
    const int tid = threadIdx.x;
    constexpr int TB = 32;
    LAS float* sA = (LAS float*)lds;
    LAS float* sK = sA + TB * 128;
    LAS float* sQ = sK + TB * 128;
    LAS float* sV = sQ + TB * 128;
    LAS float* sO = sV + TB * 64;
    const bf16* QKV = (const bf16*)(p.ws + WS_QKV); bf16* VO = (bf16*)(p.ws + WS_QKV);
    const bf16* AL = (const bf16*)(p.ws + WS_ALOW);
    for (int it = blockIdx.x; it < 8 * 4 * 4; it += G) {
        const int vs = it & 3, h = (it >> 2) & 3, b = it >> 4;
        const int vv = tid >> 3, kg = tid & 7;
        const int kp = tid & 127;
        float wa[16];
#pragma unroll
        for (int r = 0; r < 16; ++r) wa[r] = p.w_alpha[r * 512 + h * 128 + kp];
        const float balpha = p.b_alpha[h * 128 + kp];
        float S[16];
#pragma unroll
        for (int j = 0; j < 16; ++j) S[j] = 0.f;
        for (int tb = 0; tb < SEQ / TB; ++tb) {
            const size_t t0 = (size_t)b * SEQ + tb * TB;
            __syncthreads();
#pragma unroll
            for (int ps = 0; ps < TB / 4; ++ps) { const int tt = ps * 4 + (tid >> 7); const size_t t = t0 + tt;
                const u32x4 a0 = *(const u32x4*)(AL + t * 16), a1 = *(const u32x4*)(AL + t * 16 + 8);
                float z = balpha;
                z += bflo(a0.x) * wa[0] + bfhi(a0.x) * wa[1] + bflo(a0.y) * wa[2] + bfhi(a0.y) * wa[3] + bflo(a0.z) * wa[4] + bfhi(a0.z) * wa[5] + bflo(a0.w) * wa[6] + bfhi(a0.w) * wa[7];
                z += bflo(a1.x) * wa[8] + bfhi(a1.x) * wa[9] + bflo(a1.y) * wa[10] + bfhi(a1.y) * wa[11] + bflo(a1.z) * wa[12] + bfhi(a1.z) * wa[13] + bflo(a1.w) * wa[14] + bfhi(a1.w) * wa[15];
                const float ls = fminf(z, 0.f) - log1pf(__expf(-fabsf(z)));
                sA[tt * 128 + kp] = __expf(ls * (1.f / 16.f));
                sQ[tt * 128 + kp] = bf2f(QKV[t * 2048 + h * 128 + kp]) * 0.08838834764831845f;
                sK[tt * 128 + kp] = bf2f(QKV[t * 2048 + 512 + h * 128 + kp]); }
#pragma unroll
            for (int ps = 0; ps < TB * 64 / NTHR; ++ps) { const int e = ps * NTHR + tid, tt = e >> 6, v = e & 63;
                sV[e] = bf2f(QKV[(t0 + tt) * 2048 + 1024 + h * 256 + vs * 64 + v]); }
            __syncthreads();
            for (int tt = 0; tt < TB; ++tt) {
                const float vx = sV[tt * 64 + vv];
                float o = 0.f;
#pragma unroll
                for (int q4 = 0; q4 < 4; ++q4) {
                    const f32x4 a = *(const LAS f32x4*)(sA + tt * 128 + kg * 16 + q4 * 4), kk = *(const LAS f32x4*)(sK + tt * 128 + kg * 16 + q4 * 4), qq = *(const LAS f32x4*)(sQ + tt * 128 + kg * 16 + q4 * 4);
                    S[q4 * 4 + 0] = a.x * S[q4 * 4 + 0] + kk.x * vx; o += qq.x * S[q4 * 4 + 0];
                    S[q4 * 4 + 1] = a.y * S[q4 * 4 + 1] + kk.y * vx; o += qq.y * S[q4 * 4 + 1];
                    S[q4 * 4 + 2] = a.z * S[q4 * 4 + 2] + kk.z * vx; o += qq.z * S[q4 * 4 + 2];
                    S[q4 * 4 + 3] = a.w * S[q4 * 4 + 3] + kk.w * vx; o += qq.w * S[q4 * 4 + 3];
                }
                o += __shfl_xor(o, 1); o += __shfl_xor(o, 2); o += __shfl_xor(o, 4);
                if (kg == 0) sO[tt * 64 + vv] = o;
            }
            __syncthreads();
#pragma unroll
            for (int ps = 0; ps < TB * 64 / NTHR; ++ps) { const int e = ps * NTHR + tid, tt = e >> 6, v = e & 63;
                VO[(t0 + tt) * 2048 + 1024 + h * 256 + vs * 64 + v] = (bf16)f2bf(sO[e]); }
        }
    }
}

__device__ __forceinline__ void phase_gla_final(const Params& p, int G) {
    const int tid = threadIdx.x, lane = tid & 63, wave = __builtin_amdgcn_readfirstlane(tid >> 6);
    const int gw = blockIdx.x * NWAVES + wave, NGW = G * NWAVES;
    const bf16* O = (const bf16*)(p.ws + WS_QKV) + 1024; const bf16* R = (const bf16*)(p.ws + WS_R); bf16* GA = (bf16*)(p.ws + WS_GAGB);
    for (int row = gw; row < T; row += NGW) {
#pragma unroll
        for (int h = 0; h < 4; ++h) { const int c0 = h * 256 + lane * 4;
            const u32x2 ov = *(const u32x2*)(O + (size_t)row * 2048 + c0), rv = *(const u32x2*)(R + (size_t)row * 1024 + c0);
            const u32x2 gav = *(const u32x2*)(GA + (size_t)row * 2048 + c0), tv = *(const u32x2*)(GA + (size_t)row * 2048 + 1024 + c0);
            const float o[4] = {bflo(ov.x), bfhi(ov.x), bflo(ov.y), bfhi(ov.y)}, r[4] = {bflo(rv.x), bfhi(rv.x), bflo(rv.y), bfhi(rv.y)};
            const float ga[4] = {bflo(gav.x), bfhi(gav.x), bflo(gav.y), bfhi(gav.y)}, tm[4] = {bflo(tv.x), bfhi(tv.x), bflo(tv.y), bfhi(tv.y)};
            const float ss = wave_sum((o[0] * o[0] + o[1] * o[1]) + (o[2] * o[2] + o[3] * o[3]));
            const float rstd = 1.f / sqrtf(ss * (1.f / 256.f) + 1e-6f);
            const f32x4 gn = *(const f32x4*)(p.gla_norm + c0);
            float m[4];
#pragma unroll
            for (int j = 0; j < 4; ++j) m[j] = sigmoid_f(ga[j]) * (o[j] * rstd * gn[j] * silu_f(r[j])) + tm[j];
            u32x2 w; w.x = pk2(m[0], m[1]); w.y = pk2(m[2], m[3]);
            *(u32x2*)(GA + (size_t)row * 2048 + c0) = w; }
    }
}

__device__ __forceinline__ void phase_norm2(const Params& p, LAS unsigned char* lds, int G) {
    const int tid = threadIdx.x, lane = tid & 63, wave = __builtin_amdgcn_readfirstlane(tid >> 6);
    const float* modp = (const float*)(p.ws + WS_MODP);
    LAS float* g1 = (LAS float*)lds; LAS float* gs = g1 + 1024; LAS float* sh = gs + 1024;
    const bf16* Y = (const bf16*)(p.ws + WS_Y); bf16* H2 = (bf16*)(p.ws + WS_H2);
    for (int tile = blockIdx.x; tile < T / 256; tile += G) {
        const int b = tile / 32;
        __syncthreads();
        for (int k = tid; k < 1024; k += NTHR) { g1[k] = mod_at(modp, b, 2048 + k) * p.npo[k]; gs[k] = p.npf[k] * (1.f + mod_at(modp, b, 4096 + k)); sh[k] = mod_at(modp, b, 3072 + k); }
        __syncthreads();
        for (int rr = 0; rr < 32; ++rr) {
            const size_t row = (size_t)tile * 256 + wave * 32 + rr;
            const f32x4* xr = (const f32x4*)(p.x + row * 1024) + lane; const u32x2* yr = (const u32x2*)(Y + row * 1024) + lane;
            f32x4 xv[4], yv[4]; float s = 0.f;
#pragma unroll
            for (int j = 0; j < 4; ++j) { xv[j] = xr[64 * j]; const u32x2 yw = yr[64 * j]; yv[j] = (f32x4){bflo(yw.x), bfhi(yw.x), bflo(yw.y), bfhi(yw.y)};
                s += (yv[j].x * yv[j].x + yv[j].y * yv[j].y) + (yv[j].z * yv[j].z + yv[j].w * yv[j].w); }
            const float rstd = 1.f / sqrtf(wave_sum(s) * (1.f / 1024.f) + 1e-6f);
            float s2 = 0.f;
            f32x4* orow = (f32x4*)(p.out + row * 1024) + lane;
#pragma unroll
            for (int j = 0; j < 4; ++j) { const int k = 256 * j + 4 * lane; const f32x4 g4 = *(const LAS f32x4*)(g1 + k);
                xv[j] = xv[j] + yv[j] * rstd * g4; orow[64 * j] = xv[j];
                s2 += (xv[j].x * xv[j].x + xv[j].y * xv[j].y) + (xv[j].z * xv[j].z + xv[j].w * xv[j].w); }
            const float rstd2 = 1.f / sqrtf(wave_sum(s2) * (1.f / 1024.f) + 1e-6f);
            u32x2* o8 = (u32x2*)(H2 + row * 1024) + lane;
#pragma unroll
            for (int j = 0; j < 4; ++j) { const int k = 256 * j + 4 * lane; const f32x4 g4 = *(const LAS f32x4*)(gs + k), s4 = *(const LAS f32x4*)(sh + k);
                u32x2 w; w.x = pk2(xv[j].x * rstd2 * g4.x + s4.x, xv[j].y * rstd2 * g4.y + s4.y); w.y = pk2(xv[j].z * rstd2 * g4.z + s4.z, xv[j].w * rstd2 * g4.w + s4.w);
                o8[64 * j] = w; }
        }
    }
}

__device__ __forceinline__ unsigned h16_key(unsigned b) { return (b & 0x8000u) ? (~b & 0xffffu) : (b | 0x8000u); }
__device__ __forceinline__ float h16_key_val(unsigned s) { const unsigned b = (s & 0x8000u) ? (s & 0x7fffu) : (~s & 0xffffu); return (float)__builtin_bit_cast(_Float16, (unsigned short)b); }
#define INS16(top, x) do { _Pragma("unroll") for (int _j = 0; _j < 16; ++_j) { const unsigned _hi = max(top[_j], x), _lo = min(top[_j], x); top[_j] = _hi; x = _lo; } } while (0)
__device__ __forceinline__ void phase_topk(const Params& p, LAS unsigned char* lds, int G) {
    const int tid = threadIdx.x;
    const unsigned short* SC = (const unsigned short*)(p.ws + WS_SC); unsigned* TK = (unsigned*)(p.ws + WS_TOPK); float* TK2 = (float*)(p.ws + WS_TOPK2);
    const float* SU = (const float*)(p.ws + WS_SU); const float* SV = (const float*)(p.ws + WS_SV);
    LAS unsigned* my = (LAS unsigned*)lds + tid * 33;
    for (int blk = blockIdx.x; blk < T * 8 / NTHR; blk += G) {
        const int item = blk * NTHR + tid, t = item >> 3, h = item & 7;
        unsigned topA[16], topB[16];
#pragma unroll
        for (int j = 0; j < 16; ++j) { topA[j] = 0u; topB[j] = 0u; }
        const u32x4* src = (const u32x4*)(SC + (size_t)t * 2048 + h * 256);
#pragma unroll 1
        for (int c8 = 0; c8 < 16; ++c8) { const u32x4 w = src[c8];
            const unsigned ww[4] = {w.x, w.y, w.z, w.w};
#pragma unroll
            for (int q = 0; q < 4; ++q) { unsigned k0 = (h16_key(ww[q] & 0xffffu) << 16) | (unsigned)(127 - (c8 * 8 + q * 2)), k1 = (h16_key(ww[q] >> 16) << 16) | (unsigned)(127 - (c8 * 8 + q * 2 + 1));
                INS16(topA, k0); INS16(topA, k1); } }
#pragma unroll 1
        for (int c8 = 0; c8 < 16; ++c8) { const u32x4 w = src[16 + c8];
            const unsigned ww[4] = {w.x, w.y, w.z, w.w};
#pragma unroll
            for (int q = 0; q < 4; ++q) { unsigned k0 = (h16_key(ww[q] & 0xffffu) << 16) | (unsigned)(127 - (c8 * 8 + q * 2)), k1 = (h16_key(ww[q] >> 16) << 16) | (unsigned)(127 - (c8 * 8 + q * 2 + 1));
                INS16(topB, k0); INS16(topB, k1); } }
        float fa[16], fb[16];
#pragma unroll
        for (int j = 0; j < 16; ++j) { fa[j] = h16_key_val(topA[j] >> 16); fb[j] = h16_key_val(topB[j] >> 16); my[j] = 127u - (topA[j] & 127u); my[16 + j] = 127u - (topB[j] & 127u); }
        unsigned ct[16];
#pragma unroll
        for (int j = 0; j < 16; ++j) ct[j] = 0u;
#pragma unroll
        for (int i = 0; i < 16; ++i)
#pragma unroll
            for (int j = 0; j < 16; ++j) if ((i + 1) * (j + 1) <= 16) {
                const float s = fa[i] + fb[j]; unsigned u = __builtin_bit_cast(unsigned, s); u ^= (u >> 31) ? 0xffffffffu : 0x80000000u;
                unsigned key = (u & 0xffffff00u) | (unsigned)(255 - (i * 16 + j));
                INS16(ct, key); }
        float val[16], mx, sum = 0.f;
#pragma unroll
        for (int m = 0; m < 16; ++m) { unsigned u = ct[m] & 0xffffff00u; u ^= (u >> 31) ? 0x80000000u : 0xffffffffu; val[m] = __builtin_bit_cast(float, u); }
        mx = val[0];
#pragma unroll
        for (int m = 0; m < 16; ++m) { val[m] = __expf(val[m] - mx); sum += val[m]; }
        const float inv = 1.f / sum;
        LDS_WAIT();
        unsigned outw[16]; float outs[16];
#pragma unroll
        for (int m = 0; m < 16; ++m) { const unsigned pos = 255u - (ct[m] & 255u), i = pos >> 4, j = pos & 15u;
            const unsigned e = my[i] * 128u + my[16 + j];
            outw[m] = (e << 16) | f2bf(val[m] * inv * SV[e]); outs[m] = SU[e]; }
        u32x4* dst = (u32x4*)(TK + (size_t)item * 16); f32x4* dst2 = (f32x4*)(TK2 + (size_t)item * 16);
#pragma unroll
        for (int q = 0; q < 4; ++q) { dst[q] = (u32x4){outw[4 * q], outw[4 * q + 1], outw[4 * q + 2], outw[4 * q + 3]}; dst2[q] = (f32x4){outs[4 * q], outs[4 * q + 1], outs[4 * q + 2], outs[4 * q + 3]}; }
    }
}

__device__ __forceinline__ f32x2 fp8lo(unsigned w) { return __builtin_amdgcn_cvt_pk_f32_fp8((int)w, false); }
__device__ __forceinline__ f32x2 fp8hi(unsigned w) { return __builtin_amdgcn_cvt_pk_f32_fp8((int)w, true); }
__device__ __forceinline__ float rdlane(float v, int l) { return __builtin_bit_cast(float, __builtin_amdgcn_readlane(__builtin_bit_cast(int, v), l)); }
__device__ __forceinline__ void phase_gather(const Params& p, LAS unsigned char* lds, int G) {
    const int tid = threadIdx.x, lane = tid & 63, wave = __builtin_amdgcn_readfirstlane(tid >> 6);
    const float* modp = (const float*)(p.ws + WS_MODP);
    LAS float* g2 = (LAS float*)lds;
    const bf16* H2 = (const bf16*)(p.ws + WS_H2); const unsigned* TK = (const unsigned*)(p.ws + WS_TOPK); const float* TK2 = (const float*)(p.ws + WS_TOPK2);
    const unsigned char* U8 = p.ws + WS_U; const unsigned char* V8 = p.ws + WS_V;
    for (int tile = blockIdx.x; tile < T / 256; tile += G) {
        const int b = tile / 32;
        __syncthreads();
        for (int k = tid; k < 1024; k += NTHR) g2[k] = mod_at(modp, b, 5120 + k) * p.npof[k];
        __syncthreads();
#pragma unroll 1
        for (int rr = 0; rr < 32; ++rr) {
            const size_t row = (size_t)tile * 256 + wave * 32 + rr;
            f32x2 xt[8];
            { const u32x4 a = *(const u32x4*)(H2 + row * 1024 + lane * 16), c = *(const u32x4*)(H2 + row * 1024 + lane * 16 + 8);
              xt[0] = (f32x2){bflo(a.x), bfhi(a.x)}; xt[1] = (f32x2){bflo(a.y), bfhi(a.y)}; xt[2] = (f32x2){bflo(a.z), bfhi(a.z)}; xt[3] = (f32x2){bflo(a.w), bfhi(a.w)};
              xt[4] = (f32x2){bflo(c.x), bfhi(c.x)}; xt[5] = (f32x2){bflo(c.y), bfhi(c.y)}; xt[6] = (f32x2){bflo(c.z), bfhi(c.z)}; xt[7] = (f32x2){bflo(c.w), bfhi(c.w)}; }
            f32x2 acc[8];
#pragma unroll
            for (int j = 0; j < 8; ++j) acc[j] = (f32x2){0.f, 0.f};
#pragma unroll 1
            for (int h = 0; h < 8; ++h) {
                const u32x4* ra = (const u32x4*)(TK + row * 128 + h * 16);
                const u32x4 w0 = ra[0], w1 = ra[1], w2 = ra[2], w3 = ra[3];
                const unsigned ww[16] = {w0.x, w0.y, w0.z, w0.w, w1.x, w1.y, w1.z, w1.w, w2.x, w2.y, w2.z, w2.w, w3.x, w3.y, w3.z, w3.w};
                u32x4 ur[16], vr[16];
#pragma unroll
                for (int m = 0; m < 16; ++m) { const size_t eo = (size_t)((unsigned)__builtin_amdgcn_readfirstlane((int)ww[m]) >> 16) * 1024 + lane * 16;
                    ur[m] = *(const u32x4*)(U8 + eo); vr[m] = *(const u32x4*)(V8 + eo); }
                const unsigned wa = TK[row * 128 + h * 16 + (lane >> 2)]; const float su = TK2[row * 128 + h * 16 + (lane >> 2)];
                float pd[16];
#pragma unroll
                for (int m = 0; m < 16; ++m) {
                    f32x2 s = xt[0] * fp8lo(ur[m].x);
                    s += xt[1] * fp8hi(ur[m].x); s += xt[2] * fp8lo(ur[m].y); s += xt[3] * fp8hi(ur[m].y);
                    s += xt[4] * fp8lo(ur[m].z); s += xt[5] * fp8hi(ur[m].z); s += xt[6] * fp8lo(ur[m].w); s += xt[7] * fp8hi(ur[m].w);
                    pd[m] = s.x + s.y; }
#pragma unroll
                for (int j = 0; j < 8; ++j) { const bool up = (lane & 32) != 0; const float keep = up ? pd[j + 8] : pd[j], send = up ? pd[j] : pd[j + 8]; pd[j] = keep + __shfl_xor(send, 32); }
#pragma unroll
                for (int j = 0; j < 4; ++j) { const bool up = (lane & 16) != 0; const float keep = up ? pd[j + 4] : pd[j], send = up ? pd[j] : pd[j + 4]; pd[j] = keep + __shfl_xor(send, 16); }
#pragma unroll
                for (int j = 0; j < 2; ++j) { const bool up = (lane & 8) != 0; const float keep = up ? pd[j + 2] : pd[j], send = up ? pd[j] : pd[j + 2]; pd[j] = keep + __shfl_xor(send, 8); }
                { const bool up = (lane & 4) != 0; const float keep = up ? pd[1] : pd[0], send = up ? pd[0] : pd[1]; pd[0] = keep + __shfl_xor(send, 4); }
                float d = pd[0]; d += __shfl_xor(d, 2); d += __shfl_xor(d, 1);
                const float coef = bflo(wa) * gelu_f(su * d);
#pragma unroll
                for (int m = 0; m < 16; ++m) { const float cm = rdlane(coef, 4 * m); const f32x2 c2 = (f32x2){cm, cm};
                    acc[0] += c2 * fp8lo(vr[m].x); acc[1] += c2 * fp8hi(vr[m].x); acc[2] += c2 * fp8lo(vr[m].y); acc[3] += c2 * fp8hi(vr[m].y);
                    acc[4] += c2 * fp8lo(vr[m].z); acc[5] += c2 * fp8hi(vr[m].z); acc[6] += c2 * fp8lo(vr[m].w); acc[7] += c2 * fp8hi(vr[m].w); }
            }
            float s = 0.f;
#pragma unroll
            for (int j = 0; j < 8; ++j) s += acc[j].x * acc[j].x + acc[j].y * acc[j].y;
            const float rstd = 1.f / sqrtf(wave_sum(s) * (1.f / 1024.f) + 1e-6f);
            float* orow = p.out + row * 1024 + lane * 16;
#pragma unroll
            for (int q = 0; q < 4; ++q) { f32x4 o = *(const f32x4*)(orow + 4 * q); const f32x4 ga = *(const LAS f32x4*)(g2 + lane * 16 + 4 * q);
                o.x += ga.x * acc[2 * q].x * rstd; o.y += ga.y * acc[2 * q].y * rstd; o.z += ga.z * acc[2 * q + 1].x * rstd; o.w += ga.w * acc[2 * q + 1].y * rstd;
                *(f32x4*)(orow + 4 * q) = o; }
        }
    }
}

template <int PH>
__device__ __forceinline__ void run_phase(const Params& p, LAS unsigned char* lds, int G) {
    unsigned char* ws = p.ws;
    if constexpr (PH == 0) phase0(p, lds, G);
    else if constexpr (PH == 1) phase1(p, lds, G);
    else if constexpr (PH == 2) { pg8::Gemm g{(const bf16*)p.out, (const bf16*)(ws + WS_WIN), T, NPAD, 1024, 1024}; pg8::StaticOrder S; S.init(T, NPAD, G, (int)blockIdx.x);
        EpiSeg E{ws}; pg8::gemm_phase<EpiSeg, pg8::StaticOrder, true, true, 0, 1024, 1024>(lds, g, S, E); }
    else if constexpr (PH == 3) phase_conv(p, G);
    else if constexpr (PH == 4) { pg8::Gemm g{(const bf16*)p.out, (const bf16*)(ws + WS_LRUB), T, 2048, 256, 1024}; pg8::StaticOrder S; S.init(T, 2048, G, (int)blockIdx.x);
        EpiLru E{(bf16*)(ws + WS_XLXG), (bf16*)p.out, p.lba, p.lbx, p.lam}; pg8::gemm_phase<EpiLru, pg8::StaticOrder, true, true, 1, 256, 1024>(lds, g, S, E); }
    else if constexpr (PH == 5) phase_lru_scan<false>(p, G);
    else if constexpr (PH == 6) phase_lru_scan<true>(p, G);
    else if constexpr (PH == 7) phase_gla_naive(p, lds, G);
    else if constexpr (PH == 8) phase_gla_final(p, G);
    else if constexpr (PH == 9) { pg8::Gemm g{(const bf16*)(ws + WS_GAGB), (const bf16*)(ws + WS_WOUT), T, 1024, 1024, 2048}; pg8::StaticOrder S; S.init(T, 1024, G, (int)blockIdx.x);
        EpiPlain E{(bf16*)(ws + WS_Y), 1024}; pg8::gemm_phase<EpiPlain, pg8::StaticOrder, true, true, 0, 1024, 2048>(lds, g, S, E); }
    else if constexpr (PH == 10) phase_norm2(p, lds, G);
    else if constexpr (PH == 11) { pg8::Gemm g{(const bf16*)(ws + WS_H2), (const bf16*)(ws + WS_WQ), T, 2048, 1024, 1024}; pg8::StaticOrder S; S.init(T, 2048, G, (int)blockIdx.x);
        EpiPlain E{(bf16*)(ws + WS_QRY), 2048}; pg8::gemm_phase<EpiPlain, pg8::StaticOrder, true, true, 0, 1024, 1024>(lds, g, S, E); }
    else if constexpr (PH == 12) { pg8::Gemm g{(const bf16*)(ws + WS_QRY), (const bf16*)(ws + WS_SUBK), T, 2048, 256, 2048}; pg8::StaticOrder S; S.init(T, 2048, G, (int)blockIdx.x);
        EpiF16 E{(unsigned short*)(ws + WS_SC), 2048}; pg8::gemm_phase<EpiF16, pg8::StaticOrder, true, true, 2, 256, 2048>(lds, g, S, E); }
    else if constexpr (PH == 13) phase_topk(p, lds, G);
    else if constexpr (PH == 14) phase_gather(p, lds, G);
}
template <int PH>
__global__ void __launch_bounds__(NTHR, 2) k_phase(Params p) {
    extern __shared__ __attribute__((aligned(16))) unsigned char lds_raw[];
    run_phase<PH>(p, (LAS unsigned char*)lds_raw, (int)gridDim.x);
}
template <int PH>
__device__ __forceinline__ void run_from(const Params& p, LAS unsigned char* lds, int G) {
    run_phase<PH>(p, lds, G);
    if constexpr (PH + 1 < N_PHASES) { cg::this_grid().sync(); run_from<PH + 1>(p, lds, G); }
}
__global__ void __launch_bounds__(NTHR, 2) k_mega(Params p) {
    extern __shared__ __attribute__((aligned(16))) unsigned char lds_raw[];
    run_from<0>(p, (LAS unsigned char*)lds_raw, (int)gridDim.x);
}

extern "C" void kernel_launch(void* const* d_in, const int* in_sizes, int n_in, void* d_out, int out_size, void* d_ws, size_t ws_size, hipStream_t stream) {
    static int grid = 0;
    if (grid == 0) {
        if (n_in != 24 || in_sizes[0] != T * DM || out_size != T * DM || ws_size < WS_END) {
            fprintf(stderr, "kernel_launch: unexpected shapes: n_in %d in0 %d out %d ws %zu\n", n_in, n_in > 0 ? in_sizes[0] : -1, out_size, ws_size); grid = -1; return; }
        int dev = 0, cus = 0, per_cu = 0;
        if (hipGetDevice(&dev) != hipSuccess || hipDeviceGetAttribute(&cus, hipDeviceAttributeMultiprocessorCount, dev) != hipSuccess) { grid = -1; return; }
        if (hipFuncSetAttribute((const void*)k_mega, hipFuncAttributeMaxDynamicSharedMemorySize, LDS_BYTES) != hipSuccess) { fprintf(stderr, "kernel_launch: hipFuncSetAttribute failed\n"); grid = -1; return; }
        if (hipOccupancyMaxActiveBlocksPerMultiprocessor(&per_cu, (const void*)k_mega, NTHR, LDS_BYTES) != hipSuccess || per_cu < 1) { fprintf(stderr, "kernel_launch: occupancy query says %d blocks per CU\n", per_cu); grid = -1; return; }
        (void)hipGetLastError();
        grid = cus;
    }
    if (grid < 0) return;
    Params p{};
    const float** pp = (const float**)&p;
    for (int i = 0; i < 24; ++i) pp[i] = (const float*)d_in[i];
    p.out = (float*)d_out; p.ws = (unsigned char*)d_ws;
    void* args[] = {&p};
    hipError_t e = hipLaunchCooperativeKernel((const void*)k_mega, dim3(grid), dim3(NTHR), args, LDS_BYTES, stream);
    if (e != hipSuccess) fprintf(stderr, "kernel_launch: cooperative launch failed: %s (grid %d)\n", hipGetErrorString(e), grid);
}
```

```cpp
#include <hip/hip_runtime.h>
#include <hip/hip_cooperative_groups.h>
#include <cstdio>
#include <cstdint>
#include <utility>
namespace cg = cooperative_groups;

namespace pg8 {
#define PG8_LAS __attribute__((address_space(3)))
typedef unsigned short bf16_t;
typedef short bf16x8 __attribute__((ext_vector_type(8)));
typedef float f32x4 __attribute__((ext_vector_type(4)));
typedef unsigned u32x4 __attribute__((ext_vector_type(4)));
constexpr int BM = 256, BK = 64, HALF = 128, HTB = HALF * BK * 2  , STAGE_BYTES = 8 * HTB, NXCD = 8, WGM = 8;

__host__ __device__ __forceinline__ int lds_byte(int r, int c) { const int st = (r >> 4) * 2 + (c >> 5), rr = r & 15, cc = c & 31, ob = rr * 64 + cc * 2; return st * 1024 + (ob ^ (((ob >> 9) & 1) << 5)); }
__host__ __device__ __forceinline__ void stage_rc(int b, int& R, int& C) { const int st = b / 1024, sb = b % 1024, swz = sb ^ (((sb >> 9) & 1) << 5); R = (st >> 1) * 16 + swz / 64; C = (st & 1) * 32 + (swz % 64) / 2; }
__host__ __device__ __forceinline__ int perm32(int rho) { const int n = rho >> 4, i = rho & 15; return 8 * (i >> 2) + 4 * n + (i & 3); }

struct Unit { int pm, pn; };
struct Gemm { const bf16_t* A; const bf16_t* Bt; int M, N, K, lda; };
template <int AMODE> __device__ __forceinline__ size_t a_off_bytes(const Gemm& g, const Unit& u) {
    const int ac = AMODE == 0 ? 0 : (AMODE == 1 ? 128 * (u.pn < 6 ? u.pn : 6) : 256 * u.pn);
    return ((size_t)u.pm * BM * (size_t)g.lda + (size_t)ac) * 2;
}

struct StaticOrder {
    int nM, nN, nwg, G, c;
    __host__ __device__ void init(int M, int N, int G_, int c_) { nM = M / BM; nN = N / BM; nwg = nM * nN; G = G_; c = c_; }
    __host__ __device__ bool next(int i, Unit& u) const {
        const long L = (long)i * G + c; if (L >= nwg) return false;
        int wgid = (int)L; { const int q = nwg / NXCD, r = nwg % NXCD, xcd = wgid % NXCD, off = wgid / NXCD; wgid = (xcd < r ? xcd * (q + 1) : r * (q + 1) + (xcd - r) * q) + off; }
        const int nig = WGM * nN, gid = wgid / nig, fm = gid * WGM, gsz = (nM - fm) < WGM ? (nM - fm) : WGM;
        u.pm = fm + ((wgid % nig) % gsz); u.pn = (wgid % nig) / gsz; return true;
    }
    __device__ __forceinline__ void a_ready(const Unit&) const {}
    __device__ __forceinline__ void done(const Unit&) const {}
};

__device__ __forceinline__ unsigned cvt_pk_bf16(float lo, float hi) { unsigned r; asm volatile("v_cvt_pk_bf16_f32 %0, %1, %2" : "=v"(r) : "v"(lo), "v"(hi)); return r; }

template <class Epi, class Sched, bool ALIGN_EPI = false, bool SP2 = false, int AMODE = 0, int KC = 0, int LDAC = 0>
__device__ __forceinline__ void gemm_phase(PG8_LAS unsigned char* lds, const Gemm g, const Sched& S, const Epi& E) {
    const int tid = threadIdx.x, wid = __builtin_amdgcn_readfirstlane(tid >> 6), lane = tid & 63, wr = wid >> 2, wc = wid & 3, fr = lane & 15, fq = lane >> 4;
    const int K = KC ? KC : g.K, nt = K / BK; const int lda = LDAC ? LDAC : g.lda;
    unsigned voffA[2], voffB[2];
#pragma unroll
    for (int i = 0; i < 2; ++i) { int R, C; stage_rc(tid * 16 + i * 8192, R, C); const int Rb = Epi::PERM ? ((R & ~31) + perm32(R & 31)) : R;
        voffA[i] = (unsigned)(R * lda + C) * 2u; voffB[i] = (unsigned)(Rb * K + C) * 2u; }
    const size_t kstep = (size_t)(BK * 2);
    const size_t hstepA = (size_t)HALF * lda * 2;
    const size_t hstepB = (size_t)HALF * K * 2;
    const size_t tstepB = 2 * hstepB;
    const unsigned ldsw = (unsigned)wid * 1024u;
    const int aoff = lds_byte(wr * 64 + fr, fq * 8), boff = lds_byte(wc * 32 + fr, fq * 8);
#define PG8_SA(b, h) (((b) * 2 + (h)) * HTB)
#define PG8_SB(b, h) ((4 + (b) * 2 + (h)) * HTB)
#define PG8_STAGE(bufoff, gbase, voff) do { _Pragma("unroll") for (int _i = 0; _i < 2; ++_i) \
        __builtin_amdgcn_global_load_lds((const unsigned*)((const char*)(gbase) + (voff)[_i]), (PG8_LAS unsigned*)(lds + (bufoff) + ldsw + _i * 8192), 16, 0, 0); } while (0)
#define PG8_LDA(dst, b, h) do { _Pragma("unroll") for (int m = 0; m < 4; ++m) _Pragma("unroll") for (int k = 0; k < 2; ++k) dst[m][k] = *(const PG8_LAS bf16x8*)(lds + PG8_SA(b, h) + aoff + m * 2048 + k * 1024); } while (0)
#define PG8_LDB(dst, b, h) do { _Pragma("unroll") for (int n = 0; n < 2; ++n) _Pragma("unroll") for (int k = 0; k < 2; ++k) dst[n][k] = *(const PG8_LAS bf16x8*)(lds + PG8_SB(b, h) + boff + n * 2048 + k * 1024); } while (0)
#define PG8_MMA(ai, bj, At, Bt) do { __builtin_amdgcn_s_setprio(1); _Pragma("unroll") for (int m = 0; m < 4; ++m) _Pragma("unroll") for (int n = 0; n < 2; ++n) _Pragma("unroll") for (int k = 0; k < 2; ++k) \
        acc[ai][bj][m][n] = __builtin_amdgcn_mfma_f32_16x16x32_bf16(Bt[n][k], At[m][k], acc[ai][bj][m][n], 0, 0, 0); __builtin_amdgcn_s_setprio(0); } while (0)
#define PG8_WAIT_V(n) asm volatile("s_waitcnt vmcnt(" #n ")" ::: "memory")
#define PG8_WAIT_L(n) asm volatile("s_waitcnt lgkmcnt(" #n ")" ::: "memory")
#define PG8_BAR __builtin_amdgcn_s_barrier()
#define PG8_SCHED __builtin_amdgcn_sched_barrier(0)
    Unit cur, nxt; int ui = 0;
    if (!S.next(0, cur)) return;
    f32x4 acc[2][2][4][2];
#pragma unroll
    for (int a = 0; a < 2; ++a)
#pragma unroll
        for (int b = 0; b < 2; ++b)
#pragma unroll
            for (int m = 0; m < 4; ++m)
#pragma unroll
                for (int n = 0; n < 2; ++n) acc[a][b][m][n] = (f32x4){0.f, 0.f, 0.f, 0.f};
    bf16x8 At[4][2], B0[2][2], B1[2][2];
    const char* cA = (const char*)g.A + a_off_bytes<AMODE>(g, cur); const char* cB = (const char*)g.Bt + (size_t)cur.pn * tstepB;
    S.a_ready(cur);
    if constexpr (SP2) {
        PG8_STAGE(PG8_SB(0, 0), cB, voffB); PG8_STAGE(PG8_SB(0, 1), cB + hstepB, voffB); PG8_STAGE(PG8_SA(0, 0), cA, voffA); PG8_STAGE(PG8_SA(0, 1), cA + hstepA, voffA);
        if (wr == 1) PG8_BAR;
        PG8_WAIT_V(2); PG8_BAR;
        PG8_STAGE(PG8_SB(1, 0), cB + kstep, voffB); PG8_STAGE(PG8_SA(1, 0), cA + kstep, voffA); PG8_STAGE(PG8_SB(1, 1), cB + hstepB + kstep, voffB);
        PG8_WAIT_V(6); PG8_BAR;
    } else {
        PG8_STAGE(PG8_SB(0, 0), cB, voffB); PG8_STAGE(PG8_SA(0, 0), cA, voffA); PG8_STAGE(PG8_SB(0, 1), cB + hstepB, voffB); PG8_STAGE(PG8_SA(0, 1), cA + hstepA, voffA);
        if (wr == 1) PG8_BAR;
        PG8_WAIT_V(4); PG8_BAR;
        PG8_STAGE(PG8_SB(1, 0), cB + kstep, voffB); PG8_STAGE(PG8_SA(1, 0), cA + kstep, voffA); PG8_STAGE(PG8_SB(1, 1), cB + hstepB + kstep, voffB);
        PG8_WAIT_V(6); PG8_BAR;
    }
    for (;;) {
        const bool has_next = S.next(ui + 1, nxt);
        const char* nA = has_next ? (const char*)g.A + a_off_bytes<AMODE>(g, nxt) : cA; const char* nB = has_next ? (const char*)g.Bt + (size_t)nxt.pn * tstepB : cB;
#pragma unroll 1
        for (int t = 0; t < nt; t += 2) {
            const bool last = (t == nt - 2);
            const char* a1 = cA + (size_t)(t + 1) * kstep;
            const char* a2 = last ? nA : cA + (size_t)(t + 2) * kstep; const char* b2 = last ? nB : cB + (size_t)(t + 2) * kstep;
            const char* a3 = a2 + kstep; const char* b3 = b2 + kstep;
            if (last && has_next) S.a_ready(nxt);
            if constexpr (SP2) {
            PG8_LDB(B0, 0, 0); PG8_LDB(B1, 0, 1); PG8_SCHED; PG8_LDA(At, 0, 0); PG8_STAGE(PG8_SA(1, 1), a1 + hstepA, voffA);
            PG8_WAIT_V(8); PG8_WAIT_L(0); PG8_BAR; PG8_MMA(0, 0, At, B0); PG8_MMA(0, 1, At, B1); PG8_BAR; PG8_SCHED;
            PG8_LDA(At, 0, 1); PG8_STAGE(PG8_SB(0, 0), b2, voffB); PG8_STAGE(PG8_SB(0, 1), b2 + hstepB, voffB); PG8_STAGE(PG8_SA(0, 0), a2, voffA);
            PG8_WAIT_V(8); PG8_WAIT_L(0); PG8_BAR; PG8_MMA(1, 0, At, B0); PG8_MMA(1, 1, At, B1); PG8_BAR; PG8_SCHED;
            PG8_LDB(B0, 1, 0); PG8_LDB(B1, 1, 1); PG8_SCHED; PG8_LDA(At, 1, 0); PG8_STAGE(PG8_SA(0, 1), a2 + hstepA, voffA);
            PG8_WAIT_V(8); PG8_WAIT_L(0); PG8_BAR; PG8_MMA(0, 0, At, B0); PG8_MMA(0, 1, At, B1); PG8_BAR; PG8_SCHED;
            PG8_LDA(At, 1, 1); PG8_STAGE(PG8_SB(1, 0), b3, voffB); PG8_STAGE(PG8_SB(1, 1), b3 + hstepB, voffB); PG8_STAGE(PG8_SA(1, 0), a3, voffA);
            PG8_WAIT_V(8); PG8_WAIT_L(0); PG8_BAR; PG8_MMA(1, 0, At, B0); PG8_MMA(1, 1, At, B1); PG8_BAR; PG8_SCHED;
            } else {
            PG8_LDB(B0, 0, 0); PG8_SCHED; PG8_LDA(At, 0, 0); PG8_STAGE(PG8_SA(1, 1), a1 + hstepA, voffA);
            PG8_WAIT_L(8); PG8_BAR; PG8_WAIT_L(0); PG8_MMA(0, 0, At, B0); PG8_BAR; PG8_SCHED;
            PG8_LDB(B1, 0, 1); PG8_STAGE(PG8_SB(0, 0), b2, voffB);
            PG8_BAR; PG8_WAIT_L(0); PG8_MMA(0, 1, At, B1); PG8_BAR;
            PG8_LDA(At, 0, 1); PG8_STAGE(PG8_SA(0, 0), a2, voffA);
            PG8_BAR; PG8_WAIT_L(0); PG8_MMA(1, 0, At, B0); PG8_BAR; PG8_SCHED;
            PG8_STAGE(PG8_SB(0, 1), b2 + hstepB, voffB);
            PG8_WAIT_V(6); PG8_BAR; PG8_MMA(1, 1, At, B1); PG8_BAR;
            PG8_LDB(B0, 1, 0); PG8_SCHED; PG8_LDA(At, 1, 0); PG8_STAGE(PG8_SA(0, 1), a2 + hstepA, voffA);
            PG8_WAIT_L(8); PG8_BAR; PG8_WAIT_L(0); PG8_MMA(0, 0, At, B0); PG8_BAR; PG8_SCHED;
            PG8_LDB(B1, 1, 1); PG8_STAGE(PG8_SB(1, 0), b3, voffB);
            PG8_BAR; PG8_WAIT_L(0); PG8_MMA(0, 1, At, B1); PG8_BAR;
            PG8_LDA(At, 1, 1); PG8_STAGE(PG8_SA(1, 0), a3, voffA);
            PG8_BAR; PG8_WAIT_L(0); PG8_MMA(1, 0, At, B0); PG8_BAR; PG8_SCHED;
            PG8_STAGE(PG8_SB(1, 1), b3 + hstepB, voffB);
            PG8_WAIT_V(6); PG8_BAR; PG8_MMA(1, 1, At, B1); PG8_BAR;
            }
        }
        if constexpr (ALIGN_EPI) { if (wr == 0) PG8_BAR; }
        E(acc, cur, wr, wc, fr, fq); S.done(cur);
        if (!has_next) break;
#pragma unroll
        for (int a = 0; a < 2; ++a)
#pragma unroll
            for (int b = 0; b < 2; ++b)
#pragma unroll
                for (int m = 0; m < 4; ++m)
#pragma unroll
                    for (int n = 0; n < 2; ++n) acc[a][b][m][n] = (f32x4){0.f, 0.f, 0.f, 0.f};
        cur = nxt; cA = nA; cB = nB; ++ui;
        if constexpr (ALIGN_EPI) { if (wr == 1) PG8_BAR; }
    }
    PG8_WAIT_V(0);
    if constexpr (!ALIGN_EPI) { if (wr == 0) PG8_BAR; }
    PG8_BAR;
#undef PG8_SA
#undef PG8_SB
#undef PG8_STAGE
#undef PG8_LDA
#undef PG8_LDB
#undef PG8_MMA
#undef PG8_WAIT_V
#undef PG8_WAIT_L
#undef PG8_BAR
#undef PG8_SCHED
}
}

constexpr int NB = 8, SEQ = 8192, DM = 1024, T = NB * SEQ;
constexpr int NPAD = 7424;
constexpr int NWAVES = 8, NTHR = 512;
constexpr int LDS_BYTES = 147456;
constexpr int N_PHASES = 15;

constexpr size_t MiB = 1ull << 20;
constexpr size_t WS_CTL = 0;
constexpr size_t WS_MODP = 1 * MiB;
constexpr size_t WS_WIN = 3 * MiB;
constexpr size_t WS_WOUT = 18 * MiB;
constexpr size_t WS_WQ = 20 * MiB;
constexpr size_t WS_LRUB = 24 * MiB;
constexpr size_t WS_SUBK = 25 * MiB;
constexpr size_t WS_LRUC = 26 * MiB;
constexpr size_t WS_U = 32 * MiB;
constexpr size_t WS_V = 48 * MiB;
constexpr size_t WS_SU = 64 * MiB;
constexpr size_t WS_SV = 65 * MiB;
constexpr size_t WS_QKV = 96 * MiB;
constexpr size_t WS_R = 352 * MiB;
constexpr size_t WS_XLXG = 480 * MiB;
constexpr size_t WS_GAGB = 736 * MiB;
constexpr size_t WS_ALOW = 992 * MiB;
constexpr size_t WS_END = 994 * MiB;
constexpr size_t WS_Y = WS_QKV;
constexpr size_t WS_H2 = WS_QKV + 128 * MiB;
constexpr size_t WS_QRY = WS_XLXG;
constexpr size_t WS_SC = WS_GAGB;
constexpr size_t WS_TOPK = WS_R;
constexpr size_t WS_TOPK2 = WS_R + 32 * MiB;

#define LAS __attribute__((address_space(3)))
typedef unsigned short bf16;
typedef float f32x4 __attribute__((ext_vector_type(4)));
typedef float f32x2 __attribute__((ext_vector_type(2)));
typedef unsigned u32x4 __attribute__((ext_vector_type(4)));
typedef unsigned u32x2 __attribute__((ext_vector_type(2)));

struct Params {
    const float *x, *c, *w_ada, *b_ada, *npm, *npo, *w_in, *w_alpha, *b_alpha, *gla_norm, *conv_w, *conv_b,
        *lwa, *lba, *lwx, *lbx, *lam, *w_out, *npf, *npof, *wq, *subk, *pu, *pv;
    float* out; unsigned char* ws;
    int ph_lo, ph_hi;
};

__device__ __forceinline__ unsigned f2bf(float f) { unsigned u = __builtin_bit_cast(unsigned, f); return (u + 0x7fffu + ((u >> 16) & 1u)) >> 16; }
__device__ __forceinline__ unsigned pk2(float lo, float hi) { return f2bf(lo) | (f2bf(hi) << 16); }
__device__ __forceinline__ float bflo(unsigned u) { return __builtin_bit_cast(float, u << 16); }
__device__ __forceinline__ float bfhi(unsigned u) { return __builtin_bit_cast(float, u & 0xffff0000u); }
__device__ __forceinline__ float bf2f(bf16 h) { return __builtin_bit_cast(float, (unsigned)h << 16); }
__device__ __forceinline__ float sigmoid_f(float x) { return 1.f / (1.f + __expf(-x)); }
__device__ __forceinline__ float silu_f(float x) { return x / (1.f + __expf(-x)); }
__device__ __forceinline__ float gelu_f(float x) { const float u = 0.7978845608028654f * (x + 0.044715f * x * x * x); return x / (1.f + __expf(-2.f * u)); }
__device__ __forceinline__ float softplus_f(float x) { return fmaxf(x, 0.f) + log1pf(__expf(-fabsf(x))); }
__device__ __forceinline__ float wave_sum(float v) {
#pragma unroll
    for (int o = 1; o < 64; o <<= 1) v += __shfl_xor(v, o);
    return v;
}
#define LDS_WAIT() asm volatile("s_waitcnt lgkmcnt(0)" ::: "memory")

struct EpiSeg {
    static constexpr bool PERM = true;
    unsigned char* ws;
    __device__ __forceinline__ void operator()(const pg8::f32x4 (&acc)[2][2][4][2], const pg8::Unit& u, int wr, int wc, int fr, int fq) const {
        const int pn = u.pn; bf16* base; int ldc, colt;
        if (pn < 8) { base = (bf16*)(ws + WS_QKV); ldc = 2048; colt = pn * 256; }
        else if (pn < 12) { base = (bf16*)(ws + WS_R); ldc = 1024; colt = (pn - 8) * 256; }
        else if (pn < 20) { base = (bf16*)(ws + WS_XLXG); ldc = 2048; colt = (pn - 12) * 256; }
        else if (pn < 28) { base = (bf16*)(ws + WS_GAGB); ldc = 2048; colt = (pn - 20) * 256; }
        else { base = (bf16*)(ws + WS_ALOW); ldc = 16; colt = 0; }
        const int row0 = u.pm * 256 + wr * 64 + fr, col0 = colt + wc * 32 + 8 * fq;
        const bool tail = (pn == 28);
#pragma unroll
        for (int ai = 0; ai < 2; ++ai)
#pragma unroll
            for (int m = 0; m < 4; ++m) { bf16* rowp = base + (size_t)(row0 + ai * 128 + m * 16) * ldc + col0;
#pragma unroll
                for (int bj = 0; bj < 2; ++bj) { const pg8::f32x4 v0 = acc[ai][bj][m][0], v1 = acc[ai][bj][m][1];
                    u32x4 w; w.x = pg8::cvt_pk_bf16(v0[0], v0[1]); w.y = pg8::cvt_pk_bf16(v0[2], v0[3]); w.z = pg8::cvt_pk_bf16(v1[0], v1[1]); w.w = pg8::cvt_pk_bf16(v1[2], v1[3]);
                    if (!tail || (bj == 0 && wc == 0 && fq < 2)) *(u32x4*)(rowp + bj * 128) = w; } }
    }
};
struct EpiPlain {
    static constexpr bool PERM = true;
    bf16* O; int ldc;
    __device__ __forceinline__ void operator()(const pg8::f32x4 (&acc)[2][2][4][2], const pg8::Unit& u, int wr, int wc, int fr, int fq) const {
        const int row0 = u.pm * 256 + wr * 64 + fr, col0 = u.pn * 256 + wc * 32 + 8 * fq;
#pragma unroll
        for (int ai = 0; ai < 2; ++ai)
#pragma unroll
            for (int m = 0; m < 4; ++m) { bf16* rowp = O + (size_t)(row0 + ai * 128 + m * 16) * ldc + col0;
#pragma unroll
                for (int bj = 0; bj < 2; ++bj) { const pg8::f32x4 v0 = acc[ai][bj][m][0], v1 = acc[ai][bj][m][1];
                    u32x4 w; w.x = pg8::cvt_pk_bf16(v0[0], v0[1]); w.y = pg8::cvt_pk_bf16(v0[2], v0[3]); w.z = pg8::cvt_pk_bf16(v1[0], v1[1]); w.w = pg8::cvt_pk_bf16(v1[2], v1[3]);
                    *(u32x4*)(rowp + bj * 128) = w; } }
    }
};
typedef _Float16 h16x2 __attribute__((ext_vector_type(2)));
__device__ __forceinline__ unsigned pkh(float a, float b) { return __builtin_bit_cast(unsigned, __builtin_amdgcn_cvt_pkrtz(a, b)); }
struct EpiF16 {
    static constexpr bool PERM = true;
    unsigned short* O; int ldc;
    __device__ __forceinline__ void operator()(const pg8::f32x4 (&acc)[2][2][4][2], const pg8::Unit& u, int wr, int wc, int fr, int fq) const {
        const int row0 = u.pm * 256 + wr * 64 + fr, col0 = u.pn * 256 + wc * 32 + 8 * fq;
#pragma unroll
        for (int ai = 0; ai < 2; ++ai)
#pragma unroll
            for (int m = 0; m < 4; ++m) { unsigned short* rowp = O + (size_t)(row0 + ai * 128 + m * 16) * ldc + col0;
#pragma unroll
                for (int bj = 0; bj < 2; ++bj) { const pg8::f32x4 v0 = acc[ai][bj][m][0], v1 = acc[ai][bj][m][1];
                    u32x4 w; w.x = pkh(v0[0], v0[1]); w.y = pkh(v0[2], v0[3]); w.z = pkh(v1[0], v1[1]); w.w = pkh(v1[2], v1[3]);
                    *(u32x4*)(rowp + bj * 128) = w; } }
    }
};
struct EpiLru {
    static constexpr bool PERM = true;
    bf16* LA;   bf16* XCU;   const float *lba, *lbx, *lam;
    __device__ __forceinline__ void operator()(const pg8::f32x4 (&acc)[2][2][4][2], const pg8::Unit& u, int wr, int wc, int fr, int fq) const {
        const int row0 = u.pm * 256 + wr * 64 + fr, ch0 = u.pn * 128 + wc * 32 + 8 * fq;
        float ba[8], bx[8], sp[8];
#pragma unroll
        for (int j = 0; j < 8; ++j) { ba[j] = lba[ch0 + j]; bx[j] = lbx[ch0 + j]; sp[j] = -8.f * softplus_f(-lam[ch0 + j]); }
#pragma unroll
        for (int ai = 0; ai < 2; ++ai)
#pragma unroll
            for (int m = 0; m < 4; ++m) { const size_t row = (size_t)(row0 + ai * 128 + m * 16);
                const u32x4 xw = *(const u32x4*)(XCU + row * 1024 + ch0);
                float xc[8] = {bflo(xw.x), bfhi(xw.x), bflo(xw.y), bfhi(xw.y), bflo(xw.z), bfhi(xw.z), bflo(xw.w), bfhi(xw.w)};
                float la[8], uu[8];
#pragma unroll
                for (int j = 0; j < 8; ++j) { const float pr = acc[ai][0][m][j >> 2][j & 3] + ba[j], pi = acc[ai][1][m][j >> 2][j & 3] + bx[j];
                    const float gr = sigmoid_f(pr), gi = sigmoid_f(pi);
                    la[j] = sp[j] * gr; const float a2 = __expf(2.f * la[j]);
                    uu[j] = sqrtf(fmaxf(1.f - a2, 0.f)) * gi * xc[j]; }
                u32x4 w1, w2; w1.x = pk2(la[0], la[1]); w1.y = pk2(la[2], la[3]); w1.z = pk2(la[4], la[5]); w1.w = pk2(la[6], la[7]);
                w2.x = pk2(uu[0], uu[1]); w2.y = pk2(uu[2], uu[3]); w2.z = pk2(uu[4], uu[5]); w2.w = pk2(uu[6], uu[7]);
                *(u32x4*)(LA + row * 2048 + ch0) = w1; *(u32x4*)(XCU + row * 1024 + ch0) = w2; }
    }
};

__device__ __forceinline__ void p0_transpose_item(const float* W, int ldw, int k0, int n0, int nvalid, bf16* WT, int ldk, int row0, int kc0, LAS float* scr, int lane) {
#pragma unroll 8
    for (int i = 0; i < 32; ++i) { const int kk = 2 * i + (lane >> 5), cc = lane & 31; scr[kk * 33 + cc] = (cc < nvalid) ? W[(size_t)(k0 + kk) * ldw + n0 + cc] : 0.f; }
    LDS_WAIT(); asm volatile("" ::: "memory");
    const int c = lane & 7;
#pragma unroll
    for (int j = 0; j < 4; ++j) { const int n = (lane >> 3) + 8 * j; const LAS float* s = scr + (8 * c) * 33 + n;
        u32x4 o; o.x = pk2(s[0 * 33], s[1 * 33]); o.y = pk2(s[2 * 33], s[3 * 33]); o.z = pk2(s[4 * 33], s[5 * 33]); o.w = pk2(s[6 * 33], s[7 * 33]);
        *(u32x4*)(WT + (size_t)(row0 + n) * ldk + kc0 + k0 + 8 * c) = o; }
    LDS_WAIT(); asm volatile("" ::: "memory");
}
__device__ __forceinline__ void phase0(const Params& p, LAS unsigned char* lds, int G) {
    const int tid = threadIdx.x, lane = tid & 63, wave = __builtin_amdgcn_readfirstlane(tid >> 6);
    unsigned char* ws = p.ws;
    {
        LAS float* sc = (LAS float*)lds;
        LAS float* red = (LAS float*)(lds + 4096);
        float* modp = (float*)(ws + WS_MODP);
        for (int it = blockIdx.x; it < 24 * 8; it += G) {
            const int nb = it % 24, kc = it / 24;
            for (int i = tid; i < 1024; i += NTHR) { const int b = i >> 7, k = i & 127; sc[i] = silu_f(p.c[b * 1024 + kc * 128 + k]); }
            __syncthreads();
            const int col = tid & 255, kh = tid >> 8;
            float acc[8];
#pragma unroll
            for (int b = 0; b < 8; ++b) acc[b] = 0.f;
            const float* wp = p.w_ada + (size_t)(kc * 128 + kh * 64) * 6144 + nb * 256 + col;
#pragma unroll 8
            for (int kk = 0; kk < 64; ++kk) { const float w = wp[(size_t)kk * 6144];
#pragma unroll
                for (int b = 0; b < 8; ++b) acc[b] += sc[b * 128 + kh * 64 + kk] * w; }
            if (kh == 1) {
#pragma unroll
                for (int b = 0; b < 8; ++b) red[b * 256 + col] = acc[b]; }
            __syncthreads();
            if (kh == 0) { const int n = nb * 256 + col; const float bias = (kc == 0) ? p.b_ada[n] : 0.f;
#pragma unroll
                for (int b = 0; b < 8; ++b) modp[(size_t)(kc * 8 + b) * 6144 + n] = acc[b] + red[b * 256 + col] + bias; }
            __syncthreads();
        }
    }
    LAS float* scr = (LAS float*)(lds + 16384 + wave * 8448);
    const int gw = blockIdx.x * NWAVES + wave, NGW = G * NWAVES;
    bf16* WinT = (bf16*)(ws + WS_WIN); bf16* WoutT = (bf16*)(ws + WS_WOUT); bf16* WqT = (bf16*)(ws + WS_WQ);
    bf16* LruB = (bf16*)(ws + WS_LRUB); bf16* SubK = (bf16*)(ws + WS_SUBK);
    constexpr int I_IN = 16 * (NPAD / 32), I_OUT = 16 * 32, I_Q = 16 * 64, I_LRU = 16 * 8, I_SUB = 2048, I_TAB = 2 * 16384;
    constexpr int NIT = I_IN + I_OUT + I_Q + I_LRU + I_SUB + I_TAB;
    for (int it = gw; it < NIT; it += NGW) {
        int r = it;
        if (r < I_IN) { const int nb = r % (NPAD / 32), kb = r / (NPAD / 32), nq = nb * 32; int n0, nv;
            if (nq < 3072) { n0 = nq; nv = 32; } else if (nq < 7168) { n0 = nq + 16; nv = 32; } else if (nq == 7168) { n0 = 3072; nv = 16; } else { n0 = 0; nv = 0; }
            p0_transpose_item(p.w_in, 7184, kb * 64, n0, nv, WinT, 1024, nq, 0, scr, lane); continue; } r -= I_IN;
        if (r < I_OUT) { const int nb = r % 32, kb = r / 32; p0_transpose_item(p.w_out, 1024, kb * 64, nb * 32, 32, WoutT, 1024, nb * 32, 0, scr, lane); continue; } r -= I_OUT;
        if (r < I_Q) { const int nb = r % 64, kb = r / 64; p0_transpose_item(p.wq, 2048, kb * 64, nb * 32, 32, WqT, 1024, nb * 32, 0, scr, lane); continue; } r -= I_Q;
        if (r < I_LRU) {
            const int mat = r >> 3, sub = r & 7, g = mat >> 3, n = mat & 7, kb = sub >> 2, nb = sub & 3;
            const int np = n < 6 ? n : 6, half = n - np;
            const float* W = (g ? p.lwx : p.lwa) + (size_t)n * 128 * 128;
            bf16* dst = LruB + (size_t)n * 256 * 256;
            p0_transpose_item(W, 128, kb * 64, nb * 32, 32, dst, 256, g * 128 + nb * 32, half * 128, scr, lane);
            p0_transpose_item(W, 128, kb * 64, 0, 0, dst, 256, g * 128 + nb * 32, (1 - half) * 128, scr, lane);
            continue; } r -= I_LRU;
        if (r < I_SUB) {
            const int h = r >> 8, pp = (r >> 7) & 1, n = r & 127;
            const float* src = p.subk + (size_t)r * 128; bf16* dst = SubK + ((size_t)h * 256 + pp * 128 + n) * 256;
            const f32x2 v = *(const f32x2*)(src + 2 * lane);
            *(unsigned*)(dst + pp * 128 + 2 * lane) = pk2(v.x, v.y);
            *(unsigned*)(dst + (1 - pp) * 128 + 2 * lane) = 0u;
            continue; } r -= I_SUB;
        {
            const int tb = r >> 14, row = r & 16383;
            const float* src = (tb ? p.pv : p.pu) + (size_t)row * 1024 + lane * 16;
            f32x4 v[4]; float am = 0.f;
#pragma unroll
            for (int j = 0; j < 4; ++j) { v[j] = *(const f32x4*)(src + 4 * j); am = fmaxf(am, fmaxf(fmaxf(fabsf(v[j].x), fabsf(v[j].y)), fmaxf(fabsf(v[j].z), fabsf(v[j].w)))); }
#pragma unroll
            for (int o = 1; o < 64; o <<= 1) am = fmaxf(am, __shfl_xor(am, o));
            const float inv = am > 0.f ? 416.f / am : 0.f;
            u32x4 o;
            { int w = 0; w = __builtin_amdgcn_cvt_pk_fp8_f32(v[0].x * inv, v[0].y * inv, w, false); w = __builtin_amdgcn_cvt_pk_fp8_f32(v[0].z * inv, v[0].w * inv, w, true); o.x = (unsigned)w; }
            { int w = 0; w = __builtin_amdgcn_cvt_pk_fp8_f32(v[1].x * inv, v[1].y * inv, w, false); w = __builtin_amdgcn_cvt_pk_fp8_f32(v[1].z * inv, v[1].w * inv, w, true); o.y = (unsigned)w; }
            { int w = 0; w = __builtin_amdgcn_cvt_pk_fp8_f32(v[2].x * inv, v[2].y * inv, w, false); w = __builtin_amdgcn_cvt_pk_fp8_f32(v[2].z * inv, v[2].w * inv, w, true); o.z = (unsigned)w; }
            { int w = 0; w = __builtin_amdgcn_cvt_pk_fp8_f32(v[3].x * inv, v[3].y * inv, w, false); w = __builtin_amdgcn_cvt_pk_fp8_f32(v[3].z * inv, v[3].w * inv, w, true); o.w = (unsigned)w; }
            *(u32x4*)(ws + (tb ? WS_V : WS_U) + (size_t)row * 1024 + lane * 16) = o;
            if (lane == 0) ((float*)(ws + (tb ? WS_SV : WS_SU)))[row] = am * (1.f / 416.f);
        }
    }
}

__device__ __forceinline__ float mod_at(const float* modp, int b, int n) {
    float s = 0.f;
#pragma unroll
    for (int kc = 0; kc < 8; ++kc) s += modp[(size_t)(kc * 8 + b) * 6144 + n];
    return s;
}

__device__ __forceinline__ void phase1(const Params& p, LAS unsigned char* lds, int G) {
    const int tid = threadIdx.x, lane = tid & 63, wave = __builtin_amdgcn_readfirstlane(tid >> 6);
    const float* modp = (const float*)(p.ws + WS_MODP);
    LAS float* gs = (LAS float*)lds; LAS float* sh = gs + 1024;
    bf16* H = (bf16*)p.out;
    for (int tile = blockIdx.x; tile < T / 256; tile += G) {
        const int b = tile / 32;
        __syncthreads();
        for (int k = tid; k < 1024; k += NTHR) { gs[k] = p.npm[k] * (1.f + mod_at(modp, b, 1024 + k)); sh[k] = mod_at(modp, b, k); }
        __syncthreads();
        for (int rr = 0; rr < 32; ++rr) {
            const size_t row = (size_t)tile * 256 + wave * 32 + rr;
            const f32x4* xr = (const f32x4*)(p.x + row * 1024) + lane;
            f32x4 v[4]; float s = 0.f;
#pragma unroll
            for (int j = 0; j < 4; ++j) { v[j] = xr[64 * j]; s += (v[j].x * v[j].x + v[j].y * v[j].y) + (v[j].z * v[j].z + v[j].w * v[j].w); }
            const float rstd = 1.f / sqrtf(wave_sum(s) * (1.f / 1024.f) + 1e-6f);
            u32x2* o8 = (u32x2*)(H + row * 1024) + lane;
#pragma unroll
            for (int j = 0; j < 4; ++j) { const int k = 256 * j + 4 * lane; const f32x4 g4 = *(const LAS f32x4*)(gs + k), s4 = *(const LAS f32x4*)(sh + k);
                u32x2 w; w.x = pk2(v[j].x * rstd * g4.x + s4.x, v[j].y * rstd * g4.y + s4.y); w.y = pk2(v[j].z * rstd * g4.z + s4.z, v[j].w * rstd * g4.w + s4.w);
                o8[64 * j] = w; }
        }
    }
}

__device__ __forceinline__ void phase_conv(const Params& p, int G) {
    const int tid = threadIdx.x, lane = tid & 63, wave = __builtin_amdgcn_readfirstlane(tid >> 6);
    const int gw = blockIdx.x * NWAVES + wave, NGW = G * NWAVES;
    const bf16* XL = (const bf16*)(p.ws + WS_XLXG); bf16* XC = (bf16*)p.out;
    for (int it = gw; it < (T / 64) * 2; it += NGW) {
        const int rt = it >> 1, c0 = (it & 1) * 512 + lane * 8;
        float w[4][8], cb[8];
#pragma unroll
        for (int j = 0; j < 8; ++j) { cb[j] = p.conv_b[c0 + j];
#pragma unroll
            for (int q = 0; q < 4; ++q) w[q][j] = p.conv_w[q * 1024 + c0 + j]; }
        float x1[8], x2[8], x3[8];
        const int t0 = rt * 64; const bool first = (t0 % SEQ) == 0;
#pragma unroll
        for (int j = 0; j < 8; ++j) { x1[j] = 0.f; x2[j] = 0.f; x3[j] = 0.f; }
        if (!first) {
            const u32x4 a = *(const u32x4*)(XL + (size_t)(t0 - 1) * 2048 + c0), b = *(const u32x4*)(XL + (size_t)(t0 - 2) * 2048 + c0), c = *(const u32x4*)(XL + (size_t)(t0 - 3) * 2048 + c0);
            x1[0] = bflo(a.x); x1[1] = bfhi(a.x); x1[2] = bflo(a.y); x1[3] = bfhi(a.y); x1[4] = bflo(a.z); x1[5] = bfhi(a.z); x1[6] = bflo(a.w); x1[7] = bfhi(a.w);
            x2[0] = bflo(b.x); x2[1] = bfhi(b.x); x2[2] = bflo(b.y); x2[3] = bfhi(b.y); x2[4] = bflo(b.z); x2[5] = bfhi(b.z); x2[6] = bflo(b.w); x2[7] = bfhi(b.w);
            x3[0] = bflo(c.x); x3[1] = bfhi(c.x); x3[2] = bflo(c.y); x3[3] = bfhi(c.y); x3[4] = bflo(c.z); x3[5] = bfhi(c.z); x3[6] = bflo(c.w); x3[7] = bfhi(c.w);
        }
#pragma unroll 4
        for (int i = 0; i < 64; ++i) {
            const u32x4 a = *(const u32x4*)(XL + (size_t)(t0 + i) * 2048 + c0);
            float x0[8] = {bflo(a.x), bfhi(a.x), bflo(a.y), bfhi(a.y), bflo(a.z), bfhi(a.z), bflo(a.w), bfhi(a.w)};
            float o[8];
#pragma unroll
            for (int j = 0; j < 8; ++j) { o[j] = cb[j] + w[0][j] * x3[j] + w[1][j] * x2[j] + w[2][j] * x1[j] + w[3][j] * x0[j]; x3[j] = x2[j]; x2[j] = x1[j]; x1[j] = x0[j]; }
            u32x4 wv; wv.x = pk2(o[0], o[1]); wv.y = pk2(o[2], o[3]); wv.z = pk2(o[4], o[5]); wv.w = pk2(o[6], o[7]);
            *(u32x4*)(XC + (size_t)(t0 + i) * 1024 + c0) = wv;
        }
    }
}

template <bool FINAL>
__device__ __forceinline__ void phase_lru_scan(const Params& p, int G) {
    const int tid = threadIdx.x;
    const bf16* LA = (const bf16*)(p.ws + WS_XLXG); const bf16* U = (const bf16*)p.out;
    const bf16* XG = (const bf16*)(p.ws + WS_XLXG) + 1024; bf16* GB = (bf16*)(p.ws + WS_GAGB) + 1024;
    f32x2* car = (f32x2*)(p.ws + WS_LRUC);
    for (int it = blockIdx.x; it < 8 * 32 * 2; it += G) {
        const int cg_ = it & 1, j = (it >> 1) & 31, b = it >> 6, ch = cg_ * 512 + tid;
        const size_t t0 = (size_t)b * SEQ + j * 256;
        if (!FINAL) {
            float h = 0.f, ls = 0.f;
#pragma unroll 8
            for (int i = 0; i < 256; ++i) { const float la = bf2f(LA[(t0 + i) * 2048 + ch]), u = bf2f(U[(t0 + i) * 1024 + ch]);
                h = __expf(la) * h + u; ls += la; }
            car[(size_t)(b * 32 + j) * 1024 + ch] = (f32x2){__expf(ls), h};
        } else {
            float h = 0.f;
            for (int i = 0; i < j; ++i) { const f32x2 c = car[(size_t)(b * 32 + i) * 1024 + ch]; h = c.x * h + c.y; }
#pragma unroll 8
            for (int i = 0; i < 256; ++i) { const float la = bf2f(LA[(t0 + i) * 2048 + ch]), u = bf2f(U[(t0 + i) * 1024 + ch]);
                h = __expf(la) * h + u;
                const float xg = bf2f(XG[(t0 + i) * 2048 + ch]), gb = bf2f(GB[(t0 + i) * 2048 + ch]);
                GB[(t0 + i) * 2048 + ch] = (bf16)f2bf(h * gelu_f(xg) * sigmoid_f(gb)); }
        }
    }
}

__device__ __forceinline__ void phase_gla_naive(const Params& p, LAS unsigned char* lds, int G) {
    const int tid = threadIdx.x;
    constexpr int TB = 32;
    LAS float* sA = (LAS float*)lds;
    LAS float* sK = sA + TB * 128;
    LAS float* sQ = sK + TB * 128;
    LAS float* sV = sQ + TB * 128;
    LAS float* sO = sV + TB * 64;
    const bf16* QKV = (const bf16*)(p.ws + WS_QKV); bf16* VO = (bf16*)(p.ws + WS_QKV);
    const bf16* AL = (const bf16*)(p.ws + WS_ALOW);
    for (int it = blockIdx.x; it < 8 * 4 * 4; it += G) {
        const int vs = it & 3, h = (it >> 2) & 3, b = it >> 4;
        const int vv = tid >> 3, kg = tid & 7;
        const int kp = tid & 127;
        float wa[16];
#pragma unroll
        for (int r = 0; r < 16; ++r) wa[r] = p.w_alpha[r * 512 + h * 128 + kp];
        const float balpha = p.b_alpha[h * 128 + kp];
        float S[16];
#pragma unroll
        for (int j = 0; j < 16; ++j) S[j] = 0.f;
        for (int tb = 0; tb < SEQ / TB; ++tb) {
            const size_t t0 = (size_t)b * SEQ + tb * TB;
            __syncthreads();
#pragma unroll
            for (int ps = 0; ps < TB / 4; ++ps) { const int tt = ps * 4 + (tid >> 7); const size_t t = t0 + tt;
                const u32x4 a0 = *(const u32x4*)(AL + t * 16), a1 = *(const u32x4*)(AL + t * 16 + 8);
                float z = balpha;
                z += bflo(a0.x) * wa[0] + bfhi(a0.x) * wa[1] + bflo(a0.y) * wa[2] + bfhi(a0.y) * wa[3] + bflo(a0.z) * wa[4] + bfhi(a0.z) * wa[5] + bflo(a0.w) * wa[6] + bfhi(a0.w) * wa[7];
                z += bflo(a1.x) * wa[8] + bfhi(a1.x) * wa[9] + bflo(a1.y) * wa[10] + bfhi(a1.y) * wa[11] + bflo(a1.z) * wa[12] + bfhi(a1.z) * wa[13] + bflo(a1.w) * wa[14] + bfhi(a1.w) * wa[15];
                const float ls = fminf(z, 0.f) - log1pf(__expf(-fabsf(z)));
                sA[tt * 128 + kp] = __expf(ls * (1.f / 16.f));
                sQ[tt * 128 + kp] = bf2f(QKV[t * 2048 + h * 128 + kp]) * 0.08838834764831845f;
                sK[tt * 128 + kp] = bf2f(QKV[t * 2048 + 512 + h * 128 + kp]); }
#pragma unroll
            for (int ps = 0; ps < TB * 64 / NTHR; ++ps) { const int e = ps * NTHR + tid, tt = e >> 6, v = e & 63;
                sV[e] = bf2f(QKV[(t0 + tt) * 2048 + 1024 + h * 256 + vs * 64 + v]); }
            __syncthreads();
            for (int tt = 0; tt < TB; ++tt) {
                const float vx = sV[tt * 64 + vv];
                float o = 0.f;
#pragma unroll
                for (int q4 = 0; q4 < 4; ++q4) {
                    const f32x4 a = *(const LAS f32x4*)(sA + tt * 128 + kg * 16 + q4 * 4), kk = *(const LAS f32x4*)(sK + tt * 128 + kg * 16 + q4 * 4), qq = *(const LAS f32x4*)(sQ + tt * 128 + kg * 16 + q4 * 4);
                    S[q4 * 4 + 0] = a.x * S[q4 * 4 + 0] + kk.x * vx; o += qq.x * S[q4 * 4 + 0];
                    S[q4 * 4 + 1] = a.y * S[q4 * 4 + 1] + kk.y * vx; o += qq.y * S[q4 * 4 + 1];
                    S[q4 * 4 + 2] = a.z * S[q4 * 4 + 2] + kk.z * vx; o += qq.z * S[q4 * 4 + 2];
                    S[q4 * 4 + 3] = a.w * S[q4 * 4 + 3] + kk.w * vx; o += qq.w * S[q4 * 4 + 3];
                }
                o += __shfl_xor(o, 1); o += __shfl_xor(o, 2); o += __shfl_xor(o, 4);
                if (kg == 0) sO[tt * 64 + vv] = o;
            }
            __syncthreads();
#pragma unroll
            for (int ps = 0; ps < TB * 64 / NTHR; ++ps) { const int e = ps * NTHR + tid, tt = e >> 6, v = e & 63;
                VO[(t0 + tt) * 2048 + 1024 + h * 256 + vs * 64 + v] = (bf16)f2bf(sO[e]); }
        }
    }
}

typedef short bf16x8_t __attribute__((ext_vector_type(8)));
__device__ __forceinline__ void phase_gla_chunk(const Params& p, LAS unsigned char* lds, int G) {
    const int tid = threadIdx.x, lane = tid & 63, wave = __builtin_amdgcn_readfirstlane(tid >> 6), q4 = lane >> 4, c16 = lane & 15;
    constexpr int PQ = 136, PS = 72;
    LAS bf16* Qs = (LAS bf16*)lds;
    LAS bf16* Kd = Qs + 64 * PQ;
    LAS bf16* KdT = Kd + 64 * PQ;
    LAS bf16* VT = KdT + 128 * PS;
    LAS bf16* Pm = VT + 64 * PS;
    LAS bf16* ST = Pm + 64 * PS;
    LAS float* dk = (LAS float*)(ST + 64 * PQ);
    LAS float* segt = dk + 128;
    const bf16* QKV = (const bf16*)(p.ws + WS_QKV); bf16* VO = (bf16*)(p.ws + WS_QKV);
    const bf16* AL = (const bf16*)(p.ws + WS_ALOW);
    const int kp = tid & 127, seg = tid >> 7;
    const int vv = tid & 63, ss = tid >> 6;
    for (int it = blockIdx.x; it < 8 * 4 * 4; it += G) {
        const int vq = it & 3, h = (it >> 2) & 3, b = it >> 4;
        float wa[16];
#pragma unroll
        for (int r = 0; r < 16; ++r) wa[r] = p.w_alpha[r * 512 + h * 128 + kp];
        const float balpha = p.b_alpha[h * 128 + kp];
        pg8::f32x4 sacc[4];
#pragma unroll
        for (int i = 0; i < 4; ++i) sacc[i] = (pg8::f32x4){0.f, 0.f, 0.f, 0.f};
        __syncthreads();
        for (int i = tid; i < 64 * PQ / 2; i += NTHR) ((LAS unsigned*)ST)[i] = 0u;
#pragma unroll 1
        for (int ch = 0; ch < SEQ / 64; ++ch) {
            const size_t t0 = (size_t)b * SEQ + ch * 64;
            float cl[16]; float run = 0.f;
#pragma unroll
            for (int i = 0; i < 16; ++i) { const size_t t = t0 + seg * 16 + i;
                const u32x4 a0 = *(const u32x4*)(AL + t * 16), a1 = *(const u32x4*)(AL + t * 16 + 8);
                float z = balpha;
                z += bflo(a0.x) * wa[0] + bfhi(a0.x) * wa[1] + bflo(a0.y) * wa[2] + bfhi(a0.y) * wa[3] + bflo(a0.z) * wa[4] + bfhi(a0.z) * wa[5] + bflo(a0.w) * wa[6] + bfhi(a0.w) * wa[7];
                z += bflo(a1.x) * wa[8] + bfhi(a1.x) * wa[9] + bflo(a1.y) * wa[10] + bfhi(a1.y) * wa[11] + bflo(a1.z) * wa[12] + bfhi(a1.z) * wa[13] + bflo(a1.w) * wa[14] + bfhi(a1.w) * wa[15];
                const float ls = fminf(z, 0.f) - __logf(1.f + __expf(-fabsf(z)));
                run += ls * (1.f / 16.f); cl[i] = run; }
            segt[seg * 128 + kp] = run;
            { unsigned w[4];
#pragma unroll
              for (int i = 0; i < 4; ++i) { const unsigned lo = QKV[(t0 + ss * 8 + 2 * i) * 2048 + 1024 + h * 256 + vq * 64 + vv], hi = QKV[(t0 + ss * 8 + 2 * i + 1) * 2048 + 1024 + h * 256 + vq * 64 + vv]; w[i] = lo | (hi << 16); }
              *(LAS u32x4*)(VT + vv * PS + ss * 8) = (u32x4){w[0], w[1], w[2], w[3]}; }
            __syncthreads();
            { float off = 0.f, tot = 0.f;
#pragma unroll
              for (int s = 0; s < 4; ++s) { const float v = segt[s * 128 + kp]; tot += v; if (s < seg) off += v; }
              if (seg == 0) dk[kp] = __expf(tot);
              unsigned kw[8];
#pragma unroll
              for (int i = 0; i < 16; ++i) { const size_t t = t0 + seg * 16 + i; const float cum = cl[i] + off, eq = __expf(cum), ek = __expf(-cum);
                  const float qv = bf2f(QKV[t * 2048 + h * 128 + kp]) * 0.08838834764831845f * eq, kv = bf2f(QKV[t * 2048 + 512 + h * 128 + kp]) * ek;
                  const unsigned kb = f2bf(kv);
                  Qs[(seg * 16 + i) * PQ + kp] = (bf16)f2bf(qv); Kd[(seg * 16 + i) * PQ + kp] = (bf16)kb;
                  if (i & 1) kw[i >> 1] |= kb << 16; else kw[i >> 1] = kb; }
              *(LAS u32x4*)(KdT + kp * PS + seg * 16) = (u32x4){kw[0], kw[1], kw[2], kw[3]};
              *(LAS u32x4*)(KdT + kp * PS + seg * 16 + 8) = (u32x4){kw[4], kw[5], kw[6], kw[7]}; }
            __syncthreads();
            { const int tt = wave & 3;
#pragma unroll
              for (int i2 = 0; i2 < 2; ++i2) { const int ts = (wave >> 2) * 2 + i2;
                  pg8::f32x4 acc = (pg8::f32x4){0.f, 0.f, 0.f, 0.f};
                  if (ts <= tt) {
#pragma unroll
                      for (int ks = 0; ks < 4; ++ks) { const bf16x8_t a = *(const LAS bf16x8_t*)(Kd + (ts * 16 + c16) * PQ + ks * 32 + q4 * 8), bb = *(const LAS bf16x8_t*)(Qs + (tt * 16 + c16) * PQ + ks * 32 + q4 * 8);
                          acc = __builtin_amdgcn_mfma_f32_16x16x32_bf16(a, bb, acc, 0, 0, 0); }
                      const int tg = tt * 16 + c16, sg = ts * 16 + q4 * 4;
#pragma unroll
                      for (int j = 0; j < 4; ++j) if (sg + j > tg) acc[j] = 0.f;
                  }
                  *(LAS u32x2*)(Pm + (tt * 16 + c16) * PS + ts * 16 + q4 * 4) = (u32x2){pk2(acc[0], acc[1]), pk2(acc[2], acc[3])}; } }
            __syncthreads();
            { const int tt = wave & 3;
              pg8::f32x4 oacc[2] = {(pg8::f32x4){0.f, 0.f, 0.f, 0.f}, (pg8::f32x4){0.f, 0.f, 0.f, 0.f}};
#pragma unroll
              for (int ks = 0; ks < 2; ++ks) { const bf16x8_t bb = *(const LAS bf16x8_t*)(Pm + (tt * 16 + c16) * PS + ks * 32 + q4 * 8);
#pragma unroll
                  for (int i2 = 0; i2 < 2; ++i2) { const int tv = (wave >> 2) * 2 + i2; const bf16x8_t a = *(const LAS bf16x8_t*)(VT + (tv * 16 + c16) * PS + ks * 32 + q4 * 8);
                      oacc[i2] = __builtin_amdgcn_mfma_f32_16x16x32_bf16(a, bb, oacc[i2], 0, 0, 0); } }
#pragma unroll
              for (int ks = 0; ks < 4; ++ks) { const bf16x8_t bb = *(const LAS bf16x8_t*)(Qs + (tt * 16 + c16) * PQ + ks * 32 + q4 * 8);
#pragma unroll
                  for (int i2 = 0; i2 < 2; ++i2) { const int tv = (wave >> 2) * 2 + i2; const bf16x8_t a = *(const LAS bf16x8_t*)(ST + (tv * 16 + c16) * PQ + ks * 32 + q4 * 8);
                      oacc[i2] = __builtin_amdgcn_mfma_f32_16x16x32_bf16(a, bb, oacc[i2], 0, 0, 0); } }
#pragma unroll
              for (int i2 = 0; i2 < 2; ++i2) { const int tv = (wave >> 2) * 2 + i2;
                  *(u32x2*)(VO + (t0 + tt * 16 + c16) * 2048 + 1024 + h * 256 + vq * 64 + tv * 16 + q4 * 4) = (u32x2){pk2(oacc[i2][0], oacc[i2][1]), pk2(oacc[i2][2], oacc[i2][3])}; } }
#pragma unroll
            for (int ks = 0; ks < 2; ++ks) { const bf16x8_t a = *(const LAS bf16x8_t*)(KdT + (wave * 16 + c16) * PS + ks * 32 + q4 * 8);
#pragma unroll
                for (int tv = 0; tv < 4; ++tv) { const bf16x8_t bb = *(const LAS bf16x8_t*)(VT + (tv * 16 + c16) * PS + ks * 32 + q4 * 8);
                    sacc[tv] = __builtin_amdgcn_mfma_f32_16x16x32_bf16(a, bb, sacc[tv], 0, 0, 0); } }
            { const pg8::f32x4 d4 = *(const LAS pg8::f32x4*)(dk + wave * 16 + q4 * 4);
#pragma unroll
              for (int tv = 0; tv < 4; ++tv) sacc[tv] = sacc[tv] * d4; }
            __syncthreads();
#pragma unroll
            for (int tv = 0; tv < 4; ++tv) *(LAS u32x2*)(ST + (tv * 16 + c16) * PQ + wave * 16 + q4 * 4) = (u32x2){pk2(sacc[tv][0], sacc[tv][1]), pk2(sacc[tv][2], sacc[tv][3])};
        }
    }
}

__device__ __forceinline__ void phase_gla_final(const Params& p, int G) {
    const int tid = threadIdx.x, lane = tid & 63, wave = __builtin_amdgcn_readfirstlane(tid >> 6);
    const int gw = blockIdx.x * NWAVES + wave, NGW = G * NWAVES;
    const bf16* O = (const bf16*)(p.ws + WS_QKV) + 1024; const bf16* R = (const bf16*)(p.ws + WS_R); bf16* GA = (bf16*)(p.ws + WS_GAGB);
    for (int row = gw; row < T; row += NGW) {
#pragma unroll
        for (int h = 0; h < 4; ++h) { const int c0 = h * 256 + lane * 4;
            const u32x2 ov = *(const u32x2*)(O + (size_t)row * 2048 + c0), rv = *(const u32x2*)(R + (size_t)row * 1024 + c0);
            const u32x2 gav = *(const u32x2*)(GA + (size_t)row * 2048 + c0), tv = *(const u32x2*)(GA + (size_t)row * 2048 + 1024 + c0);
            const float o[4] = {bflo(ov.x), bfhi(ov.x), bflo(ov.y), bfhi(ov.y)}, r[4] = {bflo(rv.x), bfhi(rv.x), bflo(rv.y), bfhi(rv.y)};
            const float ga[4] = {bflo(gav.x), bfhi(gav.x), bflo(gav.y), bfhi(gav.y)}, tm[4] = {bflo(tv.x), bfhi(tv.x), bflo(tv.y), bfhi(tv.y)};
            const float ss = wave_sum((o[0] * o[0] + o[1] * o[1]) + (o[2] * o[2] + o[3] * o[3]));
            const float rstd = 1.f / sqrtf(ss * (1.f / 256.f) + 1e-6f);
            const f32x4 gn = *(const f32x4*)(p.gla_norm + c0);
            float m[4];
#pragma unroll
            for (int j = 0; j < 4; ++j) m[j] = sigmoid_f(ga[j]) * (o[j] * rstd * gn[j] * silu_f(r[j])) + tm[j];
            u32x2 w; w.x = pk2(m[0], m[1]); w.y = pk2(m[2], m[3]);
            *(u32x2*)(GA + (size_t)row * 2048 + c0) = w; }
    }
}

__device__ __forceinline__ void phase_norm2(const Params& p, LAS unsigned char* lds, int G) {
    const int tid = threadIdx.x, lane = tid & 63, wave = __builtin_amdgcn_readfirstlane(tid >> 6);
    const float* modp = (const float*)(p.ws + WS_MODP);
    LAS float* g1 = (LAS float*)lds; LAS float* gs = g1 + 1024; LAS float* sh = gs + 1024;
    const bf16* Y = (const bf16*)(p.ws + WS_Y); bf16* H2 = (bf16*)(p.ws + WS_H2);
    for (int tile = blockIdx.x; tile < T / 256; tile += G) {
        const int b = tile / 32;
        __syncthreads();
        for (int k = tid; k < 1024; k += NTHR) { g1[k] = mod_at(modp, b, 2048 + k) * p.npo[k]; gs[k] = p.npf[k] * (1.f + mod_at(modp, b, 4096 + k)); sh[k] = mod_at(modp, b, 3072 + k); }
        __syncthreads();
        for (int rr = 0; rr < 32; ++rr) {
            const size_t row = (size_t)tile * 256 + wave * 32 + rr;
            const f32x4* xr = (const f32x4*)(p.x + row * 1024) + lane; const u32x2* yr = (const u32x2*)(Y + row * 1024) + lane;
            f32x4 xv[4], yv[4]; float s = 0.f;
#pragma unroll
            for (int j = 0; j < 4; ++j) { xv[j] = xr[64 * j]; const u32x2 yw = yr[64 * j]; yv[j] = (f32x4){bflo(yw.x), bfhi(yw.x), bflo(yw.y), bfhi(yw.y)};
                s += (yv[j].x * yv[j].x + yv[j].y * yv[j].y) + (yv[j].z * yv[j].z + yv[j].w * yv[j].w); }
            const float rstd = 1.f / sqrtf(wave_sum(s) * (1.f / 1024.f) + 1e-6f);
            float s2 = 0.f;
            f32x4* orow = (f32x4*)(p.out + row * 1024) + lane;
#pragma unroll
            for (int j = 0; j < 4; ++j) { const int k = 256 * j + 4 * lane; const f32x4 g4 = *(const LAS f32x4*)(g1 + k);
                xv[j] = xv[j] + yv[j] * rstd * g4; orow[64 * j] = xv[j];
                s2 += (xv[j].x * xv[j].x + xv[j].y * xv[j].y) + (xv[j].z * xv[j].z + xv[j].w * xv[j].w); }
            const float rstd2 = 1.f / sqrtf(wave_sum(s2) * (1.f / 1024.f) + 1e-6f);
            u32x2* o8 = (u32x2*)(H2 + row * 1024) + lane;
#pragma unroll
            for (int j = 0; j < 4; ++j) { const int k = 256 * j + 4 * lane; const f32x4 g4 = *(const LAS f32x4*)(gs + k), s4 = *(const LAS f32x4*)(sh + k);
                u32x2 w; w.x = pk2(xv[j].x * rstd2 * g4.x + s4.x, xv[j].y * rstd2 * g4.y + s4.y); w.y = pk2(xv[j].z * rstd2 * g4.z + s4.z, xv[j].w * rstd2 * g4.w + s4.w);
                o8[64 * j] = w; }
        }
    }
}

__device__ __forceinline__ unsigned h16_key(unsigned b) { return (b & 0x8000u) ? (~b & 0xffffu) : (b | 0x8000u); }
__device__ __forceinline__ float h16_key_val(unsigned s) { const unsigned b = (s & 0x8000u) ? (s & 0x7fffu) : (~s & 0xffffu); return (float)__builtin_bit_cast(_Float16, (unsigned short)b); }
#define INS16(top, x) do { _Pragma("unroll") for (int _j = 0; _j < 16; ++_j) { const unsigned _hi = max(top[_j], x), _lo = min(top[_j], x); top[_j] = _hi; x = _lo; } } while (0)
__device__ __forceinline__ void phase_topk(const Params& p, LAS unsigned char* lds, int G) {
    const int tid = threadIdx.x;
    const unsigned short* SC = (const unsigned short*)(p.ws + WS_SC); unsigned* TK = (unsigned*)(p.ws + WS_TOPK); float* TK2 = (float*)(p.ws + WS_TOPK2);
    const float* SU = (const float*)(p.ws + WS_SU); const float* SV = (const float*)(p.ws + WS_SV);
    LAS unsigned* my = (LAS unsigned*)lds + tid * 33;
    for (int blk = blockIdx.x; blk < T * 8 / NTHR; blk += G) {
        const int item = blk * NTHR + tid, t = item >> 3, h = item & 7;
        unsigned topA[16], topB[16];
#pragma unroll
        for (int j = 0; j < 16; ++j) { topA[j] = 0u; topB[j] = 0u; }
        const u32x4* src = (const u32x4*)(SC + (size_t)t * 2048 + h * 256);
#pragma unroll 1
        for (int c8 = 0; c8 < 16; ++c8) { const u32x4 w = src[c8];
            const unsigned ww[4] = {w.x, w.y, w.z, w.w};
#pragma unroll
            for (int q = 0; q < 4; ++q) { unsigned k0 = (h16_key(ww[q] & 0xffffu) << 16) | (unsigned)(127 - (c8 * 8 + q * 2)), k1 = (h16_key(ww[q] >> 16) << 16) | (unsigned)(127 - (c8 * 8 + q * 2 + 1));
                INS16(topA, k0); INS16(topA, k1); } }
#pragma unroll 1
        for (int c8 = 0; c8 < 16; ++c8) { const u32x4 w = src[16 + c8];
            const unsigned ww[4] = {w.x, w.y, w.z, w.w};
#pragma unroll
            for (int q = 0; q < 4; ++q) { unsigned k0 = (h16_key(ww[q] & 0xffffu) << 16) | (unsigned)(127 - (c8 * 8 + q * 2)), k1 = (h16_key(ww[q] >> 16) << 16) | (unsigned)(127 - (c8 * 8 + q * 2 + 1));
                INS16(topB, k0); INS16(topB, k1); } }
        float fa[16], fb[16];
#pragma unroll
        for (int j = 0; j < 16; ++j) { fa[j] = h16_key_val(topA[j] >> 16); fb[j] = h16_key_val(topB[j] >> 16); my[j] = 127u - (topA[j] & 127u); my[16 + j] = 127u - (topB[j] & 127u); }
        unsigned ct[16];
#pragma unroll
        for (int j = 0; j < 16; ++j) ct[j] = 0u;
#pragma unroll
        for (int i = 0; i < 16; ++i)
#pragma unroll
            for (int j = 0; j < 16; ++j) if ((i + 1) * (j + 1) <= 16) {
                const float s = fa[i] + fb[j]; unsigned u = __builtin_bit_cast(unsigned, s); u ^= (u >> 31) ? 0xffffffffu : 0x80000000u;
                unsigned key = (u & 0xffffff00u) | (unsigned)(255 - (i * 16 + j));
                INS16(ct, key); }
        float val[16], mx, sum = 0.f;
#pragma unroll
        for (int m = 0; m < 16; ++m) { unsigned u = ct[m] & 0xffffff00u; u ^= (u >> 31) ? 0x80000000u : 0xffffffffu; val[m] = __builtin_bit_cast(float, u); }
        mx = val[0];
#pragma unroll
        for (int m = 0; m < 16; ++m) { val[m] = __expf(val[m] - mx); sum += val[m]; }
        const float inv = 1.f / sum;
        LDS_WAIT();
        unsigned outw[16]; float outs[16];
#pragma unroll
        for (int m = 0; m < 16; ++m) { const unsigned pos = 255u - (ct[m] & 255u), i = pos >> 4, j = pos & 15u;
            const unsigned e = my[i] * 128u + my[16 + j];
            outw[m] = (e << 16) | f2bf(val[m] * inv * SV[e]); outs[m] = SU[e]; }
        u32x4* dst = (u32x4*)(TK + (size_t)item * 16); f32x4* dst2 = (f32x4*)(TK2 + (size_t)item * 16);
#pragma unroll
        for (int q = 0; q < 4; ++q) { dst[q] = (u32x4){outw[4 * q], outw[4 * q + 1], outw[4 * q + 2], outw[4 * q + 3]}; dst2[q] = (f32x4){outs[4 * q], outs[4 * q + 1], outs[4 * q + 2], outs[4 * q + 3]}; }
    }
}

__device__ __forceinline__ f32x2 fp8lo(unsigned w) { return __builtin_amdgcn_cvt_pk_f32_fp8((int)w, false); }
__device__ __forceinline__ f32x2 fp8hi(unsigned w) { return __builtin_amdgcn_cvt_pk_f32_fp8((int)w, true); }
__device__ __forceinline__ float rdlane(float v, int l) { return __builtin_bit_cast(float, __builtin_amdgcn_readlane(__builtin_bit_cast(int, v), l)); }
__device__ __forceinline__ void phase_gather(const Params& p, LAS unsigned char* lds, int G) {
    const int tid = threadIdx.x, lane = tid & 63, wave = __builtin_amdgcn_readfirstlane(tid >> 6);
    const float* modp = (const float*)(p.ws + WS_MODP);
    LAS float* g2 = (LAS float*)lds;
    const bf16* H2 = (const bf16*)(p.ws + WS_H2); const unsigned* TK = (const unsigned*)(p.ws + WS_TOPK); const float* TK2 = (const float*)(p.ws + WS_TOPK2);
    const unsigned char* U8 = p.ws + WS_U; const unsigned char* V8 = p.ws + WS_V;
    for (int tile = blockIdx.x; tile < T / 256; tile += G) {
        const int b = tile / 32;
        __syncthreads();
        for (int k = tid; k < 1024; k += NTHR) g2[k] = mod_at(modp, b, 5120 + k) * p.npof[k];
        __syncthreads();
#pragma unroll 1
        for (int rr = 0; rr < 32; ++rr) {
            const size_t row = (size_t)tile * 256 + wave * 32 + rr;
            f32x2 xt[8];
            { const u32x4 a = *(const u32x4*)(H2 + row * 1024 + lane * 16), c = *(const u32x4*)(H2 + row * 1024 + lane * 16 + 8);
              xt[0] = (f32x2){bflo(a.x), bfhi(a.x)}; xt[1] = (f32x2){bflo(a.y), bfhi(a.y)}; xt[2] = (f32x2){bflo(a.z), bfhi(a.z)}; xt[3] = (f32x2){bflo(a.w), bfhi(a.w)};
              xt[4] = (f32x2){bflo(c.x), bfhi(c.x)}; xt[5] = (f32x2){bflo(c.y), bfhi(c.y)}; xt[6] = (f32x2){bflo(c.z), bfhi(c.z)}; xt[7] = (f32x2){bflo(c.w), bfhi(c.w)}; }
            f32x2 acc[8];
#pragma unroll
            for (int j = 0; j < 8; ++j) acc[j] = (f32x2){0.f, 0.f};
#pragma unroll 1
            for (int h = 0; h < 8; ++h) {
                const u32x4* ra = (const u32x4*)(TK + row * 128 + h * 16);
                const u32x4 w0 = ra[0], w1 = ra[1], w2 = ra[2], w3 = ra[3];
                const unsigned ww[16] = {w0.x, w0.y, w0.z, w0.w, w1.x, w1.y, w1.z, w1.w, w2.x, w2.y, w2.z, w2.w, w3.x, w3.y, w3.z, w3.w};
                u32x4 ur[16], vr[16];
#pragma unroll
                for (int m = 0; m < 16; ++m) { const size_t eo = (size_t)((unsigned)__builtin_amdgcn_readfirstlane((int)ww[m]) >> 16) * 1024 + lane * 16;
                    ur[m] = *(const u32x4*)(U8 + eo); vr[m] = *(const u32x4*)(V8 + eo); }
                const unsigned wa = TK[row * 128 + h * 16 + (lane >> 2)]; const float su = TK2[row * 128 + h * 16 + (lane >> 2)];
                float pd[16];
#pragma unroll
                for (int m = 0; m < 16; ++m) {
                    f32x2 s = xt[0] * fp8lo(ur[m].x);
                    s += xt[1] * fp8hi(ur[m].x); s += xt[2] * fp8lo(ur[m].y); s += xt[3] * fp8hi(ur[m].y);
                    s += xt[4] * fp8lo(ur[m].z); s += xt[5] * fp8hi(ur[m].z); s += xt[6] * fp8lo(ur[m].w); s += xt[7] * fp8hi(ur[m].w);
                    pd[m] = s.x + s.y; }
#pragma unroll
                for (int j = 0; j < 8; ++j) { const bool up = (lane & 32) != 0; const float keep = up ? pd[j + 8] : pd[j], send = up ? pd[j] : pd[j + 8]; pd[j] = keep + __shfl_xor(send, 32); }
#pragma unroll
                for (int j = 0; j < 4; ++j) { const bool up = (lane & 16) != 0; const float keep = up ? pd[j + 4] : pd[j], send = up ? pd[j] : pd[j + 4]; pd[j] = keep + __shfl_xor(send, 16); }
#pragma unroll
                for (int j = 0; j < 2; ++j) { const bool up = (lane & 8) != 0; const float keep = up ? pd[j + 2] : pd[j], send = up ? pd[j] : pd[j + 2]; pd[j] = keep + __shfl_xor(send, 8); }
                { const bool up = (lane & 4) != 0; const float keep = up ? pd[1] : pd[0], send = up ? pd[0] : pd[1]; pd[0] = keep + __shfl_xor(send, 4); }
                float d = pd[0]; d += __shfl_xor(d, 2); d += __shfl_xor(d, 1);
                const float coef = bflo(wa) * gelu_f(su * d);
#pragma unroll
                for (int m = 0; m < 16; ++m) { const float cm = rdlane(coef, 4 * m); const f32x2 c2 = (f32x2){cm, cm};
                    acc[0] += c2 * fp8lo(vr[m].x); acc[1] += c2 * fp8hi(vr[m].x); acc[2] += c2 * fp8lo(vr[m].y); acc[3] += c2 * fp8hi(vr[m].y);
                    acc[4] += c2 * fp8lo(vr[m].z); acc[5] += c2 * fp8hi(vr[m].z); acc[6] += c2 * fp8lo(vr[m].w); acc[7] += c2 * fp8hi(vr[m].w); }
            }
            float s = 0.f;
#pragma unroll
            for (int j = 0; j < 8; ++j) s += acc[j].x * acc[j].x + acc[j].y * acc[j].y;
            const float rstd = 1.f / sqrtf(wave_sum(s) * (1.f / 1024.f) + 1e-6f);
            float* orow = p.out + row * 1024 + lane * 16;
#pragma unroll
            for (int q = 0; q < 4; ++q) { f32x4 o = *(const f32x4*)(orow + 4 * q); const f32x4 ga = *(const LAS f32x4*)(g2 + lane * 16 + 4 * q);
                o.x += ga.x * acc[2 * q].x * rstd; o.y += ga.y * acc[2 * q].y * rstd; o.z += ga.z * acc[2 * q + 1].x * rstd; o.w += ga.w * acc[2 * q + 1].y * rstd;
                *(f32x4*)(orow + 4 * q) = o; }
        }
    }
}

template <int PH>
__device__ __forceinline__ void run_phase(const Params& p, LAS unsigned char* lds, int G) {
    unsigned char* ws = p.ws;
    if constexpr (PH == 0) phase0(p, lds, G);
    else if constexpr (PH == 1) phase1(p, lds, G);
    else if constexpr (PH == 2) { pg8::Gemm g{(const bf16*)p.out, (const bf16*)(ws + WS_WIN), T, NPAD, 1024, 1024}; pg8::StaticOrder S; S.init(T, NPAD, G, (int)blockIdx.x);
        EpiSeg E{ws}; pg8::gemm_phase<EpiSeg, pg8::StaticOrder, true, true, 0, 1024, 1024>(lds, g, S, E); }
    else if constexpr (PH == 3) phase_conv(p, G);
    else if constexpr (PH == 4) { pg8::Gemm g{(const bf16*)p.out, (const bf16*)(ws + WS_LRUB), T, 2048, 256, 1024}; pg8::StaticOrder S; S.init(T, 2048, G, (int)blockIdx.x);
        EpiLru E{(bf16*)(ws + WS_XLXG), (bf16*)p.out, p.lba, p.lbx, p.lam}; pg8::gemm_phase<EpiLru, pg8::StaticOrder, true, true, 1, 256, 1024>(lds, g, S, E); }
    else if constexpr (PH == 5) phase_lru_scan<false>(p, G);
    else if constexpr (PH == 6) phase_lru_scan<true>(p, G);
    else if constexpr (PH == 7) phase_gla_chunk(p, lds, G);
    else if constexpr (PH == 8) phase_gla_final(p, G);
    else if constexpr (PH == 9) { pg8::Gemm g{(const bf16*)(ws + WS_GAGB), (const bf16*)(ws + WS_WOUT), T, 1024, 1024, 2048}; pg8::StaticOrder S; S.init(T, 1024, G, (int)blockIdx.x);
        EpiPlain E{(bf16*)(ws + WS_Y), 1024}; pg8::gemm_phase<EpiPlain, pg8::StaticOrder, true, true, 0, 1024, 2048>(lds, g, S, E); }
    else if constexpr (PH == 10) phase_norm2(p, lds, G);
    else if constexpr (PH == 11) { pg8::Gemm g{(const bf16*)(ws + WS_H2), (const bf16*)(ws + WS_WQ), T, 2048, 1024, 1024}; pg8::StaticOrder S; S.init(T, 2048, G, (int)blockIdx.x);
        EpiPlain E{(bf16*)(ws + WS_QRY), 2048}; pg8::gemm_phase<EpiPlain, pg8::StaticOrder, true, true, 0, 1024, 1024>(lds, g, S, E); }
    else if constexpr (PH == 12) { pg8::Gemm g{(const bf16*)(ws + WS_QRY), (const bf16*)(ws + WS_SUBK), T, 2048, 256, 2048}; pg8::StaticOrder S; S.init(T, 2048, G, (int)blockIdx.x);
        EpiF16 E{(unsigned short*)(ws + WS_SC), 2048}; pg8::gemm_phase<EpiF16, pg8::StaticOrder, true, true, 2, 256, 2048>(lds, g, S, E); }
    else if constexpr (PH == 13) phase_topk(p, lds, G);
    else if constexpr (PH == 14) phase_gather(p, lds, G);
}
template <int PH>
__global__ void __launch_bounds__(NTHR, 2) k_phase(Params p) {
    extern __shared__ __attribute__((aligned(16))) unsigned char lds_raw[];
    run_phase<PH>(p, (LAS unsigned char*)lds_raw, (int)gridDim.x);
}
template <int PH>
__device__ __forceinline__ void run_from(const Params& p, LAS unsigned char* lds, int G) {
    run_phase<PH>(p, lds, G);
    if constexpr (PH + 1 < N_PHASES) { cg::this_grid().sync(); run_from<PH + 1>(p, lds, G); }
}
__global__ void __launch_bounds__(NTHR, 2) k_mega(Params p) {
    extern __shared__ __attribute__((aligned(16))) unsigned char lds_raw[];
    run_from<0>(p, (LAS unsigned char*)lds_raw, (int)gridDim.x);
}

extern "C" void kernel_launch(void* const* d_in, const int* in_sizes, int n_in, void* d_out, int out_size, void* d_ws, size_t ws_size, hipStream_t stream) {
    static int grid = 0;
    if (grid == 0) {
        if (n_in != 24 || in_sizes[0] != T * DM || out_size != T * DM || ws_size < WS_END) {
            fprintf(stderr, "kernel_launch: unexpected shapes: n_in %d in0 %d out %d ws %zu\n", n_in, n_in > 0 ? in_sizes[0] : -1, out_size, ws_size); grid = -1; return; }
        int dev = 0, cus = 0, per_cu = 0;
        if (hipGetDevice(&dev) != hipSuccess || hipDeviceGetAttribute(&cus, hipDeviceAttributeMultiprocessorCount, dev) != hipSuccess) { grid = -1; return; }
        if (hipFuncSetAttribute((const void*)k_mega, hipFuncAttributeMaxDynamicSharedMemorySize, LDS_BYTES) != hipSuccess) { fprintf(stderr, "kernel_launch: hipFuncSetAttribute failed\n"); grid = -1; return; }
        if (hipOccupancyMaxActiveBlocksPerMultiprocessor(&per_cu, (const void*)k_mega, NTHR, LDS_BYTES) != hipSuccess || per_cu < 1) { fprintf(stderr, "kernel_launch: occupancy query says %d blocks per CU\n", per_cu); grid = -1; return; }
        (void)hipGetLastError();
        grid = cus;
    }
    if (grid < 0) return;
    Params p{};
    const float** pp = (const float**)&p;
    for (int i = 0; i < 24; ++i) pp[i] = (const float*)d_in[i];
    p.out = (float*)d_out; p.ws = (unsigned char*)d_ws;
    void* args[] = {&p};
    hipError_t e = hipLaunchCooperativeKernel((const void*)k_mega, dim3(grid), dim3(NTHR), args, LDS_BYTES, stream);
    if (e != hipSuccess) fprintf(stderr, "kernel_launch: cooperative launch failed: %s (grid %d)\n", hipGetErrorString(e), grid);
}
```

```cpp
#include <hip/hip_runtime.h>
#include <hip/hip_cooperative_groups.h>
#include <cstdio>
#include <cstdint>
#include <utility>
namespace cg = cooperative_groups;

namespace pg8 {
#define PG8_LAS __attribute__((address_space(3)))
typedef unsigned short bf16_t;
typedef short bf16x8 __attribute__((ext_vector_type(8)));
typedef float f32x4 __attribute__((ext_vector_type(4)));
typedef unsigned u32x4 __attribute__((ext_vector_type(4)));
constexpr int BM = 256, BK = 64, HALF = 128, HTB = HALF * BK * 2  , STAGE_BYTES = 8 * HTB, NXCD = 8, WGM = 8;

__host__ __device__ __forceinline__ int lds_byte(int r, int c) { const int st = (r >> 4) * 2 + (c >> 5), rr = r & 15, cc = c & 31, ob = rr * 64 + cc * 2; return st * 1024 + (ob ^ (((ob >> 9) & 1) << 5)); }
__host__ __device__ __forceinline__ void stage_rc(int b, int& R, int& C) { const int st = b / 1024, sb = b % 1024, swz = sb ^ (((sb >> 9) & 1) << 5); R = (st >> 1) * 16 + swz / 64; C = (st & 1) * 32 + (swz % 64) / 2; }
__host__ __device__ __forceinline__ int perm32(int rho) { const int n = rho >> 4, i = rho & 15; return 8 * (i >> 2) + 4 * n + (i & 3); }

struct Unit { int pm, pn; };
struct Gemm { const bf16_t* A; const bf16_t* Bt; int M, N, K, lda; };
template <int AMODE> __device__ __forceinline__ size_t a_off_bytes(const Gemm& g, const Unit& u) {
    const int ac = AMODE == 0 ? 0 : (AMODE == 1 ? 128 * (u.pn < 6 ? u.pn : 6) : 256 * u.pn);
    return ((size_t)u.pm * BM * (size_t)g.lda + (size_t)ac) * 2;
}

struct StaticOrder {
    int nM, nN, nwg, G, c;
    __host__ __device__ void init(int M, int N, int G_, int c_) { nM = M / BM; nN = N / BM; nwg = nM * nN; G = G_; c = c_; }
    __host__ __device__ bool next(int i, Unit& u) const {
        const long L = (long)i * G + c; if (L >= nwg) return false;
        int wgid = (int)L; { const int q = nwg / NXCD, r = nwg % NXCD, xcd = wgid % NXCD, off = wgid / NXCD; wgid = (xcd < r ? xcd * (q + 1) : r * (q + 1) + (xcd - r) * q) + off; }
        const int nig = WGM * nN, gid = wgid / nig, fm = gid * WGM, gsz = (nM - fm) < WGM ? (nM - fm) : WGM;
        u.pm = fm + ((wgid % nig) % gsz); u.pn = (wgid % nig) / gsz; return true;
    }
    __device__ __forceinline__ void a_ready(const Unit&) const {}
    __device__ __forceinline__ void done(const Unit&) const {}
};

__device__ __forceinline__ unsigned cvt_pk_bf16(float lo, float hi) { unsigned r; asm volatile("v_cvt_pk_bf16_f32 %0, %1, %2" : "=v"(r) : "v"(lo), "v"(hi)); return r; }

template <class Epi, class Sched, bool ALIGN_EPI = false, bool SP2 = false, int AMODE = 0, int KC = 0, int LDAC = 0>
__device__ __forceinline__ void gemm_phase(PG8_LAS unsigned char* lds, const Gemm g, const Sched& S, const Epi& E) {
    const int tid = threadIdx.x, wid = __builtin_amdgcn_readfirstlane(tid >> 6), lane = tid & 63, wr = wid >> 2, wc = wid & 3, fr = lane & 15, fq = lane >> 4;
    const int K = KC ? KC : g.K, nt = K / BK; const int lda = LDAC ? LDAC : g.lda;
    unsigned voffA[2], voffB[2];
#pragma unroll
    for (int i = 0; i < 2; ++i) { int R, C; stage_rc(tid * 16 + i * 8192, R, C); const int Rb = Epi::PERM ? ((R & ~31) + perm32(R & 31)) : R;
        voffA[i] = (unsigned)(R * lda + C) * 2u; voffB[i] = (unsigned)(Rb * K + C) * 2u; }
    const size_t kstep = (size_t)(BK * 2);
    const size_t hstepA = (size_t)HALF * lda * 2;
    const size_t hstepB = (size_t)HALF * K * 2;
    const size_t tstepB = 2 * hstepB;
    const unsigned ldsw = (unsigned)wid * 1024u;
    const int aoff = lds_byte(wr * 64 + fr, fq * 8), boff = lds_byte(wc * 32 + fr, fq * 8);
#define PG8_SA(b, h) (((b) * 2 + (h)) * HTB)
#define PG8_SB(b, h) ((4 + (b) * 2 + (h)) * HTB)
#define PG8_STAGE(bufoff, gbase, voff) do { _Pragma("unroll") for (int _i = 0; _i < 2; ++_i) \
        __builtin_amdgcn_global_load_lds((const unsigned*)((const char*)(gbase) + (voff)[_i]), (PG8_LAS unsigned*)(lds + (bufoff) + ldsw + _i * 8192), 16, 0, 0); } while (0)
#define PG8_LDA(dst, b, h) do { _Pragma("unroll") for (int m = 0; m < 4; ++m) _Pragma("unroll") for (int k = 0; k < 2; ++k) dst[m][k] = *(const PG8_LAS bf16x8*)(lds + PG8_SA(b, h) + aoff + m * 2048 + k * 1024); } while (0)
#define PG8_LDB(dst, b, h) do { _Pragma("unroll") for (int n = 0; n < 2; ++n) _Pragma("unroll") for (int k = 0; k < 2; ++k) dst[n][k] = *(const PG8_LAS bf16x8*)(lds + PG8_SB(b, h) + boff + n * 2048 + k * 1024); } while (0)
#define PG8_MMA(ai, bj, At, Bt) do { __builtin_amdgcn_s_setprio(1); _Pragma("unroll") for (int m = 0; m < 4; ++m) _Pragma("unroll") for (int n = 0; n < 2; ++n) _Pragma("unroll") for (int k = 0; k < 2; ++k) \
        acc[ai][bj][m][n] = __builtin_amdgcn_mfma_f32_16x16x32_bf16(Bt[n][k], At[m][k], acc[ai][bj][m][n], 0, 0, 0); __builtin_amdgcn_s_setprio(0); } while (0)
#define PG8_WAIT_V(n) asm volatile("s_waitcnt vmcnt(" #n ")" ::: "memory")
#define PG8_WAIT_L(n) asm volatile("s_waitcnt lgkmcnt(" #n ")" ::: "memory")
#define PG8_BAR __builtin_amdgcn_s_barrier()
#define PG8_SCHED __builtin_amdgcn_sched_barrier(0)
    Unit cur, nxt; int ui = 0;
    if (!S.next(0, cur)) return;
    f32x4 acc[2][2][4][2];
#pragma unroll
    for (int a = 0; a < 2; ++a)
#pragma unroll
        for (int b = 0; b < 2; ++b)
#pragma unroll
            for (int m = 0; m < 4; ++m)
#pragma unroll
                for (int n = 0; n < 2; ++n) acc[a][b][m][n] = (f32x4){0.f, 0.f, 0.f, 0.f};
    bf16x8 At[4][2], B0[2][2], B1[2][2];
    const char* cA = (const char*)g.A + a_off_bytes<AMODE>(g, cur); const char* cB = (const char*)g.Bt + (size_t)cur.pn * tstepB;
    S.a_ready(cur);
    if constexpr (SP2) {
        PG8_STAGE(PG8_SB(0, 0), cB, voffB); PG8_STAGE(PG8_SB(0, 1), cB + hstepB, voffB); PG8_STAGE(PG8_SA(0, 0), cA, voffA); PG8_STAGE(PG8_SA(0, 1), cA + hstepA, voffA);
        if (wr == 1) PG8_BAR;
        PG8_WAIT_V(2); PG8_BAR;
        PG8_STAGE(PG8_SB(1, 0), cB + kstep, voffB); PG8_STAGE(PG8_SA(1, 0), cA + kstep, voffA); PG8_STAGE(PG8_SB(1, 1), cB + hstepB + kstep, voffB);
        PG8_WAIT_V(6); PG8_BAR;
    } else {
        PG8_STAGE(PG8_SB(0, 0), cB, voffB); PG8_STAGE(PG8_SA(0, 0), cA, voffA); PG8_STAGE(PG8_SB(0, 1), cB + hstepB, voffB); PG8_STAGE(PG8_SA(0, 1), cA + hstepA, voffA);
        if (wr == 1) PG8_BAR;
        PG8_WAIT_V(4); PG8_BAR;
        PG8_STAGE(PG8_SB(1, 0), cB + kstep, voffB); PG8_STAGE(PG8_SA(1, 0), cA + kstep, voffA); PG8_STAGE(PG8_SB(1, 1), cB + hstepB + kstep, voffB);
        PG8_WAIT_V(6); PG8_BAR;
    }
    for (;;) {
        const bool has_next = S.next(ui + 1, nxt);
        const char* nA = has_next ? (const char*)g.A + a_off_bytes<AMODE>(g, nxt) : cA; const char* nB = has_next ? (const char*)g.Bt + (size_t)nxt.pn * tstepB : cB;
#pragma unroll 1
        for (int t = 0; t < nt; t += 2) {
            const bool last = (t == nt - 2);
            const char* a1 = cA + (size_t)(t + 1) * kstep;
            const char* a2 = last ? nA : cA + (size_t)(t + 2) * kstep; const char* b2 = last ? nB : cB + (size_t)(t + 2) * kstep;
            const char* a3 = a2 + kstep; const char* b3 = b2 + kstep;
            if (last && has_next) S.a_ready(nxt);
            if constexpr (SP2) {
            PG8_LDB(B0, 0, 0); PG8_LDB(B1, 0, 1); PG8_SCHED; PG8_LDA(At, 0, 0); PG8_STAGE(PG8_SA(1, 1), a1 + hstepA, voffA);
            PG8_WAIT_V(8); PG8_WAIT_L(0); PG8_BAR; PG8_MMA(0, 0, At, B0); PG8_MMA(0, 1, At, B1); PG8_BAR; PG8_SCHED;
            PG8_LDA(At, 0, 1); PG8_STAGE(PG8_SB(0, 0), b2, voffB); PG8_STAGE(PG8_SB(0, 1), b2 + hstepB, voffB); PG8_STAGE(PG8_SA(0, 0), a2, voffA);
            PG8_WAIT_V(8); PG8_WAIT_L(0); PG8_BAR; PG8_MMA(1, 0, At, B0); PG8_MMA(1, 1, At, B1); PG8_BAR; PG8_SCHED;
            PG8_LDB(B0, 1, 0); PG8_LDB(B1, 1, 1); PG8_SCHED; PG8_LDA(At, 1, 0); PG8_STAGE(PG8_SA(0, 1), a2 + hstepA, voffA);
            PG8_WAIT_V(8); PG8_WAIT_L(0); PG8_BAR; PG8_MMA(0, 0, At, B0); PG8_MMA(0, 1, At, B1); PG8_BAR; PG8_SCHED;
            PG8_LDA(At, 1, 1); PG8_STAGE(PG8_SB(1, 0), b3, voffB); PG8_STAGE(PG8_SB(1, 1), b3 + hstepB, voffB); PG8_STAGE(PG8_SA(1, 0), a3, voffA);
            PG8_WAIT_V(8); PG8_WAIT_L(0); PG8_BAR; PG8_MMA(1, 0, At, B0); PG8_MMA(1, 1, At, B1); PG8_BAR; PG8_SCHED;
            } else {
            PG8_LDB(B0, 0, 0); PG8_SCHED; PG8_LDA(At, 0, 0); PG8_STAGE(PG8_SA(1, 1), a1 + hstepA, voffA);
            PG8_WAIT_L(8); PG8_BAR; PG8_WAIT_L(0); PG8_MMA(0, 0, At, B0); PG8_BAR; PG8_SCHED;
            PG8_LDB(B1, 0, 1); PG8_STAGE(PG8_SB(0, 0), b2, voffB);
            PG8_BAR; PG8_WAIT_L(0); PG8_MMA(0, 1, At, B1); PG8_BAR;
            PG8_LDA(At, 0, 1); PG8_STAGE(PG8_SA(0, 0), a2, voffA);
            PG8_BAR; PG8_WAIT_L(0); PG8_MMA(1, 0, At, B0); PG8_BAR; PG8_SCHED;
            PG8_STAGE(PG8_SB(0, 1), b2 + hstepB, voffB);
            PG8_WAIT_V(6); PG8_BAR; PG8_MMA(1, 1, At, B1); PG8_BAR;
            PG8_LDB(B0, 1, 0); PG8_SCHED; PG8_LDA(At, 1, 0); PG8_STAGE(PG8_SA(0, 1), a2 + hstepA, voffA);
            PG8_WAIT_L(8); PG8_BAR; PG8_WAIT_L(0); PG8_MMA(0, 0, At, B0); PG8_BAR; PG8_SCHED;
            PG8_LDB(B1, 1, 1); PG8_STAGE(PG8_SB(1, 0), b3, voffB);
            PG8_BAR; PG8_WAIT_L(0); PG8_MMA(0, 1, At, B1); PG8_BAR;
            PG8_LDA(At, 1, 1); PG8_STAGE(PG8_SA(1, 0), a3, voffA);
            PG8_BAR; PG8_WAIT_L(0); PG8_MMA(1, 0, At, B0); PG8_BAR; PG8_SCHED;
            PG8_STAGE(PG8_SB(1, 1), b3 + hstepB, voffB);
            PG8_WAIT_V(6); PG8_BAR; PG8_MMA(1, 1, At, B1); PG8_BAR;
            }
        }
        if constexpr (ALIGN_EPI) { if (wr == 0) PG8_BAR; }
        E(acc, cur, wr, wc, fr, fq); S.done(cur);
        if (!has_next) break;
#pragma unroll
        for (int a = 0; a < 2; ++a)
#pragma unroll
            for (int b = 0; b < 2; ++b)
#pragma unroll
                for (int m = 0; m < 4; ++m)
#pragma unroll
                    for (int n = 0; n < 2; ++n) acc[a][b][m][n] = (f32x4){0.f, 0.f, 0.f, 0.f};
        cur = nxt; cA = nA; cB = nB; ++ui;
        if constexpr (ALIGN_EPI) { if (wr == 1) PG8_BAR; }
    }
    PG8_WAIT_V(0);
    if constexpr (!ALIGN_EPI) { if (wr == 0) PG8_BAR; }
    PG8_BAR;
#undef PG8_SA
#undef PG8_SB
#undef PG8_STAGE
#undef PG8_LDA
#undef PG8_LDB
#undef PG8_MMA
#undef PG8_WAIT_V
#undef PG8_WAIT_L
#undef PG8_BAR
#undef PG8_SCHED
}
}

constexpr int NB = 8, SEQ = 8192, DM = 1024, T = NB * SEQ;
constexpr int NPAD = 7424;
constexpr int NWAVES = 8, NTHR = 512;
constexpr int LDS_BYTES = 147456;
constexpr int N_PHASES = 15;

constexpr size_t MiB = 1ull << 20;
constexpr size_t WS_CTL = 0;
constexpr size_t WS_MODP = 1 * MiB;
constexpr size_t WS_WIN = 3 * MiB;
constexpr size_t WS_WOUT = 18 * MiB;
constexpr size_t WS_WQ = 20 * MiB;
constexpr size_t WS_LRUB = 24 * MiB;
constexpr size_t WS_SUBK = 25 * MiB;
constexpr size_t WS_LRUC = 26 * MiB;
constexpr size_t WS_U = 32 * MiB;
constexpr size_t WS_V = 48 * MiB;
constexpr size_t WS_SU = 64 * MiB;
constexpr size_t WS_SV = 65 * MiB;
constexpr size_t WS_QKV = 96 * MiB;
constexpr size_t WS_R = 352 * MiB;
constexpr size_t WS_XLXG = 480 * MiB;
constexpr size_t WS_GAGB = 736 * MiB;
constexpr size_t WS_ALOW = 992 * MiB;
constexpr size_t WS_END = 994 * MiB;
constexpr size_t WS_Y = WS_QKV;
constexpr size_t WS_H2 = WS_QKV + 128 * MiB;
constexpr size_t WS_QRY = WS_XLXG;
constexpr size_t WS_SC = WS_GAGB;
constexpr size_t WS_TOPK = WS_R;
constexpr size_t WS_TOPK2 = WS_R + 32 * MiB;

#define LAS __attribute__((address_space(3)))
typedef unsigned short bf16;
typedef float f32x4 __attribute__((ext_vector_type(4)));
typedef float f32x2 __attribute__((ext_vector_type(2)));
typedef unsigned u32x4 __attribute__((ext_vector_type(4)));
typedef unsigned u32x2 __attribute__((ext_vector_type(2)));

struct Params {
    const float *x, *c, *w_ada, *b_ada, *npm, *npo, *w_in, *w_alpha, *b_alpha, *gla_norm, *conv_w, *conv_b,
        *lwa, *lba, *lwx, *lbx, *lam, *w_out, *npf, *npof, *wq, *subk, *pu, *pv;
    float* out; unsigned char* ws;
    int ph_lo, ph_hi;
};

__device__ __forceinline__ unsigned f2bf(float f) { unsigned u = __builtin_bit_cast(unsigned, f); return (u + 0x7fffu + ((u >> 16) & 1u)) >> 16; }
__device__ __forceinline__ unsigned pk2(float lo, float hi) { return f2bf(lo) | (f2bf(hi) << 16); }
__device__ __forceinline__ float bflo(unsigned u) { return __builtin_bit_cast(float, u << 16); }
__device__ __forceinline__ float bfhi(unsigned u) { return __builtin_bit_cast(float, u & 0xffff0000u); }
__device__ __forceinline__ float bf2f(bf16 h) { return __builtin_bit_cast(float, (unsigned)h << 16); }
__device__ __forceinline__ float sigmoid_f(float x) { return 1.f / (1.f + __expf(-x)); }
__device__ __forceinline__ float silu_f(float x) { return x / (1.f + __expf(-x)); }
__device__ __forceinline__ float gelu_f(float x) { const float u = 0.7978845608028654f * (x + 0.044715f * x * x * x); return x / (1.f + __expf(-2.f * u)); }
__device__ __forceinline__ float softplus_f(float x) { return fmaxf(x, 0.f) + log1pf(__expf(-fabsf(x))); }
__device__ __forceinline__ float wave_sum(float v) {
#pragma unroll
    for (int o = 1; o < 64; o <<= 1) v += __shfl_xor(v, o);
    return v;
}
#define LDS_WAIT() asm volatile("s_waitcnt lgkmcnt(0)" ::: "memory")

struct EpiSeg {
    static constexpr bool PERM = true;
    unsigned char* ws;
    __device__ __forceinline__ void operator()(const pg8::f32x4 (&acc)[2][2][4][2], const pg8::Unit& u, int wr, int wc, int fr, int fq) const {
        const int pn = u.pn; bf16* base; int ldc, colt;
        if (pn < 8) { base = (bf16*)(ws + WS_QKV); ldc = 2048; colt = pn * 256; }
        else if (pn < 12) { base = (bf16*)(ws + WS_R); ldc = 1024; colt = (pn - 8) * 256; }
        else if (pn < 20) { base = (bf16*)(ws + WS_XLXG); ldc = 2048; colt = (pn - 12) * 256; }
        else if (pn < 28) { base = (bf16*)(ws + WS_GAGB); ldc = 2048; colt = (pn - 20) * 256; }
        else { base = (bf16*)(ws + WS_ALOW); ldc = 16; colt = 0; }
        const int row0 = u.pm * 256 + wr * 64 + fr, col0 = colt + wc * 32 + 8 * fq;
        const bool tail = (pn == 28);
#pragma unroll
        for (int ai = 0; ai < 2; ++ai)
#pragma unroll
            for (int m = 0; m < 4; ++m) { bf16* rowp = base + (size_t)(row0 + ai * 128 + m * 16) * ldc + col0;
#pragma unroll
                for (int bj = 0; bj < 2; ++bj) { const pg8::f32x4 v0 = acc[ai][bj][m][0], v1 = acc[ai][bj][m][1];
                    u32x4 w; w.x = pg8::cvt_pk_bf16(v0[0], v0[1]); w.y = pg8::cvt_pk_bf16(v0[2], v0[3]); w.z = pg8::cvt_pk_bf16(v1[0], v1[1]); w.w = pg8::cvt_pk_bf16(v1[2], v1[3]);
                    if (!tail || (bj == 0 && wc == 0 && fq < 2)) *(u32x4*)(rowp + bj * 128) = w; } }
    }
};
struct EpiPlain {
    static constexpr bool PERM = true;
    bf16* O; int ldc;
    __device__ __forceinline__ void operator()(const pg8::f32x4 (&acc)[2][2][4][2], const pg8::Unit& u, int wr, int wc, int fr, int fq) const {
        const int row0 = u.pm * 256 + wr * 64 + fr, col0 = u.pn * 256 + wc * 32 + 8 * fq;
#pragma unroll
        for (int ai = 0; ai < 2; ++ai)
#pragma unroll
            for (int m = 0; m < 4; ++m) { bf16* rowp = O + (size_t)(row0 + ai * 128 + m * 16) * ldc + col0;
#pragma unroll
                for (int bj = 0; bj < 2; ++bj) { const pg8::f32x4 v0 = acc[ai][bj][m][0], v1 = acc[ai][bj][m][1];
                    u32x4 w; w.x = pg8::cvt_pk_bf16(v0[0], v0[1]); w.y = pg8::cvt_pk_bf16(v0[2], v0[3]); w.z = pg8::cvt_pk_bf16(v1[0], v1[1]); w.w = pg8::cvt_pk_bf16(v1[2], v1[3]);
                    *(u32x4*)(rowp + bj * 128) = w; } }
    }
};
typedef _Float16 h16x2 __attribute__((ext_vector_type(2)));
__device__ __forceinline__ unsigned pkh(float a, float b) { return __builtin_bit_cast(unsigned, __builtin_amdgcn_cvt_pkrtz(a, b)); }
struct EpiF16 {
    static constexpr bool PERM = true;
    unsigned short* O; int ldc;
    __device__ __forceinline__ void operator()(const pg8::f32x4 (&acc)[2][2][4][2], const pg8::Unit& u, int wr, int wc, int fr, int fq) const {
        const int row0 = u.pm * 256 + wr * 64 + fr, col0 = u.pn * 256 + wc * 32 + 8 * fq;
#pragma unroll
        for (int ai = 0; ai < 2; ++ai)
#pragma unroll
            for (int m = 0; m < 4; ++m) { unsigned short* rowp = O + (size_t)(row0 + ai * 128 + m * 16) * ldc + col0;
#pragma unroll
                for (int bj = 0; bj < 2; ++bj) { const pg8::f32x4 v0 = acc[ai][bj][m][0], v1 = acc[ai][bj][m][1];
                    u32x4 w; w.x = pkh(v0[0], v0[1]); w.y = pkh(v0[2], v0[3]); w.z = pkh(v1[0], v1[1]); w.w = pkh(v1[2], v1[3]);
                    *(u32x4*)(rowp + bj * 128) = w; } }
    }
};
struct EpiLru {
    static constexpr bool PERM = true;
    bf16* LA;   bf16* XCU;   const float *lba, *lbx, *lam;
    __device__ __forceinline__ void operator()(const pg8::f32x4 (&acc)[2][2][4][2], const pg8::Unit& u, int wr, int wc, int fr, int fq) const {
        const int row0 = u.pm * 256 + wr * 64 + fr, ch0 = u.pn * 128 + wc * 32 + 8 * fq;
        float ba[8], bx[8], sp[8];
#pragma unroll
        for (int j = 0; j < 8; ++j) { ba[j] = lba[ch0 + j]; bx[j] = lbx[ch0 + j]; sp[j] = -8.f * softplus_f(-lam[ch0 + j]); }
#pragma unroll
        for (int ai = 0; ai < 2; ++ai)
#pragma unroll
            for (int m = 0; m < 4; ++m) { const size_t row = (size_t)(row0 + ai * 128 + m * 16);
                const u32x4 xw = *(const u32x4*)(XCU + row * 1024 + ch0);
                float xc[8] = {bflo(xw.x), bfhi(xw.x), bflo(xw.y), bfhi(xw.y), bflo(xw.z), bfhi(xw.z), bflo(xw.w), bfhi(xw.w)};
                float la[8], uu[8];
#pragma unroll
                for (int j = 0; j < 8; ++j) { const float pr = acc[ai][0][m][j >> 2][j & 3] + ba[j], pi = acc[ai][1][m][j >> 2][j & 3] + bx[j];
                    const float gr = sigmoid_f(pr), gi = sigmoid_f(pi);
                    la[j] = sp[j] * gr; const float a2 = __expf(2.f * la[j]);
                    uu[j] = sqrtf(fmaxf(1.f - a2, 0.f)) * gi * xc[j]; }
                u32x4 w1, w2; w1.x = pk2(la[0], la[1]); w1.y = pk2(la[2], la[3]); w1.z = pk2(la[4], la[5]); w1.w = pk2(la[6], la[7]);
                w2.x = pk2(uu[0], uu[1]); w2.y = pk2(uu[2], uu[3]); w2.z = pk2(uu[4], uu[5]); w2.w = pk2(uu[6], uu[7]);
                *(u32x4*)(LA + row * 2048 + ch0) = w1; *(u32x4*)(XCU + row * 1024 + ch0) = w2; }
    }
};

__device__ __forceinline__ void p0_transpose_item(const float* W, int ldw, int k0, int n0, int nvalid, bf16* WT, int ldk, int row0, int kc0, LAS float* scr, int lane) {
#pragma unroll 8
    for (int i = 0; i < 32; ++i) { const int kk = 2 * i + (lane >> 5), cc = lane & 31; scr[kk * 33 + cc] = (cc < nvalid) ? W[(size_t)(k0 + kk) * ldw + n0 + cc] : 0.f; }
    LDS_WAIT(); asm volatile("" ::: "memory");
    const int c = lane & 7;
#pragma unroll
    for (int j = 0; j < 4; ++j) { const int n = (lane >> 3) + 8 * j; const LAS float* s = scr + (8 * c) * 33 + n;
        u32x4 o; o.x = pk2(s[0 * 33], s[1 * 33]); o.y = pk2(s[2 * 33], s[3 * 33]); o.z = pk2(s[4 * 33], s[5 * 33]); o.w = pk2(s[6 * 33], s[7 * 33]);
        *(u32x4*)(WT + (size_t)(row0 + n) * ldk + kc0 + k0 + 8 * c) = o; }
    LDS_WAIT(); asm volatile("" ::: "memory");
}
__device__ __forceinline__ void phase0(const Params& p, LAS unsigned char* lds, int G) {
    const int tid = threadIdx.x, lane = tid & 63, wave = __builtin_amdgcn_readfirstlane(tid >> 6);
    unsigned char* ws = p.ws;
    {
        LAS float* sc = (LAS float*)lds;
        LAS float* red = (LAS float*)(lds + 4096);
        float* modp = (float*)(ws + WS_MODP);
        for (int it = blockIdx.x; it < 24 * 8; it += G) {
            const int nb = it % 24, kc = it / 24;
            for (int i = tid; i < 1024; i += NTHR) { const int b = i >> 7, k = i & 127; sc[i] = silu_f(p.c[b * 1024 + kc * 128 + k]); }
            __syncthreads();
            const int col = tid & 255, kh = tid >> 8;
            float acc[8];
#pragma unroll
            for (int b = 0; b < 8; ++b) acc[b] = 0.f;
            const float* wp = p.w_ada + (size_t)(kc * 128 + kh * 64) * 6144 + nb * 256 + col;
#pragma unroll 8
            for (int kk = 0; kk < 64; ++kk) { const float w = wp[(size_t)kk * 6144];
#pragma unroll
                for (int b = 0; b < 8; ++b) acc[b] += sc[b * 128 + kh * 64 + kk] * w; }
            if (kh == 1) {
#pragma unroll
                for (int b = 0; b < 8; ++b) red[b * 256 + col] = acc[b]; }
            __syncthreads();
            if (kh == 0) { const int n = nb * 256 + col; const float bias = (kc == 0) ? p.b_ada[n] : 0.f;
#pragma unroll
                for (int b = 0; b < 8; ++b) modp[(size_t)(kc * 8 + b) * 6144 + n] = acc[b] + red[b * 256 + col] + bias; }
            __syncthreads();
        }
    }
    LAS float* scr = (LAS float*)(lds + 16384 + wave * 8448);
    const int gw = blockIdx.x * NWAVES + wave, NGW = G * NWAVES;
    bf16* WinT = (bf16*)(ws + WS_WIN); bf16* WoutT = (bf16*)(ws + WS_WOUT); bf16* WqT = (bf16*)(ws + WS_WQ);
    bf16* LruB = (bf16*)(ws + WS_LRUB); bf16* SubK = (bf16*)(ws + WS_SUBK);
    constexpr int I_IN = 16 * (NPAD / 32), I_OUT = 16 * 32, I_Q = 16 * 64, I_LRU = 16 * 8, I_SUB = 2048, I_TAB = 2 * 16384;
    constexpr int NIT = I_IN + I_OUT + I_Q + I_LRU + I_SUB + I_TAB;
    for (int it = gw; it < NIT; it += NGW) {
        int r = it;
        if (r < I_IN) { const int nb = r % (NPAD / 32), kb = r / (NPAD / 32), nq = nb * 32; int n0, nv;
            if (nq < 3072) { n0 = nq; nv = 32; } else if (nq < 7168) { n0 = nq + 16; nv = 32; } else if (nq == 7168) { n0 = 3072; nv = 16; } else { n0 = 0; nv = 0; }
            p0_transpose_item(p.w_in, 7184, kb * 64, n0, nv, WinT, 1024, nq, 0, scr, lane); continue; } r -= I_IN;
        if (r < I_OUT) { const int nb = r % 32, kb = r / 32; p0_transpose_item(p.w_out, 1024, kb * 64, nb * 32, 32, WoutT, 1024, nb * 32, 0, scr, lane); continue; } r -= I_OUT;
        if (r < I_Q) { const int nb = r % 64, kb = r / 64; p0_transpose_item(p.wq, 2048, kb * 64, nb * 32, 32, WqT, 1024, nb * 32, 0, scr, lane); continue; } r -= I_Q;
        if (r < I_LRU) {
            const int mat = r >> 3, sub = r & 7, g = mat >> 3, n = mat & 7, kb = sub >> 2, nb = sub & 3;
            const int np = n < 6 ? n : 6, half = n - np;
            const float* W = (g ? p.lwx : p.lwa) + (size_t)n * 128 * 128;
            bf16* dst = LruB + (size_t)n * 256 * 256;
            p0_transpose_item(W, 128, kb * 64, nb * 32, 32, dst, 256, g * 128 + nb * 32, half * 128, scr, lane);
            p0_transpose_item(W, 128, kb * 64, 0, 0, dst, 256, g * 128 + nb * 32, (1 - half) * 128, scr, lane);
            continue; } r -= I_LRU;
        if (r < I_SUB) {
            const int h = r >> 8, pp = (r >> 7) & 1, n = r & 127;
            const float* src = p.subk + (size_t)r * 128; bf16* dst = SubK + ((size_t)h * 256 + pp * 128 + n) * 256;
            const f32x2 v = *(const f32x2*)(src + 2 * lane);
            *(unsigned*)(dst + pp * 128 + 2 * lane) = pk2(v.x, v.y);
            *(unsigned*)(dst + (1 - pp) * 128 + 2 * lane) = 0u;
            continue; } r -= I_SUB;
        {
            const int tb = r >> 14, row = r & 16383;
            const float* src = (tb ? p.pv : p.pu) + (size_t)row * 1024 + lane * 16;
            f32x4 v[4]; float am = 0.f;
#pragma unroll
            for (int j = 0; j < 4; ++j) { v[j] = *(const f32x4*)(src + 4 * j); am = fmaxf(am, fmaxf(fmaxf(fabsf(v[j].x), fabsf(v[j].y)), fmaxf(fabsf(v[j].z), fabsf(v[j].w)))); }
#pragma unroll
            for (int o = 1; o < 64; o <<= 1) am = fmaxf(am, __shfl_xor(am, o));
            const float inv = am > 0.f ? 416.f / am : 0.f;
            u32x4 o;
            { int w = 0; w = __builtin_amdgcn_cvt_pk_fp8_f32(v[0].x * inv, v[0].y * inv, w, false); w = __builtin_amdgcn_cvt_pk_fp8_f32(v[0].z * inv, v[0].w * inv, w, true); o.x = (unsigned)w; }
            { int w = 0; w = __builtin_amdgcn_cvt_pk_fp8_f32(v[1].x * inv, v[1].y * inv, w, false); w = __builtin_amdgcn_cvt_pk_fp8_f32(v[1].z * inv, v[1].w * inv, w, true); o.y = (unsigned)w; }
            { int w = 0; w = __builtin_amdgcn_cvt_pk_fp8_f32(v[2].x * inv, v[2].y * inv, w, false); w = __builtin_amdgcn_cvt_pk_fp8_f32(v[2].z * inv, v[2].w * inv, w, true); o.z = (unsigned)w; }
            { int w = 0; w = __builtin_amdgcn_cvt_pk_fp8_f32(v[3].x * inv, v[3].y * inv, w, false); w = __builtin_amdgcn_cvt_pk_fp8_f32(v[3].z * inv, v[3].w * inv, w, true); o.w = (unsigned)w; }
            *(u32x4*)(ws + (tb ? WS_V : WS_U) + (size_t)row * 1024 + lane * 16) = o;
            if (lane == 0) ((float*)(ws + (tb ? WS_SV : WS_SU)))[row] = am * (1.f / 416.f);
        }
    }
}

__device__ __forceinline__ float mod_at(const float* modp, int b, int n) {
    float s = 0.f;
#pragma unroll
    for (int kc = 0; kc < 8; ++kc) s += modp[(size_t)(kc * 8 + b) * 6144 + n];
    return s;
}

__device__ __forceinline__ void phase1(const Params& p, LAS unsigned char* lds, int G) {
    const int tid = threadIdx.x, lane = tid & 63, wave = __builtin_amdgcn_readfirstlane(tid >> 6);
    const float* modp = (const float*)(p.ws + WS_MODP);
    LAS float* gs = (LAS float*)lds; LAS float* sh = gs + 1024;
    bf16* H = (bf16*)p.out;
    for (int tile = blockIdx.x; tile < T / 256; tile += G) {
        const int b = tile / 32;
        __syncthreads();
        for (int k = tid; k < 1024; k += NTHR) { gs[k] = p.npm[k] * (1.f + mod_at(modp, b, 1024 + k)); sh[k] = mod_at(modp, b, k); }
        __syncthreads();
        for (int rr = 0; rr < 32; ++rr) {
            const size_t row = (size_t)tile * 256 + wave * 32 + rr;
            const f32x4* xr = (const f32x4*)(p.x + row * 1024) + lane;
            f32x4 v[4]; float s = 0.f;
#pragma unroll
            for (int j = 0; j < 4; ++j) { v[j] = xr[64 * j]; s += (v[j].x * v[j].x + v[j].y * v[j].y) + (v[j].z * v[j].z + v[j].w * v[j].w); }
            const float rstd = 1.f / sqrtf(wave_sum(s) * (1.f / 1024.f) + 1e-6f);
            u32x2* o8 = (u32x2*)(H + row * 1024) + lane;
#pragma unroll
            for (int j = 0; j < 4; ++j) { const int k = 256 * j + 4 * lane; const f32x4 g4 = *(const LAS f32x4*)(gs + k), s4 = *(const LAS f32x4*)(sh + k);
                u32x2 w; w.x = pk2(v[j].x * rstd * g4.x + s4.x, v[j].y * rstd * g4.y + s4.y); w.y = pk2(v[j].z * rstd * g4.z + s4.z, v[j].w * rstd * g4.w + s4.w);
                o8[64 * j] = w; }
        }
    }
}

__device__ __forceinline__ void phase_conv(const Params& p, int G) {
    const int tid = threadIdx.x, lane = tid & 63, wave = __builtin_amdgcn_readfirstlane(tid >> 6);
    const int gw = blockIdx.x * NWAVES + wave, NGW = G * NWAVES;
    const bf16* XL = (const bf16*)(p.ws + WS_XLXG); bf16* XC = (bf16*)p.out;
    for (int it = gw; it < (T / 64) * 2; it += NGW) {
        const int rt = it >> 1, c0 = (it & 1) * 512 + lane * 8;
        float w[4][8], cb[8];
#pragma unroll
        for (int j = 0; j < 8; ++j) { cb[j] = p.conv_b[c0 + j];
#pragma unroll
            for (int q = 0; q < 4; ++q) w[q][j] = p.conv_w[q * 1024 + c0 + j]; }
        float x1[8], x2[8], x3[8];
        const int t0 = rt * 64; const bool first = (t0 % SEQ) == 0;
#pragma unroll
        for (int j = 0; j < 8; ++j) { x1[j] = 0.f; x2[j] = 0.f; x3[j] = 0.f; }
        if (!first) {
            const u32x4 a = *(const u32x4*)(XL + (size_t)(t0 - 1) * 2048 + c0), b = *(const u32x4*)(XL + (size_t)(t0 - 2) * 2048 + c0), c = *(const u32x4*)(XL + (size_t)(t0 - 3) * 2048 + c0);
            x1[0] = bflo(a.x); x1[1] = bfhi(a.x); x1[2] = bflo(a.y); x1[3] = bfhi(a.y); x1[4] = bflo(a.z); x1[5] = bfhi(a.z); x1[6] = bflo(a.w); x1[7] = bfhi(a.w);
            x2[0] = bflo(b.x); x2[1] = bfhi(b.x); x2[2] = bflo(b.y); x2[3] = bfhi(b.y); x2[4] = bflo(b.z); x2[5] = bfhi(b.z); x2[6] = bflo(b.w); x2[7] = bfhi(b.w);
            x3[0] = bflo(c.x); x3[1] = bfhi(c.x); x3[2] = bflo(c.y); x3[3] = bfhi(c.y); x3[4] = bflo(c.z); x3[5] = bfhi(c.z); x3[6] = bflo(c.w); x3[7] = bfhi(c.w);
        }
#pragma unroll 4
        for (int i = 0; i < 64; ++i) {
            const u32x4 a = *(const u32x4*)(XL + (size_t)(t0 + i) * 2048 + c0);
            float x0[8] = {bflo(a.x), bfhi(a.x), bflo(a.y), bfhi(a.y), bflo(a.z), bfhi(a.z), bflo(a.w), bfhi(a.w)};
            float o[8];
#pragma unroll
            for (int j = 0; j < 8; ++j) { o[j] = cb[j] + w[0][j] * x3[j] + w[1][j] * x2[j] + w[2][j] * x1[j] + w[3][j] * x0[j]; x3[j] = x2[j]; x2[j] = x1[j]; x1[j] = x0[j]; }
            u32x4 wv; wv.x = pk2(o[0], o[1]); wv.y = pk2(o[2], o[3]); wv.z = pk2(o[4], o[5]); wv.w = pk2(o[6], o[7]);
            *(u32x4*)(XC + (size_t)(t0 + i) * 1024 + c0) = wv;
        }
    }
}

template <bool FINAL>
__device__ __forceinline__ void phase_lru_scan(const Params& p, int G) {
    const int tid = threadIdx.x;
    const bf16* LA = (const bf16*)(p.ws + WS_XLXG); const bf16* U = (const bf16*)p.out;
    const bf16* XG = (const bf16*)(p.ws + WS_XLXG) + 1024; bf16* GB = (bf16*)(p.ws + WS_GAGB) + 1024;
    f32x2* car = (f32x2*)(p.ws + WS_LRUC);
    for (int it = blockIdx.x; it < 8 * 32 * 2; it += G) {
        const int cg_ = it & 1, j = (it >> 1) & 31, b = it >> 6, ch = cg_ * 512 + tid;
        const size_t t0 = (size_t)b * SEQ + j * 256;
        if (!FINAL) {
            float h = 0.f, ls = 0.f;
#pragma unroll 8
            for (int i = 0; i < 256; ++i) { const float la = bf2f(LA[(t0 + i) * 2048 + ch]), u = bf2f(U[(t0 + i) * 1024 + ch]);
                h = __expf(la) * h + u; ls += la; }
            car[(size_t)(b * 32 + j) * 1024 + ch] = (f32x2){__expf(ls), h};
        } else {
            float h = 0.f;
            for (int i = 0; i < j; ++i) { const f32x2 c = car[(size_t)(b * 32 + i) * 1024 + ch]; h = c.x * h + c.y; }
#pragma unroll 8
            for (int i = 0; i < 256; ++i) { const float la = bf2f(LA[(t0 + i) * 2048 + ch]), u = bf2f(U[(t0 + i) * 1024 + ch]);
                h = __expf(la) * h + u;
                const float xg = bf2f(XG[(t0 + i) * 2048 + ch]), gb = bf2f(GB[(t0 + i) * 2048 + ch]);
                GB[(t0 + i) * 2048 + ch] = (bf16)f2bf(h * gelu_f(xg) * sigmoid_f(gb)); }
        }
    }
}

__device__ __forceinline__ void phase_gla_naive(const Params& p, LAS unsigned char* lds, int G) {
    const int tid = threadIdx.x;
    constexpr int TB = 32;
    LAS float* sA = (LAS float*)lds;
    LAS float* sK = sA + TB * 128;
    LAS float* sQ = sK + TB * 128;
    LAS float* sV = sQ + TB * 128;
    LAS float* sO = sV + TB * 64;
    const bf16* QKV = (const bf16*)(p.ws + WS_QKV); bf16* VO = (bf16*)(p.ws + WS_QKV);
    const bf16* AL = (const bf16*)(p.ws + WS_ALOW);
    for (int it = blockIdx.x; it < 8 * 4 * 4; it += G) {
        const int vs = it & 3, h = (it >> 2) & 3, b = it >> 4;
        const int vv = tid >> 3, kg = tid & 7;
        const int kp = tid & 127;
        float wa[16];
#pragma unroll
        for (int r = 0; r < 16; ++r) wa[r] = p.w_alpha[r * 512 + h * 128 + kp];
        const float balpha = p.b_alpha[h * 128 + kp];
        float S[16];
#pragma unroll
        for (int j = 0; j < 16; ++j) S[j] = 0.f;
        for (int tb = 0; tb < SEQ / TB; ++tb) {
            const size_t t0 = (size_t)b * SEQ + tb * TB;
            __syncthreads();
#pragma unroll
            for (int ps = 0; ps < TB / 4; ++ps) { const int tt = ps * 4 + (tid >> 7); const size_t t = t0 + tt;
                const u32x4 a0 = *(const u32x4*)(AL + t * 16), a1 = *(const u32x4*)(AL + t * 16 + 8);
                float z = balpha;
                z += bflo(a0.x) * wa[0] + bfhi(a0.x) * wa[1] + bflo(a0.y) * wa[2] + bfhi(a0.y) * wa[3] + bflo(a0.z) * wa[4] + bfhi(a0.z) * wa[5] + bflo(a0.w) * wa[6] + bfhi(a0.w) * wa[7];
                z += bflo(a1.x) * wa[8] + bfhi(a1.x) * wa[9] + bflo(a1.y) * wa[10] + bfhi(a1.y) * wa[11] + bflo(a1.z) * wa[12] + bfhi(a1.z) * wa[13] + bflo(a1.w) * wa[14] + bfhi(a1.w) * wa[15];
                const float ls = fminf(z, 0.f) - log1pf(__expf(-fabsf(z)));
                sA[tt * 128 + kp] = __expf(ls * (1.f / 16.f));
                sQ[tt * 128 + kp] = bf2f(QKV[t * 2048 + h * 128 + kp]) * 0.08838834764831845f;
                sK[tt * 128 + kp] = bf2f(QKV[t * 2048 + 512 + h * 128 + kp]); }
#pragma unroll
            for (int ps = 0; ps < TB * 64 / NTHR; ++ps) { const int e = ps * NTHR + tid, tt = e >> 6, v = e & 63;
                sV[e] = bf2f(QKV[(t0 + tt) * 2048 + 1024 + h * 256 + vs * 64 + v]); }
            __syncthreads();
            for (int tt = 0; tt < TB; ++tt) {
                const float vx = sV[tt * 64 + vv];
                float o = 0.f;
#pragma unroll
                for (int q4 = 0; q4 < 4; ++q4) {
                    const f32x4 a = *(const LAS f32x4*)(sA + tt * 128 + kg * 16 + q4 * 4), kk = *(const LAS f32x4*)(sK + tt * 128 + kg * 16 + q4 * 4), qq = *(const LAS f32x4*)(sQ + tt * 128 + kg * 16 + q4 * 4);
                    S[q4 * 4 + 0] = a.x * S[q4 * 4 + 0] + kk.x * vx; o += qq.x * S[q4 * 4 + 0];
                    S[q4 * 4 + 1] = a.y * S[q4 * 4 + 1] + kk.y * vx; o += qq.y * S[q4 * 4 + 1];
                    S[q4 * 4 + 2] = a.z * S[q4 * 4 + 2] + kk.z * vx; o += qq.z * S[q4 * 4 + 2];
                    S[q4 * 4 + 3] = a.w * S[q4 * 4 + 3] + kk.w * vx; o += qq.w * S[q4 * 4 + 3];
                }
                o += __shfl_xor(o, 1); o += __shfl_xor(o, 2); o += __shfl_xor(o, 4);
                if (kg == 0) sO[tt * 64 + vv] = o;
            }
            __syncthreads();
#pragma unroll
            for (int ps = 0; ps < TB * 64 / NTHR; ++ps) { const int e = ps * NTHR + tid, tt = e >> 6, v = e & 63;
                VO[(t0 + tt) * 2048 + 1024 + h * 256 + vs * 64 + v] = (bf16)f2bf(sO[e]); }
        }
    }
}

typedef short bf16x8_t __attribute__((ext_vector_type(8)));
__device__ __forceinline__ void phase_gla_chunk(const Params& p, LAS unsigned char* lds, int G) {
    const int tid = threadIdx.x, lane = tid & 63, wave = __builtin_amdgcn_readfirstlane(tid >> 6), q4 = lane >> 4, c16 = lane & 15;
    constexpr int PQ = 136, PS = 72;
    LAS bf16* Qs = (LAS bf16*)lds;
    LAS bf16* Kd = Qs + 64 * PQ;
    LAS bf16* KdT = Kd + 64 * PQ;
    LAS bf16* VT = KdT + 128 * PS;
    LAS bf16* Pm = VT + 64 * PS;
    LAS bf16* ST = Pm + 64 * PS;
    LAS float* dk = (LAS float*)(ST + 64 * PQ);
    LAS float* segt = dk + 128;
    const bf16* QKV = (const bf16*)(p.ws + WS_QKV); bf16* VO = (bf16*)(p.ws + WS_QKV);
    const bf16* AL = (const bf16*)(p.ws + WS_ALOW);
    const int kp = tid & 127, seg = tid >> 7;
    const int vv = tid & 63, ss = tid >> 6;
    for (int it = blockIdx.x; it < 8 * 4 * 4; it += G) {
        const int vq = it & 3, h = (it >> 2) & 3, b = it >> 4;
        float wa[16];
#pragma unroll
        for (int r = 0; r < 16; ++r) wa[r] = p.w_alpha[r * 512 + h * 128 + kp];
        const float balpha = p.b_alpha[h * 128 + kp];
        pg8::f32x4 sacc[4];
#pragma unroll
        for (int i = 0; i < 4; ++i) sacc[i] = (pg8::f32x4){0.f, 0.f, 0.f, 0.f};
        __syncthreads();
        for (int i = tid; i < 64 * PQ / 2; i += NTHR) ((LAS unsigned*)ST)[i] = 0u;
#pragma unroll 1
        for (int ch = 0; ch < SEQ / 64; ++ch) {
            const size_t t0 = (size_t)b * SEQ + ch * 64;
            float cl[16]; float run = 0.f;
#pragma unroll
            for (int i = 0; i < 16; ++i) { const size_t t = t0 + seg * 16 + i;
                const u32x4 a0 = *(const u32x4*)(AL + t * 16), a1 = *(const u32x4*)(AL + t * 16 + 8);
                float z = balpha;
                z += bflo(a0.x) * wa[0] + bfhi(a0.x) * wa[1] + bflo(a0.y) * wa[2] + bfhi(a0.y) * wa[3] + bflo(a0.z) * wa[4] + bfhi(a0.z) * wa[5] + bflo(a0.w) * wa[6] + bfhi(a0.w) * wa[7];
                z += bflo(a1.x) * wa[8] + bfhi(a1.x) * wa[9] + bflo(a1.y) * wa[10] + bfhi(a1.y) * wa[11] + bflo(a1.z) * wa[12] + bfhi(a1.z) * wa[13] + bflo(a1.w) * wa[14] + bfhi(a1.w) * wa[15];
                const float ls = fminf(z, 0.f) - __logf(1.f + __expf(-fabsf(z)));
                run += ls * (1.f / 16.f); cl[i] = run; }
            segt[seg * 128 + kp] = run;
            { unsigned w[4];
#pragma unroll
              for (int i = 0; i < 4; ++i) { const unsigned lo = QKV[(t0 + ss * 8 + 2 * i) * 2048 + 1024 + h * 256 + vq * 64 + vv], hi = QKV[(t0 + ss * 8 + 2 * i + 1) * 2048 + 1024 + h * 256 + vq * 64 + vv]; w[i] = lo | (hi << 16); }
              *(LAS u32x4*)(VT + vv * PS + ss * 8) = (u32x4){w[0], w[1], w[2], w[3]}; }
            __syncthreads();
            { float off = 0.f, tot = 0.f;
#pragma unroll
              for (int s = 0; s < 4; ++s) { const float v = segt[s * 128 + kp]; tot += v; if (s < seg) off += v; }
              if (seg == 0) dk[kp] = __expf(tot);
              unsigned kw[8];
#pragma unroll
              for (int i = 0; i < 16; ++i) { const size_t t = t0 + seg * 16 + i; const float cum = cl[i] + off, eq = __expf(cum), ek = __expf(-cum);
                  const float qv = bf2f(QKV[t * 2048 + h * 128 + kp]) * 0.08838834764831845f * eq, kv = bf2f(QKV[t * 2048 + 512 + h * 128 + kp]) * ek;
                  const unsigned kb = f2bf(kv);
                  Qs[(seg * 16 + i) * PQ + kp] = (bf16)f2bf(qv); Kd[(seg * 16 + i) * PQ + kp] = (bf16)kb;
                  if (i & 1) kw[i >> 1] |= kb << 16; else kw[i >> 1] = kb; }
              *(LAS u32x4*)(KdT + kp * PS + seg * 16) = (u32x4){kw[0], kw[1], kw[2], kw[3]};
              *(LAS u32x4*)(KdT + kp * PS + seg * 16 + 8) = (u32x4){kw[4], kw[5], kw[6], kw[7]}; }
            __syncthreads();
            { const int tt = wave & 3;
#pragma unroll
              for (int i2 = 0; i2 < 2; ++i2) { const int ts = (wave >> 2) * 2 + i2;
                  pg8::f32x4 acc = (pg8::f32x4){0.f, 0.f, 0.f, 0.f};
                  if (ts <= tt) {
#pragma unroll
                      for (int ks = 0; ks < 4; ++ks) { const bf16x8_t a = *(const LAS bf16x8_t*)(Kd + (ts * 16 + c16) * PQ + ks * 32 + q4 * 8), bb = *(const LAS bf16x8_t*)(Qs + (tt * 16 + c16) * PQ + ks * 32 + q4 * 8);
                          acc = __builtin_amdgcn_mfma_f32_16x16x32_bf16(a, bb, acc, 0, 0, 0); }
                      const int tg = tt * 16 + c16, sg = ts * 16 + q4 * 4;
#pragma unroll
                      for (int j = 0; j < 4; ++j) if (sg + j > tg) acc[j] = 0.f;
                  }
                  *(LAS u32x2*)(Pm + (tt * 16 + c16) * PS + ts * 16 + q4 * 4) = (u32x2){pk2(acc[0], acc[1]), pk2(acc[2], acc[3])}; } }
            __syncthreads();
            { const int tt = wave & 3;
              pg8::f32x4 oacc[2] = {(pg8::f32x4){0.f, 0.f, 0.f, 0.f}, (pg8::f32x4){0.f, 0.f, 0.f, 0.f}};
#pragma unroll
              for (int ks = 0; ks < 2; ++ks) { const bf16x8_t bb = *(const LAS bf16x8_t*)(Pm + (tt * 16 + c16) * PS + ks * 32 + q4 * 8);
#pragma unroll
                  for (int i2 = 0; i2 < 2; ++i2) { const int tv = (wave >> 2) * 2 + i2; const bf16x8_t a = *(const LAS bf16x8_t*)(VT + (tv * 16 + c16) * PS + ks * 32 + q4 * 8);
                      oacc[i2] = __builtin_amdgcn_mfma_f32_16x16x32_bf16(a, bb, oacc[i2], 0, 0, 0); } }
#pragma unroll
              for (int ks = 0; ks < 4; ++ks) { const bf16x8_t bb = *(const LAS bf16x8_t*)(Qs + (tt * 16 + c16) * PQ + ks * 32 + q4 * 8);
#pragma unroll
                  for (int i2 = 0; i2 < 2; ++i2) { const int tv = (wave >> 2) * 2 + i2; const bf16x8_t a = *(const LAS bf16x8_t*)(ST + (tv * 16 + c16) * PQ + ks * 32 + q4 * 8);
                      oacc[i2] = __builtin_amdgcn_mfma_f32_16x16x32_bf16(a, bb, oacc[i2], 0, 0, 0); } }
#pragma unroll
              for (int i2 = 0; i2 < 2; ++i2) { const int tv = (wave >> 2) * 2 + i2;
                  *(u32x2*)(VO + (t0 + tt * 16 + c16) * 2048 + 1024 + h * 256 + vq * 64 + tv * 16 + q4 * 4) = (u32x2){pk2(oacc[i2][0], oacc[i2][1]), pk2(oacc[i2][2], oacc[i2][3])}; } }
#pragma unroll
            for (int ks = 0; ks < 2; ++ks) { const bf16x8_t a = *(const LAS bf16x8_t*)(KdT + (wave * 16 + c16) * PS + ks * 32 + q4 * 8);
#pragma unroll
                for (int tv = 0; tv < 4; ++tv) { const bf16x8_t bb = *(const LAS bf16x8_t*)(VT + (tv * 16 + c16) * PS + ks * 32 + q4 * 8);
                    sacc[tv] = __builtin_amdgcn_mfma_f32_16x16x32_bf16(a, bb, sacc[tv], 0, 0, 0); } }
            { const pg8::f32x4 d4 = *(const LAS pg8::f32x4*)(dk + wave * 16 + q4 * 4);
#pragma unroll
              for (int tv = 0; tv < 4; ++tv) sacc[tv] = sacc[tv] * d4; }
            __syncthreads();
#pragma unroll
            for (int tv = 0; tv < 4; ++tv) *(LAS u32x2*)(ST + (tv * 16 + c16) * PQ + wave * 16 + q4 * 4) = (u32x2){pk2(sacc[tv][0], sacc[tv][1]), pk2(sacc[tv][2], sacc[tv][3])};
        }
    }
}

__device__ __forceinline__ void phase_gla_final(const Params& p, int G) {
    const int tid = threadIdx.x, lane = tid & 63, wave = __builtin_amdgcn_readfirstlane(tid >> 6);
    const int gw = blockIdx.x * NWAVES + wave, NGW = G * NWAVES;
    const bf16* O = (const bf16*)(p.ws + WS_QKV) + 1024; const bf16* R = (const bf16*)(p.ws + WS_R); bf16* GA = (bf16*)(p.ws + WS_GAGB);
    for (int row = gw; row < T; row += NGW) {
#pragma unroll
        for (int h = 0; h < 4; ++h) { const int c0 = h * 256 + lane * 4;
            const u32x2 ov = *(const u32x2*)(O + (size_t)row * 2048 + c0), rv = *(const u32x2*)(R + (size_t)row * 1024 + c0);
            const u32x2 gav = *(const u32x2*)(GA + (size_t)row * 2048 + c0), tv = *(const u32x2*)(GA + (size_t)row * 2048 + 1024 + c0);
            const float o[4] = {bflo(ov.x), bfhi(ov.x), bflo(ov.y), bfhi(ov.y)}, r[4] = {bflo(rv.x), bfhi(rv.x), bflo(rv.y), bfhi(rv.y)};
            const float ga[4] = {bflo(gav.x), bfhi(gav.x), bflo(gav.y), bfhi(gav.y)}, tm[4] = {bflo(tv.x), bfhi(tv.x), bflo(tv.y), bfhi(tv.y)};
            const float ss = wave_sum((o[0] * o[0] + o[1] * o[1]) + (o[2] * o[2] + o[3] * o[3]));
            const float rstd = 1.f / sqrtf(ss * (1.f / 256.f) + 1e-6f);
            const f32x4 gn = *(const f32x4*)(p.gla_norm + c0);
            float m[4];
#pragma unroll
            for (int j = 0; j < 4; ++j) m[j] = sigmoid_f(ga[j]) * (o[j] * rstd * gn[j] * silu_f(r[j])) + tm[j];
            u32x2 w; w.x = pk2(m[0], m[1]); w.y = pk2(m[2], m[3]);
            *(u32x2*)(GA + (size_t)row * 2048 + c0) = w; }
    }
}

__device__ __forceinline__ void phase_norm2(const Params& p, LAS unsigned char* lds, int G) {
    const int tid = threadIdx.x, lane = tid & 63, wave = __builtin_amdgcn_readfirstlane(tid >> 6);
    const float* modp = (const float*)(p.ws + WS_MODP);
    LAS float* g1 = (LAS float*)lds; LAS float* gs = g1 + 1024; LAS float* sh = gs + 1024;
    const bf16* Y = (const bf16*)(p.ws + WS_Y); bf16* H2 = (bf16*)(p.ws + WS_H2);
    for (int tile = blockIdx.x; tile < T / 256; tile += G) {
        const int b = tile / 32;
        __syncthreads();
        for (int k = tid; k < 1024; k += NTHR) { g1[k] = mod_at(modp, b, 2048 + k) * p.npo[k]; gs[k] = p.npf[k] * (1.f + mod_at(modp, b, 4096 + k)); sh[k] = mod_at(modp, b, 3072 + k); }
        __syncthreads();
        for (int rr = 0; rr < 32; ++rr) {
            const size_t row = (size_t)tile * 256 + wave * 32 + rr;
            const f32x4* xr = (const f32x4*)(p.x + row * 1024) + lane; const u32x2* yr = (const u32x2*)(Y + row * 1024) + lane;
            f32x4 xv[4], yv[4]; float s = 0.f;
#pragma unroll
            for (int j = 0; j < 4; ++j) { xv[j] = xr[64 * j]; const u32x2 yw = yr[64 * j]; yv[j] = (f32x4){bflo(yw.x), bfhi(yw.x), bflo(yw.y), bfhi(yw.y)};
                s += (yv[j].x * yv[j].x + yv[j].y * yv[j].y) + (yv[j].z * yv[j].z + yv[j].w * yv[j].w); }
            const float rstd = 1.f / sqrtf(wave_sum(s) * (1.f / 1024.f) + 1e-6f);
            float s2 = 0.f;
            f32x4* orow = (f32x4*)(p.out + row * 1024) + lane;
#pragma unroll
            for (int j = 0; j < 4; ++j) { const int k = 256 * j + 4 * lane; const f32x4 g4 = *(const LAS f32x4*)(g1 + k);
                xv[j] = xv[j] + yv[j] * rstd * g4; orow[64 * j] = xv[j];
                s2 += (xv[j].x * xv[j].x + xv[j].y * xv[j].y) + (xv[j].z * xv[j].z + xv[j].w * xv[j].w); }
            const float rstd2 = 1.f / sqrtf(wave_sum(s2) * (1.f / 1024.f) + 1e-6f);
            u32x2* o8 = (u32x2*)(H2 + row * 1024) + lane;
#pragma unroll
            for (int j = 0; j < 4; ++j) { const int k = 256 * j + 4 * lane; const f32x4 g4 = *(const LAS f32x4*)(gs + k), s4 = *(const LAS f32x4*)(sh + k);
                u32x2 w; w.x = pk2(xv[j].x * rstd2 * g4.x + s4.x, xv[j].y * rstd2 * g4.y + s4.y); w.y = pk2(xv[j].z * rstd2 * g4.z + s4.z, xv[j].w * rstd2 * g4.w + s4.w);
                o8[64 * j] = w; }
        }
    }
}

__device__ __forceinline__ unsigned h16_key(unsigned b) { return (b & 0x8000u) ? (~b & 0xffffu) : (b | 0x8000u); }
__device__ __forceinline__ float h16_key_val(unsigned s) { const unsigned b = (s & 0x8000u) ? (s & 0x7fffu) : (~s & 0xffffu); return (float)__builtin_bit_cast(_Float16, (unsigned short)b); }
#define INS16(top, x) do { _Pragma("unroll") for (int _j = 0; _j < 16; ++_j) { const unsigned _hi = max(top[_j], x), _lo = min(top[_j], x); top[_j] = _hi; x = _lo; } } while (0)
__device__ __forceinline__ void phase_topk(const Params& p, LAS unsigned char* lds, int G) {
    const int tid = threadIdx.x;
    const unsigned short* SC = (const unsigned short*)(p.ws + WS_SC); unsigned* TK = (unsigned*)(p.ws + WS_TOPK); float* TK2 = (float*)(p.ws + WS_TOPK2);
    const float* SU = (const float*)(p.ws + WS_SU); const float* SV = (const float*)(p.ws + WS_SV);
    LAS unsigned* my = (LAS unsigned*)lds + tid * 33;
    for (int blk = blockIdx.x; blk < T * 8 / NTHR; blk += G) {
        const int item = blk * NTHR + tid, t = item >> 3, h = item & 7;
        unsigned topA[16], topB[16];
#pragma unroll
        for (int j = 0; j < 16; ++j) { topA[j] = 0u; topB[j] = 0u; }
        const u32x4* src = (const u32x4*)(SC + (size_t)t * 2048 + h * 256);
#pragma unroll 1
        for (int c8 = 0; c8 < 16; ++c8) { const u32x4 w = src[c8];
            const unsigned ww[4] = {w.x, w.y, w.z, w.w};
#pragma unroll
            for (int q = 0; q < 4; ++q) { unsigned k0 = (h16_key(ww[q] & 0xffffu) << 16) | (unsigned)(127 - (c8 * 8 + q * 2)), k1 = (h16_key(ww[q] >> 16) << 16) | (unsigned)(127 - (c8 * 8 + q * 2 + 1));
                INS16(topA, k0); INS16(topA, k1); } }
#pragma unroll 1
        for (int c8 = 0; c8 < 16; ++c8) { const u32x4 w = src[16 + c8];
            const unsigned ww[4] = {w.x, w.y, w.z, w.w};
#pragma unroll
            for (int q = 0; q < 4; ++q) { unsigned k0 = (h16_key(ww[q] & 0xffffu) << 16) | (unsigned)(127 - (c8 * 8 + q * 2)), k1 = (h16_key(ww[q] >> 16) << 16) | (unsigned)(127 - (c8 * 8 + q * 2 + 1));
                INS16(topB, k0); INS16(topB, k1); } }
        float fa[16], fb[16];
#pragma unroll
        for (int j = 0; j < 16; ++j) { fa[j] = h16_key_val(topA[j] >> 16); fb[j] = h16_key_val(topB[j] >> 16); my[j] = 127u - (topA[j] & 127u); my[16 + j] = 127u - (topB[j] & 127u); }
        unsigned ct[16];
#pragma unroll
        for (int j = 0; j < 16; ++j) ct[j] = 0u;
#pragma unroll
        for (int i = 0; i < 16; ++i)
#pragma unroll
            for (int j = 0; j < 16; ++j) if ((i + 1) * (j + 1) <= 16) {
                const float s = fa[i] + fb[j]; unsigned u = __builtin_bit_cast(unsigned, s); u ^= (u >> 31) ? 0xffffffffu : 0x80000000u;
                unsigned key = (u & 0xffffff00u) | (unsigned)(255 - (i * 16 + j));
                INS16(ct, key); }
        float val[16], mx, sum = 0.f;
#pragma unroll
        for (int m = 0; m < 16; ++m) { unsigned u = ct[m] & 0xffffff00u; u ^= (u >> 31) ? 0x80000000u : 0xffffffffu; val[m] = __builtin_bit_cast(float, u); }
        mx = val[0];
#pragma unroll
        for (int m = 0; m < 16; ++m) { val[m] = __expf(val[m] - mx); sum += val[m]; }
        const float inv = 1.f / sum;
        LDS_WAIT();
        unsigned outw[16]; float outs[16];
#pragma unroll
        for (int m = 0; m < 16; ++m) { const unsigned pos = 255u - (ct[m] & 255u), i = pos >> 4, j = pos & 15u;
            const unsigned e = my[i] * 128u + my[16 + j];
            outw[m] = (e << 16) | f2bf(val[m] * inv * SV[e]); outs[m] = SU[e]; }
        u32x4* dst = (u32x4*)(TK + (size_t)item * 16); f32x4* dst2 = (f32x4*)(TK2 + (size_t)item * 16);
#pragma unroll
        for (int q = 0; q < 4; ++q) { dst[q] = (u32x4){outw[4 * q], outw[4 * q + 1], outw[4 * q + 2], outw[4 * q + 3]}; dst2[q] = (f32x4){outs[4 * q], outs[4 * q + 1], outs[4 * q + 2], outs[4 * q + 3]}; }
    }
}

__device__ __forceinline__ f32x2 fp8lo(unsigned w) { return __builtin_amdgcn_cvt_pk_f32_fp8((int)w, false); }
__device__ __forceinline__ f32x2 fp8hi(unsigned w) { return __builtin_amdgcn_cvt_pk_f32_fp8((int)w, true); }
__device__ __forceinline__ float rdlane(float v, int l) { return __builtin_bit_cast(float, __builtin_amdgcn_readlane(__builtin_bit_cast(int, v), l)); }
__device__ __forceinline__ void phase_gather(const Params& p, LAS unsigned char* lds, int G) {
    const int tid = threadIdx.x, lane = tid & 63, wave = __builtin_amdgcn_readfirstlane(tid >> 6);
    const float* modp = (const float*)(p.ws + WS_MODP);
    LAS float* g2 = (LAS float*)lds;
    const bf16* H2 = (const bf16*)(p.ws + WS_H2); const unsigned* TK = (const unsigned*)(p.ws + WS_TOPK); const float* TK2 = (const float*)(p.ws + WS_TOPK2);
    const unsigned char* U8 = p.ws + WS_U; const unsigned char* V8 = p.ws + WS_V;
    for (int tile = blockIdx.x; tile < T / 256; tile += G) {
        const int b = tile / 32;
        __syncthreads();
        for (int k = tid; k < 1024; k += NTHR) g2[k] = mod_at(modp, b, 5120 + k) * p.npof[k];
        __syncthreads();
#pragma unroll 1
        for (int rr = 0; rr < 32; ++rr) {
            const size_t row = (size_t)tile * 256 + wave * 32 + rr;
            f32x2 xt[8];
            { const u32x4 a = *(const u32x4*)(H2 + row * 1024 + lane * 16), c = *(const u32x4*)(H2 + row * 1024 + lane * 16 + 8);
              xt[0] = (f32x2){bflo(a.x), bfhi(a.x)}; xt[1] = (f32x2){bflo(a.y), bfhi(a.y)}; xt[2] = (f32x2){bflo(a.z), bfhi(a.z)}; xt[3] = (f32x2){bflo(a.w), bfhi(a.w)};
              xt[4] = (f32x2){bflo(c.x), bfhi(c.x)}; xt[5] = (f32x2){bflo(c.y), bfhi(c.y)}; xt[6] = (f32x2){bflo(c.z), bfhi(c.z)}; xt[7] = (f32x2){bflo(c.w), bfhi(c.w)}; }
            f32x2 acc[8];
#pragma unroll
            for (int j = 0; j < 8; ++j) acc[j] = (f32x2){0.f, 0.f};
#pragma unroll 1
            for (int h = 0; h < 8; ++h) {
                const u32x4* ra = (const u32x4*)(TK + row * 128 + h * 16);
                const u32x4 w0 = ra[0], w1 = ra[1], w2 = ra[2], w3 = ra[3];
                const unsigned ww[16] = {w0.x, w0.y, w0.z, w0.w, w1.x, w1.y, w1.z, w1.w, w2.x, w2.y, w2.z, w2.w, w3.x, w3.y, w3.z, w3.w};
                u32x4 ur[16], vr[16];
#pragma unroll
                for (int m = 0; m < 16; ++m) { const size_t eo = (size_t)((unsigned)__builtin_amdgcn_readfirstlane((int)ww[m]) >> 16) * 1024 + lane * 16;
                    ur[m] = *(const u32x4*)(U8 + eo); vr[m] = *(const u32x4*)(V8 + eo); }
                const unsigned wa = TK[row * 128 + h * 16 + (lane >> 2)]; const float su = TK2[row * 128 + h * 16 + (lane >> 2)];
                float pd[16];
#pragma unroll
                for (int m = 0; m < 16; ++m) {
                    f32x2 s = xt[0] * fp8lo(ur[m].x);
                    s += xt[1] * fp8hi(ur[m].x); s += xt[2] * fp8lo(ur[m].y); s += xt[3] * fp8hi(ur[m].y);
                    s += xt[4] * fp8lo(ur[m].z); s += xt[5] * fp8hi(ur[m].z); s += xt[6] * fp8lo(ur[m].w); s += xt[7] * fp8hi(ur[m].w);
                    pd[m] = s.x + s.y; }
#pragma unroll
                for (int j = 0; j < 8; ++j) { const bool up = (lane & 32) != 0; const float keep = up ? pd[j + 8] : pd[j], send = up ? pd[j] : pd[j + 8]; pd[j] = keep + __shfl_xor(send, 32); }
#pragma unroll
                for (int j = 0; j < 4; ++j) { const bool up = (lane & 16) != 0; const float keep = up ? pd[j + 4] : pd[j], send = up ? pd[j] : pd[j + 4]; pd[j] = keep + __shfl_xor(send, 16); }
#pragma unroll
                for (int j = 0; j < 2; ++j) { const bool up = (lane & 8) != 0; const float keep = up ? pd[j + 2] : pd[j], send = up ? pd[j] : pd[j + 2]; pd[j] = keep + __shfl_xor(send, 8); }
                { const bool up = (lane & 4) != 0; const float keep = up ? pd[1] : pd[0], send = up ? pd[0] : pd[1]; pd[0] = keep + __shfl_xor(send, 4); }
                float d = pd[0]; d += __shfl_xor(d, 2); d += __shfl_xor(d, 1);
                const float coef = bflo(wa) * gelu_f(su * d);
#pragma unroll
                for (int m = 0; m < 16; ++m) { const float cm = rdlane(coef, 4 * m); const f32x2 c2 = (f32x2){cm, cm};
                    acc[0] += c2 * fp8lo(vr[m].x); acc[1] += c2 * fp8hi(vr[m].x); acc[2] += c2 * fp8lo(vr[m].y); acc[3] += c2 * fp8hi(vr[m].y);
                    acc[4] += c2 * fp8lo(vr[m].z); acc[5] += c2 * fp8hi(vr[m].z); acc[6] += c2 * fp8lo(vr[m].w); acc[7] += c2 * fp8hi(vr[m].w); }
            }
            float s = 0.f;
#pragma unroll
            for (int j = 0; j < 8; ++j) s += acc[j].x * acc[j].x + acc[j].y * acc[j].y;
            const float rstd = 1.f / sqrtf(wave_sum(s) * (1.f / 1024.f) + 1e-6f);
            float* orow = p.out + row * 1024 + lane * 16;
#pragma unroll
            for (int q = 0; q < 4; ++q) { f32x4 o = *(const f32x4*)(orow + 4 * q); const f32x4 ga = *(const LAS f32x4*)(g2 + lane * 16 + 4 * q);
                o.x += ga.x * acc[2 * q].x * rstd; o.y += ga.y * acc[2 * q].y * rstd; o.z += ga.z * acc[2 * q + 1].x * rstd; o.w += ga.w * acc[2 * q + 1].y * rstd;
                *(f32x4*)(orow + 4 * q) = o; }
        }
    }
}

#define XB_TMO      128
#define XB_XCNT(j)  (256  + 64 * (j))
#define XB_XSUB(j)  (1280 + 64 * (j))
#define XB_XGEN(j)  (2304 + 64 * (j))
#define XB_TOP      3328
#define XB_TOPGEN   3392
#define XCD_BAR_WORDS 3456
#define XB_SPIN_CAP (1u << 18)

__device__ __forceinline__ unsigned xb_ld(unsigned* p)              { return __hip_atomic_load(p, __ATOMIC_RELAXED, __HIP_MEMORY_SCOPE_AGENT); }
__device__ __forceinline__ unsigned xb_add(unsigned* p, unsigned v) { return __hip_atomic_fetch_add(p, v, __ATOMIC_RELAXED, __HIP_MEMORY_SCOPE_AGENT); }
__device__ __forceinline__ unsigned xb_xcc_id() { return (unsigned)__builtin_amdgcn_s_getreg((3 << 11) | 20) & 0xFu; }
#define XB_SPIN(cond, bar) do { unsigned _sp = 0; while (cond) { __builtin_amdgcn_s_sleep(1); \
    if ((++_sp & 255u) == 0u) { if (xb_ld(&(bar)[XB_TMO])) break; if (_sp > XB_SPIN_CAP) { atomicAdd(&(bar)[XB_TMO], 1u); break; } } } } while (0)

struct XcdBarrier {
    unsigned* bar; unsigned x;
    volatile LAS unsigned* st;
};

__device__ __forceinline__ XcdBarrier xcd_barrier_post(unsigned* bar, volatile LAS unsigned* st) {
    XcdBarrier b; b.bar = bar; b.x = xb_xcc_id(); b.st = st;
    if (threadIdx.x == 0) (void)xb_add(&bar[XB_XCNT(b.x)], 1u);
    return b;
}
__device__ __forceinline__ void xcd_barrier_complete(unsigned* bar, unsigned x, unsigned& nloc, unsigned& nx) {
    const unsigned G = gridDim.x * gridDim.y * gridDim.z;
    unsigned sum, cnt, mine, sp = 0u;
    for (;;) {
        sum = 0u; cnt = 0u; mine = 0u;
#pragma unroll
        for (unsigned j = 0; j < 16; ++j) { const unsigned c = xb_ld(&bar[XB_XCNT(j)]); sum += c; cnt += (c > 0u) ? 1u : 0u; mine = (j == x) ? c : mine; }
        if (sum == G) break;
        __builtin_amdgcn_s_sleep(1);
        if ((++sp & 255u) == 0u) { if (xb_ld(&bar[XB_TMO])) break; if (sp > XB_SPIN_CAP) { atomicAdd(&bar[XB_TMO], 1u); break; } }
    }
    nloc = mine > 0u ? mine : 1u; nx = cnt > 0u ? cnt : 1u;
}

__device__ __forceinline__ void xcd_barrier(const XcdBarrier& b) {
    asm volatile("s_waitcnt vmcnt(0)" ::: "memory");
    __syncthreads();
    if (threadIdx.x == 0) {
        unsigned* bar = b.bar;
        __builtin_amdgcn_s_waitcnt(0);
        unsigned nloc = b.st[0], nx = b.st[1];
        if (nloc == 0u) { xcd_barrier_complete(bar, b.x, nloc, nx); b.st[0] = nloc; b.st[1] = nx; }
        const unsigned old = xb_add(&bar[XB_XSUB(b.x)], 1u);
        const unsigned gen = old / nloc;
        if (old + 1u == (gen + 1u) * nloc) {
            __builtin_amdgcn_fence(__ATOMIC_RELEASE, "agent");
            asm volatile("s_waitcnt vmcnt(0)" ::: "memory");
            const unsigned og = xb_add(&bar[XB_TOP], 1u);
            const unsigned tg = og / nx;
            if (og + 1u == (tg + 1u) * nx) xb_add(&bar[XB_TOPGEN], 1u);
            else XB_SPIN(xb_ld(&bar[XB_TOPGEN]) == tg, bar);
            __builtin_amdgcn_fence(__ATOMIC_ACQUIRE, "agent");
            xb_add(&bar[XB_XGEN(b.x)], 1u);
            asm volatile("s_waitcnt vmcnt(0)" ::: "memory");
        } else {
            XB_SPIN(xb_ld(&bar[XB_XGEN(b.x)]) == gen, bar);
            __builtin_amdgcn_fence(__ATOMIC_ACQUIRE, "agent");
            asm volatile("s_waitcnt vmcnt(0)" ::: "memory");
        }
    }
    __syncthreads();
}


template <int PH>
__device__ __forceinline__ void run_phase(const Params& p, LAS unsigned char* lds, int G) {
    unsigned char* ws = p.ws;
    if constexpr (PH == 0) phase0(p, lds, G);
    else if constexpr (PH == 1) phase1(p, lds, G);
    else if constexpr (PH == 2) { pg8::Gemm g{(const bf16*)p.out, (const bf16*)(ws + WS_WIN), T, NPAD, 1024, 1024}; pg8::StaticOrder S; S.init(T, NPAD, G, (int)blockIdx.x);
        EpiSeg E{ws}; pg8::gemm_phase<EpiSeg, pg8::StaticOrder, true, true, 0, 1024, 1024>(lds, g, S, E); }
    else if constexpr (PH == 3) phase_conv(p, G);
    else if constexpr (PH == 4) { pg8::Gemm g{(const bf16*)p.out, (const bf16*)(ws + WS_LRUB), T, 2048, 256, 1024}; pg8::StaticOrder S; S.init(T, 2048, G, (int)blockIdx.x);
        EpiLru E{(bf16*)(ws + WS_XLXG), (bf16*)p.out, p.lba, p.lbx, p.lam}; pg8::gemm_phase<EpiLru, pg8::StaticOrder, true, true, 1, 256, 1024>(lds, g, S, E); }
    else if constexpr (PH == 5) phase_lru_scan<false>(p, G);
    else if constexpr (PH == 6) phase_lru_scan<true>(p, G);
    else if constexpr (PH == 7) phase_gla_chunk(p, lds, G);
    else if constexpr (PH == 8) phase_gla_final(p, G);
    else if constexpr (PH == 9) { pg8::Gemm g{(const bf16*)(ws + WS_GAGB), (const bf16*)(ws + WS_WOUT), T, 1024, 1024, 2048}; pg8::StaticOrder S; S.init(T, 1024, G, (int)blockIdx.x);
        EpiPlain E{(bf16*)(ws + WS_Y), 1024}; pg8::gemm_phase<EpiPlain, pg8::StaticOrder, true, true, 0, 1024, 2048>(lds, g, S, E); }
    else if constexpr (PH == 10) phase_norm2(p, lds, G);
    else if constexpr (PH == 11) { pg8::Gemm g{(const bf16*)(ws + WS_H2), (const bf16*)(ws + WS_WQ), T, 2048, 1024, 1024}; pg8::StaticOrder S; S.init(T, 2048, G, (int)blockIdx.x);
        EpiPlain E{(bf16*)(ws + WS_QRY), 2048}; pg8::gemm_phase<EpiPlain, pg8::StaticOrder, true, true, 0, 1024, 1024>(lds, g, S, E); }
    else if constexpr (PH == 12) { pg8::Gemm g{(const bf16*)(ws + WS_QRY), (const bf16*)(ws + WS_SUBK), T, 2048, 256, 2048}; pg8::StaticOrder S; S.init(T, 2048, G, (int)blockIdx.x);
        EpiF16 E{(unsigned short*)(ws + WS_SC), 2048}; pg8::gemm_phase<EpiF16, pg8::StaticOrder, true, true, 2, 256, 2048>(lds, g, S, E); }
    else if constexpr (PH == 13) phase_topk(p, lds, G);
    else if constexpr (PH == 14) phase_gather(p, lds, G);
}
template <int PH>
__global__ void __launch_bounds__(NTHR, 2) k_phase(Params p) {
    extern __shared__ __attribute__((aligned(16))) unsigned char lds_raw[];
    run_phase<PH>(p, (LAS unsigned char*)lds_raw, (int)gridDim.x);
}
constexpr int LDS_BAR_OFF = LDS_BYTES - 16;
template <int PH>
__device__ __forceinline__ void run_from(const Params& p, LAS unsigned char* lds, int G, const XcdBarrier& bar) {
    run_phase<PH>(p, lds, G);
    if constexpr (PH + 1 < N_PHASES) {
        if constexpr (PH == 0) cg::this_grid().sync();
        else xcd_barrier(bar);
        run_from<PH + 1>(p, lds, G, bar);
    }
}
__global__ void __launch_bounds__(NTHR, 2) k_mega(Params p) {
    extern __shared__ __attribute__((aligned(16))) unsigned char lds_raw[];
    LAS unsigned char* lds = (LAS unsigned char*)lds_raw;
    if (threadIdx.x < 4) ((LAS unsigned*)(lds + LDS_BAR_OFF))[threadIdx.x] = 0u;
    __syncthreads();
    const XcdBarrier bar = xcd_barrier_post((unsigned*)(p.ws + WS_CTL), (volatile LAS unsigned*)(lds + LDS_BAR_OFF));
    run_from<0>(p, lds, (int)gridDim.x, bar);
}

extern "C" void kernel_launch(void* const* d_in, const int* in_sizes, int n_in, void* d_out, int out_size, void* d_ws, size_t ws_size, hipStream_t stream) {
    static int grid = 0;
    if (grid == 0) {
        if (n_in != 24 || in_sizes[0] != T * DM || out_size != T * DM || ws_size < WS_END) {
            fprintf(stderr, "kernel_launch: unexpected shapes: n_in %d in0 %d out %d ws %zu\n", n_in, n_in > 0 ? in_sizes[0] : -1, out_size, ws_size); grid = -1; return; }
        int dev = 0, cus = 0, per_cu = 0;
        if (hipGetDevice(&dev) != hipSuccess || hipDeviceGetAttribute(&cus, hipDeviceAttributeMultiprocessorCount, dev) != hipSuccess) { grid = -1; return; }
        if (hipFuncSetAttribute((const void*)k_mega, hipFuncAttributeMaxDynamicSharedMemorySize, LDS_BYTES) != hipSuccess) { fprintf(stderr, "kernel_launch: hipFuncSetAttribute failed\n"); grid = -1; return; }
        if (hipOccupancyMaxActiveBlocksPerMultiprocessor(&per_cu, (const void*)k_mega, NTHR, LDS_BYTES) != hipSuccess || per_cu < 1) { fprintf(stderr, "kernel_launch: occupancy query says %d blocks per CU\n", per_cu); grid = -1; return; }
        (void)hipGetLastError();
        grid = cus;
    }
    if (grid < 0) return;
    Params p{};
    const float** pp = (const float**)&p;
    for (int i = 0; i < 24; ++i) pp[i] = (const float*)d_in[i];
    p.out = (float*)d_out; p.ws = (unsigned char*)d_ws;
    if (hipMemsetAsync((char*)d_ws + WS_CTL, 0, 65536, stream) != hipSuccess) { fprintf(stderr, "kernel_launch: hipMemsetAsync failed\n"); return; }
    void* args[] = {&p};
    hipError_t e = hipLaunchCooperativeKernel((const void*)k_mega, dim3(grid), dim3(NTHR), args, LDS_BYTES, stream);
    if (e != hipSuccess) fprintf(stderr, "kernel_launch: cooperative launch failed: %s (grid %d)\n", hipGetErrorString(e), grid);
}
```

```cpp
#include <hip/hip_runtime.h>
#include <hip/hip_cooperative_groups.h>
#include <cstdio>
#include <cstdint>
#include <utility>
namespace cg = cooperative_groups;

namespace pg8 {
#define PG8_LAS __attribute__((address_space(3)))
typedef unsigned short bf16_t;
typedef short bf16x8 __attribute__((ext_vector_type(8)));
typedef float f32x4 __attribute__((ext_vector_type(4)));
typedef unsigned u32x4 __attribute__((ext_vector_type(4)));
constexpr int BM = 256, BK = 64, HALF = 128, HTB = HALF * BK * 2  , STAGE_BYTES = 8 * HTB, NXCD = 8, WGM = 8;

__host__ __device__ __forceinline__ int lds_byte(int r, int c) { const int st = (r >> 4) * 2 + (c >> 5), rr = r & 15, cc = c & 31, ob = rr * 64 + cc * 2; return st * 1024 + (ob ^ (((ob >> 9) & 1) << 5)); }
__host__ __device__ __forceinline__ void stage_rc(int b, int& R, int& C) { const int st = b / 1024, sb = b % 1024, swz = sb ^ (((sb >> 9) & 1) << 5); R = (st >> 1) * 16 + swz / 64; C = (st & 1) * 32 + (swz % 64) / 2; }
__host__ __device__ __forceinline__ int perm32(int rho) { const int n = rho >> 4, i = rho & 15; return 8 * (i >> 2) + 4 * n + (i & 3); }

struct Unit { int pm, pn; };
struct Gemm { const bf16_t* A; const bf16_t* Bt; int M, N, K, lda; };
template <int AMODE> __device__ __forceinline__ size_t a_off_bytes(const Gemm& g, const Unit& u) {
    const int ac = AMODE == 0 ? 0 : (AMODE == 1 ? 128 * (u.pn < 6 ? u.pn : 6) : 256 * u.pn);
    return ((size_t)u.pm * BM * (size_t)g.lda + (size_t)ac) * 2;
}

struct StaticOrder {
    int nM, nN, nwg, G, c;
    __host__ __device__ void init(int M, int N, int G_, int c_) { nM = M / BM; nN = N / BM; nwg = nM * nN; G = G_; c = c_; }
    __host__ __device__ bool next(int i, Unit& u) const {
        const long L = (long)i * G + c; if (L >= nwg) return false;
        int wgid = (int)L; { const int q = nwg / NXCD, r = nwg % NXCD, xcd = wgid % NXCD, off = wgid / NXCD; wgid = (xcd < r ? xcd * (q + 1) : r * (q + 1) + (xcd - r) * q) + off; }
        const int nig = WGM * nN, gid = wgid / nig, fm = gid * WGM, gsz = (nM - fm) < WGM ? (nM - fm) : WGM;
        u.pm = fm + ((wgid % nig) % gsz); u.pn = (wgid % nig) / gsz; return true;
    }
    __device__ __forceinline__ void a_ready(const Unit&) const {}
    __device__ __forceinline__ void done(const Unit&) const {}
};

__device__ __forceinline__ unsigned cvt_pk_bf16(float lo, float hi) { unsigned r; asm volatile("v_cvt_pk_bf16_f32 %0, %1, %2" : "=v"(r) : "v"(lo), "v"(hi)); return r; }

template <class Epi, class Sched, bool ALIGN_EPI = false, bool SP2 = false, int AMODE = 0, int KC = 0, int LDAC = 0>
__device__ __forceinline__ void gemm_phase(PG8_LAS unsigned char* lds, const Gemm g, const Sched& S, const Epi& E) {
    const int tid = threadIdx.x, wid = __builtin_amdgcn_readfirstlane(tid >> 6), lane = tid & 63, wr = wid >> 2, wc = wid & 3, fr = lane & 15, fq = lane >> 4;
    const int K = KC ? KC : g.K, nt = K / BK; const int lda = LDAC ? LDAC : g.lda;
    unsigned voffA[2], voffB[2];
#pragma unroll
    for (int i = 0; i < 2; ++i) { int R, C; stage_rc(tid * 16 + i * 8192, R, C); const int Rb = Epi::PERM ? ((R & ~31) + perm32(R & 31)) : R;
        voffA[i] = (unsigned)(R * lda + C) * 2u; voffB[i] = (unsigned)(Rb * K + C) * 2u; }
    const size_t kstep = (size_t)(BK * 2);
    const size_t hstepA = (size_t)HALF * lda * 2;
    const size_t hstepB = (size_t)HALF * K * 2;
    const size_t tstepB = 2 * hstepB;
    const unsigned ldsw = (unsigned)wid * 1024u;
    const int aoff = lds_byte(wr * 64 + fr, fq * 8), boff = lds_byte(wc * 32 + fr, fq * 8);
#define PG8_SA(b, h) (((b) * 2 + (h)) * HTB)
#define PG8_SB(b, h) ((4 + (b) * 2 + (h)) * HTB)
#define PG8_STAGE(bufoff, gbase, voff) do { _Pragma("unroll") for (int _i = 0; _i < 2; ++_i) \
        __builtin_amdgcn_global_load_lds((const unsigned*)((const char*)(gbase) + (voff)[_i]), (PG8_LAS unsigned*)(lds + (bufoff) + ldsw + _i * 8192), 16, 0, 0); } while (0)
#define PG8_LDA(dst, b, h) do { _Pragma("unroll") for (int m = 0; m < 4; ++m) _Pragma("unroll") for (int k = 0; k < 2; ++k) dst[m][k] = *(const PG8_LAS bf16x8*)(lds + PG8_SA(b, h) + aoff + m * 2048 + k * 1024); } while (0)
#define PG8_LDB(dst, b, h) do { _Pragma("unroll") for (int n = 0; n < 2; ++n) _Pragma("unroll") for (int k = 0; k < 2; ++k) dst[n][k] = *(const PG8_LAS bf16x8*)(lds + PG8_SB(b, h) + boff + n * 2048 + k * 1024); } while (0)
#define PG8_MMA(ai, bj, At, Bt) do { __builtin_amdgcn_s_setprio(1); _Pragma("unroll") for (int m = 0; m < 4; ++m) _Pragma("unroll") for (int n = 0; n < 2; ++n) _Pragma("unroll") for (int k = 0; k < 2; ++k) \
        acc[ai][bj][m][n] = __builtin_amdgcn_mfma_f32_16x16x32_bf16(Bt[n][k], At[m][k], acc[ai][bj][m][n], 0, 0, 0); __builtin_amdgcn_s_setprio(0); } while (0)
#define PG8_WAIT_V(n) asm volatile("s_waitcnt vmcnt(" #n ")" ::: "memory")
#define PG8_WAIT_L(n) asm volatile("s_waitcnt lgkmcnt(" #n ")" ::: "memory")
#define PG8_BAR __builtin_amdgcn_s_barrier()
#define PG8_SCHED __builtin_amdgcn_sched_barrier(0)
    Unit cur, nxt; int ui = 0;
    if (!S.next(0, cur)) return;
    f32x4 acc[2][2][4][2];
#pragma unroll
    for (int a = 0; a < 2; ++a)
#pragma unroll
        for (int b = 0; b < 2; ++b)
#pragma unroll
            for (int m = 0; m < 4; ++m)
#pragma unroll
                for (int n = 0; n < 2; ++n) acc[a][b][m][n] = (f32x4){0.f, 0.f, 0.f, 0.f};
    bf16x8 At[4][2], B0[2][2], B1[2][2];
    const char* cA = (const char*)g.A + a_off_bytes<AMODE>(g, cur); const char* cB = (const char*)g.Bt + (size_t)cur.pn * tstepB;
    S.a_ready(cur);
    if constexpr (SP2) {
        PG8_STAGE(PG8_SB(0, 0), cB, voffB); PG8_STAGE(PG8_SB(0, 1), cB + hstepB, voffB); PG8_STAGE(PG8_SA(0, 0), cA, voffA); PG8_STAGE(PG8_SA(0, 1), cA + hstepA, voffA);
        if (wr == 1) PG8_BAR;
        PG8_WAIT_V(2); PG8_BAR;
        PG8_STAGE(PG8_SB(1, 0), cB + kstep, voffB); PG8_STAGE(PG8_SA(1, 0), cA + kstep, voffA); PG8_STAGE(PG8_SB(1, 1), cB + hstepB + kstep, voffB);
        PG8_WAIT_V(6); PG8_BAR;
    } else {
        PG8_STAGE(PG8_SB(0, 0), cB, voffB); PG8_STAGE(PG8_SA(0, 0), cA, voffA); PG8_STAGE(PG8_SB(0, 1), cB + hstepB, voffB); PG8_STAGE(PG8_SA(0, 1), cA + hstepA, voffA);
        if (wr == 1) PG8_BAR;
        PG8_WAIT_V(4); PG8_BAR;
        PG8_STAGE(PG8_SB(1, 0), cB + kstep, voffB); PG8_STAGE(PG8_SA(1, 0), cA + kstep, voffA); PG8_STAGE(PG8_SB(1, 1), cB + hstepB + kstep, voffB);
        PG8_WAIT_V(6); PG8_BAR;
    }
    for (;;) {
        const bool has_next = S.next(ui + 1, nxt);
        const char* nA = has_next ? (const char*)g.A + a_off_bytes<AMODE>(g, nxt) : cA; const char* nB = has_next ? (const char*)g.Bt + (size_t)nxt.pn * tstepB : cB;
#pragma unroll 1
        for (int t = 0; t < nt; t += 2) {
            const bool last = (t == nt - 2);
            const char* a1 = cA + (size_t)(t + 1) * kstep;
            const char* a2 = last ? nA : cA + (size_t)(t + 2) * kstep; const char* b2 = last ? nB : cB + (size_t)(t + 2) * kstep;
            const char* a3 = a2 + kstep; const char* b3 = b2 + kstep;
            if (last && has_next) S.a_ready(nxt);
            if constexpr (SP2) {
            PG8_LDB(B0, 0, 0); PG8_LDB(B1, 0, 1); PG8_SCHED; PG8_LDA(At, 0, 0); PG8_STAGE(PG8_SA(1, 1), a1 + hstepA, voffA);
            PG8_WAIT_V(8); PG8_WAIT_L(0); PG8_BAR; PG8_MMA(0, 0, At, B0); PG8_MMA(0, 1, At, B1); PG8_BAR; PG8_SCHED;
            PG8_LDA(At, 0, 1); PG8_STAGE(PG8_SB(0, 0), b2, voffB); PG8_STAGE(PG8_SB(0, 1), b2 + hstepB, voffB); PG8_STAGE(PG8_SA(0, 0), a2, voffA);
            PG8_WAIT_V(8); PG8_WAIT_L(0); PG8_BAR; PG8_MMA(1, 0, At, B0); PG8_MMA(1, 1, At, B1); PG8_BAR; PG8_SCHED;
            PG8_LDB(B0, 1, 0); PG8_LDB(B1, 1, 1); PG8_SCHED; PG8_LDA(At, 1, 0); PG8_STAGE(PG8_SA(0, 1), a2 + hstepA, voffA);
            PG8_WAIT_V(8); PG8_WAIT_L(0); PG8_BAR; PG8_MMA(0, 0, At, B0); PG8_MMA(0, 1, At, B1); PG8_BAR; PG8_SCHED;
            PG8_LDA(At, 1, 1); PG8_STAGE(PG8_SB(1, 0), b3, voffB); PG8_STAGE(PG8_SB(1, 1), b3 + hstepB, voffB); PG8_STAGE(PG8_SA(1, 0), a3, voffA);
            PG8_WAIT_V(8); PG8_WAIT_L(0); PG8_BAR; PG8_MMA(1, 0, At, B0); PG8_MMA(1, 1, At, B1); PG8_BAR; PG8_SCHED;
            } else {
            PG8_LDB(B0, 0, 0); PG8_SCHED; PG8_LDA(At, 0, 0); PG8_STAGE(PG8_SA(1, 1), a1 + hstepA, voffA);
            PG8_WAIT_L(8); PG8_BAR; PG8_WAIT_L(0); PG8_MMA(0, 0, At, B0); PG8_BAR; PG8_SCHED;
            PG8_LDB(B1, 0, 1); PG8_STAGE(PG8_SB(0, 0), b2, voffB);
            PG8_BAR; PG8_WAIT_L(0); PG8_MMA(0, 1, At, B1); PG8_BAR;
            PG8_LDA(At, 0, 1); PG8_STAGE(PG8_SA(0, 0), a2, voffA);
            PG8_BAR; PG8_WAIT_L(0); PG8_MMA(1, 0, At, B0); PG8_BAR; PG8_SCHED;
            PG8_STAGE(PG8_SB(0, 1), b2 + hstepB, voffB);
            PG8_WAIT_V(6); PG8_BAR; PG8_MMA(1, 1, At, B1); PG8_BAR;
            PG8_LDB(B0, 1, 0); PG8_SCHED; PG8_LDA(At, 1, 0); PG8_STAGE(PG8_SA(0, 1), a2 + hstepA, voffA);
            PG8_WAIT_L(8); PG8_BAR; PG8_WAIT_L(0); PG8_MMA(0, 0, At, B0); PG8_BAR; PG8_SCHED;
            PG8_LDB(B1, 1, 1); PG8_STAGE(PG8_SB(1, 0), b3, voffB);
            PG8_BAR; PG8_WAIT_L(0); PG8_MMA(0, 1, At, B1); PG8_BAR;
            PG8_LDA(At, 1, 1); PG8_STAGE(PG8_SA(1, 0), a3, voffA);
            PG8_BAR; PG8_WAIT_L(0); PG8_MMA(1, 0, At, B0); PG8_BAR; PG8_SCHED;
            PG8_STAGE(PG8_SB(1, 1), b3 + hstepB, voffB);
            PG8_WAIT_V(6); PG8_BAR; PG8_MMA(1, 1, At, B1); PG8_BAR;
            }
        }
        if constexpr (ALIGN_EPI) { if (wr == 0) PG8_BAR; }
        E(acc, cur, wr, wc, fr, fq); S.done(cur);
        if (!has_next) break;
#pragma unroll
        for (int a = 0; a < 2; ++a)
#pragma unroll
            for (int b = 0; b < 2; ++b)
#pragma unroll
                for (int m = 0; m < 4; ++m)
#pragma unroll
                    for (int n = 0; n < 2; ++n) acc[a][b][m][n] = (f32x4){0.f, 0.f, 0.f, 0.f};
        cur = nxt; cA = nA; cB = nB; ++ui;
        if constexpr (ALIGN_EPI) { if (wr == 1) PG8_BAR; }
    }
    PG8_WAIT_V(0);
    if constexpr (!ALIGN_EPI) { if (wr == 0) PG8_BAR; }
    PG8_BAR;
#undef PG8_SA
#undef PG8_SB
#undef PG8_STAGE
#undef PG8_LDA
#undef PG8_LDB
#undef PG8_MMA
#undef PG8_WAIT_V
#undef PG8_WAIT_L
#undef PG8_BAR
#undef PG8_SCHED
}
}

constexpr int NB = 8, SEQ = 8192, DM = 1024, T = NB * SEQ;
constexpr int NPAD = 7424;
constexpr int NWAVES = 8, NTHR = 512;
constexpr int LDS_BYTES = 147456;
constexpr int N_PHASES = 16;
#define PROBE_PH -1
#define PROBE_MULT 3

constexpr size_t MiB = 1ull << 20;
constexpr size_t WS_CTL = 0;
constexpr size_t WS_MODP = 1 * MiB;
constexpr size_t WS_WIN = 3 * MiB;
constexpr size_t WS_WOUT = 18 * MiB;
constexpr size_t WS_WQ = 20 * MiB;
constexpr size_t WS_LRUB = 24 * MiB;
constexpr size_t WS_SUBK = 25 * MiB;
constexpr size_t WS_LRUC = 26 * MiB;
constexpr size_t WS_U = 32 * MiB;
constexpr size_t WS_V = 48 * MiB;
constexpr size_t WS_SU = 64 * MiB;
constexpr size_t WS_SV = 65 * MiB;
constexpr size_t WS_DK = 66 * MiB;
constexpr size_t WS_QKV = 96 * MiB;
constexpr size_t WS_R = 352 * MiB;
constexpr size_t WS_XLXG = 480 * MiB;
constexpr size_t WS_GAGB = 736 * MiB;
constexpr size_t WS_ALOW = 992 * MiB;
constexpr size_t WS_END = 994 * MiB;
constexpr size_t WS_Y = WS_QKV;
constexpr size_t WS_H2 = WS_QKV + 128 * MiB;
constexpr size_t WS_QRY = WS_XLXG;
constexpr size_t WS_SC = WS_GAGB;
constexpr size_t WS_TOPK = WS_R;
constexpr size_t WS_TOPK2 = WS_R + 32 * MiB;

#define LAS __attribute__((address_space(3)))
typedef unsigned short bf16;
typedef float f32x4 __attribute__((ext_vector_type(4)));
typedef float f32x2 __attribute__((ext_vector_type(2)));
typedef unsigned u32x4 __attribute__((ext_vector_type(4)));
typedef unsigned u32x2 __attribute__((ext_vector_type(2)));

struct Params {
    const float *x, *c, *w_ada, *b_ada, *npm, *npo, *w_in, *w_alpha, *b_alpha, *gla_norm, *conv_w, *conv_b,
        *lwa, *lba, *lwx, *lbx, *lam, *w_out, *npf, *npof, *wq, *subk, *pu, *pv;
    float* out; unsigned char* ws;
    int ph_lo, ph_hi;
};

__device__ __forceinline__ unsigned f2bf(float f) { unsigned u = __builtin_bit_cast(unsigned, f); return (u + 0x7fffu + ((u >> 16) & 1u)) >> 16; }
__device__ __forceinline__ unsigned pk2(float lo, float hi) { return f2bf(lo) | (f2bf(hi) << 16); }
__device__ __forceinline__ float bflo(unsigned u) { return __builtin_bit_cast(float, u << 16); }
__device__ __forceinline__ float bfhi(unsigned u) { return __builtin_bit_cast(float, u & 0xffff0000u); }
__device__ __forceinline__ float bf2f(bf16 h) { return __builtin_bit_cast(float, (unsigned)h << 16); }
__device__ __forceinline__ float sigmoid_f(float x) { return 1.f / (1.f + __expf(-x)); }
__device__ __forceinline__ float silu_f(float x) { return x / (1.f + __expf(-x)); }
__device__ __forceinline__ float gelu_f(float x) { const float u = 0.7978845608028654f * (x + 0.044715f * x * x * x); return x / (1.f + __expf(-2.f * u)); }
__device__ __forceinline__ float softplus_f(float x) { return fmaxf(x, 0.f) + log1pf(__expf(-fabsf(x))); }
__device__ __forceinline__ float wave_sum(float v) {
#pragma unroll
    for (int o = 1; o < 64; o <<= 1) v += __shfl_xor(v, o);
    return v;
}
#define LDS_WAIT() asm volatile("s_waitcnt lgkmcnt(0)" ::: "memory")

struct EpiSeg {
    static constexpr bool PERM = true;
    unsigned char* ws;
    __device__ __forceinline__ void operator()(const pg8::f32x4 (&acc)[2][2][4][2], const pg8::Unit& u, int wr, int wc, int fr, int fq) const {
        const int pn = u.pn; bf16* base; int ldc, colt;
        if (pn < 8) { base = (bf16*)(ws + WS_QKV); ldc = 2048; colt = pn * 256; }
        else if (pn < 12) { base = (bf16*)(ws + WS_R); ldc = 1024; colt = (pn - 8) * 256; }
        else if (pn < 20) { base = (bf16*)(ws + WS_XLXG); ldc = 2048; colt = (pn - 12) * 256; }
        else if (pn < 28) { base = (bf16*)(ws + WS_GAGB); ldc = 2048; colt = (pn - 20) * 256; }
        else { base = (bf16*)(ws + WS_ALOW); ldc = 16; colt = 0; }
        const int row0 = u.pm * 256 + wr * 64 + fr, col0 = colt + wc * 32 + 8 * fq;
        const bool tail = (pn == 28);
#pragma unroll
        for (int ai = 0; ai < 2; ++ai)
#pragma unroll
            for (int m = 0; m < 4; ++m) { bf16* rowp = base + (size_t)(row0 + ai * 128 + m * 16) * ldc + col0;
#pragma unroll
                for (int bj = 0; bj < 2; ++bj) { const pg8::f32x4 v0 = acc[ai][bj][m][0], v1 = acc[ai][bj][m][1];
                    u32x4 w; w.x = pg8::cvt_pk_bf16(v0[0], v0[1]); w.y = pg8::cvt_pk_bf16(v0[2], v0[3]); w.z = pg8::cvt_pk_bf16(v1[0], v1[1]); w.w = pg8::cvt_pk_bf16(v1[2], v1[3]);
                    if (!tail || (bj == 0 && wc == 0 && fq < 2)) *(u32x4*)(rowp + bj * 128) = w; } }
    }
};
struct EpiPlain {
    static constexpr bool PERM = true;
    bf16* O; int ldc;
    __device__ __forceinline__ void operator()(const pg8::f32x4 (&acc)[2][2][4][2], const pg8::Unit& u, int wr, int wc, int fr, int fq) const {
        const int row0 = u.pm * 256 + wr * 64 + fr, col0 = u.pn * 256 + wc * 32 + 8 * fq;
#pragma unroll
        for (int ai = 0; ai < 2; ++ai)
#pragma unroll
            for (int m = 0; m < 4; ++m) { bf16* rowp = O + (size_t)(row0 + ai * 128 + m * 16) * ldc + col0;
#pragma unroll
                for (int bj = 0; bj < 2; ++bj) { const pg8::f32x4 v0 = acc[ai][bj][m][0], v1 = acc[ai][bj][m][1];
                    u32x4 w; w.x = pg8::cvt_pk_bf16(v0[0], v0[1]); w.y = pg8::cvt_pk_bf16(v0[2], v0[3]); w.z = pg8::cvt_pk_bf16(v1[0], v1[1]); w.w = pg8::cvt_pk_bf16(v1[2], v1[3]);
                    *(u32x4*)(rowp + bj * 128) = w; } }
    }
};
typedef _Float16 h16x2 __attribute__((ext_vector_type(2)));
__device__ __forceinline__ unsigned pkh(float a, float b) { return __builtin_bit_cast(unsigned, __builtin_amdgcn_cvt_pkrtz(a, b)); }
struct EpiF16 {
    static constexpr bool PERM = true;
    unsigned short* O; int ldc;
    __device__ __forceinline__ void operator()(const pg8::f32x4 (&acc)[2][2][4][2], const pg8::Unit& u, int wr, int wc, int fr, int fq) const {
        const int row0 = u.pm * 256 + wr * 64 + fr, col0 = u.pn * 256 + wc * 32 + 8 * fq;
#pragma unroll
        for (int ai = 0; ai < 2; ++ai)
#pragma unroll
            for (int m = 0; m < 4; ++m) { unsigned short* rowp = O + (size_t)(row0 + ai * 128 + m * 16) * ldc + col0;
#pragma unroll
                for (int bj = 0; bj < 2; ++bj) { const pg8::f32x4 v0 = acc[ai][bj][m][0], v1 = acc[ai][bj][m][1];
                    u32x4 w; w.x = pkh(v0[0], v0[1]); w.y = pkh(v0[2], v0[3]); w.z = pkh(v1[0], v1[1]); w.w = pkh(v1[2], v1[3]);
                    *(u32x4*)(rowp + bj * 128) = w; } }
    }
};
struct EpiLru {
    static constexpr bool PERM = true;
    bf16* LA;   bf16* XCU;   const float *lba, *lbx, *lam;
    __device__ __forceinline__ void operator()(const pg8::f32x4 (&acc)[2][2][4][2], const pg8::Unit& u, int wr, int wc, int fr, int fq) const {
        const int row0 = u.pm * 256 + wr * 64 + fr, ch0 = u.pn * 128 + wc * 32 + 8 * fq;
        float ba[8], bx[8], sp[8];
#pragma unroll
        for (int j = 0; j < 8; ++j) { ba[j] = lba[ch0 + j]; bx[j] = lbx[ch0 + j]; sp[j] = -8.f * softplus_f(-lam[ch0 + j]); }
#pragma unroll
        for (int ai = 0; ai < 2; ++ai)
#pragma unroll
            for (int m = 0; m < 4; ++m) { const size_t row = (size_t)(row0 + ai * 128 + m * 16);
                const u32x4 xw = *(const u32x4*)(XCU + row * 1024 + ch0);
                float xc[8] = {bflo(xw.x), bfhi(xw.x), bflo(xw.y), bfhi(xw.y), bflo(xw.z), bfhi(xw.z), bflo(xw.w), bfhi(xw.w)};
                float la[8], uu[8];
#pragma unroll
                for (int j = 0; j < 8; ++j) { const float pr = acc[ai][0][m][j >> 2][j & 3] + ba[j], pi = acc[ai][1][m][j >> 2][j & 3] + bx[j];
                    const float gr = sigmoid_f(pr), gi = sigmoid_f(pi);
                    la[j] = sp[j] * gr; const float a2 = __expf(2.f * la[j]);
                    uu[j] = sqrtf(fmaxf(1.f - a2, 0.f)) * gi * xc[j]; }
                u32x4 w1, w2; w1.x = pk2(la[0], la[1]); w1.y = pk2(la[2], la[3]); w1.z = pk2(la[4], la[5]); w1.w = pk2(la[6], la[7]);
                w2.x = pk2(uu[0], uu[1]); w2.y = pk2(uu[2], uu[3]); w2.z = pk2(uu[4], uu[5]); w2.w = pk2(uu[6], uu[7]);
                *(u32x4*)(LA + row * 2048 + ch0) = w1; *(u32x4*)(XCU + row * 1024 + ch0) = w2; }
    }
};

__device__ __forceinline__ void p0_transpose_item(const float* W, int ldw, int k0, int n0, int nvalid, bf16* WT, int ldk, int row0, int kc0, LAS float* scr, int lane) {
#pragma unroll 8
    for (int i = 0; i < 32; ++i) { const int kk = 2 * i + (lane >> 5), cc = lane & 31; scr[kk * 33 + cc] = (cc < nvalid) ? W[(size_t)(k0 + kk) * ldw + n0 + cc] : 0.f; }
    LDS_WAIT(); asm volatile("" ::: "memory");
    const int c = lane & 7;
#pragma unroll
    for (int j = 0; j < 4; ++j) { const int n = (lane >> 3) + 8 * j; const LAS float* s = scr + (8 * c) * 33 + n;
        u32x4 o; o.x = pk2(s[0 * 33], s[1 * 33]); o.y = pk2(s[2 * 33], s[3 * 33]); o.z = pk2(s[4 * 33], s[5 * 33]); o.w = pk2(s[6 * 33], s[7 * 33]);
        *(u32x4*)(WT + (size_t)(row0 + n) * ldk + kc0 + k0 + 8 * c) = o; }
    LDS_WAIT(); asm volatile("" ::: "memory");
}
__device__ __forceinline__ void phase0(const Params& p, LAS unsigned char* lds, int G) {
    const int tid = threadIdx.x, lane = tid & 63, wave = __builtin_amdgcn_readfirstlane(tid >> 6);
    unsigned char* ws = p.ws;
    {
        LAS float* sc = (LAS float*)lds;
        LAS float* red = (LAS float*)(lds + 4096);
        float* modp = (float*)(ws + WS_MODP);
        for (int it = blockIdx.x; it < 24 * 8; it += G) {
            const int nb = it % 24, kc = it / 24;
            for (int i = tid; i < 1024; i += NTHR) { const int b = i >> 7, k = i & 127; sc[i] = silu_f(p.c[b * 1024 + kc * 128 + k]); }
            __syncthreads();
            const int col = tid & 255, kh = tid >> 8;
            float acc[8];
#pragma unroll
            for (int b = 0; b < 8; ++b) acc[b] = 0.f;
            const float* wp = p.w_ada + (size_t)(kc * 128 + kh * 64) * 6144 + nb * 256 + col;
#pragma unroll 8
            for (int kk = 0; kk < 64; ++kk) { const float w = wp[(size_t)kk * 6144];
#pragma unroll
                for (int b = 0; b < 8; ++b) acc[b] += sc[b * 128 + kh * 64 + kk] * w; }
            if (kh == 1) {
#pragma unroll
                for (int b = 0; b < 8; ++b) red[b * 256 + col] = acc[b]; }
            __syncthreads();
            if (kh == 0) { const int n = nb * 256 + col; const float bias = (kc == 0) ? p.b_ada[n] : 0.f;
#pragma unroll
                for (int b = 0; b < 8; ++b) modp[(size_t)(kc * 8 + b) * 6144 + n] = acc[b] + red[b * 256 + col] + bias; }
            __syncthreads();
        }
    }
    LAS float* scr = (LAS float*)(lds + 16384 + wave * 8448);
    const int gw = blockIdx.x * NWAVES + wave, NGW = G * NWAVES;
    bf16* WinT = (bf16*)(ws + WS_WIN); bf16* WoutT = (bf16*)(ws + WS_WOUT); bf16* WqT = (bf16*)(ws + WS_WQ);
    bf16* LruB = (bf16*)(ws + WS_LRUB); bf16* SubK = (bf16*)(ws + WS_SUBK);
    constexpr int I_IN = 16 * (NPAD / 32), I_OUT = 16 * 32, I_Q = 16 * 64, I_LRU = 16 * 8, I_SUB = 2048, I_TAB = 2 * 16384;
    constexpr int NIT = I_IN + I_OUT + I_Q + I_LRU + I_SUB + I_TAB;
    for (int it = gw; it < NIT; it += NGW) {
        int r = it;
        if (r < I_IN) { const int nb = r % (NPAD / 32), kb = r / (NPAD / 32), nq = nb * 32; int n0, nv;
            if (nq < 3072) { n0 = nq; nv = 32; } else if (nq < 7168) { n0 = nq + 16; nv = 32; } else if (nq == 7168) { n0 = 3072; nv = 16; } else { n0 = 0; nv = 0; }
            p0_transpose_item(p.w_in, 7184, kb * 64, n0, nv, WinT, 1024, nq, 0, scr, lane); continue; } r -= I_IN;
        if (r < I_OUT) { const int nb = r % 32, kb = r / 32; p0_transpose_item(p.w_out, 1024, kb * 64, nb * 32, 32, WoutT, 1024, nb * 32, 0, scr, lane); continue; } r -= I_OUT;
        if (r < I_Q) { const int nb = r % 64, kb = r / 64; p0_transpose_item(p.wq, 2048, kb * 64, nb * 32, 32, WqT, 1024, nb * 32, 0, scr, lane); continue; } r -= I_Q;
        if (r < I_LRU) {
            const int mat = r >> 3, sub = r & 7, g = mat >> 3, n = mat & 7, kb = sub >> 2, nb = sub & 3;
            const int np = n < 6 ? n : 6, half = n - np;
            const float* W = (g ? p.lwx : p.lwa) + (size_t)n * 128 * 128;
            bf16* dst = LruB + (size_t)n * 256 * 256;
            p0_transpose_item(W, 128, kb * 64, nb * 32, 32, dst, 256, g * 128 + nb * 32, half * 128, scr, lane);
            p0_transpose_item(W, 128, kb * 64, 0, 0, dst, 256, g * 128 + nb * 32, (1 - half) * 128, scr, lane);
            continue; } r -= I_LRU;
        if (r < I_SUB) {
            const int h = r >> 8, pp = (r >> 7) & 1, n = r & 127;
            const float* src = p.subk + (size_t)r * 128; bf16* dst = SubK + ((size_t)h * 256 + pp * 128 + n) * 256;
            const f32x2 v = *(const f32x2*)(src + 2 * lane);
            *(unsigned*)(dst + pp * 128 + 2 * lane) = pk2(v.x, v.y);
            *(unsigned*)(dst + (1 - pp) * 128 + 2 * lane) = 0u;
            continue; } r -= I_SUB;
        {
            const int tb = r >> 14, row = r & 16383;
            const float* src = (tb ? p.pv : p.pu) + (size_t)row * 1024 + lane * 16;
            f32x4 v[4]; float am = 0.f;
#pragma unroll
            for (int j = 0; j < 4; ++j) { v[j] = *(const f32x4*)(src + 4 * j); am = fmaxf(am, fmaxf(fmaxf(fabsf(v[j].x), fabsf(v[j].y)), fmaxf(fabsf(v[j].z), fabsf(v[j].w)))); }
#pragma unroll
            for (int o = 1; o < 64; o <<= 1) am = fmaxf(am, __shfl_xor(am, o));
            const float inv = am > 0.f ? 416.f / am : 0.f;
            u32x4 o;
            { int w = 0; w = __builtin_amdgcn_cvt_pk_fp8_f32(v[0].x * inv, v[0].y * inv, w, false); w = __builtin_amdgcn_cvt_pk_fp8_f32(v[0].z * inv, v[0].w * inv, w, true); o.x = (unsigned)w; }
            { int w = 0; w = __builtin_amdgcn_cvt_pk_fp8_f32(v[1].x * inv, v[1].y * inv, w, false); w = __builtin_amdgcn_cvt_pk_fp8_f32(v[1].z * inv, v[1].w * inv, w, true); o.y = (unsigned)w; }
            { int w = 0; w = __builtin_amdgcn_cvt_pk_fp8_f32(v[2].x * inv, v[2].y * inv, w, false); w = __builtin_amdgcn_cvt_pk_fp8_f32(v[2].z * inv, v[2].w * inv, w, true); o.z = (unsigned)w; }
            { int w = 0; w = __builtin_amdgcn_cvt_pk_fp8_f32(v[3].x * inv, v[3].y * inv, w, false); w = __builtin_amdgcn_cvt_pk_fp8_f32(v[3].z * inv, v[3].w * inv, w, true); o.w = (unsigned)w; }
            *(u32x4*)(ws + (tb ? WS_V : WS_U) + (size_t)row * 1024 + lane * 16) = o;
            if (lane == 0) ((float*)(ws + (tb ? WS_SV : WS_SU)))[row] = am * (1.f / 416.f);
        }
    }
}

__device__ __forceinline__ float mod_at(const float* modp, int b, int n) {
    float s = 0.f;
#pragma unroll
    for (int kc = 0; kc < 8; ++kc) s += modp[(size_t)(kc * 8 + b) * 6144 + n];
    return s;
}

__device__ __forceinline__ void phase1(const Params& p, LAS unsigned char* lds, int G) {
    const int tid = threadIdx.x, lane = tid & 63, wave = __builtin_amdgcn_readfirstlane(tid >> 6);
    const float* modp = (const float*)(p.ws + WS_MODP);
    LAS float* gs = (LAS float*)lds; LAS float* sh = gs + 1024;
    bf16* H = (bf16*)p.out;
    for (int tile = blockIdx.x; tile < T / 256; tile += G) {
        const int b = tile / 32;
        __syncthreads();
        for (int k = tid; k < 1024; k += NTHR) { gs[k] = p.npm[k] * (1.f + mod_at(modp, b, 1024 + k)); sh[k] = mod_at(modp, b, k); }
        __syncthreads();
        for (int rr = 0; rr < 32; ++rr) {
            const size_t row = (size_t)tile * 256 + wave * 32 + rr;
            const f32x4* xr = (const f32x4*)(p.x + row * 1024) + lane;
            f32x4 v[4]; float s = 0.f;
#pragma unroll
            for (int j = 0; j < 4; ++j) { v[j] = xr[64 * j]; s += (v[j].x * v[j].x + v[j].y * v[j].y) + (v[j].z * v[j].z + v[j].w * v[j].w); }
            const float rstd = 1.f / sqrtf(wave_sum(s) * (1.f / 1024.f) + 1e-6f);
            u32x2* o8 = (u32x2*)(H + row * 1024) + lane;
#pragma unroll
            for (int j = 0; j < 4; ++j) { const int k = 256 * j + 4 * lane; const f32x4 g4 = *(const LAS f32x4*)(gs + k), s4 = *(const LAS f32x4*)(sh + k);
                u32x2 w; w.x = pk2(v[j].x * rstd * g4.x + s4.x, v[j].y * rstd * g4.y + s4.y); w.y = pk2(v[j].z * rstd * g4.z + s4.z, v[j].w * rstd * g4.w + s4.w);
                o8[64 * j] = w; }
        }
    }
}

__device__ __forceinline__ void phase_conv(const Params& p, int G) {
    const int tid = threadIdx.x, lane = tid & 63, wave = __builtin_amdgcn_readfirstlane(tid >> 6);
    const int gw = blockIdx.x * NWAVES + wave, NGW = G * NWAVES;
    const bf16* XL = (const bf16*)(p.ws + WS_XLXG); bf16* XC = (bf16*)p.out;
    for (int it = gw; it < (T / 64) * 2; it += NGW) {
        const int rt = it >> 1, c0 = (it & 1) * 512 + lane * 8;
        float w[4][8], cb[8];
#pragma unroll
        for (int j = 0; j < 8; ++j) { cb[j] = p.conv_b[c0 + j];
#pragma unroll
            for (int q = 0; q < 4; ++q) w[q][j] = p.conv_w[q * 1024 + c0 + j]; }
        float x1[8], x2[8], x3[8];
        const int t0 = rt * 64; const bool first = (t0 % SEQ) == 0;
#pragma unroll
        for (int j = 0; j < 8; ++j) { x1[j] = 0.f; x2[j] = 0.f; x3[j] = 0.f; }
        if (!first) {
            const u32x4 a = *(const u32x4*)(XL + (size_t)(t0 - 1) * 2048 + c0), b = *(const u32x4*)(XL + (size_t)(t0 - 2) * 2048 + c0), c = *(const u32x4*)(XL + (size_t)(t0 - 3) * 2048 + c0);
            x1[0] = bflo(a.x); x1[1] = bfhi(a.x); x1[2] = bflo(a.y); x1[3] = bfhi(a.y); x1[4] = bflo(a.z); x1[5] = bfhi(a.z); x1[6] = bflo(a.w); x1[7] = bfhi(a.w);
            x2[0] = bflo(b.x); x2[1] = bfhi(b.x); x2[2] = bflo(b.y); x2[3] = bfhi(b.y); x2[4] = bflo(b.z); x2[5] = bfhi(b.z); x2[6] = bflo(b.w); x2[7] = bfhi(b.w);
            x3[0] = bflo(c.x); x3[1] = bfhi(c.x); x3[2] = bflo(c.y); x3[3] = bfhi(c.y); x3[4] = bflo(c.z); x3[5] = bfhi(c.z); x3[6] = bflo(c.w); x3[7] = bfhi(c.w);
        }
#pragma unroll 4
        for (int i = 0; i < 64; ++i) {
            const u32x4 a = *(const u32x4*)(XL + (size_t)(t0 + i) * 2048 + c0);
            float x0[8] = {bflo(a.x), bfhi(a.x), bflo(a.y), bfhi(a.y), bflo(a.z), bfhi(a.z), bflo(a.w), bfhi(a.w)};
            float o[8];
#pragma unroll
            for (int j = 0; j < 8; ++j) { o[j] = cb[j] + w[0][j] * x3[j] + w[1][j] * x2[j] + w[2][j] * x1[j] + w[3][j] * x0[j]; x3[j] = x2[j]; x2[j] = x1[j]; x1[j] = x0[j]; }
            u32x4 wv; wv.x = pk2(o[0], o[1]); wv.y = pk2(o[2], o[3]); wv.z = pk2(o[4], o[5]); wv.w = pk2(o[6], o[7]);
            *(u32x4*)(XC + (size_t)(t0 + i) * 1024 + c0) = wv;
        }
    }
}

template <bool FINAL>
__device__ __forceinline__ void phase_lru_scan(const Params& p, int G) {
    const int tid = threadIdx.x;
    const bf16* LA = (const bf16*)(p.ws + WS_XLXG); const bf16* U = (const bf16*)p.out;
    const bf16* XG = (const bf16*)(p.ws + WS_XLXG) + 1024; bf16* GB = (bf16*)(p.ws + WS_GAGB) + 1024;
    f32x2* car = (f32x2*)(p.ws + WS_LRUC);
    for (int it = blockIdx.x; it < 8 * 32 * 2; it += G) {
        const int cg_ = it & 1, j = (it >> 1) & 31, b = it >> 6, ch = cg_ * 512 + tid;
        const size_t t0 = (size_t)b * SEQ + j * 256;
        if (!FINAL) {
            float h = 0.f, ls = 0.f;
#pragma unroll 8
            for (int i = 0; i < 256; ++i) { const float la = bf2f(LA[(t0 + i) * 2048 + ch]), u = bf2f(U[(t0 + i) * 1024 + ch]);
                h = __expf(la) * h + u; ls += la; }
            car[(size_t)(b * 32 + j) * 1024 + ch] = (f32x2){__expf(ls), h};
        } else {
            float h = 0.f;
            for (int i = 0; i < j; ++i) { const f32x2 c = car[(size_t)(b * 32 + i) * 1024 + ch]; h = c.x * h + c.y; }
#pragma unroll 8
            for (int i = 0; i < 256; ++i) { const float la = bf2f(LA[(t0 + i) * 2048 + ch]), u = bf2f(U[(t0 + i) * 1024 + ch]);
                h = __expf(la) * h + u;
                const float xg = bf2f(XG[(t0 + i) * 2048 + ch]), gb = bf2f(GB[(t0 + i) * 2048 + ch]);
                GB[(t0 + i) * 2048 + ch] = (bf16)f2bf(h * gelu_f(xg) * sigmoid_f(gb)); }
        }
    }
}

typedef short bf16x8_t __attribute__((ext_vector_type(8)));
__device__ __forceinline__ void phase_gla_prep(const Params& p, LAS unsigned char* lds, int G) {
    const int tid = threadIdx.x;
    LAS float* segt = (LAS float*)lds;
    bf16* QKV = (bf16*)(p.ws + WS_QKV); const bf16* AL = (const bf16*)(p.ws + WS_ALOW); float* DK = (float*)(p.ws + WS_DK);
    const int kp = tid & 127, seg = tid >> 7;
    for (int it = blockIdx.x; it < 8 * 128 * 4; it += G) {
        const int h = it & 3, ch = (it >> 2) & 127, b = it >> 9;
        float wa[16];
#pragma unroll
        for (int r = 0; r < 16; ++r) wa[r] = p.w_alpha[r * 512 + h * 128 + kp];
        const float balpha = p.b_alpha[h * 128 + kp];
        const size_t t0 = (size_t)b * SEQ + ch * 64 + seg * 16;
        float qv[16], kv[16];
#pragma unroll
        for (int i = 0; i < 16; ++i) { qv[i] = bf2f(QKV[(t0 + i) * 2048 + h * 128 + kp]); kv[i] = bf2f(QKV[(t0 + i) * 2048 + 512 + h * 128 + kp]); }
        float cl[16]; float run = 0.f;
#pragma unroll
        for (int i = 0; i < 16; ++i) { const size_t t = t0 + i;
            const u32x4 a0 = *(const u32x4*)(AL + t * 16), a1 = *(const u32x4*)(AL + t * 16 + 8);
            float z = balpha;
            z += bflo(a0.x) * wa[0] + bfhi(a0.x) * wa[1] + bflo(a0.y) * wa[2] + bfhi(a0.y) * wa[3] + bflo(a0.z) * wa[4] + bfhi(a0.z) * wa[5] + bflo(a0.w) * wa[6] + bfhi(a0.w) * wa[7];
            z += bflo(a1.x) * wa[8] + bfhi(a1.x) * wa[9] + bflo(a1.y) * wa[10] + bfhi(a1.y) * wa[11] + bflo(a1.z) * wa[12] + bfhi(a1.z) * wa[13] + bflo(a1.w) * wa[14] + bfhi(a1.w) * wa[15];
            const float ls = fminf(z, 0.f) - __logf(1.f + __expf(-fabsf(z)));
            run += ls * (1.f / 16.f); cl[i] = run; }
        __syncthreads();
        segt[seg * 128 + kp] = run;
        __syncthreads();
        float off = 0.f, tot = 0.f;
#pragma unroll
        for (int s = 0; s < 4; ++s) { const float v = segt[s * 128 + kp]; tot += v; if (s < seg) off += v; }
        if (seg == 0) DK[(size_t)(b * 128 + ch) * 512 + h * 128 + kp] = __expf(tot);
#pragma unroll
        for (int i = 0; i < 16; ++i) { const float cum = cl[i] + off;
            QKV[(t0 + i) * 2048 + h * 128 + kp] = (bf16)f2bf(qv[i] * 0.08838834764831845f * __expf(cum));
            QKV[(t0 + i) * 2048 + 512 + h * 128 + kp] = (bf16)f2bf(kv[i] * __expf(-cum)); }
    }
}
__device__ __forceinline__ void phase_gla_seq(const Params& p, LAS unsigned char* lds, int G) {
    const int tid = threadIdx.x, lane = tid & 63, wave = __builtin_amdgcn_readfirstlane(tid >> 6), q4 = lane >> 4, c16 = lane & 15;
    constexpr int PQ = 136, PS = 72;
    LAS bf16* Qs = (LAS bf16*)lds;
    LAS bf16* Kd = Qs + 64 * PQ;
    LAS bf16* KdT = Kd + 64 * PQ;
    LAS bf16* VT = KdT + 128 * PS;
    LAS bf16* Pm = VT + 32 * PS;
    LAS bf16* ST = Pm + 64 * PS;
    LAS float* dk = (LAS float*)(ST + 32 * PQ);
    const bf16* QKV = (const bf16*)(p.ws + WS_QKV); bf16* VO = (bf16*)(p.ws + WS_QKV); const float* DK = (const float*)(p.ws + WS_DK);
    const int kp = tid & 127, seg = tid >> 7;
    const int vv = tid & 31, sg = tid >> 5;
    const int r0 = tid >> 4, cc = (tid & 15) * 8;
    for (int it = blockIdx.x; it < 8 * 4 * 8; it += G) {
        const int v8 = it & 7, h = (it >> 3) & 3, b = it >> 5;
        pg8::f32x4 sacc[2] = {(pg8::f32x4){0.f, 0.f, 0.f, 0.f}, (pg8::f32x4){0.f, 0.f, 0.f, 0.f}};
        __syncthreads();
        for (int i = tid; i < 32 * PQ / 2; i += NTHR) ((LAS unsigned*)ST)[i] = 0u;
        u32x4 rq[2], rk[2]; unsigned rkt[8], rv[2]; float rdk = 0.f;
#define GLA_LOAD(chn) do { const size_t _t0 = (size_t)b * SEQ + (size_t)(chn) * 64; \
            _Pragma("unroll") for (int _j = 0; _j < 2; ++_j) { rq[_j] = *(const u32x4*)(QKV + (_t0 + r0 + 32 * _j) * 2048 + h * 128 + cc); rk[_j] = *(const u32x4*)(QKV + (_t0 + r0 + 32 * _j) * 2048 + 512 + h * 128 + cc); } \
            _Pragma("unroll") for (int _i = 0; _i < 8; ++_i) { const unsigned _lo = QKV[(_t0 + seg * 16 + 2 * _i) * 2048 + 512 + h * 128 + kp], _hi = QKV[(_t0 + seg * 16 + 2 * _i + 1) * 2048 + 512 + h * 128 + kp]; rkt[_i] = _lo | (_hi << 16); } \
            _Pragma("unroll") for (int _i = 0; _i < 2; ++_i) { const unsigned _lo = QKV[(_t0 + sg * 4 + 2 * _i) * 2048 + 1024 + h * 256 + v8 * 32 + vv], _hi = QKV[(_t0 + sg * 4 + 2 * _i + 1) * 2048 + 1024 + h * 256 + v8 * 32 + vv]; rv[_i] = _lo | (_hi << 16); } \
            if (tid < 128) rdk = DK[(size_t)(b * 128 + (chn)) * 512 + h * 128 + tid]; } while (0)
        GLA_LOAD(0);
#pragma unroll 1
        for (int ch = 0; ch < SEQ / 64; ++ch) {
            const size_t t0 = (size_t)b * SEQ + ch * 64;
#pragma unroll
            for (int j = 0; j < 2; ++j) { *(LAS u32x4*)(Qs + (r0 + 32 * j) * PQ + cc) = rq[j]; *(LAS u32x4*)(Kd + (r0 + 32 * j) * PQ + cc) = rk[j]; }
            *(LAS u32x4*)(KdT + kp * PS + seg * 16) = (u32x4){rkt[0], rkt[1], rkt[2], rkt[3]};
            *(LAS u32x4*)(KdT + kp * PS + seg * 16 + 8) = (u32x4){rkt[4], rkt[5], rkt[6], rkt[7]};
            *(LAS u32x2*)(VT + vv * PS + sg * 4) = (u32x2){rv[0], rv[1]};
            if (tid < 128) dk[tid] = rdk;
            if (ch + 1 < SEQ / 64) GLA_LOAD(ch + 1);
            __syncthreads();
            { const int tt = wave & 3;
#pragma unroll
              for (int i2 = 0; i2 < 2; ++i2) { const int ts = (wave >> 2) * 2 + i2;
                  pg8::f32x4 acc = (pg8::f32x4){0.f, 0.f, 0.f, 0.f};
                  if (ts <= tt) {
#pragma unroll
                      for (int ks = 0; ks < 4; ++ks) { const bf16x8_t a = *(const LAS bf16x8_t*)(Kd + (ts * 16 + c16) * PQ + ks * 32 + q4 * 8), bb = *(const LAS bf16x8_t*)(Qs + (tt * 16 + c16) * PQ + ks * 32 + q4 * 8);
                          acc = __builtin_amdgcn_mfma_f32_16x16x32_bf16(a, bb, acc, 0, 0, 0); }
                      const int tg = tt * 16 + c16, sgl = ts * 16 + q4 * 4;
#pragma unroll
                      for (int j = 0; j < 4; ++j) if (sgl + j > tg) acc[j] = 0.f;
                  }
                  *(LAS u32x2*)(Pm + (tt * 16 + c16) * PS + ts * 16 + q4 * 4) = (u32x2){pk2(acc[0], acc[1]), pk2(acc[2], acc[3])}; } }
            __syncthreads();
            { const int tt = wave & 3, tv = wave >> 2;
              pg8::f32x4 oacc = (pg8::f32x4){0.f, 0.f, 0.f, 0.f};
#pragma unroll
              for (int ks = 0; ks < 2; ++ks) { const bf16x8_t bb = *(const LAS bf16x8_t*)(Pm + (tt * 16 + c16) * PS + ks * 32 + q4 * 8), a = *(const LAS bf16x8_t*)(VT + (tv * 16 + c16) * PS + ks * 32 + q4 * 8);
                  oacc = __builtin_amdgcn_mfma_f32_16x16x32_bf16(a, bb, oacc, 0, 0, 0); }
#pragma unroll
              for (int ks = 0; ks < 4; ++ks) { const bf16x8_t bb = *(const LAS bf16x8_t*)(Qs + (tt * 16 + c16) * PQ + ks * 32 + q4 * 8), a = *(const LAS bf16x8_t*)(ST + (tv * 16 + c16) * PQ + ks * 32 + q4 * 8);
                  oacc = __builtin_amdgcn_mfma_f32_16x16x32_bf16(a, bb, oacc, 0, 0, 0); }
              *(u32x2*)(VO + (t0 + tt * 16 + c16) * 2048 + 1024 + h * 256 + v8 * 32 + tv * 16 + q4 * 4) = (u32x2){pk2(oacc[0], oacc[1]), pk2(oacc[2], oacc[3])}; }
#pragma unroll
            for (int ks = 0; ks < 2; ++ks) { const bf16x8_t a = *(const LAS bf16x8_t*)(KdT + (wave * 16 + c16) * PS + ks * 32 + q4 * 8);
#pragma unroll
                for (int tv = 0; tv < 2; ++tv) { const bf16x8_t bb = *(const LAS bf16x8_t*)(VT + (tv * 16 + c16) * PS + ks * 32 + q4 * 8);
                    sacc[tv] = __builtin_amdgcn_mfma_f32_16x16x32_bf16(a, bb, sacc[tv], 0, 0, 0); } }
            { const pg8::f32x4 d4 = *(const LAS pg8::f32x4*)(dk + wave * 16 + q4 * 4);
#pragma unroll
              for (int tv = 0; tv < 2; ++tv) sacc[tv] = sacc[tv] * d4; }
            __syncthreads();
#pragma unroll
            for (int tv = 0; tv < 2; ++tv) *(LAS u32x2*)(ST + (tv * 16 + c16) * PQ + wave * 16 + q4 * 4) = (u32x2){pk2(sacc[tv][0], sacc[tv][1]), pk2(sacc[tv][2], sacc[tv][3])};
        }
#undef GLA_LOAD
    }
}

__device__ __forceinline__ void phase_gla_final(const Params& p, int G) {
    const int tid = threadIdx.x, lane = tid & 63, wave = __builtin_amdgcn_readfirstlane(tid >> 6);
    const int gw = blockIdx.x * NWAVES + wave, NGW = G * NWAVES;
    const bf16* O = (const bf16*)(p.ws + WS_QKV) + 1024; const bf16* R = (const bf16*)(p.ws + WS_R); bf16* GA = (bf16*)(p.ws + WS_GAGB);
    for (int row = gw; row < T; row += NGW) {
#pragma unroll
        for (int h = 0; h < 4; ++h) { const int c0 = h * 256 + lane * 4;
            const u32x2 ov = *(const u32x2*)(O + (size_t)row * 2048 + c0), rv = *(const u32x2*)(R + (size_t)row * 1024 + c0);
            const u32x2 gav = *(const u32x2*)(GA + (size_t)row * 2048 + c0), tv = *(const u32x2*)(GA + (size_t)row * 2048 + 1024 + c0);
            const float o[4] = {bflo(ov.x), bfhi(ov.x), bflo(ov.y), bfhi(ov.y)}, r[4] = {bflo(rv.x), bfhi(rv.x), bflo(rv.y), bfhi(rv.y)};
            const float ga[4] = {bflo(gav.x), bfhi(gav.x), bflo(gav.y), bfhi(gav.y)}, tm[4] = {bflo(tv.x), bfhi(tv.x), bflo(tv.y), bfhi(tv.y)};
            const float ss = wave_sum((o[0] * o[0] + o[1] * o[1]) + (o[2] * o[2] + o[3] * o[3]));
            const float rstd = 1.f / sqrtf(ss * (1.f / 256.f) + 1e-6f);
            const f32x4 gn = *(const f32x4*)(p.gla_norm + c0);
            float m[4];
#pragma unroll
            for (int j = 0; j < 4; ++j) m[j] = sigmoid_f(ga[j]) * (o[j] * rstd * gn[j] * silu_f(r[j])) + tm[j];
            u32x2 w; w.x = pk2(m[0], m[1]); w.y = pk2(m[2], m[3]);
            *(u32x2*)(GA + (size_t)row * 2048 + c0) = w; }
    }
}

__device__ __forceinline__ void phase_norm2(const Params& p, LAS unsigned char* lds, int G) {
    const int tid = threadIdx.x, lane = tid & 63, wave = __builtin_amdgcn_readfirstlane(tid >> 6);
    const float* modp = (const float*)(p.ws + WS_MODP);
    LAS float* g1 = (LAS float*)lds; LAS float* gs = g1 + 1024; LAS float* sh = gs + 1024;
    const bf16* Y = (const bf16*)(p.ws + WS_Y); bf16* H2 = (bf16*)(p.ws + WS_H2);
    for (int tile = blockIdx.x; tile < T / 256; tile += G) {
        const int b = tile / 32;
        __syncthreads();
        for (int k = tid; k < 1024; k += NTHR) { g1[k] = mod_at(modp, b, 2048 + k) * p.npo[k]; gs[k] = p.npf[k] * (1.f + mod_at(modp, b, 4096 + k)); sh[k] = mod_at(modp, b, 3072 + k); }
        __syncthreads();
        for (int rr = 0; rr < 32; ++rr) {
            const size_t row = (size_t)tile * 256 + wave * 32 + rr;
            const f32x4* xr = (const f32x4*)(p.x + row * 1024) + lane; const u32x2* yr = (const u32x2*)(Y + row * 1024) + lane;
            f32x4 xv[4], yv[4]; float s = 0.f;
#pragma unroll
            for (int j = 0; j < 4; ++j) { xv[j] = xr[64 * j]; const u32x2 yw = yr[64 * j]; yv[j] = (f32x4){bflo(yw.x), bfhi(yw.x), bflo(yw.y), bfhi(yw.y)};
                s += (yv[j].x * yv[j].x + yv[j].y * yv[j].y) + (yv[j].z * yv[j].z + yv[j].w * yv[j].w); }
            const float rstd = 1.f / sqrtf(wave_sum(s) * (1.f / 1024.f) + 1e-6f);
            float s2 = 0.f;
            f32x4* orow = (f32x4*)(p.out + row * 1024) + lane;
#pragma unroll
            for (int j = 0; j < 4; ++j) { const int k = 256 * j + 4 * lane; const f32x4 g4 = *(const LAS f32x4*)(g1 + k);
                xv[j] = xv[j] + yv[j] * rstd * g4; orow[64 * j] = xv[j];
                s2 += (xv[j].x * xv[j].x + xv[j].y * xv[j].y) + (xv[j].z * xv[j].z + xv[j].w * xv[j].w); }
            const float rstd2 = 1.f / sqrtf(wave_sum(s2) * (1.f / 1024.f) + 1e-6f);
            u32x2* o8 = (u32x2*)(H2 + row * 1024) + lane;
#pragma unroll
            for (int j = 0; j < 4; ++j) { const int k = 256 * j + 4 * lane; const f32x4 g4 = *(const LAS f32x4*)(gs + k), s4 = *(const LAS f32x4*)(sh + k);
                u32x2 w; w.x = pk2(xv[j].x * rstd2 * g4.x + s4.x, xv[j].y * rstd2 * g4.y + s4.y); w.y = pk2(xv[j].z * rstd2 * g4.z + s4.z, xv[j].w * rstd2 * g4.w + s4.w);
                o8[64 * j] = w; }
        }
    }
}

__device__ __forceinline__ unsigned h16_key(unsigned b) { return (b & 0x8000u) ? (~b & 0xffffu) : (b | 0x8000u); }
__device__ __forceinline__ float h16_key_val(unsigned s) { const unsigned b = (s & 0x8000u) ? (s & 0x7fffu) : (~s & 0xffffu); return (float)__builtin_bit_cast(_Float16, (unsigned short)b); }
#define INS16(top, x) do { _Pragma("unroll") for (int _j = 0; _j < 16; ++_j) { const unsigned _hi = max(top[_j], x), _lo = min(top[_j], x); top[_j] = _hi; x = _lo; } } while (0)
__device__ __forceinline__ void phase_topk(const Params& p, LAS unsigned char* lds, int G) {
    const int tid = threadIdx.x;
    const unsigned short* SC = (const unsigned short*)(p.ws + WS_SC); unsigned* TK = (unsigned*)(p.ws + WS_TOPK); float* TK2 = (float*)(p.ws + WS_TOPK2);
    const float* SU = (const float*)(p.ws + WS_SU); const float* SV = (const float*)(p.ws + WS_SV);
    LAS unsigned* my = (LAS unsigned*)lds + tid * 33;
    for (int blk = blockIdx.x; blk < T * 8 / NTHR; blk += G) {
        const int item = blk * NTHR + tid, t = item >> 3, h = item & 7;
        unsigned topA[16], topB[16];
#pragma unroll
        for (int j = 0; j < 16; ++j) { topA[j] = 0u; topB[j] = 0u; }
        const u32x4* src = (const u32x4*)(SC + (size_t)t * 2048 + h * 256);
#pragma unroll 1
        for (int c8 = 0; c8 < 16; ++c8) { const u32x4 w = src[c8];
            const unsigned ww[4] = {w.x, w.y, w.z, w.w};
#pragma unroll
            for (int q = 0; q < 4; ++q) { unsigned k0 = (h16_key(ww[q] & 0xffffu) << 16) | (unsigned)(127 - (c8 * 8 + q * 2)), k1 = (h16_key(ww[q] >> 16) << 16) | (unsigned)(127 - (c8 * 8 + q * 2 + 1));
                INS16(topA, k0); INS16(topA, k1); } }
#pragma unroll 1
        for (int c8 = 0; c8 < 16; ++c8) { const u32x4 w = src[16 + c8];
            const unsigned ww[4] = {w.x, w.y, w.z, w.w};
#pragma unroll
            for (int q = 0; q < 4; ++q) { unsigned k0 = (h16_key(ww[q] & 0xffffu) << 16) | (unsigned)(127 - (c8 * 8 + q * 2)), k1 = (h16_key(ww[q] >> 16) << 16) | (unsigned)(127 - (c8 * 8 + q * 2 + 1));
                INS16(topB, k0); INS16(topB, k1); } }
        float fa[16], fb[16];
#pragma unroll
        for (int j = 0; j < 16; ++j) { fa[j] = h16_key_val(topA[j] >> 16); fb[j] = h16_key_val(topB[j] >> 16); my[j] = 127u - (topA[j] & 127u); my[16 + j] = 127u - (topB[j] & 127u); }
        unsigned ct[16];
#pragma unroll
        for (int j = 0; j < 16; ++j) ct[j] = 0u;
#pragma unroll
        for (int i = 0; i < 16; ++i)
#pragma unroll
            for (int j = 0; j < 16; ++j) if ((i + 1) * (j + 1) <= 16) {
                const float s = fa[i] + fb[j]; unsigned u = __builtin_bit_cast(unsigned, s); u ^= (u >> 31) ? 0xffffffffu : 0x80000000u;
                unsigned key = (u & 0xffffff00u) | (unsigned)(255 - (i * 16 + j));
                INS16(ct, key); }
        float val[16], mx, sum = 0.f;
#pragma unroll
        for (int m = 0; m < 16; ++m) { unsigned u = ct[m] & 0xffffff00u; u ^= (u >> 31) ? 0x80000000u : 0xffffffffu; val[m] = __builtin_bit_cast(float, u); }
        mx = val[0];
#pragma unroll
        for (int m = 0; m < 16; ++m) { val[m] = __expf(val[m] - mx); sum += val[m]; }
        const float inv = 1.f / sum;
        LDS_WAIT();
        unsigned outw[16]; float outs[16];
#pragma unroll
        for (int m = 0; m < 16; ++m) { const unsigned pos = 255u - (ct[m] & 255u), i = pos >> 4, j = pos & 15u;
            const unsigned e = my[i] * 128u + my[16 + j];
            outw[m] = (e << 16) | f2bf(val[m] * inv * SV[e]); outs[m] = SU[e]; }
        u32x4* dst = (u32x4*)(TK + (size_t)item * 16); f32x4* dst2 = (f32x4*)(TK2 + (size_t)item * 16);
#pragma unroll
        for (int q = 0; q < 4; ++q) { dst[q] = (u32x4){outw[4 * q], outw[4 * q + 1], outw[4 * q + 2], outw[4 * q + 3]}; dst2[q] = (f32x4){outs[4 * q], outs[4 * q + 1], outs[4 * q + 2], outs[4 * q + 3]}; }
    }
}

__device__ __forceinline__ f32x2 fp8lo(unsigned w) { return __builtin_amdgcn_cvt_pk_f32_fp8((int)w, false); }
__device__ __forceinline__ f32x2 fp8hi(unsigned w) { return __builtin_amdgcn_cvt_pk_f32_fp8((int)w, true); }
__device__ __forceinline__ float rdlane(float v, int l) { return __builtin_bit_cast(float, __builtin_amdgcn_readlane(__builtin_bit_cast(int, v), l)); }
__device__ __forceinline__ void phase_gather(const Params& p, LAS unsigned char* lds, int G) {
    const int tid = threadIdx.x, lane = tid & 63, wave = __builtin_amdgcn_readfirstlane(tid >> 6);
    const float* modp = (const float*)(p.ws + WS_MODP);
    LAS float* g2 = (LAS float*)lds;
    const bf16* H2 = (const bf16*)(p.ws + WS_H2); const unsigned* TK = (const unsigned*)(p.ws + WS_TOPK); const float* TK2 = (const float*)(p.ws + WS_TOPK2);
    const unsigned char* U8 = p.ws + WS_U; const unsigned char* V8 = p.ws + WS_V;
    for (int tile = blockIdx.x; tile < T / 256; tile += G) {
        const int b = tile / 32;
        __syncthreads();
        for (int k = tid; k < 1024; k += NTHR) g2[k] = mod_at(modp, b, 5120 + k) * p.npof[k];
        __syncthreads();
#pragma unroll 1
        for (int rr = 0; rr < 32; ++rr) {
            const size_t row = (size_t)tile * 256 + wave * 32 + rr;
            f32x2 xt[8];
            { const u32x4 a = *(const u32x4*)(H2 + row * 1024 + lane * 16), c = *(const u32x4*)(H2 + row * 1024 + lane * 16 + 8);
              xt[0] = (f32x2){bflo(a.x), bfhi(a.x)}; xt[1] = (f32x2){bflo(a.y), bfhi(a.y)}; xt[2] = (f32x2){bflo(a.z), bfhi(a.z)}; xt[3] = (f32x2){bflo(a.w), bfhi(a.w)};
              xt[4] = (f32x2){bflo(c.x), bfhi(c.x)}; xt[5] = (f32x2){bflo(c.y), bfhi(c.y)}; xt[6] = (f32x2){bflo(c.z), bfhi(c.z)}; xt[7] = (f32x2){bflo(c.w), bfhi(c.w)}; }
            f32x2 acc[8];
#pragma unroll
            for (int j = 0; j < 8; ++j) acc[j] = (f32x2){0.f, 0.f};
#pragma unroll 1
            for (int h = 0; h < 8; ++h) {
                const u32x4* ra = (const u32x4*)(TK + row * 128 + h * 16);
                const u32x4 w0 = ra[0], w1 = ra[1], w2 = ra[2], w3 = ra[3];
                const unsigned ww[16] = {w0.x, w0.y, w0.z, w0.w, w1.x, w1.y, w1.z, w1.w, w2.x, w2.y, w2.z, w2.w, w3.x, w3.y, w3.z, w3.w};
                u32x4 ur[16], vr[16];
#pragma unroll
                for (int m = 0; m < 16; ++m) { const size_t eo = (size_t)((unsigned)__builtin_amdgcn_readfirstlane((int)ww[m]) >> 16) * 1024 + lane * 16;
                    ur[m] = *(const u32x4*)(U8 + eo); vr[m] = *(const u32x4*)(V8 + eo); }
                const unsigned wa = TK[row * 128 + h * 16 + (lane >> 2)]; const float su = TK2[row * 128 + h * 16 + (lane >> 2)];
                float pd[16];
#pragma unroll
                for (int m = 0; m < 16; ++m) {
                    f32x2 s = xt[0] * fp8lo(ur[m].x);
                    s += xt[1] * fp8hi(ur[m].x); s += xt[2] * fp8lo(ur[m].y); s += xt[3] * fp8hi(ur[m].y);
                    s += xt[4] * fp8lo(ur[m].z); s += xt[5] * fp8hi(ur[m].z); s += xt[6] * fp8lo(ur[m].w); s += xt[7] * fp8hi(ur[m].w);
                    pd[m] = s.x + s.y; }
#pragma unroll
                for (int j = 0; j < 8; ++j) { const bool up = (lane & 32) != 0; const float keep = up ? pd[j + 8] : pd[j], send = up ? pd[j] : pd[j + 8]; pd[j] = keep + __shfl_xor(send, 32); }
#pragma unroll
                for (int j = 0; j < 4; ++j) { const bool up = (lane & 16) != 0; const float keep = up ? pd[j + 4] : pd[j], send = up ? pd[j] : pd[j + 4]; pd[j] = keep + __shfl_xor(send, 16); }
#pragma unroll
                for (int j = 0; j < 2; ++j) { const bool up = (lane & 8) != 0; const float keep = up ? pd[j + 2] : pd[j], send = up ? pd[j] : pd[j + 2]; pd[j] = keep + __shfl_xor(send, 8); }
                { const bool up = (lane & 4) != 0; const float keep = up ? pd[1] : pd[0], send = up ? pd[0] : pd[1]; pd[0] = keep + __shfl_xor(send, 4); }
                float d = pd[0]; d += __shfl_xor(d, 2); d += __shfl_xor(d, 1);
                const float coef = bflo(wa) * gelu_f(su * d);
#pragma unroll
                for (int m = 0; m < 16; ++m) { const float cm = rdlane(coef, 4 * m); const f32x2 c2 = (f32x2){cm, cm};
                    acc[0] += c2 * fp8lo(vr[m].x); acc[1] += c2 * fp8hi(vr[m].x); acc[2] += c2 * fp8lo(vr[m].y); acc[3] += c2 * fp8hi(vr[m].y);
                    acc[4] += c2 * fp8lo(vr[m].z); acc[5] += c2 * fp8hi(vr[m].z); acc[6] += c2 * fp8lo(vr[m].w); acc[7] += c2 * fp8hi(vr[m].w); }
            }
            float s = 0.f;
#pragma unroll
            for (int j = 0; j < 8; ++j) s += acc[j].x * acc[j].x + acc[j].y * acc[j].y;
            const float rstd = 1.f / sqrtf(wave_sum(s) * (1.f / 1024.f) + 1e-6f);
            float* orow = p.out + row * 1024 + lane * 16;
#pragma unroll
            for (int q = 0; q < 4; ++q) { f32x4 o = *(const f32x4*)(orow + 4 * q); const f32x4 ga = *(const LAS f32x4*)(g2 + lane * 16 + 4 * q);
                o.x += ga.x * acc[2 * q].x * rstd; o.y += ga.y * acc[2 * q].y * rstd; o.z += ga.z * acc[2 * q + 1].x * rstd; o.w += ga.w * acc[2 * q + 1].y * rstd;
                *(f32x4*)(orow + 4 * q) = o; }
        }
    }
}

#define XB_TMO      128
#define XB_XCNT(j)  (256  + 64 * (j))
#define XB_XSUB(j)  (1280 + 64 * (j))
#define XB_XGEN(j)  (2304 + 64 * (j))
#define XB_TOP      3328
#define XB_TOPGEN   3392
#define XCD_BAR_WORDS 3456
#define XB_SPIN_CAP (1u << 18)

__device__ __forceinline__ unsigned xb_ld(unsigned* p)              { return __hip_atomic_load(p, __ATOMIC_RELAXED, __HIP_MEMORY_SCOPE_AGENT); }
__device__ __forceinline__ unsigned xb_add(unsigned* p, unsigned v) { return __hip_atomic_fetch_add(p, v, __ATOMIC_RELAXED, __HIP_MEMORY_SCOPE_AGENT); }
__device__ __forceinline__ unsigned xb_xcc_id() { return (unsigned)__builtin_amdgcn_s_getreg((3 << 11) | 20) & 0xFu; }
#define XB_SPIN(cond, bar) do { unsigned _sp = 0; while (cond) { __builtin_amdgcn_s_sleep(1); \
    if ((++_sp & 255u) == 0u) { if (xb_ld(&(bar)[XB_TMO])) break; if (_sp > XB_SPIN_CAP) { atomicAdd(&(bar)[XB_TMO], 1u); break; } } } } while (0)

struct XcdBarrier {
    unsigned* bar; unsigned x;
    volatile LAS unsigned* st;
};

__device__ __forceinline__ XcdBarrier xcd_barrier_post(unsigned* bar, volatile LAS unsigned* st) {
    XcdBarrier b; b.bar = bar; b.x = xb_xcc_id(); b.st = st;
    if (threadIdx.x == 0) (void)xb_add(&bar[XB_XCNT(b.x)], 1u);
    return b;
}
__device__ __forceinline__ void xcd_barrier_complete(unsigned* bar, unsigned x, unsigned& nloc, unsigned& nx) {
    const unsigned G = gridDim.x * gridDim.y * gridDim.z;
    unsigned sum, cnt, mine, sp = 0u;
    for (;;) {
        sum = 0u; cnt = 0u; mine = 0u;
#pragma unroll
        for (unsigned j = 0; j < 16; ++j) { const unsigned c = xb_ld(&bar[XB_XCNT(j)]); sum += c; cnt += (c > 0u) ? 1u : 0u; mine = (j == x) ? c : mine; }
        if (sum == G) break;
        __builtin_amdgcn_s_sleep(1);
        if ((++sp & 255u) == 0u) { if (xb_ld(&bar[XB_TMO])) break; if (sp > XB_SPIN_CAP) { atomicAdd(&bar[XB_TMO], 1u); break; } }
    }
    nloc = mine > 0u ? mine : 1u; nx = cnt > 0u ? cnt : 1u;
}

__device__ __forceinline__ void xcd_barrier(const XcdBarrier& b) {
    asm volatile("s_waitcnt vmcnt(0)" ::: "memory");
    __syncthreads();
    if (threadIdx.x == 0) {
        unsigned* bar = b.bar;
        __builtin_amdgcn_s_waitcnt(0);
        unsigned nloc = b.st[0], nx = b.st[1];
        if (nloc == 0u) { xcd_barrier_complete(bar, b.x, nloc, nx); b.st[0] = nloc; b.st[1] = nx; }
        const unsigned old = xb_add(&bar[XB_XSUB(b.x)], 1u);
        const unsigned gen = old / nloc;
        if (old + 1u == (gen + 1u) * nloc) {
            __builtin_amdgcn_fence(__ATOMIC_RELEASE, "agent");
            asm volatile("s_waitcnt vmcnt(0)" ::: "memory");
            const unsigned og = xb_add(&bar[XB_TOP], 1u);
            const unsigned tg = og / nx;
            if (og + 1u == (tg + 1u) * nx) xb_add(&bar[XB_TOPGEN], 1u);
            else XB_SPIN(xb_ld(&bar[XB_TOPGEN]) == tg, bar);
            __builtin_amdgcn_fence(__ATOMIC_ACQUIRE, "agent");
            xb_add(&bar[XB_XGEN(b.x)], 1u);
            asm volatile("s_waitcnt vmcnt(0)" ::: "memory");
        } else {
            XB_SPIN(xb_ld(&bar[XB_XGEN(b.x)]) == gen, bar);
            __builtin_amdgcn_fence(__ATOMIC_ACQUIRE, "agent");
            asm volatile("s_waitcnt vmcnt(0)" ::: "memory");
        }
    }
    __syncthreads();
}


template <int PH>
__device__ __forceinline__ void run_phase(const Params& p, LAS unsigned char* lds, int G) {
    unsigned char* ws = p.ws;
    if constexpr (PH == 0) phase0(p, lds, G);
    else if constexpr (PH == 1) phase1(p, lds, G);
    else if constexpr (PH == 2) { pg8::Gemm g{(const bf16*)p.out, (const bf16*)(ws + WS_WIN), T, NPAD, 1024, 1024}; pg8::StaticOrder S; S.init(T, NPAD, G, (int)blockIdx.x);
        EpiSeg E{ws}; pg8::gemm_phase<EpiSeg, pg8::StaticOrder, true, true, 0, 1024, 1024>(lds, g, S, E); }
    else if constexpr (PH == 3) phase_gla_prep(p, lds, G);
    else if constexpr (PH == 4) phase_gla_seq(p, lds, G);
    else if constexpr (PH == 5) phase_conv(p, G);
    else if constexpr (PH == 6) { pg8::Gemm g{(const bf16*)p.out, (const bf16*)(ws + WS_LRUB), T, 2048, 256, 1024}; pg8::StaticOrder S; S.init(T, 2048, G, (int)blockIdx.x);
        EpiLru E{(bf16*)(ws + WS_XLXG), (bf16*)p.out, p.lba, p.lbx, p.lam}; pg8::gemm_phase<EpiLru, pg8::StaticOrder, true, true, 1, 256, 1024>(lds, g, S, E); }
    else if constexpr (PH == 7) phase_lru_scan<false>(p, G);
    else if constexpr (PH == 8) phase_lru_scan<true>(p, G);
    else if constexpr (PH == 9) phase_gla_final(p, G);
    else if constexpr (PH == 10) { pg8::Gemm g{(const bf16*)(ws + WS_GAGB), (const bf16*)(ws + WS_WOUT), T, 1024, 1024, 2048}; pg8::StaticOrder S; S.init(T, 1024, G, (int)blockIdx.x);
        EpiPlain E{(bf16*)(ws + WS_Y), 1024}; pg8::gemm_phase<EpiPlain, pg8::StaticOrder, true, true, 0, 1024, 2048>(lds, g, S, E); }
    else if constexpr (PH == 11) phase_norm2(p, lds, G);
    else if constexpr (PH == 12) { pg8::Gemm g{(const bf16*)(ws + WS_H2), (const bf16*)(ws + WS_WQ), T, 2048, 1024, 1024}; pg8::StaticOrder S; S.init(T, 2048, G, (int)blockIdx.x);
        EpiPlain E{(bf16*)(ws + WS_QRY), 2048}; pg8::gemm_phase<EpiPlain, pg8::StaticOrder, true, true, 0, 1024, 1024>(lds, g, S, E); }
    else if constexpr (PH == 13) { pg8::Gemm g{(const bf16*)(ws + WS_QRY), (const bf16*)(ws + WS_SUBK), T, 2048, 256, 2048}; pg8::StaticOrder S; S.init(T, 2048, G, (int)blockIdx.x);
        EpiF16 E{(unsigned short*)(ws + WS_SC), 2048}; pg8::gemm_phase<EpiF16, pg8::StaticOrder, true, true, 2, 256, 2048>(lds, g, S, E); }
    else if constexpr (PH == 14) phase_topk(p, lds, G);
    else if constexpr (PH == 15) phase_gather(p, lds, G);
}
template <int PH>
__global__ void __launch_bounds__(NTHR, 2) k_phase(Params p) {
    extern __shared__ __attribute__((aligned(16))) unsigned char lds_raw[];
    run_phase<PH>(p, (LAS unsigned char*)lds_raw, (int)gridDim.x);
}
constexpr int LDS_BAR_OFF = LDS_BYTES - 16;
template <int PH>
__device__ __forceinline__ void run_from(const Params& p, LAS unsigned char* lds, int G, const XcdBarrier& bar) {
#if PROBE_PH >= 0
    unsigned long long pt0 = 0; if constexpr (PH == PROBE_PH) pt0 = __builtin_amdgcn_s_memrealtime();
#endif
    run_phase<PH>(p, lds, G);
    if constexpr (PH + 1 < N_PHASES) {
        if constexpr (PH == 0) cg::this_grid().sync();
        else xcd_barrier(bar);
    }
#if PROBE_PH >= 0
    if constexpr (PH == PROBE_PH) { const unsigned long long pt1 = __builtin_amdgcn_s_memrealtime(), span = pt1 - pt0;
        while (__builtin_amdgcn_s_memrealtime() - pt1 < (unsigned long long)PROBE_MULT * span) __builtin_amdgcn_s_sleep(8); }
#endif
    if constexpr (PH + 1 < N_PHASES) run_from<PH + 1>(p, lds, G, bar);
}
__global__ void __launch_bounds__(NTHR, 2) k_mega(Params p) {
    extern __shared__ __attribute__((aligned(16))) unsigned char lds_raw[];
    LAS unsigned char* lds = (LAS unsigned char*)lds_raw;
    if (threadIdx.x < 4) ((LAS unsigned*)(lds + LDS_BAR_OFF))[threadIdx.x] = 0u;
    __syncthreads();
    const XcdBarrier bar = xcd_barrier_post((unsigned*)(p.ws + WS_CTL), (volatile LAS unsigned*)(lds + LDS_BAR_OFF));
    run_from<0>(p, lds, (int)gridDim.x, bar);
}

extern "C" void kernel_launch(void* const* d_in, const int* in_sizes, int n_in, void* d_out, int out_size, void* d_ws, size_t ws_size, hipStream_t stream) {
    static int grid = 0;
    if (grid == 0) {
        if (n_in != 24 || in_sizes[0] != T * DM || out_size != T * DM || ws_size < WS_END) {
            fprintf(stderr, "kernel_launch: unexpected shapes: n_in %d in0 %d out %d ws %zu\n", n_in, n_in > 0 ? in_sizes[0] : -1, out_size, ws_size); grid = -1; return; }
        int dev = 0, cus = 0, per_cu = 0;
        if (hipGetDevice(&dev) != hipSuccess || hipDeviceGetAttribute(&cus, hipDeviceAttributeMultiprocessorCount, dev) != hipSuccess) { grid = -1; return; }
        if (hipFuncSetAttribute((const void*)k_mega, hipFuncAttributeMaxDynamicSharedMemorySize, LDS_BYTES) != hipSuccess) { fprintf(stderr, "kernel_launch: hipFuncSetAttribute failed\n"); grid = -1; return; }
        if (hipOccupancyMaxActiveBlocksPerMultiprocessor(&per_cu, (const void*)k_mega, NTHR, LDS_BYTES) != hipSuccess || per_cu < 1) { fprintf(stderr, "kernel_launch: occupancy query says %d blocks per CU\n", per_cu); grid = -1; return; }
        (void)hipGetLastError();
        grid = cus;
    }
    if (grid < 0) return;
    Params p{};
    const float** pp = (const float**)&p;
    for (int i = 0; i < 24; ++i) pp[i] = (const float*)d_in[i];
    p.out = (float*)d_out; p.ws = (unsigned char*)d_ws;
    if (hipMemsetAsync((char*)d_ws + WS_CTL, 0, 65536, stream) != hipSuccess) { fprintf(stderr, "kernel_launch: hipMemsetAsync failed\n"); return; }
    void* args[] = {&p};
    hipError_t e = hipLaunchCooperativeKernel((const void*)k_mega, dim3(grid), dim3(NTHR), args, LDS_BYTES, stream);
    if (e != hipSuccess) fprintf(stderr, "kernel_launch: cooperative launch failed: %s (grid %d)\n", hipGetErrorString(e), grid);
}
```

```cpp
#include <hip/hip_runtime.h>
#include <hip/hip_cooperative_groups.h>
#include <cstdio>
#include <cstdint>
#include <utility>
namespace cg = cooperative_groups;

namespace pg8 {
#define PG8_LAS __attribute__((address_space(3)))
typedef unsigned short bf16_t;
typedef short bf16x8 __attribute__((ext_vector_type(8)));
typedef float f32x4 __attribute__((ext_vector_type(4)));
typedef unsigned u32x4 __attribute__((ext_vector_type(4)));
constexpr int BM = 256, BK = 64, HALF = 128, HTB = HALF * BK * 2  , STAGE_BYTES = 8 * HTB, NXCD = 8, WGM = 8;

__host__ __device__ __forceinline__ int lds_byte(int r, int c) { const int st = (r >> 4) * 2 + (c >> 5), rr = r & 15, cc = c & 31, ob = rr * 64 + cc * 2; return st * 1024 + (ob ^ (((ob >> 9) & 1) << 5)); }
__host__ __device__ __forceinline__ void stage_rc(int b, int& R, int& C) { const int st = b / 1024, sb = b % 1024, swz = sb ^ (((sb >> 9) & 1) << 5); R = (st >> 1) * 16 + swz / 64; C = (st & 1) * 32 + (swz % 64) / 2; }
__host__ __device__ __forceinline__ int perm32(int rho) { const int n = rho >> 4, i = rho & 15; return 8 * (i >> 2) + 4 * n + (i & 3); }

struct Unit { int pm, pn; };
struct Gemm { const bf16_t* A; const bf16_t* Bt; int M, N, K, lda; };
template <int AMODE> __device__ __forceinline__ size_t a_off_bytes(const Gemm& g, const Unit& u) {
    const int ac = AMODE == 0 ? 0 : (AMODE == 1 ? 128 * (u.pn < 6 ? u.pn : 6) : 256 * u.pn);
    return ((size_t)u.pm * BM * (size_t)g.lda + (size_t)ac) * 2;
}

struct StaticOrder {
    int nM, nN, nwg, G, c;
    __host__ __device__ void init(int M, int N, int G_, int c_) { nM = M / BM; nN = N / BM; nwg = nM * nN; G = G_; c = c_; }
    __host__ __device__ bool next(int i, Unit& u) const {
        const long L = (long)i * G + c; if (L >= nwg) return false;
        int wgid = (int)L; { const int q = nwg / NXCD, r = nwg % NXCD, xcd = wgid % NXCD, off = wgid / NXCD; wgid = (xcd < r ? xcd * (q + 1) : r * (q + 1) + (xcd - r) * q) + off; }
        const int nig = WGM * nN, gid = wgid / nig, fm = gid * WGM, gsz = (nM - fm) < WGM ? (nM - fm) : WGM;
        u.pm = fm + ((wgid % nig) % gsz); u.pn = (wgid % nig) / gsz; return true;
    }
    __device__ __forceinline__ void a_ready(const Unit&) const {}
    __device__ __forceinline__ void done(const Unit&) const {}
};

__device__ __forceinline__ unsigned cvt_pk_bf16(float lo, float hi) { unsigned r; asm volatile("v_cvt_pk_bf16_f32 %0, %1, %2" : "=v"(r) : "v"(lo), "v"(hi)); return r; }

template <class Epi, class Sched, bool ALIGN_EPI = false, bool SP2 = false, int AMODE = 0, int KC = 0, int LDAC = 0>
__device__ __forceinline__ void gemm_phase(PG8_LAS unsigned char* lds, const Gemm g, const Sched& S, const Epi& E) {
    const int tid = threadIdx.x, wid = __builtin_amdgcn_readfirstlane(tid >> 6), lane = tid & 63, wr = wid >> 2, wc = wid & 3, fr = lane & 15, fq = lane >> 4;
    const int K = KC ? KC : g.K, nt = K / BK; const int lda = LDAC ? LDAC : g.lda;
    unsigned voffA[2], voffB[2];
#pragma unroll
    for (int i = 0; i < 2; ++i) { int R, C; stage_rc(tid * 16 + i * 8192, R, C); const int Rb = Epi::PERM ? ((R & ~31) + perm32(R & 31)) : R;
        voffA[i] = (unsigned)(R * lda + C) * 2u; voffB[i] = (unsigned)(Rb * K + C) * 2u; }
    const size_t kstep = (size_t)(BK * 2);
    const size_t hstepA = (size_t)HALF * lda * 2;
    const size_t hstepB = (size_t)HALF * K * 2;
    const size_t tstepB = 2 * hstepB;
    const unsigned ldsw = (unsigned)wid * 1024u;
    const int aoff = lds_byte(wr * 64 + fr, fq * 8), boff = lds_byte(wc * 32 + fr, fq * 8);
#define PG8_SA(b, h) (((b) * 2 + (h)) * HTB)
#define PG8_SB(b, h) ((4 + (b) * 2 + (h)) * HTB)
#define PG8_STAGE(bufoff, gbase, voff) do { _Pragma("unroll") for (int _i = 0; _i < 2; ++_i) \
        __builtin_amdgcn_global_load_lds((const unsigned*)((const char*)(gbase) + (voff)[_i]), (PG8_LAS unsigned*)(lds + (bufoff) + ldsw + _i * 8192), 16, 0, 0); } while (0)
#define PG8_LDA(dst, b, h) do { _Pragma("unroll") for (int m = 0; m < 4; ++m) _Pragma("unroll") for (int k = 0; k < 2; ++k) dst[m][k] = *(const PG8_LAS bf16x8*)(lds + PG8_SA(b, h) + aoff + m * 2048 + k * 1024); } while (0)
#define PG8_LDB(dst, b, h) do { _Pragma("unroll") for (int n = 0; n < 2; ++n) _Pragma("unroll") for (int k = 0; k < 2; ++k) dst[n][k] = *(const PG8_LAS bf16x8*)(lds + PG8_SB(b, h) + boff + n * 2048 + k * 1024); } while (0)
#define PG8_MMA(ai, bj, At, Bt) do { __builtin_amdgcn_s_setprio(1); _Pragma("unroll") for (int m = 0; m < 4; ++m) _Pragma("unroll") for (int n = 0; n < 2; ++n) _Pragma("unroll") for (int k = 0; k < 2; ++k) \
        acc[ai][bj][m][n] = __builtin_amdgcn_mfma_f32_16x16x32_bf16(Bt[n][k], At[m][k], acc[ai][bj][m][n], 0, 0, 0); __builtin_amdgcn_s_setprio(0); } while (0)
#define PG8_WAIT_V(n) asm volatile("s_waitcnt vmcnt(" #n ")" ::: "memory")
#define PG8_WAIT_L(n) asm volatile("s_waitcnt lgkmcnt(" #n ")" ::: "memory")
#define PG8_BAR __builtin_amdgcn_s_barrier()
#define PG8_SCHED __builtin_amdgcn_sched_barrier(0)
    Unit cur, nxt; int ui = 0;
    if (!S.next(0, cur)) return;
    f32x4 acc[2][2][4][2];
#pragma unroll
    for (int a = 0; a < 2; ++a)
#pragma unroll
        for (int b = 0; b < 2; ++b)
#pragma unroll
            for (int m = 0; m < 4; ++m)
#pragma unroll
                for (int n = 0; n < 2; ++n) acc[a][b][m][n] = (f32x4){0.f, 0.f, 0.f, 0.f};
    bf16x8 At[4][2], B0[2][2], B1[2][2];
    const char* cA = (const char*)g.A + a_off_bytes<AMODE>(g, cur); const char* cB = (const char*)g.Bt + (size_t)cur.pn * tstepB;
    S.a_ready(cur);
    if constexpr (SP2) {
        PG8_STAGE(PG8_SB(0, 0), cB, voffB); PG8_STAGE(PG8_SB(0, 1), cB + hstepB, voffB); PG8_STAGE(PG8_SA(0, 0), cA, voffA); PG8_STAGE(PG8_SA(0, 1), cA + hstepA, voffA);
        if (wr == 1) PG8_BAR;
        PG8_WAIT_V(2); PG8_BAR;
        PG8_STAGE(PG8_SB(1, 0), cB + kstep, voffB); PG8_STAGE(PG8_SA(1, 0), cA + kstep, voffA); PG8_STAGE(PG8_SB(1, 1), cB + hstepB + kstep, voffB);
        PG8_WAIT_V(6); PG8_BAR;
    } else {
        PG8_STAGE(PG8_SB(0, 0), cB, voffB); PG8_STAGE(PG8_SA(0, 0), cA, voffA); PG8_STAGE(PG8_SB(0, 1), cB + hstepB, voffB); PG8_STAGE(PG8_SA(0, 1), cA + hstepA, voffA);
        if (wr == 1) PG8_BAR;
        PG8_WAIT_V(4); PG8_BAR;
        PG8_STAGE(PG8_SB(1, 0), cB + kstep, voffB); PG8_STAGE(PG8_SA(1, 0), cA + kstep, voffA); PG8_STAGE(PG8_SB(1, 1), cB + hstepB + kstep, voffB);
        PG8_WAIT_V(6); PG8_BAR;
    }
    for (;;) {
        const bool has_next = S.next(ui + 1, nxt);
        const char* nA = has_next ? (const char*)g.A + a_off_bytes<AMODE>(g, nxt) : cA; const char* nB = has_next ? (const char*)g.Bt + (size_t)nxt.pn * tstepB : cB;
#pragma unroll 1
        for (int t = 0; t < nt; t += 2) {
            const bool last = (t == nt - 2);
            const char* a1 = cA + (size_t)(t + 1) * kstep;
            const char* a2 = last ? nA : cA + (size_t)(t + 2) * kstep; const char* b2 = last ? nB : cB + (size_t)(t + 2) * kstep;
            const char* a3 = a2 + kstep; const char* b3 = b2 + kstep;
            if (last && has_next) S.a_ready(nxt);
            if constexpr (SP2) {
            PG8_LDB(B0, 0, 0); PG8_LDB(B1, 0, 1); PG8_SCHED; PG8_LDA(At, 0, 0); PG8_STAGE(PG8_SA(1, 1), a1 + hstepA, voffA);
            PG8_WAIT_V(8); PG8_WAIT_L(0); PG8_BAR; PG8_MMA(0, 0, At, B0); PG8_MMA(0, 1, At, B1); PG8_BAR; PG8_SCHED;
            PG8_LDA(At, 0, 1); PG8_STAGE(PG8_SB(0, 0), b2, voffB); PG8_STAGE(PG8_SB(0, 1), b2 + hstepB, voffB); PG8_STAGE(PG8_SA(0, 0), a2, voffA);
            PG8_WAIT_V(8); PG8_WAIT_L(0); PG8_BAR; PG8_MMA(1, 0, At, B0); PG8_MMA(1, 1, At, B1); PG8_BAR; PG8_SCHED;
            PG8_LDB(B0, 1, 0); PG8_LDB(B1, 1, 1); PG8_SCHED; PG8_LDA(At, 1, 0); PG8_STAGE(PG8_SA(0, 1), a2 + hstepA, voffA);
            PG8_WAIT_V(8); PG8_WAIT_L(0); PG8_BAR; PG8_MMA(0, 0, At, B0); PG8_MMA(0, 1, At, B1); PG8_BAR; PG8_SCHED;
            PG8_LDA(At, 1, 1); PG8_STAGE(PG8_SB(1, 0), b3, voffB); PG8_STAGE(PG8_SB(1, 1), b3 + hstepB, voffB); PG8_STAGE(PG8_SA(1, 0), a3, voffA);
            PG8_WAIT_V(8); PG8_WAIT_L(0); PG8_BAR; PG8_MMA(1, 0, At, B0); PG8_MMA(1, 1, At, B1); PG8_BAR; PG8_SCHED;
            } else {
            PG8_LDB(B0, 0, 0); PG8_SCHED; PG8_LDA(At, 0, 0); PG8_STAGE(PG8_SA(1, 1), a1 + hstepA, voffA);
            PG8_WAIT_L(8); PG8_BAR; PG8_WAIT_L(0); PG8_MMA(0, 0, At, B0); PG8_BAR; PG8_SCHED;
            PG8_LDB(B1, 0, 1); PG8_STAGE(PG8_SB(0, 0), b2, voffB);
            PG8_BAR; PG8_WAIT_L(0); PG8_MMA(0, 1, At, B1); PG8_BAR;
            PG8_LDA(At, 0, 1); PG8_STAGE(PG8_SA(0, 0), a2, voffA);
            PG8_BAR; PG8_WAIT_L(0); PG8_MMA(1, 0, At, B0); PG8_BAR; PG8_SCHED;
            PG8_STAGE(PG8_SB(0, 1), b2 + hstepB, voffB);
            PG8_WAIT_V(6); PG8_BAR; PG8_MMA(1, 1, At, B1); PG8_BAR;
            PG8_LDB(B0, 1, 0); PG8_SCHED; PG8_LDA(At, 1, 0); PG8_STAGE(PG8_SA(0, 1), a2 + hstepA, voffA);
            PG8_WAIT_L(8); PG8_BAR; PG8_WAIT_L(0); PG8_MMA(0, 0, At, B0); PG8_BAR; PG8_SCHED;
            PG8_LDB(B1, 1, 1); PG8_STAGE(PG8_SB(1, 0), b3, voffB);
            PG8_BAR; PG8_WAIT_L(0); PG8_MMA(0, 1, At, B1); PG8_BAR;
            PG8_LDA(At, 1, 1); PG8_STAGE(PG8_SA(1, 0), a3, voffA);
            PG8_BAR; PG8_WAIT_L(0); PG8_MMA(1, 0, At, B0); PG8_BAR; PG8_SCHED;
            PG8_STAGE(PG8_SB(1, 1), b3 + hstepB, voffB);
            PG8_WAIT_V(6); PG8_BAR; PG8_MMA(1, 1, At, B1); PG8_BAR;
            }
        }
        if constexpr (ALIGN_EPI) { if (wr == 0) PG8_BAR; }
        E(acc, cur, wr, wc, fr, fq); S.done(cur);
        if (!has_next) break;
#pragma unroll
        for (int a = 0; a < 2; ++a)
#pragma unroll
            for (int b = 0; b < 2; ++b)
#pragma unroll
                for (int m = 0; m < 4; ++m)
#pragma unroll
                    for (int n = 0; n < 2; ++n) acc[a][b][m][n] = (f32x4){0.f, 0.f, 0.f, 0.f};
        cur = nxt; cA = nA; cB = nB; ++ui;
        if constexpr (ALIGN_EPI) { if (wr == 1) PG8_BAR; }
    }
    PG8_WAIT_V(0);
    if constexpr (!ALIGN_EPI) { if (wr == 0) PG8_BAR; }
    PG8_BAR;
#undef PG8_SA
#undef PG8_SB
#undef PG8_STAGE
#undef PG8_LDA
#undef PG8_LDB
#undef PG8_MMA
#undef PG8_WAIT_V
#undef PG8_WAIT_L
#undef PG8_BAR
#undef PG8_SCHED
}
}

constexpr int NB = 8, SEQ = 8192, DM = 1024, T = NB * SEQ;
constexpr int NPAD = 7424;
constexpr int NWAVES = 8, NTHR = 512;
constexpr int LDS_BYTES = 147456;
constexpr int N_PHASES = 16;
#define PROBE_PH -1
#define PROBE_MULT 3

constexpr size_t MiB = 1ull << 20;
constexpr size_t WS_CTL = 0;
constexpr size_t WS_MODP = 1 * MiB;
constexpr size_t WS_WIN = 3 * MiB;
constexpr size_t WS_WOUT = 18 * MiB;
constexpr size_t WS_WQ = 20 * MiB;
constexpr size_t WS_LRUB = 24 * MiB;
constexpr size_t WS_SUBK = 25 * MiB;
constexpr size_t WS_LRUC = 26 * MiB;
constexpr size_t WS_U = 32 * MiB;
constexpr size_t WS_V = 48 * MiB;
constexpr size_t WS_SU = 64 * MiB;
constexpr size_t WS_SV = 65 * MiB;
constexpr size_t WS_DK = 66 * MiB;
constexpr size_t WS_QKV = 96 * MiB;
constexpr size_t WS_R = 352 * MiB;
constexpr size_t WS_XLXG = 480 * MiB;
constexpr size_t WS_GAGB = 736 * MiB;
constexpr size_t WS_ALOW = 992 * MiB;
constexpr size_t WS_END = 994 * MiB;
constexpr size_t WS_Y = WS_QKV;
constexpr size_t WS_H2 = WS_QKV + 128 * MiB;
constexpr size_t WS_QRY = WS_XLXG;
constexpr size_t WS_SC = WS_GAGB;
constexpr size_t WS_TOPK = WS_R;
constexpr size_t WS_TOPK2 = WS_R + 32 * MiB;

#define LAS __attribute__((address_space(3)))
typedef unsigned short bf16;
typedef float f32x4 __attribute__((ext_vector_type(4)));
typedef float f32x2 __attribute__((ext_vector_type(2)));
typedef unsigned u32x4 __attribute__((ext_vector_type(4)));
typedef unsigned u32x2 __attribute__((ext_vector_type(2)));

struct Params {
    const float *x, *c, *w_ada, *b_ada, *npm, *npo, *w_in, *w_alpha, *b_alpha, *gla_norm, *conv_w, *conv_b,
        *lwa, *lba, *lwx, *lbx, *lam, *w_out, *npf, *npof, *wq, *subk, *pu, *pv;
    float* out; unsigned char* ws;
    int ph_lo, ph_hi;
};

__device__ __forceinline__ unsigned f2bf(float f) { unsigned u = __builtin_bit_cast(unsigned, f); return (u + 0x7fffu + ((u >> 16) & 1u)) >> 16; }
__device__ __forceinline__ unsigned pk2(float lo, float hi) { return f2bf(lo) | (f2bf(hi) << 16); }
__device__ __forceinline__ float bflo(unsigned u) { return __builtin_bit_cast(float, u << 16); }
__device__ __forceinline__ float bfhi(unsigned u) { return __builtin_bit_cast(float, u & 0xffff0000u); }
__device__ __forceinline__ float bf2f(bf16 h) { return __builtin_bit_cast(float, (unsigned)h << 16); }
__device__ __forceinline__ float sigmoid_f(float x) { return 1.f / (1.f + __expf(-x)); }
__device__ __forceinline__ float silu_f(float x) { return x / (1.f + __expf(-x)); }
__device__ __forceinline__ float gelu_f(float x) { const float u = 0.7978845608028654f * (x + 0.044715f * x * x * x); return x / (1.f + __expf(-2.f * u)); }
__device__ __forceinline__ float softplus_f(float x) { return fmaxf(x, 0.f) + log1pf(__expf(-fabsf(x))); }
__device__ __forceinline__ float wave_sum(float v) {
#pragma unroll
    for (int o = 1; o < 64; o <<= 1) v += __shfl_xor(v, o);
    return v;
}
#define LDS_WAIT() asm volatile("s_waitcnt lgkmcnt(0)" ::: "memory")

struct EpiSeg {
    static constexpr bool PERM = true;
    unsigned char* ws;
    __device__ __forceinline__ void operator()(const pg8::f32x4 (&acc)[2][2][4][2], const pg8::Unit& u, int wr, int wc, int fr, int fq) const {
        const int pn = u.pn; bf16* base; int ldc, colt;
        if (pn < 8) { base = (bf16*)(ws + WS_QKV); ldc = 2048; colt = pn * 256; }
        else if (pn < 12) { base = (bf16*)(ws + WS_R); ldc = 1024; colt = (pn - 8) * 256; }
        else if (pn < 20) { base = (bf16*)(ws + WS_XLXG); ldc = 2048; colt = (pn - 12) * 256; }
        else if (pn < 28) { base = (bf16*)(ws + WS_GAGB); ldc = 2048; colt = (pn - 20) * 256; }
        else { base = (bf16*)(ws + WS_ALOW); ldc = 16; colt = 0; }
        const int row0 = u.pm * 256 + wr * 64 + fr, col0 = colt + wc * 32 + 8 * fq;
        const bool tail = (pn == 28);
#pragma unroll
        for (int ai = 0; ai < 2; ++ai)
#pragma unroll
            for (int m = 0; m < 4; ++m) { bf16* rowp = base + (size_t)(row0 + ai * 128 + m * 16) * ldc + col0;
#pragma unroll
                for (int bj = 0; bj < 2; ++bj) { const pg8::f32x4 v0 = acc[ai][bj][m][0], v1 = acc[ai][bj][m][1];
                    u32x4 w; w.x = pg8::cvt_pk_bf16(v0[0], v0[1]); w.y = pg8::cvt_pk_bf16(v0[2], v0[3]); w.z = pg8::cvt_pk_bf16(v1[0], v1[1]); w.w = pg8::cvt_pk_bf16(v1[2], v1[3]);
                    if (!tail || (bj == 0 && wc == 0 && fq < 2)) *(u32x4*)(rowp + bj * 128) = w; } }
    }
};
struct EpiPlain {
    static constexpr bool PERM = true;
    bf16* O; int ldc;
    __device__ __forceinline__ void operator()(const pg8::f32x4 (&acc)[2][2][4][2], const pg8::Unit& u, int wr, int wc, int fr, int fq) const {
        const int row0 = u.pm * 256 + wr * 64 + fr, col0 = u.pn * 256 + wc * 32 + 8 * fq;
#pragma unroll
        for (int ai = 0; ai < 2; ++ai)
#pragma unroll
            for (int m = 0; m < 4; ++m) { bf16* rowp = O + (size_t)(row0 + ai * 128 + m * 16) * ldc + col0;
#pragma unroll
                for (int bj = 0; bj < 2; ++bj) { const pg8::f32x4 v0 = acc[ai][bj][m][0], v1 = acc[ai][bj][m][1];
                    u32x4 w; w.x = pg8::cvt_pk_bf16(v0[0], v0[1]); w.y = pg8::cvt_pk_bf16(v0[2], v0[3]); w.z = pg8::cvt_pk_bf16(v1[0], v1[1]); w.w = pg8::cvt_pk_bf16(v1[2], v1[3]);
                    *(u32x4*)(rowp + bj * 128) = w; } }
    }
};
typedef _Float16 h16x2 __attribute__((ext_vector_type(2)));
__device__ __forceinline__ unsigned pkh(float a, float b) { return __builtin_bit_cast(unsigned, __builtin_amdgcn_cvt_pkrtz(a, b)); }
struct EpiF16 {
    static constexpr bool PERM = true;
    unsigned short* O; int ldc;
    __device__ __forceinline__ void operator()(const pg8::f32x4 (&acc)[2][2][4][2], const pg8::Unit& u, int wr, int wc, int fr, int fq) const {
        const int row0 = u.pm * 256 + wr * 64 + fr, col0 = u.pn * 256 + wc * 32 + 8 * fq;
#pragma unroll
        for (int ai = 0; ai < 2; ++ai)
#pragma unroll
            for (int m = 0; m < 4; ++m) { unsigned short* rowp = O + (size_t)(row0 + ai * 128 + m * 16) * ldc + col0;
#pragma unroll
                for (int bj = 0; bj < 2; ++bj) { const pg8::f32x4 v0 = acc[ai][bj][m][0], v1 = acc[ai][bj][m][1];
                    u32x4 w; w.x = pkh(v0[0], v0[1]); w.y = pkh(v0[2], v0[3]); w.z = pkh(v1[0], v1[1]); w.w = pkh(v1[2], v1[3]);
                    *(u32x4*)(rowp + bj * 128) = w; } }
    }
};
struct EpiLru {
    static constexpr bool PERM = true;
    bf16* LA;   bf16* XCU;   const float *lba, *lbx, *lam;
    __device__ __forceinline__ void operator()(const pg8::f32x4 (&acc)[2][2][4][2], const pg8::Unit& u, int wr, int wc, int fr, int fq) const {
        const int row0 = u.pm * 256 + wr * 64 + fr, ch0 = u.pn * 128 + wc * 32 + 8 * fq;
        float ba[8], bx[8], sp[8];
#pragma unroll
        for (int j = 0; j < 8; ++j) { ba[j] = lba[ch0 + j]; bx[j] = lbx[ch0 + j]; sp[j] = -8.f * softplus_f(-lam[ch0 + j]); }
#pragma unroll
        for (int ai = 0; ai < 2; ++ai)
#pragma unroll
            for (int m = 0; m < 4; ++m) { const size_t row = (size_t)(row0 + ai * 128 + m * 16);
                const u32x4 xw = *(const u32x4*)(XCU + row * 1024 + ch0);
                float xc[8] = {bflo(xw.x), bfhi(xw.x), bflo(xw.y), bfhi(xw.y), bflo(xw.z), bfhi(xw.z), bflo(xw.w), bfhi(xw.w)};
                float la[8], uu[8];
#pragma unroll
                for (int j = 0; j < 8; ++j) { const float pr = acc[ai][0][m][j >> 2][j & 3] + ba[j], pi = acc[ai][1][m][j >> 2][j & 3] + bx[j];
                    const float gr = sigmoid_f(pr), gi = sigmoid_f(pi);
                    la[j] = sp[j] * gr; const float a2 = __expf(2.f * la[j]);
                    uu[j] = sqrtf(fmaxf(1.f - a2, 0.f)) * gi * xc[j]; }
                u32x4 w1, w2; w1.x = pk2(la[0], la[1]); w1.y = pk2(la[2], la[3]); w1.z = pk2(la[4], la[5]); w1.w = pk2(la[6], la[7]);
                w2.x = pk2(uu[0], uu[1]); w2.y = pk2(uu[2], uu[3]); w2.z = pk2(uu[4], uu[5]); w2.w = pk2(uu[6], uu[7]);
                *(u32x4*)(LA + row * 2048 + ch0) = w1; *(u32x4*)(XCU + row * 1024 + ch0) = w2; }
    }
};

__device__ __forceinline__ void p0_transpose_item(const float* W, int ldw, int k0, int n0, int nvalid, bf16* WT, int ldk, int row0, int kc0, LAS float* scr, int lane) {
#pragma unroll 8
    for (int i = 0; i < 32; ++i) { const int kk = 2 * i + (lane >> 5), cc = lane & 31; scr[kk * 33 + cc] = (cc < nvalid) ? W[(size_t)(k0 + kk) * ldw + n0 + cc] : 0.f; }
    LDS_WAIT(); asm volatile("" ::: "memory");
    const int c = lane & 7;
#pragma unroll
    for (int j = 0; j < 4; ++j) { const int n = (lane >> 3) + 8 * j; const LAS float* s = scr + (8 * c) * 33 + n;
        u32x4 o; o.x = pk2(s[0 * 33], s[1 * 33]); o.y = pk2(s[2 * 33], s[3 * 33]); o.z = pk2(s[4 * 33], s[5 * 33]); o.w = pk2(s[6 * 33], s[7 * 33]);
        *(u32x4*)(WT + (size_t)(row0 + n) * ldk + kc0 + k0 + 8 * c) = o; }
    LDS_WAIT(); asm volatile("" ::: "memory");
}
__device__ __forceinline__ void phase0(const Params& p, LAS unsigned char* lds, int G) {
    const int tid = threadIdx.x, lane = tid & 63, wave = __builtin_amdgcn_readfirstlane(tid >> 6);
    unsigned char* ws = p.ws;
    {
        LAS float* sc = (LAS float*)lds;
        LAS float* red = (LAS float*)(lds + 4096);
        float* modp = (float*)(ws + WS_MODP);
        for (int it = blockIdx.x; it < 24 * 8; it += G) {
            const int nb = it % 24, kc = it / 24;
            for (int i = tid; i < 1024; i += NTHR) { const int b = i >> 7, k = i & 127; sc[i] = silu_f(p.c[b * 1024 + kc * 128 + k]); }
            __syncthreads();
            const int col = tid & 255, kh = tid >> 8;
            float acc[8];
#pragma unroll
            for (int b = 0; b < 8; ++b) acc[b] = 0.f;
            const float* wp = p.w_ada + (size_t)(kc * 128 + kh * 64) * 6144 + nb * 256 + col;
#pragma unroll 8
            for (int kk = 0; kk < 64; ++kk) { const float w = wp[(size_t)kk * 6144];
#pragma unroll
                for (int b = 0; b < 8; ++b) acc[b] += sc[b * 128 + kh * 64 + kk] * w; }
            if (kh == 1) {
#pragma unroll
                for (int b = 0; b < 8; ++b) red[b * 256 + col] = acc[b]; }
            __syncthreads();
            if (kh == 0) { const int n = nb * 256 + col; const float bias = (kc == 0) ? p.b_ada[n] : 0.f;
#pragma unroll
                for (int b = 0; b < 8; ++b) modp[(size_t)(kc * 8 + b) * 6144 + n] = acc[b] + red[b * 256 + col] + bias; }
            __syncthreads();
        }
    }
    LAS float* scr = (LAS float*)(lds + 16384 + wave * 8448);
    const int gw = blockIdx.x * NWAVES + wave, NGW = G * NWAVES;
    bf16* WinT = (bf16*)(ws + WS_WIN); bf16* WoutT = (bf16*)(ws + WS_WOUT); bf16* WqT = (bf16*)(ws + WS_WQ);
    bf16* LruB = (bf16*)(ws + WS_LRUB); bf16* SubK = (bf16*)(ws + WS_SUBK);
    constexpr int I_IN = 16 * (NPAD / 32), I_OUT = 16 * 32, I_Q = 16 * 64, I_LRU = 16 * 8, I_SUB = 2048, I_TAB = 2 * 16384;
    constexpr int NIT = I_IN + I_OUT + I_Q + I_LRU + I_SUB + I_TAB;
    for (int it = gw; it < NIT; it += NGW) {
        int r = it;
        if (r < I_IN) { const int nb = r % (NPAD / 32), kb = r / (NPAD / 32), nq = nb * 32; int n0, nv;
            if (nq < 3072) { n0 = nq; nv = 32; } else if (nq < 7168) { n0 = nq + 16; nv = 32; } else if (nq == 7168) { n0 = 3072; nv = 16; } else { n0 = 0; nv = 0; }
            p0_transpose_item(p.w_in, 7184, kb * 64, n0, nv, WinT, 1024, nq, 0, scr, lane); continue; } r -= I_IN;
        if (r < I_OUT) { const int nb = r % 32, kb = r / 32; p0_transpose_item(p.w_out, 1024, kb * 64, nb * 32, 32, WoutT, 1024, nb * 32, 0, scr, lane); continue; } r -= I_OUT;
        if (r < I_Q) { const int nb = r % 64, kb = r / 64; p0_transpose_item(p.wq, 2048, kb * 64, nb * 32, 32, WqT, 1024, nb * 32, 0, scr, lane); continue; } r -= I_Q;
        if (r < I_LRU) {
            const int mat = r >> 3, sub = r & 7, g = mat >> 3, n = mat & 7, kb = sub >> 2, nb = sub & 3;
            const int np = n < 6 ? n : 6, half = n - np;
            const float* W = (g ? p.lwx : p.lwa) + (size_t)n * 128 * 128;
            bf16* dst = LruB + (size_t)n * 256 * 256;
            p0_transpose_item(W, 128, kb * 64, nb * 32, 32, dst, 256, g * 128 + nb * 32, half * 128, scr, lane);
            p0_transpose_item(W, 128, kb * 64, 0, 0, dst, 256, g * 128 + nb * 32, (1 - half) * 128, scr, lane);
            continue; } r -= I_LRU;
        if (r < I_SUB) {
            const int h = r >> 8, pp = (r >> 7) & 1, n = r & 127;
            const float* src = p.subk + (size_t)r * 128; bf16* dst = SubK + ((size_t)h * 256 + pp * 128 + n) * 256;
            const f32x2 v = *(const f32x2*)(src + 2 * lane);
            *(unsigned*)(dst + pp * 128 + 2 * lane) = pk2(v.x, v.y);
            *(unsigned*)(dst + (1 - pp) * 128 + 2 * lane) = 0u;
            continue; } r -= I_SUB;
        {
            const int tb = r >> 14, row = r & 16383;
            const float* src = (tb ? p.pv : p.pu) + (size_t)row * 1024 + lane * 16;
            f32x4 v[4]; float am = 0.f;
#pragma unroll
            for (int j = 0; j < 4; ++j) { v[j] = *(const f32x4*)(src + 4 * j); am = fmaxf(am, fmaxf(fmaxf(fabsf(v[j].x), fabsf(v[j].y)), fmaxf(fabsf(v[j].z), fabsf(v[j].w)))); }
#pragma unroll
            for (int o = 1; o < 64; o <<= 1) am = fmaxf(am, __shfl_xor(am, o));
            const float inv = am > 0.f ? 7.5f / am : 0.f;
            unsigned long long lo = 0ull; unsigned hi = 0u;
#pragma unroll
            for (int j = 0; j < 16; ++j) { const float x = v[j >> 2][j & 3] * inv, a = fabsf(x);
                unsigned code = a < 1.f ? (unsigned)__builtin_rintf(a * 8.f) : (a < 2.f ? 8u + (unsigned)__builtin_rintf((a - 1.f) * 8.f) : (a < 4.f ? 16u + (unsigned)__builtin_rintf((a - 2.f) * 4.f) : 24u + (unsigned)__builtin_rintf((a - 4.f) * 2.f)));
                code = code > 31u ? 31u : code; code |= (x < 0.f) ? 32u : 0u;
                const int bit = 6 * j;
                if (bit + 6 <= 64) lo |= (unsigned long long)code << bit;
                else if (bit >= 64) hi |= code << (bit - 64);
                else { lo |= (unsigned long long)code << bit; hi |= code >> (64 - bit); } }
            unsigned* dst = (unsigned*)(ws + (tb ? WS_V : WS_U) + (size_t)row * 768 + lane * 12);
            dst[0] = (unsigned)lo; dst[1] = (unsigned)(lo >> 32); dst[2] = hi;
            if (lane == 0) ((float*)(ws + (tb ? WS_SV : WS_SU)))[row] = am * (1.f / 7.5f);
        }
    }
}

__device__ __forceinline__ float mod_at(const float* modp, int b, int n) {
    float s = 0.f;
#pragma unroll
    for (int kc = 0; kc < 8; ++kc) s += modp[(size_t)(kc * 8 + b) * 6144 + n];
    return s;
}

__device__ __forceinline__ void phase1(const Params& p, LAS unsigned char* lds, int G) {
    const int tid = threadIdx.x, lane = tid & 63, wave = __builtin_amdgcn_readfirstlane(tid >> 6);
    const float* modp = (const float*)(p.ws + WS_MODP);
    LAS float* gs = (LAS float*)lds; LAS float* sh = gs + 1024;
    bf16* H = (bf16*)p.out;
    for (int tile = blockIdx.x; tile < T / 256; tile += G) {
        const int b = tile / 32;
        __syncthreads();
        for (int k = tid; k < 1024; k += NTHR) { gs[k] = p.npm[k] * (1.f + mod_at(modp, b, 1024 + k)); sh[k] = mod_at(modp, b, k); }
        __syncthreads();
        for (int rr = 0; rr < 32; ++rr) {
            const size_t row = (size_t)tile * 256 + wave * 32 + rr;
            const f32x4* xr = (const f32x4*)(p.x + row * 1024) + lane;
            f32x4 v[4]; float s = 0.f;
#pragma unroll
            for (int j = 0; j < 4; ++j) { v[j] = xr[64 * j]; s += (v[j].x * v[j].x + v[j].y * v[j].y) + (v[j].z * v[j].z + v[j].w * v[j].w); }
            const float rstd = 1.f / sqrtf(wave_sum(s) * (1.f / 1024.f) + 1e-6f);
            u32x2* o8 = (u32x2*)(H + row * 1024) + lane;
#pragma unroll
            for (int j = 0; j < 4; ++j) { const int k = 256 * j + 4 * lane; const f32x4 g4 = *(const LAS f32x4*)(gs + k), s4 = *(const LAS f32x4*)(sh + k);
                u32x2 w; w.x = pk2(v[j].x * rstd * g4.x + s4.x, v[j].y * rstd * g4.y + s4.y); w.y = pk2(v[j].z * rstd * g4.z + s4.z, v[j].w * rstd * g4.w + s4.w);
                o8[64 * j] = w; }
        }
    }
}

__device__ __forceinline__ void phase_conv(const Params& p, int G) {
    const int tid = threadIdx.x, lane = tid & 63, wave = __builtin_amdgcn_readfirstlane(tid >> 6);
    const int gw = blockIdx.x * NWAVES + wave, NGW = G * NWAVES;
    const bf16* XL = (const bf16*)(p.ws + WS_XLXG); bf16* XC = (bf16*)p.out;
    for (int it = gw; it < (T / 64) * 2; it += NGW) {
        const int rt = it >> 1, c0 = (it & 1) * 512 + lane * 8;
        float w[4][8], cb[8];
#pragma unroll
        for (int j = 0; j < 8; ++j) { cb[j] = p.conv_b[c0 + j];
#pragma unroll
            for (int q = 0; q < 4; ++q) w[q][j] = p.conv_w[q * 1024 + c0 + j]; }
        float x1[8], x2[8], x3[8];
        const int t0 = rt * 64; const bool first = (t0 % SEQ) == 0;
#pragma unroll
        for (int j = 0; j < 8; ++j) { x1[j] = 0.f; x2[j] = 0.f; x3[j] = 0.f; }
        if (!first) {
            const u32x4 a = *(const u32x4*)(XL + (size_t)(t0 - 1) * 2048 + c0), b = *(const u32x4*)(XL + (size_t)(t0 - 2) * 2048 + c0), c = *(const u32x4*)(XL + (size_t)(t0 - 3) * 2048 + c0);
            x1[0] = bflo(a.x); x1[1] = bfhi(a.x); x1[2] = bflo(a.y); x1[3] = bfhi(a.y); x1[4] = bflo(a.z); x1[5] = bfhi(a.z); x1[6] = bflo(a.w); x1[7] = bfhi(a.w);
            x2[0] = bflo(b.x); x2[1] = bfhi(b.x); x2[2] = bflo(b.y); x2[3] = bfhi(b.y); x2[4] = bflo(b.z); x2[5] = bfhi(b.z); x2[6] = bflo(b.w); x2[7] = bfhi(b.w);
            x3[0] = bflo(c.x); x3[1] = bfhi(c.x); x3[2] = bflo(c.y); x3[3] = bfhi(c.y); x3[4] = bflo(c.z); x3[5] = bfhi(c.z); x3[6] = bflo(c.w); x3[7] = bfhi(c.w);
        }
#pragma unroll 4
        for (int i = 0; i < 64; ++i) {
            const u32x4 a = *(const u32x4*)(XL + (size_t)(t0 + i) * 2048 + c0);
            float x0[8] = {bflo(a.x), bfhi(a.x), bflo(a.y), bfhi(a.y), bflo(a.z), bfhi(a.z), bflo(a.w), bfhi(a.w)};
            float o[8];
#pragma unroll
            for (int j = 0; j < 8; ++j) { o[j] = cb[j] + w[0][j] * x3[j] + w[1][j] * x2[j] + w[2][j] * x1[j] + w[3][j] * x0[j]; x3[j] = x2[j]; x2[j] = x1[j]; x1[j] = x0[j]; }
            u32x4 wv; wv.x = pk2(o[0], o[1]); wv.y = pk2(o[2], o[3]); wv.z = pk2(o[4], o[5]); wv.w = pk2(o[6], o[7]);
            *(u32x4*)(XC + (size_t)(t0 + i) * 1024 + c0) = wv;
        }
    }
}

template <bool FINAL>
__device__ __forceinline__ void phase_lru_scan(const Params& p, int G) {
    const int tid = threadIdx.x;
    const bf16* LA = (const bf16*)(p.ws + WS_XLXG); const bf16* U = (const bf16*)p.out;
    const bf16* XG = (const bf16*)(p.ws + WS_XLXG) + 1024; bf16* GB = (bf16*)(p.ws + WS_GAGB) + 1024;
    f32x2* car = (f32x2*)(p.ws + WS_LRUC);
    for (int it = blockIdx.x; it < 8 * 32 * 2; it += G) {
        const int cg_ = it & 1, j = (it >> 1) & 31, b = it >> 6, ch = cg_ * 512 + tid;
        const size_t t0 = (size_t)b * SEQ + j * 256;
        if (!FINAL) {
            float h = 0.f, ls = 0.f;
#pragma unroll 8
            for (int i = 0; i < 256; ++i) { const float la = bf2f(LA[(t0 + i) * 2048 + ch]), u = bf2f(U[(t0 + i) * 1024 + ch]);
                h = __expf(la) * h + u; ls += la; }
            car[(size_t)(b * 32 + j) * 1024 + ch] = (f32x2){__expf(ls), h};
        } else {
            float h = 0.f;
            for (int i = 0; i < j; ++i) { const f32x2 c = car[(size_t)(b * 32 + i) * 1024 + ch]; h = c.x * h + c.y; }
#pragma unroll 8
            for (int i = 0; i < 256; ++i) { const float la = bf2f(LA[(t0 + i) * 2048 + ch]), u = bf2f(U[(t0 + i) * 1024 + ch]);
                h = __expf(la) * h + u;
                const float xg = bf2f(XG[(t0 + i) * 2048 + ch]), gb = bf2f(GB[(t0 + i) * 2048 + ch]);
                GB[(t0 + i) * 2048 + ch] = (bf16)f2bf(h * gelu_f(xg) * sigmoid_f(gb)); }
        }
    }
}

typedef short bf16x8_t __attribute__((ext_vector_type(8)));
__device__ __forceinline__ void phase_gla_prep(const Params& p, LAS unsigned char* lds, int G) {
    const int tid = threadIdx.x;
    LAS float* segt = (LAS float*)lds;
    bf16* QKV = (bf16*)(p.ws + WS_QKV); const bf16* AL = (const bf16*)(p.ws + WS_ALOW); float* DK = (float*)(p.ws + WS_DK);
    const int kp = tid & 127, seg = tid >> 7;
    for (int it = blockIdx.x; it < 8 * 128 * 4; it += G) {
        const int h = it & 3, ch = (it >> 2) & 127, b = it >> 9;
        float wa[16];
#pragma unroll
        for (int r = 0; r < 16; ++r) wa[r] = p.w_alpha[r * 512 + h * 128 + kp];
        const float balpha = p.b_alpha[h * 128 + kp];
        const size_t t0 = (size_t)b * SEQ + ch * 64 + seg * 16;
        float qv[16], kv[16];
#pragma unroll
        for (int i = 0; i < 16; ++i) { qv[i] = bf2f(QKV[(t0 + i) * 2048 + h * 128 + kp]); kv[i] = bf2f(QKV[(t0 + i) * 2048 + 512 + h * 128 + kp]); }
        float cl[16]; float run = 0.f;
#pragma unroll
        for (int i = 0; i < 16; ++i) { const size_t t = t0 + i;
            const u32x4 a0 = *(const u32x4*)(AL + t * 16), a1 = *(const u32x4*)(AL + t * 16 + 8);
            float z = balpha;
            z += bflo(a0.x) * wa[0] + bfhi(a0.x) * wa[1] + bflo(a0.y) * wa[2] + bfhi(a0.y) * wa[3] + bflo(a0.z) * wa[4] + bfhi(a0.z) * wa[5] + bflo(a0.w) * wa[6] + bfhi(a0.w) * wa[7];
            z += bflo(a1.x) * wa[8] + bfhi(a1.x) * wa[9] + bflo(a1.y) * wa[10] + bfhi(a1.y) * wa[11] + bflo(a1.z) * wa[12] + bfhi(a1.z) * wa[13] + bflo(a1.w) * wa[14] + bfhi(a1.w) * wa[15];
            const float ls = fminf(z, 0.f) - __logf(1.f + __expf(-fabsf(z)));
            run += ls * (1.f / 16.f); cl[i] = run; }
        __syncthreads();
        segt[seg * 128 + kp] = run;
        __syncthreads();
        float off = 0.f, tot = 0.f;
#pragma unroll
        for (int s = 0; s < 4; ++s) { const float v = segt[s * 128 + kp]; tot += v; if (s < seg) off += v; }
        if (seg == 0) DK[(size_t)(b * 128 + ch) * 512 + h * 128 + kp] = __expf(tot);
#pragma unroll
        for (int i = 0; i < 16; ++i) { const float cum = cl[i] + off;
            QKV[(t0 + i) * 2048 + h * 128 + kp] = (bf16)f2bf(qv[i] * 0.08838834764831845f * __expf(cum));
            QKV[(t0 + i) * 2048 + 512 + h * 128 + kp] = (bf16)f2bf(kv[i] * __expf(-cum)); }
    }
}
__device__ __forceinline__ void phase_gla_seq(const Params& p, LAS unsigned char* lds, int G) {
    const int tid = threadIdx.x, lane = tid & 63, wave = __builtin_amdgcn_readfirstlane(tid >> 6), q4 = lane >> 4, c16 = lane & 15;
    constexpr int PQ = 136, PS = 72;
    LAS bf16* Qs = (LAS bf16*)lds;
    LAS bf16* Kd = Qs + 64 * PQ;
    LAS bf16* KdT = Kd + 64 * PQ;
    LAS bf16* VT = KdT + 128 * PS;
    LAS bf16* Pm = VT + 32 * PS;
    LAS bf16* ST = Pm + 64 * PS;
    LAS float* dk = (LAS float*)(ST + 32 * PQ);
    const bf16* QKV = (const bf16*)(p.ws + WS_QKV); bf16* VO = (bf16*)(p.ws + WS_QKV); const float* DK = (const float*)(p.ws + WS_DK);
    const int kp = tid & 127, seg = tid >> 7;
    const int vv = tid & 31, sg = tid >> 5;
    const int r0 = tid >> 4, cc = (tid & 15) * 8;
    for (int it = blockIdx.x; it < 8 * 4 * 8; it += G) {
        const int v8 = it & 7, h = (it >> 3) & 3, b = it >> 5;
        pg8::f32x4 sacc[2] = {(pg8::f32x4){0.f, 0.f, 0.f, 0.f}, (pg8::f32x4){0.f, 0.f, 0.f, 0.f}};
        __syncthreads();
        for (int i = tid; i < 32 * PQ / 2; i += NTHR) ((LAS unsigned*)ST)[i] = 0u;
        u32x4 rq[2], rk[2]; unsigned rkt[8], rv[2]; float rdk = 0.f;
#define GLA_LOAD(chn) do { const size_t _t0 = (size_t)b * SEQ + (size_t)(chn) * 64; \
            _Pragma("unroll") for (int _j = 0; _j < 2; ++_j) { rq[_j] = *(const u32x4*)(QKV + (_t0 + r0 + 32 * _j) * 2048 + h * 128 + cc); rk[_j] = *(const u32x4*)(QKV + (_t0 + r0 + 32 * _j) * 2048 + 512 + h * 128 + cc); } \
            _Pragma("unroll") for (int _i = 0; _i < 8; ++_i) { const unsigned _lo = QKV[(_t0 + seg * 16 + 2 * _i) * 2048 + 512 + h * 128 + kp], _hi = QKV[(_t0 + seg * 16 + 2 * _i + 1) * 2048 + 512 + h * 128 + kp]; rkt[_i] = _lo | (_hi << 16); } \
            _Pragma("unroll") for (int _i = 0; _i < 2; ++_i) { const unsigned _lo = QKV[(_t0 + sg * 4 + 2 * _i) * 2048 + 1024 + h * 256 + v8 * 32 + vv], _hi = QKV[(_t0 + sg * 4 + 2 * _i + 1) * 2048 + 1024 + h * 256 + v8 * 32 + vv]; rv[_i] = _lo | (_hi << 16); } \
            if (tid < 128) rdk = DK[(size_t)(b * 128 + (chn)) * 512 + h * 128 + tid]; } while (0)
        GLA_LOAD(0);
#pragma unroll 1
        for (int ch = 0; ch < SEQ / 64; ++ch) {
            const size_t t0 = (size_t)b * SEQ + ch * 64;
#pragma unroll
            for (int j = 0; j < 2; ++j) { *(LAS u32x4*)(Qs + (r0 + 32 * j) * PQ + cc) = rq[j]; *(LAS u32x4*)(Kd + (r0 + 32 * j) * PQ + cc) = rk[j]; }
            *(LAS u32x4*)(KdT + kp * PS + seg * 16) = (u32x4){rkt[0], rkt[1], rkt[2], rkt[3]};
            *(LAS u32x4*)(KdT + kp * PS + seg * 16 + 8) = (u32x4){rkt[4], rkt[5], rkt[6], rkt[7]};
            *(LAS u32x2*)(VT + vv * PS + sg * 4) = (u32x2){rv[0], rv[1]};
            if (tid < 128) dk[tid] = rdk;
            if (ch + 1 < SEQ / 64) GLA_LOAD(ch + 1);
            __syncthreads();
            { const int tt = wave & 3;
#pragma unroll
              for (int i2 = 0; i2 < 2; ++i2) { const int ts = (wave >> 2) * 2 + i2;
                  pg8::f32x4 acc = (pg8::f32x4){0.f, 0.f, 0.f, 0.f};
                  if (ts <= tt) {
#pragma unroll
                      for (int ks = 0; ks < 4; ++ks) { const bf16x8_t a = *(const LAS bf16x8_t*)(Kd + (ts * 16 + c16) * PQ + ks * 32 + q4 * 8), bb = *(const LAS bf16x8_t*)(Qs + (tt * 16 + c16) * PQ + ks * 32 + q4 * 8);
                          acc = __builtin_amdgcn_mfma_f32_16x16x32_bf16(a, bb, acc, 0, 0, 0); }
                      const int tg = tt * 16 + c16, sgl = ts * 16 + q4 * 4;
#pragma unroll
                      for (int j = 0; j < 4; ++j) if (sgl + j > tg) acc[j] = 0.f;
                  }
                  *(LAS u32x2*)(Pm + (tt * 16 + c16) * PS + ts * 16 + q4 * 4) = (u32x2){pk2(acc[0], acc[1]), pk2(acc[2], acc[3])}; } }
            __syncthreads();
            { const int tt = wave & 3, tv = wave >> 2;
              pg8::f32x4 oacc = (pg8::f32x4){0.f, 0.f, 0.f, 0.f};
#pragma unroll
              for (int ks = 0; ks < 2; ++ks) { const bf16x8_t bb = *(const LAS bf16x8_t*)(Pm + (tt * 16 + c16) * PS + ks * 32 + q4 * 8), a = *(const LAS bf16x8_t*)(VT + (tv * 16 + c16) * PS + ks * 32 + q4 * 8);
                  oacc = __builtin_amdgcn_mfma_f32_16x16x32_bf16(a, bb, oacc, 0, 0, 0); }
#pragma unroll
              for (int ks = 0; ks < 4; ++ks) { const bf16x8_t bb = *(const LAS bf16x8_t*)(Qs + (tt * 16 + c16) * PQ + ks * 32 + q4 * 8), a = *(const LAS bf16x8_t*)(ST + (tv * 16 + c16) * PQ + ks * 32 + q4 * 8);
                  oacc = __builtin_amdgcn_mfma_f32_16x16x32_bf16(a, bb, oacc, 0, 0, 0); }
              *(u32x2*)(VO + (t0 + tt * 16 + c16) * 2048 + 1024 + h * 256 + v8 * 32 + tv * 16 + q4 * 4) = (u32x2){pk2(oacc[0], oacc[1]), pk2(oacc[2], oacc[3])}; }
#pragma unroll
            for (int ks = 0; ks < 2; ++ks) { const bf16x8_t a = *(const LAS bf16x8_t*)(KdT + (wave * 16 + c16) * PS + ks * 32 + q4 * 8);
#pragma unroll
                for (int tv = 0; tv < 2; ++tv) { const bf16x8_t bb = *(const LAS bf16x8_t*)(VT + (tv * 16 + c16) * PS + ks * 32 + q4 * 8);
                    sacc[tv] = __builtin_amdgcn_mfma_f32_16x16x32_bf16(a, bb, sacc[tv], 0, 0, 0); } }
            { const pg8::f32x4 d4 = *(const LAS pg8::f32x4*)(dk + wave * 16 + q4 * 4);
#pragma unroll
              for (int tv = 0; tv < 2; ++tv) sacc[tv] = sacc[tv] * d4; }
            __syncthreads();
#pragma unroll
            for (int tv = 0; tv < 2; ++tv) *(LAS u32x2*)(ST + (tv * 16 + c16) * PQ + wave * 16 + q4 * 4) = (u32x2){pk2(sacc[tv][0], sacc[tv][1]), pk2(sacc[tv][2], sacc[tv][3])};
        }
#undef GLA_LOAD
    }
}

__device__ __forceinline__ void phase_gla_final(const Params& p, int G) {
    const int tid = threadIdx.x, lane = tid & 63, wave = __builtin_amdgcn_readfirstlane(tid >> 6);
    const int gw = blockIdx.x * NWAVES + wave, NGW = G * NWAVES;
    const bf16* O = (const bf16*)(p.ws + WS_QKV) + 1024; const bf16* R = (const bf16*)(p.ws + WS_R); bf16* GA = (bf16*)(p.ws + WS_GAGB);
    for (int row = gw; row < T; row += NGW) {
#pragma unroll
        for (int h = 0; h < 4; ++h) { const int c0 = h * 256 + lane * 4;
            const u32x2 ov = *(const u32x2*)(O + (size_t)row * 2048 + c0), rv = *(const u32x2*)(R + (size_t)row * 1024 + c0);
            const u32x2 gav = *(const u32x2*)(GA + (size_t)row * 2048 + c0), tv = *(const u32x2*)(GA + (size_t)row * 2048 + 1024 + c0);
            const float o[4] = {bflo(ov.x), bfhi(ov.x), bflo(ov.y), bfhi(ov.y)}, r[4] = {bflo(rv.x), bfhi(rv.x), bflo(rv.y), bfhi(rv.y)};
            const float ga[4] = {bflo(gav.x), bfhi(gav.x), bflo(gav.y), bfhi(gav.y)}, tm[4] = {bflo(tv.x), bfhi(tv.x), bflo(tv.y), bfhi(tv.y)};
            const float ss = wave_sum((o[0] * o[0] + o[1] * o[1]) + (o[2] * o[2] + o[3] * o[3]));
            const float rstd = 1.f / sqrtf(ss * (1.f / 256.f) + 1e-6f);
            const f32x4 gn = *(const f32x4*)(p.gla_norm + c0);
            float m[4];
#pragma unroll
            for (int j = 0; j < 4; ++j) m[j] = sigmoid_f(ga[j]) * (o[j] * rstd * gn[j] * silu_f(r[j])) + tm[j];
            u32x2 w; w.x = pk2(m[0], m[1]); w.y = pk2(m[2], m[3]);
            *(u32x2*)(GA + (size_t)row * 2048 + c0) = w; }
    }
}

__device__ __forceinline__ void phase_norm2(const Params& p, LAS unsigned char* lds, int G) {
    const int tid = threadIdx.x, lane = tid & 63, wave = __builtin_amdgcn_readfirstlane(tid >> 6);
    const float* modp = (const float*)(p.ws + WS_MODP);
    LAS float* g1 = (LAS float*)lds; LAS float* gs = g1 + 1024; LAS float* sh = gs + 1024;
    const bf16* Y = (const bf16*)(p.ws + WS_Y); bf16* H2 = (bf16*)(p.ws + WS_H2);
    for (int tile = blockIdx.x; tile < T / 256; tile += G) {
        const int b = tile / 32;
        __syncthreads();
        for (int k = tid; k < 1024; k += NTHR) { g1[k] = mod_at(modp, b, 2048 + k) * p.npo[k]; gs[k] = p.npf[k] * (1.f + mod_at(modp, b, 4096 + k)); sh[k] = mod_at(modp, b, 3072 + k); }
        __syncthreads();
        for (int rr = 0; rr < 32; ++rr) {
            const size_t row = (size_t)tile * 256 + wave * 32 + rr;
            const f32x4* xr = (const f32x4*)(p.x + row * 1024) + lane; const u32x2* yr = (const u32x2*)(Y + row * 1024) + lane;
            f32x4 xv[4], yv[4]; float s = 0.f;
#pragma unroll
            for (int j = 0; j < 4; ++j) { xv[j] = xr[64 * j]; const u32x2 yw = yr[64 * j]; yv[j] = (f32x4){bflo(yw.x), bfhi(yw.x), bflo(yw.y), bfhi(yw.y)};
                s += (yv[j].x * yv[j].x + yv[j].y * yv[j].y) + (yv[j].z * yv[j].z + yv[j].w * yv[j].w); }
            const float rstd = 1.f / sqrtf(wave_sum(s) * (1.f / 1024.f) + 1e-6f);
            float s2 = 0.f;
            f32x4* orow = (f32x4*)(p.out + row * 1024) + lane;
#pragma unroll
            for (int j = 0; j < 4; ++j) { const int k = 256 * j + 4 * lane; const f32x4 g4 = *(const LAS f32x4*)(g1 + k);
                xv[j] = xv[j] + yv[j] * rstd * g4; orow[64 * j] = xv[j];
                s2 += (xv[j].x * xv[j].x + xv[j].y * xv[j].y) + (xv[j].z * xv[j].z + xv[j].w * xv[j].w); }
            const float rstd2 = 1.f / sqrtf(wave_sum(s2) * (1.f / 1024.f) + 1e-6f);
            u32x2* o8 = (u32x2*)(H2 + row * 1024) + lane;
#pragma unroll
            for (int j = 0; j < 4; ++j) { const int k = 256 * j + 4 * lane; const f32x4 g4 = *(const LAS f32x4*)(gs + k), s4 = *(const LAS f32x4*)(sh + k);
                u32x2 w; w.x = pk2(xv[j].x * rstd2 * g4.x + s4.x, xv[j].y * rstd2 * g4.y + s4.y); w.y = pk2(xv[j].z * rstd2 * g4.z + s4.z, xv[j].w * rstd2 * g4.w + s4.w);
                o8[64 * j] = w; }
        }
    }
}

__device__ __forceinline__ unsigned h16_key(unsigned b) { return (b & 0x8000u) ? (~b & 0xffffu) : (b | 0x8000u); }
__device__ __forceinline__ float h16_key_val(unsigned s) { const unsigned b = (s & 0x8000u) ? (s & 0x7fffu) : (~s & 0xffffu); return (float)__builtin_bit_cast(_Float16, (unsigned short)b); }
#define INS16(top, x) do { _Pragma("unroll") for (int _j = 0; _j < 16; ++_j) { const unsigned _hi = max(top[_j], x), _lo = min(top[_j], x); top[_j] = _hi; x = _lo; } } while (0)
__device__ __forceinline__ void phase_topk(const Params& p, LAS unsigned char* lds, int G) {
    const int tid = threadIdx.x;
    const unsigned short* SC = (const unsigned short*)(p.ws + WS_SC); unsigned* TK = (unsigned*)(p.ws + WS_TOPK); float* TK2 = (float*)(p.ws + WS_TOPK2);
    const float* SU = (const float*)(p.ws + WS_SU); const float* SV = (const float*)(p.ws + WS_SV);
    LAS unsigned* my = (LAS unsigned*)lds + tid * 33;
    for (int blk = blockIdx.x; blk < T * 8 / NTHR; blk += G) {
        const int item = blk * NTHR + tid, t = item >> 3, h = item & 7;
        unsigned topA[16], topB[16];
#pragma unroll
        for (int j = 0; j < 16; ++j) { topA[j] = 0u; topB[j] = 0u; }
        const u32x4* src = (const u32x4*)(SC + (size_t)t * 2048 + h * 256);
#pragma unroll 1
        for (int c8 = 0; c8 < 16; ++c8) { const u32x4 w = src[c8];
            const unsigned ww[4] = {w.x, w.y, w.z, w.w};
#pragma unroll
            for (int q = 0; q < 4; ++q) { unsigned k0 = (h16_key(ww[q] & 0xffffu) << 16) | (unsigned)(127 - (c8 * 8 + q * 2)), k1 = (h16_key(ww[q] >> 16) << 16) | (unsigned)(127 - (c8 * 8 + q * 2 + 1));
                INS16(topA, k0); INS16(topA, k1); } }
#pragma unroll 1
        for (int c8 = 0; c8 < 16; ++c8) { const u32x4 w = src[16 + c8];
            const unsigned ww[4] = {w.x, w.y, w.z, w.w};
#pragma unroll
            for (int q = 0; q < 4; ++q) { unsigned k0 = (h16_key(ww[q] & 0xffffu) << 16) | (unsigned)(127 - (c8 * 8 + q * 2)), k1 = (h16_key(ww[q] >> 16) << 16) | (unsigned)(127 - (c8 * 8 + q * 2 + 1));
                INS16(topB, k0); INS16(topB, k1); } }
        float fa[16], fb[16];
#pragma unroll
        for (int j = 0; j < 16; ++j) { fa[j] = h16_key_val(topA[j] >> 16); fb[j] = h16_key_val(topB[j] >> 16); my[j] = 127u - (topA[j] & 127u); my[16 + j] = 127u - (topB[j] & 127u); }
        unsigned ct[16];
#pragma unroll
        for (int j = 0; j < 16; ++j) ct[j] = 0u;
#pragma unroll
        for (int i = 0; i < 16; ++i)
#pragma unroll
            for (int j = 0; j < 16; ++j) if ((i + 1) * (j + 1) <= 16) {
                const float s = fa[i] + fb[j]; unsigned u = __builtin_bit_cast(unsigned, s); u ^= (u >> 31) ? 0xffffffffu : 0x80000000u;
                unsigned key = (u & 0xffffff00u) | (unsigned)(255 - (i * 16 + j));
                INS16(ct, key); }
        float val[16], mx, sum = 0.f;
#pragma unroll
        for (int m = 0; m < 16; ++m) { unsigned u = ct[m] & 0xffffff00u; u ^= (u >> 31) ? 0x80000000u : 0xffffffffu; val[m] = __builtin_bit_cast(float, u); }
        mx = val[0];
#pragma unroll
        for (int m = 0; m < 16; ++m) { val[m] = __expf(val[m] - mx); sum += val[m]; }
        const float inv = 1.f / sum;
        LDS_WAIT();
        unsigned outw[16]; float outs[16];
#pragma unroll
        for (int m = 0; m < 16; ++m) { const unsigned pos = 255u - (ct[m] & 255u), i = pos >> 4, j = pos & 15u;
            const unsigned e = my[i] * 128u + my[16 + j];
            outw[m] = (e << 16) | f2bf(val[m] * inv * SV[e]); outs[m] = SU[e]; }
        u32x4* dst = (u32x4*)(TK + (size_t)item * 16); f32x4* dst2 = (f32x4*)(TK2 + (size_t)item * 16);
#pragma unroll
        for (int q = 0; q < 4; ++q) { dst[q] = (u32x4){outw[4 * q], outw[4 * q + 1], outw[4 * q + 2], outw[4 * q + 3]}; dst2[q] = (f32x4){outs[4 * q], outs[4 * q + 1], outs[4 * q + 2], outs[4 * q + 3]}; }
    }
}

typedef unsigned u32x3 __attribute__((ext_vector_type(3)));
typedef unsigned u32x6 __attribute__((ext_vector_type(6)));
typedef float f32x32 __attribute__((ext_vector_type(32)));
__device__ __forceinline__ float rdlane(float v, int l) { return __builtin_bit_cast(float, __builtin_amdgcn_readlane(__builtin_bit_cast(int, v), l)); }
__device__ __forceinline__ f32x32 fp6x2(u32x3 a, u32x3 b) { const u32x6 s = {a.x, a.y, a.z, b.x, b.y, b.z}; return __builtin_amdgcn_cvt_scalef32_pk32_f32_fp6(s, 1.0f); }
__device__ __forceinline__ void phase_gather(const Params& p, LAS unsigned char* lds, int G) {
    const int tid = threadIdx.x, lane = tid & 63, wave = __builtin_amdgcn_readfirstlane(tid >> 6);
    const float* modp = (const float*)(p.ws + WS_MODP);
    LAS float* g2 = (LAS float*)lds;
    const bf16* H2 = (const bf16*)(p.ws + WS_H2); const unsigned* TK = (const unsigned*)(p.ws + WS_TOPK); const float* TK2 = (const float*)(p.ws + WS_TOPK2);
    const unsigned char* U6 = p.ws + WS_U; const unsigned char* V6 = p.ws + WS_V;
    for (int tile = blockIdx.x; tile < T / 256; tile += G) {
        const int b = tile / 32;
        __syncthreads();
        for (int k = tid; k < 1024; k += NTHR) g2[k] = mod_at(modp, b, 5120 + k) * p.npof[k];
        __syncthreads();
#pragma unroll 1
        for (int rr = 0; rr < 32; ++rr) {
            const size_t row = (size_t)tile * 256 + wave * 32 + rr;
            float xt[16];
            { const u32x4 a = *(const u32x4*)(H2 + row * 1024 + lane * 16), c = *(const u32x4*)(H2 + row * 1024 + lane * 16 + 8);
              xt[0] = bflo(a.x); xt[1] = bfhi(a.x); xt[2] = bflo(a.y); xt[3] = bfhi(a.y); xt[4] = bflo(a.z); xt[5] = bfhi(a.z); xt[6] = bflo(a.w); xt[7] = bfhi(a.w);
              xt[8] = bflo(c.x); xt[9] = bfhi(c.x); xt[10] = bflo(c.y); xt[11] = bfhi(c.y); xt[12] = bflo(c.z); xt[13] = bfhi(c.z); xt[14] = bflo(c.w); xt[15] = bfhi(c.w); }
            float acc[16];
#pragma unroll
            for (int j = 0; j < 16; ++j) acc[j] = 0.f;
#pragma unroll 1
            for (int hh = 0; hh < 16; ++hh) {
                const u32x4* ra = (const u32x4*)(TK + row * 128 + hh * 8);
                const u32x4 w0 = ra[0], w1 = ra[1];
                const unsigned ww[8] = {w0.x, w0.y, w0.z, w0.w, w1.x, w1.y, w1.z, w1.w};
                u32x6 up[4], vp[4];
#pragma unroll
                for (int m = 0; m < 8; ++m) { const size_t eo = (size_t)((unsigned)__builtin_amdgcn_readfirstlane((int)ww[m]) >> 16) * 768 + lane * 12;
                    const u32x3 a = *(const u32x3*)(U6 + eo), c = *(const u32x3*)(V6 + eo);
                    if (m & 1) { up[m >> 1][3] = a.x; up[m >> 1][4] = a.y; up[m >> 1][5] = a.z; vp[m >> 1][3] = c.x; vp[m >> 1][4] = c.y; vp[m >> 1][5] = c.z; }
                    else { up[m >> 1][0] = a.x; up[m >> 1][1] = a.y; up[m >> 1][2] = a.z; vp[m >> 1][0] = c.x; vp[m >> 1][1] = c.y; vp[m >> 1][2] = c.z; } }
                const unsigned wa = TK[row * 128 + hh * 8 + (lane >> 3)]; const float su = TK2[row * 128 + hh * 8 + (lane >> 3)];
                float pd[8];
#pragma unroll
                for (int m = 0; m < 8; m += 2) { const f32x32 f = __builtin_amdgcn_cvt_scalef32_pk32_f32_fp6(up[m >> 1], 1.0f);
                    float s0 = 0.f, s1 = 0.f;
#pragma unroll
                    for (int j = 0; j < 16; ++j) { s0 += xt[j] * f[j]; s1 += xt[j] * f[16 + j]; }
                    pd[m] = s0; pd[m + 1] = s1; __builtin_amdgcn_sched_barrier(0); }
#pragma unroll
                for (int j = 0; j < 4; ++j) { const bool up_ = (lane & 32) != 0; const float keep = up_ ? pd[j + 4] : pd[j], send = up_ ? pd[j] : pd[j + 4]; pd[j] = keep + __shfl_xor(send, 32); }
#pragma unroll
                for (int j = 0; j < 2; ++j) { const bool up_ = (lane & 16) != 0; const float keep = up_ ? pd[j + 2] : pd[j], send = up_ ? pd[j] : pd[j + 2]; pd[j] = keep + __shfl_xor(send, 16); }
                { const bool up_ = (lane & 8) != 0; const float keep = up_ ? pd[1] : pd[0], send = up_ ? pd[0] : pd[1]; pd[0] = keep + __shfl_xor(send, 8); }
                float d = pd[0]; d += __shfl_xor(d, 4); d += __shfl_xor(d, 2); d += __shfl_xor(d, 1);
                const float coef = bflo(wa) * gelu_f(su * d);
#pragma unroll
                for (int m = 0; m < 8; m += 2) { const f32x32 f = __builtin_amdgcn_cvt_scalef32_pk32_f32_fp6(vp[m >> 1], 1.0f); const float c0 = rdlane(coef, 8 * m), c1 = rdlane(coef, 8 * m + 8);
#pragma unroll
                    for (int j = 0; j < 16; ++j) acc[j] += c0 * f[j] + c1 * f[16 + j];
                    __builtin_amdgcn_sched_barrier(0); }
            }
            float s = 0.f;
#pragma unroll
            for (int j = 0; j < 16; ++j) s += acc[j] * acc[j];
            const float rstd = 1.f / sqrtf(wave_sum(s) * (1.f / 1024.f) + 1e-6f);
            float* orow = p.out + row * 1024 + lane * 16;
#pragma unroll
            for (int q = 0; q < 4; ++q) { f32x4 o = *(const f32x4*)(orow + 4 * q); const f32x4 ga = *(const LAS f32x4*)(g2 + lane * 16 + 4 * q);
                o.x += ga.x * acc[4 * q] * rstd; o.y += ga.y * acc[4 * q + 1] * rstd; o.z += ga.z * acc[4 * q + 2] * rstd; o.w += ga.w * acc[4 * q + 3] * rstd;
                *(f32x4*)(orow + 4 * q) = o; }
        }
    }
}

#define XB_TMO      128
#define XB_XCNT(j)  (256  + 64 * (j))
#define XB_XSUB(j)  (1280 + 64 * (j))
#define XB_XGEN(j)  (2304 + 64 * (j))
#define XB_TOP      3328
#define XB_TOPGEN   3392
#define XCD_BAR_WORDS 3456
#define XB_SPIN_CAP (1u << 18)

__device__ __forceinline__ unsigned xb_ld(unsigned* p)              { return __hip_atomic_load(p, __ATOMIC_RELAXED, __HIP_MEMORY_SCOPE_AGENT); }
__device__ __forceinline__ unsigned xb_add(unsigned* p, unsigned v) { return __hip_atomic_fetch_add(p, v, __ATOMIC_RELAXED, __HIP_MEMORY_SCOPE_AGENT); }
__device__ __forceinline__ unsigned xb_xcc_id() { return (unsigned)__builtin_amdgcn_s_getreg((3 << 11) | 20) & 0xFu; }
#define XB_SPIN(cond, bar) do { unsigned _sp = 0; while (cond) { __builtin_amdgcn_s_sleep(1); \
    if ((++_sp & 255u) == 0u) { if (xb_ld(&(bar)[XB_TMO])) break; if (_sp > XB_SPIN_CAP) { atomicAdd(&(bar)[XB_TMO], 1u); break; } } } } while (0)

struct XcdBarrier {
    unsigned* bar; unsigned x;
    volatile LAS unsigned* st;
};

__device__ __forceinline__ XcdBarrier xcd_barrier_post(unsigned* bar, volatile LAS unsigned* st) {
    XcdBarrier b; b.bar = bar; b.x = xb_xcc_id(); b.st = st;
    if (threadIdx.x == 0) (void)xb_add(&bar[XB_XCNT(b.x)], 1u);
    return b;
}
__device__ __forceinline__ void xcd_barrier_complete(unsigned* bar, unsigned x, unsigned& nloc, unsigned& nx) {
    const unsigned G = gridDim.x * gridDim.y * gridDim.z;
    unsigned sum, cnt, mine, sp = 0u;
    for (;;) {
        sum = 0u; cnt = 0u; mine = 0u;
#pragma unroll
        for (unsigned j = 0; j < 16; ++j) { const unsigned c = xb_ld(&bar[XB_XCNT(j)]); sum += c; cnt += (c > 0u) ? 1u : 0u; mine = (j == x) ? c : mine; }
        if (sum == G) break;
        __builtin_amdgcn_s_sleep(1);
        if ((++sp & 255u) == 0u) { if (xb_ld(&bar[XB_TMO])) break; if (sp > XB_SPIN_CAP) { atomicAdd(&bar[XB_TMO], 1u); break; } }
    }
    nloc = mine > 0u ? mine : 1u; nx = cnt > 0u ? cnt : 1u;
}

__device__ __forceinline__ void xcd_barrier(const XcdBarrier& b) {
    asm volatile("s_waitcnt vmcnt(0)" ::: "memory");
    __syncthreads();
    if (threadIdx.x == 0) {
        unsigned* bar = b.bar;
        __builtin_amdgcn_s_waitcnt(0);
        unsigned nloc = b.st[0], nx = b.st[1];
        if (nloc == 0u) { xcd_barrier_complete(bar, b.x, nloc, nx); b.st[0] = nloc; b.st[1] = nx; }
        const unsigned old = xb_add(&bar[XB_XSUB(b.x)], 1u);
        const unsigned gen = old / nloc;
        if (old + 1u == (gen + 1u) * nloc) {
            __builtin_amdgcn_fence(__ATOMIC_RELEASE, "agent");
            asm volatile("s_waitcnt vmcnt(0)" ::: "memory");
            const unsigned og = xb_add(&bar[XB_TOP], 1u);
            const unsigned tg = og / nx;
            if (og + 1u == (tg + 1u) * nx) xb_add(&bar[XB_TOPGEN], 1u);
            else XB_SPIN(xb_ld(&bar[XB_TOPGEN]) == tg, bar);
            __builtin_amdgcn_fence(__ATOMIC_ACQUIRE, "agent");
            xb_add(&bar[XB_XGEN(b.x)], 1u);
            asm volatile("s_waitcnt vmcnt(0)" ::: "memory");
        } else {
            XB_SPIN(xb_ld(&bar[XB_XGEN(b.x)]) == gen, bar);
            __builtin_amdgcn_fence(__ATOMIC_ACQUIRE, "agent");
            asm volatile("s_waitcnt vmcnt(0)" ::: "memory");
        }
    }
    __syncthreads();
}


template <int PH>
__device__ __forceinline__ void run_phase(const Params& p, LAS unsigned char* lds, int G) {
    unsigned char* ws = p.ws;
    if constexpr (PH == 0) phase0(p, lds, G);
    else if constexpr (PH == 1) phase1(p, lds, G);
    else if constexpr (PH == 2) { pg8::Gemm g{(const bf16*)p.out, (const bf16*)(ws + WS_WIN), T, NPAD, 1024, 1024}; pg8::StaticOrder S; S.init(T, NPAD, G, (int)blockIdx.x);
        EpiSeg E{ws}; pg8::gemm_phase<EpiSeg, pg8::StaticOrder, true, true, 0, 1024, 1024>(lds, g, S, E); }
    else if constexpr (PH == 3) phase_gla_prep(p, lds, G);
    else if constexpr (PH == 4) phase_gla_seq(p, lds, G);
    else if constexpr (PH == 5) phase_conv(p, G);
    else if constexpr (PH == 6) { pg8::Gemm g{(const bf16*)p.out, (const bf16*)(ws + WS_LRUB), T, 2048, 256, 1024}; pg8::StaticOrder S; S.init(T, 2048, G, (int)blockIdx.x);
        EpiLru E{(bf16*)(ws + WS_XLXG), (bf16*)p.out, p.lba, p.lbx, p.lam}; pg8::gemm_phase<EpiLru, pg8::StaticOrder, true, true, 1, 256, 1024>(lds, g, S, E); }
    else if constexpr (PH == 7) phase_lru_scan<false>(p, G);
    else if constexpr (PH == 8) phase_lru_scan<true>(p, G);
    else if constexpr (PH == 9) phase_gla_final(p, G);
    else if constexpr (PH == 10) { pg8::Gemm g{(const bf16*)(ws + WS_GAGB), (const bf16*)(ws + WS_WOUT), T, 1024, 1024, 2048}; pg8::StaticOrder S; S.init(T, 1024, G, (int)blockIdx.x);
        EpiPlain E{(bf16*)(ws + WS_Y), 1024}; pg8::gemm_phase<EpiPlain, pg8::StaticOrder, true, true, 0, 1024, 2048>(lds, g, S, E); }
    else if constexpr (PH == 11) phase_norm2(p, lds, G);
    else if constexpr (PH == 12) { pg8::Gemm g{(const bf16*)(ws + WS_H2), (const bf16*)(ws + WS_WQ), T, 2048, 1024, 1024}; pg8::StaticOrder S; S.init(T, 2048, G, (int)blockIdx.x);
        EpiPlain E{(bf16*)(ws + WS_QRY), 2048}; pg8::gemm_phase<EpiPlain, pg8::StaticOrder, true, true, 0, 1024, 1024>(lds, g, S, E); }
    else if constexpr (PH == 13) { pg8::Gemm g{(const bf16*)(ws + WS_QRY), (const bf16*)(ws + WS_SUBK), T, 2048, 256, 2048}; pg8::StaticOrder S; S.init(T, 2048, G, (int)blockIdx.x);
        EpiF16 E{(unsigned short*)(ws + WS_SC), 2048}; pg8::gemm_phase<EpiF16, pg8::StaticOrder, true, true, 2, 256, 2048>(lds, g, S, E); }
    else if constexpr (PH == 14) phase_topk(p, lds, G);
    else if constexpr (PH == 15) phase_gather(p, lds, G);
}
template <int PH>
__global__ void __launch_bounds__(NTHR, 2) k_phase(Params p) {
    extern __shared__ __attribute__((aligned(16))) unsigned char lds_raw[];
    run_phase<PH>(p, (LAS unsigned char*)lds_raw, (int)gridDim.x);
}
constexpr int LDS_BAR_OFF = LDS_BYTES - 16;
template <int PH>
__device__ __forceinline__ void run_from(const Params& p, LAS unsigned char* lds, int G, const XcdBarrier& bar) {
#if PROBE_PH >= 0
    unsigned long long pt0 = 0; if constexpr (PH == PROBE_PH) pt0 = __builtin_amdgcn_s_memrealtime();
#endif
    run_phase<PH>(p, lds, G);
    if constexpr (PH + 1 < N_PHASES) {
        if constexpr (PH == 0) cg::this_grid().sync();
        else xcd_barrier(bar);
    }
#if PROBE_PH >= 0
    if constexpr (PH == PROBE_PH) { const unsigned long long pt1 = __builtin_amdgcn_s_memrealtime(), span = pt1 - pt0;
        while (__builtin_amdgcn_s_memrealtime() - pt1 < (unsigned long long)PROBE_MULT * span) __builtin_amdgcn_s_sleep(8); }
#endif
    if constexpr (PH + 1 < N_PHASES) run_from<PH + 1>(p, lds, G, bar);
}
__global__ void __launch_bounds__(NTHR, 2) k_mega(Params p) {
    extern __shared__ __attribute__((aligned(16))) unsigned char lds_raw[];
    LAS unsigned char* lds = (LAS unsigned char*)lds_raw;
    if (threadIdx.x < 4) ((LAS unsigned*)(lds + LDS_BAR_OFF))[threadIdx.x] = 0u;
    __syncthreads();
    const XcdBarrier bar = xcd_barrier_post((unsigned*)(p.ws + WS_CTL), (volatile LAS unsigned*)(lds + LDS_BAR_OFF));
    run_from<0>(p, lds, (int)gridDim.x, bar);
}

extern "C" void kernel_launch(void* const* d_in, const int* in_sizes, int n_in, void* d_out, int out_size, void* d_ws, size_t ws_size, hipStream_t stream) {
    static int grid = 0;
    if (grid == 0) {
        if (n_in != 24 || in_sizes[0] != T * DM || out_size != T * DM || ws_size < WS_END) {
            fprintf(stderr, "kernel_launch: unexpected shapes: n_in %d in0 %d out %d ws %zu\n", n_in, n_in > 0 ? in_sizes[0] : -1, out_size, ws_size); grid = -1; return; }
        int dev = 0, cus = 0, per_cu = 0;
        if (hipGetDevice(&dev) != hipSuccess || hipDeviceGetAttribute(&cus, hipDeviceAttributeMultiprocessorCount, dev) != hipSuccess) { grid = -1; return; }
        if (hipFuncSetAttribute((const void*)k_mega, hipFuncAttributeMaxDynamicSharedMemorySize, LDS_BYTES) != hipSuccess) { fprintf(stderr, "kernel_launch: hipFuncSetAttribute failed\n"); grid = -1; return; }
        if (hipOccupancyMaxActiveBlocksPerMultiprocessor(&per_cu, (const void*)k_mega, NTHR, LDS_BYTES) != hipSuccess || per_cu < 1) { fprintf(stderr, "kernel_launch: occupancy query says %d blocks per CU\n", per_cu); grid = -1; return; }
        (void)hipGetLastError();
        grid = cus;
    }
    if (grid < 0) return;
    Params p{};
    const float** pp = (const float**)&p;
    for (int i = 0; i < 24; ++i) pp[i] = (const float*)d_in[i];
    p.out = (float*)d_out; p.ws = (unsigned char*)d_ws;
    if (hipMemsetAsync((char*)d_ws + WS_CTL, 0, 65536, stream) != hipSuccess) { fprintf(stderr, "kernel_launch: hipMemsetAsync failed\n"); return; }
    void* args[] = {&p};
    hipError_t e = hipLaunchCooperativeKernel((const void*)k_mega, dim3(grid), dim3(NTHR), args, LDS_BYTES, stream);
    if (e != hipSuccess) fprintf(stderr, "kernel_launch: cooperative launch failed: %s (grid %d)\n", hipGetErrorString(e), grid);
}
```

```cpp
#include <hip/hip_runtime.h>
#include <hip/hip_cooperative_groups.h>
#include <cstdio>
#include <cstdint>
#include <utility>
namespace cg = cooperative_groups;

namespace pg8 {
#define PG8_LAS __attribute__((address_space(3)))
typedef unsigned short bf16_t;
typedef short bf16x8 __attribute__((ext_vector_type(8)));
typedef float f32x4 __attribute__((ext_vector_type(4)));
typedef unsigned u32x4 __attribute__((ext_vector_type(4)));
constexpr int BM = 256, BK = 64, HALF = 128, HTB = HALF * BK * 2  , STAGE_BYTES = 8 * HTB, NXCD = 8, WGM = 8;

__host__ __device__ __forceinline__ int lds_byte(int r, int c) { const int st = (r >> 4) * 2 + (c >> 5), rr = r & 15, cc = c & 31, ob = rr * 64 + cc * 2; return st * 1024 + (ob ^ (((ob >> 9) & 1) << 5)); }
__host__ __device__ __forceinline__ void stage_rc(int b, int& R, int& C) { const int st = b / 1024, sb = b % 1024, swz = sb ^ (((sb >> 9) & 1) << 5); R = (st >> 1) * 16 + swz / 64; C = (st & 1) * 32 + (swz % 64) / 2; }
__host__ __device__ __forceinline__ int perm32(int rho) { const int n = rho >> 4, i = rho & 15; return 8 * (i >> 2) + 4 * n + (i & 3); }

struct Unit { int pm, pn; };
struct Gemm { const bf16_t* A; const bf16_t* Bt; int M, N, K, lda; };
template <int AMODE> __device__ __forceinline__ size_t a_off_bytes(const Gemm& g, const Unit& u) {
    const int ac = AMODE == 0 ? 0 : (AMODE == 1 ? 128 * (u.pn < 6 ? u.pn : 6) : 256 * u.pn);
    return ((size_t)u.pm * BM * (size_t)g.lda + (size_t)ac) * 2;
}

struct StaticOrder {
    int nM, nN, nwg, G, c;
    __host__ __device__ void init(int M, int N, int G_, int c_) { nM = M / BM; nN = N / BM; nwg = nM * nN; G = G_; c = c_; }
    __host__ __device__ bool next(int i, Unit& u) const {
        const long L = (long)i * G + c; if (L >= nwg) return false;
        int wgid = (int)L; { const int q = nwg / NXCD, r = nwg % NXCD, xcd = wgid % NXCD, off = wgid / NXCD; wgid = (xcd < r ? xcd * (q + 1) : r * (q + 1) + (xcd - r) * q) + off; }
        const int nig = WGM * nN, gid = wgid / nig, fm = gid * WGM, gsz = (nM - fm) < WGM ? (nM - fm) : WGM;
        u.pm = fm + ((wgid % nig) % gsz); u.pn = (wgid % nig) / gsz; return true;
    }
    __device__ __forceinline__ void a_ready(const Unit&) const {}
    __device__ __forceinline__ void done(const Unit&) const {}
};

__device__ __forceinline__ unsigned cvt_pk_bf16(float lo, float hi) { unsigned r; asm volatile("v_cvt_pk_bf16_f32 %0, %1, %2" : "=v"(r) : "v"(lo), "v"(hi)); return r; }

template <class Epi, class Sched, bool ALIGN_EPI = false, bool SP2 = false, int AMODE = 0, int KC = 0, int LDAC = 0>
__device__ __forceinline__ void gemm_phase(PG8_LAS unsigned char* lds, const Gemm g, const Sched& S, const Epi& E) {
    const int tid = threadIdx.x, wid = __builtin_amdgcn_readfirstlane(tid >> 6), lane = tid & 63, wr = wid >> 2, wc = wid & 3, fr = lane & 15, fq = lane >> 4;
    const int K = KC ? KC : g.K, nt = K / BK; const int lda = LDAC ? LDAC : g.lda;
    unsigned voffA[2], voffB[2];
#pragma unroll
    for (int i = 0; i < 2; ++i) { int R, C; stage_rc(tid * 16 + i * 8192, R, C); const int Rb = Epi::PERM ? ((R & ~31) + perm32(R & 31)) : R;
        voffA[i] = (unsigned)(R * lda + C) * 2u; voffB[i] = (unsigned)(Rb * K + C) * 2u; }
    const size_t kstep = (size_t)(BK * 2);
    const size_t hstepA = (size_t)HALF * lda * 2;
    const size_t hstepB = (size_t)HALF * K * 2;
    const size_t tstepB = 2 * hstepB;
    const unsigned ldsw = (unsigned)wid * 1024u;
    const int aoff = lds_byte(wr * 64 + fr, fq * 8), boff = lds_byte(wc * 32 + fr, fq * 8);
#define PG8_SA(b, h) (((b) * 2 + (h)) * HTB)
#define PG8_SB(b, h) ((4 + (b) * 2 + (h)) * HTB)
#define PG8_STAGE(bufoff, gbase, voff) do { _Pragma("unroll") for (int _i = 0; _i < 2; ++_i) \
        __builtin_amdgcn_global_load_lds((const unsigned*)((const char*)(gbase) + (voff)[_i]), (PG8_LAS unsigned*)(lds + (bufoff) + ldsw + _i * 8192), 16, 0, 0); } while (0)
#define PG8_LDA(dst, b, h) do { _Pragma("unroll") for (int m = 0; m < 4; ++m) _Pragma("unroll") for (int k = 0; k < 2; ++k) dst[m][k] = *(const PG8_LAS bf16x8*)(lds + PG8_SA(b, h) + aoff + m * 2048 + k * 1024); } while (0)
#define PG8_LDB(dst, b, h) do { _Pragma("unroll") for (int n = 0; n < 2; ++n) _Pragma("unroll") for (int k = 0; k < 2; ++k) dst[n][k] = *(const PG8_LAS bf16x8*)(lds + PG8_SB(b, h) + boff + n * 2048 + k * 1024); } while (0)
#define PG8_MMA(ai, bj, At, Bt) do { __builtin_amdgcn_s_setprio(1); _Pragma("unroll") for (int m = 0; m < 4; ++m) _Pragma("unroll") for (int n = 0; n < 2; ++n) _Pragma("unroll") for (int k = 0; k < 2; ++k) \
        acc[ai][bj][m][n] = __builtin_amdgcn_mfma_f32_16x16x32_bf16(Bt[n][k], At[m][k], acc[ai][bj][m][n], 0, 0, 0); __builtin_amdgcn_s_setprio(0); } while (0)
#define PG8_WAIT_V(n) asm volatile("s_waitcnt vmcnt(" #n ")" ::: "memory")
#define PG8_WAIT_L(n) asm volatile("s_waitcnt lgkmcnt(" #n ")" ::: "memory")
#define PG8_BAR __builtin_amdgcn_s_barrier()
#define PG8_SCHED __builtin_amdgcn_sched_barrier(0)
    Unit cur, nxt; int ui = 0;
    if (!S.next(0, cur)) return;
    f32x4 acc[2][2][4][2];
#pragma unroll
    for (int a = 0; a < 2; ++a)
#pragma unroll
        for (int b = 0; b < 2; ++b)
#pragma unroll
            for (int m = 0; m < 4; ++m)
#pragma unroll
                for (int n = 0; n < 2; ++n) acc[a][b][m][n] = (f32x4){0.f, 0.f, 0.f, 0.f};
    bf16x8 At[4][2], B0[2][2], B1[2][2];
    const char* cA = (const char*)g.A + a_off_bytes<AMODE>(g, cur); const char* cB = (const char*)g.Bt + (size_t)cur.pn * tstepB;
    S.a_ready(cur);
    if constexpr (SP2) {
        PG8_STAGE(PG8_SB(0, 0), cB, voffB); PG8_STAGE(PG8_SB(0, 1), cB + hstepB, voffB); PG8_STAGE(PG8_SA(0, 0), cA, voffA); PG8_STAGE(PG8_SA(0, 1), cA + hstepA, voffA);
        if (wr == 1) PG8_BAR;
        PG8_WAIT_V(2); PG8_BAR;
        PG8_STAGE(PG8_SB(1, 0), cB + kstep, voffB); PG8_STAGE(PG8_SA(1, 0), cA + kstep, voffA); PG8_STAGE(PG8_SB(1, 1), cB + hstepB + kstep, voffB);
        PG8_WAIT_V(6); PG8_BAR;
    } else {
        PG8_STAGE(PG8_SB(0, 0), cB, voffB); PG8_STAGE(PG8_SA(0, 0), cA, voffA); PG8_STAGE(PG8_SB(0, 1), cB + hstepB, voffB); PG8_STAGE(PG8_SA(0, 1), cA + hstepA, voffA);
        if (wr == 1) PG8_BAR;
        PG8_WAIT_V(4); PG8_BAR;
        PG8_STAGE(PG8_SB(1, 0), cB + kstep, voffB); PG8_STAGE(PG8_SA(1, 0), cA + kstep, voffA); PG8_STAGE(PG8_SB(1, 1), cB + hstepB + kstep, voffB);
        PG8_WAIT_V(6); PG8_BAR;
    }
    for (;;) {
        const bool has_next = S.next(ui + 1, nxt);
        const char* nA = has_next ? (const char*)g.A + a_off_bytes<AMODE>(g, nxt) : cA; const char* nB = has_next ? (const char*)g.Bt + (size_t)nxt.pn * tstepB : cB;
#pragma unroll 1
        for (int t = 0; t < nt; t += 2) {
            const bool last = (t == nt - 2);
            const char* a1 = cA + (size_t)(t + 1) * kstep;
            const char* a2 = last ? nA : cA + (size_t)(t + 2) * kstep; const char* b2 = last ? nB : cB + (size_t)(t + 2) * kstep;
            const char* a3 = a2 + kstep; const char* b3 = b2 + kstep;
            if (last && has_next) S.a_ready(nxt);
            if constexpr (SP2) {
            PG8_LDB(B0, 0, 0); PG8_LDB(B1, 0, 1); PG8_SCHED; PG8_LDA(At, 0, 0); PG8_STAGE(PG8_SA(1, 1), a1 + hstepA, voffA);
            PG8_WAIT_V(8); PG8_WAIT_L(0); PG8_BAR; PG8_MMA(0, 0, At, B0); PG8_MMA(0, 1, At, B1); PG8_BAR; PG8_SCHED;
            PG8_LDA(At, 0, 1); PG8_STAGE(PG8_SB(0, 0), b2, voffB); PG8_STAGE(PG8_SB(0, 1), b2 + hstepB, voffB); PG8_STAGE(PG8_SA(0, 0), a2, voffA);
            PG8_WAIT_V(8); PG8_WAIT_L(0); PG8_BAR; PG8_MMA(1, 0, At, B0); PG8_MMA(1, 1, At, B1); PG8_BAR; PG8_SCHED;
            PG8_LDB(B0, 1, 0); PG8_LDB(B1, 1, 1); PG8_SCHED; PG8_LDA(At, 1, 0); PG8_STAGE(PG8_SA(0, 1), a2 + hstepA, voffA);
            PG8_WAIT_V(8); PG8_WAIT_L(0); PG8_BAR; PG8_MMA(0, 0, At, B0); PG8_MMA(0, 1, At, B1); PG8_BAR; PG8_SCHED;
            PG8_LDA(At, 1, 1); PG8_STAGE(PG8_SB(1, 0), b3, voffB); PG8_STAGE(PG8_SB(1, 1), b3 + hstepB, voffB); PG8_STAGE(PG8_SA(1, 0), a3, voffA);
            PG8_WAIT_V(8); PG8_WAIT_L(0); PG8_BAR; PG8_MMA(1, 0, At, B0); PG8_MMA(1, 1, At, B1); PG8_BAR; PG8_SCHED;
            } else {
            PG8_LDB(B0, 0, 0); PG8_SCHED; PG8_LDA(At, 0, 0); PG8_STAGE(PG8_SA(1, 1), a1 + hstepA, voffA);
            PG8_WAIT_L(8); PG8_BAR; PG8_WAIT_L(0); PG8_MMA(0, 0, At, B0); PG8_BAR; PG8_SCHED;
            PG8_LDB(B1, 0, 1); PG8_STAGE(PG8_SB(0, 0), b2, voffB);
            PG8_BAR; PG8_WAIT_L(0); PG8_MMA(0, 1, At, B1); PG8_BAR;
            PG8_LDA(At, 0, 1); PG8_STAGE(PG8_SA(0, 0), a2, voffA);
            PG8_BAR; PG8_WAIT_L(0); PG8_MMA(1, 0, At, B0); PG8_BAR; PG8_SCHED;
            PG8_STAGE(PG8_SB(0, 1), b2 + hstepB, voffB);
            PG8_WAIT_V(6); PG8_BAR; PG8_MMA(1, 1, At, B1); PG8_BAR;
            PG8_LDB(B0, 1, 0); PG8_SCHED; PG8_LDA(At, 1, 0); PG8_STAGE(PG8_SA(0, 1), a2 + hstepA, voffA);
            PG8_WAIT_L(8); PG8_BAR; PG8_WAIT_L(0); PG8_MMA(0, 0, At, B0); PG8_BAR; PG8_SCHED;
            PG8_LDB(B1, 1, 1); PG8_STAGE(PG8_SB(1, 0), b3, voffB);
            PG8_BAR; PG8_WAIT_L(0); PG8_MMA(0, 1, At, B1); PG8_BAR;
            PG8_LDA(At, 1, 1); PG8_STAGE(PG8_SA(1, 0), a3, voffA);
            PG8_BAR; PG8_WAIT_L(0); PG8_MMA(1, 0, At, B0); PG8_BAR; PG8_SCHED;
            PG8_STAGE(PG8_SB(1, 1), b3 + hstepB, voffB);
            PG8_WAIT_V(6); PG8_BAR; PG8_MMA(1, 1, At, B1); PG8_BAR;
            }
        }
        if constexpr (ALIGN_EPI) { if (wr == 0) PG8_BAR; }
        E(acc, cur, wr, wc, fr, fq); S.done(cur);
        if (!has_next) break;
#pragma unroll
        for (int a = 0; a < 2; ++a)
#pragma unroll
            for (int b = 0; b < 2; ++b)
#pragma unroll
                for (int m = 0; m < 4; ++m)
#pragma unroll
                    for (int n = 0; n < 2; ++n) acc[a][b][m][n] = (f32x4){0.f, 0.f, 0.f, 0.f};
        cur = nxt; cA = nA; cB = nB; ++ui;
        if constexpr (ALIGN_EPI) { if (wr == 1) PG8_BAR; }
    }
    PG8_WAIT_V(0);
    if constexpr (!ALIGN_EPI) { if (wr == 0) PG8_BAR; }
    PG8_BAR;
#undef PG8_SA
#undef PG8_SB
#undef PG8_STAGE
#undef PG8_LDA
#undef PG8_LDB
#undef PG8_MMA
#undef PG8_WAIT_V
#undef PG8_WAIT_L
#undef PG8_BAR
#undef PG8_SCHED
}
}

constexpr int NB = 8, SEQ = 8192, DM = 1024, T = NB * SEQ;
constexpr int NPAD = 7424;
constexpr int NWAVES = 8, NTHR = 512;
constexpr int LDS_BYTES = 147456;
constexpr int N_PHASES = 15;
#define PROBE_PH -1
#define PROBE_MULT 3

constexpr size_t MiB = 1ull << 20;
constexpr size_t WS_CTL = 0;
constexpr size_t WS_MODP = 1 * MiB;
constexpr size_t WS_WIN = 3 * MiB;
constexpr size_t WS_WOUT = 18 * MiB;
constexpr size_t WS_WQ = 20 * MiB;
constexpr size_t WS_LRUB = 24 * MiB;
constexpr size_t WS_SUBK = 25 * MiB;
constexpr size_t WS_LRUC = 26 * MiB;
constexpr size_t WS_U = 32 * MiB;
constexpr size_t WS_V = 48 * MiB;
constexpr size_t WS_SU = 64 * MiB;
constexpr size_t WS_SV = 65 * MiB;
constexpr size_t WS_SS = 30 * MiB;
constexpr size_t WS_DK = 66 * MiB;
constexpr size_t WS_QKV = 96 * MiB;
constexpr size_t WS_R = 352 * MiB;
constexpr size_t WS_XLXG = 480 * MiB;
constexpr size_t WS_GAGB = 736 * MiB;
constexpr size_t WS_ALOW = 992 * MiB;
constexpr size_t WS_END = 994 * MiB;
constexpr size_t WS_Y = WS_QKV;
constexpr size_t WS_H2 = WS_QKV + 128 * MiB;
constexpr size_t WS_QRY = WS_XLXG;
constexpr size_t WS_SC = WS_GAGB;
constexpr size_t WS_TOPK = WS_R;
constexpr size_t WS_TOPK2 = WS_R + 32 * MiB;

#define LAS __attribute__((address_space(3)))
typedef unsigned short bf16;
typedef float f32x4 __attribute__((ext_vector_type(4)));
typedef float f32x2 __attribute__((ext_vector_type(2)));
typedef unsigned u32x4 __attribute__((ext_vector_type(4)));
typedef unsigned u32x2 __attribute__((ext_vector_type(2)));

struct Params {
    const float *x, *c, *w_ada, *b_ada, *npm, *npo, *w_in, *w_alpha, *b_alpha, *gla_norm, *conv_w, *conv_b,
        *lwa, *lba, *lwx, *lbx, *lam, *w_out, *npf, *npof, *wq, *subk, *pu, *pv;
    float* out; unsigned char* ws;
    int ph_lo, ph_hi;
};

__device__ __forceinline__ unsigned f2bf(float f) { unsigned u = __builtin_bit_cast(unsigned, f); return (u + 0x7fffu + ((u >> 16) & 1u)) >> 16; }
__device__ __forceinline__ unsigned pk2(float lo, float hi) { return f2bf(lo) | (f2bf(hi) << 16); }
__device__ __forceinline__ float bflo(unsigned u) { return __builtin_bit_cast(float, u << 16); }
__device__ __forceinline__ float bfhi(unsigned u) { return __builtin_bit_cast(float, u & 0xffff0000u); }
__device__ __forceinline__ float bf2f(bf16 h) { return __builtin_bit_cast(float, (unsigned)h << 16); }
__device__ __forceinline__ float sigmoid_f(float x) { return 1.f / (1.f + __expf(-x)); }
__device__ __forceinline__ float silu_f(float x) { return x / (1.f + __expf(-x)); }
__device__ __forceinline__ float gelu_f(float x) { const float u = 0.7978845608028654f * (x + 0.044715f * x * x * x); return x / (1.f + __expf(-2.f * u)); }
__device__ __forceinline__ float softplus_f(float x) { return fmaxf(x, 0.f) + log1pf(__expf(-fabsf(x))); }
__device__ __forceinline__ float wave_sum(float v) {
#pragma unroll
    for (int o = 1; o < 64; o <<= 1) v += __shfl_xor(v, o);
    return v;
}
#define LDS_WAIT() asm volatile("s_waitcnt lgkmcnt(0)" ::: "memory")

struct EpiSeg {
    static constexpr bool PERM = true;
    unsigned char* ws;
    __device__ __forceinline__ void operator()(const pg8::f32x4 (&acc)[2][2][4][2], const pg8::Unit& u, int wr, int wc, int fr, int fq) const {
        const int pn = u.pn; bf16* base; int ldc, colt;
        if (pn < 8) { base = (bf16*)(ws + WS_QKV); ldc = 2048; colt = pn * 256; }
        else if (pn < 12) { base = (bf16*)(ws + WS_R); ldc = 1024; colt = (pn - 8) * 256; }
        else if (pn < 20) { base = (bf16*)(ws + WS_XLXG); ldc = 2048; colt = (pn - 12) * 256; }
        else if (pn < 28) { base = (bf16*)(ws + WS_GAGB); ldc = 2048; colt = (pn - 20) * 256; }
        else { base = (bf16*)(ws + WS_ALOW); ldc = 16; colt = 0; }
        const int row0 = u.pm * 256 + wr * 64 + fr, col0 = colt + wc * 32 + 8 * fq;
        const bool tail = (pn == 28);
#pragma unroll
        for (int ai = 0; ai < 2; ++ai)
#pragma unroll
            for (int m = 0; m < 4; ++m) { bf16* rowp = base + (size_t)(row0 + ai * 128 + m * 16) * ldc + col0;
#pragma unroll
                for (int bj = 0; bj < 2; ++bj) { const pg8::f32x4 v0 = acc[ai][bj][m][0], v1 = acc[ai][bj][m][1];
                    u32x4 w; w.x = pg8::cvt_pk_bf16(v0[0], v0[1]); w.y = pg8::cvt_pk_bf16(v0[2], v0[3]); w.z = pg8::cvt_pk_bf16(v1[0], v1[1]); w.w = pg8::cvt_pk_bf16(v1[2], v1[3]);
                    if (!tail || (bj == 0 && wc == 0 && fq < 2)) *(u32x4*)(rowp + bj * 128) = w; } }
    }
};
struct EpiPlain {
    static constexpr bool PERM = true;
    bf16* O; int ldc;
    __device__ __forceinline__ void operator()(const pg8::f32x4 (&acc)[2][2][4][2], const pg8::Unit& u, int wr, int wc, int fr, int fq) const {
        const int row0 = u.pm * 256 + wr * 64 + fr, col0 = u.pn * 256 + wc * 32 + 8 * fq;
#pragma unroll
        for (int ai = 0; ai < 2; ++ai)
#pragma unroll
            for (int m = 0; m < 4; ++m) { bf16* rowp = O + (size_t)(row0 + ai * 128 + m * 16) * ldc + col0;
#pragma unroll
                for (int bj = 0; bj < 2; ++bj) { const pg8::f32x4 v0 = acc[ai][bj][m][0], v1 = acc[ai][bj][m][1];
                    u32x4 w; w.x = pg8::cvt_pk_bf16(v0[0], v0[1]); w.y = pg8::cvt_pk_bf16(v0[2], v0[3]); w.z = pg8::cvt_pk_bf16(v1[0], v1[1]); w.w = pg8::cvt_pk_bf16(v1[2], v1[3]);
                    *(u32x4*)(rowp + bj * 128) = w; } }
    }
};
typedef _Float16 h16x2 __attribute__((ext_vector_type(2)));
__device__ __forceinline__ unsigned pkh(float a, float b) { return __builtin_bit_cast(unsigned, __builtin_amdgcn_cvt_pkrtz(a, b)); }
struct EpiF16 {
    static constexpr bool PERM = true;
    unsigned short* O; int ldc;
    __device__ __forceinline__ void operator()(const pg8::f32x4 (&acc)[2][2][4][2], const pg8::Unit& u, int wr, int wc, int fr, int fq) const {
        const int row0 = u.pm * 256 + wr * 64 + fr, col0 = u.pn * 256 + wc * 32 + 8 * fq;
#pragma unroll
        for (int ai = 0; ai < 2; ++ai)
#pragma unroll
            for (int m = 0; m < 4; ++m) { unsigned short* rowp = O + (size_t)(row0 + ai * 128 + m * 16) * ldc + col0;
#pragma unroll
                for (int bj = 0; bj < 2; ++bj) { const pg8::f32x4 v0 = acc[ai][bj][m][0], v1 = acc[ai][bj][m][1];
                    u32x4 w; w.x = pkh(v0[0], v0[1]); w.y = pkh(v0[2], v0[3]); w.z = pkh(v1[0], v1[1]); w.w = pkh(v1[2], v1[3]);
                    *(u32x4*)(rowp + bj * 128) = w; } }
    }
};
struct EpiLru {
    static constexpr bool PERM = true;
    bf16* LA;   bf16* XCU;   const float *lba, *lbx, *lam;
    __device__ __forceinline__ void operator()(const pg8::f32x4 (&acc)[2][2][4][2], const pg8::Unit& u, int wr, int wc, int fr, int fq) const {
        const int row0 = u.pm * 256 + wr * 64 + fr, ch0 = u.pn * 128 + wc * 32 + 8 * fq;
        float ba[8], bx[8], sp[8];
#pragma unroll
        for (int j = 0; j < 8; ++j) { ba[j] = lba[ch0 + j]; bx[j] = lbx[ch0 + j]; sp[j] = -8.f * softplus_f(-lam[ch0 + j]); }
#pragma unroll
        for (int ai = 0; ai < 2; ++ai)
#pragma unroll
            for (int m = 0; m < 4; ++m) { const size_t row = (size_t)(row0 + ai * 128 + m * 16);
                const u32x4 xw = *(const u32x4*)(XCU + row * 1024 + ch0);
                float xc[8] = {bflo(xw.x), bfhi(xw.x), bflo(xw.y), bfhi(xw.y), bflo(xw.z), bfhi(xw.z), bflo(xw.w), bfhi(xw.w)};
                float la[8], uu[8];
#pragma unroll
                for (int j = 0; j < 8; ++j) { const float pr = acc[ai][0][m][j >> 2][j & 3] + ba[j], pi = acc[ai][1][m][j >> 2][j & 3] + bx[j];
                    const float gr = sigmoid_f(pr), gi = sigmoid_f(pi);
                    la[j] = sp[j] * gr; const float a2 = __expf(2.f * la[j]);
                    uu[j] = sqrtf(fmaxf(1.f - a2, 0.f)) * gi * xc[j]; }
                u32x4 w1, w2; w1.x = pk2(la[0], la[1]); w1.y = pk2(la[2], la[3]); w1.z = pk2(la[4], la[5]); w1.w = pk2(la[6], la[7]);
                w2.x = pk2(uu[0], uu[1]); w2.y = pk2(uu[2], uu[3]); w2.z = pk2(uu[4], uu[5]); w2.w = pk2(uu[6], uu[7]);
                *(u32x4*)(LA + row * 2048 + ch0) = w1; *(u32x4*)(XCU + row * 1024 + ch0) = w2; }
    }
};

__device__ __forceinline__ void p0_transpose_item(const float* W, int ldw, int k0, int n0, int nvalid, bf16* WT, int ldk, int row0, int kc0, LAS float* scr, int lane) {
#pragma unroll 8
    for (int i = 0; i < 32; ++i) { const int kk = 2 * i + (lane >> 5), cc = lane & 31; scr[kk * 33 + cc] = (cc < nvalid) ? W[(size_t)(k0 + kk) * ldw + n0 + cc] : 0.f; }
    LDS_WAIT(); asm volatile("" ::: "memory");
    const int c = lane & 7;
#pragma unroll
    for (int j = 0; j < 4; ++j) { const int n = (lane >> 3) + 8 * j; const LAS float* s = scr + (8 * c) * 33 + n;
        u32x4 o; o.x = pk2(s[0 * 33], s[1 * 33]); o.y = pk2(s[2 * 33], s[3 * 33]); o.z = pk2(s[4 * 33], s[5 * 33]); o.w = pk2(s[6 * 33], s[7 * 33]);
        *(u32x4*)(WT + (size_t)(row0 + n) * ldk + kc0 + k0 + 8 * c) = o; }
    LDS_WAIT(); asm volatile("" ::: "memory");
}
__device__ __forceinline__ void phase0(const Params& p, LAS unsigned char* lds, int G) {
    const int tid = threadIdx.x, lane = tid & 63, wave = __builtin_amdgcn_readfirstlane(tid >> 6);
    unsigned char* ws = p.ws;
    {
        LAS float* sc = (LAS float*)lds;
        LAS float* red = (LAS float*)(lds + 4096);
        float* modp = (float*)(ws + WS_MODP);
        for (int it = blockIdx.x; it < 24 * 8; it += G) {
            const int nb = it % 24, kc = it / 24;
            for (int i = tid; i < 1024; i += NTHR) { const int b = i >> 7, k = i & 127; sc[i] = silu_f(p.c[b * 1024 + kc * 128 + k]); }
            __syncthreads();
            const int col = tid & 255, kh = tid >> 8;
            float acc[8];
#pragma unroll
            for (int b = 0; b < 8; ++b) acc[b] = 0.f;
            const float* wp = p.w_ada + (size_t)(kc * 128 + kh * 64) * 6144 + nb * 256 + col;
#pragma unroll 8
            for (int kk = 0; kk < 64; ++kk) { const float w = wp[(size_t)kk * 6144];
#pragma unroll
                for (int b = 0; b < 8; ++b) acc[b] += sc[b * 128 + kh * 64 + kk] * w; }
            if (kh == 1) {
#pragma unroll
                for (int b = 0; b < 8; ++b) red[b * 256 + col] = acc[b]; }
            __syncthreads();
            if (kh == 0) { const int n = nb * 256 + col; const float bias = (kc == 0) ? p.b_ada[n] : 0.f;
#pragma unroll
                for (int b = 0; b < 8; ++b) modp[(size_t)(kc * 8 + b) * 6144 + n] = acc[b] + red[b * 256 + col] + bias; }
            __syncthreads();
        }
    }
    for (int i = blockIdx.x * NTHR + tid; i < T * 4 / 4; i += G * NTHR) ((f32x4*)(ws + WS_SS))[i] = (f32x4){0.f, 0.f, 0.f, 0.f};
    LAS float* scr = (LAS float*)(lds + 16384 + wave * 8448);
    const int gw = blockIdx.x * NWAVES + wave, NGW = G * NWAVES;
    bf16* WinT = (bf16*)(ws + WS_WIN); bf16* WoutT = (bf16*)(ws + WS_WOUT); bf16* WqT = (bf16*)(ws + WS_WQ);
    bf16* LruB = (bf16*)(ws + WS_LRUB); bf16* SubK = (bf16*)(ws + WS_SUBK);
    constexpr int I_IN = 16 * (NPAD / 32), I_OUT = 16 * 32, I_Q = 16 * 64, I_LRU = 16 * 8, I_SUB = 2048, I_TAB = 2 * 16384;
    constexpr int NIT = I_IN + I_OUT + I_Q + I_LRU + I_SUB + I_TAB;
    for (int it = gw; it < NIT; it += NGW) {
        int r = it;
        if (r < I_IN) { const int nb = r % (NPAD / 32), kb = r / (NPAD / 32), nq = nb * 32; int n0, nv;
            if (nq < 3072) { n0 = nq; nv = 32; } else if (nq < 7168) { n0 = nq + 16; nv = 32; } else if (nq == 7168) { n0 = 3072; nv = 16; } else { n0 = 0; nv = 0; }
            p0_transpose_item(p.w_in, 7184, kb * 64, n0, nv, WinT, 1024, nq, 0, scr, lane); continue; } r -= I_IN;
        if (r < I_OUT) { const int nb = r % 32, kb = r / 32; p0_transpose_item(p.w_out, 1024, kb * 64, nb * 32, 32, WoutT, 1024, nb * 32, 0, scr, lane); continue; } r -= I_OUT;
        if (r < I_Q) { const int nb = r % 64, kb = r / 64; p0_transpose_item(p.wq, 2048, kb * 64, nb * 32, 32, WqT, 1024, nb * 32, 0, scr, lane); continue; } r -= I_Q;
        if (r < I_LRU) {
            const int mat = r >> 3, sub = r & 7, g = mat >> 3, n = mat & 7, kb = sub >> 2, nb = sub & 3;
            const int np = n < 6 ? n : 6, half = n - np;
            const float* W = (g ? p.lwx : p.lwa) + (size_t)n * 128 * 128;
            bf16* dst = LruB + (size_t)n * 256 * 256;
            p0_transpose_item(W, 128, kb * 64, nb * 32, 32, dst, 256, g * 128 + nb * 32, half * 128, scr, lane);
            p0_transpose_item(W, 128, kb * 64, 0, 0, dst, 256, g * 128 + nb * 32, (1 - half) * 128, scr, lane);
            continue; } r -= I_LRU;
        if (r < I_SUB) {
            const int h = r >> 8, pp = (r >> 7) & 1, n = r & 127;
            const float* src = p.subk + (size_t)r * 128; bf16* dst = SubK + ((size_t)h * 256 + pp * 128 + n) * 256;
            const f32x2 v = *(const f32x2*)(src + 2 * lane);
            *(unsigned*)(dst + pp * 128 + 2 * lane) = pk2(v.x, v.y);
            *(unsigned*)(dst + (1 - pp) * 128 + 2 * lane) = 0u;
            continue; } r -= I_SUB;
        {
            const int tb = r >> 14, row = r & 16383;
            const float* src = (tb ? p.pv : p.pu) + (size_t)row * 1024 + lane * 16;
            f32x4 v[4]; float am = 0.f;
#pragma unroll
            for (int j = 0; j < 4; ++j) { v[j] = *(const f32x4*)(src + 4 * j); am = fmaxf(am, fmaxf(fmaxf(fabsf(v[j].x), fabsf(v[j].y)), fmaxf(fabsf(v[j].z), fabsf(v[j].w)))); }
#pragma unroll
            for (int o = 1; o < 64; o <<= 1) am = fmaxf(am, __shfl_xor(am, o));
            const float inv = am > 0.f ? 7.5f / am : 0.f;
            unsigned long long lo = 0ull; unsigned hi = 0u;
#pragma unroll
            for (int j = 0; j < 16; ++j) { const float x = v[j >> 2][j & 3] * inv, a = fabsf(x);
                unsigned code = a < 1.f ? (unsigned)__builtin_rintf(a * 8.f) : (a < 2.f ? 8u + (unsigned)__builtin_rintf((a - 1.f) * 8.f) : (a < 4.f ? 16u + (unsigned)__builtin_rintf((a - 2.f) * 4.f) : 24u + (unsigned)__builtin_rintf((a - 4.f) * 2.f)));
                code = code > 31u ? 31u : code; code |= (x < 0.f) ? 32u : 0u;
                const int bit = 6 * j;
                if (bit + 6 <= 64) lo |= (unsigned long long)code << bit;
                else if (bit >= 64) hi |= code << (bit - 64);
                else { lo |= (unsigned long long)code << bit; hi |= code >> (64 - bit); } }
            unsigned* dst = (unsigned*)(ws + (tb ? WS_V : WS_U) + (size_t)row * 768 + lane * 12);
            dst[0] = (unsigned)lo; dst[1] = (unsigned)(lo >> 32); dst[2] = hi;
            if (lane == 0) ((float*)(ws + (tb ? WS_SV : WS_SU)))[row] = am * (1.f / 7.5f);
        }
    }
}

__device__ __forceinline__ float mod_at(const float* modp, int b, int n) {
    float s = 0.f;
#pragma unroll
    for (int kc = 0; kc < 8; ++kc) s += modp[(size_t)(kc * 8 + b) * 6144 + n];
    return s;
}

__device__ __forceinline__ void phase1(const Params& p, LAS unsigned char* lds, int G) {
    const int tid = threadIdx.x, lane = tid & 63, wave = __builtin_amdgcn_readfirstlane(tid >> 6);
    const float* modp = (const float*)(p.ws + WS_MODP);
    LAS float* gs = (LAS float*)lds; LAS float* sh = gs + 1024;
    bf16* H = (bf16*)p.out;
    for (int tile = blockIdx.x; tile < T / 256; tile += G) {
        const int b = tile / 32;
        __syncthreads();
        for (int k = tid; k < 1024; k += NTHR) { gs[k] = p.npm[k] * (1.f + mod_at(modp, b, 1024 + k)); sh[k] = mod_at(modp, b, k); }
        __syncthreads();
        for (int rr = 0; rr < 32; ++rr) {
            const size_t row = (size_t)tile * 256 + wave * 32 + rr;
            const f32x4* xr = (const f32x4*)(p.x + row * 1024) + lane;
            f32x4 v[4]; float s = 0.f;
#pragma unroll
            for (int j = 0; j < 4; ++j) { v[j] = xr[64 * j]; s += (v[j].x * v[j].x + v[j].y * v[j].y) + (v[j].z * v[j].z + v[j].w * v[j].w); }
            const float rstd = 1.f / sqrtf(wave_sum(s) * (1.f / 1024.f) + 1e-6f);
            u32x2* o8 = (u32x2*)(H + row * 1024) + lane;
#pragma unroll
            for (int j = 0; j < 4; ++j) { const int k = 256 * j + 4 * lane; const f32x4 g4 = *(const LAS f32x4*)(gs + k), s4 = *(const LAS f32x4*)(sh + k);
                u32x2 w; w.x = pk2(v[j].x * rstd * g4.x + s4.x, v[j].y * rstd * g4.y + s4.y); w.y = pk2(v[j].z * rstd * g4.z + s4.z, v[j].w * rstd * g4.w + s4.w);
                o8[64 * j] = w; }
        }
    }
}

__device__ __forceinline__ void phase_conv(const Params& p, int G) {
    const int tid = threadIdx.x, lane = tid & 63, wave = __builtin_amdgcn_readfirstlane(tid >> 6);
    const int gw = blockIdx.x * NWAVES + wave, NGW = G * NWAVES;
    const bf16* XL = (const bf16*)(p.ws + WS_XLXG); bf16* XC = (bf16*)p.out;
    for (int it = gw; it < (T / 64) * 2; it += NGW) {
        const int rt = it >> 1, c0 = (it & 1) * 512 + lane * 8;
        float w[4][8], cb[8];
#pragma unroll
        for (int j = 0; j < 8; ++j) { cb[j] = p.conv_b[c0 + j];
#pragma unroll
            for (int q = 0; q < 4; ++q) w[q][j] = p.conv_w[q * 1024 + c0 + j]; }
        float x1[8], x2[8], x3[8];
        const int t0 = rt * 64; const bool first = (t0 % SEQ) == 0;
#pragma unroll
        for (int j = 0; j < 8; ++j) { x1[j] = 0.f; x2[j] = 0.f; x3[j] = 0.f; }
        if (!first) {
            const u32x4 a = *(const u32x4*)(XL + (size_t)(t0 - 1) * 2048 + c0), b = *(const u32x4*)(XL + (size_t)(t0 - 2) * 2048 + c0), c = *(const u32x4*)(XL + (size_t)(t0 - 3) * 2048 + c0);
            x1[0] = bflo(a.x); x1[1] = bfhi(a.x); x1[2] = bflo(a.y); x1[3] = bfhi(a.y); x1[4] = bflo(a.z); x1[5] = bfhi(a.z); x1[6] = bflo(a.w); x1[7] = bfhi(a.w);
            x2[0] = bflo(b.x); x2[1] = bfhi(b.x); x2[2] = bflo(b.y); x2[3] = bfhi(b.y); x2[4] = bflo(b.z); x2[5] = bfhi(b.z); x2[6] = bflo(b.w); x2[7] = bfhi(b.w);
            x3[0] = bflo(c.x); x3[1] = bfhi(c.x); x3[2] = bflo(c.y); x3[3] = bfhi(c.y); x3[4] = bflo(c.z); x3[5] = bfhi(c.z); x3[6] = bflo(c.w); x3[7] = bfhi(c.w);
        }
#pragma unroll 4
        for (int i = 0; i < 64; ++i) {
            const u32x4 a = *(const u32x4*)(XL + (size_t)(t0 + i) * 2048 + c0);
            float x0[8] = {bflo(a.x), bfhi(a.x), bflo(a.y), bfhi(a.y), bflo(a.z), bfhi(a.z), bflo(a.w), bfhi(a.w)};
            float o[8];
#pragma unroll
            for (int j = 0; j < 8; ++j) { o[j] = cb[j] + w[0][j] * x3[j] + w[1][j] * x2[j] + w[2][j] * x1[j] + w[3][j] * x0[j]; x3[j] = x2[j]; x2[j] = x1[j]; x1[j] = x0[j]; }
            u32x4 wv; wv.x = pk2(o[0], o[1]); wv.y = pk2(o[2], o[3]); wv.z = pk2(o[4], o[5]); wv.w = pk2(o[6], o[7]);
            *(u32x4*)(XC + (size_t)(t0 + i) * 1024 + c0) = wv;
        }
    }
}

template <bool FINAL>
__device__ __forceinline__ void phase_lru_scan(const Params& p, int G) {
    const int tid = threadIdx.x, ch = 2 * tid;
    const unsigned* LA = (const unsigned*)(p.ws + WS_XLXG); const unsigned* U = (const unsigned*)p.out;
    const unsigned* XG = (const unsigned*)(p.ws + WS_XLXG) + 512; const unsigned* GB = (const unsigned*)(p.ws + WS_GAGB) + 512; unsigned* GA = (unsigned*)(p.ws + WS_GAGB);
    const unsigned* O = (const unsigned*)(p.ws + WS_QKV) + 512; const unsigned* R = (const unsigned*)(p.ws + WS_R);
    const float* SS = (const float*)(p.ws + WS_SS);
    f32x4* car = (f32x4*)(p.ws + WS_LRUC);
    for (int it = blockIdx.x; it < 8 * 32; it += G) {
        const int j = it & 31, b = it >> 5;
        const size_t t0 = (size_t)b * SEQ + j * 256;
        if (!FINAL) {
            float h0 = 0.f, h1 = 0.f, l0 = 0.f, l1 = 0.f;
#pragma unroll 8
            for (int i = 0; i < 256; ++i) { const unsigned la = LA[(t0 + i) * 1024 + tid], u = U[(t0 + i) * 512 + tid];
                h0 = __expf(bflo(la)) * h0 + bflo(u); h1 = __expf(bfhi(la)) * h1 + bfhi(u); l0 += bflo(la); l1 += bfhi(la); }
            car[(size_t)(b * 32 + j) * 512 + tid] = (f32x4){__expf(l0), h0, __expf(l1), h1};
        } else {
            float h0 = 0.f, h1 = 0.f;
            for (int i = 0; i < j; ++i) { const f32x4 c = car[(size_t)(b * 32 + i) * 512 + tid]; h0 = c.x * h0 + c.y; h1 = c.z * h1 + c.w; }
            const int hd = tid >> 7;
            const float gn0 = p.gla_norm[ch], gn1 = p.gla_norm[ch + 1];
#pragma unroll 4
            for (int i = 0; i < 256; ++i) { const size_t t = t0 + i;
                const unsigned la = LA[t * 1024 + tid], u = U[t * 512 + tid], xg = XG[t * 1024 + tid], gb = GB[t * 1024 + tid];
                const unsigned o = O[t * 1024 + tid], r = R[t * 512 + tid], ga = GA[t * 1024 + tid];
                const float rstd = 1.f / sqrtf(SS[t * 4 + hd] * (1.f / 256.f) + 1e-6f);
                h0 = __expf(bflo(la)) * h0 + bflo(u); h1 = __expf(bfhi(la)) * h1 + bfhi(u);
                const float m0 = sigmoid_f(bflo(ga)) * (bflo(o) * rstd * gn0 * silu_f(bflo(r))) + sigmoid_f(bflo(gb)) * (h0 * gelu_f(bflo(xg)));
                const float m1 = sigmoid_f(bfhi(ga)) * (bfhi(o) * rstd * gn1 * silu_f(bfhi(r))) + sigmoid_f(bfhi(gb)) * (h1 * gelu_f(bfhi(xg)));
                GA[t * 1024 + tid] = pk2(m0, m1); }
        }
    }
}

typedef short bf16x8_t __attribute__((ext_vector_type(8)));
__device__ __forceinline__ void phase_gla_prep(const Params& p, LAS unsigned char* lds, int G) {
    const int tid = threadIdx.x;
    LAS float* segt = (LAS float*)lds;
    bf16* QKV = (bf16*)(p.ws + WS_QKV); const bf16* AL = (const bf16*)(p.ws + WS_ALOW); float* DK = (float*)(p.ws + WS_DK);
    const int kp = tid & 127, seg = tid >> 7;
    for (int it = blockIdx.x; it < 8 * 128 * 4; it += G) {
        const int h = it & 3, ch = (it >> 2) & 127, b = it >> 9;
        float wa[16];
#pragma unroll
        for (int r = 0; r < 16; ++r) wa[r] = p.w_alpha[r * 512 + h * 128 + kp];
        const float balpha = p.b_alpha[h * 128 + kp];
        const size_t t0 = (size_t)b * SEQ + ch * 64 + seg * 16;
        float qv[16], kv[16];
#pragma unroll
        for (int i = 0; i < 16; ++i) { qv[i] = bf2f(QKV[(t0 + i) * 2048 + h * 128 + kp]); kv[i] = bf2f(QKV[(t0 + i) * 2048 + 512 + h * 128 + kp]); }
        float cl[16]; float run = 0.f;
#pragma unroll
        for (int i = 0; i < 16; ++i) { const size_t t = t0 + i;
            const u32x4 a0 = *(const u32x4*)(AL + t * 16), a1 = *(const u32x4*)(AL + t * 16 + 8);
            float z = balpha;
            z += bflo(a0.x) * wa[0] + bfhi(a0.x) * wa[1] + bflo(a0.y) * wa[2] + bfhi(a0.y) * wa[3] + bflo(a0.z) * wa[4] + bfhi(a0.z) * wa[5] + bflo(a0.w) * wa[6] + bfhi(a0.w) * wa[7];
            z += bflo(a1.x) * wa[8] + bfhi(a1.x) * wa[9] + bflo(a1.y) * wa[10] + bfhi(a1.y) * wa[11] + bflo(a1.z) * wa[12] + bfhi(a1.z) * wa[13] + bflo(a1.w) * wa[14] + bfhi(a1.w) * wa[15];
            const float ls = fminf(z, 0.f) - __logf(1.f + __expf(-fabsf(z)));
            run += ls * (1.f / 16.f); cl[i] = run; }
        __syncthreads();
        segt[seg * 128 + kp] = run;
        __syncthreads();
        float off = 0.f, tot = 0.f;
#pragma unroll
        for (int s = 0; s < 4; ++s) { const float v = segt[s * 128 + kp]; tot += v; if (s < seg) off += v; }
        if (seg == 0) DK[(size_t)(b * 128 + ch) * 512 + h * 128 + kp] = __expf(tot);
#pragma unroll
        for (int i = 0; i < 16; ++i) { const float cum = cl[i] + off;
            QKV[(t0 + i) * 2048 + h * 128 + kp] = (bf16)f2bf(qv[i] * 0.08838834764831845f * __expf(cum));
            QKV[(t0 + i) * 2048 + 512 + h * 128 + kp] = (bf16)f2bf(kv[i] * __expf(-cum)); }
    }
}
__device__ __forceinline__ void phase_gla_seq(const Params& p, LAS unsigned char* lds, int G) {
    const int tid = threadIdx.x, lane = tid & 63, wave = __builtin_amdgcn_readfirstlane(tid >> 6), q4 = lane >> 4, c16 = lane & 15;
    constexpr int PQ = 136, PS = 72;
    LAS bf16* Qs = (LAS bf16*)lds;
    LAS bf16* Kd = Qs + 64 * PQ;
    LAS bf16* KdT = Kd + 64 * PQ;
    LAS bf16* VT = KdT + 128 * PS;
    LAS bf16* Pm = VT + 32 * PS;
    LAS bf16* ST = Pm + 64 * PS;
    LAS float* dk = (LAS float*)(ST + 32 * PQ);
    const bf16* QKV = (const bf16*)(p.ws + WS_QKV); bf16* VO = (bf16*)(p.ws + WS_QKV); const float* DK = (const float*)(p.ws + WS_DK); float* SS = (float*)(p.ws + WS_SS);
    const int kp = tid & 127, seg = tid >> 7;
    const int vv = tid & 31, sg = tid >> 5;
    const int r0 = tid >> 4, cc = (tid & 15) * 8;
    for (int it = blockIdx.x; it < 8 * 4 * 8; it += G) {
        const int v8 = it & 7, h = (it >> 3) & 3, b = it >> 5;
        pg8::f32x4 sacc[2] = {(pg8::f32x4){0.f, 0.f, 0.f, 0.f}, (pg8::f32x4){0.f, 0.f, 0.f, 0.f}};
        __syncthreads();
        for (int i = tid; i < 32 * PQ / 2; i += NTHR) ((LAS unsigned*)ST)[i] = 0u;
        u32x4 rq[2], rk[2]; unsigned rkt[8], rv[2]; float rdk = 0.f;
#define GLA_LOAD(chn) do { const size_t _t0 = (size_t)b * SEQ + (size_t)(chn) * 64; \
            _Pragma("unroll") for (int _j = 0; _j < 2; ++_j) { rq[_j] = *(const u32x4*)(QKV + (_t0 + r0 + 32 * _j) * 2048 + h * 128 + cc); rk[_j] = *(const u32x4*)(QKV + (_t0 + r0 + 32 * _j) * 2048 + 512 + h * 128 + cc); } \
            _Pragma("unroll") for (int _i = 0; _i < 8; ++_i) { const unsigned _lo = QKV[(_t0 + seg * 16 + 2 * _i) * 2048 + 512 + h * 128 + kp], _hi = QKV[(_t0 + seg * 16 + 2 * _i + 1) * 2048 + 512 + h * 128 + kp]; rkt[_i] = _lo | (_hi << 16); } \
            _Pragma("unroll") for (int _i = 0; _i < 2; ++_i) { const unsigned _lo = QKV[(_t0 + sg * 4 + 2 * _i) * 2048 + 1024 + h * 256 + v8 * 32 + vv], _hi = QKV[(_t0 + sg * 4 + 2 * _i + 1) * 2048 + 1024 + h * 256 + v8 * 32 + vv]; rv[_i] = _lo | (_hi << 16); } \
            if (tid < 128) rdk = DK[(size_t)(b * 128 + (chn)) * 512 + h * 128 + tid]; } while (0)
        GLA_LOAD(0);
#pragma unroll 1
        for (int ch = 0; ch < SEQ / 64; ++ch) {
            const size_t t0 = (size_t)b * SEQ + ch * 64;
#pragma unroll
            for (int j = 0; j < 2; ++j) { *(LAS u32x4*)(Qs + (r0 + 32 * j) * PQ + cc) = rq[j]; *(LAS u32x4*)(Kd + (r0 + 32 * j) * PQ + cc) = rk[j]; }
            *(LAS u32x4*)(KdT + kp * PS + seg * 16) = (u32x4){rkt[0], rkt[1], rkt[2], rkt[3]};
            *(LAS u32x4*)(KdT + kp * PS + seg * 16 + 8) = (u32x4){rkt[4], rkt[5], rkt[6], rkt[7]};
            *(LAS u32x2*)(VT + vv * PS + sg * 4) = (u32x2){rv[0], rv[1]};
            if (tid < 128) dk[tid] = rdk;
            if (ch + 1 < SEQ / 64) GLA_LOAD(ch + 1);
            __syncthreads();
            { const int tt = wave & 3;
#pragma unroll
              for (int i2 = 0; i2 < 2; ++i2) { const int ts = (wave >> 2) * 2 + i2;
                  pg8::f32x4 acc = (pg8::f32x4){0.f, 0.f, 0.f, 0.f};
                  if (ts <= tt) {
#pragma unroll
                      for (int ks = 0; ks < 4; ++ks) { const bf16x8_t a = *(const LAS bf16x8_t*)(Kd + (ts * 16 + c16) * PQ + ks * 32 + q4 * 8), bb = *(const LAS bf16x8_t*)(Qs + (tt * 16 + c16) * PQ + ks * 32 + q4 * 8);
                          acc = __builtin_amdgcn_mfma_f32_16x16x32_bf16(a, bb, acc, 0, 0, 0); }
                      const int tg = tt * 16 + c16, sgl = ts * 16 + q4 * 4;
#pragma unroll
                      for (int j = 0; j < 4; ++j) if (sgl + j > tg) acc[j] = 0.f;
                  }
                  *(LAS u32x2*)(Pm + (tt * 16 + c16) * PS + ts * 16 + q4 * 4) = (u32x2){pk2(acc[0], acc[1]), pk2(acc[2], acc[3])}; } }
            __syncthreads();
            { const int tt = wave & 3, tv = wave >> 2;
              pg8::f32x4 oacc = (pg8::f32x4){0.f, 0.f, 0.f, 0.f};
#pragma unroll
              for (int ks = 0; ks < 2; ++ks) { const bf16x8_t bb = *(const LAS bf16x8_t*)(Pm + (tt * 16 + c16) * PS + ks * 32 + q4 * 8), a = *(const LAS bf16x8_t*)(VT + (tv * 16 + c16) * PS + ks * 32 + q4 * 8);
                  oacc = __builtin_amdgcn_mfma_f32_16x16x32_bf16(a, bb, oacc, 0, 0, 0); }
#pragma unroll
              for (int ks = 0; ks < 4; ++ks) { const bf16x8_t bb = *(const LAS bf16x8_t*)(Qs + (tt * 16 + c16) * PQ + ks * 32 + q4 * 8), a = *(const LAS bf16x8_t*)(ST + (tv * 16 + c16) * PQ + ks * 32 + q4 * 8);
                  oacc = __builtin_amdgcn_mfma_f32_16x16x32_bf16(a, bb, oacc, 0, 0, 0); }
              *(u32x2*)(VO + (t0 + tt * 16 + c16) * 2048 + 1024 + h * 256 + v8 * 32 + tv * 16 + q4 * 4) = (u32x2){pk2(oacc[0], oacc[1]), pk2(oacc[2], oacc[3])};
              float sq = (oacc[0] * oacc[0] + oacc[1] * oacc[1]) + (oacc[2] * oacc[2] + oacc[3] * oacc[3]);
              sq += __shfl_xor(sq, 16); sq += __shfl_xor(sq, 32);
              if (q4 == 0) atomicAdd(SS + (t0 + tt * 16 + c16) * 4 + h, sq); }
#pragma unroll
            for (int ks = 0; ks < 2; ++ks) { const bf16x8_t a = *(const LAS bf16x8_t*)(KdT + (wave * 16 + c16) * PS + ks * 32 + q4 * 8);
#pragma unroll
                for (int tv = 0; tv < 2; ++tv) { const bf16x8_t bb = *(const LAS bf16x8_t*)(VT + (tv * 16 + c16) * PS + ks * 32 + q4 * 8);
                    sacc[tv] = __builtin_amdgcn_mfma_f32_16x16x32_bf16(a, bb, sacc[tv], 0, 0, 0); } }
            { const pg8::f32x4 d4 = *(const LAS pg8::f32x4*)(dk + wave * 16 + q4 * 4);
#pragma unroll
              for (int tv = 0; tv < 2; ++tv) sacc[tv] = sacc[tv] * d4; }
            __syncthreads();
#pragma unroll
            for (int tv = 0; tv < 2; ++tv) *(LAS u32x2*)(ST + (tv * 16 + c16) * PQ + wave * 16 + q4 * 4) = (u32x2){pk2(sacc[tv][0], sacc[tv][1]), pk2(sacc[tv][2], sacc[tv][3])};
        }
#undef GLA_LOAD
    }
}

__device__ __forceinline__ void phase_norm2(const Params& p, LAS unsigned char* lds, int G) {
    const int tid = threadIdx.x, lane = tid & 63, wave = __builtin_amdgcn_readfirstlane(tid >> 6);
    const float* modp = (const float*)(p.ws + WS_MODP);
    LAS float* g1 = (LAS float*)lds; LAS float* gs = g1 + 1024; LAS float* sh = gs + 1024;
    const bf16* Y = (const bf16*)(p.ws + WS_Y); bf16* H2 = (bf16*)(p.ws + WS_H2);
    for (int tile = blockIdx.x; tile < T / 256; tile += G) {
        const int b = tile / 32;
        __syncthreads();
        for (int k = tid; k < 1024; k += NTHR) { g1[k] = mod_at(modp, b, 2048 + k) * p.npo[k]; gs[k] = p.npf[k] * (1.f + mod_at(modp, b, 4096 + k)); sh[k] = mod_at(modp, b, 3072 + k); }
        __syncthreads();
        for (int rr = 0; rr < 32; ++rr) {
            const size_t row = (size_t)tile * 256 + wave * 32 + rr;
            const f32x4* xr = (const f32x4*)(p.x + row * 1024) + lane; const u32x2* yr = (const u32x2*)(Y + row * 1024) + lane;
            f32x4 xv[4], yv[4]; float s = 0.f;
#pragma unroll
            for (int j = 0; j < 4; ++j) { xv[j] = xr[64 * j]; const u32x2 yw = yr[64 * j]; yv[j] = (f32x4){bflo(yw.x), bfhi(yw.x), bflo(yw.y), bfhi(yw.y)};
                s += (yv[j].x * yv[j].x + yv[j].y * yv[j].y) + (yv[j].z * yv[j].z + yv[j].w * yv[j].w); }
            const float rstd = 1.f / sqrtf(wave_sum(s) * (1.f / 1024.f) + 1e-6f);
            float s2 = 0.f;
            f32x4* orow = (f32x4*)(p.out + row * 1024) + lane;
#pragma unroll
            for (int j = 0; j < 4; ++j) { const int k = 256 * j + 4 * lane; const f32x4 g4 = *(const LAS f32x4*)(g1 + k);
                xv[j] = xv[j] + yv[j] * rstd * g4; orow[64 * j] = xv[j];
                s2 += (xv[j].x * xv[j].x + xv[j].y * xv[j].y) + (xv[j].z * xv[j].z + xv[j].w * xv[j].w); }
            const float rstd2 = 1.f / sqrtf(wave_sum(s2) * (1.f / 1024.f) + 1e-6f);
            u32x2* o8 = (u32x2*)(H2 + row * 1024) + lane;
#pragma unroll
            for (int j = 0; j < 4; ++j) { const int k = 256 * j + 4 * lane; const f32x4 g4 = *(const LAS f32x4*)(gs + k), s4 = *(const LAS f32x4*)(sh + k);
                u32x2 w; w.x = pk2(xv[j].x * rstd2 * g4.x + s4.x, xv[j].y * rstd2 * g4.y + s4.y); w.y = pk2(xv[j].z * rstd2 * g4.z + s4.z, xv[j].w * rstd2 * g4.w + s4.w);
                o8[64 * j] = w; }
        }
    }
}

__device__ __forceinline__ unsigned h16_key(unsigned b) { return (b & 0x8000u) ? (~b & 0xffffu) : (b | 0x8000u); }
__device__ __forceinline__ float h16_key_val(unsigned s) { const unsigned b = (s & 0x8000u) ? (s & 0x7fffu) : (~s & 0xffffu); return (float)__builtin_bit_cast(_Float16, (unsigned short)b); }
#define INS16(top, x) do { _Pragma("unroll") for (int _j = 0; _j < 16; ++_j) { const unsigned _hi = max(top[_j], x), _lo = min(top[_j], x); top[_j] = _hi; x = _lo; } } while (0)
__device__ __forceinline__ void phase_topk(const Params& p, LAS unsigned char* lds, int G) {
    const int tid = threadIdx.x;
    const unsigned short* SC = (const unsigned short*)(p.ws + WS_SC); unsigned* TK = (unsigned*)(p.ws + WS_TOPK); float* TK2 = (float*)(p.ws + WS_TOPK2);
    const float* SU = (const float*)(p.ws + WS_SU); const float* SV = (const float*)(p.ws + WS_SV);
    LAS unsigned* my = (LAS unsigned*)lds + tid * 33;
    for (int blk = blockIdx.x; blk < T * 8 / NTHR; blk += G) {
        const int item = blk * NTHR + tid, t = item >> 3, h = item & 7;
        unsigned topA[16], topB[16];
#pragma unroll
        for (int j = 0; j < 16; ++j) { topA[j] = 0u; topB[j] = 0u; }
        const u32x4* src = (const u32x4*)(SC + (size_t)t * 2048 + h * 256);
#pragma unroll 1
        for (int c8 = 0; c8 < 16; ++c8) { const u32x4 w = src[c8];
            const unsigned ww[4] = {w.x, w.y, w.z, w.w};
#pragma unroll
            for (int q = 0; q < 4; ++q) { unsigned k0 = (h16_key(ww[q] & 0xffffu) << 16) | (unsigned)(127 - (c8 * 8 + q * 2)), k1 = (h16_key(ww[q] >> 16) << 16) | (unsigned)(127 - (c8 * 8 + q * 2 + 1));
                INS16(topA, k0); INS16(topA, k1); } }
#pragma unroll 1
        for (int c8 = 0; c8 < 16; ++c8) { const u32x4 w = src[16 + c8];
            const unsigned ww[4] = {w.x, w.y, w.z, w.w};
#pragma unroll
            for (int q = 0; q < 4; ++q) { unsigned k0 = (h16_key(ww[q] & 0xffffu) << 16) | (unsigned)(127 - (c8 * 8 + q * 2)), k1 = (h16_key(ww[q] >> 16) << 16) | (unsigned)(127 - (c8 * 8 + q * 2 + 1));
                INS16(topB, k0); INS16(topB, k1); } }
        float fa[16], fb[16];
#pragma unroll
        for (int j = 0; j < 16; ++j) { fa[j] = h16_key_val(topA[j] >> 16); fb[j] = h16_key_val(topB[j] >> 16); my[j] = 127u - (topA[j] & 127u); my[16 + j] = 127u - (topB[j] & 127u); }
        unsigned ct[16];
#pragma unroll
        for (int j = 0; j < 16; ++j) ct[j] = 0u;
#pragma unroll
        for (int i = 0; i < 16; ++i)
#pragma unroll
            for (int j = 0; j < 16; ++j) if ((i + 1) * (j + 1) <= 16) {
                const float s = fa[i] + fb[j]; unsigned u = __builtin_bit_cast(unsigned, s); u ^= (u >> 31) ? 0xffffffffu : 0x80000000u;
                unsigned key = (u & 0xffffff00u) | (unsigned)(255 - (i * 16 + j));
                INS16(ct, key); }
        float val[16], mx, sum = 0.f;
#pragma unroll
        for (int m = 0; m < 16; ++m) { unsigned u = ct[m] & 0xffffff00u; u ^= (u >> 31) ? 0x80000000u : 0xffffffffu; val[m] = __builtin_bit_cast(float, u); }
        mx = val[0];
#pragma unroll
        for (int m = 0; m < 16; ++m) { val[m] = __expf(val[m] - mx); sum += val[m]; }
        const float inv = 1.f / sum;
        LDS_WAIT();
        unsigned outw[16]; float outs[16];
#pragma unroll
        for (int m = 0; m < 16; ++m) { const unsigned pos = 255u - (ct[m] & 255u), i = pos >> 4, j = pos & 15u;
            const unsigned e = my[i] * 128u + my[16 + j];
            outw[m] = (e << 16) | f2bf(val[m] * inv * SV[e]); outs[m] = SU[e]; }
        u32x4* dst = (u32x4*)(TK + (size_t)item * 16); f32x4* dst2 = (f32x4*)(TK2 + (size_t)item * 16);
#pragma unroll
        for (int q = 0; q < 4; ++q) { dst[q] = (u32x4){outw[4 * q], outw[4 * q + 1], outw[4 * q + 2], outw[4 * q + 3]}; dst2[q] = (f32x4){outs[4 * q], outs[4 * q + 1], outs[4 * q + 2], outs[4 * q + 3]}; }
    }
}

typedef unsigned u32x3 __attribute__((ext_vector_type(3)));
typedef unsigned u32x6 __attribute__((ext_vector_type(6)));
typedef float f32x32 __attribute__((ext_vector_type(32)));
__device__ __forceinline__ float rdlane(float v, int l) { return __builtin_bit_cast(float, __builtin_amdgcn_readlane(__builtin_bit_cast(int, v), l)); }
__device__ __forceinline__ f32x32 fp6x2(u32x3 a, u32x3 b) { const u32x6 s = {a.x, a.y, a.z, b.x, b.y, b.z}; return __builtin_amdgcn_cvt_scalef32_pk32_f32_fp6(s, 1.0f); }
__device__ __forceinline__ void phase_gather(const Params& p, LAS unsigned char* lds, int G) {
    const int tid = threadIdx.x, lane = tid & 63, wave = __builtin_amdgcn_readfirstlane(tid >> 6);
    const float* modp = (const float*)(p.ws + WS_MODP);
    LAS float* g2 = (LAS float*)lds;
    const bf16* H2 = (const bf16*)(p.ws + WS_H2); const unsigned* TK = (const unsigned*)(p.ws + WS_TOPK); const float* TK2 = (const float*)(p.ws + WS_TOPK2);
    const unsigned char* U6 = p.ws + WS_U; const unsigned char* V6 = p.ws + WS_V;
    for (int tile = blockIdx.x; tile < T / 256; tile += G) {
        const int b = tile / 32;
        __syncthreads();
        for (int k = tid; k < 1024; k += NTHR) g2[k] = mod_at(modp, b, 5120 + k) * p.npof[k];
        __syncthreads();
#pragma unroll 1
        for (int rr = 0; rr < 32; ++rr) {
            const size_t row = (size_t)tile * 256 + wave * 32 + rr;
            float xt[16];
            { const u32x4 a = *(const u32x4*)(H2 + row * 1024 + lane * 16), c = *(const u32x4*)(H2 + row * 1024 + lane * 16 + 8);
              xt[0] = bflo(a.x); xt[1] = bfhi(a.x); xt[2] = bflo(a.y); xt[3] = bfhi(a.y); xt[4] = bflo(a.z); xt[5] = bfhi(a.z); xt[6] = bflo(a.w); xt[7] = bfhi(a.w);
              xt[8] = bflo(c.x); xt[9] = bfhi(c.x); xt[10] = bflo(c.y); xt[11] = bfhi(c.y); xt[12] = bflo(c.z); xt[13] = bfhi(c.z); xt[14] = bflo(c.w); xt[15] = bfhi(c.w); }
            float acc[16];
#pragma unroll
            for (int j = 0; j < 16; ++j) acc[j] = 0.f;
#pragma unroll 1
            for (int hh = 0; hh < 16; ++hh) {
                const u32x4* ra = (const u32x4*)(TK + row * 128 + hh * 8);
                const u32x4 w0 = ra[0], w1 = ra[1];
                const unsigned ww[8] = {w0.x, w0.y, w0.z, w0.w, w1.x, w1.y, w1.z, w1.w};
                u32x6 up[4], vp[4];
#pragma unroll
                for (int m = 0; m < 8; ++m) { const size_t eo = (size_t)((unsigned)__builtin_amdgcn_readfirstlane((int)ww[m]) >> 16) * 768 + lane * 12;
                    const u32x3 a = *(const u32x3*)(U6 + eo), c = *(const u32x3*)(V6 + eo);
                    if (m & 1) { up[m >> 1][3] = a.x; up[m >> 1][4] = a.y; up[m >> 1][5] = a.z; vp[m >> 1][3] = c.x; vp[m >> 1][4] = c.y; vp[m >> 1][5] = c.z; }
                    else { up[m >> 1][0] = a.x; up[m >> 1][1] = a.y; up[m >> 1][2] = a.z; vp[m >> 1][0] = c.x; vp[m >> 1][1] = c.y; vp[m >> 1][2] = c.z; } }
                const unsigned wa = TK[row * 128 + hh * 8 + (lane >> 3)]; const float su = TK2[row * 128 + hh * 8 + (lane >> 3)];
                float pd[8];
#pragma unroll
                for (int m = 0; m < 8; m += 2) { const f32x32 f = __builtin_amdgcn_cvt_scalef32_pk32_f32_fp6(up[m >> 1], 1.0f);
                    float s0 = 0.f, s1 = 0.f;
#pragma unroll
                    for (int j = 0; j < 16; ++j) { s0 += xt[j] * f[j]; s1 += xt[j] * f[16 + j]; }
                    pd[m] = s0; pd[m + 1] = s1; __builtin_amdgcn_sched_barrier(0); }
#pragma unroll
                for (int j = 0; j < 4; ++j) { const bool up_ = (lane & 32) != 0; const float keep = up_ ? pd[j + 4] : pd[j], send = up_ ? pd[j] : pd[j + 4]; pd[j] = keep + __shfl_xor(send, 32); }
#pragma unroll
                for (int j = 0; j < 2; ++j) { const bool up_ = (lane & 16) != 0; const float keep = up_ ? pd[j + 2] : pd[j], send = up_ ? pd[j] : pd[j + 2]; pd[j] = keep + __shfl_xor(send, 16); }
                { const bool up_ = (lane & 8) != 0; const float keep = up_ ? pd[1] : pd[0], send = up_ ? pd[0] : pd[1]; pd[0] = keep + __shfl_xor(send, 8); }
                float d = pd[0]; d += __shfl_xor(d, 4); d += __shfl_xor(d, 2); d += __shfl_xor(d, 1);
                const float coef = bflo(wa) * gelu_f(su * d);
#pragma unroll
                for (int m = 0; m < 8; m += 2) { const f32x32 f = __builtin_amdgcn_cvt_scalef32_pk32_f32_fp6(vp[m >> 1], 1.0f); const float c0 = rdlane(coef, 8 * m), c1 = rdlane(coef, 8 * m + 8);
#pragma unroll
                    for (int j = 0; j < 16; ++j) acc[j] += c0 * f[j] + c1 * f[16 + j];
                    __builtin_amdgcn_sched_barrier(0); }
            }
            float s = 0.f;
#pragma unroll
            for (int j = 0; j < 16; ++j) s += acc[j] * acc[j];
            const float rstd = 1.f / sqrtf(wave_sum(s) * (1.f / 1024.f) + 1e-6f);
            float* orow = p.out + row * 1024 + lane * 16;
#pragma unroll
            for (int q = 0; q < 4; ++q) { f32x4 o = *(const f32x4*)(orow + 4 * q); const f32x4 ga = *(const LAS f32x4*)(g2 + lane * 16 + 4 * q);
                o.x += ga.x * acc[4 * q] * rstd; o.y += ga.y * acc[4 * q + 1] * rstd; o.z += ga.z * acc[4 * q + 2] * rstd; o.w += ga.w * acc[4 * q + 3] * rstd;
                *(f32x4*)(orow + 4 * q) = o; }
        }
    }
}

#define XB_TMO      128
#define XB_XCNT(j)  (256  + 64 * (j))
#define XB_XSUB(j)  (1280 + 64 * (j))
#define XB_XGEN(j)  (2304 + 64 * (j))
#define XB_TOP      3328
#define XB_TOPGEN   3392
#define XCD_BAR_WORDS 3456
#define XB_SPIN_CAP (1u << 18)

__device__ __forceinline__ unsigned xb_ld(unsigned* p)              { return __hip_atomic_load(p, __ATOMIC_RELAXED, __HIP_MEMORY_SCOPE_AGENT); }
__device__ __forceinline__ unsigned xb_add(unsigned* p, unsigned v) { return __hip_atomic_fetch_add(p, v, __ATOMIC_RELAXED, __HIP_MEMORY_SCOPE_AGENT); }
__device__ __forceinline__ unsigned xb_xcc_id() { return (unsigned)__builtin_amdgcn_s_getreg((3 << 11) | 20) & 0xFu; }
#define XB_SPIN(cond, bar) do { unsigned _sp = 0; while (cond) { __builtin_amdgcn_s_sleep(1); \
    if ((++_sp & 255u) == 0u) { if (xb_ld(&(bar)[XB_TMO])) break; if (_sp > XB_SPIN_CAP) { atomicAdd(&(bar)[XB_TMO], 1u); break; } } } } while (0)

struct XcdBarrier {
    unsigned* bar; unsigned x;
    volatile LAS unsigned* st;
};

__device__ __forceinline__ XcdBarrier xcd_barrier_post(unsigned* bar, volatile LAS unsigned* st) {
    XcdBarrier b; b.bar = bar; b.x = xb_xcc_id(); b.st = st;
    if (threadIdx.x == 0) (void)xb_add(&bar[XB_XCNT(b.x)], 1u);
    return b;
}
__device__ __forceinline__ void xcd_barrier_complete(unsigned* bar, unsigned x, unsigned& nloc, unsigned& nx) {
    const unsigned G = gridDim.x * gridDim.y * gridDim.z;
    unsigned sum, cnt, mine, sp = 0u;
    for (;;) {
        sum = 0u; cnt = 0u; mine = 0u;
#pragma unroll
        for (unsigned j = 0; j < 16; ++j) { const unsigned c = xb_ld(&bar[XB_XCNT(j)]); sum += c; cnt += (c > 0u) ? 1u : 0u; mine = (j == x) ? c : mine; }
        if (sum == G) break;
        __builtin_amdgcn_s_sleep(1);
        if ((++sp & 255u) == 0u) { if (xb_ld(&bar[XB_TMO])) break; if (sp > XB_SPIN_CAP) { atomicAdd(&bar[XB_TMO], 1u); break; } }
    }
    nloc = mine > 0u ? mine : 1u; nx = cnt > 0u ? cnt : 1u;
}

__device__ __forceinline__ void xcd_barrier(const XcdBarrier& b) {
    asm volatile("s_waitcnt vmcnt(0)" ::: "memory");
    __syncthreads();
    if (threadIdx.x == 0) {
        unsigned* bar = b.bar;
        __builtin_amdgcn_s_waitcnt(0);
        unsigned nloc = b.st[0], nx = b.st[1];
        if (nloc == 0u) { xcd_barrier_complete(bar, b.x, nloc, nx); b.st[0] = nloc; b.st[1] = nx; }
        const unsigned old = xb_add(&bar[XB_XSUB(b.x)], 1u);
        const unsigned gen = old / nloc;
        if (old + 1u == (gen + 1u) * nloc) {
            __builtin_amdgcn_fence(__ATOMIC_RELEASE, "agent");
            asm volatile("s_waitcnt vmcnt(0)" ::: "memory");
            const unsigned og = xb_add(&bar[XB_TOP], 1u);
            const unsigned tg = og / nx;
            if (og + 1u == (tg + 1u) * nx) xb_add(&bar[XB_TOPGEN], 1u);
            else XB_SPIN(xb_ld(&bar[XB_TOPGEN]) == tg, bar);
            __builtin_amdgcn_fence(__ATOMIC_ACQUIRE, "agent");
            xb_add(&bar[XB_XGEN(b.x)], 1u);
            asm volatile("s_waitcnt vmcnt(0)" ::: "memory");
        } else {
            XB_SPIN(xb_ld(&bar[XB_XGEN(b.x)]) == gen, bar);
            __builtin_amdgcn_fence(__ATOMIC_ACQUIRE, "agent");
            asm volatile("s_waitcnt vmcnt(0)" ::: "memory");
        }
    }
    __syncthreads();
}


template <int PH>
__device__ __forceinline__ void run_phase(const Params& p, LAS unsigned char* lds, int G) {
    unsigned char* ws = p.ws;
    if constexpr (PH == 0) phase0(p, lds, G);
    else if constexpr (PH == 1) phase1(p, lds, G);
    else if constexpr (PH == 2) { pg8::Gemm g{(const bf16*)p.out, (const bf16*)(ws + WS_WIN), T, NPAD, 1024, 1024}; pg8::StaticOrder S; S.init(T, NPAD, G, (int)blockIdx.x);
        EpiSeg E{ws}; pg8::gemm_phase<EpiSeg, pg8::StaticOrder, true, true, 0, 1024, 1024>(lds, g, S, E); }
    else if constexpr (PH == 3) phase_gla_prep(p, lds, G);
    else if constexpr (PH == 4) phase_gla_seq(p, lds, G);
    else if constexpr (PH == 5) phase_conv(p, G);
    else if constexpr (PH == 6) { pg8::Gemm g{(const bf16*)p.out, (const bf16*)(ws + WS_LRUB), T, 2048, 256, 1024}; pg8::StaticOrder S; S.init(T, 2048, G, (int)blockIdx.x);
        EpiLru E{(bf16*)(ws + WS_XLXG), (bf16*)p.out, p.lba, p.lbx, p.lam}; pg8::gemm_phase<EpiLru, pg8::StaticOrder, true, true, 1, 256, 1024>(lds, g, S, E); }
    else if constexpr (PH == 7) phase_lru_scan<false>(p, G);
    else if constexpr (PH == 8) phase_lru_scan<true>(p, G);
    else if constexpr (PH == 9) { pg8::Gemm g{(const bf16*)(ws + WS_GAGB), (const bf16*)(ws + WS_WOUT), T, 1024, 1024, 2048}; pg8::StaticOrder S; S.init(T, 1024, G, (int)blockIdx.x);
        EpiPlain E{(bf16*)(ws + WS_Y), 1024}; pg8::gemm_phase<EpiPlain, pg8::StaticOrder, true, true, 0, 1024, 2048>(lds, g, S, E); }
    else if constexpr (PH == 10) phase_norm2(p, lds, G);
    else if constexpr (PH == 11) { pg8::Gemm g{(const bf16*)(ws + WS_H2), (const bf16*)(ws + WS_WQ), T, 2048, 1024, 1024}; pg8::StaticOrder S; S.init(T, 2048, G, (int)blockIdx.x);
        EpiPlain E{(bf16*)(ws + WS_QRY), 2048}; pg8::gemm_phase<EpiPlain, pg8::StaticOrder, true, true, 0, 1024, 1024>(lds, g, S, E); }
    else if constexpr (PH == 12) { pg8::Gemm g{(const bf16*)(ws + WS_QRY), (const bf16*)(ws + WS_SUBK), T, 2048, 256, 2048}; pg8::StaticOrder S; S.init(T, 2048, G, (int)blockIdx.x);
        EpiF16 E{(unsigned short*)(ws + WS_SC), 2048}; pg8::gemm_phase<EpiF16, pg8::StaticOrder, true, true, 2, 256, 2048>(lds, g, S, E); }
    else if constexpr (PH == 13) phase_topk(p, lds, G);
    else if constexpr (PH == 14) phase_gather(p, lds, G);
}
template <int PH>
__global__ void __launch_bounds__(NTHR, 2) k_phase(Params p) {
    extern __shared__ __attribute__((aligned(16))) unsigned char lds_raw[];
    run_phase<PH>(p, (LAS unsigned char*)lds_raw, (int)gridDim.x);
}
constexpr int LDS_BAR_OFF = LDS_BYTES - 16;
template <int PH>
__device__ __forceinline__ void run_from(const Params& p, LAS unsigned char* lds, int G, const XcdBarrier& bar) {
#if PROBE_PH >= 0
    unsigned long long pt0 = 0; if constexpr (PH == PROBE_PH) pt0 = __builtin_amdgcn_s_memrealtime();
#endif
    run_phase<PH>(p, lds, G);
    if constexpr (PH + 1 < N_PHASES) {
        if constexpr (PH == 0) cg::this_grid().sync();
        else xcd_barrier(bar);
    }
#if PROBE_PH >= 0
    if constexpr (PH == PROBE_PH) { const unsigned long long pt1 = __builtin_amdgcn_s_memrealtime(), span = pt1 - pt0;
        while (__builtin_amdgcn_s_memrealtime() - pt1 < (unsigned long long)PROBE_MULT * span) __builtin_amdgcn_s_sleep(8); }
#endif
    if constexpr (PH + 1 < N_PHASES) run_from<PH + 1>(p, lds, G, bar);
}
__global__ void __launch_bounds__(NTHR, 2) k_mega(Params p) {
    extern __shared__ __attribute__((aligned(16))) unsigned char lds_raw[];
    LAS unsigned char* lds = (LAS unsigned char*)lds_raw;
    if (threadIdx.x < 4) ((LAS unsigned*)(lds + LDS_BAR_OFF))[threadIdx.x] = 0u;
    __syncthreads();
    const XcdBarrier bar = xcd_barrier_post((unsigned*)(p.ws + WS_CTL), (volatile LAS unsigned*)(lds + LDS_BAR_OFF));
    run_from<0>(p, lds, (int)gridDim.x, bar);
}

extern "C" void kernel_launch(void* const* d_in, const int* in_sizes, int n_in, void* d_out, int out_size, void* d_ws, size_t ws_size, hipStream_t stream) {
    static int grid = 0;
    if (grid == 0) {
        if (n_in != 24 || in_sizes[0] != T * DM || out_size != T * DM || ws_size < WS_END) {
            fprintf(stderr, "kernel_launch: unexpected shapes: n_in %d in0 %d out %d ws %zu\n", n_in, n_in > 0 ? in_sizes[0] : -1, out_size, ws_size); grid = -1; return; }
        int dev = 0, cus = 0, per_cu = 0;
        if (hipGetDevice(&dev) != hipSuccess || hipDeviceGetAttribute(&cus, hipDeviceAttributeMultiprocessorCount, dev) != hipSuccess) { grid = -1; return; }
        if (hipFuncSetAttribute((const void*)k_mega, hipFuncAttributeMaxDynamicSharedMemorySize, LDS_BYTES) != hipSuccess) { fprintf(stderr, "kernel_launch: hipFuncSetAttribute failed\n"); grid = -1; return; }
        if (hipOccupancyMaxActiveBlocksPerMultiprocessor(&per_cu, (const void*)k_mega, NTHR, LDS_BYTES) != hipSuccess || per_cu < 1) { fprintf(stderr, "kernel_launch: occupancy query says %d blocks per CU\n", per_cu); grid = -1; return; }
        (void)hipGetLastError();
        grid = cus;
    }
    if (grid < 0) return;
    Params p{};
    const float** pp = (const float**)&p;
    for (int i = 0; i < 24; ++i) pp[i] = (const float*)d_in[i];
    p.out = (float*)d_out; p.ws = (unsigned char*)d_ws;
    if (hipMemsetAsync((char*)d_ws + WS_CTL, 0, 65536, stream) != hipSuccess) { fprintf(stderr, "kernel_launch: hipMemsetAsync failed\n"); return; }
    void* args[] = {&p};
    hipError_t e = hipLaunchCooperativeKernel((const void*)k_mega, dim3(grid), dim3(NTHR), args, LDS_BYTES, stream);
    if (e != hipSuccess) fprintf(stderr, "kernel_launch: cooperative launch failed: %s (grid %d)\n", hipGetErrorString(e), grid);
}
```

```cpp
#include <hip/hip_runtime.h>
#include <hip/hip_cooperative_groups.h>
#include <cstdio>
#include <cstdint>
#include <utility>
namespace cg = cooperative_groups;

namespace pg8 {
#define PG8_LAS __attribute__((address_space(3)))
typedef unsigned short bf16_t;
typedef short bf16x8 __attribute__((ext_vector_type(8)));
typedef float f32x4 __attribute__((ext_vector_type(4)));
typedef unsigned u32x4 __attribute__((ext_vector_type(4)));
constexpr int BM = 256, BK = 64, HALF = 128, HTB = HALF * BK * 2  , STAGE_BYTES = 8 * HTB, NXCD = 8, WGM = 8;

__host__ __device__ __forceinline__ int lds_byte(int r, int c) { const int st = (r >> 4) * 2 + (c >> 5), rr = r & 15, cc = c & 31, ob = rr * 64 + cc * 2; return st * 1024 + (ob ^ (((ob >> 9) & 1) << 5)); }
__host__ __device__ __forceinline__ void stage_rc(int b, int& R, int& C) { const int st = b / 1024, sb = b % 1024, swz = sb ^ (((sb >> 9) & 1) << 5); R = (st >> 1) * 16 + swz / 64; C = (st & 1) * 32 + (swz % 64) / 2; }
__host__ __device__ __forceinline__ int perm32(int rho) { const int n = rho >> 4, i = rho & 15; return 8 * (i >> 2) + 4 * n + (i & 3); }

struct Unit { int pm, pn; };
struct Gemm { const bf16_t* A; const bf16_t* Bt; int M, N, K, lda; };
template <int AMODE> __device__ __forceinline__ size_t a_off_bytes(const Gemm& g, const Unit& u) {
    const int ac = AMODE == 0 ? 0 : (AMODE == 1 ? 128 * (u.pn < 6 ? u.pn : 6) : 256 * u.pn);
    return ((size_t)u.pm * BM * (size_t)g.lda + (size_t)ac) * 2;
}

struct StaticOrder {
    int nM, nN, nwg, G, c;
    __host__ __device__ void init(int M, int N, int G_, int c_) { nM = M / BM; nN = N / BM; nwg = nM * nN; G = G_; c = c_; }
    __host__ __device__ bool next(int i, Unit& u) const {
        const long L = (long)i * G + c; if (L >= nwg) return false;
        int wgid = (int)L; { const int q = nwg / NXCD, r = nwg % NXCD, xcd = wgid % NXCD, off = wgid / NXCD; wgid = (xcd < r ? xcd * (q + 1) : r * (q + 1) + (xcd - r) * q) + off; }
        const int nig = WGM * nN, gid = wgid / nig, fm = gid * WGM, gsz = (nM - fm) < WGM ? (nM - fm) : WGM;
        u.pm = fm + ((wgid % nig) % gsz); u.pn = (wgid % nig) / gsz; return true;
    }
    __device__ __forceinline__ void a_ready(const Unit&) const {}
    __device__ __forceinline__ void done(const Unit&) const {}
};

__device__ __forceinline__ unsigned cvt_pk_bf16(float lo, float hi) { unsigned r; asm volatile("v_cvt_pk_bf16_f32 %0, %1, %2" : "=v"(r) : "v"(lo), "v"(hi)); return r; }

template <class Epi, class Sched, bool ALIGN_EPI = false, bool SP2 = false, int AMODE = 0, int KC = 0, int LDAC = 0>
__device__ __forceinline__ void gemm_phase(PG8_LAS unsigned char* lds, const Gemm g, const Sched& S, const Epi& E) {
    const int tid = threadIdx.x, wid = __builtin_amdgcn_readfirstlane(tid >> 6), lane = tid & 63, wr = wid >> 2, wc = wid & 3, fr = lane & 15, fq = lane >> 4;
    const int K = KC ? KC : g.K, nt = K / BK; const int lda = LDAC ? LDAC : g.lda;
    unsigned voffA[2], voffB[2];
#pragma unroll
    for (int i = 0; i < 2; ++i) { int R, C; stage_rc(tid * 16 + i * 8192, R, C); const int Rb = Epi::PERM ? ((R & ~31) + perm32(R & 31)) : R;
        voffA[i] = (unsigned)(R * lda + C) * 2u; voffB[i] = (unsigned)(Rb * K + C) * 2u; }
    const size_t kstep = (size_t)(BK * 2);
    const size_t hstepA = (size_t)HALF * lda * 2;
    const size_t hstepB = (size_t)HALF * K * 2;
    const size_t tstepB = 2 * hstepB;
    const unsigned ldsw = (unsigned)wid * 1024u;
    const int aoff = lds_byte(wr * 64 + fr, fq * 8), boff = lds_byte(wc * 32 + fr, fq * 8);
#define PG8_SA(b, h) (((b) * 2 + (h)) * HTB)
#define PG8_SB(b, h) ((4 + (b) * 2 + (h)) * HTB)
#define PG8_STAGE(bufoff, gbase, voff) do { _Pragma("unroll") for (int _i = 0; _i < 2; ++_i) \
        __builtin_amdgcn_global_load_lds((const unsigned*)((const char*)(gbase) + (voff)[_i]), (PG8_LAS unsigned*)(lds + (bufoff) + ldsw + _i * 8192), 16, 0, 0); } while (0)
#define PG8_LDA(dst, b, h) do { _Pragma("unroll") for (int m = 0; m < 4; ++m) _Pragma("unroll") for (int k = 0; k < 2; ++k) dst[m][k] = *(const PG8_LAS bf16x8*)(lds + PG8_SA(b, h) + aoff + m * 2048 + k * 1024); } while (0)
#define PG8_LDB(dst, b, h) do { _Pragma("unroll") for (int n = 0; n < 2; ++n) _Pragma("unroll") for (int k = 0; k < 2; ++k) dst[n][k] = *(const PG8_LAS bf16x8*)(lds + PG8_SB(b, h) + boff + n * 2048 + k * 1024); } while (0)
#define PG8_MMA(ai, bj, At, Bt) do { __builtin_amdgcn_s_setprio(1); _Pragma("unroll") for (int m = 0; m < 4; ++m) _Pragma("unroll") for (int n = 0; n < 2; ++n) _Pragma("unroll") for (int k = 0; k < 2; ++k) \
        acc[ai][bj][m][n] = __builtin_amdgcn_mfma_f32_16x16x32_bf16(Bt[n][k], At[m][k], acc[ai][bj][m][n], 0, 0, 0); __builtin_amdgcn_s_setprio(0); } while (0)
#define PG8_WAIT_V(n) asm volatile("s_waitcnt vmcnt(" #n ")" ::: "memory")
#define PG8_WAIT_L(n) asm volatile("s_waitcnt lgkmcnt(" #n ")" ::: "memory")
#define PG8_BAR __builtin_amdgcn_s_barrier()
#define PG8_SCHED __builtin_amdgcn_sched_barrier(0)
    Unit cur, nxt; int ui = 0;
    if (!S.next(0, cur)) return;
    f32x4 acc[2][2][4][2];
#pragma unroll
    for (int a = 0; a < 2; ++a)
#pragma unroll
        for (int b = 0; b < 2; ++b)
#pragma unroll
            for (int m = 0; m < 4; ++m)
#pragma unroll
                for (int n = 0; n < 2; ++n) acc[a][b][m][n] = (f32x4){0.f, 0.f, 0.f, 0.f};
    bf16x8 At[4][2], B0[2][2], B1[2][2];
    const char* cA = (const char*)g.A + a_off_bytes<AMODE>(g, cur); const char* cB = (const char*)g.Bt + (size_t)cur.pn * tstepB;
    S.a_ready(cur);
    if constexpr (SP2) {
        PG8_STAGE(PG8_SB(0, 0), cB, voffB); PG8_STAGE(PG8_SB(0, 1), cB + hstepB, voffB); PG8_STAGE(PG8_SA(0, 0), cA, voffA); PG8_STAGE(PG8_SA(0, 1), cA + hstepA, voffA);
        if (wr == 1) PG8_BAR;
        PG8_WAIT_V(2); PG8_BAR;
        PG8_STAGE(PG8_SB(1, 0), cB + kstep, voffB); PG8_STAGE(PG8_SA(1, 0), cA + kstep, voffA); PG8_STAGE(PG8_SB(1, 1), cB + hstepB + kstep, voffB);
        PG8_WAIT_V(6); PG8_BAR;
    } else {
        PG8_STAGE(PG8_SB(0, 0), cB, voffB); PG8_STAGE(PG8_SA(0, 0), cA, voffA); PG8_STAGE(PG8_SB(0, 1), cB + hstepB, voffB); PG8_STAGE(PG8_SA(0, 1), cA + hstepA, voffA);
        if (wr == 1) PG8_BAR;
        PG8_WAIT_V(4); PG8_BAR;
        PG8_STAGE(PG8_SB(1, 0), cB + kstep, voffB); PG8_STAGE(PG8_SA(1, 0), cA + kstep, voffA); PG8_STAGE(PG8_SB(1, 1), cB + hstepB + kstep, voffB);
        PG8_WAIT_V(6); PG8_BAR;
    }
    for (;;) {
        const bool has_next = S.next(ui + 1, nxt);
        const char* nA = has_next ? (const char*)g.A + a_off_bytes<AMODE>(g, nxt) : cA; const char* nB = has_next ? (const char*)g.Bt + (size_t)nxt.pn * tstepB : cB;
#pragma unroll 1
        for (int t = 0; t < nt; t += 2) {
            const bool last = (t == nt - 2);
            const char* a1 = cA + (size_t)(t + 1) * kstep;
            const char* a2 = last ? nA : cA + (size_t)(t + 2) * kstep; const char* b2 = last ? nB : cB + (size_t)(t + 2) * kstep;
            const char* a3 = a2 + kstep; const char* b3 = b2 + kstep;
            if (last && has_next) S.a_ready(nxt);
            if constexpr (SP2) {
            PG8_LDB(B0, 0, 0); PG8_LDB(B1, 0, 1); PG8_SCHED; PG8_LDA(At, 0, 0); PG8_STAGE(PG8_SA(1, 1), a1 + hstepA, voffA);
            PG8_WAIT_V(8); PG8_WAIT_L(0); PG8_BAR; PG8_MMA(0, 0, At, B0); PG8_MMA(0, 1, At, B1); PG8_BAR; PG8_SCHED;
            PG8_LDA(At, 0, 1); PG8_STAGE(PG8_SB(0, 0), b2, voffB); PG8_STAGE(PG8_SB(0, 1), b2 + hstepB, voffB); PG8_STAGE(PG8_SA(0, 0), a2, voffA);
            PG8_WAIT_V(8); PG8_WAIT_L(0); PG8_BAR; PG8_MMA(1, 0, At, B0); PG8_MMA(1, 1, At, B1); PG8_BAR; PG8_SCHED;
            PG8_LDB(B0, 1, 0); PG8_LDB(B1, 1, 1); PG8_SCHED; PG8_LDA(At, 1, 0); PG8_STAGE(PG8_SA(0, 1), a2 + hstepA, voffA);
            PG8_WAIT_V(8); PG8_WAIT_L(0); PG8_BAR; PG8_MMA(0, 0, At, B0); PG8_MMA(0, 1, At, B1); PG8_BAR; PG8_SCHED;
            PG8_LDA(At, 1, 1); PG8_STAGE(PG8_SB(1, 0), b3, voffB); PG8_STAGE(PG8_SB(1, 1), b3 + hstepB, voffB); PG8_STAGE(PG8_SA(1, 0), a3, voffA);
            PG8_WAIT_V(8); PG8_WAIT_L(0); PG8_BAR; PG8_MMA(1, 0, At, B0); PG8_MMA(1, 1, At, B1); PG8_BAR; PG8_SCHED;
            } else {
            PG8_LDB(B0, 0, 0); PG8_SCHED; PG8_LDA(At, 0, 0); PG8_STAGE(PG8_SA(1, 1), a1 + hstepA, voffA);
            PG8_WAIT_L(8); PG8_BAR; PG8_WAIT_L(0); PG8_MMA(0, 0, At, B0); PG8_BAR; PG8_SCHED;
            PG8_LDB(B1, 0, 1); PG8_STAGE(PG8_SB(0, 0), b2, voffB);
            PG8_BAR; PG8_WAIT_L(0); PG8_MMA(0, 1, At, B1); PG8_BAR;
            PG8_LDA(At, 0, 1); PG8_STAGE(PG8_SA(0, 0), a2, voffA);
            PG8_BAR; PG8_WAIT_L(0); PG8_MMA(1, 0, At, B0); PG8_BAR; PG8_SCHED;
            PG8_STAGE(PG8_SB(0, 1), b2 + hstepB, voffB);
            PG8_WAIT_V(6); PG8_BAR; PG8_MMA(1, 1, At, B1); PG8_BAR;
            PG8_LDB(B0, 1, 0); PG8_SCHED; PG8_LDA(At, 1, 0); PG8_STAGE(PG8_SA(0, 1), a2 + hstepA, voffA);
            PG8_WAIT_L(8); PG8_BAR; PG8_WAIT_L(0); PG8_MMA(0, 0, At, B0); PG8_BAR; PG8_SCHED;
            PG8_LDB(B1, 1, 1); PG8_STAGE(PG8_SB(1, 0), b3, voffB);
            PG8_BAR; PG8_WAIT_L(0); PG8_MMA(0, 1, At, B1); PG8_BAR;
            PG8_LDA(At, 1, 1); PG8_STAGE(PG8_SA(1, 0), a3, voffA);
            PG8_BAR; PG8_WAIT_L(0); PG8_MMA(1, 0, At, B0); PG8_BAR; PG8_SCHED;
            PG8_STAGE(PG8_SB(1, 1), b3 + hstepB, voffB);
            PG8_WAIT_V(6); PG8_BAR; PG8_MMA(1, 1, At, B1); PG8_BAR;
            }
        }
        if constexpr (ALIGN_EPI) { if (wr == 0) PG8_BAR; }
        E(acc, cur, wr, wc, fr, fq); S.done(cur);
        if (!has_next) break;
#pragma unroll
        for (int a = 0; a < 2; ++a)
#pragma unroll
            for (int b = 0; b < 2; ++b)
#pragma unroll
                for (int m = 0; m < 4; ++m)
#pragma unroll
                    for (int n = 0; n < 2; ++n) acc[a][b][m][n] = (f32x4){0.f, 0.f, 0.f, 0.f};
        cur = nxt; cA = nA; cB = nB; ++ui;
        if constexpr (ALIGN_EPI) { if (wr == 1) PG8_BAR; }
    }
    PG8_WAIT_V(0);
    if constexpr (!ALIGN_EPI) { if (wr == 0) PG8_BAR; }
    PG8_BAR;
#undef PG8_SA
#undef PG8_SB
#undef PG8_STAGE
#undef PG8_LDA
#undef PG8_LDB
#undef PG8_MMA
#undef PG8_WAIT_V
#undef PG8_WAIT_L
#undef PG8_BAR
#undef PG8_SCHED
}
}

constexpr int NB = 8, SEQ = 8192, DM = 1024, T = NB * SEQ;
constexpr int NPAD = 7424;
constexpr int NWAVES = 8, NTHR = 512;
constexpr int LDS_BYTES = 147456;
constexpr int N_PHASES = 12;
#define PROBE_PH -1
#define PROBE_MULT 3

constexpr size_t MiB = 1ull << 20;
constexpr size_t WS_CTL = 0;
constexpr size_t WS_MODP = 1 * MiB;
constexpr size_t WS_WIN = 3 * MiB;
constexpr size_t WS_WOUT = 18 * MiB;
constexpr size_t WS_WQ = 20 * MiB;
constexpr size_t WS_LRUB = 24 * MiB;
constexpr size_t WS_SUBK = 25 * MiB;
constexpr size_t WS_LRUC = 26 * MiB;
constexpr size_t WS_U = 32 * MiB;
constexpr size_t WS_V = 48 * MiB;
constexpr size_t WS_SU = 64 * MiB;
constexpr size_t WS_SV = 65 * MiB;
constexpr size_t WS_SS = 30 * MiB;
constexpr size_t WS_DK = 66 * MiB;
constexpr size_t WS_QKV = 96 * MiB;
constexpr size_t WS_R = 352 * MiB;
constexpr size_t WS_XLXG = 480 * MiB;
constexpr size_t WS_GAGB = 736 * MiB;
constexpr size_t WS_ALOW = 992 * MiB;
constexpr size_t WS_END = 994 * MiB;
constexpr size_t WS_Y = WS_QKV;
constexpr size_t WS_H2 = WS_QKV + 128 * MiB;
constexpr size_t WS_QRY = WS_XLXG;
constexpr size_t WS_SC = WS_GAGB;
constexpr size_t WS_TOPK = WS_R;
constexpr size_t WS_TOPK2 = WS_R + 32 * MiB;

#define LAS __attribute__((address_space(3)))
typedef unsigned short bf16;
typedef float f32x4 __attribute__((ext_vector_type(4)));
typedef float f32x2 __attribute__((ext_vector_type(2)));
typedef unsigned u32x4 __attribute__((ext_vector_type(4)));
typedef unsigned u32x2 __attribute__((ext_vector_type(2)));

struct Params {
    const float *x, *c, *w_ada, *b_ada, *npm, *npo, *w_in, *w_alpha, *b_alpha, *gla_norm, *conv_w, *conv_b,
        *lwa, *lba, *lwx, *lbx, *lam, *w_out, *npf, *npof, *wq, *subk, *pu, *pv;
    float* out; unsigned char* ws;
    int ph_lo, ph_hi;
};

__device__ __forceinline__ unsigned f2bf(float f) { unsigned u = __builtin_bit_cast(unsigned, f); return (u + 0x7fffu + ((u >> 16) & 1u)) >> 16; }
__device__ __forceinline__ unsigned pk2(float lo, float hi) { return f2bf(lo) | (f2bf(hi) << 16); }
__device__ __forceinline__ float bflo(unsigned u) { return __builtin_bit_cast(float, u << 16); }
__device__ __forceinline__ float bfhi(unsigned u) { return __builtin_bit_cast(float, u & 0xffff0000u); }
__device__ __forceinline__ float bf2f(bf16 h) { return __builtin_bit_cast(float, (unsigned)h << 16); }
__device__ __forceinline__ float sigmoid_f(float x) { return 1.f / (1.f + __expf(-x)); }
__device__ __forceinline__ float silu_f(float x) { return x / (1.f + __expf(-x)); }
__device__ __forceinline__ float gelu_f(float x) { const float u = 0.7978845608028654f * (x + 0.044715f * x * x * x); return x / (1.f + __expf(-2.f * u)); }
__device__ __forceinline__ float softplus_f(float x) { return fmaxf(x, 0.f) + log1pf(__expf(-fabsf(x))); }
__device__ __forceinline__ float wave_sum(float v) {
#pragma unroll
    for (int o = 1; o < 64; o <<= 1) v += __shfl_xor(v, o);
    return v;
}
#define LDS_WAIT() asm volatile("s_waitcnt lgkmcnt(0)" ::: "memory")

struct EpiSeg {
    static constexpr bool PERM = true;
    unsigned char* ws;
    __device__ __forceinline__ void operator()(const pg8::f32x4 (&acc)[2][2][4][2], const pg8::Unit& u, int wr, int wc, int fr, int fq) const {
        const int pn = u.pn; bf16* base; int ldc, colt;
        if (pn < 8) { base = (bf16*)(ws + WS_QKV); ldc = 2048; colt = pn * 256; }
        else if (pn < 12) { base = (bf16*)(ws + WS_R); ldc = 1024; colt = (pn - 8) * 256; }
        else if (pn < 20) { base = (bf16*)(ws + WS_XLXG); ldc = 2048; colt = (pn - 12) * 256; }
        else if (pn < 28) { base = (bf16*)(ws + WS_GAGB); ldc = 2048; colt = (pn - 20) * 256; }
        else { base = (bf16*)(ws + WS_ALOW); ldc = 16; colt = 0; }
        const int row0 = u.pm * 256 + wr * 64 + fr, col0 = colt + wc * 32 + 8 * fq;
        const bool tail = (pn == 28);
#pragma unroll
        for (int ai = 0; ai < 2; ++ai)
#pragma unroll
            for (int m = 0; m < 4; ++m) { bf16* rowp = base + (size_t)(row0 + ai * 128 + m * 16) * ldc + col0;
#pragma unroll
                for (int bj = 0; bj < 2; ++bj) { const pg8::f32x4 v0 = acc[ai][bj][m][0], v1 = acc[ai][bj][m][1];
                    u32x4 w; w.x = pg8::cvt_pk_bf16(v0[0], v0[1]); w.y = pg8::cvt_pk_bf16(v0[2], v0[3]); w.z = pg8::cvt_pk_bf16(v1[0], v1[1]); w.w = pg8::cvt_pk_bf16(v1[2], v1[3]);
                    if (!tail || (bj == 0 && wc == 0 && fq < 2)) *(u32x4*)(rowp + bj * 128) = w; } }
    }
};
struct EpiPlain {
    static constexpr bool PERM = true;
    bf16* O; int ldc;
    __device__ __forceinline__ void operator()(const pg8::f32x4 (&acc)[2][2][4][2], const pg8::Unit& u, int wr, int wc, int fr, int fq) const {
        const int row0 = u.pm * 256 + wr * 64 + fr, col0 = u.pn * 256 + wc * 32 + 8 * fq;
#pragma unroll
        for (int ai = 0; ai < 2; ++ai)
#pragma unroll
            for (int m = 0; m < 4; ++m) { bf16* rowp = O + (size_t)(row0 + ai * 128 + m * 16) * ldc + col0;
#pragma unroll
                for (int bj = 0; bj < 2; ++bj) { const pg8::f32x4 v0 = acc[ai][bj][m][0], v1 = acc[ai][bj][m][1];
                    u32x4 w; w.x = pg8::cvt_pk_bf16(v0[0], v0[1]); w.y = pg8::cvt_pk_bf16(v0[2], v0[3]); w.z = pg8::cvt_pk_bf16(v1[0], v1[1]); w.w = pg8::cvt_pk_bf16(v1[2], v1[3]);
                    *(u32x4*)(rowp + bj * 128) = w; } }
    }
};
typedef _Float16 h16x2 __attribute__((ext_vector_type(2)));
__device__ __forceinline__ unsigned pkh(float a, float b) { return __builtin_bit_cast(unsigned, __builtin_amdgcn_cvt_pkrtz(a, b)); }
struct EpiF16 {
    static constexpr bool PERM = true;
    unsigned short* O; int ldc;
    __device__ __forceinline__ void operator()(const pg8::f32x4 (&acc)[2][2][4][2], const pg8::Unit& u, int wr, int wc, int fr, int fq) const {
        const int row0 = u.pm * 256 + wr * 64 + fr, col0 = u.pn * 256 + wc * 32 + 8 * fq;
#pragma unroll
        for (int ai = 0; ai < 2; ++ai)
#pragma unroll
            for (int m = 0; m < 4; ++m) { unsigned short* rowp = O + (size_t)(row0 + ai * 128 + m * 16) * ldc + col0;
#pragma unroll
                for (int bj = 0; bj < 2; ++bj) { const pg8::f32x4 v0 = acc[ai][bj][m][0], v1 = acc[ai][bj][m][1];
                    u32x4 w; w.x = pkh(v0[0], v0[1]); w.y = pkh(v0[2], v0[3]); w.z = pkh(v1[0], v1[1]); w.w = pkh(v1[2], v1[3]);
                    *(u32x4*)(rowp + bj * 128) = w; } }
    }
};
__device__ __forceinline__ void p0_transpose_item(const float* W, int ldw, int k0, int n0, int nvalid, bf16* WT, int ldk, int row0, int kc0, LAS float* scr, int lane) {
#pragma unroll 8
    for (int i = 0; i < 32; ++i) { const int kk = 2 * i + (lane >> 5), cc = lane & 31; scr[kk * 33 + cc] = (cc < nvalid) ? W[(size_t)(k0 + kk) * ldw + n0 + cc] : 0.f; }
    LDS_WAIT(); asm volatile("" ::: "memory");
    const int c = lane & 7;
#pragma unroll
    for (int j = 0; j < 4; ++j) { const int n = (lane >> 3) + 8 * j; const LAS float* s = scr + (8 * c) * 33 + n;
        u32x4 o; o.x = pk2(s[0 * 33], s[1 * 33]); o.y = pk2(s[2 * 33], s[3 * 33]); o.z = pk2(s[4 * 33], s[5 * 33]); o.w = pk2(s[6 * 33], s[7 * 33]);
        *(u32x4*)(WT + (size_t)(row0 + n) * ldk + kc0 + k0 + 8 * c) = o; }
    LDS_WAIT(); asm volatile("" ::: "memory");
}
__device__ __forceinline__ void phase0(const Params& p, LAS unsigned char* lds, int G) {
    const int tid = threadIdx.x, lane = tid & 63, wave = __builtin_amdgcn_readfirstlane(tid >> 6);
    unsigned char* ws = p.ws;
    {
        LAS float* sc = (LAS float*)lds;
        LAS float* red = (LAS float*)(lds + 4096);
        float* modp = (float*)(ws + WS_MODP);
        for (int it = blockIdx.x; it < 24 * 8; it += G) {
            const int nb = it % 24, kc = it / 24;
            for (int i = tid; i < 1024; i += NTHR) { const int b = i >> 7, k = i & 127; sc[i] = silu_f(p.c[b * 1024 + kc * 128 + k]); }
            __syncthreads();
            const int col = tid & 255, kh = tid >> 8;
            float acc[8];
#pragma unroll
            for (int b = 0; b < 8; ++b) acc[b] = 0.f;
            const float* wp = p.w_ada + (size_t)(kc * 128 + kh * 64) * 6144 + nb * 256 + col;
#pragma unroll 8
            for (int kk = 0; kk < 64; ++kk) { const float w = wp[(size_t)kk * 6144];
#pragma unroll
                for (int b = 0; b < 8; ++b) acc[b] += sc[b * 128 + kh * 64 + kk] * w; }
            if (kh == 1) {
#pragma unroll
                for (int b = 0; b < 8; ++b) red[b * 256 + col] = acc[b]; }
            __syncthreads();
            if (kh == 0) { const int n = nb * 256 + col; const float bias = (kc == 0) ? p.b_ada[n] : 0.f;
#pragma unroll
                for (int b = 0; b < 8; ++b) modp[(size_t)(kc * 8 + b) * 6144 + n] = acc[b] + red[b * 256 + col] + bias; }
            __syncthreads();
        }
    }
    for (int i = blockIdx.x * NTHR + tid; i < T * 4 / 4; i += G * NTHR) ((f32x4*)(ws + WS_SS))[i] = (f32x4){0.f, 0.f, 0.f, 0.f};
    LAS float* scr = (LAS float*)(lds + 16384 + wave * 8448);
    const int gw = blockIdx.x * NWAVES + wave, NGW = G * NWAVES;
    bf16* WinT = (bf16*)(ws + WS_WIN); bf16* WoutT = (bf16*)(ws + WS_WOUT); bf16* WqT = (bf16*)(ws + WS_WQ);
    bf16* LruB = (bf16*)(ws + WS_LRUB); bf16* SubK = (bf16*)(ws + WS_SUBK);
    constexpr int I_IN = 16 * (NPAD / 32), I_OUT = 16 * 32, I_Q = 16 * 64, I_LRU = 16 * 8, I_SUB = 2048, I_TAB = 2 * 16384;
    constexpr int NIT = I_IN + I_OUT + I_Q + I_LRU + I_SUB + I_TAB;
    for (int it = gw; it < NIT; it += NGW) {
        int r = it;
        if (r < I_IN) { const int nb = r % (NPAD / 32), kb = r / (NPAD / 32), nq = nb * 32; int n0, nv;
            if (nq < 3072) { n0 = nq; nv = 32; } else if (nq < 7168) { n0 = nq + 16; nv = 32; } else if (nq == 7168) { n0 = 3072; nv = 16; } else { n0 = 0; nv = 0; }
            p0_transpose_item(p.w_in, 7184, kb * 64, n0, nv, WinT, 1024, nq, 0, scr, lane); continue; } r -= I_IN;
        if (r < I_OUT) { const int nb = r % 32, kb = r / 32; p0_transpose_item(p.w_out, 1024, kb * 64, nb * 32, 32, WoutT, 1024, nb * 32, 0, scr, lane); continue; } r -= I_OUT;
        if (r < I_Q) { const int nb = r % 64, kb = r / 64; p0_transpose_item(p.wq, 2048, kb * 64, nb * 32, 32, WqT, 1024, nb * 32, 0, scr, lane); continue; } r -= I_Q;
        if (r < I_LRU) {
            const int mat = r >> 3, sub = r & 7, g = mat >> 3, n = mat & 7, kb = sub >> 2, nb = sub & 3;
            const int np = n < 6 ? n : 6, half = n - np;
            const float* W = (g ? p.lwx : p.lwa) + (size_t)n * 128 * 128;
            bf16* dst = LruB + (size_t)n * 256 * 256;
            p0_transpose_item(W, 128, kb * 64, nb * 32, 32, dst, 256, g * 128 + nb * 32, half * 128, scr, lane);
            p0_transpose_item(W, 128, kb * 64, 0, 0, dst, 256, g * 128 + nb * 32, (1 - half) * 128, scr, lane);
            continue; } r -= I_LRU;
        if (r < I_SUB) {
            const int h = r >> 8, pp = (r >> 7) & 1, n = r & 127;
            const float* src = p.subk + (size_t)r * 128; bf16* dst = SubK + ((size_t)h * 256 + pp * 128 + n) * 256;
            const f32x2 v = *(const f32x2*)(src + 2 * lane);
            *(unsigned*)(dst + pp * 128 + 2 * lane) = pk2(v.x, v.y);
            *(unsigned*)(dst + (1 - pp) * 128 + 2 * lane) = 0u;
            continue; } r -= I_SUB;
        {
            const int tb = r >> 14, row = r & 16383;
            const float* src = (tb ? p.pv : p.pu) + (size_t)row * 1024 + lane * 16;
            f32x4 v[4]; float am = 0.f;
#pragma unroll
            for (int j = 0; j < 4; ++j) { v[j] = *(const f32x4*)(src + 4 * j); am = fmaxf(am, fmaxf(fmaxf(fabsf(v[j].x), fabsf(v[j].y)), fmaxf(fabsf(v[j].z), fabsf(v[j].w)))); }
#pragma unroll
            for (int o = 1; o < 64; o <<= 1) am = fmaxf(am, __shfl_xor(am, o));
            const float inv = am > 0.f ? 7.5f / am : 0.f;
            unsigned long long lo = 0ull; unsigned hi = 0u;
#pragma unroll
            for (int j = 0; j < 16; ++j) { const float x = v[j >> 2][j & 3] * inv, a = fabsf(x);
                unsigned code = a < 1.f ? (unsigned)__builtin_rintf(a * 8.f) : (a < 2.f ? 8u + (unsigned)__builtin_rintf((a - 1.f) * 8.f) : (a < 4.f ? 16u + (unsigned)__builtin_rintf((a - 2.f) * 4.f) : 24u + (unsigned)__builtin_rintf((a - 4.f) * 2.f)));
                code = code > 31u ? 31u : code; code |= (x < 0.f) ? 32u : 0u;
                const int bit = 6 * j;
                if (bit + 6 <= 64) lo |= (unsigned long long)code << bit;
                else if (bit >= 64) hi |= code << (bit - 64);
                else { lo |= (unsigned long long)code << bit; hi |= code >> (64 - bit); } }
            unsigned* dst = (unsigned*)(ws + (tb ? WS_V : WS_U) + (size_t)row * 768 + lane * 12);
            dst[0] = (unsigned)lo; dst[1] = (unsigned)(lo >> 32); dst[2] = hi;
            if (lane == 0) ((float*)(ws + (tb ? WS_SV : WS_SU)))[row] = am * (1.f / 7.5f);
        }
    }
}

__device__ __forceinline__ float mod_at(const float* modp, int b, int n) {
    float s = 0.f;
#pragma unroll
    for (int kc = 0; kc < 8; ++kc) s += modp[(size_t)(kc * 8 + b) * 6144 + n];
    return s;
}

__device__ __forceinline__ void phase1(const Params& p, LAS unsigned char* lds, int G) {
    const int tid = threadIdx.x, lane = tid & 63, wave = __builtin_amdgcn_readfirstlane(tid >> 6);
    const float* modp = (const float*)(p.ws + WS_MODP);
    LAS float* gs = (LAS float*)lds; LAS float* sh = gs + 1024;
    bf16* H = (bf16*)p.out;
    for (int tile = blockIdx.x; tile < T / 256; tile += G) {
        const int b = tile / 32;
        __syncthreads();
        for (int k = tid; k < 1024; k += NTHR) { gs[k] = p.npm[k] * (1.f + mod_at(modp, b, 1024 + k)); sh[k] = mod_at(modp, b, k); }
        __syncthreads();
        for (int rr = 0; rr < 32; ++rr) {
            const size_t row = (size_t)tile * 256 + wave * 32 + rr;
            const f32x4* xr = (const f32x4*)(p.x + row * 1024) + lane;
            f32x4 v[4]; float s = 0.f;
#pragma unroll
            for (int j = 0; j < 4; ++j) { v[j] = xr[64 * j]; s += (v[j].x * v[j].x + v[j].y * v[j].y) + (v[j].z * v[j].z + v[j].w * v[j].w); }
            const float rstd = 1.f / sqrtf(wave_sum(s) * (1.f / 1024.f) + 1e-6f);
            u32x2* o8 = (u32x2*)(H + row * 1024) + lane;
#pragma unroll
            for (int j = 0; j < 4; ++j) { const int k = 256 * j + 4 * lane; const f32x4 g4 = *(const LAS f32x4*)(gs + k), s4 = *(const LAS f32x4*)(sh + k);
                u32x2 w; w.x = pk2(v[j].x * rstd * g4.x + s4.x, v[j].y * rstd * g4.y + s4.y); w.y = pk2(v[j].z * rstd * g4.z + s4.z, v[j].w * rstd * g4.w + s4.w);
                o8[64 * j] = w; }
        }
    }
}

typedef short bf16x8_t __attribute__((ext_vector_type(8)));
template <bool FINAL>
__device__ __forceinline__ void phase_lru(const Params& p, LAS unsigned char* lds, int G) {
    const int tid = threadIdx.x, lane = tid & 63, wave = __builtin_amdgcn_readfirstlane(tid >> 6), q4 = lane >> 4, c16 = lane & 15;
    constexpr int PQ = 136;
    LAS bf16* XC = (LAS bf16*)lds;
    LAS bf16* HB = XC + 64 * PQ;
    LAS float* CW = (LAS float*)(HB + 64 * PQ);
    const bf16* XL = (const bf16*)(p.ws + WS_XLXG); const bf16* LruB = (const bf16*)(p.ws + WS_LRUB);
    const bf16* XG = (const bf16*)(p.ws + WS_XLXG) + 1024; const bf16* GB = (const bf16*)(p.ws + WS_GAGB) + 1024; bf16* GA = (bf16*)(p.ws + WS_GAGB);
    const bf16* O = (const bf16*)(p.ws + WS_QKV) + 1024; const bf16* R = (const bf16*)(p.ws + WS_R); const float* SS = (const float*)(p.ws + WS_SS);
    f32x2* CAR = (f32x2*)(p.ws + WS_LRUC);
    const int c8 = tid & 15, tr = tid >> 4;
    for (int it = blockIdx.x; it < 8 * 8 * 4; it += G) {
        const int sg = it & 3, n = (it >> 2) & 7, b = it >> 5;
        const int chc = n * 128 + c8 * 8;
        const int chm = n * 128 + wave * 16 + c16;
        __syncthreads();
        for (int i = tid; i < 768; i += NTHR) { const int q = i >> 7, c = i & 127; CW[i] = q < 4 ? p.conv_w[q * 1024 + n * 128 + c] : (q == 4 ? p.conv_b[n * 128 + c] : p.gla_norm[n * 128 + c]); }
        const float ba = p.lba[chm], bx = p.lbx[chm], sp = -8.f * softplus_f(-p.lam[chm]);
        bf16x8_t wf[2][4];
        { const int np = n < 6 ? n : 6, half = n - np;
#pragma unroll
          for (int g = 0; g < 2; ++g)
#pragma unroll
              for (int ks = 0; ks < 4; ++ks) wf[g][ks] = *(const bf16x8_t*)(LruB + (size_t)n * 65536 + (size_t)(g * 128 + wave * 16 + c16) * 256 + half * 128 + ks * 32 + q4 * 8); }
        float hc = 0.f, aseg = 1.f;
        if (FINAL) { for (int s = 0; s < sg; ++s) { const f32x2 c = CAR[(size_t)((b * 8 + n) * 4 + s) * 128 + wave * 16 + c16]; hc = c.x * hc + c.y; } }
        const size_t tseg = (size_t)b * SEQ + sg * 2048;
        u32x4 xr[5];
#define LRU_LOADX(t0_) do { _Pragma("unroll") for (int _k = 0; _k < 5; ++_k) { const long _t = (long)(t0_) + 2 * tr + _k - 3; \
            xr[_k] = (_t < (long)b * SEQ) ? (u32x4){0u, 0u, 0u, 0u} : *(const u32x4*)(XL + (size_t)_t * 2048 + chc); } } while (0)
        LRU_LOADX(tseg);
        __syncthreads();
#pragma unroll 1
        for (int tl = 0; tl < 32; ++tl) {
            const size_t t0 = tseg + tl * 64;
            { float xv[5][8];
#pragma unroll
              for (int k = 0; k < 5; ++k) { xv[k][0] = bflo(xr[k].x); xv[k][1] = bfhi(xr[k].x); xv[k][2] = bflo(xr[k].y); xv[k][3] = bfhi(xr[k].y); xv[k][4] = bflo(xr[k].z); xv[k][5] = bfhi(xr[k].z); xv[k][6] = bflo(xr[k].w); xv[k][7] = bfhi(xr[k].w); }
              float cw[5][8];
#pragma unroll
              for (int q = 0; q < 5; ++q) { const f32x4 w0 = *(const LAS f32x4*)(CW + q * 128 + c8 * 8), w1 = *(const LAS f32x4*)(CW + q * 128 + c8 * 8 + 4);
                  cw[q][0] = w0.x; cw[q][1] = w0.y; cw[q][2] = w0.z; cw[q][3] = w0.w; cw[q][4] = w1.x; cw[q][5] = w1.y; cw[q][6] = w1.z; cw[q][7] = w1.w; }
#pragma unroll
              for (int i2 = 0; i2 < 2; ++i2) { float o[8];
#pragma unroll
                  for (int j = 0; j < 8; ++j) o[j] = cw[4][j] + cw[0][j] * xv[i2][j] + cw[1][j] * xv[i2 + 1][j] + cw[2][j] * xv[i2 + 2][j] + cw[3][j] * xv[i2 + 3][j];
                  *(LAS u32x4*)(XC + (2 * tr + i2) * PQ + c8 * 8) = (u32x4){pk2(o[0], o[1]), pk2(o[2], o[3]), pk2(o[4], o[5]), pk2(o[6], o[7])}; } }
            u32x4 mxg[2], mgb[2], mo[2], mr[2], mga[2]; float mss[2];
            if (FINAL) {
#pragma unroll
                for (int i2 = 0; i2 < 2; ++i2) { const size_t t = t0 + 2 * tr + i2;
                    mxg[i2] = *(const u32x4*)(XG + t * 2048 + chc); mgb[i2] = *(const u32x4*)(GB + t * 2048 + chc); mo[i2] = *(const u32x4*)(O + t * 2048 + chc);
                    mr[i2] = *(const u32x4*)(R + t * 1024 + chc); mga[i2] = *(const u32x4*)(GA + t * 2048 + chc); mss[i2] = SS[t * 4 + (chc >> 8)]; } }
            if (tl + 1 < 32) LRU_LOADX(t0 + 64);
            __syncthreads();
            pg8::f32x4 acc[4][2];
#pragma unroll
            for (int tt = 0; tt < 4; ++tt) { acc[tt][0] = (pg8::f32x4){0.f, 0.f, 0.f, 0.f}; acc[tt][1] = (pg8::f32x4){0.f, 0.f, 0.f, 0.f}; }
#pragma unroll
            for (int ks = 0; ks < 4; ++ks)
#pragma unroll
                for (int tt = 0; tt < 4; ++tt) { const bf16x8_t a = *(const LAS bf16x8_t*)(XC + (tt * 16 + c16) * PQ + ks * 32 + q4 * 8);
                    acc[tt][0] = __builtin_amdgcn_mfma_f32_16x16x32_bf16(a, wf[0][ks], acc[tt][0], 0, 0, 0);
                    acc[tt][1] = __builtin_amdgcn_mfma_f32_16x16x32_bf16(a, wf[1][ks], acc[tt][1], 0, 0, 0); }
#pragma unroll
            for (int tt = 0; tt < 4; ++tt) {
                float av[4], uv[4];
#pragma unroll
                for (int j = 0; j < 4; ++j) { const float xc = bf2f(XC[(tt * 16 + q4 * 4 + j) * PQ + wave * 16 + c16]);
                    const float gr = sigmoid_f(acc[tt][0][j] + ba), gi = sigmoid_f(acc[tt][1][j] + bx);
                    const float a = __expf(sp * gr); av[j] = a; uv[j] = sqrtf(fmaxf(1.f - a * a, 0.f)) * gi * xc; }
                float A4 = av[0], H4 = uv[0];
#pragma unroll
                for (int j = 1; j < 4; ++j) { H4 = av[j] * H4 + uv[j]; A4 *= av[j]; }
                float Ai = A4, Hi = H4;
                { const float Ap = __shfl_up(Ai, 16), Hp = __shfl_up(Hi, 16); if (q4 >= 1) { Hi = Hp * Ai + Hi; Ai = Ap * Ai; } }
                { const float Ap = __shfl_up(Ai, 32), Hp = __shfl_up(Hi, 32); if (q4 >= 2) { Hi = Hp * Ai + Hi; Ai = Ap * Ai; } }
                float Ae = __shfl_up(Ai, 16), He = __shfl_up(Hi, 16); if (q4 == 0) { Ae = 1.f; He = 0.f; }
                float h = hc * Ae + He;
                const float At = __shfl(Ai, 48 + c16), Ht = __shfl(Hi, 48 + c16);
                if (FINAL) {
#pragma unroll
                    for (int j = 0; j < 4; ++j) { h = av[j] * h + uv[j]; HB[(tt * 16 + q4 * 4 + j) * PQ + wave * 16 + c16] = (bf16)f2bf(h); } }
                hc = hc * At + Ht; aseg *= At;
            }
            __syncthreads();
            if (FINAL) {
#pragma unroll
                for (int i2 = 0; i2 < 2; ++i2) { const size_t t = t0 + 2 * tr + i2;
                    const u32x4 hw = *(const LAS u32x4*)(HB + (2 * tr + i2) * PQ + c8 * 8);
                    const float rstd = 1.f / sqrtf(mss[i2] * (1.f / 256.f) + 1e-6f);
                    const unsigned hwv[4] = {hw.x, hw.y, hw.z, hw.w}, xgv[4] = {mxg[i2].x, mxg[i2].y, mxg[i2].z, mxg[i2].w}, gbv[4] = {mgb[i2].x, mgb[i2].y, mgb[i2].z, mgb[i2].w};
                    const unsigned ov[4] = {mo[i2].x, mo[i2].y, mo[i2].z, mo[i2].w}, rv[4] = {mr[i2].x, mr[i2].y, mr[i2].z, mr[i2].w}, gav[4] = {mga[i2].x, mga[i2].y, mga[i2].z, mga[i2].w};
                    unsigned ow[4];
                    const f32x4 g0 = *(const LAS f32x4*)(CW + 640 + c8 * 8), g1 = *(const LAS f32x4*)(CW + 640 + c8 * 8 + 4);
                    const float gn[8] = {g0.x, g0.y, g0.z, g0.w, g1.x, g1.y, g1.z, g1.w};
#pragma unroll
                    for (int q = 0; q < 4; ++q) {
                        const float m0 = sigmoid_f(bflo(gav[q])) * (bflo(ov[q]) * rstd * gn[2 * q] * silu_f(bflo(rv[q]))) + sigmoid_f(bflo(gbv[q])) * (bflo(hwv[q]) * gelu_f(bflo(xgv[q])));
                        const float m1 = sigmoid_f(bfhi(gav[q])) * (bfhi(ov[q]) * rstd * gn[2 * q + 1] * silu_f(bfhi(rv[q]))) + sigmoid_f(bfhi(gbv[q])) * (bfhi(hwv[q]) * gelu_f(bfhi(xgv[q])));
                        ow[q] = pk2(m0, m1); }
                    *(u32x4*)(GA + t * 2048 + chc) = (u32x4){ow[0], ow[1], ow[2], ow[3]}; }
            }
        }
#undef LRU_LOADX
        if (!FINAL) { if (q4 == 0) CAR[(size_t)((b * 8 + n) * 4 + sg) * 128 + wave * 16 + c16] = (f32x2){aseg, hc}; }
        __syncthreads();
    }
}

__device__ __forceinline__ void phase_gla_prep(const Params& p, LAS unsigned char* lds, int G) {
    const int tid = threadIdx.x;
    LAS float* segt = (LAS float*)lds;
    bf16* QKV = (bf16*)(p.ws + WS_QKV); const bf16* AL = (const bf16*)(p.ws + WS_ALOW); float* DK = (float*)(p.ws + WS_DK);
    const int kp = tid & 127, seg = tid >> 7;
    for (int it = blockIdx.x; it < 8 * 128 * 4; it += G) {
        const int h = it & 3, ch = (it >> 2) & 127, b = it >> 9;
        float wa[16];
#pragma unroll
        for (int r = 0; r < 16; ++r) wa[r] = p.w_alpha[r * 512 + h * 128 + kp];
        const float balpha = p.b_alpha[h * 128 + kp];
        const size_t t0 = (size_t)b * SEQ + ch * 64 + seg * 16;
        float qv[16], kv[16];
#pragma unroll
        for (int i = 0; i < 16; ++i) { qv[i] = bf2f(QKV[(t0 + i) * 2048 + h * 128 + kp]); kv[i] = bf2f(QKV[(t0 + i) * 2048 + 512 + h * 128 + kp]); }
        float cl[16]; float run = 0.f;
#pragma unroll
        for (int i = 0; i < 16; ++i) { const size_t t = t0 + i;
            const u32x4 a0 = *(const u32x4*)(AL + t * 16), a1 = *(const u32x4*)(AL + t * 16 + 8);
            float z = balpha;
            z += bflo(a0.x) * wa[0] + bfhi(a0.x) * wa[1] + bflo(a0.y) * wa[2] + bfhi(a0.y) * wa[3] + bflo(a0.z) * wa[4] + bfhi(a0.z) * wa[5] + bflo(a0.w) * wa[6] + bfhi(a0.w) * wa[7];
            z += bflo(a1.x) * wa[8] + bfhi(a1.x) * wa[9] + bflo(a1.y) * wa[10] + bfhi(a1.y) * wa[11] + bflo(a1.z) * wa[12] + bfhi(a1.z) * wa[13] + bflo(a1.w) * wa[14] + bfhi(a1.w) * wa[15];
            const float ls = fminf(z, 0.f) - __logf(1.f + __expf(-fabsf(z)));
            run += ls * (1.f / 16.f); cl[i] = run; }
        __syncthreads();
        segt[seg * 128 + kp] = run;
        __syncthreads();
        float off = 0.f, tot = 0.f;
#pragma unroll
        for (int s = 0; s < 4; ++s) { const float v = segt[s * 128 + kp]; tot += v; if (s < seg) off += v; }
        if (seg == 0) DK[(size_t)(b * 128 + ch) * 512 + h * 128 + kp] = __expf(tot);
#pragma unroll
        for (int i = 0; i < 16; ++i) { const float cum = cl[i] + off;
            QKV[(t0 + i) * 2048 + h * 128 + kp] = (bf16)f2bf(qv[i] * 0.08838834764831845f * __expf(cum));
            QKV[(t0 + i) * 2048 + 512 + h * 128 + kp] = (bf16)f2bf(kv[i] * __expf(-cum)); }
    }
}
__device__ __forceinline__ void phase_gla_seq(const Params& p, LAS unsigned char* lds, int G) {
    const int tid = threadIdx.x, lane = tid & 63, wave = __builtin_amdgcn_readfirstlane(tid >> 6), q4 = lane >> 4, c16 = lane & 15;
    constexpr int PQ = 136, PS = 72;
    LAS bf16* Qs = (LAS bf16*)lds;
    LAS bf16* Kd = Qs + 64 * PQ;
    LAS bf16* KdT = Kd + 64 * PQ;
    LAS bf16* VT = KdT + 128 * PS;
    LAS bf16* Pm = VT + 32 * PS;
    LAS bf16* ST = Pm + 64 * PS;
    LAS float* dk = (LAS float*)(ST + 32 * PQ);
    const bf16* QKV = (const bf16*)(p.ws + WS_QKV); bf16* VO = (bf16*)(p.ws + WS_QKV); const float* DK = (const float*)(p.ws + WS_DK); float* SS = (float*)(p.ws + WS_SS);
    const int kp = tid & 127, seg = tid >> 7;
    const int vv = tid & 31, sg = tid >> 5;
    const int r0 = tid >> 4, cc = (tid & 15) * 8;
    for (int it = blockIdx.x; it < 8 * 4 * 8; it += G) {
        const int v8 = it & 7, h = (it >> 3) & 3, b = it >> 5;
        pg8::f32x4 sacc[2] = {(pg8::f32x4){0.f, 0.f, 0.f, 0.f}, (pg8::f32x4){0.f, 0.f, 0.f, 0.f}};
        __syncthreads();
        for (int i = tid; i < 32 * PQ / 2; i += NTHR) ((LAS unsigned*)ST)[i] = 0u;
        u32x4 rq[2], rk[2]; unsigned rkt[8], rv[2]; float rdk = 0.f;
#define GLA_LOAD(chn) do { const size_t _t0 = (size_t)b * SEQ + (size_t)(chn) * 64; \
            _Pragma("unroll") for (int _j = 0; _j < 2; ++_j) { rq[_j] = *(const u32x4*)(QKV + (_t0 + r0 + 32 * _j) * 2048 + h * 128 + cc); rk[_j] = *(const u32x4*)(QKV + (_t0 + r0 + 32 * _j) * 2048 + 512 + h * 128 + cc); } \
            _Pragma("unroll") for (int _i = 0; _i < 8; ++_i) { const unsigned _lo = QKV[(_t0 + seg * 16 + 2 * _i) * 2048 + 512 + h * 128 + kp], _hi = QKV[(_t0 + seg * 16 + 2 * _i + 1) * 2048 + 512 + h * 128 + kp]; rkt[_i] = _lo | (_hi << 16); } \
            _Pragma("unroll") for (int _i = 0; _i < 2; ++_i) { const unsigned _lo = QKV[(_t0 + sg * 4 + 2 * _i) * 2048 + 1024 + h * 256 + v8 * 32 + vv], _hi = QKV[(_t0 + sg * 4 + 2 * _i + 1) * 2048 + 1024 + h * 256 + v8 * 32 + vv]; rv[_i] = _lo | (_hi << 16); } \
            if (tid < 128) rdk = DK[(size_t)(b * 128 + (chn)) * 512 + h * 128 + tid]; } while (0)
        GLA_LOAD(0);
#pragma unroll 1
        for (int ch = 0; ch < SEQ / 64; ++ch) {
            const size_t t0 = (size_t)b * SEQ + ch * 64;
#pragma unroll
            for (int j = 0; j < 2; ++j) { *(LAS u32x4*)(Qs + (r0 + 32 * j) * PQ + cc) = rq[j]; *(LAS u32x4*)(Kd + (r0 + 32 * j) * PQ + cc) = rk[j]; }
            *(LAS u32x4*)(KdT + kp * PS + seg * 16) = (u32x4){rkt[0], rkt[1], rkt[2], rkt[3]};
            *(LAS u32x4*)(KdT + kp * PS + seg * 16 + 8) = (u32x4){rkt[4], rkt[5], rkt[6], rkt[7]};
            *(LAS u32x2*)(VT + vv * PS + sg * 4) = (u32x2){rv[0], rv[1]};
            if (tid < 128) dk[tid] = rdk;
            if (ch + 1 < SEQ / 64) GLA_LOAD(ch + 1);
            __syncthreads();
            { const int tt = wave & 3;
#pragma unroll
              for (int i2 = 0; i2 < 2; ++i2) { const int ts = (wave >> 2) * 2 + i2;
                  pg8::f32x4 acc = (pg8::f32x4){0.f, 0.f, 0.f, 0.f};
                  if (ts <= tt) {
#pragma unroll
                      for (int ks = 0; ks < 4; ++ks) { const bf16x8_t a = *(const LAS bf16x8_t*)(Kd + (ts * 16 + c16) * PQ + ks * 32 + q4 * 8), bb = *(const LAS bf16x8_t*)(Qs + (tt * 16 + c16) * PQ + ks * 32 + q4 * 8);
                          acc = __builtin_amdgcn_mfma_f32_16x16x32_bf16(a, bb, acc, 0, 0, 0); }
                      const int tg = tt * 16 + c16, sgl = ts * 16 + q4 * 4;
#pragma unroll
                      for (int j = 0; j < 4; ++j) if (sgl + j > tg) acc[j] = 0.f;
                  }
                  *(LAS u32x2*)(Pm + (tt * 16 + c16) * PS + ts * 16 + q4 * 4) = (u32x2){pk2(acc[0], acc[1]), pk2(acc[2], acc[3])}; } }
            __syncthreads();
            { const int tt = wave & 3, tv = wave >> 2;
              pg8::f32x4 oacc = (pg8::f32x4){0.f, 0.f, 0.f, 0.f};
#pragma unroll
              for (int ks = 0; ks < 2; ++ks) { const bf16x8_t bb = *(const LAS bf16x8_t*)(Pm + (tt * 16 + c16) * PS + ks * 32 + q4 * 8), a = *(const LAS bf16x8_t*)(VT + (tv * 16 + c16) * PS + ks * 32 + q4 * 8);
                  oacc = __builtin_amdgcn_mfma_f32_16x16x32_bf16(a, bb, oacc, 0, 0, 0); }
#pragma unroll
              for (int ks = 0; ks < 4; ++ks) { const bf16x8_t bb = *(const LAS bf16x8_t*)(Qs + (tt * 16 + c16) * PQ + ks * 32 + q4 * 8), a = *(const LAS bf16x8_t*)(ST + (tv * 16 + c16) * PQ + ks * 32 + q4 * 8);
                  oacc = __builtin_amdgcn_mfma_f32_16x16x32_bf16(a, bb, oacc, 0, 0, 0); }
              *(u32x2*)(VO + (t0 + tt * 16 + c16) * 2048 + 1024 + h * 256 + v8 * 32 + tv * 16 + q4 * 4) = (u32x2){pk2(oacc[0], oacc[1]), pk2(oacc[2], oacc[3])};
              float sq = (oacc[0] * oacc[0] + oacc[1] * oacc[1]) + (oacc[2] * oacc[2] + oacc[3] * oacc[3]);
              sq += __shfl_xor(sq, 16); sq += __shfl_xor(sq, 32);
              if (q4 == 0) atomicAdd(SS + (t0 + tt * 16 + c16) * 4 + h, sq); }
#pragma unroll
            for (int ks = 0; ks < 2; ++ks) { const bf16x8_t a = *(const LAS bf16x8_t*)(KdT + (wave * 16 + c16) * PS + ks * 32 + q4 * 8);
#pragma unroll
                for (int tv = 0; tv < 2; ++tv) { const bf16x8_t bb = *(const LAS bf16x8_t*)(VT + (tv * 16 + c16) * PS + ks * 32 + q4 * 8);
                    sacc[tv] = __builtin_amdgcn_mfma_f32_16x16x32_bf16(a, bb, sacc[tv], 0, 0, 0); } }
            { const pg8::f32x4 d4 = *(const LAS pg8::f32x4*)(dk + wave * 16 + q4 * 4);
#pragma unroll
              for (int tv = 0; tv < 2; ++tv) sacc[tv] = sacc[tv] * d4; }
            __syncthreads();
#pragma unroll
            for (int tv = 0; tv < 2; ++tv) *(LAS u32x2*)(ST + (tv * 16 + c16) * PQ + wave * 16 + q4 * 4) = (u32x2){pk2(sacc[tv][0], sacc[tv][1]), pk2(sacc[tv][2], sacc[tv][3])};
        }
#undef GLA_LOAD
    }
}

__device__ __forceinline__ void phase_norm2(const Params& p, LAS unsigned char* lds, int G) {
    const int tid = threadIdx.x, lane = tid & 63, wave = __builtin_amdgcn_readfirstlane(tid >> 6);
    const float* modp = (const float*)(p.ws + WS_MODP);
    LAS float* g1 = (LAS float*)lds; LAS float* gs = g1 + 1024; LAS float* sh = gs + 1024;
    const bf16* Y = (const bf16*)(p.ws + WS_Y); bf16* H2 = (bf16*)(p.ws + WS_H2);
    for (int tile = blockIdx.x; tile < T / 256; tile += G) {
        const int b = tile / 32;
        __syncthreads();
        for (int k = tid; k < 1024; k += NTHR) { g1[k] = mod_at(modp, b, 2048 + k) * p.npo[k]; gs[k] = p.npf[k] * (1.f + mod_at(modp, b, 4096 + k)); sh[k] = mod_at(modp, b, 3072 + k); }
        __syncthreads();
        for (int rr = 0; rr < 32; ++rr) {
            const size_t row = (size_t)tile * 256 + wave * 32 + rr;
            const f32x4* xr = (const f32x4*)(p.x + row * 1024) + lane; const u32x2* yr = (const u32x2*)(Y + row * 1024) + lane;
            f32x4 xv[4], yv[4]; float s = 0.f;
#pragma unroll
            for (int j = 0; j < 4; ++j) { xv[j] = xr[64 * j]; const u32x2 yw = yr[64 * j]; yv[j] = (f32x4){bflo(yw.x), bfhi(yw.x), bflo(yw.y), bfhi(yw.y)};
                s += (yv[j].x * yv[j].x + yv[j].y * yv[j].y) + (yv[j].z * yv[j].z + yv[j].w * yv[j].w); }
            const float rstd = 1.f / sqrtf(wave_sum(s) * (1.f / 1024.f) + 1e-6f);
            float s2 = 0.f;
            f32x4* orow = (f32x4*)(p.out + row * 1024) + lane;
#pragma unroll
            for (int j = 0; j < 4; ++j) { const int k = 256 * j + 4 * lane; const f32x4 g4 = *(const LAS f32x4*)(g1 + k);
                xv[j] = xv[j] + yv[j] * rstd * g4; orow[64 * j] = xv[j];
                s2 += (xv[j].x * xv[j].x + xv[j].y * xv[j].y) + (xv[j].z * xv[j].z + xv[j].w * xv[j].w); }
            const float rstd2 = 1.f / sqrtf(wave_sum(s2) * (1.f / 1024.f) + 1e-6f);
            u32x2* o8 = (u32x2*)(H2 + row * 1024) + lane;
#pragma unroll
            for (int j = 0; j < 4; ++j) { const int k = 256 * j + 4 * lane; const f32x4 g4 = *(const LAS f32x4*)(gs + k), s4 = *(const LAS f32x4*)(sh + k);
                u32x2 w; w.x = pk2(xv[j].x * rstd2 * g4.x + s4.x, xv[j].y * rstd2 * g4.y + s4.y); w.y = pk2(xv[j].z * rstd2 * g4.z + s4.z, xv[j].w * rstd2 * g4.w + s4.w);
                o8[64 * j] = w; }
        }
    }
}

__device__ __forceinline__ unsigned h16_key(unsigned b) { return (b & 0x8000u) ? (~b & 0xffffu) : (b | 0x8000u); }
__device__ __forceinline__ float h16_key_val(unsigned s) { const unsigned b = (s & 0x8000u) ? (s & 0x7fffu) : (~s & 0xffffu); return (float)__builtin_bit_cast(_Float16, (unsigned short)b); }
#define INS16(top, x) do { _Pragma("unroll") for (int _j = 0; _j < 16; ++_j) { const unsigned _hi = max(top[_j], x), _lo = min(top[_j], x); top[_j] = _hi; x = _lo; } } while (0)
__device__ __forceinline__ void phase_topk(const Params& p, LAS unsigned char* lds, int G) {
    const int tid = threadIdx.x;
    const unsigned short* SC = (const unsigned short*)(p.ws + WS_SC); unsigned* TK = (unsigned*)(p.ws + WS_TOPK); float* TK2 = (float*)(p.ws + WS_TOPK2);
    const float* SU = (const float*)(p.ws + WS_SU); const float* SV = (const float*)(p.ws + WS_SV);
    LAS unsigned* my = (LAS unsigned*)lds + tid * 33;
    for (int blk = blockIdx.x; blk < T * 8 / NTHR; blk += G) {
        const int item = blk * NTHR + tid, t = item >> 3, h = item & 7;
        unsigned topA[16], topB[16];
#pragma unroll
        for (int j = 0; j < 16; ++j) { topA[j] = 0u; topB[j] = 0u; }
        const u32x4* src = (const u32x4*)(SC + (size_t)t * 2048 + h * 256);
#pragma unroll 1
        for (int c8 = 0; c8 < 16; ++c8) { const u32x4 w = src[c8];
            const unsigned ww[4] = {w.x, w.y, w.z, w.w};
#pragma unroll
            for (int q = 0; q < 4; ++q) { unsigned k0 = (h16_key(ww[q] & 0xffffu) << 16) | (unsigned)(127 - (c8 * 8 + q * 2)), k1 = (h16_key(ww[q] >> 16) << 16) | (unsigned)(127 - (c8 * 8 + q * 2 + 1));
                INS16(topA, k0); INS16(topA, k1); } }
#pragma unroll 1
        for (int c8 = 0; c8 < 16; ++c8) { const u32x4 w = src[16 + c8];
            const unsigned ww[4] = {w.x, w.y, w.z, w.w};
#pragma unroll
            for (int q = 0; q < 4; ++q) { unsigned k0 = (h16_key(ww[q] & 0xffffu) << 16) | (unsigned)(127 - (c8 * 8 + q * 2)), k1 = (h16_key(ww[q] >> 16) << 16) | (unsigned)(127 - (c8 * 8 + q * 2 + 1));
                INS16(topB, k0); INS16(topB, k1); } }
        float fa[16], fb[16];
#pragma unroll
        for (int j = 0; j < 16; ++j) { fa[j] = h16_key_val(topA[j] >> 16); fb[j] = h16_key_val(topB[j] >> 16); my[j] = 127u - (topA[j] & 127u); my[16 + j] = 127u - (topB[j] & 127u); }
        unsigned ct[16];
#pragma unroll
        for (int j = 0; j < 16; ++j) ct[j] = 0u;
#pragma unroll
        for (int i = 0; i < 16; ++i)
#pragma unroll
            for (int j = 0; j < 16; ++j) if ((i + 1) * (j + 1) <= 16) {
                const float s = fa[i] + fb[j]; unsigned u = __builtin_bit_cast(unsigned, s); u ^= (u >> 31) ? 0xffffffffu : 0x80000000u;
                unsigned key = (u & 0xffffff00u) | (unsigned)(255 - (i * 16 + j));
                INS16(ct, key); }
        float val[16], mx, sum = 0.f;
#pragma unroll
        for (int m = 0; m < 16; ++m) { unsigned u = ct[m] & 0xffffff00u; u ^= (u >> 31) ? 0x80000000u : 0xffffffffu; val[m] = __builtin_bit_cast(float, u); }
        mx = val[0];
#pragma unroll
        for (int m = 0; m < 16; ++m) { val[m] = __expf(val[m] - mx); sum += val[m]; }
        const float inv = 1.f / sum;
        LDS_WAIT();
        unsigned outw[16]; float outs[16];
#pragma unroll
        for (int m = 0; m < 16; ++m) { const unsigned pos = 255u - (ct[m] & 255u), i = pos >> 4, j = pos & 15u;
            const unsigned e = my[i] * 128u + my[16 + j];
            outw[m] = (e << 16) | f2bf(val[m] * inv * SV[e]); outs[m] = SU[e]; }
        u32x4* dst = (u32x4*)(TK + (size_t)item * 16); f32x4* dst2 = (f32x4*)(TK2 + (size_t)item * 16);
#pragma unroll
        for (int q = 0; q < 4; ++q) { dst[q] = (u32x4){outw[4 * q], outw[4 * q + 1], outw[4 * q + 2], outw[4 * q + 3]}; dst2[q] = (f32x4){outs[4 * q], outs[4 * q + 1], outs[4 * q + 2], outs[4 * q + 3]}; }
    }
}

typedef unsigned u32x3 __attribute__((ext_vector_type(3)));
typedef unsigned u32x6 __attribute__((ext_vector_type(6)));
typedef float f32x32 __attribute__((ext_vector_type(32)));
__device__ __forceinline__ float rdlane(float v, int l) { return __builtin_bit_cast(float, __builtin_amdgcn_readlane(__builtin_bit_cast(int, v), l)); }
__device__ __forceinline__ f32x32 fp6x2(u32x3 a, u32x3 b) { const u32x6 s = {a.x, a.y, a.z, b.x, b.y, b.z}; return __builtin_amdgcn_cvt_scalef32_pk32_f32_fp6(s, 1.0f); }
__device__ __forceinline__ void phase_gather(const Params& p, LAS unsigned char* lds, int G) {
    const int tid = threadIdx.x, lane = tid & 63, wave = __builtin_amdgcn_readfirstlane(tid >> 6);
    const float* modp = (const float*)(p.ws + WS_MODP);
    LAS float* g2 = (LAS float*)lds;
    const bf16* H2 = (const bf16*)(p.ws + WS_H2); const unsigned* TK = (const unsigned*)(p.ws + WS_TOPK); const float* TK2 = (const float*)(p.ws + WS_TOPK2);
    const unsigned char* U6 = p.ws + WS_U; const unsigned char* V6 = p.ws + WS_V;
    for (int tile = blockIdx.x; tile < T / 256; tile += G) {
        const int b = tile / 32;
        __syncthreads();
        for (int k = tid; k < 1024; k += NTHR) g2[k] = mod_at(modp, b, 5120 + k) * p.npof[k];
        __syncthreads();
#pragma unroll 1
        for (int rr = 0; rr < 32; ++rr) {
            const size_t row = (size_t)tile * 256 + wave * 32 + rr;
            float xt[16];
            { const u32x4 a = *(const u32x4*)(H2 + row * 1024 + lane * 16), c = *(const u32x4*)(H2 + row * 1024 + lane * 16 + 8);
              xt[0] = bflo(a.x); xt[1] = bfhi(a.x); xt[2] = bflo(a.y); xt[3] = bfhi(a.y); xt[4] = bflo(a.z); xt[5] = bfhi(a.z); xt[6] = bflo(a.w); xt[7] = bfhi(a.w);
              xt[8] = bflo(c.x); xt[9] = bfhi(c.x); xt[10] = bflo(c.y); xt[11] = bfhi(c.y); xt[12] = bflo(c.z); xt[13] = bfhi(c.z); xt[14] = bflo(c.w); xt[15] = bfhi(c.w); }
            float acc[16];
#pragma unroll
            for (int j = 0; j < 16; ++j) acc[j] = 0.f;
#pragma unroll 1
            for (int hh = 0; hh < 16; ++hh) {
                const u32x4* ra = (const u32x4*)(TK + row * 128 + hh * 8);
                const u32x4 w0 = ra[0], w1 = ra[1];
                const unsigned ww[8] = {w0.x, w0.y, w0.z, w0.w, w1.x, w1.y, w1.z, w1.w};
                u32x6 up[4], vp[4];
#pragma unroll
                for (int m = 0; m < 8; ++m) { const size_t eo = (size_t)((unsigned)__builtin_amdgcn_readfirstlane((int)ww[m]) >> 16) * 768 + lane * 12;
                    const u32x3 a = *(const u32x3*)(U6 + eo), c = *(const u32x3*)(V6 + eo);
                    if (m & 1) { up[m >> 1][3] = a.x; up[m >> 1][4] = a.y; up[m >> 1][5] = a.z; vp[m >> 1][3] = c.x; vp[m >> 1][4] = c.y; vp[m >> 1][5] = c.z; }
                    else { up[m >> 1][0] = a.x; up[m >> 1][1] = a.y; up[m >> 1][2] = a.z; vp[m >> 1][0] = c.x; vp[m >> 1][1] = c.y; vp[m >> 1][2] = c.z; } }
                const unsigned wa = TK[row * 128 + hh * 8 + (lane >> 3)]; const float su = TK2[row * 128 + hh * 8 + (lane >> 3)];
                float pd[8];
#pragma unroll
                for (int m = 0; m < 8; m += 2) { const f32x32 f = __builtin_amdgcn_cvt_scalef32_pk32_f32_fp6(up[m >> 1], 1.0f);
                    float s0 = 0.f, s1 = 0.f;
#pragma unroll
                    for (int j = 0; j < 16; ++j) { s0 += xt[j] * f[j]; s1 += xt[j] * f[16 + j]; }
                    pd[m] = s0; pd[m + 1] = s1; __builtin_amdgcn_sched_barrier(0); }
#pragma unroll
                for (int j = 0; j < 4; ++j) { const bool up_ = (lane & 32) != 0; const float keep = up_ ? pd[j + 4] : pd[j], send = up_ ? pd[j] : pd[j + 4]; pd[j] = keep + __shfl_xor(send, 32); }
#pragma unroll
                for (int j = 0; j < 2; ++j) { const bool up_ = (lane & 16) != 0; const float keep = up_ ? pd[j + 2] : pd[j], send = up_ ? pd[j] : pd[j + 2]; pd[j] = keep + __shfl_xor(send, 16); }
                { const bool up_ = (lane & 8) != 0; const float keep = up_ ? pd[1] : pd[0], send = up_ ? pd[0] : pd[1]; pd[0] = keep + __shfl_xor(send, 8); }
                float d = pd[0]; d += __shfl_xor(d, 4); d += __shfl_xor(d, 2); d += __shfl_xor(d, 1);
                const float coef = bflo(wa) * gelu_f(su * d);
#pragma unroll
                for (int m = 0; m < 8; m += 2) { const f32x32 f = __builtin_amdgcn_cvt_scalef32_pk32_f32_fp6(vp[m >> 1], 1.0f); const float c0 = rdlane(coef, 8 * m), c1 = rdlane(coef, 8 * m + 8);
#pragma unroll
                    for (int j = 0; j < 16; ++j) acc[j] += c0 * f[j] + c1 * f[16 + j];
                    __builtin_amdgcn_sched_barrier(0); }
            }
            float s = 0.f;
#pragma unroll
            for (int j = 0; j < 16; ++j) s += acc[j] * acc[j];
            const float rstd = 1.f / sqrtf(wave_sum(s) * (1.f / 1024.f) + 1e-6f);
            float* orow = p.out + row * 1024 + lane * 16;
#pragma unroll
            for (int q = 0; q < 4; ++q) { f32x4 o = *(const f32x4*)(orow + 4 * q); const f32x4 ga = *(const LAS f32x4*)(g2 + lane * 16 + 4 * q);
                o.x += ga.x * acc[4 * q] * rstd; o.y += ga.y * acc[4 * q + 1] * rstd; o.z += ga.z * acc[4 * q + 2] * rstd; o.w += ga.w * acc[4 * q + 3] * rstd;
                *(f32x4*)(orow + 4 * q) = o; }
        }
    }
}

#define XB_TMO      128
#define XB_XCNT(j)  (256  + 64 * (j))
#define XB_XSUB(j)  (1280 + 64 * (j))
#define XB_XGEN(j)  (2304 + 64 * (j))
#define XB_TOP      3328
#define XB_TOPGEN   3392
#define XCD_BAR_WORDS 3456
#define XB_SPIN_CAP (1u << 18)

__device__ __forceinline__ unsigned xb_ld(unsigned* p)              { return __hip_atomic_load(p, __ATOMIC_RELAXED, __HIP_MEMORY_SCOPE_AGENT); }
__device__ __forceinline__ unsigned xb_add(unsigned* p, unsigned v) { return __hip_atomic_fetch_add(p, v, __ATOMIC_RELAXED, __HIP_MEMORY_SCOPE_AGENT); }
__device__ __forceinline__ unsigned xb_xcc_id() { return (unsigned)__builtin_amdgcn_s_getreg((3 << 11) | 20) & 0xFu; }
#define XB_SPIN(cond, bar) do { unsigned _sp = 0; while (cond) { __builtin_amdgcn_s_sleep(1); \
    if ((++_sp & 255u) == 0u) { if (xb_ld(&(bar)[XB_TMO])) break; if (_sp > XB_SPIN_CAP) { atomicAdd(&(bar)[XB_TMO], 1u); break; } } } } while (0)

struct XcdBarrier {
    unsigned* bar; unsigned x;
    volatile LAS unsigned* st;
};

__device__ __forceinline__ XcdBarrier xcd_barrier_post(unsigned* bar, volatile LAS unsigned* st) {
    XcdBarrier b; b.bar = bar; b.x = xb_xcc_id(); b.st = st;
    if (threadIdx.x == 0) (void)xb_add(&bar[XB_XCNT(b.x)], 1u);
    return b;
}
__device__ __forceinline__ void xcd_barrier_complete(unsigned* bar, unsigned x, unsigned& nloc, unsigned& nx) {
    const unsigned G = gridDim.x * gridDim.y * gridDim.z;
    unsigned sum, cnt, mine, sp = 0u;
    for (;;) {
        sum = 0u; cnt = 0u; mine = 0u;
#pragma unroll
        for (unsigned j = 0; j < 16; ++j) { const unsigned c = xb_ld(&bar[XB_XCNT(j)]); sum += c; cnt += (c > 0u) ? 1u : 0u; mine = (j == x) ? c : mine; }
        if (sum == G) break;
        __builtin_amdgcn_s_sleep(1);
        if ((++sp & 255u) == 0u) { if (xb_ld(&bar[XB_TMO])) break; if (sp > XB_SPIN_CAP) { atomicAdd(&bar[XB_TMO], 1u); break; } }
    }
    nloc = mine > 0u ? mine : 1u; nx = cnt > 0u ? cnt : 1u;
}

__device__ __forceinline__ void xcd_barrier(const XcdBarrier& b) {
    asm volatile("s_waitcnt vmcnt(0)" ::: "memory");
    __syncthreads();
    if (threadIdx.x == 0) {
        unsigned* bar = b.bar;
        __builtin_amdgcn_s_waitcnt(0);
        unsigned nloc = b.st[0], nx = b.st[1];
        if (nloc == 0u) { xcd_barrier_complete(bar, b.x, nloc, nx); b.st[0] = nloc; b.st[1] = nx; }
        const unsigned old = xb_add(&bar[XB_XSUB(b.x)], 1u);
        const unsigned gen = old / nloc;
        if (old + 1u == (gen + 1u) * nloc) {
            __builtin_amdgcn_fence(__ATOMIC_RELEASE, "agent");
            asm volatile("s_waitcnt vmcnt(0)" ::: "memory");
            const unsigned og = xb_add(&bar[XB_TOP], 1u);
            const unsigned tg = og / nx;
            if (og + 1u == (tg + 1u) * nx) xb_add(&bar[XB_TOPGEN], 1u);
            else XB_SPIN(xb_ld(&bar[XB_TOPGEN]) == tg, bar);
            __builtin_amdgcn_fence(__ATOMIC_ACQUIRE, "agent");
            xb_add(&bar[XB_XGEN(b.x)], 1u);
            asm volatile("s_waitcnt vmcnt(0)" ::: "memory");
        } else {
            XB_SPIN(xb_ld(&bar[XB_XGEN(b.x)]) == gen, bar);
            __builtin_amdgcn_fence(__ATOMIC_ACQUIRE, "agent");
            asm volatile("s_waitcnt vmcnt(0)" ::: "memory");
        }
    }
    __syncthreads();
}


template <int PH>
__device__ __forceinline__ void run_phase(const Params& p, LAS unsigned char* lds, int G) {
    unsigned char* ws = p.ws;
    if constexpr (PH == 0) phase0(p, lds, G);
    else if constexpr (PH == 1) phase1(p, lds, G);
    else if constexpr (PH == 2) { pg8::Gemm g{(const bf16*)p.out, (const bf16*)(ws + WS_WIN), T, NPAD, 1024, 1024}; pg8::StaticOrder S; S.init(T, NPAD, G, (int)blockIdx.x);
        EpiSeg E{ws}; pg8::gemm_phase<EpiSeg, pg8::StaticOrder, true, true, 0, 1024, 1024>(lds, g, S, E); }
    else if constexpr (PH == 3) { phase_gla_prep(p, lds, G); __syncthreads(); phase_lru<false>(p, lds, G); }
    else if constexpr (PH == 4) phase_gla_seq(p, lds, G);
    else if constexpr (PH == 5) phase_lru<true>(p, lds, G);
    else if constexpr (PH == 6) { pg8::Gemm g{(const bf16*)(ws + WS_GAGB), (const bf16*)(ws + WS_WOUT), T, 1024, 1024, 2048}; pg8::StaticOrder S; S.init(T, 1024, G, (int)blockIdx.x);
        EpiPlain E{(bf16*)(ws + WS_Y), 1024}; pg8::gemm_phase<EpiPlain, pg8::StaticOrder, true, true, 0, 1024, 2048>(lds, g, S, E); }
    else if constexpr (PH == 7) phase_norm2(p, lds, G);
    else if constexpr (PH == 8) { pg8::Gemm g{(const bf16*)(ws + WS_H2), (const bf16*)(ws + WS_WQ), T, 2048, 1024, 1024}; pg8::StaticOrder S; S.init(T, 2048, G, (int)blockIdx.x);
        EpiPlain E{(bf16*)(ws + WS_QRY), 2048}; pg8::gemm_phase<EpiPlain, pg8::StaticOrder, true, true, 0, 1024, 1024>(lds, g, S, E); }
    else if constexpr (PH == 9) { pg8::Gemm g{(const bf16*)(ws + WS_QRY), (const bf16*)(ws + WS_SUBK), T, 2048, 256, 2048}; pg8::StaticOrder S; S.init(T, 2048, G, (int)blockIdx.x);
        EpiF16 E{(unsigned short*)(ws + WS_SC), 2048}; pg8::gemm_phase<EpiF16, pg8::StaticOrder, true, true, 2, 256, 2048>(lds, g, S, E); }
    else if constexpr (PH == 10) phase_topk(p, lds, G);
    else if constexpr (PH == 11) phase_gather(p, lds, G);
}
template <int PH>
__global__ void __launch_bounds__(NTHR, 2) k_phase(Params p) {
    extern __shared__ __attribute__((aligned(16))) unsigned char lds_raw[];
    run_phase<PH>(p, (LAS unsigned char*)lds_raw, (int)gridDim.x);
}
constexpr int LDS_BAR_OFF = LDS_BYTES - 16;
template <int PH>
__device__ __forceinline__ void run_from(const Params& p, LAS unsigned char* lds, int G, const XcdBarrier& bar) {
#if PROBE_PH >= 0
    unsigned long long pt0 = 0; if constexpr (PH == PROBE_PH) pt0 = __builtin_amdgcn_s_memrealtime();
#endif
    run_phase<PH>(p, lds, G);
    if constexpr (PH + 1 < N_PHASES) {
        if constexpr (PH == 0) cg::this_grid().sync();
        else xcd_barrier(bar);
    }
#if PROBE_PH >= 0
    if constexpr (PH == PROBE_PH) { const unsigned long long pt1 = __builtin_amdgcn_s_memrealtime(), span = pt1 - pt0;
        while (__builtin_amdgcn_s_memrealtime() - pt1 < (unsigned long long)PROBE_MULT * span) __builtin_amdgcn_s_sleep(8); }
#endif
    if constexpr (PH + 1 < N_PHASES) run_from<PH + 1>(p, lds, G, bar);
}
__global__ void __launch_bounds__(NTHR, 2) k_mega(Params p) {
    extern __shared__ __attribute__((aligned(16))) unsigned char lds_raw[];
    LAS unsigned char* lds = (LAS unsigned char*)lds_raw;
    if (threadIdx.x < 4) ((LAS unsigned*)(lds + LDS_BAR_OFF))[threadIdx.x] = 0u;
    __syncthreads();
    const XcdBarrier bar = xcd_barrier_post((unsigned*)(p.ws + WS_CTL), (volatile LAS unsigned*)(lds + LDS_BAR_OFF));
    run_from<0>(p, lds, (int)gridDim.x, bar);
}

extern "C" void kernel_launch(void* const* d_in, const int* in_sizes, int n_in, void* d_out, int out_size, void* d_ws, size_t ws_size, hipStream_t stream) {
    static int grid = 0;
    if (grid == 0) {
        if (n_in != 24 || in_sizes[0] != T * DM || out_size != T * DM || ws_size < WS_END) {
            fprintf(stderr, "kernel_launch: unexpected shapes: n_in %d in0 %d out %d ws %zu\n", n_in, n_in > 0 ? in_sizes[0] : -1, out_size, ws_size); grid = -1; return; }
        int dev = 0, cus = 0, per_cu = 0;
        if (hipGetDevice(&dev) != hipSuccess || hipDeviceGetAttribute(&cus, hipDeviceAttributeMultiprocessorCount, dev) != hipSuccess) { grid = -1; return; }
        if (hipFuncSetAttribute((const void*)k_mega, hipFuncAttributeMaxDynamicSharedMemorySize, LDS_BYTES) != hipSuccess) { fprintf(stderr, "kernel_launch: hipFuncSetAttribute failed\n"); grid = -1; return; }
        if (hipOccupancyMaxActiveBlocksPerMultiprocessor(&per_cu, (const void*)k_mega, NTHR, LDS_BYTES) != hipSuccess || per_cu < 1) { fprintf(stderr, "kernel_launch: occupancy query says %d blocks per CU\n", per_cu); grid = -1; return; }
        (void)hipGetLastError();
        grid = cus;
    }
    if (grid < 0) return;
    Params p{};
    const float** pp = (const float**)&p;
    for (int i = 0; i < 24; ++i) pp[i] = (const float*)d_in[i];
    p.out = (float*)d_out; p.ws = (unsigned char*)d_ws;
    if (hipMemsetAsync((char*)d_ws + WS_CTL, 0, 65536, stream) != hipSuccess) { fprintf(stderr, "kernel_launch: hipMemsetAsync failed\n"); return; }
    void* args[] = {&p};
    hipError_t e = hipLaunchCooperativeKernel((const void*)k_mega, dim3(grid), dim3(NTHR), args, LDS_BYTES, stream);
    if (e != hipSuccess) fprintf(stderr, "kernel_launch: cooperative launch failed: %s (grid %d)\n", hipGetErrorString(e), grid);
}
```

```cpp
#include <hip/hip_runtime.h>
#include <hip/hip_cooperative_groups.h>
#include <cstdio>
#include <cstdint>
#include <utility>
namespace cg = cooperative_groups;

namespace pg8 {
#define PG8_LAS __attribute__((address_space(3)))
typedef unsigned short bf16_t;
typedef short bf16x8 __attribute__((ext_vector_type(8)));
typedef float f32x4 __attribute__((ext_vector_type(4)));
typedef unsigned u32x4 __attribute__((ext_vector_type(4)));
constexpr int BM = 256, BK = 64, HALF = 128, HTB = HALF * BK * 2  , STAGE_BYTES = 8 * HTB, NXCD = 8, WGM = 8;

__host__ __device__ __forceinline__ int lds_byte(int r, int c) { const int st = (r >> 4) * 2 + (c >> 5), rr = r & 15, cc = c & 31, ob = rr * 64 + cc * 2; return st * 1024 + (ob ^ (((ob >> 9) & 1) << 5)); }
__host__ __device__ __forceinline__ void stage_rc(int b, int& R, int& C) { const int st = b / 1024, sb = b % 1024, swz = sb ^ (((sb >> 9) & 1) << 5); R = (st >> 1) * 16 + swz / 64; C = (st & 1) * 32 + (swz % 64) / 2; }
__host__ __device__ __forceinline__ int perm32(int rho) { const int n = rho >> 4, i = rho & 15; return 8 * (i >> 2) + 4 * n + (i & 3); }

struct Unit { int pm, pn; };
struct Gemm { const bf16_t* A; const bf16_t* Bt; int M, N, K, lda; };
template <int AMODE> __device__ __forceinline__ size_t a_off_bytes(const Gemm& g, const Unit& u) {
    const int ac = AMODE == 0 ? 0 : (AMODE == 1 ? 128 * (u.pn < 6 ? u.pn : 6) : 256 * u.pn);
    return ((size_t)u.pm * BM * (size_t)g.lda + (size_t)ac) * 2;
}

struct StaticOrder {
    int nM, nN, nwg, G, c;
    __host__ __device__ void init(int M, int N, int G_, int c_) { nM = M / BM; nN = N / BM; nwg = nM * nN; G = G_; c = c_; }
    __host__ __device__ bool next(int i, Unit& u) const {
        const long L = (long)i * G + c; if (L >= nwg) return false;
        int wgid = (int)L; { const int q = nwg / NXCD, r = nwg % NXCD, xcd = wgid % NXCD, off = wgid / NXCD; wgid = (xcd < r ? xcd * (q + 1) : r * (q + 1) + (xcd - r) * q) + off; }
        const int nig = WGM * nN, gid = wgid / nig, fm = gid * WGM, gsz = (nM - fm) < WGM ? (nM - fm) : WGM;
        u.pm = fm + ((wgid % nig) % gsz); u.pn = (wgid % nig) / gsz; return true;
    }
    __device__ __forceinline__ void a_ready(const Unit&) const {}
    __device__ __forceinline__ void done(const Unit&) const {}
};

__device__ __forceinline__ unsigned cvt_pk_bf16(float lo, float hi) { unsigned r; asm volatile("v_cvt_pk_bf16_f32 %0, %1, %2" : "=v"(r) : "v"(lo), "v"(hi)); return r; }

template <class Epi, class Sched, bool ALIGN_EPI = false, bool SP2 = false, int AMODE = 0, int KC = 0, int LDAC = 0>
__device__ __forceinline__ void gemm_phase(PG8_LAS unsigned char* lds, const Gemm g, const Sched& S, const Epi& E) {
    const int tid = threadIdx.x, wid = __builtin_amdgcn_readfirstlane(tid >> 6), lane = tid & 63, wr = wid >> 2, wc = wid & 3, fr = lane & 15, fq = lane >> 4;
    const int K = KC ? KC : g.K, nt = K / BK; const int lda = LDAC ? LDAC : g.lda;
    unsigned voffA[2], voffB[2];
#pragma unroll
    for (int i = 0; i < 2; ++i) { int R, C; stage_rc(tid * 16 + i * 8192, R, C); const int Rb = Epi::PERM ? ((R & ~31) + perm32(R & 31)) : R;
        voffA[i] = (unsigned)(R * lda + C) * 2u; voffB[i] = (unsigned)(Rb * K + C) * 2u; }
    const size_t kstep = (size_t)(BK * 2);
    const size_t hstepA = (size_t)HALF * lda * 2;
    const size_t hstepB = (size_t)HALF * K * 2;
    const size_t tstepB = 2 * hstepB;
    const unsigned ldsw = (unsigned)wid * 1024u;
    const int aoff = lds_byte(wr * 64 + fr, fq * 8), boff = lds_byte(wc * 32 + fr, fq * 8);
#define PG8_SA(b, h) (((b) * 2 + (h)) * HTB)
#define PG8_SB(b, h) ((4 + (b) * 2 + (h)) * HTB)
#define PG8_STAGE(bufoff, gbase, voff) do { _Pragma("unroll") for (int _i = 0; _i < 2; ++_i) \
        __builtin_amdgcn_global_load_lds((const unsigned*)((const char*)(gbase) + (voff)[_i]), (PG8_LAS unsigned*)(lds + (bufoff) + ldsw + _i * 8192), 16, 0, 0); } while (0)
#define PG8_LDA(dst, b, h) do { _Pragma("unroll") for (int m = 0; m < 4; ++m) _Pragma("unroll") for (int k = 0; k < 2; ++k) dst[m][k] = *(const PG8_LAS bf16x8*)(lds + PG8_SA(b, h) + aoff + m * 2048 + k * 1024); } while (0)
#define PG8_LDB(dst, b, h) do { _Pragma("unroll") for (int n = 0; n < 2; ++n) _Pragma("unroll") for (int k = 0; k < 2; ++k) dst[n][k] = *(const PG8_LAS bf16x8*)(lds + PG8_SB(b, h) + boff + n * 2048 + k * 1024); } while (0)
#define PG8_MMA(ai, bj, At, Bt) do { __builtin_amdgcn_s_setprio(1); _Pragma("unroll") for (int m = 0; m < 4; ++m) _Pragma("unroll") for (int n = 0; n < 2; ++n) _Pragma("unroll") for (int k = 0; k < 2; ++k) \
        acc[ai][bj][m][n] = __builtin_amdgcn_mfma_f32_16x16x32_bf16(Bt[n][k], At[m][k], acc[ai][bj][m][n], 0, 0, 0); __builtin_amdgcn_s_setprio(0); } while (0)
#define PG8_WAIT_V(n) asm volatile("s_waitcnt vmcnt(" #n ")" ::: "memory")
#define PG8_WAIT_L(n) asm volatile("s_waitcnt lgkmcnt(" #n ")" ::: "memory")
#define PG8_BAR __builtin_amdgcn_s_barrier()
#define PG8_SCHED __builtin_amdgcn_sched_barrier(0)
    Unit cur, nxt; int ui = 0;
    if (!S.next(0, cur)) return;
    f32x4 acc[2][2][4][2];
#pragma unroll
    for (int a = 0; a < 2; ++a)
#pragma unroll
        for (int b = 0; b < 2; ++b)
#pragma unroll
            for (int m = 0; m < 4; ++m)
#pragma unroll
                for (int n = 0; n < 2; ++n) acc[a][b][m][n] = (f32x4){0.f, 0.f, 0.f, 0.f};
    bf16x8 At[4][2], B0[2][2], B1[2][2];
    const char* cA = (const char*)g.A + a_off_bytes<AMODE>(g, cur); const char* cB = (const char*)g.Bt + (size_t)cur.pn * tstepB;
    S.a_ready(cur);
    if constexpr (SP2) {
        PG8_STAGE(PG8_SB(0, 0), cB, voffB); PG8_STAGE(PG8_SB(0, 1), cB + hstepB, voffB); PG8_STAGE(PG8_SA(0, 0), cA, voffA); PG8_STAGE(PG8_SA(0, 1), cA + hstepA, voffA);
        if (wr == 1) PG8_BAR;
        PG8_WAIT_V(2); PG8_BAR;
        PG8_STAGE(PG8_SB(1, 0), cB + kstep, voffB); PG8_STAGE(PG8_SA(1, 0), cA + kstep, voffA); PG8_STAGE(PG8_SB(1, 1), cB + hstepB + kstep, voffB);
        PG8_WAIT_V(6); PG8_BAR;
    } else {
        PG8_STAGE(PG8_SB(0, 0), cB, voffB); PG8_STAGE(PG8_SA(0, 0), cA, voffA); PG8_STAGE(PG8_SB(0, 1), cB + hstepB, voffB); PG8_STAGE(PG8_SA(0, 1), cA + hstepA, voffA);
        if (wr == 1) PG8_BAR;
        PG8_WAIT_V(4); PG8_BAR;
        PG8_STAGE(PG8_SB(1, 0), cB + kstep, voffB); PG8_STAGE(PG8_SA(1, 0), cA + kstep, voffA); PG8_STAGE(PG8_SB(1, 1), cB + hstepB + kstep, voffB);
        PG8_WAIT_V(6); PG8_BAR;
    }
    for (;;) {
        const bool has_next = S.next(ui + 1, nxt);
        const char* nA = has_next ? (const char*)g.A + a_off_bytes<AMODE>(g, nxt) : cA; const char* nB = has_next ? (const char*)g.Bt + (size_t)nxt.pn * tstepB : cB;
#pragma unroll 1
        for (int t = 0; t < nt; t += 2) {
            const bool last = (t == nt - 2);
            const char* a1 = cA + (size_t)(t + 1) * kstep;
            const char* a2 = last ? nA : cA + (size_t)(t + 2) * kstep; const char* b2 = last ? nB : cB + (size_t)(t + 2) * kstep;
            const char* a3 = a2 + kstep; const char* b3 = b2 + kstep;
            if (last && has_next) S.a_ready(nxt);
            if constexpr (SP2) {
            PG8_LDB(B0, 0, 0); PG8_LDB(B1, 0, 1); PG8_SCHED; PG8_LDA(At, 0, 0); PG8_STAGE(PG8_SA(1, 1), a1 + hstepA, voffA);
            PG8_WAIT_V(8); PG8_WAIT_L(0); PG8_BAR; PG8_MMA(0, 0, At, B0); PG8_MMA(0, 1, At, B1); PG8_BAR; PG8_SCHED;
            PG8_LDA(At, 0, 1); PG8_STAGE(PG8_SB(0, 0), b2, voffB); PG8_STAGE(PG8_SB(0, 1), b2 + hstepB, voffB); PG8_STAGE(PG8_SA(0, 0), a2, voffA);
            PG8_WAIT_V(8); PG8_WAIT_L(0); PG8_BAR; PG8_MMA(1, 0, At, B0); PG8_MMA(1, 1, At, B1); PG8_BAR; PG8_SCHED;
            PG8_LDB(B0, 1, 0); PG8_LDB(B1, 1, 1); PG8_SCHED; PG8_LDA(At, 1, 0); PG8_STAGE(PG8_SA(0, 1), a2 + hstepA, voffA);
            PG8_WAIT_V(8); PG8_WAIT_L(0); PG8_BAR; PG8_MMA(0, 0, At, B0); PG8_MMA(0, 1, At, B1); PG8_BAR; PG8_SCHED;
            PG8_LDA(At, 1, 1); PG8_STAGE(PG8_SB(1, 0), b3, voffB); PG8_STAGE(PG8_SB(1, 1), b3 + hstepB, voffB); PG8_STAGE(PG8_SA(1, 0), a3, voffA);
            PG8_WAIT_V(8); PG8_WAIT_L(0); PG8_BAR; PG8_MMA(1, 0, At, B0); PG8_MMA(1, 1, At, B1); PG8_BAR; PG8_SCHED;
            } else {
            PG8_LDB(B0, 0, 0); PG8_SCHED; PG8_LDA(At, 0, 0); PG8_STAGE(PG8_SA(1, 1), a1 + hstepA, voffA);
            PG8_WAIT_L(8); PG8_BAR; PG8_WAIT_L(0); PG8_MMA(0, 0, At, B0); PG8_BAR; PG8_SCHED;
            PG8_LDB(B1, 0, 1); PG8_STAGE(PG8_SB(0, 0), b2, voffB);
            PG8_BAR; PG8_WAIT_L(0); PG8_MMA(0, 1, At, B1); PG8_BAR;
            PG8_LDA(At, 0, 1); PG8_STAGE(PG8_SA(0, 0), a2, voffA);
            PG8_BAR; PG8_WAIT_L(0); PG8_MMA(1, 0, At, B0); PG8_BAR; PG8_SCHED;
            PG8_STAGE(PG8_SB(0, 1), b2 + hstepB, voffB);
            PG8_WAIT_V(6); PG8_BAR; PG8_MMA(1, 1, At, B1); PG8_BAR;
            PG8_LDB(B0, 1, 0); PG8_SCHED; PG8_LDA(At, 1, 0); PG8_STAGE(PG8_SA(0, 1), a2 + hstepA, voffA);
            PG8_WAIT_L(8); PG8_BAR; PG8_WAIT_L(0); PG8_MMA(0, 0, At, B0); PG8_BAR; PG8_SCHED;
            PG8_LDB(B1, 1, 1); PG8_STAGE(PG8_SB(1, 0), b3, voffB);
            PG8_BAR; PG8_WAIT_L(0); PG8_MMA(0, 1, At, B1); PG8_BAR;
            PG8_LDA(At, 1, 1); PG8_STAGE(PG8_SA(1, 0), a3, voffA);
            PG8_BAR; PG8_WAIT_L(0); PG8_MMA(1, 0, At, B0); PG8_BAR; PG8_SCHED;
            PG8_STAGE(PG8_SB(1, 1), b3 + hstepB, voffB);
            PG8_WAIT_V(6); PG8_BAR; PG8_MMA(1, 1, At, B1); PG8_BAR;
            }
        }
        if constexpr (ALIGN_EPI) { if (wr == 0) PG8_BAR; }
        E(acc, cur, wr, wc, fr, fq); S.done(cur);
        if (!has_next) break;
#pragma unroll
        for (int a = 0; a < 2; ++a)
#pragma unroll
            for (int b = 0; b < 2; ++b)
#pragma unroll
                for (int m = 0; m < 4; ++m)
#pragma unroll
                    for (int n = 0; n < 2; ++n) acc[a][b][m][n] = (f32x4){0.f, 0.f, 0.f, 0.f};
        cur = nxt; cA = nA; cB = nB; ++ui;
        if constexpr (ALIGN_EPI) { if (wr == 1) PG8_BAR; }
    }
    PG8_WAIT_V(0);
    if constexpr (!ALIGN_EPI) { if (wr == 0) PG8_BAR; }
    PG8_BAR;
#undef PG8_SA
#undef PG8_SB
#undef PG8_STAGE
#undef PG8_LDA
#undef PG8_LDB
#undef PG8_MMA
#undef PG8_WAIT_V
#undef PG8_WAIT_L
#undef PG8_BAR
#undef PG8_SCHED
}
}

constexpr int NB = 8, SEQ = 8192, DM = 1024, T = NB * SEQ;
constexpr int NPAD = 7424;
constexpr int NWAVES = 8, NTHR = 512;
constexpr int LDS_BYTES = 147456;
constexpr int N_PHASES = 12;
#define PROBE_PH -1
#define PROBE_MULT 3

constexpr size_t MiB = 1ull << 20;
constexpr size_t WS_CTL = 0;
constexpr size_t WS_MODP = 1 * MiB;
constexpr size_t WS_WIN = 3 * MiB;
constexpr size_t WS_WOUT = 18 * MiB;
constexpr size_t WS_WQ = 20 * MiB;
constexpr size_t WS_LRUB = 24 * MiB;
constexpr size_t WS_SUBK = 25 * MiB;
constexpr size_t WS_LRUC = 26 * MiB;
constexpr size_t WS_U = 32 * MiB;
constexpr size_t WS_V = 48 * MiB;
constexpr size_t WS_SU = 64 * MiB;
constexpr size_t WS_SV = 65 * MiB;
constexpr size_t WS_SS = 30 * MiB;
constexpr size_t WS_DK = 66 * MiB;
constexpr size_t WS_QKV = 96 * MiB;
constexpr size_t WS_R = 352 * MiB;
constexpr size_t WS_XLXG = 480 * MiB;
constexpr size_t WS_GAGB = 736 * MiB;
constexpr size_t WS_ALOW = 992 * MiB;
constexpr size_t WS_END = 994 * MiB;
constexpr size_t WS_Y = WS_QKV;
constexpr size_t WS_H2 = WS_QKV + 128 * MiB;
constexpr size_t WS_QRY = WS_XLXG;
constexpr size_t WS_SC = WS_GAGB;
constexpr size_t WS_TOPK = WS_R;
constexpr size_t WS_TOPK2 = WS_R + 32 * MiB;

#define LAS __attribute__((address_space(3)))
typedef unsigned short bf16;
typedef float f32x4 __attribute__((ext_vector_type(4)));
typedef float f32x2 __attribute__((ext_vector_type(2)));
typedef unsigned u32x4 __attribute__((ext_vector_type(4)));
typedef unsigned u32x2 __attribute__((ext_vector_type(2)));

struct Params {
    const float *x, *c, *w_ada, *b_ada, *npm, *npo, *w_in, *w_alpha, *b_alpha, *gla_norm, *conv_w, *conv_b,
        *lwa, *lba, *lwx, *lbx, *lam, *w_out, *npf, *npof, *wq, *subk, *pu, *pv;
    float* out; unsigned char* ws;
    int ph_lo, ph_hi;
};

__device__ __forceinline__ unsigned f2bf(float f) { unsigned u = __builtin_bit_cast(unsigned, f); return (u + 0x7fffu + ((u >> 16) & 1u)) >> 16; }
__device__ __forceinline__ unsigned pk2(float lo, float hi) { return f2bf(lo) | (f2bf(hi) << 16); }
__device__ __forceinline__ float bflo(unsigned u) { return __builtin_bit_cast(float, u << 16); }
__device__ __forceinline__ float bfhi(unsigned u) { return __builtin_bit_cast(float, u & 0xffff0000u); }
__device__ __forceinline__ float bf2f(bf16 h) { return __builtin_bit_cast(float, (unsigned)h << 16); }
__device__ __forceinline__ float sigmoid_f(float x) { return __builtin_amdgcn_rcpf(1.f + __expf(-x)); }
__device__ __forceinline__ float silu_f(float x) { return x * __builtin_amdgcn_rcpf(1.f + __expf(-x)); }
__device__ __forceinline__ float gelu_f(float x) { const float u = 0.7978845608028654f * (x + 0.044715f * x * x * x); return x * __builtin_amdgcn_rcpf(1.f + __expf(-2.f * u)); }
__device__ __forceinline__ float softplus_f(float x) { return fmaxf(x, 0.f) + log1pf(__expf(-fabsf(x))); }
__device__ __forceinline__ float wave_sum(float v) {
#pragma unroll
    for (int o = 1; o < 64; o <<= 1) v += __shfl_xor(v, o);
    return v;
}
#define LDS_WAIT() asm volatile("s_waitcnt lgkmcnt(0)" ::: "memory")

struct EpiSeg {
    static constexpr bool PERM = true;
    unsigned char* ws;
    __device__ __forceinline__ void operator()(const pg8::f32x4 (&acc)[2][2][4][2], const pg8::Unit& u, int wr, int wc, int fr, int fq) const {
        const int pn = u.pn; bf16* base; int ldc, colt;
        if (pn < 8) { base = (bf16*)(ws + WS_QKV); ldc = 2048; colt = pn * 256; }
        else if (pn < 12) { base = (bf16*)(ws + WS_R); ldc = 1024; colt = (pn - 8) * 256; }
        else if (pn < 20) { base = (bf16*)(ws + WS_XLXG); ldc = 2048; colt = (pn - 12) * 256; }
        else if (pn < 28) { base = (bf16*)(ws + WS_GAGB); ldc = 2048; colt = (pn - 20) * 256; }
        else { base = (bf16*)(ws + WS_ALOW); ldc = 16; colt = 0; }
        const int row0 = u.pm * 256 + wr * 64 + fr, col0 = colt + wc * 32 + 8 * fq;
        const bool tail = (pn == 28);
#pragma unroll
        for (int ai = 0; ai < 2; ++ai)
#pragma unroll
            for (int m = 0; m < 4; ++m) { bf16* rowp = base + (size_t)(row0 + ai * 128 + m * 16) * ldc + col0;
#pragma unroll
                for (int bj = 0; bj < 2; ++bj) { const pg8::f32x4 v0 = acc[ai][bj][m][0], v1 = acc[ai][bj][m][1];
                    u32x4 w; w.x = pg8::cvt_pk_bf16(v0[0], v0[1]); w.y = pg8::cvt_pk_bf16(v0[2], v0[3]); w.z = pg8::cvt_pk_bf16(v1[0], v1[1]); w.w = pg8::cvt_pk_bf16(v1[2], v1[3]);
                    if (!tail || (bj == 0 && wc == 0 && fq < 2)) *(u32x4*)(rowp + bj * 128) = w; } }
    }
};
struct EpiPlain {
    static constexpr bool PERM = true;
    bf16* O; int ldc;
    __device__ __forceinline__ void operator()(const pg8::f32x4 (&acc)[2][2][4][2], const pg8::Unit& u, int wr, int wc, int fr, int fq) const {
        const int row0 = u.pm * 256 + wr * 64 + fr, col0 = u.pn * 256 + wc * 32 + 8 * fq;
#pragma unroll
        for (int ai = 0; ai < 2; ++ai)
#pragma unroll
            for (int m = 0; m < 4; ++m) { bf16* rowp = O + (size_t)(row0 + ai * 128 + m * 16) * ldc + col0;
#pragma unroll
                for (int bj = 0; bj < 2; ++bj) { const pg8::f32x4 v0 = acc[ai][bj][m][0], v1 = acc[ai][bj][m][1];
                    u32x4 w; w.x = pg8::cvt_pk_bf16(v0[0], v0[1]); w.y = pg8::cvt_pk_bf16(v0[2], v0[3]); w.z = pg8::cvt_pk_bf16(v1[0], v1[1]); w.w = pg8::cvt_pk_bf16(v1[2], v1[3]);
                    *(u32x4*)(rowp + bj * 128) = w; } }
    }
};
typedef _Float16 h16x2 __attribute__((ext_vector_type(2)));
__device__ __forceinline__ unsigned pkh(float a, float b) { return __builtin_bit_cast(unsigned, __builtin_amdgcn_cvt_pkrtz(a, b)); }
struct EpiF16 {
    static constexpr bool PERM = true;
    unsigned short* O; int ldc;
    __device__ __forceinline__ void operator()(const pg8::f32x4 (&acc)[2][2][4][2], const pg8::Unit& u, int wr, int wc, int fr, int fq) const {
        const int row0 = u.pm * 256 + wr * 64 + fr, col0 = u.pn * 256 + wc * 32 + 8 * fq;
#pragma unroll
        for (int ai = 0; ai < 2; ++ai)
#pragma unroll
            for (int m = 0; m < 4; ++m) { unsigned short* rowp = O + (size_t)(row0 + ai * 128 + m * 16) * ldc + col0;
#pragma unroll
                for (int bj = 0; bj < 2; ++bj) { const pg8::f32x4 v0 = acc[ai][bj][m][0], v1 = acc[ai][bj][m][1];
                    u32x4 w; w.x = pkh(v0[0], v0[1]); w.y = pkh(v0[2], v0[3]); w.z = pkh(v1[0], v1[1]); w.w = pkh(v1[2], v1[3]);
                    *(u32x4*)(rowp + bj * 128) = w; } }
    }
};
__device__ __forceinline__ void p0_transpose_item(const float* W, int ldw, int k0, int n0, int nvalid, bf16* WT, int ldk, int row0, int kc0, LAS float* scr, int lane) {
#pragma unroll 8
    for (int i = 0; i < 32; ++i) { const int kk = 2 * i + (lane >> 5), cc = lane & 31; scr[kk * 33 + cc] = (cc < nvalid) ? W[(size_t)(k0 + kk) * ldw + n0 + cc] : 0.f; }
    LDS_WAIT(); asm volatile("" ::: "memory");
    const int c = lane & 7;
#pragma unroll
    for (int j = 0; j < 4; ++j) { const int n = (lane >> 3) + 8 * j; const LAS float* s = scr + (8 * c) * 33 + n;
        u32x4 o; o.x = pk2(s[0 * 33], s[1 * 33]); o.y = pk2(s[2 * 33], s[3 * 33]); o.z = pk2(s[4 * 33], s[5 * 33]); o.w = pk2(s[6 * 33], s[7 * 33]);
        *(u32x4*)(WT + (size_t)(row0 + n) * ldk + kc0 + k0 + 8 * c) = o; }
    LDS_WAIT(); asm volatile("" ::: "memory");
}
__device__ __forceinline__ void phase0(const Params& p, LAS unsigned char* lds, int G) {
    const int tid = threadIdx.x, lane = tid & 63, wave = __builtin_amdgcn_readfirstlane(tid >> 6);
    unsigned char* ws = p.ws;
    {
        LAS float* sc = (LAS float*)lds;
        LAS float* red = (LAS float*)(lds + 4096);
        float* modp = (float*)(ws + WS_MODP);
        for (int it = blockIdx.x; it < 24 * 8; it += G) {
            const int nb = it % 24, kc = it / 24;
            for (int i = tid; i < 1024; i += NTHR) { const int b = i >> 7, k = i & 127; sc[i] = silu_f(p.c[b * 1024 + kc * 128 + k]); }
            __syncthreads();
            const int col = tid & 255, kh = tid >> 8;
            float acc[8];
#pragma unroll
            for (int b = 0; b < 8; ++b) acc[b] = 0.f;
            const float* wp = p.w_ada + (size_t)(kc * 128 + kh * 64) * 6144 + nb * 256 + col;
#pragma unroll 8
            for (int kk = 0; kk < 64; ++kk) { const float w = wp[(size_t)kk * 6144];
#pragma unroll
                for (int b = 0; b < 8; ++b) acc[b] += sc[b * 128 + kh * 64 + kk] * w; }
            if (kh == 1) {
#pragma unroll
                for (int b = 0; b < 8; ++b) red[b * 256 + col] = acc[b]; }
            __syncthreads();
            if (kh == 0) { const int n = nb * 256 + col; const float bias = (kc == 0) ? p.b_ada[n] : 0.f;
#pragma unroll
                for (int b = 0; b < 8; ++b) modp[(size_t)(kc * 8 + b) * 6144 + n] = acc[b] + red[b * 256 + col] + bias; }
            __syncthreads();
        }
    }
    for (int i = blockIdx.x * NTHR + tid; i < T * 4 / 4; i += G * NTHR) ((f32x4*)(ws + WS_SS))[i] = (f32x4){0.f, 0.f, 0.f, 0.f};
    LAS float* scr = (LAS float*)(lds + 16384 + wave * 8448);
    const int gw = blockIdx.x * NWAVES + wave, NGW = G * NWAVES;
    bf16* WinT = (bf16*)(ws + WS_WIN); bf16* WoutT = (bf16*)(ws + WS_WOUT); bf16* WqT = (bf16*)(ws + WS_WQ);
    bf16* LruB = (bf16*)(ws + WS_LRUB); bf16* SubK = (bf16*)(ws + WS_SUBK);
    constexpr int I_IN = 16 * (NPAD / 32), I_OUT = 16 * 32, I_Q = 16 * 64, I_LRU = 16 * 8, I_SUB = 2048, I_TAB = 2 * 16384;
    constexpr int NIT = I_IN + I_OUT + I_Q + I_LRU + I_SUB + I_TAB;
    for (int it = gw; it < NIT; it += NGW) {
        int r = it;
        if (r < I_IN) { const int nb = r % (NPAD / 32), kb = r / (NPAD / 32), nq = nb * 32; int n0, nv;
            if (nq < 3072) { n0 = nq; nv = 32; } else if (nq < 7168) { n0 = nq + 16; nv = 32; } else if (nq == 7168) { n0 = 3072; nv = 16; } else { n0 = 0; nv = 0; }
            p0_transpose_item(p.w_in, 7184, kb * 64, n0, nv, WinT, 1024, nq, 0, scr, lane); continue; } r -= I_IN;
        if (r < I_OUT) { const int nb = r % 32, kb = r / 32; p0_transpose_item(p.w_out, 1024, kb * 64, nb * 32, 32, WoutT, 1024, nb * 32, 0, scr, lane); continue; } r -= I_OUT;
        if (r < I_Q) { const int nb = r % 64, kb = r / 64; p0_transpose_item(p.wq, 2048, kb * 64, nb * 32, 32, WqT, 1024, nb * 32, 0, scr, lane); continue; } r -= I_Q;
        if (r < I_LRU) {
            const int mat = r >> 3, sub = r & 7, g = mat >> 3, n = mat & 7, kb = sub >> 2, nb = sub & 3;
            const int np = n < 6 ? n : 6, half = n - np;
            const float* W = (g ? p.lwx : p.lwa) + (size_t)n * 128 * 128;
            bf16* dst = LruB + (size_t)n * 256 * 256;
            p0_transpose_item(W, 128, kb * 64, nb * 32, 32, dst, 256, g * 128 + nb * 32, half * 128, scr, lane);
            p0_transpose_item(W, 128, kb * 64, 0, 0, dst, 256, g * 128 + nb * 32, (1 - half) * 128, scr, lane);
            continue; } r -= I_LRU;
        if (r < I_SUB) {
            const int h = r >> 8, pp = (r >> 7) & 1, n = r & 127;
            const float* src = p.subk + (size_t)r * 128; bf16* dst = SubK + ((size_t)h * 256 + pp * 128 + n) * 256;
            const f32x2 v = *(const f32x2*)(src + 2 * lane);
            *(unsigned*)(dst + pp * 128 + 2 * lane) = pk2(v.x, v.y);
            *(unsigned*)(dst + (1 - pp) * 128 + 2 * lane) = 0u;
            continue; } r -= I_SUB;
        {
            const int tb = r >> 14, row = r & 16383;
            const float* src = (tb ? p.pv : p.pu) + (size_t)row * 1024 + lane * 16;
            f32x4 v[4]; float am = 0.f;
#pragma unroll
            for (int j = 0; j < 4; ++j) { v[j] = *(const f32x4*)(src + 4 * j); am = fmaxf(am, fmaxf(fmaxf(fabsf(v[j].x), fabsf(v[j].y)), fmaxf(fabsf(v[j].z), fabsf(v[j].w)))); }
#pragma unroll
            for (int o = 1; o < 64; o <<= 1) am = fmaxf(am, __shfl_xor(am, o));
            const float inv = am > 0.f ? 7.5f / am : 0.f;
            unsigned long long lo = 0ull; unsigned hi = 0u;
#pragma unroll
            for (int j = 0; j < 16; ++j) { const float x = v[j >> 2][j & 3] * inv, a = fabsf(x);
                unsigned code = a < 1.f ? (unsigned)__builtin_rintf(a * 8.f) : (a < 2.f ? 8u + (unsigned)__builtin_rintf((a - 1.f) * 8.f) : (a < 4.f ? 16u + (unsigned)__builtin_rintf((a - 2.f) * 4.f) : 24u + (unsigned)__builtin_rintf((a - 4.f) * 2.f)));
                code = code > 31u ? 31u : code; code |= (x < 0.f) ? 32u : 0u;
                const int bit = 6 * j;
                if (bit + 6 <= 64) lo |= (unsigned long long)code << bit;
                else if (bit >= 64) hi |= code << (bit - 64);
                else { lo |= (unsigned long long)code << bit; hi |= code >> (64 - bit); } }
            unsigned* dst = (unsigned*)(ws + (tb ? WS_V : WS_U) + (size_t)row * 768 + lane * 12);
            dst[0] = (unsigned)lo; dst[1] = (unsigned)(lo >> 32); dst[2] = hi;
            if (lane == 0) ((float*)(ws + (tb ? WS_SV : WS_SU)))[row] = am * (1.f / 7.5f);
        }
    }
}

__device__ __forceinline__ float mod_at(const float* modp, int b, int n) {
    float s = 0.f;
#pragma unroll
    for (int kc = 0; kc < 8; ++kc) s += modp[(size_t)(kc * 8 + b) * 6144 + n];
    return s;
}

__device__ __forceinline__ void phase1(const Params& p, LAS unsigned char* lds, int G) {
    const int tid = threadIdx.x, lane = tid & 63, wave = __builtin_amdgcn_readfirstlane(tid >> 6);
    const float* modp = (const float*)(p.ws + WS_MODP);
    LAS float* gs = (LAS float*)lds; LAS float* sh = gs + 1024;
    bf16* H = (bf16*)p.out;
    for (int tile = blockIdx.x; tile < T / 256; tile += G) {
        const int b = tile / 32;
        __syncthreads();
        for (int k = tid; k < 1024; k += NTHR) { gs[k] = p.npm[k] * (1.f + mod_at(modp, b, 1024 + k)); sh[k] = mod_at(modp, b, k); }
        __syncthreads();
        for (int rr = 0; rr < 32; ++rr) {
            const size_t row = (size_t)tile * 256 + wave * 32 + rr;
            const f32x4* xr = (const f32x4*)(p.x + row * 1024) + lane;
            f32x4 v[4]; float s = 0.f;
#pragma unroll
            for (int j = 0; j < 4; ++j) { v[j] = xr[64 * j]; s += (v[j].x * v[j].x + v[j].y * v[j].y) + (v[j].z * v[j].z + v[j].w * v[j].w); }
            const float rstd = __builtin_amdgcn_rsqf(wave_sum(s) * (1.f / 1024.f) + 1e-6f);
            u32x2* o8 = (u32x2*)(H + row * 1024) + lane;
#pragma unroll
            for (int j = 0; j < 4; ++j) { const int k = 256 * j + 4 * lane; const f32x4 g4 = *(const LAS f32x4*)(gs + k), s4 = *(const LAS f32x4*)(sh + k);
                u32x2 w; w.x = pk2(v[j].x * rstd * g4.x + s4.x, v[j].y * rstd * g4.y + s4.y); w.y = pk2(v[j].z * rstd * g4.z + s4.z, v[j].w * rstd * g4.w + s4.w);
                o8[64 * j] = w; }
        }
    }
}

typedef short bf16x8_t __attribute__((ext_vector_type(8)));
template <bool FINAL>
__device__ __forceinline__ void phase_lru(const Params& p, LAS unsigned char* lds, int G) {
    const int tid = threadIdx.x, lane = tid & 63, wave = __builtin_amdgcn_readfirstlane(tid >> 6), q4 = lane >> 4, c16 = lane & 15;
    constexpr int PQ = 136;
    LAS bf16* XC = (LAS bf16*)lds;
    LAS bf16* HB = XC + 64 * PQ;
    LAS float* CW = (LAS float*)(HB + 64 * PQ);
    const bf16* XL = (const bf16*)(p.ws + WS_XLXG); const bf16* LruB = (const bf16*)(p.ws + WS_LRUB);
    const bf16* XG = (const bf16*)(p.ws + WS_XLXG) + 1024; const bf16* GB = (const bf16*)(p.ws + WS_GAGB) + 1024; bf16* GA = (bf16*)(p.ws + WS_GAGB);
    const bf16* O = (const bf16*)(p.ws + WS_QKV) + 1024; const bf16* R = (const bf16*)(p.ws + WS_R); const float* SS = (const float*)(p.ws + WS_SS);
    f32x2* CAR = (f32x2*)(p.ws + WS_LRUC);
    const int c8 = tid & 15, tr = tid >> 4;
    for (int it = blockIdx.x; it < 8 * 8 * 4; it += G) {
        const int sg = it & 3, n = (it >> 2) & 7, b = it >> 5;
        const int chc = n * 128 + c8 * 8;
        const int chm = n * 128 + wave * 16 + c16;
        __syncthreads();
        for (int i = tid; i < 768; i += NTHR) { const int q = i >> 7, c = i & 127; CW[i] = q < 4 ? p.conv_w[q * 1024 + n * 128 + c] : (q == 4 ? p.conv_b[n * 128 + c] : p.gla_norm[n * 128 + c]); }
        const float ba = p.lba[chm], bx = p.lbx[chm], sp = -8.f * softplus_f(-p.lam[chm]);
        bf16x8_t wf[2][4];
        { const int np = n < 6 ? n : 6, half = n - np;
#pragma unroll
          for (int g = 0; g < 2; ++g)
#pragma unroll
              for (int ks = 0; ks < 4; ++ks) wf[g][ks] = *(const bf16x8_t*)(LruB + (size_t)n * 65536 + (size_t)(g * 128 + wave * 16 + c16) * 256 + half * 128 + ks * 32 + q4 * 8); }
        float hc = 0.f, aseg = 1.f;
        if (FINAL) { for (int s = 0; s < sg; ++s) { const f32x2 c = CAR[(size_t)((b * 8 + n) * 4 + s) * 128 + wave * 16 + c16]; hc = c.x * hc + c.y; } }
        const size_t tseg = (size_t)b * SEQ + sg * 2048;
        u32x4 xr[5];
#define LRU_LOADX(t0_) do { _Pragma("unroll") for (int _k = 0; _k < 5; ++_k) { const long _t = (long)(t0_) + 2 * tr + _k - 3; \
            xr[_k] = (_t < (long)b * SEQ) ? (u32x4){0u, 0u, 0u, 0u} : *(const u32x4*)(XL + (size_t)_t * 2048 + chc); } } while (0)
        LRU_LOADX(tseg);
        __syncthreads();
#pragma unroll 1
        for (int tl = 0; tl < 32; ++tl) {
            const size_t t0 = tseg + tl * 64;
            { float xv[5][8];
#pragma unroll
              for (int k = 0; k < 5; ++k) { xv[k][0] = bflo(xr[k].x); xv[k][1] = bfhi(xr[k].x); xv[k][2] = bflo(xr[k].y); xv[k][3] = bfhi(xr[k].y); xv[k][4] = bflo(xr[k].z); xv[k][5] = bfhi(xr[k].z); xv[k][6] = bflo(xr[k].w); xv[k][7] = bfhi(xr[k].w); }
              float cw[5][8];
#pragma unroll
              for (int q = 0; q < 5; ++q) { const f32x4 w0 = *(const LAS f32x4*)(CW + q * 128 + c8 * 8), w1 = *(const LAS f32x4*)(CW + q * 128 + c8 * 8 + 4);
                  cw[q][0] = w0.x; cw[q][1] = w0.y; cw[q][2] = w0.z; cw[q][3] = w0.w; cw[q][4] = w1.x; cw[q][5] = w1.y; cw[q][6] = w1.z; cw[q][7] = w1.w; }
#pragma unroll
              for (int i2 = 0; i2 < 2; ++i2) { float o[8];
#pragma unroll
                  for (int j = 0; j < 8; ++j) o[j] = cw[4][j] + cw[0][j] * xv[i2][j] + cw[1][j] * xv[i2 + 1][j] + cw[2][j] * xv[i2 + 2][j] + cw[3][j] * xv[i2 + 3][j];
                  *(LAS u32x4*)(XC + (2 * tr + i2) * PQ + c8 * 8) = (u32x4){pk2(o[0], o[1]), pk2(o[2], o[3]), pk2(o[4], o[5]), pk2(o[6], o[7])}; } }
            u32x4 mxg[2], mgb[2], mo[2], mr[2], mga[2]; float mss[2];
            if (FINAL) {
#pragma unroll
                for (int i2 = 0; i2 < 2; ++i2) { const size_t t = t0 + 2 * tr + i2;
                    mxg[i2] = *(const u32x4*)(XG + t * 2048 + chc); mgb[i2] = *(const u32x4*)(GB + t * 2048 + chc); mo[i2] = *(const u32x4*)(O + t * 2048 + chc);
                    mr[i2] = *(const u32x4*)(R + t * 1024 + chc); mga[i2] = *(const u32x4*)(GA + t * 2048 + chc); mss[i2] = SS[t * 4 + (chc >> 8)]; } }
            if (tl + 1 < 32) LRU_LOADX(t0 + 64);
            __syncthreads();
            pg8::f32x4 acc[4][2];
#pragma unroll
            for (int tt = 0; tt < 4; ++tt) { acc[tt][0] = (pg8::f32x4){0.f, 0.f, 0.f, 0.f}; acc[tt][1] = (pg8::f32x4){0.f, 0.f, 0.f, 0.f}; }
#pragma unroll
            for (int ks = 0; ks < 4; ++ks)
#pragma unroll
                for (int tt = 0; tt < 4; ++tt) { const bf16x8_t a = *(const LAS bf16x8_t*)(XC + (tt * 16 + c16) * PQ + ks * 32 + q4 * 8);
                    acc[tt][0] = __builtin_amdgcn_mfma_f32_16x16x32_bf16(a, wf[0][ks], acc[tt][0], 0, 0, 0);
                    acc[tt][1] = __builtin_amdgcn_mfma_f32_16x16x32_bf16(a, wf[1][ks], acc[tt][1], 0, 0, 0); }
#pragma unroll
            for (int tt = 0; tt < 4; ++tt) {
                float av[4], uv[4];
#pragma unroll
                for (int j = 0; j < 4; ++j) { const float xc = bf2f(XC[(tt * 16 + q4 * 4 + j) * PQ + wave * 16 + c16]);
                    const float gr = sigmoid_f(acc[tt][0][j] + ba), gi = sigmoid_f(acc[tt][1][j] + bx);
                    const float a = __expf(sp * gr); av[j] = a; uv[j] = __builtin_amdgcn_sqrtf(fmaxf(1.f - a * a, 0.f)) * gi * xc; }
                float A4 = av[0], H4 = uv[0];
#pragma unroll
                for (int j = 1; j < 4; ++j) { H4 = av[j] * H4 + uv[j]; A4 *= av[j]; }
                float Ai = A4, Hi = H4;
                { const float Ap = __shfl_up(Ai, 16), Hp = __shfl_up(Hi, 16); if (q4 >= 1) { Hi = Hp * Ai + Hi; Ai = Ap * Ai; } }
                { const float Ap = __shfl_up(Ai, 32), Hp = __shfl_up(Hi, 32); if (q4 >= 2) { Hi = Hp * Ai + Hi; Ai = Ap * Ai; } }
                float Ae = __shfl_up(Ai, 16), He = __shfl_up(Hi, 16); if (q4 == 0) { Ae = 1.f; He = 0.f; }
                float h = hc * Ae + He;
                const float At = __shfl(Ai, 48 + c16), Ht = __shfl(Hi, 48 + c16);
                if (FINAL) {
#pragma unroll
                    for (int j = 0; j < 4; ++j) { h = av[j] * h + uv[j]; HB[(tt * 16 + q4 * 4 + j) * PQ + wave * 16 + c16] = (bf16)f2bf(h); } }
                hc = hc * At + Ht; aseg *= At;
            }
            __syncthreads();
            if (FINAL) {
#pragma unroll
                for (int i2 = 0; i2 < 2; ++i2) { const size_t t = t0 + 2 * tr + i2;
                    const u32x4 hw = *(const LAS u32x4*)(HB + (2 * tr + i2) * PQ + c8 * 8);
                    const float rstd = __builtin_amdgcn_rsqf(mss[i2] * (1.f / 256.f) + 1e-6f);
                    const unsigned hwv[4] = {hw.x, hw.y, hw.z, hw.w}, xgv[4] = {mxg[i2].x, mxg[i2].y, mxg[i2].z, mxg[i2].w}, gbv[4] = {mgb[i2].x, mgb[i2].y, mgb[i2].z, mgb[i2].w};
                    const unsigned ov[4] = {mo[i2].x, mo[i2].y, mo[i2].z, mo[i2].w}, rv[4] = {mr[i2].x, mr[i2].y, mr[i2].z, mr[i2].w}, gav[4] = {mga[i2].x, mga[i2].y, mga[i2].z, mga[i2].w};
                    unsigned ow[4];
                    const f32x4 g0 = *(const LAS f32x4*)(CW + 640 + c8 * 8), g1 = *(const LAS f32x4*)(CW + 640 + c8 * 8 + 4);
                    const float gn[8] = {g0.x, g0.y, g0.z, g0.w, g1.x, g1.y, g1.z, g1.w};
#pragma unroll
                    for (int q = 0; q < 4; ++q) {
                        const float m0 = sigmoid_f(bflo(gav[q])) * (bflo(ov[q]) * rstd * gn[2 * q] * silu_f(bflo(rv[q]))) + sigmoid_f(bflo(gbv[q])) * (bflo(hwv[q]) * gelu_f(bflo(xgv[q])));
                        const float m1 = sigmoid_f(bfhi(gav[q])) * (bfhi(ov[q]) * rstd * gn[2 * q + 1] * silu_f(bfhi(rv[q]))) + sigmoid_f(bfhi(gbv[q])) * (bfhi(hwv[q]) * gelu_f(bfhi(xgv[q])));
                        ow[q] = pk2(m0, m1); }
                    *(u32x4*)(GA + t * 2048 + chc) = (u32x4){ow[0], ow[1], ow[2], ow[3]}; }
            }
        }
#undef LRU_LOADX
        if (!FINAL) { if (q4 == 0) CAR[(size_t)((b * 8 + n) * 4 + sg) * 128 + wave * 16 + c16] = (f32x2){aseg, hc}; }
        __syncthreads();
    }
}

__device__ __forceinline__ void phase_gla_prep(const Params& p, LAS unsigned char* lds, int G) {
    const int tid = threadIdx.x;
    LAS float* segt = (LAS float*)lds;
    bf16* QKV = (bf16*)(p.ws + WS_QKV); const bf16* AL = (const bf16*)(p.ws + WS_ALOW); float* DK = (float*)(p.ws + WS_DK);
    const int kp = tid & 127, seg = tid >> 7;
    for (int it = blockIdx.x; it < 8 * 128 * 4; it += G) {
        const int h = it & 3, ch = (it >> 2) & 127, b = it >> 9;
        float wa[16];
#pragma unroll
        for (int r = 0; r < 16; ++r) wa[r] = p.w_alpha[r * 512 + h * 128 + kp];
        const float balpha = p.b_alpha[h * 128 + kp];
        const size_t t0 = (size_t)b * SEQ + ch * 64 + seg * 16;
        float qv[16], kv[16];
#pragma unroll
        for (int i = 0; i < 16; ++i) { qv[i] = bf2f(QKV[(t0 + i) * 2048 + h * 128 + kp]); kv[i] = bf2f(QKV[(t0 + i) * 2048 + 512 + h * 128 + kp]); }
        float cl[16]; float run = 0.f;
#pragma unroll
        for (int i = 0; i < 16; ++i) { const size_t t = t0 + i;
            const u32x4 a0 = *(const u32x4*)(AL + t * 16), a1 = *(const u32x4*)(AL + t * 16 + 8);
            float z = balpha;
            z += bflo(a0.x) * wa[0] + bfhi(a0.x) * wa[1] + bflo(a0.y) * wa[2] + bfhi(a0.y) * wa[3] + bflo(a0.z) * wa[4] + bfhi(a0.z) * wa[5] + bflo(a0.w) * wa[6] + bfhi(a0.w) * wa[7];
            z += bflo(a1.x) * wa[8] + bfhi(a1.x) * wa[9] + bflo(a1.y) * wa[10] + bfhi(a1.y) * wa[11] + bflo(a1.z) * wa[12] + bfhi(a1.z) * wa[13] + bflo(a1.w) * wa[14] + bfhi(a1.w) * wa[15];
            const float ls = fminf(z, 0.f) - __logf(1.f + __expf(-fabsf(z)));
            run += ls * (1.f / 16.f); cl[i] = run; }
        __syncthreads();
        segt[seg * 128 + kp] = run;
        __syncthreads();
        float off = 0.f, tot = 0.f;
#pragma unroll
        for (int s = 0; s < 4; ++s) { const float v = segt[s * 128 + kp]; tot += v; if (s < seg) off += v; }
        if (seg == 0) DK[(size_t)(b * 128 + ch) * 512 + h * 128 + kp] = __expf(tot);
#pragma unroll
        for (int i = 0; i < 16; ++i) { const float cum = cl[i] + off;
            QKV[(t0 + i) * 2048 + h * 128 + kp] = (bf16)f2bf(qv[i] * 0.08838834764831845f * __expf(cum));
            QKV[(t0 + i) * 2048 + 512 + h * 128 + kp] = (bf16)f2bf(kv[i] * __expf(-cum)); }
    }
}
__device__ __forceinline__ void phase_gla_seq(const Params& p, LAS unsigned char* lds, int G) {
    const int tid = threadIdx.x, lane = tid & 63, wave = __builtin_amdgcn_readfirstlane(tid >> 6), q4 = lane >> 4, c16 = lane & 15;
    constexpr int PQ = 136, PS = 72;
    LAS bf16* Qs = (LAS bf16*)lds;
    LAS bf16* Kd = Qs + 64 * PQ;
    LAS bf16* KdT = Kd + 64 * PQ;
    LAS bf16* VT = KdT + 128 * PS;
    LAS bf16* Pm = VT + 32 * PS;
    LAS bf16* ST = Pm + 64 * PS;
    LAS float* dk = (LAS float*)(ST + 32 * PQ);
    const bf16* QKV = (const bf16*)(p.ws + WS_QKV); bf16* VO = (bf16*)(p.ws + WS_QKV); const float* DK = (const float*)(p.ws + WS_DK); float* SS = (float*)(p.ws + WS_SS);
    const int kp = tid & 127, seg = tid >> 7;
    const int vv = tid & 31, sg = tid >> 5;
    const int r0 = tid >> 4, cc = (tid & 15) * 8;
    for (int it = blockIdx.x; it < 8 * 4 * 8; it += G) {
        const int v8 = it & 7, h = (it >> 3) & 3, b = it >> 5;
        pg8::f32x4 sacc[2] = {(pg8::f32x4){0.f, 0.f, 0.f, 0.f}, (pg8::f32x4){0.f, 0.f, 0.f, 0.f}};
        __syncthreads();
        for (int i = tid; i < 32 * PQ / 2; i += NTHR) ((LAS unsigned*)ST)[i] = 0u;
        u32x4 rq[2], rk[2]; unsigned rkt[8], rv[2]; float rdk = 0.f;
#define GLA_LOAD(chn) do { const size_t _t0 = (size_t)b * SEQ + (size_t)(chn) * 64; \
            _Pragma("unroll") for (int _j = 0; _j < 2; ++_j) { rq[_j] = *(const u32x4*)(QKV + (_t0 + r0 + 32 * _j) * 2048 + h * 128 + cc); rk[_j] = *(const u32x4*)(QKV + (_t0 + r0 + 32 * _j) * 2048 + 512 + h * 128 + cc); } \
            _Pragma("unroll") for (int _i = 0; _i < 8; ++_i) { const unsigned _lo = QKV[(_t0 + seg * 16 + 2 * _i) * 2048 + 512 + h * 128 + kp], _hi = QKV[(_t0 + seg * 16 + 2 * _i + 1) * 2048 + 512 + h * 128 + kp]; rkt[_i] = _lo | (_hi << 16); } \
            _Pragma("unroll") for (int _i = 0; _i < 2; ++_i) { const unsigned _lo = QKV[(_t0 + sg * 4 + 2 * _i) * 2048 + 1024 + h * 256 + v8 * 32 + vv], _hi = QKV[(_t0 + sg * 4 + 2 * _i + 1) * 2048 + 1024 + h * 256 + v8 * 32 + vv]; rv[_i] = _lo | (_hi << 16); } \
            if (tid < 128) rdk = DK[(size_t)(b * 128 + (chn)) * 512 + h * 128 + tid]; } while (0)
        GLA_LOAD(0);
#pragma unroll 1
        for (int ch = 0; ch < SEQ / 64; ++ch) {
            const size_t t0 = (size_t)b * SEQ + ch * 64;
#pragma unroll
            for (int j = 0; j < 2; ++j) { *(LAS u32x4*)(Qs + (r0 + 32 * j) * PQ + cc) = rq[j]; *(LAS u32x4*)(Kd + (r0 + 32 * j) * PQ + cc) = rk[j]; }
            *(LAS u32x4*)(KdT + kp * PS + seg * 16) = (u32x4){rkt[0], rkt[1], rkt[2], rkt[3]};
            *(LAS u32x4*)(KdT + kp * PS + seg * 16 + 8) = (u32x4){rkt[4], rkt[5], rkt[6], rkt[7]};
            *(LAS u32x2*)(VT + vv * PS + sg * 4) = (u32x2){rv[0], rv[1]};
            if (tid < 128) dk[tid] = rdk;
            if (ch + 1 < SEQ / 64) GLA_LOAD(ch + 1);
            __syncthreads();
            { const int tt = wave & 3;
#pragma unroll
              for (int i2 = 0; i2 < 2; ++i2) { const int ts = (wave >> 2) * 2 + i2;
                  pg8::f32x4 acc = (pg8::f32x4){0.f, 0.f, 0.f, 0.f};
                  if (ts <= tt) {
#pragma unroll
                      for (int ks = 0; ks < 4; ++ks) { const bf16x8_t a = *(const LAS bf16x8_t*)(Kd + (ts * 16 + c16) * PQ + ks * 32 + q4 * 8), bb = *(const LAS bf16x8_t*)(Qs + (tt * 16 + c16) * PQ + ks * 32 + q4 * 8);
                          acc = __builtin_amdgcn_mfma_f32_16x16x32_bf16(a, bb, acc, 0, 0, 0); }
                      const int tg = tt * 16 + c16, sgl = ts * 16 + q4 * 4;
#pragma unroll
                      for (int j = 0; j < 4; ++j) if (sgl + j > tg) acc[j] = 0.f;
                  }
                  *(LAS u32x2*)(Pm + (tt * 16 + c16) * PS + ts * 16 + q4 * 4) = (u32x2){pk2(acc[0], acc[1]), pk2(acc[2], acc[3])}; } }
            __syncthreads();
            { const int tt = wave & 3, tv = wave >> 2;
              pg8::f32x4 oacc = (pg8::f32x4){0.f, 0.f, 0.f, 0.f};
#pragma unroll
              for (int ks = 0; ks < 2; ++ks) { const bf16x8_t bb = *(const LAS bf16x8_t*)(Pm + (tt * 16 + c16) * PS + ks * 32 + q4 * 8), a = *(const LAS bf16x8_t*)(VT + (tv * 16 + c16) * PS + ks * 32 + q4 * 8);
                  oacc = __builtin_amdgcn_mfma_f32_16x16x32_bf16(a, bb, oacc, 0, 0, 0); }
#pragma unroll
              for (int ks = 0; ks < 4; ++ks) { const bf16x8_t bb = *(const LAS bf16x8_t*)(Qs + (tt * 16 + c16) * PQ + ks * 32 + q4 * 8), a = *(const LAS bf16x8_t*)(ST + (tv * 16 + c16) * PQ + ks * 32 + q4 * 8);
                  oacc = __builtin_amdgcn_mfma_f32_16x16x32_bf16(a, bb, oacc, 0, 0, 0); }
              *(u32x2*)(VO + (t0 + tt * 16 + c16) * 2048 + 1024 + h * 256 + v8 * 32 + tv * 16 + q4 * 4) = (u32x2){pk2(oacc[0], oacc[1]), pk2(oacc[2], oacc[3])};
              float sq = (oacc[0] * oacc[0] + oacc[1] * oacc[1]) + (oacc[2] * oacc[2] + oacc[3] * oacc[3]);
              sq += __shfl_xor(sq, 16); sq += __shfl_xor(sq, 32);
              if (q4 == 0) atomicAdd(SS + (t0 + tt * 16 + c16) * 4 + h, sq); }
#pragma unroll
            for (int ks = 0; ks < 2; ++ks) { const bf16x8_t a = *(const LAS bf16x8_t*)(KdT + (wave * 16 + c16) * PS + ks * 32 + q4 * 8);
#pragma unroll
                for (int tv = 0; tv < 2; ++tv) { const bf16x8_t bb = *(const LAS bf16x8_t*)(VT + (tv * 16 + c16) * PS + ks * 32 + q4 * 8);
                    sacc[tv] = __builtin_amdgcn_mfma_f32_16x16x32_bf16(a, bb, sacc[tv], 0, 0, 0); } }
            { const pg8::f32x4 d4 = *(const LAS pg8::f32x4*)(dk + wave * 16 + q4 * 4);
#pragma unroll
              for (int tv = 0; tv < 2; ++tv) sacc[tv] = sacc[tv] * d4; }
            __syncthreads();
#pragma unroll
            for (int tv = 0; tv < 2; ++tv) *(LAS u32x2*)(ST + (tv * 16 + c16) * PQ + wave * 16 + q4 * 4) = (u32x2){pk2(sacc[tv][0], sacc[tv][1]), pk2(sacc[tv][2], sacc[tv][3])};
        }
#undef GLA_LOAD
    }
}

__device__ __forceinline__ void phase_norm2(const Params& p, LAS unsigned char* lds, int G) {
    const int tid = threadIdx.x, lane = tid & 63, wave = __builtin_amdgcn_readfirstlane(tid >> 6);
    const float* modp = (const float*)(p.ws + WS_MODP);
    LAS float* g1 = (LAS float*)lds; LAS float* gs = g1 + 1024; LAS float* sh = gs + 1024;
    const bf16* Y = (const bf16*)(p.ws + WS_Y); bf16* H2 = (bf16*)(p.ws + WS_H2);
    for (int tile = blockIdx.x; tile < T / 256; tile += G) {
        const int b = tile / 32;
        __syncthreads();
        for (int k = tid; k < 1024; k += NTHR) { g1[k] = mod_at(modp, b, 2048 + k) * p.npo[k]; gs[k] = p.npf[k] * (1.f + mod_at(modp, b, 4096 + k)); sh[k] = mod_at(modp, b, 3072 + k); }
        __syncthreads();
        for (int rr = 0; rr < 32; ++rr) {
            const size_t row = (size_t)tile * 256 + wave * 32 + rr;
            const f32x4* xr = (const f32x4*)(p.x + row * 1024) + lane; const u32x2* yr = (const u32x2*)(Y + row * 1024) + lane;
            f32x4 xv[4], yv[4]; float s = 0.f;
#pragma unroll
            for (int j = 0; j < 4; ++j) { xv[j] = xr[64 * j]; const u32x2 yw = yr[64 * j]; yv[j] = (f32x4){bflo(yw.x), bfhi(yw.x), bflo(yw.y), bfhi(yw.y)};
                s += (yv[j].x * yv[j].x + yv[j].y * yv[j].y) + (yv[j].z * yv[j].z + yv[j].w * yv[j].w); }
            const float rstd = __builtin_amdgcn_rsqf(wave_sum(s) * (1.f / 1024.f) + 1e-6f);
            float s2 = 0.f;
            f32x4* orow = (f32x4*)(p.out + row * 1024) + lane;
#pragma unroll
            for (int j = 0; j < 4; ++j) { const int k = 256 * j + 4 * lane; const f32x4 g4 = *(const LAS f32x4*)(g1 + k);
                xv[j] = xv[j] + yv[j] * rstd * g4; orow[64 * j] = xv[j];
                s2 += (xv[j].x * xv[j].x + xv[j].y * xv[j].y) + (xv[j].z * xv[j].z + xv[j].w * xv[j].w); }
            const float rstd2 = __builtin_amdgcn_rsqf(wave_sum(s2) * (1.f / 1024.f) + 1e-6f);
            u32x2* o8 = (u32x2*)(H2 + row * 1024) + lane;
#pragma unroll
            for (int j = 0; j < 4; ++j) { const int k = 256 * j + 4 * lane; const f32x4 g4 = *(const LAS f32x4*)(gs + k), s4 = *(const LAS f32x4*)(sh + k);
                u32x2 w; w.x = pk2(xv[j].x * rstd2 * g4.x + s4.x, xv[j].y * rstd2 * g4.y + s4.y); w.y = pk2(xv[j].z * rstd2 * g4.z + s4.z, xv[j].w * rstd2 * g4.w + s4.w);
                o8[64 * j] = w; }
        }
    }
}

__device__ __forceinline__ unsigned h16_key(unsigned b) { return (b & 0x8000u) ? (~b & 0xffffu) : (b | 0x8000u); }
__device__ __forceinline__ float h16_key_val(unsigned s) { const unsigned b = (s & 0x8000u) ? (s & 0x7fffu) : (~s & 0xffffu); return (float)__builtin_bit_cast(_Float16, (unsigned short)b); }
#define INS16(top, x) do { _Pragma("unroll") for (int _j = 0; _j < 16; ++_j) { const unsigned _hi = max(top[_j], x), _lo = min(top[_j], x); top[_j] = _hi; x = _lo; } } while (0)
__device__ __forceinline__ void phase_topk(const Params& p, LAS unsigned char* lds, int G) {
    const int tid = threadIdx.x;
    const unsigned short* SC = (const unsigned short*)(p.ws + WS_SC); unsigned* TK = (unsigned*)(p.ws + WS_TOPK); float* TK2 = (float*)(p.ws + WS_TOPK2);
    const float* SU = (const float*)(p.ws + WS_SU); const float* SV = (const float*)(p.ws + WS_SV);
    LAS unsigned* my = (LAS unsigned*)lds + tid * 33;
    for (int blk = blockIdx.x; blk < T * 8 / NTHR; blk += G) {
        const int item = blk * NTHR + tid, t = item >> 3, h = item & 7;
        unsigned topA[16], topB[16];
#pragma unroll
        for (int j = 0; j < 16; ++j) { topA[j] = 0u; topB[j] = 0u; }
        const u32x4* src = (const u32x4*)(SC + (size_t)t * 2048 + h * 256);
#pragma unroll 1
        for (int c8 = 0; c8 < 16; ++c8) { const u32x4 w = src[c8];
            const unsigned ww[4] = {w.x, w.y, w.z, w.w};
#pragma unroll
            for (int q = 0; q < 4; ++q) { unsigned k0 = (h16_key(ww[q] & 0xffffu) << 16) | (unsigned)(127 - (c8 * 8 + q * 2)), k1 = (h16_key(ww[q] >> 16) << 16) | (unsigned)(127 - (c8 * 8 + q * 2 + 1));
                INS16(topA, k0); INS16(topA, k1); } }
#pragma unroll 1
        for (int c8 = 0; c8 < 16; ++c8) { const u32x4 w = src[16 + c8];
            const unsigned ww[4] = {w.x, w.y, w.z, w.w};
#pragma unroll
            for (int q = 0; q < 4; ++q) { unsigned k0 = (h16_key(ww[q] & 0xffffu) << 16) | (unsigned)(127 - (c8 * 8 + q * 2)), k1 = (h16_key(ww[q] >> 16) << 16) | (unsigned)(127 - (c8 * 8 + q * 2 + 1));
                INS16(topB, k0); INS16(topB, k1); } }
        float fa[16], fb[16];
#pragma unroll
        for (int j = 0; j < 16; ++j) { fa[j] = h16_key_val(topA[j] >> 16); fb[j] = h16_key_val(topB[j] >> 16); my[j] = 127u - (topA[j] & 127u); my[16 + j] = 127u - (topB[j] & 127u); }
        unsigned ct[16];
#pragma unroll
        for (int j = 0; j < 16; ++j) ct[j] = 0u;
#pragma unroll
        for (int i = 0; i < 16; ++i)
#pragma unroll
            for (int j = 0; j < 16; ++j) if ((i + 1) * (j + 1) <= 16) {
                const float s = fa[i] + fb[j]; unsigned u = __builtin_bit_cast(unsigned, s); u ^= (u >> 31) ? 0xffffffffu : 0x80000000u;
                unsigned key = (u & 0xffffff00u) | (unsigned)(255 - (i * 16 + j));
                INS16(ct, key); }
        float val[16], mx, sum = 0.f;
#pragma unroll
        for (int m = 0; m < 16; ++m) { unsigned u = ct[m] & 0xffffff00u; u ^= (u >> 31) ? 0x80000000u : 0xffffffffu; val[m] = __builtin_bit_cast(float, u); }
        mx = val[0];
#pragma unroll
        for (int m = 0; m < 16; ++m) { val[m] = __expf(val[m] - mx); sum += val[m]; }
        const float inv = 1.f / sum;
        LDS_WAIT();
        unsigned outw[16]; float outs[16];
#pragma unroll
        for (int m = 0; m < 16; ++m) { const unsigned pos = 255u - (ct[m] & 255u), i = pos >> 4, j = pos & 15u;
            const unsigned e = my[i] * 128u + my[16 + j];
            outw[m] = (e << 16) | f2bf(val[m] * inv * SV[e]); outs[m] = SU[e]; }
        u32x4* dst = (u32x4*)(TK + (size_t)item * 16); f32x4* dst2 = (f32x4*)(TK2 + (size_t)item * 16);
#pragma unroll
        for (int q = 0; q < 4; ++q) { dst[q] = (u32x4){outw[4 * q], outw[4 * q + 1], outw[4 * q + 2], outw[4 * q + 3]}; dst2[q] = (f32x4){outs[4 * q], outs[4 * q + 1], outs[4 * q + 2], outs[4 * q + 3]}; }
    }
}

typedef unsigned u32x3 __attribute__((ext_vector_type(3)));
typedef unsigned u32x6 __attribute__((ext_vector_type(6)));
typedef float f32x32 __attribute__((ext_vector_type(32)));
__device__ __forceinline__ float rdlane(float v, int l) { return __builtin_bit_cast(float, __builtin_amdgcn_readlane(__builtin_bit_cast(int, v), l)); }
__device__ __forceinline__ f32x32 fp6x2(u32x3 a, u32x3 b) { const u32x6 s = {a.x, a.y, a.z, b.x, b.y, b.z}; return __builtin_amdgcn_cvt_scalef32_pk32_f32_fp6(s, 1.0f); }
__device__ __forceinline__ void phase_gather(const Params& p, LAS unsigned char* lds, int G) {
    const int tid = threadIdx.x, lane = tid & 63, wave = __builtin_amdgcn_readfirstlane(tid >> 6);
    const float* modp = (const float*)(p.ws + WS_MODP);
    LAS float* g2 = (LAS float*)lds;
    const bf16* H2 = (const bf16*)(p.ws + WS_H2); const unsigned* TK = (const unsigned*)(p.ws + WS_TOPK); const float* TK2 = (const float*)(p.ws + WS_TOPK2);
    const unsigned char* U6 = p.ws + WS_U; const unsigned char* V6 = p.ws + WS_V;
    for (int tile = blockIdx.x; tile < T / 256; tile += G) {
        const int b = tile / 32;
        __syncthreads();
        for (int k = tid; k < 1024; k += NTHR) g2[k] = mod_at(modp, b, 5120 + k) * p.npof[k];
        __syncthreads();
#pragma unroll 1
        for (int rr = 0; rr < 32; ++rr) {
            const size_t row = (size_t)tile * 256 + wave * 32 + rr;
            float xt[16];
            { const u32x4 a = *(const u32x4*)(H2 + row * 1024 + lane * 16), c = *(const u32x4*)(H2 + row * 1024 + lane * 16 + 8);
              xt[0] = bflo(a.x); xt[1] = bfhi(a.x); xt[2] = bflo(a.y); xt[3] = bfhi(a.y); xt[4] = bflo(a.z); xt[5] = bfhi(a.z); xt[6] = bflo(a.w); xt[7] = bfhi(a.w);
              xt[8] = bflo(c.x); xt[9] = bfhi(c.x); xt[10] = bflo(c.y); xt[11] = bfhi(c.y); xt[12] = bflo(c.z); xt[13] = bfhi(c.z); xt[14] = bflo(c.w); xt[15] = bfhi(c.w); }
            float acc[16];
#pragma unroll
            for (int j = 0; j < 16; ++j) acc[j] = 0.f;
#pragma unroll 1
            for (int hh = 0; hh < 16; ++hh) {
                const u32x4* ra = (const u32x4*)(TK + row * 128 + hh * 8);
                const u32x4 w0 = ra[0], w1 = ra[1];
                const unsigned ww[8] = {w0.x, w0.y, w0.z, w0.w, w1.x, w1.y, w1.z, w1.w};
                u32x6 up[4], vp[4];
#pragma unroll
                for (int m = 0; m < 8; ++m) { const size_t eo = (size_t)((unsigned)__builtin_amdgcn_readfirstlane((int)ww[m]) >> 16) * 768 + lane * 12;
                    const u32x3 a = *(const u32x3*)(U6 + eo), c = *(const u32x3*)(V6 + eo);
                    if (m & 1) { up[m >> 1][3] = a.x; up[m >> 1][4] = a.y; up[m >> 1][5] = a.z; vp[m >> 1][3] = c.x; vp[m >> 1][4] = c.y; vp[m >> 1][5] = c.z; }
                    else { up[m >> 1][0] = a.x; up[m >> 1][1] = a.y; up[m >> 1][2] = a.z; vp[m >> 1][0] = c.x; vp[m >> 1][1] = c.y; vp[m >> 1][2] = c.z; } }
                const unsigned wa = TK[row * 128 + hh * 8 + (lane >> 3)]; const float su = TK2[row * 128 + hh * 8 + (lane >> 3)];
                float pd[8];
#pragma unroll
                for (int m = 0; m < 8; m += 2) { const f32x32 f = __builtin_amdgcn_cvt_scalef32_pk32_f32_fp6(up[m >> 1], 1.0f);
                    float s0 = 0.f, s1 = 0.f;
#pragma unroll
                    for (int j = 0; j < 16; ++j) { s0 += xt[j] * f[j]; s1 += xt[j] * f[16 + j]; }
                    pd[m] = s0; pd[m + 1] = s1; __builtin_amdgcn_sched_barrier(0); }
#pragma unroll
                for (int j = 0; j < 4; ++j) { const bool up_ = (lane & 32) != 0; const float keep = up_ ? pd[j + 4] : pd[j], send = up_ ? pd[j] : pd[j + 4]; pd[j] = keep + __shfl_xor(send, 32); }
#pragma unroll
                for (int j = 0; j < 2; ++j) { const bool up_ = (lane & 16) != 0; const float keep = up_ ? pd[j + 2] : pd[j], send = up_ ? pd[j] : pd[j + 2]; pd[j] = keep + __shfl_xor(send, 16); }
                { const bool up_ = (lane & 8) != 0; const float keep = up_ ? pd[1] : pd[0], send = up_ ? pd[0] : pd[1]; pd[0] = keep + __shfl_xor(send, 8); }
                float d = pd[0]; d += __shfl_xor(d, 4); d += __shfl_xor(d, 2); d += __shfl_xor(d, 1);
                const float coef = bflo(wa) * gelu_f(su * d);
#pragma unroll
                for (int m = 0; m < 8; m += 2) { const f32x32 f = __builtin_amdgcn_cvt_scalef32_pk32_f32_fp6(vp[m >> 1], 1.0f); const float c0 = rdlane(coef, 8 * m), c1 = rdlane(coef, 8 * m + 8);
#pragma unroll
                    for (int j = 0; j < 16; ++j) acc[j] += c0 * f[j] + c1 * f[16 + j];
                    __builtin_amdgcn_sched_barrier(0); }
            }
            float s = 0.f;
#pragma unroll
            for (int j = 0; j < 16; ++j) s += acc[j] * acc[j];
            const float rstd = __builtin_amdgcn_rsqf(wave_sum(s) * (1.f / 1024.f) + 1e-6f);
            float* orow = p.out + row * 1024 + lane * 16;
#pragma unroll
            for (int q = 0; q < 4; ++q) { f32x4 o = *(const f32x4*)(orow + 4 * q); const f32x4 ga = *(const LAS f32x4*)(g2 + lane * 16 + 4 * q);
                o.x += ga.x * acc[4 * q] * rstd; o.y += ga.y * acc[4 * q + 1] * rstd; o.z += ga.z * acc[4 * q + 2] * rstd; o.w += ga.w * acc[4 * q + 3] * rstd;
                *(f32x4*)(orow + 4 * q) = o; }
        }
    }
}

#define XB_TMO      128
#define XB_XCNT(j)  (256  + 64 * (j))
#define XB_XSUB(j)  (1280 + 64 * (j))
#define XB_XGEN(j)  (2304 + 64 * (j))
#define XB_TOP      3328
#define XB_TOPGEN   3392
#define XCD_BAR_WORDS 3456
#define XB_SPIN_CAP (1u << 18)

__device__ __forceinline__ unsigned xb_ld(unsigned* p)              { return __hip_atomic_load(p, __ATOMIC_RELAXED, __HIP_MEMORY_SCOPE_AGENT); }
__device__ __forceinline__ unsigned xb_add(unsigned* p, unsigned v) { return __hip_atomic_fetch_add(p, v, __ATOMIC_RELAXED, __HIP_MEMORY_SCOPE_AGENT); }
__device__ __forceinline__ unsigned xb_xcc_id() { return (unsigned)__builtin_amdgcn_s_getreg((3 << 11) | 20) & 0xFu; }
#define XB_SPIN(cond, bar) do { unsigned _sp = 0; while (cond) { __builtin_amdgcn_s_sleep(1); \
    if ((++_sp & 255u) == 0u) { if (xb_ld(&(bar)[XB_TMO])) break; if (_sp > XB_SPIN_CAP) { atomicAdd(&(bar)[XB_TMO], 1u); break; } } } } while (0)

struct XcdBarrier {
    unsigned* bar; unsigned x;
    volatile LAS unsigned* st;
};

__device__ __forceinline__ XcdBarrier xcd_barrier_post(unsigned* bar, volatile LAS unsigned* st) {
    XcdBarrier b; b.bar = bar; b.x = xb_xcc_id(); b.st = st;
    if (threadIdx.x == 0) (void)xb_add(&bar[XB_XCNT(b.x)], 1u);
    return b;
}
__device__ __forceinline__ void xcd_barrier_complete(unsigned* bar, unsigned x, unsigned& nloc, unsigned& nx) {
    const unsigned G = gridDim.x * gridDim.y * gridDim.z;
    unsigned sum, cnt, mine, sp = 0u;
    for (;;) {
        sum = 0u; cnt = 0u; mine = 0u;
#pragma unroll
        for (unsigned j = 0; j < 16; ++j) { const unsigned c = xb_ld(&bar[XB_XCNT(j)]); sum += c; cnt += (c > 0u) ? 1u : 0u; mine = (j == x) ? c : mine; }
        if (sum == G) break;
        __builtin_amdgcn_s_sleep(1);
        if ((++sp & 255u) == 0u) { if (xb_ld(&bar[XB_TMO])) break; if (sp > XB_SPIN_CAP) { atomicAdd(&bar[XB_TMO], 1u); break; } }
    }
    nloc = mine > 0u ? mine : 1u; nx = cnt > 0u ? cnt : 1u;
}

__device__ __forceinline__ void xcd_barrier(const XcdBarrier& b) {
    asm volatile("s_waitcnt vmcnt(0)" ::: "memory");
    __syncthreads();
    if (threadIdx.x == 0) {
        unsigned* bar = b.bar;
        __builtin_amdgcn_s_waitcnt(0);
        unsigned nloc = b.st[0], nx = b.st[1];
        if (nloc == 0u) { xcd_barrier_complete(bar, b.x, nloc, nx); b.st[0] = nloc; b.st[1] = nx; }
        const unsigned old = xb_add(&bar[XB_XSUB(b.x)], 1u);
        const unsigned gen = old / nloc;
        if (old + 1u == (gen + 1u) * nloc) {
            __builtin_amdgcn_fence(__ATOMIC_RELEASE, "agent");
            asm volatile("s_waitcnt vmcnt(0)" ::: "memory");
            const unsigned og = xb_add(&bar[XB_TOP], 1u);
            const unsigned tg = og / nx;
            if (og + 1u == (tg + 1u) * nx) xb_add(&bar[XB_TOPGEN], 1u);
            else XB_SPIN(xb_ld(&bar[XB_TOPGEN]) == tg, bar);
            __builtin_amdgcn_fence(__ATOMIC_ACQUIRE, "agent");
            xb_add(&bar[XB_XGEN(b.x)], 1u);
            asm volatile("s_waitcnt vmcnt(0)" ::: "memory");
        } else {
            XB_SPIN(xb_ld(&bar[XB_XGEN(b.x)]) == gen, bar);
            __builtin_amdgcn_fence(__ATOMIC_ACQUIRE, "agent");
            asm volatile("s_waitcnt vmcnt(0)" ::: "memory");
        }
    }
    __syncthreads();
}


template <int PH>
__device__ __forceinline__ void run_phase(const Params& p, LAS unsigned char* lds, int G) {
    unsigned char* ws = p.ws;
    if constexpr (PH == 0) phase0(p, lds, G);
    else if constexpr (PH == 1) phase1(p, lds, G);
    else if constexpr (PH == 2) { pg8::Gemm g{(const bf16*)p.out, (const bf16*)(ws + WS_WIN), T, NPAD, 1024, 1024}; pg8::StaticOrder S; S.init(T, NPAD, G, (int)blockIdx.x);
        EpiSeg E{ws}; pg8::gemm_phase<EpiSeg, pg8::StaticOrder, true, true, 0, 1024, 1024>(lds, g, S, E); }
    else if constexpr (PH == 3) { phase_gla_prep(p, lds, G); __syncthreads(); phase_lru<false>(p, lds, G); }
    else if constexpr (PH == 4) phase_gla_seq(p, lds, G);
    else if constexpr (PH == 5) phase_lru<true>(p, lds, G);
    else if constexpr (PH == 6) { pg8::Gemm g{(const bf16*)(ws + WS_GAGB), (const bf16*)(ws + WS_WOUT), T, 1024, 1024, 2048}; pg8::StaticOrder S; S.init(T, 1024, G, (int)blockIdx.x);
        EpiPlain E{(bf16*)(ws + WS_Y), 1024}; pg8::gemm_phase<EpiPlain, pg8::StaticOrder, true, true, 0, 1024, 2048>(lds, g, S, E); }
    else if constexpr (PH == 7) phase_norm2(p, lds, G);
    else if constexpr (PH == 8) { pg8::Gemm g{(const bf16*)(ws + WS_H2), (const bf16*)(ws + WS_WQ), T, 2048, 1024, 1024}; pg8::StaticOrder S; S.init(T, 2048, G, (int)blockIdx.x);
        EpiPlain E{(bf16*)(ws + WS_QRY), 2048}; pg8::gemm_phase<EpiPlain, pg8::StaticOrder, true, true, 0, 1024, 1024>(lds, g, S, E); }
    else if constexpr (PH == 9) { pg8::Gemm g{(const bf16*)(ws + WS_QRY), (const bf16*)(ws + WS_SUBK), T, 2048, 256, 2048}; pg8::StaticOrder S; S.init(T, 2048, G, (int)blockIdx.x);
        EpiF16 E{(unsigned short*)(ws + WS_SC), 2048}; pg8::gemm_phase<EpiF16, pg8::StaticOrder, true, true, 2, 256, 2048>(lds, g, S, E); }
    else if constexpr (PH == 10) phase_topk(p, lds, G);
    else if constexpr (PH == 11) phase_gather(p, lds, G);
}
template <int PH>
__global__ void __launch_bounds__(NTHR, 2) k_phase(Params p) {
    extern __shared__ __attribute__((aligned(16))) unsigned char lds_raw[];
    run_phase<PH>(p, (LAS unsigned char*)lds_raw, (int)gridDim.x);
}
constexpr int LDS_BAR_OFF = LDS_BYTES - 16;
template <int PH>
__device__ __forceinline__ void run_from(const Params& p, LAS unsigned char* lds, int G, const XcdBarrier& bar) {
#if PROBE_PH >= 0
    unsigned long long pt0 = 0; if constexpr (PH == PROBE_PH) pt0 = __builtin_amdgcn_s_memrealtime();
#endif
    run_phase<PH>(p, lds, G);
    if constexpr (PH + 1 < N_PHASES) {
        if constexpr (PH == 0) cg::this_grid().sync();
        else xcd_barrier(bar);
    }
#if PROBE_PH >= 0
    if constexpr (PH == PROBE_PH) { const unsigned long long pt1 = __builtin_amdgcn_s_memrealtime(), span = pt1 - pt0;
        while (__builtin_amdgcn_s_memrealtime() - pt1 < (unsigned long long)PROBE_MULT * span) __builtin_amdgcn_s_sleep(8); }
#endif
    if constexpr (PH + 1 < N_PHASES) run_from<PH + 1>(p, lds, G, bar);
}
__global__ void __launch_bounds__(NTHR, 2) k_mega(Params p) {
    extern __shared__ __attribute__((aligned(16))) unsigned char lds_raw[];
    LAS unsigned char* lds = (LAS unsigned char*)lds_raw;
    if (threadIdx.x < 4) ((LAS unsigned*)(lds + LDS_BAR_OFF))[threadIdx.x] = 0u;
    __syncthreads();
    const XcdBarrier bar = xcd_barrier_post((unsigned*)(p.ws + WS_CTL), (volatile LAS unsigned*)(lds + LDS_BAR_OFF));
    run_from<0>(p, lds, (int)gridDim.x, bar);
}

extern "C" void kernel_launch(void* const* d_in, const int* in_sizes, int n_in, void* d_out, int out_size, void* d_ws, size_t ws_size, hipStream_t stream) {
    static int grid = 0;
    if (grid == 0) {
        if (n_in != 24 || in_sizes[0] != T * DM || out_size != T * DM || ws_size < WS_END) {
            fprintf(stderr, "kernel_launch: unexpected shapes: n_in %d in0 %d out %d ws %zu\n", n_in, n_in > 0 ? in_sizes[0] : -1, out_size, ws_size); grid = -1; return; }
        int dev = 0, cus = 0, per_cu = 0;
        if (hipGetDevice(&dev) != hipSuccess || hipDeviceGetAttribute(&cus, hipDeviceAttributeMultiprocessorCount, dev) != hipSuccess) { grid = -1; return; }
        if (hipFuncSetAttribute((const void*)k_mega, hipFuncAttributeMaxDynamicSharedMemorySize, LDS_BYTES) != hipSuccess) { fprintf(stderr, "kernel_launch: hipFuncSetAttribute failed\n"); grid = -1; return; }
        if (hipOccupancyMaxActiveBlocksPerMultiprocessor(&per_cu, (const void*)k_mega, NTHR, LDS_BYTES) != hipSuccess || per_cu < 1) { fprintf(stderr, "kernel_launch: occupancy query says %d blocks per CU\n", per_cu); grid = -1; return; }
        (void)hipGetLastError();
        grid = cus;
    }
    if (grid < 0) return;
    Params p{};
    const float** pp = (const float**)&p;
    for (int i = 0; i < 24; ++i) pp[i] = (const float*)d_in[i];
    p.out = (float*)d_out; p.ws = (unsigned char*)d_ws;
    if (hipMemsetAsync((char*)d_ws + WS_CTL, 0, 65536, stream) != hipSuccess) { fprintf(stderr, "kernel_launch: hipMemsetAsync failed\n"); return; }
    void* args[] = {&p};
    hipError_t e = hipLaunchCooperativeKernel((const void*)k_mega, dim3(grid), dim3(NTHR), args, LDS_BYTES, stream);
    if (e != hipSuccess) fprintf(stderr, "kernel_launch: cooperative launch failed: %s (grid %d)\n", hipGetErrorString(e), grid);
}
```

```cpp
#include <hip/hip_runtime.h>
#include <hip/hip_cooperative_groups.h>
#include <cstdio>
#include <cstdint>
#include <utility>
namespace cg = cooperative_groups;

namespace pg8 {
#define PG8_LAS __attribute__((address_space(3)))
typedef unsigned short bf16_t;
typedef short bf16x8 __attribute__((ext_vector_type(8)));
typedef float f32x4 __attribute__((ext_vector_type(4)));
typedef unsigned u32x4 __attribute__((ext_vector_type(4)));
constexpr int BM = 256, BK = 64, HALF = 128, HTB = HALF * BK * 2  , STAGE_BYTES = 8 * HTB, NXCD = 8, WGM = 8;

__host__ __device__ __forceinline__ int lds_byte(int r, int c) { const int st = (r >> 4) * 2 + (c >> 5), rr = r & 15, cc = c & 31, ob = rr * 64 + cc * 2; return st * 1024 + (ob ^ (((ob >> 9) & 1) << 5)); }
__host__ __device__ __forceinline__ void stage_rc(int b, int& R, int& C) { const int st = b / 1024, sb = b % 1024, swz = sb ^ (((sb >> 9) & 1) << 5); R = (st >> 1) * 16 + swz / 64; C = (st & 1) * 32 + (swz % 64) / 2; }
__host__ __device__ __forceinline__ int perm32(int rho) { const int n = rho >> 4, i = rho & 15; return 8 * (i >> 2) + 4 * n + (i & 3); }

struct Unit { int pm, pn; };
struct Gemm { const bf16_t* A; const bf16_t* Bt; int M, N, K, lda; };
template <int AMODE> __device__ __forceinline__ size_t a_off_bytes(const Gemm& g, const Unit& u) {
    const int ac = AMODE == 0 ? 0 : (AMODE == 1 ? 128 * (u.pn < 6 ? u.pn : 6) : 256 * u.pn);
    return ((size_t)u.pm * BM * (size_t)g.lda + (size_t)ac) * 2;
}

struct StaticOrder {
    int nM, nN, nwg, G, c;
    __host__ __device__ void init(int M, int N, int G_, int c_) { nM = M / BM; nN = N / BM; nwg = nM * nN; G = G_; c = c_; }
    __host__ __device__ bool next(int i, Unit& u) const {
        const long L = (long)i * G + c; if (L >= nwg) return false;
        int wgid = (int)L; { const int q = nwg / NXCD, r = nwg % NXCD, xcd = wgid % NXCD, off = wgid / NXCD; wgid = (xcd < r ? xcd * (q + 1) : r * (q + 1) + (xcd - r) * q) + off; }
        const int nig = WGM * nN, gid = wgid / nig, fm = gid * WGM, gsz = (nM - fm) < WGM ? (nM - fm) : WGM;
        u.pm = fm + ((wgid % nig) % gsz); u.pn = (wgid % nig) / gsz; return true;
    }
    __device__ __forceinline__ void a_ready(const Unit&) const {}
    __device__ __forceinline__ void done(const Unit&) const {}
};

__device__ __forceinline__ unsigned cvt_pk_bf16(float lo, float hi) { unsigned r; asm volatile("v_cvt_pk_bf16_f32 %0, %1, %2" : "=v"(r) : "v"(lo), "v"(hi)); return r; }

template <class Epi, class Sched, bool ALIGN_EPI = false, bool SP2 = false, int AMODE = 0, int KC = 0, int LDAC = 0>
__device__ __forceinline__ void gemm_phase(PG8_LAS unsigned char* lds, const Gemm g, const Sched& S, const Epi& E) {
    const int tid = threadIdx.x, wid = __builtin_amdgcn_readfirstlane(tid >> 6), lane = tid & 63, wr = wid >> 2, wc = wid & 3, fr = lane & 15, fq = lane >> 4;
    const int K = KC ? KC : g.K, nt = K / BK; const int lda = LDAC ? LDAC : g.lda;
    unsigned voffA[2], voffB[2];
#pragma unroll
    for (int i = 0; i < 2; ++i) { int R, C; stage_rc(tid * 16 + i * 8192, R, C); const int Rb = Epi::PERM ? ((R & ~31) + perm32(R & 31)) : R;
        voffA[i] = (unsigned)(R * lda + C) * 2u; voffB[i] = (unsigned)(Rb * K + C) * 2u; }
    const size_t kstep = (size_t)(BK * 2);
    const size_t hstepA = (size_t)HALF * lda * 2;
    const size_t hstepB = (size_t)HALF * K * 2;
    const size_t tstepB = 2 * hstepB;
    const unsigned ldsw = (unsigned)wid * 1024u;
    const int aoff = lds_byte(wr * 64 + fr, fq * 8), boff = lds_byte(wc * 32 + fr, fq * 8);
#define PG8_SA(b, h) (((b) * 2 + (h)) * HTB)
#define PG8_SB(b, h) ((4 + (b) * 2 + (h)) * HTB)
#define PG8_STAGE(bufoff, gbase, voff) do { _Pragma("unroll") for (int _i = 0; _i < 2; ++_i) \
        __builtin_amdgcn_global_load_lds((const unsigned*)((const char*)(gbase) + (voff)[_i]), (PG8_LAS unsigned*)(lds + (bufoff) + ldsw + _i * 8192), 16, 0, 0); } while (0)
#define PG8_LDA(dst, b, h) do { _Pragma("unroll") for (int m = 0; m < 4; ++m) _Pragma("unroll") for (int k = 0; k < 2; ++k) dst[m][k] = *(const PG8_LAS bf16x8*)(lds + PG8_SA(b, h) + aoff + m * 2048 + k * 1024); } while (0)
#define PG8_LDB(dst, b, h) do { _Pragma("unroll") for (int n = 0; n < 2; ++n) _Pragma("unroll") for (int k = 0; k < 2; ++k) dst[n][k] = *(const PG8_LAS bf16x8*)(lds + PG8_SB(b, h) + boff + n * 2048 + k * 1024); } while (0)
#define PG8_MMA(ai, bj, At, Bt) do { __builtin_amdgcn_s_setprio(1); _Pragma("unroll") for (int m = 0; m < 4; ++m) _Pragma("unroll") for (int n = 0; n < 2; ++n) _Pragma("unroll") for (int k = 0; k < 2; ++k) \
        acc[ai][bj][m][n] = __builtin_amdgcn_mfma_f32_16x16x32_bf16(Bt[n][k], At[m][k], acc[ai][bj][m][n], 0, 0, 0); __builtin_amdgcn_s_setprio(0); } while (0)
#define PG8_WAIT_V(n) asm volatile("s_waitcnt vmcnt(" #n ")" ::: "memory")
#define PG8_WAIT_L(n) asm volatile("s_waitcnt lgkmcnt(" #n ")" ::: "memory")
#define PG8_BAR __builtin_amdgcn_s_barrier()
#define PG8_SCHED __builtin_amdgcn_sched_barrier(0)
    Unit cur, nxt; int ui = 0;
    if (!S.next(0, cur)) return;
    f32x4 acc[2][2][4][2];
#pragma unroll
    for (int a = 0; a < 2; ++a)
#pragma unroll
        for (int b = 0; b < 2; ++b)
#pragma unroll
            for (int m = 0; m < 4; ++m)
#pragma unroll
                for (int n = 0; n < 2; ++n) acc[a][b][m][n] = (f32x4){0.f, 0.f, 0.f, 0.f};
    bf16x8 At[4][2], B0[2][2], B1[2][2];
    const char* cA = (const char*)g.A + a_off_bytes<AMODE>(g, cur); const char* cB = (const char*)g.Bt + (size_t)cur.pn * tstepB;
    S.a_ready(cur);
    if constexpr (SP2) {
        PG8_STAGE(PG8_SB(0, 0), cB, voffB); PG8_STAGE(PG8_SB(0, 1), cB + hstepB, voffB); PG8_STAGE(PG8_SA(0, 0), cA, voffA); PG8_STAGE(PG8_SA(0, 1), cA + hstepA, voffA);
        if (wr == 1) PG8_BAR;
        PG8_WAIT_V(2); PG8_BAR;
        PG8_STAGE(PG8_SB(1, 0), cB + kstep, voffB); PG8_STAGE(PG8_SA(1, 0), cA + kstep, voffA); PG8_STAGE(PG8_SB(1, 1), cB + hstepB + kstep, voffB);
        PG8_WAIT_V(6); PG8_BAR;
    } else {
        PG8_STAGE(PG8_SB(0, 0), cB, voffB); PG8_STAGE(PG8_SA(0, 0), cA, voffA); PG8_STAGE(PG8_SB(0, 1), cB + hstepB, voffB); PG8_STAGE(PG8_SA(0, 1), cA + hstepA, voffA);
        if (wr == 1) PG8_BAR;
        PG8_WAIT_V(4); PG8_BAR;
        PG8_STAGE(PG8_SB(1, 0), cB + kstep, voffB); PG8_STAGE(PG8_SA(1, 0), cA + kstep, voffA); PG8_STAGE(PG8_SB(1, 1), cB + hstepB + kstep, voffB);
        PG8_WAIT_V(6); PG8_BAR;
    }
    for (;;) {
        const bool has_next = S.next(ui + 1, nxt);
        const char* nA = has_next ? (const char*)g.A + a_off_bytes<AMODE>(g, nxt) : cA; const char* nB = has_next ? (const char*)g.Bt + (size_t)nxt.pn * tstepB : cB;
#pragma unroll 1
        for (int t = 0; t < nt; t += 2) {
            const bool last = (t == nt - 2);
            const char* a1 = cA + (size_t)(t + 1) * kstep;
            const char* a2 = last ? nA : cA + (size_t)(t + 2) * kstep; const char* b2 = last ? nB : cB + (size_t)(t + 2) * kstep;
            const char* a3 = a2 + kstep; const char* b3 = b2 + kstep;
            if (last && has_next) S.a_ready(nxt);
            if constexpr (SP2) {
            PG8_LDB(B0, 0, 0); PG8_LDB(B1, 0, 1); PG8_SCHED; PG8_LDA(At, 0, 0); PG8_STAGE(PG8_SA(1, 1), a1 + hstepA, voffA);
            PG8_WAIT_V(8); PG8_WAIT_L(0); PG8_BAR; PG8_MMA(0, 0, At, B0); PG8_MMA(0, 1, At, B1); PG8_BAR; PG8_SCHED;
            PG8_LDA(At, 0, 1); PG8_STAGE(PG8_SB(0, 0), b2, voffB); PG8_STAGE(PG8_SB(0, 1), b2 + hstepB, voffB); PG8_STAGE(PG8_SA(0, 0), a2, voffA);
            PG8_WAIT_V(8); PG8_WAIT_L(0); PG8_BAR; PG8_MMA(1, 0, At, B0); PG8_MMA(1, 1, At, B1); PG8_BAR; PG8_SCHED;
            PG8_LDB(B0, 1, 0); PG8_LDB(B1, 1, 1); PG8_SCHED; PG8_LDA(At, 1, 0); PG8_STAGE(PG8_SA(0, 1), a2 + hstepA, voffA);
            PG8_WAIT_V(8); PG8_WAIT_L(0); PG8_BAR; PG8_MMA(0, 0, At, B0); PG8_MMA(0, 1, At, B1); PG8_BAR; PG8_SCHED;
            PG8_LDA(At, 1, 1); PG8_STAGE(PG8_SB(1, 0), b3, voffB); PG8_STAGE(PG8_SB(1, 1), b3 + hstepB, voffB); PG8_STAGE(PG8_SA(1, 0), a3, voffA);
            PG8_WAIT_V(8); PG8_WAIT_L(0); PG8_BAR; PG8_MMA(1, 0, At, B0); PG8_MMA(1, 1, At, B1); PG8_BAR; PG8_SCHED;
            } else {
            PG8_LDB(B0, 0, 0); PG8_SCHED; PG8_LDA(At, 0, 0); PG8_STAGE(PG8_SA(1, 1), a1 + hstepA, voffA);
            PG8_WAIT_L(8); PG8_BAR; PG8_WAIT_L(0); PG8_MMA(0, 0, At, B0); PG8_BAR; PG8_SCHED;
            PG8_LDB(B1, 0, 1); PG8_STAGE(PG8_SB(0, 0), b2, voffB);
            PG8_BAR; PG8_WAIT_L(0); PG8_MMA(0, 1, At, B1); PG8_BAR;
            PG8_LDA(At, 0, 1); PG8_STAGE(PG8_SA(0, 0), a2, voffA);
            PG8_BAR; PG8_WAIT_L(0); PG8_MMA(1, 0, At, B0); PG8_BAR; PG8_SCHED;
            PG8_STAGE(PG8_SB(0, 1), b2 + hstepB, voffB);
            PG8_WAIT_V(6); PG8_BAR; PG8_MMA(1, 1, At, B1); PG8_BAR;
            PG8_LDB(B0, 1, 0); PG8_SCHED; PG8_LDA(At, 1, 0); PG8_STAGE(PG8_SA(0, 1), a2 + hstepA, voffA);
            PG8_WAIT_L(8); PG8_BAR; PG8_WAIT_L(0); PG8_MMA(0, 0, At, B0); PG8_BAR; PG8_SCHED;
            PG8_LDB(B1, 1, 1); PG8_STAGE(PG8_SB(1, 0), b3, voffB);
            PG8_BAR; PG8_WAIT_L(0); PG8_MMA(0, 1, At, B1); PG8_BAR;
            PG8_LDA(At, 1, 1); PG8_STAGE(PG8_SA(1, 0), a3, voffA);
            PG8_BAR; PG8_WAIT_L(0); PG8_MMA(1, 0, At, B0); PG8_BAR; PG8_SCHED;
            PG8_STAGE(PG8_SB(1, 1), b3 + hstepB, voffB);
            PG8_WAIT_V(6); PG8_BAR; PG8_MMA(1, 1, At, B1); PG8_BAR;
            }
        }
        if constexpr (ALIGN_EPI) { if (wr == 0) PG8_BAR; }
        E(acc, cur, wr, wc, fr, fq); S.done(cur);
        if (!has_next) break;
#pragma unroll
        for (int a = 0; a < 2; ++a)
#pragma unroll
            for (int b = 0; b < 2; ++b)
#pragma unroll
                for (int m = 0; m < 4; ++m)
#pragma unroll
                    for (int n = 0; n < 2; ++n) acc[a][b][m][n] = (f32x4){0.f, 0.f, 0.f, 0.f};
        cur = nxt; cA = nA; cB = nB; ++ui;
        if constexpr (ALIGN_EPI) { if (wr == 1) PG8_BAR; }
    }
    PG8_WAIT_V(0);
    if constexpr (!ALIGN_EPI) { if (wr == 0) PG8_BAR; }
    PG8_BAR;
#undef PG8_SA
#undef PG8_SB
#undef PG8_STAGE
#undef PG8_LDA
#undef PG8_LDB
#undef PG8_MMA
#undef PG8_WAIT_V
#undef PG8_WAIT_L
#undef PG8_BAR
#undef PG8_SCHED
}
}

constexpr int NB = 8, SEQ = 8192, DM = 1024, T = NB * SEQ;
constexpr int NPAD = 7424;
constexpr int NWAVES = 8, NTHR = 512;
constexpr int LDS_BYTES = 147456;
constexpr int N_PHASES = 12;
#define PROBE_PH -1
#define PROBE_MULT 3

constexpr size_t MiB = 1ull << 20;
constexpr size_t WS_CTL = 0;
constexpr size_t WS_MODP = 1 * MiB;
constexpr size_t WS_WIN = 3 * MiB;
constexpr size_t WS_WOUT = 18 * MiB;
constexpr size_t WS_WQ = 20 * MiB;
constexpr size_t WS_LRUB = 24 * MiB;
constexpr size_t WS_SUBK = 25 * MiB;
constexpr size_t WS_LRUC = 26 * MiB;
constexpr size_t WS_U = 32 * MiB;
constexpr size_t WS_V = 48 * MiB;
constexpr size_t WS_SU = 64 * MiB;
constexpr size_t WS_SV = 65 * MiB;
constexpr size_t WS_SS = 30 * MiB;
constexpr size_t WS_DK = 66 * MiB;
constexpr size_t WS_QKV = 96 * MiB;
constexpr size_t WS_R = 352 * MiB;
constexpr size_t WS_XLXG = 480 * MiB;
constexpr size_t WS_GAGB = 736 * MiB;
constexpr size_t WS_ALOW = 992 * MiB;
constexpr size_t WS_END = 994 * MiB;
constexpr size_t WS_Y = WS_QKV;
constexpr size_t WS_H2 = WS_QKV + 128 * MiB;
constexpr size_t WS_QRY = WS_XLXG;
constexpr size_t WS_SC = WS_GAGB;
constexpr size_t WS_TOPK = WS_R;
constexpr size_t WS_TOPK2 = WS_R + 32 * MiB;

#define LAS __attribute__((address_space(3)))
typedef unsigned short bf16;
typedef float f32x4 __attribute__((ext_vector_type(4)));
typedef float f32x2 __attribute__((ext_vector_type(2)));
typedef unsigned u32x4 __attribute__((ext_vector_type(4)));
typedef unsigned u32x2 __attribute__((ext_vector_type(2)));

struct Params {
    const float *x, *c, *w_ada, *b_ada, *npm, *npo, *w_in, *w_alpha, *b_alpha, *gla_norm, *conv_w, *conv_b,
        *lwa, *lba, *lwx, *lbx, *lam, *w_out, *npf, *npof, *wq, *subk, *pu, *pv;
    float* out; unsigned char* ws;
    int ph_lo, ph_hi;
};

__device__ __forceinline__ unsigned f2bf(float f) { unsigned u = __builtin_bit_cast(unsigned, f); return (u + 0x7fffu + ((u >> 16) & 1u)) >> 16; }
__device__ __forceinline__ unsigned pk2(float lo, float hi) { return f2bf(lo) | (f2bf(hi) << 16); }
__device__ __forceinline__ float bflo(unsigned u) { return __builtin_bit_cast(float, u << 16); }
__device__ __forceinline__ float bfhi(unsigned u) { return __builtin_bit_cast(float, u & 0xffff0000u); }
__device__ __forceinline__ float bf2f(bf16 h) { return __builtin_bit_cast(float, (unsigned)h << 16); }
__device__ __forceinline__ float sigmoid_f(float x) { return __builtin_amdgcn_rcpf(1.f + __expf(-x)); }
__device__ __forceinline__ float silu_f(float x) { return x * __builtin_amdgcn_rcpf(1.f + __expf(-x)); }
__device__ __forceinline__ float gelu_f(float x) { const float u = 0.7978845608028654f * (x + 0.044715f * x * x * x); return x * __builtin_amdgcn_rcpf(1.f + __expf(-2.f * u)); }
__device__ __forceinline__ float softplus_f(float x) { return fmaxf(x, 0.f) + log1pf(__expf(-fabsf(x))); }
__device__ __forceinline__ float wave_sum(float v) {
#pragma unroll
    for (int o = 1; o < 64; o <<= 1) v += __shfl_xor(v, o);
    return v;
}
#define LDS_WAIT() asm volatile("s_waitcnt lgkmcnt(0)" ::: "memory")

struct EpiSeg {
    static constexpr bool PERM = true;
    unsigned char* ws;
    __device__ __forceinline__ void operator()(const pg8::f32x4 (&acc)[2][2][4][2], const pg8::Unit& u, int wr, int wc, int fr, int fq) const {
        const int pn = u.pn; bf16* base; int ldc, colt;
        if (pn < 8) { base = (bf16*)(ws + WS_QKV); ldc = 2048; colt = pn * 256; }
        else if (pn < 12) { base = (bf16*)(ws + WS_R); ldc = 1024; colt = (pn - 8) * 256; }
        else if (pn < 20) { base = (bf16*)(ws + WS_XLXG); ldc = 2048; colt = (pn - 12) * 256; }
        else if (pn < 28) { base = (bf16*)(ws + WS_GAGB); ldc = 2048; colt = (pn - 20) * 256; }
        else { base = (bf16*)(ws + WS_ALOW); ldc = 16; colt = 0; }
        const int row0 = u.pm * 256 + wr * 64 + fr, col0 = colt + wc * 32 + 8 * fq;
        const bool tail = (pn == 28);
#pragma unroll
        for (int ai = 0; ai < 2; ++ai)
#pragma unroll
            for (int m = 0; m < 4; ++m) { bf16* rowp = base + (size_t)(row0 + ai * 128 + m * 16) * ldc + col0;
#pragma unroll
                for (int bj = 0; bj < 2; ++bj) { const pg8::f32x4 v0 = acc[ai][bj][m][0], v1 = acc[ai][bj][m][1];
                    u32x4 w; w.x = pg8::cvt_pk_bf16(v0[0], v0[1]); w.y = pg8::cvt_pk_bf16(v0[2], v0[3]); w.z = pg8::cvt_pk_bf16(v1[0], v1[1]); w.w = pg8::cvt_pk_bf16(v1[2], v1[3]);
                    if (!tail || (bj == 0 && wc == 0 && fq < 2)) *(u32x4*)(rowp + bj * 128) = w; } }
    }
};
struct EpiPlain {
    static constexpr bool PERM = true;
    bf16* O; int ldc;
    __device__ __forceinline__ void operator()(const pg8::f32x4 (&acc)[2][2][4][2], const pg8::Unit& u, int wr, int wc, int fr, int fq) const {
        const int row0 = u.pm * 256 + wr * 64 + fr, col0 = u.pn * 256 + wc * 32 + 8 * fq;
#pragma unroll
        for (int ai = 0; ai < 2; ++ai)
#pragma unroll
            for (int m = 0; m < 4; ++m) { bf16* rowp = O + (size_t)(row0 + ai * 128 + m * 16) * ldc + col0;
#pragma unroll
                for (int bj = 0; bj < 2; ++bj) { const pg8::f32x4 v0 = acc[ai][bj][m][0], v1 = acc[ai][bj][m][1];
                    u32x4 w; w.x = pg8::cvt_pk_bf16(v0[0], v0[1]); w.y = pg8::cvt_pk_bf16(v0[2], v0[3]); w.z = pg8::cvt_pk_bf16(v1[0], v1[1]); w.w = pg8::cvt_pk_bf16(v1[2], v1[3]);
                    *(u32x4*)(rowp + bj * 128) = w; } }
    }
};
typedef _Float16 h16x2 __attribute__((ext_vector_type(2)));
__device__ __forceinline__ unsigned pkh(float a, float b) { return __builtin_bit_cast(unsigned, __builtin_amdgcn_cvt_pkrtz(a, b)); }
struct EpiF16 {
    static constexpr bool PERM = true;
    unsigned short* O; int ldc;
    __device__ __forceinline__ void operator()(const pg8::f32x4 (&acc)[2][2][4][2], const pg8::Unit& u, int wr, int wc, int fr, int fq) const {
        const int row0 = u.pm * 256 + wr * 64 + fr, col0 = u.pn * 256 + wc * 32 + 8 * fq;
#pragma unroll
        for (int ai = 0; ai < 2; ++ai)
#pragma unroll
            for (int m = 0; m < 4; ++m) { unsigned short* rowp = O + (size_t)(row0 + ai * 128 + m * 16) * ldc + col0;
#pragma unroll
                for (int bj = 0; bj < 2; ++bj) { const pg8::f32x4 v0 = acc[ai][bj][m][0], v1 = acc[ai][bj][m][1];
                    u32x4 w; w.x = pkh(v0[0], v0[1]); w.y = pkh(v0[2], v0[3]); w.z = pkh(v1[0], v1[1]); w.w = pkh(v1[2], v1[3]);
                    *(u32x4*)(rowp + bj * 128) = w; } }
    }
};
__device__ __forceinline__ void p0_transpose_item(const float* W, int ldw, int k0, int n0, int nvalid, bf16* WT, int ldk, int row0, int kc0, LAS float* scr, int lane) {
#pragma unroll 8
    for (int i = 0; i < 32; ++i) { const int kk = 2 * i + (lane >> 5), cc = lane & 31; scr[kk * 33 + cc] = (cc < nvalid) ? W[(size_t)(k0 + kk) * ldw + n0 + cc] : 0.f; }
    LDS_WAIT(); asm volatile("" ::: "memory");
    const int c = lane & 7;
#pragma unroll
    for (int j = 0; j < 4; ++j) { const int n = (lane >> 3) + 8 * j; const LAS float* s = scr + (8 * c) * 33 + n;
        u32x4 o; o.x = pk2(s[0 * 33], s[1 * 33]); o.y = pk2(s[2 * 33], s[3 * 33]); o.z = pk2(s[4 * 33], s[5 * 33]); o.w = pk2(s[6 * 33], s[7 * 33]);
        *(u32x4*)(WT + (size_t)(row0 + n) * ldk + kc0 + k0 + 8 * c) = o; }
    LDS_WAIT(); asm volatile("" ::: "memory");
}
__device__ __forceinline__ void phase0(const Params& p, LAS unsigned char* lds, int G) {
    const int tid = threadIdx.x, lane = tid & 63, wave = __builtin_amdgcn_readfirstlane(tid >> 6);
    unsigned char* ws = p.ws;
    {
        LAS float* sc = (LAS float*)lds;
        LAS float* red = (LAS float*)(lds + 4096);
        float* modp = (float*)(ws + WS_MODP);
        for (int it = blockIdx.x; it < 24 * 8; it += G) {
            const int nb = it % 24, kc = it / 24;
            for (int i = tid; i < 1024; i += NTHR) { const int b = i >> 7, k = i & 127; sc[i] = silu_f(p.c[b * 1024 + kc * 128 + k]); }
            __syncthreads();
            const int col = tid & 255, kh = tid >> 8;
            float acc[8];
#pragma unroll
            for (int b = 0; b < 8; ++b) acc[b] = 0.f;
            const float* wp = p.w_ada + (size_t)(kc * 128 + kh * 64) * 6144 + nb * 256 + col;
#pragma unroll 8
            for (int kk = 0; kk < 64; ++kk) { const float w = wp[(size_t)kk * 6144];
#pragma unroll
                for (int b = 0; b < 8; ++b) acc[b] += sc[b * 128 + kh * 64 + kk] * w; }
            if (kh == 1) {
#pragma unroll
                for (int b = 0; b < 8; ++b) red[b * 256 + col] = acc[b]; }
            __syncthreads();
            if (kh == 0) { const int n = nb * 256 + col; const float bias = (kc == 0) ? p.b_ada[n] : 0.f;
#pragma unroll
                for (int b = 0; b < 8; ++b) modp[(size_t)(kc * 8 + b) * 6144 + n] = acc[b] + red[b * 256 + col] + bias; }
            __syncthreads();
        }
    }
    for (int i = blockIdx.x * NTHR + tid; i < T * 4 / 4; i += G * NTHR) ((f32x4*)(ws + WS_SS))[i] = (f32x4){0.f, 0.f, 0.f, 0.f};
    LAS float* scr = (LAS float*)(lds + 16384 + wave * 8448);
    const int gw = blockIdx.x * NWAVES + wave, NGW = G * NWAVES;
    bf16* WinT = (bf16*)(ws + WS_WIN); bf16* WoutT = (bf16*)(ws + WS_WOUT); bf16* WqT = (bf16*)(ws + WS_WQ);
    bf16* LruB = (bf16*)(ws + WS_LRUB); bf16* SubK = (bf16*)(ws + WS_SUBK);
    constexpr int I_IN = 16 * (NPAD / 32), I_OUT = 16 * 32, I_Q = 16 * 64, I_LRU = 16 * 8, I_SUB = 2048, I_TAB = 2 * 16384;
    constexpr int NIT = I_IN + I_OUT + I_Q + I_LRU + I_SUB + I_TAB;
    for (int it = gw; it < NIT; it += NGW) {
        int r = it;
        if (r < I_IN) { const int nb = r % (NPAD / 32), kb = r / (NPAD / 32), nq = nb * 32; int n0, nv;
            if (nq < 3072) { n0 = nq; nv = 32; } else if (nq < 7168) { n0 = nq + 16; nv = 32; } else if (nq == 7168) { n0 = 3072; nv = 16; } else { n0 = 0; nv = 0; }
            p0_transpose_item(p.w_in, 7184, kb * 64, n0, nv, WinT, 1024, nq, 0, scr, lane); continue; } r -= I_IN;
        if (r < I_OUT) { const int nb = r % 32, kb = r / 32; p0_transpose_item(p.w_out, 1024, kb * 64, nb * 32, 32, WoutT, 1024, nb * 32, 0, scr, lane); continue; } r -= I_OUT;
        if (r < I_Q) { const int nb = r % 64, kb = r / 64; p0_transpose_item(p.wq, 2048, kb * 64, nb * 32, 32, WqT, 1024, nb * 32, 0, scr, lane); continue; } r -= I_Q;
        if (r < I_LRU) {
            const int mat = r >> 3, sub = r & 7, g = mat >> 3, n = mat & 7, kb = sub >> 2, nb = sub & 3;
            const int np = n < 6 ? n : 6, half = n - np;
            const float* W = (g ? p.lwx : p.lwa) + (size_t)n * 128 * 128;
            bf16* dst = LruB + (size_t)n * 256 * 256;
            p0_transpose_item(W, 128, kb * 64, nb * 32, 32, dst, 256, g * 128 + nb * 32, half * 128, scr, lane);
            p0_transpose_item(W, 128, kb * 64, 0, 0, dst, 256, g * 128 + nb * 32, (1 - half) * 128, scr, lane);
            continue; } r -= I_LRU;
        if (r < I_SUB) {
            const int h = r >> 8, pp = (r >> 7) & 1, n = r & 127;
            const float* src = p.subk + (size_t)r * 128; bf16* dst = SubK + ((size_t)h * 256 + pp * 128 + n) * 256;
            const f32x2 v = *(const f32x2*)(src + 2 * lane);
            *(unsigned*)(dst + pp * 128 + 2 * lane) = pk2(v.x, v.y);
            *(unsigned*)(dst + (1 - pp) * 128 + 2 * lane) = 0u;
            continue; } r -= I_SUB;
        {
            const int tb = r >> 14, row = r & 16383;
            const float* src = (tb ? p.pv : p.pu) + (size_t)row * 1024 + lane * 16;
            f32x4 v[4]; float am = 0.f;
#pragma unroll
            for (int j = 0; j < 4; ++j) { v[j] = *(const f32x4*)(src + 4 * j); am = fmaxf(am, fmaxf(fmaxf(fabsf(v[j].x), fabsf(v[j].y)), fmaxf(fabsf(v[j].z), fabsf(v[j].w)))); }
#pragma unroll
            for (int o = 1; o < 64; o <<= 1) am = fmaxf(am, __shfl_xor(am, o));
            const float inv = am > 0.f ? 7.5f / am : 0.f;
            unsigned long long lo = 0ull; unsigned hi = 0u;
#pragma unroll
            for (int j = 0; j < 16; ++j) { const float x = v[j >> 2][j & 3] * inv, a = fabsf(x);
                unsigned code = a < 1.f ? (unsigned)__builtin_rintf(a * 8.f) : (a < 2.f ? 8u + (unsigned)__builtin_rintf((a - 1.f) * 8.f) : (a < 4.f ? 16u + (unsigned)__builtin_rintf((a - 2.f) * 4.f) : 24u + (unsigned)__builtin_rintf((a - 4.f) * 2.f)));
                code = code > 31u ? 31u : code; code |= (x < 0.f) ? 32u : 0u;
                const int bit = 6 * j;
                if (bit + 6 <= 64) lo |= (unsigned long long)code << bit;
                else if (bit >= 64) hi |= code << (bit - 64);
                else { lo |= (unsigned long long)code << bit; hi |= code >> (64 - bit); } }
            unsigned* dst = (unsigned*)(ws + (tb ? WS_V : WS_U) + (size_t)row * 768 + lane * 12);
            dst[0] = (unsigned)lo; dst[1] = (unsigned)(lo >> 32); dst[2] = hi;
            if (lane == 0) ((float*)(ws + (tb ? WS_SV : WS_SU)))[row] = am * (1.f / 7.5f);
        }
    }
}

__device__ __forceinline__ float mod_at(const float* modp, int b, int n) {
    float s = 0.f;
#pragma unroll
    for (int kc = 0; kc < 8; ++kc) s += modp[(size_t)(kc * 8 + b) * 6144 + n];
    return s;
}

__device__ __forceinline__ void phase1(const Params& p, LAS unsigned char* lds, int G) {
    const int tid = threadIdx.x, lane = tid & 63, wave = __builtin_amdgcn_readfirstlane(tid >> 6);
    const float* modp = (const float*)(p.ws + WS_MODP);
    LAS float* gs = (LAS float*)lds; LAS float* sh = gs + 1024;
    bf16* H = (bf16*)p.out;
    for (int tile = blockIdx.x; tile < T / 256; tile += G) {
        const int b = tile / 32;
        __syncthreads();
        for (int k = tid; k < 1024; k += NTHR) { gs[k] = p.npm[k] * (1.f + mod_at(modp, b, 1024 + k)); sh[k] = mod_at(modp, b, k); }
        __syncthreads();
        for (int rr = 0; rr < 32; ++rr) {
            const size_t row = (size_t)tile * 256 + wave * 32 + rr;
            const f32x4* xr = (const f32x4*)(p.x + row * 1024) + lane;
            f32x4 v[4]; float s = 0.f;
#pragma unroll
            for (int j = 0; j < 4; ++j) { v[j] = xr[64 * j]; s += (v[j].x * v[j].x + v[j].y * v[j].y) + (v[j].z * v[j].z + v[j].w * v[j].w); }
            const float rstd = __builtin_amdgcn_rsqf(wave_sum(s) * (1.f / 1024.f) + 1e-6f);
            u32x2* o8 = (u32x2*)(H + row * 1024) + lane;
#pragma unroll
            for (int j = 0; j < 4; ++j) { const int k = 256 * j + 4 * lane; const f32x4 g4 = *(const LAS f32x4*)(gs + k), s4 = *(const LAS f32x4*)(sh + k);
                u32x2 w; w.x = pk2(v[j].x * rstd * g4.x + s4.x, v[j].y * rstd * g4.y + s4.y); w.y = pk2(v[j].z * rstd * g4.z + s4.z, v[j].w * rstd * g4.w + s4.w);
                o8[64 * j] = w; }
        }
    }
}

typedef short bf16x8_t __attribute__((ext_vector_type(8)));
template <bool FINAL>
__device__ __forceinline__ void phase_lru(const Params& p, LAS unsigned char* lds, int G) {
    const int tid = threadIdx.x, lane = tid & 63, wave = __builtin_amdgcn_readfirstlane(tid >> 6), q4 = lane >> 4, c16 = lane & 15;
    constexpr int PQ = 136;
    LAS bf16* XC = (LAS bf16*)lds;
    LAS bf16* HB = XC + 64 * PQ;
    LAS float* CW = (LAS float*)(HB + 64 * PQ);
    const bf16* XL = (const bf16*)(p.ws + WS_XLXG); const bf16* LruB = (const bf16*)(p.ws + WS_LRUB);
    const bf16* XG = (const bf16*)(p.ws + WS_XLXG) + 1024; const bf16* GB = (const bf16*)(p.ws + WS_GAGB) + 1024; bf16* GA = (bf16*)(p.ws + WS_GAGB);
    const bf16* O = (const bf16*)(p.ws + WS_QKV) + 1024; const bf16* R = (const bf16*)(p.ws + WS_R); const float* SS = (const float*)(p.ws + WS_SS);
    f32x2* CAR = (f32x2*)(p.ws + WS_LRUC);
    const int c8 = tid & 15, tr = tid >> 4;
    for (int it = blockIdx.x; it < 8 * 8 * 4; it += G) {
        const int sg = it & 3, n = (it >> 2) & 7, b = it >> 5;
        const int chc = n * 128 + c8 * 8;
        const int chm = n * 128 + wave * 16 + c16;
        __syncthreads();
        for (int i = tid; i < 768; i += NTHR) { const int q = i >> 7, c = i & 127; CW[i] = q < 4 ? p.conv_w[q * 1024 + n * 128 + c] : (q == 4 ? p.conv_b[n * 128 + c] : p.gla_norm[n * 128 + c]); }
        const float ba = p.lba[chm], bx = p.lbx[chm], sp = -8.f * softplus_f(-p.lam[chm]);
        bf16x8_t wf[2][4];
        { const int np = n < 6 ? n : 6, half = n - np;
#pragma unroll
          for (int g = 0; g < 2; ++g)
#pragma unroll
              for (int ks = 0; ks < 4; ++ks) wf[g][ks] = *(const bf16x8_t*)(LruB + (size_t)n * 65536 + (size_t)(g * 128 + wave * 16 + c16) * 256 + half * 128 + ks * 32 + q4 * 8); }
        float hc = 0.f, aseg = 1.f;
        if (FINAL) { for (int s = 0; s < sg; ++s) { const f32x2 c = CAR[(size_t)((b * 8 + n) * 4 + s) * 128 + wave * 16 + c16]; hc = c.x * hc + c.y; } }
        const size_t tseg = (size_t)b * SEQ + sg * 2048;
        u32x4 xr[5];
#define LRU_LOADX(t0_) do { _Pragma("unroll") for (int _k = 0; _k < 5; ++_k) { const long _t = (long)(t0_) + 2 * tr + _k - 3; \
            xr[_k] = (_t < (long)b * SEQ) ? (u32x4){0u, 0u, 0u, 0u} : *(const u32x4*)(XL + (size_t)_t * 2048 + chc); } } while (0)
        LRU_LOADX(tseg);
        __syncthreads();
#pragma unroll 1
        for (int tl = 0; tl < 32; ++tl) {
            const size_t t0 = tseg + tl * 64;
            { float xv[5][8];
#pragma unroll
              for (int k = 0; k < 5; ++k) { xv[k][0] = bflo(xr[k].x); xv[k][1] = bfhi(xr[k].x); xv[k][2] = bflo(xr[k].y); xv[k][3] = bfhi(xr[k].y); xv[k][4] = bflo(xr[k].z); xv[k][5] = bfhi(xr[k].z); xv[k][6] = bflo(xr[k].w); xv[k][7] = bfhi(xr[k].w); }
              float cw[5][8];
#pragma unroll
              for (int q = 0; q < 5; ++q) { const f32x4 w0 = *(const LAS f32x4*)(CW + q * 128 + c8 * 8), w1 = *(const LAS f32x4*)(CW + q * 128 + c8 * 8 + 4);
                  cw[q][0] = w0.x; cw[q][1] = w0.y; cw[q][2] = w0.z; cw[q][3] = w0.w; cw[q][4] = w1.x; cw[q][5] = w1.y; cw[q][6] = w1.z; cw[q][7] = w1.w; }
#pragma unroll
              for (int i2 = 0; i2 < 2; ++i2) { float o[8];
#pragma unroll
                  for (int j = 0; j < 8; ++j) o[j] = cw[4][j] + cw[0][j] * xv[i2][j] + cw[1][j] * xv[i2 + 1][j] + cw[2][j] * xv[i2 + 2][j] + cw[3][j] * xv[i2 + 3][j];
                  *(LAS u32x4*)(XC + (2 * tr + i2) * PQ + c8 * 8) = (u32x4){pk2(o[0], o[1]), pk2(o[2], o[3]), pk2(o[4], o[5]), pk2(o[6], o[7])}; } }
            u32x4 mxg[2], mgb[2], mo[2], mr[2], mga[2]; float mss[2];
            if (FINAL) {
#pragma unroll
                for (int i2 = 0; i2 < 2; ++i2) { const size_t t = t0 + 2 * tr + i2;
                    mxg[i2] = *(const u32x4*)(XG + t * 2048 + chc); mgb[i2] = *(const u32x4*)(GB + t * 2048 + chc); mo[i2] = *(const u32x4*)(O + t * 2048 + chc);
                    mr[i2] = *(const u32x4*)(R + t * 1024 + chc); mga[i2] = *(const u32x4*)(GA + t * 2048 + chc); mss[i2] = SS[t * 4 + (chc >> 8)]; } }
            if (tl + 1 < 32) LRU_LOADX(t0 + 64);
            __syncthreads();
            pg8::f32x4 acc[4][2];
#pragma unroll
            for (int tt = 0; tt < 4; ++tt) { acc[tt][0] = (pg8::f32x4){0.f, 0.f, 0.f, 0.f}; acc[tt][1] = (pg8::f32x4){0.f, 0.f, 0.f, 0.f}; }
#pragma unroll
            for (int ks = 0; ks < 4; ++ks)
#pragma unroll
                for (int tt = 0; tt < 4; ++tt) { const bf16x8_t a = *(const LAS bf16x8_t*)(XC + (tt * 16 + c16) * PQ + ks * 32 + q4 * 8);
                    acc[tt][0] = __builtin_amdgcn_mfma_f32_16x16x32_bf16(a, wf[0][ks], acc[tt][0], 0, 0, 0);
                    acc[tt][1] = __builtin_amdgcn_mfma_f32_16x16x32_bf16(a, wf[1][ks], acc[tt][1], 0, 0, 0); }
#pragma unroll
            for (int tt = 0; tt < 4; ++tt) {
                float av[4], uv[4];
#pragma unroll
                for (int j = 0; j < 4; ++j) { const float xc = bf2f(XC[(tt * 16 + q4 * 4 + j) * PQ + wave * 16 + c16]);
                    const float gr = sigmoid_f(acc[tt][0][j] + ba), gi = sigmoid_f(acc[tt][1][j] + bx);
                    const float a = __expf(sp * gr); av[j] = a; uv[j] = __builtin_amdgcn_sqrtf(fmaxf(1.f - a * a, 0.f)) * gi * xc; }
                float A4 = av[0], H4 = uv[0];
#pragma unroll
                for (int j = 1; j < 4; ++j) { H4 = av[j] * H4 + uv[j]; A4 *= av[j]; }
                float Ai = A4, Hi = H4;
                { const float Ap = __shfl_up(Ai, 16), Hp = __shfl_up(Hi, 16); if (q4 >= 1) { Hi = Hp * Ai + Hi; Ai = Ap * Ai; } }
                { const float Ap = __shfl_up(Ai, 32), Hp = __shfl_up(Hi, 32); if (q4 >= 2) { Hi = Hp * Ai + Hi; Ai = Ap * Ai; } }
                float Ae = __shfl_up(Ai, 16), He = __shfl_up(Hi, 16); if (q4 == 0) { Ae = 1.f; He = 0.f; }
                float h = hc * Ae + He;
                const float At = __shfl(Ai, 48 + c16), Ht = __shfl(Hi, 48 + c16);
                if (FINAL) {
#pragma unroll
                    for (int j = 0; j < 4; ++j) { h = av[j] * h + uv[j]; HB[(tt * 16 + q4 * 4 + j) * PQ + wave * 16 + c16] = (bf16)f2bf(h); } }
                hc = hc * At + Ht; aseg *= At;
            }
            __syncthreads();
            if (FINAL) {
#pragma unroll
                for (int i2 = 0; i2 < 2; ++i2) { const size_t t = t0 + 2 * tr + i2;
                    const u32x4 hw = *(const LAS u32x4*)(HB + (2 * tr + i2) * PQ + c8 * 8);
                    const float rstd = __builtin_amdgcn_rsqf(mss[i2] * (1.f / 256.f) + 1e-6f);
                    const unsigned hwv[4] = {hw.x, hw.y, hw.z, hw.w}, xgv[4] = {mxg[i2].x, mxg[i2].y, mxg[i2].z, mxg[i2].w}, gbv[4] = {mgb[i2].x, mgb[i2].y, mgb[i2].z, mgb[i2].w};
                    const unsigned ov[4] = {mo[i2].x, mo[i2].y, mo[i2].z, mo[i2].w}, rv[4] = {mr[i2].x, mr[i2].y, mr[i2].z, mr[i2].w}, gav[4] = {mga[i2].x, mga[i2].y, mga[i2].z, mga[i2].w};
                    unsigned ow[4];
                    const f32x4 g0 = *(const LAS f32x4*)(CW + 640 + c8 * 8), g1 = *(const LAS f32x4*)(CW + 640 + c8 * 8 + 4);
                    const float gn[8] = {g0.x, g0.y, g0.z, g0.w, g1.x, g1.y, g1.z, g1.w};
#pragma unroll
                    for (int q = 0; q < 4; ++q) {
                        const float m0 = sigmoid_f(bflo(gav[q])) * (bflo(ov[q]) * rstd * gn[2 * q] * silu_f(bflo(rv[q]))) + sigmoid_f(bflo(gbv[q])) * (bflo(hwv[q]) * gelu_f(bflo(xgv[q])));
                        const float m1 = sigmoid_f(bfhi(gav[q])) * (bfhi(ov[q]) * rstd * gn[2 * q + 1] * silu_f(bfhi(rv[q]))) + sigmoid_f(bfhi(gbv[q])) * (bfhi(hwv[q]) * gelu_f(bfhi(xgv[q])));
                        ow[q] = pk2(m0, m1); }
                    *(u32x4*)(GA + t * 2048 + chc) = (u32x4){ow[0], ow[1], ow[2], ow[3]}; }
            }
        }
#undef LRU_LOADX
        if (!FINAL) { if (q4 == 0) CAR[(size_t)((b * 8 + n) * 4 + sg) * 128 + wave * 16 + c16] = (f32x2){aseg, hc}; }
        __syncthreads();
    }
}

__device__ __forceinline__ void phase_gla_prep(const Params& p, LAS unsigned char* lds, int G) {
    const int tid = threadIdx.x;
    LAS float* segt = (LAS float*)lds;
    bf16* QKV = (bf16*)(p.ws + WS_QKV); const bf16* AL = (const bf16*)(p.ws + WS_ALOW); float* DK = (float*)(p.ws + WS_DK);
    const int kp = tid & 127, seg = tid >> 7;
    for (int it = blockIdx.x; it < 8 * 128 * 4; it += G) {
        const int h = it & 3, ch = (it >> 2) & 127, b = it >> 9;
        float wa[16];
#pragma unroll
        for (int r = 0; r < 16; ++r) wa[r] = p.w_alpha[r * 512 + h * 128 + kp];
        const float balpha = p.b_alpha[h * 128 + kp];
        const size_t t0 = (size_t)b * SEQ + ch * 64 + seg * 16;
        float qv[16], kv[16];
#pragma unroll
        for (int i = 0; i < 16; ++i) { qv[i] = bf2f(QKV[(t0 + i) * 2048 + h * 128 + kp]); kv[i] = bf2f(QKV[(t0 + i) * 2048 + 512 + h * 128 + kp]); }
        float cl[16]; float run = 0.f;
#pragma unroll
        for (int i = 0; i < 16; ++i) { const size_t t = t0 + i;
            const u32x4 a0 = *(const u32x4*)(AL + t * 16), a1 = *(const u32x4*)(AL + t * 16 + 8);
            float z = balpha;
            z += bflo(a0.x) * wa[0] + bfhi(a0.x) * wa[1] + bflo(a0.y) * wa[2] + bfhi(a0.y) * wa[3] + bflo(a0.z) * wa[4] + bfhi(a0.z) * wa[5] + bflo(a0.w) * wa[6] + bfhi(a0.w) * wa[7];
            z += bflo(a1.x) * wa[8] + bfhi(a1.x) * wa[9] + bflo(a1.y) * wa[10] + bfhi(a1.y) * wa[11] + bflo(a1.z) * wa[12] + bfhi(a1.z) * wa[13] + bflo(a1.w) * wa[14] + bfhi(a1.w) * wa[15];
            const float ls = fminf(z, 0.f) - __logf(1.f + __expf(-fabsf(z)));
            run += ls * (1.f / 16.f); cl[i] = run; }
        __syncthreads();
        segt[seg * 128 + kp] = run;
        __syncthreads();
        float off = 0.f, tot = 0.f;
#pragma unroll
        for (int s = 0; s < 4; ++s) { const float v = segt[s * 128 + kp]; tot += v; if (s < seg) off += v; }
        if (seg == 0) DK[(size_t)(b * 128 + ch) * 512 + h * 128 + kp] = __expf(tot);
#pragma unroll
        for (int i = 0; i < 16; ++i) { const float cum = cl[i] + off;
            QKV[(t0 + i) * 2048 + h * 128 + kp] = (bf16)f2bf(qv[i] * 0.08838834764831845f * __expf(cum));
            QKV[(t0 + i) * 2048 + 512 + h * 128 + kp] = (bf16)f2bf(kv[i] * __expf(-cum)); }
    }
}
__device__ __forceinline__ void phase_gla_seq(const Params& p, LAS unsigned char* lds, int G) {
    const int tid = threadIdx.x, lane = tid & 63, wave = __builtin_amdgcn_readfirstlane(tid >> 6), q4 = lane >> 4, c16 = lane & 15;
    constexpr int PQ = 136, PS = 72;
    LAS bf16* Qs = (LAS bf16*)lds;
    LAS bf16* Kd = Qs + 64 * PQ;
    LAS bf16* KdT = Kd + 64 * PQ;
    LAS bf16* VT = KdT + 128 * PS;
    LAS bf16* Pm = VT + 32 * PS;
    LAS bf16* ST = Pm + 64 * PS;
    LAS float* dk = (LAS float*)(ST + 32 * PQ);
    const bf16* QKV = (const bf16*)(p.ws + WS_QKV); bf16* VO = (bf16*)(p.ws + WS_QKV); const float* DK = (const float*)(p.ws + WS_DK); float* SS = (float*)(p.ws + WS_SS);
    const int kp = tid & 127, seg = tid >> 7;
    const int vv = tid & 31, sg = tid >> 5;
    const int r0 = tid >> 4, cc = (tid & 15) * 8;
    for (int it = blockIdx.x; it < 8 * 4 * 8; it += G) {
        const int v8 = it & 7, h = (it >> 3) & 3, b = it >> 5;
        pg8::f32x4 sacc[2] = {(pg8::f32x4){0.f, 0.f, 0.f, 0.f}, (pg8::f32x4){0.f, 0.f, 0.f, 0.f}};
        __syncthreads();
        for (int i = tid; i < 32 * PQ / 2; i += NTHR) ((LAS unsigned*)ST)[i] = 0u;
        u32x4 rq[2], rk[2]; unsigned rkt[8], rv[2]; float rdk = 0.f;
#define GLA_LOAD(chn) do { const size_t _t0 = (size_t)b * SEQ + (size_t)(chn) * 64; \
            _Pragma("unroll") for (int _j = 0; _j < 2; ++_j) { rq[_j] = *(const u32x4*)(QKV + (_t0 + r0 + 32 * _j) * 2048 + h * 128 + cc); rk[_j] = *(const u32x4*)(QKV + (_t0 + r0 + 32 * _j) * 2048 + 512 + h * 128 + cc); } \
            _Pragma("unroll") for (int _i = 0; _i < 8; ++_i) { const unsigned _lo = QKV[(_t0 + seg * 16 + 2 * _i) * 2048 + 512 + h * 128 + kp], _hi = QKV[(_t0 + seg * 16 + 2 * _i + 1) * 2048 + 512 + h * 128 + kp]; rkt[_i] = _lo | (_hi << 16); } \
            _Pragma("unroll") for (int _i = 0; _i < 2; ++_i) { const unsigned _lo = QKV[(_t0 + sg * 4 + 2 * _i) * 2048 + 1024 + h * 256 + v8 * 32 + vv], _hi = QKV[(_t0 + sg * 4 + 2 * _i + 1) * 2048 + 1024 + h * 256 + v8 * 32 + vv]; rv[_i] = _lo | (_hi << 16); } \
            if (tid < 128) rdk = DK[(size_t)(b * 128 + (chn)) * 512 + h * 128 + tid]; } while (0)
        GLA_LOAD(0);
#pragma unroll 1
        for (int ch = 0; ch < SEQ / 64; ++ch) {
            const size_t t0 = (size_t)b * SEQ + ch * 64;
#pragma unroll
            for (int j = 0; j < 2; ++j) { *(LAS u32x4*)(Qs + (r0 + 32 * j) * PQ + cc) = rq[j]; *(LAS u32x4*)(Kd + (r0 + 32 * j) * PQ + cc) = rk[j]; }
            *(LAS u32x4*)(KdT + kp * PS + seg * 16) = (u32x4){rkt[0], rkt[1], rkt[2], rkt[3]};
            *(LAS u32x4*)(KdT + kp * PS + seg * 16 + 8) = (u32x4){rkt[4], rkt[5], rkt[6], rkt[7]};
            *(LAS u32x2*)(VT + vv * PS + sg * 4) = (u32x2){rv[0], rv[1]};
            if (tid < 128) dk[tid] = rdk;
            if (ch + 1 < SEQ / 64) GLA_LOAD(ch + 1);
            __syncthreads();
            { const int tt = wave & 3;
#pragma unroll
              for (int i2 = 0; i2 < 2; ++i2) { const int ts = (wave >> 2) * 2 + i2;
                  pg8::f32x4 acc = (pg8::f32x4){0.f, 0.f, 0.f, 0.f};
                  if (ts <= tt) {
#pragma unroll
                      for (int ks = 0; ks < 4; ++ks) { const bf16x8_t a = *(const LAS bf16x8_t*)(Kd + (ts * 16 + c16) * PQ + ks * 32 + q4 * 8), bb = *(const LAS bf16x8_t*)(Qs + (tt * 16 + c16) * PQ + ks * 32 + q4 * 8);
                          acc = __builtin_amdgcn_mfma_f32_16x16x32_bf16(a, bb, acc, 0, 0, 0); }
                      const int tg = tt * 16 + c16, sgl = ts * 16 + q4 * 4;
#pragma unroll
                      for (int j = 0; j < 4; ++j) if (sgl + j > tg) acc[j] = 0.f;
                  }
                  *(LAS u32x2*)(Pm + (tt * 16 + c16) * PS + ts * 16 + q4 * 4) = (u32x2){pk2(acc[0], acc[1]), pk2(acc[2], acc[3])}; } }
            __syncthreads();
            { const int tt = wave & 3, tv = wave >> 2;
              pg8::f32x4 oacc = (pg8::f32x4){0.f, 0.f, 0.f, 0.f};
#pragma unroll
              for (int ks = 0; ks < 2; ++ks) { const bf16x8_t bb = *(const LAS bf16x8_t*)(Pm + (tt * 16 + c16) * PS + ks * 32 + q4 * 8), a = *(const LAS bf16x8_t*)(VT + (tv * 16 + c16) * PS + ks * 32 + q4 * 8);
                  oacc = __builtin_amdgcn_mfma_f32_16x16x32_bf16(a, bb, oacc, 0, 0, 0); }
#pragma unroll
              for (int ks = 0; ks < 4; ++ks) { const bf16x8_t bb = *(const LAS bf16x8_t*)(Qs + (tt * 16 + c16) * PQ + ks * 32 + q4 * 8), a = *(const LAS bf16x8_t*)(ST + (tv * 16 + c16) * PQ + ks * 32 + q4 * 8);
                  oacc = __builtin_amdgcn_mfma_f32_16x16x32_bf16(a, bb, oacc, 0, 0, 0); }
              *(u32x2*)(VO + (t0 + tt * 16 + c16) * 2048 + 1024 + h * 256 + v8 * 32 + tv * 16 + q4 * 4) = (u32x2){pk2(oacc[0], oacc[1]), pk2(oacc[2], oacc[3])};
              float sq = (oacc[0] * oacc[0] + oacc[1] * oacc[1]) + (oacc[2] * oacc[2] + oacc[3] * oacc[3]);
              sq += __shfl_xor(sq, 16); sq += __shfl_xor(sq, 32);
              if (q4 == 0) atomicAdd(SS + (t0 + tt * 16 + c16) * 4 + h, sq); }
#pragma unroll
            for (int ks = 0; ks < 2; ++ks) { const bf16x8_t a = *(const LAS bf16x8_t*)(KdT + (wave * 16 + c16) * PS + ks * 32 + q4 * 8);
#pragma unroll
                for (int tv = 0; tv < 2; ++tv) { const bf16x8_t bb = *(const LAS bf16x8_t*)(VT + (tv * 16 + c16) * PS + ks * 32 + q4 * 8);
                    sacc[tv] = __builtin_amdgcn_mfma_f32_16x16x32_bf16(a, bb, sacc[tv], 0, 0, 0); } }
            { const pg8::f32x4 d4 = *(const LAS pg8::f32x4*)(dk + wave * 16 + q4 * 4);
#pragma unroll
              for (int tv = 0; tv < 2; ++tv) sacc[tv] = sacc[tv] * d4; }
            __syncthreads();
#pragma unroll
            for (int tv = 0; tv < 2; ++tv) *(LAS u32x2*)(ST + (tv * 16 + c16) * PQ + wave * 16 + q4 * 4) = (u32x2){pk2(sacc[tv][0], sacc[tv][1]), pk2(sacc[tv][2], sacc[tv][3])};
        }
#undef GLA_LOAD
    }
}

__device__ __forceinline__ void phase_norm2(const Params& p, LAS unsigned char* lds, int G) {
    const int tid = threadIdx.x, lane = tid & 63, wave = __builtin_amdgcn_readfirstlane(tid >> 6);
    const float* modp = (const float*)(p.ws + WS_MODP);
    LAS float* g1 = (LAS float*)lds; LAS float* gs = g1 + 1024; LAS float* sh = gs + 1024;
    const bf16* Y = (const bf16*)(p.ws + WS_Y); bf16* H2 = (bf16*)(p.ws + WS_H2);
    for (int tile = blockIdx.x; tile < T / 256; tile += G) {
        const int b = tile / 32;
        __syncthreads();
        for (int k = tid; k < 1024; k += NTHR) { g1[k] = mod_at(modp, b, 2048 + k) * p.npo[k]; gs[k] = p.npf[k] * (1.f + mod_at(modp, b, 4096 + k)); sh[k] = mod_at(modp, b, 3072 + k); }
        __syncthreads();
        for (int rr = 0; rr < 32; ++rr) {
            const size_t row = (size_t)tile * 256 + wave * 32 + rr;
            const f32x4* xr = (const f32x4*)(p.x + row * 1024) + lane; const u32x2* yr = (const u32x2*)(Y + row * 1024) + lane;
            f32x4 xv[4], yv[4]; float s = 0.f;
#pragma unroll
            for (int j = 0; j < 4; ++j) { xv[j] = xr[64 * j]; const u32x2 yw = yr[64 * j]; yv[j] = (f32x4){bflo(yw.x), bfhi(yw.x), bflo(yw.y), bfhi(yw.y)};
                s += (yv[j].x * yv[j].x + yv[j].y * yv[j].y) + (yv[j].z * yv[j].z + yv[j].w * yv[j].w); }
            const float rstd = __builtin_amdgcn_rsqf(wave_sum(s) * (1.f / 1024.f) + 1e-6f);
            float s2 = 0.f;
            f32x4* orow = (f32x4*)(p.out + row * 1024) + lane;
#pragma unroll
            for (int j = 0; j < 4; ++j) { const int k = 256 * j + 4 * lane; const f32x4 g4 = *(const LAS f32x4*)(g1 + k);
                xv[j] = xv[j] + yv[j] * rstd * g4; orow[64 * j] = xv[j];
                s2 += (xv[j].x * xv[j].x + xv[j].y * xv[j].y) + (xv[j].z * xv[j].z + xv[j].w * xv[j].w); }
            const float rstd2 = __builtin_amdgcn_rsqf(wave_sum(s2) * (1.f / 1024.f) + 1e-6f);
            u32x2* o8 = (u32x2*)(H2 + row * 1024) + lane;
#pragma unroll
            for (int j = 0; j < 4; ++j) { const int k = 256 * j + 4 * lane; const f32x4 g4 = *(const LAS f32x4*)(gs + k), s4 = *(const LAS f32x4*)(sh + k);
                u32x2 w; w.x = pk2(xv[j].x * rstd2 * g4.x + s4.x, xv[j].y * rstd2 * g4.y + s4.y); w.y = pk2(xv[j].z * rstd2 * g4.z + s4.z, xv[j].w * rstd2 * g4.w + s4.w);
                o8[64 * j] = w; }
        }
    }
}

__device__ __forceinline__ unsigned h16_key(unsigned b) { return (b & 0x8000u) ? (~b & 0xffffu) : (b | 0x8000u); }
__device__ __forceinline__ float h16_key_val(unsigned s) { const unsigned b = (s & 0x8000u) ? (s & 0x7fffu) : (~s & 0xffffu); return (float)__builtin_bit_cast(_Float16, (unsigned short)b); }
template <bool ASC> __device__ __forceinline__ void sort16(unsigned (&k)[16]) {
#pragma unroll
    for (int size = 2; size <= 16; size <<= 1)
#pragma unroll
        for (int stride = size >> 1; stride > 0; stride >>= 1)
#pragma unroll
            for (int i = 0; i < 16; ++i) { const int j = i ^ stride; if (j > i) { const bool up = ((i & size) == 0) == ASC; const unsigned lo = min(k[i], k[j]), hi = max(k[i], k[j]); k[i] = up ? lo : hi; k[j] = up ? hi : lo; } }
}
__device__ __forceinline__ void merge16_desc(unsigned (&k)[16]) {
#pragma unroll
    for (int stride = 8; stride > 0; stride >>= 1)
#pragma unroll
        for (int i = 0; i < 16; ++i) { const int j = i ^ stride; if (j > i) { const unsigned lo = min(k[i], k[j]), hi = max(k[i], k[j]); k[i] = hi; k[j] = lo; } }
}
__device__ __forceinline__ void top16_merge(unsigned (&top)[16], unsigned (&grp)[16]) {
    sort16<true>(grp);
#pragma unroll
    for (int i = 0; i < 16; ++i) top[i] = max(top[i], grp[i]);
    merge16_desc(top);
}
__device__ __forceinline__ void keys16(unsigned (&k)[16], const u32x4 w0, const u32x4 w1, int n0) {
    const unsigned ww[8] = {w0.x, w0.y, w0.z, w0.w, w1.x, w1.y, w1.z, w1.w};
#pragma unroll
    for (int q = 0; q < 8; ++q) { k[2 * q] = (h16_key(ww[q] & 0xffffu) << 16) | (unsigned)(127 - (n0 + 2 * q)); k[2 * q + 1] = (h16_key(ww[q] >> 16) << 16) | (unsigned)(127 - (n0 + 2 * q + 1)); }
}
__device__ __forceinline__ void phase_topk(const Params& p, LAS unsigned char* lds, int G) {
    const int tid = threadIdx.x;
    const unsigned short* SC = (const unsigned short*)(p.ws + WS_SC); unsigned* TK = (unsigned*)(p.ws + WS_TOPK); float* TK2 = (float*)(p.ws + WS_TOPK2);
    const float* SU = (const float*)(p.ws + WS_SU); const float* SV = (const float*)(p.ws + WS_SV);
    LAS unsigned* my = (LAS unsigned*)lds + tid * 33;
    for (int blk = blockIdx.x; blk < T * 8 / NTHR; blk += G) {
        const int item = blk * NTHR + tid, t = item >> 3, h = item & 7;
        const u32x4* src = (const u32x4*)(SC + (size_t)t * 2048 + h * 256);
        unsigned topA[16], topB[16];
        keys16(topA, src[0], src[1], 0); sort16<false>(topA);
#pragma unroll 1
        for (int g = 1; g < 8; ++g) { unsigned grp[16]; keys16(grp, src[2 * g], src[2 * g + 1], 16 * g); top16_merge(topA, grp); }
        keys16(topB, src[16], src[17], 0); sort16<false>(topB);
#pragma unroll 1
        for (int g = 1; g < 8; ++g) { unsigned grp[16]; keys16(grp, src[16 + 2 * g], src[17 + 2 * g], 16 * g); top16_merge(topB, grp); }
        float fa[16], fb[16];
#pragma unroll
        for (int j = 0; j < 16; ++j) { fa[j] = h16_key_val(topA[j] >> 16); fb[j] = h16_key_val(topB[j] >> 16); my[j] = 127u - (topA[j] & 127u); my[16 + j] = 127u - (topB[j] & 127u); }
        unsigned ct[16];
#pragma unroll
        for (int g = 0; g < 4; ++g) { unsigned grp[16];
#pragma unroll
            for (int s = 0; s < 16; ++s) grp[s] = 0u;
            { int slot = 0;
#pragma unroll
              for (int i = 0; i < 16; ++i)
#pragma unroll
                  for (int j = 0; j < 16; ++j) if ((i + 1) * (j + 1) <= 16) { if ((slot >> 4) == g) {
                      const float s = fa[i] + fb[j]; unsigned u = __builtin_bit_cast(unsigned, s); u ^= (u >> 31) ? 0xffffffffu : 0x80000000u;
                      grp[slot & 15] = (u & 0xffffff00u) | (unsigned)(255 - (i * 16 + j)); } ++slot; } }
            if (g == 0) { sort16<false>(grp);
#pragma unroll
                for (int s = 0; s < 16; ++s) ct[s] = grp[s]; }
            else top16_merge(ct, grp); }
        float val[16], mx, sum = 0.f;
#pragma unroll
        for (int m = 0; m < 16; ++m) { unsigned u = ct[m] & 0xffffff00u; u ^= (u >> 31) ? 0x80000000u : 0xffffffffu; val[m] = __builtin_bit_cast(float, u); }
        mx = val[0];
#pragma unroll
        for (int m = 0; m < 16; ++m) { val[m] = __expf(val[m] - mx); sum += val[m]; }
        const float inv = 1.f / sum;
        LDS_WAIT();
        unsigned outw[16]; float outs[16];
#pragma unroll
        for (int m = 0; m < 16; ++m) { const unsigned pos = 255u - (ct[m] & 255u), i = pos >> 4, j = pos & 15u;
            const unsigned e = my[i] * 128u + my[16 + j];
            outw[m] = (e << 16) | f2bf(val[m] * inv * SV[e]); outs[m] = SU[e]; }
        u32x4* dst = (u32x4*)(TK + (size_t)item * 16); f32x4* dst2 = (f32x4*)(TK2 + (size_t)item * 16);
#pragma unroll
        for (int q = 0; q < 4; ++q) { dst[q] = (u32x4){outw[4 * q], outw[4 * q + 1], outw[4 * q + 2], outw[4 * q + 3]}; dst2[q] = (f32x4){outs[4 * q], outs[4 * q + 1], outs[4 * q + 2], outs[4 * q + 3]}; }
    }
}

typedef unsigned u32x3 __attribute__((ext_vector_type(3)));
typedef unsigned u32x6 __attribute__((ext_vector_type(6)));
typedef float f32x32 __attribute__((ext_vector_type(32)));
__device__ __forceinline__ float rdlane(float v, int l) { return __builtin_bit_cast(float, __builtin_amdgcn_readlane(__builtin_bit_cast(int, v), l)); }
__device__ __forceinline__ f32x32 fp6x2(u32x3 a, u32x3 b) { const u32x6 s = {a.x, a.y, a.z, b.x, b.y, b.z}; return __builtin_amdgcn_cvt_scalef32_pk32_f32_fp6(s, 1.0f); }
__device__ __forceinline__ void phase_gather(const Params& p, LAS unsigned char* lds, int G) {
    const int tid = threadIdx.x, lane = tid & 63, wave = __builtin_amdgcn_readfirstlane(tid >> 6);
    const float* modp = (const float*)(p.ws + WS_MODP);
    LAS float* g2 = (LAS float*)lds;
    const bf16* H2 = (const bf16*)(p.ws + WS_H2); const unsigned* TK = (const unsigned*)(p.ws + WS_TOPK); const float* TK2 = (const float*)(p.ws + WS_TOPK2);
    const unsigned char* U6 = p.ws + WS_U; const unsigned char* V6 = p.ws + WS_V;
    for (int tile = blockIdx.x; tile < T / 256; tile += G) {
        const int b = tile / 32;
        __syncthreads();
        for (int k = tid; k < 1024; k += NTHR) g2[k] = mod_at(modp, b, 5120 + k) * p.npof[k];
        __syncthreads();
#pragma unroll 1
        for (int rr = 0; rr < 32; ++rr) {
            const size_t row = (size_t)tile * 256 + wave * 32 + rr;
            float xt[16];
            { const u32x4 a = *(const u32x4*)(H2 + row * 1024 + lane * 16), c = *(const u32x4*)(H2 + row * 1024 + lane * 16 + 8);
              xt[0] = bflo(a.x); xt[1] = bfhi(a.x); xt[2] = bflo(a.y); xt[3] = bfhi(a.y); xt[4] = bflo(a.z); xt[5] = bfhi(a.z); xt[6] = bflo(a.w); xt[7] = bfhi(a.w);
              xt[8] = bflo(c.x); xt[9] = bfhi(c.x); xt[10] = bflo(c.y); xt[11] = bfhi(c.y); xt[12] = bflo(c.z); xt[13] = bfhi(c.z); xt[14] = bflo(c.w); xt[15] = bfhi(c.w); }
            float acc[16];
#pragma unroll
            for (int j = 0; j < 16; ++j) acc[j] = 0.f;
#pragma unroll 1
            for (int hh = 0; hh < 16; ++hh) {
                const u32x4* ra = (const u32x4*)(TK + row * 128 + hh * 8);
                const u32x4 w0 = ra[0], w1 = ra[1];
                const unsigned ww[8] = {w0.x, w0.y, w0.z, w0.w, w1.x, w1.y, w1.z, w1.w};
                u32x6 up[4], vp[4];
#pragma unroll
                for (int m = 0; m < 8; ++m) { const size_t eo = (size_t)((unsigned)__builtin_amdgcn_readfirstlane((int)ww[m]) >> 16) * 768 + lane * 12;
                    const u32x3 a = *(const u32x3*)(U6 + eo), c = *(const u32x3*)(V6 + eo);
                    if (m & 1) { up[m >> 1][3] = a.x; up[m >> 1][4] = a.y; up[m >> 1][5] = a.z; vp[m >> 1][3] = c.x; vp[m >> 1][4] = c.y; vp[m >> 1][5] = c.z; }
                    else { up[m >> 1][0] = a.x; up[m >> 1][1] = a.y; up[m >> 1][2] = a.z; vp[m >> 1][0] = c.x; vp[m >> 1][1] = c.y; vp[m >> 1][2] = c.z; } }
                const unsigned wa = TK[row * 128 + hh * 8 + (lane >> 3)]; const float su = TK2[row * 128 + hh * 8 + (lane >> 3)];
                float pd[8];
#pragma unroll
                for (int m = 0; m < 8; m += 2) { const f32x32 f = __builtin_amdgcn_cvt_scalef32_pk32_f32_fp6(up[m >> 1], 1.0f);
                    float s0 = 0.f, s1 = 0.f;
#pragma unroll
                    for (int j = 0; j < 16; ++j) { s0 += xt[j] * f[j]; s1 += xt[j] * f[16 + j]; }
                    pd[m] = s0; pd[m + 1] = s1; __builtin_amdgcn_sched_barrier(0); }
#pragma unroll
                for (int j = 0; j < 4; ++j) { const bool up_ = (lane & 32) != 0; const float keep = up_ ? pd[j + 4] : pd[j], send = up_ ? pd[j] : pd[j + 4]; pd[j] = keep + __shfl_xor(send, 32); }
#pragma unroll
                for (int j = 0; j < 2; ++j) { const bool up_ = (lane & 16) != 0; const float keep = up_ ? pd[j + 2] : pd[j], send = up_ ? pd[j] : pd[j + 2]; pd[j] = keep + __shfl_xor(send, 16); }
                { const bool up_ = (lane & 8) != 0; const float keep = up_ ? pd[1] : pd[0], send = up_ ? pd[0] : pd[1]; pd[0] = keep + __shfl_xor(send, 8); }
                float d = pd[0]; d += __shfl_xor(d, 4); d += __shfl_xor(d, 2); d += __shfl_xor(d, 1);
                const float coef = bflo(wa) * gelu_f(su * d);
#pragma unroll
                for (int m = 0; m < 8; m += 2) { const f32x32 f = __builtin_amdgcn_cvt_scalef32_pk32_f32_fp6(vp[m >> 1], 1.0f); const float c0 = rdlane(coef, 8 * m), c1 = rdlane(coef, 8 * m + 8);
#pragma unroll
                    for (int j = 0; j < 16; ++j) acc[j] += c0 * f[j] + c1 * f[16 + j];
                    __builtin_amdgcn_sched_barrier(0); }
            }
            float s = 0.f;
#pragma unroll
            for (int j = 0; j < 16; ++j) s += acc[j] * acc[j];
            const float rstd = __builtin_amdgcn_rsqf(wave_sum(s) * (1.f / 1024.f) + 1e-6f);
            float* orow = p.out + row * 1024 + lane * 16;
#pragma unroll
            for (int q = 0; q < 4; ++q) { f32x4 o = *(const f32x4*)(orow + 4 * q); const f32x4 ga = *(const LAS f32x4*)(g2 + lane * 16 + 4 * q);
                o.x += ga.x * acc[4 * q] * rstd; o.y += ga.y * acc[4 * q + 1] * rstd; o.z += ga.z * acc[4 * q + 2] * rstd; o.w += ga.w * acc[4 * q + 3] * rstd;
                *(f32x4*)(orow + 4 * q) = o; }
        }
    }
}

#define XB_TMO      128
#define XB_XCNT(j)  (256  + 64 * (j))
#define XB_XSUB(j)  (1280 + 64 * (j))
#define XB_XGEN(j)  (2304 + 64 * (j))
#define XB_TOP      3328
#define XB_TOPGEN   3392
#define XCD_BAR_WORDS 3456
#define XB_SPIN_CAP (1u << 18)

__device__ __forceinline__ unsigned xb_ld(unsigned* p)              { return __hip_atomic_load(p, __ATOMIC_RELAXED, __HIP_MEMORY_SCOPE_AGENT); }
__device__ __forceinline__ unsigned xb_add(unsigned* p, unsigned v) { return __hip_atomic_fetch_add(p, v, __ATOMIC_RELAXED, __HIP_MEMORY_SCOPE_AGENT); }
__device__ __forceinline__ unsigned xb_xcc_id() { return (unsigned)__builtin_amdgcn_s_getreg((3 << 11) | 20) & 0xFu; }
#define XB_SPIN(cond, bar) do { unsigned _sp = 0; while (cond) { __builtin_amdgcn_s_sleep(1); \
    if ((++_sp & 255u) == 0u) { if (xb_ld(&(bar)[XB_TMO])) break; if (_sp > XB_SPIN_CAP) { atomicAdd(&(bar)[XB_TMO], 1u); break; } } } } while (0)

struct XcdBarrier {
    unsigned* bar; unsigned x;
    volatile LAS unsigned* st;
};

__device__ __forceinline__ XcdBarrier xcd_barrier_post(unsigned* bar, volatile LAS unsigned* st) {
    XcdBarrier b; b.bar = bar; b.x = xb_xcc_id(); b.st = st;
    if (threadIdx.x == 0) (void)xb_add(&bar[XB_XCNT(b.x)], 1u);
    return b;
}
__device__ __forceinline__ void xcd_barrier_complete(unsigned* bar, unsigned x, unsigned& nloc, unsigned& nx) {
    const unsigned G = gridDim.x * gridDim.y * gridDim.z;
    unsigned sum, cnt, mine, sp = 0u;
    for (;;) {
        sum = 0u; cnt = 0u; mine = 0u;
#pragma unroll
        for (unsigned j = 0; j < 16; ++j) { const unsigned c = xb_ld(&bar[XB_XCNT(j)]); sum += c; cnt += (c > 0u) ? 1u : 0u; mine = (j == x) ? c : mine; }
        if (sum == G) break;
        __builtin_amdgcn_s_sleep(1);
        if ((++sp & 255u) == 0u) { if (xb_ld(&bar[XB_TMO])) break; if (sp > XB_SPIN_CAP) { atomicAdd(&bar[XB_TMO], 1u); break; } }
    }
    nloc = mine > 0u ? mine : 1u; nx = cnt > 0u ? cnt : 1u;
}

__device__ __forceinline__ void xcd_barrier(const XcdBarrier& b) {
    asm volatile("s_waitcnt vmcnt(0)" ::: "memory");
    __syncthreads();
    if (threadIdx.x == 0) {
        unsigned* bar = b.bar;
        __builtin_amdgcn_s_waitcnt(0);
        unsigned nloc = b.st[0], nx = b.st[1];
        if (nloc == 0u) { xcd_barrier_complete(bar, b.x, nloc, nx); b.st[0] = nloc; b.st[1] = nx; }
        const unsigned old = xb_add(&bar[XB_XSUB(b.x)], 1u);
        const unsigned gen = old / nloc;
        if (old + 1u == (gen + 1u) * nloc) {
            __builtin_amdgcn_fence(__ATOMIC_RELEASE, "agent");
            asm volatile("s_waitcnt vmcnt(0)" ::: "memory");
            const unsigned og = xb_add(&bar[XB_TOP], 1u);
            const unsigned tg = og / nx;
            if (og + 1u == (tg + 1u) * nx) xb_add(&bar[XB_TOPGEN], 1u);
            else XB_SPIN(xb_ld(&bar[XB_TOPGEN]) == tg, bar);
            __builtin_amdgcn_fence(__ATOMIC_ACQUIRE, "agent");
            xb_add(&bar[XB_XGEN(b.x)], 1u);
            asm volatile("s_waitcnt vmcnt(0)" ::: "memory");
        } else {
            XB_SPIN(xb_ld(&bar[XB_XGEN(b.x)]) == gen, bar);
            __builtin_amdgcn_fence(__ATOMIC_ACQUIRE, "agent");
            asm volatile("s_waitcnt vmcnt(0)" ::: "memory");
        }
    }
    __syncthreads();
}


template <int PH>
__device__ __forceinline__ void run_phase(const Params& p, LAS unsigned char* lds, int G) {
    unsigned char* ws = p.ws;
    if constexpr (PH == 0) phase0(p, lds, G);
    else if constexpr (PH == 1) phase1(p, lds, G);
    else if constexpr (PH == 2) { pg8::Gemm g{(const bf16*)p.out, (const bf16*)(ws + WS_WIN), T, NPAD, 1024, 1024}; pg8::StaticOrder S; S.init(T, NPAD, G, (int)blockIdx.x);
        EpiSeg E{ws}; pg8::gemm_phase<EpiSeg, pg8::StaticOrder, true, true, 0, 1024, 1024>(lds, g, S, E); }
    else if constexpr (PH == 3) { phase_gla_prep(p, lds, G); __syncthreads(); phase_lru<false>(p, lds, G); }
    else if constexpr (PH == 4) phase_gla_seq(p, lds, G);
    else if constexpr (PH == 5) phase_lru<true>(p, lds, G);
    else if constexpr (PH == 6) { pg8::Gemm g{(const bf16*)(ws + WS_GAGB), (const bf16*)(ws + WS_WOUT), T, 1024, 1024, 2048}; pg8::StaticOrder S; S.init(T, 1024, G, (int)blockIdx.x);
        EpiPlain E{(bf16*)(ws + WS_Y), 1024}; pg8::gemm_phase<EpiPlain, pg8::StaticOrder, true, true, 0, 1024, 2048>(lds, g, S, E); }
    else if constexpr (PH == 7) phase_norm2(p, lds, G);
    else if constexpr (PH == 8) { pg8::Gemm g{(const bf16*)(ws + WS_H2), (const bf16*)(ws + WS_WQ), T, 2048, 1024, 1024}; pg8::StaticOrder S; S.init(T, 2048, G, (int)blockIdx.x);
        EpiPlain E{(bf16*)(ws + WS_QRY), 2048}; pg8::gemm_phase<EpiPlain, pg8::StaticOrder, true, true, 0, 1024, 1024>(lds, g, S, E); }
    else if constexpr (PH == 9) { pg8::Gemm g{(const bf16*)(ws + WS_QRY), (const bf16*)(ws + WS_SUBK), T, 2048, 256, 2048}; pg8::StaticOrder S; S.init(T, 2048, G, (int)blockIdx.x);
        EpiF16 E{(unsigned short*)(ws + WS_SC), 2048}; pg8::gemm_phase<EpiF16, pg8::StaticOrder, true, true, 2, 256, 2048>(lds, g, S, E); }
    else if constexpr (PH == 10) phase_topk(p, lds, G);
    else if constexpr (PH == 11) phase_gather(p, lds, G);
}
template <int PH>
__global__ void __launch_bounds__(NTHR, 2) k_phase(Params p) {
    extern __shared__ __attribute__((aligned(16))) unsigned char lds_raw[];
    run_phase<PH>(p, (LAS unsigned char*)lds_raw, (int)gridDim.x);
}
constexpr int LDS_BAR_OFF = LDS_BYTES - 16;
template <int PH>
__device__ __forceinline__ void run_from(const Params& p, LAS unsigned char* lds, int G, const XcdBarrier& bar) {
#if PROBE_PH >= 0
    unsigned long long pt0 = 0; if constexpr (PH == PROBE_PH) pt0 = __builtin_amdgcn_s_memrealtime();
#endif
    run_phase<PH>(p, lds, G);
    if constexpr (PH + 1 < N_PHASES) {
        if constexpr (PH == 0) cg::this_grid().sync();
        else xcd_barrier(bar);
    }
#if PROBE_PH >= 0
    if constexpr (PH == PROBE_PH) { const unsigned long long pt1 = __builtin_amdgcn_s_memrealtime(), span = pt1 - pt0;
        while (__builtin_amdgcn_s_memrealtime() - pt1 < (unsigned long long)PROBE_MULT * span) __builtin_amdgcn_s_sleep(8); }
#endif
    if constexpr (PH + 1 < N_PHASES) run_from<PH + 1>(p, lds, G, bar);
}
__global__ void __launch_bounds__(NTHR, 2) k_mega(Params p) {
    extern __shared__ __attribute__((aligned(16))) unsigned char lds_raw[];
    LAS unsigned char* lds = (LAS unsigned char*)lds_raw;
    if (threadIdx.x < 4) ((LAS unsigned*)(lds + LDS_BAR_OFF))[threadIdx.x] = 0u;
    __syncthreads();
    const XcdBarrier bar = xcd_barrier_post((unsigned*)(p.ws + WS_CTL), (volatile LAS unsigned*)(lds + LDS_BAR_OFF));
    run_from<0>(p, lds, (int)gridDim.x, bar);
}

extern "C" void kernel_launch(void* const* d_in, const int* in_sizes, int n_in, void* d_out, int out_size, void* d_ws, size_t ws_size, hipStream_t stream) {
    static int grid = 0;
    if (grid == 0) {
        if (n_in != 24 || in_sizes[0] != T * DM || out_size != T * DM || ws_size < WS_END) {
            fprintf(stderr, "kernel_launch: unexpected shapes: n_in %d in0 %d out %d ws %zu\n", n_in, n_in > 0 ? in_sizes[0] : -1, out_size, ws_size); grid = -1; return; }
        int dev = 0, cus = 0, per_cu = 0;
        if (hipGetDevice(&dev) != hipSuccess || hipDeviceGetAttribute(&cus, hipDeviceAttributeMultiprocessorCount, dev) != hipSuccess) { grid = -1; return; }
        if (hipFuncSetAttribute((const void*)k_mega, hipFuncAttributeMaxDynamicSharedMemorySize, LDS_BYTES) != hipSuccess) { fprintf(stderr, "kernel_launch: hipFuncSetAttribute failed\n"); grid = -1; return; }
        if (hipOccupancyMaxActiveBlocksPerMultiprocessor(&per_cu, (const void*)k_mega, NTHR, LDS_BYTES) != hipSuccess || per_cu < 1) { fprintf(stderr, "kernel_launch: occupancy query says %d blocks per CU\n", per_cu); grid = -1; return; }
        (void)hipGetLastError();
        grid = cus;
    }
    if (grid < 0) return;
    Params p{};
    const float** pp = (const float**)&p;
    for (int i = 0; i < 24; ++i) pp[i] = (const float*)d_in[i];
    p.out = (float*)d_out; p.ws = (unsigned char*)d_ws;
    if (hipMemsetAsync((char*)d_ws + WS_CTL, 0, 65536, stream) != hipSuccess) { fprintf(stderr, "kernel_launch: hipMemsetAsync failed\n"); return; }
    void* args[] = {&p};
    hipError_t e = hipLaunchCooperativeKernel((const void*)k_mega, dim3(grid), dim3(NTHR), args, LDS_BYTES, stream);
    if (e != hipSuccess) fprintf(stderr, "kernel_launch: cooperative launch failed: %s (grid %d)\n", hipGetErrorString(e), grid);
}
```

```cpp
#include <hip/hip_runtime.h>
#include <hip/hip_cooperative_groups.h>
#include <cstdio>
#include <cstdint>
#include <utility>
namespace cg = cooperative_groups;

namespace pg8 {
#define PG8_LAS __attribute__((address_space(3)))
typedef unsigned short bf16_t;
typedef short bf16x8 __attribute__((ext_vector_type(8)));
typedef float f32x4 __attribute__((ext_vector_type(4)));
typedef unsigned u32x4 __attribute__((ext_vector_type(4)));
constexpr int BM = 256, BK = 64, HALF = 128, HTB = HALF * BK * 2  , STAGE_BYTES = 8 * HTB, NXCD = 8, WGM = 8;

__host__ __device__ __forceinline__ int lds_byte(int r, int c) { const int st = (r >> 4) * 2 + (c >> 5), rr = r & 15, cc = c & 31, ob = rr * 64 + cc * 2; return st * 1024 + (ob ^ (((ob >> 9) & 1) << 5)); }
__host__ __device__ __forceinline__ void stage_rc(int b, int& R, int& C) { const int st = b / 1024, sb = b % 1024, swz = sb ^ (((sb >> 9) & 1) << 5); R = (st >> 1) * 16 + swz / 64; C = (st & 1) * 32 + (swz % 64) / 2; }
__host__ __device__ __forceinline__ int perm32(int rho) { const int n = rho >> 4, i = rho & 15; return 8 * (i >> 2) + 4 * n + (i & 3); }

struct Unit { int pm, pn; };
struct Gemm { const bf16_t* A; const bf16_t* Bt; int M, N, K, lda; };
template <int AMODE> __device__ __forceinline__ size_t a_off_bytes(const Gemm& g, const Unit& u) {
    const int ac = AMODE == 0 ? 0 : (AMODE == 1 ? 128 * (u.pn < 6 ? u.pn : 6) : 256 * u.pn);
    return ((size_t)u.pm * BM * (size_t)g.lda + (size_t)ac) * 2;
}

struct StaticOrder {
    int nM, nN, nwg, G, c;
    __host__ __device__ void init(int M, int N, int G_, int c_) { nM = M / BM; nN = N / BM; nwg = nM * nN; G = G_; c = c_; }
    __host__ __device__ bool next(int i, Unit& u) const {
        const long L = (long)i * G + c; if (L >= nwg) return false;
        int wgid = (int)L; { const int q = nwg / NXCD, r = nwg % NXCD, xcd = wgid % NXCD, off = wgid / NXCD; wgid = (xcd < r ? xcd * (q + 1) : r * (q + 1) + (xcd - r) * q) + off; }
        const int nig = WGM * nN, gid = wgid / nig, fm = gid * WGM, gsz = (nM - fm) < WGM ? (nM - fm) : WGM;
        u.pm = fm + ((wgid % nig) % gsz); u.pn = (wgid % nig) / gsz; return true;
    }
    __device__ __forceinline__ void a_ready(const Unit&) const {}
    __device__ __forceinline__ void done(const Unit&) const {}
};

__device__ __forceinline__ unsigned cvt_pk_bf16(float lo, float hi) { unsigned r; asm volatile("v_cvt_pk_bf16_f32 %0, %1, %2" : "=v"(r) : "v"(lo), "v"(hi)); return r; }

template <class Epi, class Sched, bool ALIGN_EPI = false, bool SP2 = false, int AMODE = 0, int KC = 0, int LDAC = 0>
__device__ __forceinline__ void gemm_phase(PG8_LAS unsigned char* lds, const Gemm g, const Sched& S, const Epi& E) {
    const int tid = threadIdx.x, wid = __builtin_amdgcn_readfirstlane(tid >> 6), lane = tid & 63, wr = wid >> 2, wc = wid & 3, fr = lane & 15, fq = lane >> 4;
    const int K = KC ? KC : g.K, nt = K / BK; const int lda = LDAC ? LDAC : g.lda;
    unsigned voffA[2], voffB[2];
#pragma unroll
    for (int i = 0; i < 2; ++i) { int R, C; stage_rc(tid * 16 + i * 8192, R, C); const int Rb = Epi::PERM ? ((R & ~31) + perm32(R & 31)) : R;
        voffA[i] = (unsigned)(R * lda + C) * 2u; voffB[i] = (unsigned)(Rb * K + C) * 2u; }
    const size_t kstep = (size_t)(BK * 2);
    const size_t hstepA = (size_t)HALF * lda * 2;
    const size_t hstepB = (size_t)HALF * K * 2;
    const size_t tstepB = 2 * hstepB;
    const unsigned ldsw = (unsigned)wid * 1024u;
    const int aoff = lds_byte(wr * 64 + fr, fq * 8), boff = lds_byte(wc * 32 + fr, fq * 8);
#define PG8_SA(b, h) (((b) * 2 + (h)) * HTB)
#define PG8_SB(b, h) ((4 + (b) * 2 + (h)) * HTB)
#define PG8_STAGE(bufoff, gbase, voff) do { _Pragma("unroll") for (int _i = 0; _i < 2; ++_i) \
        __builtin_amdgcn_global_load_lds((const unsigned*)((const char*)(gbase) + (voff)[_i]), (PG8_LAS unsigned*)(lds + (bufoff) + ldsw + _i * 8192), 16, 0, 0); } while (0)
#define PG8_LDA(dst, b, h) do { _Pragma("unroll") for (int m = 0; m < 4; ++m) _Pragma("unroll") for (int k = 0; k < 2; ++k) dst[m][k] = *(const PG8_LAS bf16x8*)(lds + PG8_SA(b, h) + aoff + m * 2048 + k * 1024); } while (0)
#define PG8_LDB(dst, b, h) do { _Pragma("unroll") for (int n = 0; n < 2; ++n) _Pragma("unroll") for (int k = 0; k < 2; ++k) dst[n][k] = *(const PG8_LAS bf16x8*)(lds + PG8_SB(b, h) + boff + n * 2048 + k * 1024); } while (0)
#define PG8_MMA(ai, bj, At, Bt) do { __builtin_amdgcn_s_setprio(1); _Pragma("unroll") for (int m = 0; m < 4; ++m) _Pragma("unroll") for (int n = 0; n < 2; ++n) _Pragma("unroll") for (int k = 0; k < 2; ++k) \
        acc[ai][bj][m][n] = __builtin_amdgcn_mfma_f32_16x16x32_bf16(Bt[n][k], At[m][k], acc[ai][bj][m][n], 0, 0, 0); __builtin_amdgcn_s_setprio(0); } while (0)
#define PG8_WAIT_V(n) asm volatile("s_waitcnt vmcnt(" #n ")" ::: "memory")
#define PG8_WAIT_L(n) asm volatile("s_waitcnt lgkmcnt(" #n ")" ::: "memory")
#define PG8_BAR __builtin_amdgcn_s_barrier()
#define PG8_SCHED __builtin_amdgcn_sched_barrier(0)
    Unit cur, nxt; int ui = 0;
    if (!S.next(0, cur)) return;
    f32x4 acc[2][2][4][2];
#pragma unroll
    for (int a = 0; a < 2; ++a)
#pragma unroll
        for (int b = 0; b < 2; ++b)
#pragma unroll
            for (int m = 0; m < 4; ++m)
#pragma unroll
                for (int n = 0; n < 2; ++n) acc[a][b][m][n] = (f32x4){0.f, 0.f, 0.f, 0.f};
    bf16x8 At[4][2], B0[2][2], B1[2][2];
    const char* cA = (const char*)g.A + a_off_bytes<AMODE>(g, cur); const char* cB = (const char*)g.Bt + (size_t)cur.pn * tstepB;
    S.a_ready(cur);
    if constexpr (SP2) {
        PG8_STAGE(PG8_SB(0, 0), cB, voffB); PG8_STAGE(PG8_SB(0, 1), cB + hstepB, voffB); PG8_STAGE(PG8_SA(0, 0), cA, voffA); PG8_STAGE(PG8_SA(0, 1), cA + hstepA, voffA);
        if (wr == 1) PG8_BAR;
        PG8_WAIT_V(2); PG8_BAR;
        PG8_STAGE(PG8_SB(1, 0), cB + kstep, voffB); PG8_STAGE(PG8_SA(1, 0), cA + kstep, voffA); PG8_STAGE(PG8_SB(1, 1), cB + hstepB + kstep, voffB);
        PG8_WAIT_V(6); PG8_BAR;
    } else {
        PG8_STAGE(PG8_SB(0, 0), cB, voffB); PG8_STAGE(PG8_SA(0, 0), cA, voffA); PG8_STAGE(PG8_SB(0, 1), cB + hstepB, voffB); PG8_STAGE(PG8_SA(0, 1), cA + hstepA, voffA);
        if (wr == 1) PG8_BAR;
        PG8_WAIT_V(4); PG8_BAR;
        PG8_STAGE(PG8_SB(1, 0), cB + kstep, voffB); PG8_STAGE(PG8_SA(1, 0), cA + kstep, voffA); PG8_STAGE(PG8_SB(1, 1), cB + hstepB + kstep, voffB);
        PG8_WAIT_V(6); PG8_BAR;
    }
    for (;;) {
        const bool has_next = S.next(ui + 1, nxt);
        const char* nA = has_next ? (const char*)g.A + a_off_bytes<AMODE>(g, nxt) : cA; const char* nB = has_next ? (const char*)g.Bt + (size_t)nxt.pn * tstepB : cB;
#pragma unroll 1
        for (int t = 0; t < nt; t += 2) {
            const bool last = (t == nt - 2);
            const char* a1 = cA + (size_t)(t + 1) * kstep;
            const char* a2 = last ? nA : cA + (size_t)(t + 2) * kstep; const char* b2 = last ? nB : cB + (size_t)(t + 2) * kstep;
            const char* a3 = a2 + kstep; const char* b3 = b2 + kstep;
            if (last && has_next) S.a_ready(nxt);
            if constexpr (SP2) {
            PG8_LDB(B0, 0, 0); PG8_LDB(B1, 0, 1); PG8_SCHED; PG8_LDA(At, 0, 0); PG8_STAGE(PG8_SA(1, 1), a1 + hstepA, voffA);
            PG8_WAIT_V(8); PG8_WAIT_L(0); PG8_BAR; PG8_MMA(0, 0, At, B0); PG8_MMA(0, 1, At, B1); PG8_BAR; PG8_SCHED;
            PG8_LDA(At, 0, 1); PG8_STAGE(PG8_SB(0, 0), b2, voffB); PG8_STAGE(PG8_SB(0, 1), b2 + hstepB, voffB); PG8_STAGE(PG8_SA(0, 0), a2, voffA);
            PG8_WAIT_V(8); PG8_WAIT_L(0); PG8_BAR; PG8_MMA(1, 0, At, B0); PG8_MMA(1, 1, At, B1); PG8_BAR; PG8_SCHED;
            PG8_LDB(B0, 1, 0); PG8_LDB(B1, 1, 1); PG8_SCHED; PG8_LDA(At, 1, 0); PG8_STAGE(PG8_SA(0, 1), a2 + hstepA, voffA);
            PG8_WAIT_V(8); PG8_WAIT_L(0); PG8_BAR; PG8_MMA(0, 0, At, B0); PG8_MMA(0, 1, At, B1); PG8_BAR; PG8_SCHED;
            PG8_LDA(At, 1, 1); PG8_STAGE(PG8_SB(1, 0), b3, voffB); PG8_STAGE(PG8_SB(1, 1), b3 + hstepB, voffB); PG8_STAGE(PG8_SA(1, 0), a3, voffA);
            PG8_WAIT_V(8); PG8_WAIT_L(0); PG8_BAR; PG8_MMA(1, 0, At, B0); PG8_MMA(1, 1, At, B1); PG8_BAR; PG8_SCHED;
            } else {
            PG8_LDB(B0, 0, 0); PG8_SCHED; PG8_LDA(At, 0, 0); PG8_STAGE(PG8_SA(1, 1), a1 + hstepA, voffA);
            PG8_WAIT_L(8); PG8_BAR; PG8_WAIT_L(0); PG8_MMA(0, 0, At, B0); PG8_BAR; PG8_SCHED;
            PG8_LDB(B1, 0, 1); PG8_STAGE(PG8_SB(0, 0), b2, voffB);
            PG8_BAR; PG8_WAIT_L(0); PG8_MMA(0, 1, At, B1); PG8_BAR;
            PG8_LDA(At, 0, 1); PG8_STAGE(PG8_SA(0, 0), a2, voffA);
            PG8_BAR; PG8_WAIT_L(0); PG8_MMA(1, 0, At, B0); PG8_BAR; PG8_SCHED;
            PG8_STAGE(PG8_SB(0, 1), b2 + hstepB, voffB);
            PG8_WAIT_V(6); PG8_BAR; PG8_MMA(1, 1, At, B1); PG8_BAR;
            PG8_LDB(B0, 1, 0); PG8_SCHED; PG8_LDA(At, 1, 0); PG8_STAGE(PG8_SA(0, 1), a2 + hstepA, voffA);
            PG8_WAIT_L(8); PG8_BAR; PG8_WAIT_L(0); PG8_MMA(0, 0, At, B0); PG8_BAR; PG8_SCHED;
            PG8_LDB(B1, 1, 1); PG8_STAGE(PG8_SB(1, 0), b3, voffB);
            PG8_BAR; PG8_WAIT_L(0); PG8_MMA(0, 1, At, B1); PG8_BAR;
            PG8_LDA(At, 1, 1); PG8_STAGE(PG8_SA(1, 0), a3, voffA);
            PG8_BAR; PG8_WAIT_L(0); PG8_MMA(1, 0, At, B0); PG8_BAR; PG8_SCHED;
            PG8_STAGE(PG8_SB(1, 1), b3 + hstepB, voffB);
            PG8_WAIT_V(6); PG8_BAR; PG8_MMA(1, 1, At, B1); PG8_BAR;
            }
        }
        if constexpr (ALIGN_EPI) { if (wr == 0) PG8_BAR; }
        E(acc, cur, wr, wc, fr, fq); S.done(cur);
        if (!has_next) break;
#pragma unroll
        for (int a = 0; a < 2; ++a)
#pragma unroll
            for (int b = 0; b < 2; ++b)
#pragma unroll
                for (int m = 0; m < 4; ++m)
#pragma unroll
                    for (int n = 0; n < 2; ++n) acc[a][b][m][n] = (f32x4){0.f, 0.f, 0.f, 0.f};
        cur = nxt; cA = nA; cB = nB; ++ui;
        if constexpr (ALIGN_EPI) { if (wr == 1) PG8_BAR; }
    }
    PG8_WAIT_V(0);
    if constexpr (!ALIGN_EPI) { if (wr == 0) PG8_BAR; }
    PG8_BAR;
#undef PG8_SA
#undef PG8_SB
#undef PG8_STAGE
#undef PG8_LDA
#undef PG8_LDB
#undef PG8_MMA
#undef PG8_WAIT_V
#undef PG8_WAIT_L
#undef PG8_BAR
#undef PG8_SCHED
}
}

constexpr int NB = 8, SEQ = 8192, DM = 1024, T = NB * SEQ;
constexpr int NPAD = 7424;
constexpr int NWAVES = 8, NTHR = 512;
constexpr int LDS_BYTES = 147456;
constexpr int N_PHASES = 11;
#define PROBE_PH -1
#define PROBE_MULT 3

constexpr size_t MiB = 1ull << 20;
constexpr size_t WS_CTL = 0;
constexpr size_t WS_MODP = 1 * MiB;
constexpr size_t WS_WIN = 3 * MiB;
constexpr size_t WS_WOUT = 18 * MiB;
constexpr size_t WS_WQ = 20 * MiB;
constexpr size_t WS_WQB = 480 * MiB;
constexpr size_t WS_LRUB = 24 * MiB;
constexpr size_t WS_SUBK = 25 * MiB;
constexpr size_t WS_LRUC = 26 * MiB;
constexpr size_t WS_U = 32 * MiB;
constexpr size_t WS_V = 48 * MiB;
constexpr size_t WS_SU = 64 * MiB;
constexpr size_t WS_SV = 65 * MiB;
constexpr size_t WS_SS = 30 * MiB;
constexpr size_t WS_DK = 66 * MiB;
constexpr size_t WS_QKV = 96 * MiB;
constexpr size_t WS_R = 352 * MiB;
constexpr size_t WS_XLXG = 480 * MiB;
constexpr size_t WS_GAGB = 736 * MiB;
constexpr size_t WS_ALOW = 992 * MiB;
constexpr size_t WS_END = 994 * MiB;
constexpr size_t WS_Y = WS_QKV;
constexpr size_t WS_H2 = WS_QKV + 128 * MiB;
constexpr size_t WS_QRY = WS_XLXG;
constexpr size_t WS_SC = WS_GAGB;
constexpr size_t WS_TOPK = WS_R;
constexpr size_t WS_TOPK2 = WS_R + 32 * MiB;

#define LAS __attribute__((address_space(3)))
typedef unsigned short bf16;
typedef float f32x4 __attribute__((ext_vector_type(4)));
typedef float f32x2 __attribute__((ext_vector_type(2)));
typedef unsigned u32x4 __attribute__((ext_vector_type(4)));
typedef unsigned u32x2 __attribute__((ext_vector_type(2)));

struct Params {
    const float *x, *c, *w_ada, *b_ada, *npm, *npo, *w_in, *w_alpha, *b_alpha, *gla_norm, *conv_w, *conv_b,
        *lwa, *lba, *lwx, *lbx, *lam, *w_out, *npf, *npof, *wq, *subk, *pu, *pv;
    float* out; unsigned char* ws;
    int ph_lo, ph_hi;
};

__device__ __forceinline__ unsigned f2bf(float f) { unsigned u = __builtin_bit_cast(unsigned, f); return (u + 0x7fffu + ((u >> 16) & 1u)) >> 16; }
__device__ __forceinline__ unsigned pk2(float lo, float hi) { return f2bf(lo) | (f2bf(hi) << 16); }
__device__ __forceinline__ float bflo(unsigned u) { return __builtin_bit_cast(float, u << 16); }
__device__ __forceinline__ float bfhi(unsigned u) { return __builtin_bit_cast(float, u & 0xffff0000u); }
__device__ __forceinline__ float bf2f(bf16 h) { return __builtin_bit_cast(float, (unsigned)h << 16); }
__device__ __forceinline__ float sigmoid_f(float x) { return __builtin_amdgcn_rcpf(1.f + __expf(-x)); }
__device__ __forceinline__ float silu_f(float x) { return x * __builtin_amdgcn_rcpf(1.f + __expf(-x)); }
__device__ __forceinline__ float gelu_f(float x) { const float u = 0.7978845608028654f * (x + 0.044715f * x * x * x); return x * __builtin_amdgcn_rcpf(1.f + __expf(-2.f * u)); }
__device__ __forceinline__ float softplus_f(float x) { return fmaxf(x, 0.f) + log1pf(__expf(-fabsf(x))); }
__device__ __forceinline__ float wave_sum(float v) {
#pragma unroll
    for (int o = 1; o < 64; o <<= 1) v += __shfl_xor(v, o);
    return v;
}
#define LDS_WAIT() asm volatile("s_waitcnt lgkmcnt(0)" ::: "memory")

struct EpiSeg {
    static constexpr bool PERM = true;
    unsigned char* ws;
    __device__ __forceinline__ void operator()(const pg8::f32x4 (&acc)[2][2][4][2], const pg8::Unit& u, int wr, int wc, int fr, int fq) const {
        const int pn = u.pn; bf16* base; int ldc, colt;
        if (pn < 8) { base = (bf16*)(ws + WS_QKV); ldc = 2048; colt = pn * 256; }
        else if (pn < 12) { base = (bf16*)(ws + WS_R); ldc = 1024; colt = (pn - 8) * 256; }
        else if (pn < 20) { base = (bf16*)(ws + WS_XLXG); ldc = 2048; colt = (pn - 12) * 256; }
        else if (pn < 28) { base = (bf16*)(ws + WS_GAGB); ldc = 2048; colt = (pn - 20) * 256; }
        else { base = (bf16*)(ws + WS_ALOW); ldc = 16; colt = 0; }
        const int row0 = u.pm * 256 + wr * 64 + fr, col0 = colt + wc * 32 + 8 * fq;
        const bool tail = (pn == 28);
#pragma unroll
        for (int ai = 0; ai < 2; ++ai)
#pragma unroll
            for (int m = 0; m < 4; ++m) { bf16* rowp = base + (size_t)(row0 + ai * 128 + m * 16) * ldc + col0;
#pragma unroll
                for (int bj = 0; bj < 2; ++bj) { const pg8::f32x4 v0 = acc[ai][bj][m][0], v1 = acc[ai][bj][m][1];
                    u32x4 w; w.x = pg8::cvt_pk_bf16(v0[0], v0[1]); w.y = pg8::cvt_pk_bf16(v0[2], v0[3]); w.z = pg8::cvt_pk_bf16(v1[0], v1[1]); w.w = pg8::cvt_pk_bf16(v1[2], v1[3]);
                    if (!tail || (bj == 0 && wc == 0 && fq < 2)) *(u32x4*)(rowp + bj * 128) = w; } }
    }
};
struct EpiPlain {
    static constexpr bool PERM = true;
    bf16* O; int ldc;
    __device__ __forceinline__ void operator()(const pg8::f32x4 (&acc)[2][2][4][2], const pg8::Unit& u, int wr, int wc, int fr, int fq) const {
        const int row0 = u.pm * 256 + wr * 64 + fr, col0 = u.pn * 256 + wc * 32 + 8 * fq;
#pragma unroll
        for (int ai = 0; ai < 2; ++ai)
#pragma unroll
            for (int m = 0; m < 4; ++m) { bf16* rowp = O + (size_t)(row0 + ai * 128 + m * 16) * ldc + col0;
#pragma unroll
                for (int bj = 0; bj < 2; ++bj) { const pg8::f32x4 v0 = acc[ai][bj][m][0], v1 = acc[ai][bj][m][1];
                    u32x4 w; w.x = pg8::cvt_pk_bf16(v0[0], v0[1]); w.y = pg8::cvt_pk_bf16(v0[2], v0[3]); w.z = pg8::cvt_pk_bf16(v1[0], v1[1]); w.w = pg8::cvt_pk_bf16(v1[2], v1[3]);
                    *(u32x4*)(rowp + bj * 128) = w; } }
    }
};
typedef _Float16 h16x2 __attribute__((ext_vector_type(2)));
__device__ __forceinline__ unsigned pkh(float a, float b) { return __builtin_bit_cast(unsigned, __builtin_amdgcn_cvt_pkrtz(a, b)); }
struct EpiF16 {
    static constexpr bool PERM = true;
    unsigned short* O; int ldc;
    __device__ __forceinline__ void operator()(const pg8::f32x4 (&acc)[2][2][4][2], const pg8::Unit& u, int wr, int wc, int fr, int fq) const {
        const int row0 = u.pm * 256 + wr * 64 + fr, col0 = u.pn * 256 + wc * 32 + 8 * fq;
#pragma unroll
        for (int ai = 0; ai < 2; ++ai)
#pragma unroll
            for (int m = 0; m < 4; ++m) { unsigned short* rowp = O + (size_t)(row0 + ai * 128 + m * 16) * ldc + col0;
#pragma unroll
                for (int bj = 0; bj < 2; ++bj) { const pg8::f32x4 v0 = acc[ai][bj][m][0], v1 = acc[ai][bj][m][1];
                    u32x4 w; w.x = pkh(v0[0], v0[1]); w.y = pkh(v0[2], v0[3]); w.z = pkh(v1[0], v1[1]); w.w = pkh(v1[2], v1[3]);
                    *(u32x4*)(rowp + bj * 128) = w; } }
    }
};
struct EpiTrans {
    static constexpr bool PERM = true;
    bf16* O; int ldc;
    __device__ __forceinline__ void operator()(const pg8::f32x4 (&acc)[2][2][4][2], const pg8::Unit& u, int wr, int wc, int fr, int fq) const {
        const int row0 = u.pm * 256 + wr * 64 + fr, col0 = u.pn * 256 + wc * 32 + 8 * fq;
#pragma unroll
        for (int ai = 0; ai < 2; ++ai)
#pragma unroll
            for (int m = 0; m < 4; ++m) { const int row = row0 + ai * 128 + m * 16;
#pragma unroll
                for (int bj = 0; bj < 2; ++bj)
#pragma unroll
                    for (int n = 0; n < 2; ++n)
#pragma unroll
                        for (int e = 0; e < 4; ++e) O[(size_t)(col0 + bj * 128 + 4 * n + e) * ldc + row] = (bf16)f2bf(acc[ai][bj][m][n][e]); }
    }
};

__device__ __forceinline__ void p0_transpose_item(const float* W, int ldw, int k0, int n0, int nvalid, bf16* WT, int ldk, int row0, int kc0, LAS float* scr, int lane) {
#pragma unroll 8
    for (int i = 0; i < 32; ++i) { const int kk = 2 * i + (lane >> 5), cc = lane & 31; scr[kk * 33 + cc] = (cc < nvalid) ? W[(size_t)(k0 + kk) * ldw + n0 + cc] : 0.f; }
    LDS_WAIT(); asm volatile("" ::: "memory");
    const int c = lane & 7;
#pragma unroll
    for (int j = 0; j < 4; ++j) { const int n = (lane >> 3) + 8 * j; const LAS float* s = scr + (8 * c) * 33 + n;
        u32x4 o; o.x = pk2(s[0 * 33], s[1 * 33]); o.y = pk2(s[2 * 33], s[3 * 33]); o.z = pk2(s[4 * 33], s[5 * 33]); o.w = pk2(s[6 * 33], s[7 * 33]);
        *(u32x4*)(WT + (size_t)(row0 + n) * ldk + kc0 + k0 + 8 * c) = o; }
    LDS_WAIT(); asm volatile("" ::: "memory");
}
__device__ __forceinline__ void phase0(const Params& p, LAS unsigned char* lds, int G) {
    const int tid = threadIdx.x, lane = tid & 63, wave = __builtin_amdgcn_readfirstlane(tid >> 6);
    unsigned char* ws = p.ws;
    {
        LAS float* sc = (LAS float*)lds;
        LAS float* red = (LAS float*)(lds + 4096);
        float* modp = (float*)(ws + WS_MODP);
        for (int it = blockIdx.x; it < 24 * 8; it += G) {
            const int nb = it % 24, kc = it / 24;
            for (int i = tid; i < 1024; i += NTHR) { const int b = i >> 7, k = i & 127; sc[i] = silu_f(p.c[b * 1024 + kc * 128 + k]); }
            __syncthreads();
            const int col = tid & 255, kh = tid >> 8;
            float acc[8];
#pragma unroll
            for (int b = 0; b < 8; ++b) acc[b] = 0.f;
            const float* wp = p.w_ada + (size_t)(kc * 128 + kh * 64) * 6144 + nb * 256 + col;
#pragma unroll 8
            for (int kk = 0; kk < 64; ++kk) { const float w = wp[(size_t)kk * 6144];
#pragma unroll
                for (int b = 0; b < 8; ++b) acc[b] += sc[b * 128 + kh * 64 + kk] * w; }
            if (kh == 1) {
#pragma unroll
                for (int b = 0; b < 8; ++b) red[b * 256 + col] = acc[b]; }
            __syncthreads();
            if (kh == 0) { const int n = nb * 256 + col; const float bias = (kc == 0) ? p.b_ada[n] : 0.f;
#pragma unroll
                for (int b = 0; b < 8; ++b) modp[(size_t)(kc * 8 + b) * 6144 + n] = acc[b] + red[b * 256 + col] + bias; }
            __syncthreads();
        }
    }
    for (int i = blockIdx.x * NTHR + tid; i < T * 4 / 4; i += G * NTHR) ((f32x4*)(ws + WS_SS))[i] = (f32x4){0.f, 0.f, 0.f, 0.f};
    LAS float* scr = (LAS float*)(lds + 16384 + wave * 8448);
    const int gw = blockIdx.x * NWAVES + wave, NGW = G * NWAVES;
    bf16* WinT = (bf16*)(ws + WS_WIN); bf16* WoutT = (bf16*)(ws + WS_WOUT);
    bf16* LruB = (bf16*)(ws + WS_LRUB); bf16* SubK = (bf16*)(ws + WS_SUBK);
    constexpr int I_IN = 16 * (NPAD / 32), I_OUT = 16 * 32, I_Q = 2048, I_LRU = 16 * 8, I_SUB = 2048, I_TAB = 2 * 16384;
    constexpr int NIT = I_IN + I_OUT + I_Q + I_LRU + I_SUB + I_TAB;
    for (int it = gw; it < NIT; it += NGW) {
        int r = it;
        if (r < I_IN) { const int nb = r % (NPAD / 32), kb = r / (NPAD / 32), nq = nb * 32; int n0, nv;
            if (nq < 3072) { n0 = nq; nv = 32; } else if (nq < 7168) { n0 = nq + 16; nv = 32; } else if (nq == 7168) { n0 = 3072; nv = 16; } else { n0 = 0; nv = 0; }
            p0_transpose_item(p.w_in, 7184, kb * 64, n0, nv, WinT, 1024, nq, 0, scr, lane); continue; } r -= I_IN;
        if (r < I_OUT) { const int nb = r % 32, kb = r / 32; p0_transpose_item(p.w_out, 1024, kb * 64, nb * 32, 32, WoutT, 1024, nb * 32, 0, scr, lane); continue; } r -= I_OUT;
        if (r < I_Q) {
            const float* src = p.wq + (size_t)r * 1024; bf16* dst = (bf16*)(ws + WS_WQB) + (size_t)r * 1024;
#pragma unroll
            for (int j = 0; j < 2; ++j) { const f32x4 a = *(const f32x4*)(src + j * 512 + lane * 8), b = *(const f32x4*)(src + j * 512 + lane * 8 + 4);
                u32x4 o; o.x = pk2(a.x, a.y); o.y = pk2(a.z, a.w); o.z = pk2(b.x, b.y); o.w = pk2(b.z, b.w);
                *(u32x4*)(dst + j * 512 + lane * 8) = o; }
            continue; } r -= I_Q;
        if (r < I_LRU) {
            const int mat = r >> 3, sub = r & 7, g = mat >> 3, n = mat & 7, kb = sub >> 2, nb = sub & 3;
            const int np = n < 6 ? n : 6, half = n - np;
            const float* W = (g ? p.lwx : p.lwa) + (size_t)n * 128 * 128;
            bf16* dst = LruB + (size_t)n * 256 * 256;
            p0_transpose_item(W, 128, kb * 64, nb * 32, 32, dst, 256, g * 128 + nb * 32, half * 128, scr, lane);
            p0_transpose_item(W, 128, kb * 64, 0, 0, dst, 256, g * 128 + nb * 32, (1 - half) * 128, scr, lane);
            continue; } r -= I_LRU;
        if (r < I_SUB) {
            const int h = r >> 8, pp = (r >> 7) & 1, n = r & 127;
            const float* src = p.subk + (size_t)r * 128; bf16* dst = SubK + ((size_t)h * 256 + pp * 128 + n) * 256;
            const f32x2 v = *(const f32x2*)(src + 2 * lane);
            *(unsigned*)(dst + pp * 128 + 2 * lane) = pk2(v.x, v.y);
            *(unsigned*)(dst + (1 - pp) * 128 + 2 * lane) = 0u;
            continue; } r -= I_SUB;
        {
            const int tb = r >> 14, row = r & 16383;
            const float* src = (tb ? p.pv : p.pu) + (size_t)row * 1024 + lane * 16;
            f32x4 v[4]; float am = 0.f;
#pragma unroll
            for (int j = 0; j < 4; ++j) { v[j] = *(const f32x4*)(src + 4 * j); am = fmaxf(am, fmaxf(fmaxf(fabsf(v[j].x), fabsf(v[j].y)), fmaxf(fabsf(v[j].z), fabsf(v[j].w)))); }
#pragma unroll
            for (int o = 1; o < 64; o <<= 1) am = fmaxf(am, __shfl_xor(am, o));
            const float inv = am > 0.f ? 7.5f / am : 0.f;
            unsigned long long lo = 0ull; unsigned hi = 0u;
#pragma unroll
            for (int j = 0; j < 16; ++j) { const float x = v[j >> 2][j & 3] * inv, a = fabsf(x);
                unsigned code = a < 1.f ? (unsigned)__builtin_rintf(a * 8.f) : (a < 2.f ? 8u + (unsigned)__builtin_rintf((a - 1.f) * 8.f) : (a < 4.f ? 16u + (unsigned)__builtin_rintf((a - 2.f) * 4.f) : 24u + (unsigned)__builtin_rintf((a - 4.f) * 2.f)));
                code = code > 31u ? 31u : code; code |= (x < 0.f) ? 32u : 0u;
                const int bit = 6 * j;
                if (bit + 6 <= 64) lo |= (unsigned long long)code << bit;
                else if (bit >= 64) hi |= code << (bit - 64);
                else { lo |= (unsigned long long)code << bit; hi |= code >> (64 - bit); } }
            unsigned* dst = (unsigned*)(ws + (tb ? WS_V : WS_U) + (size_t)row * 768 + lane * 12);
            dst[0] = (unsigned)lo; dst[1] = (unsigned)(lo >> 32); dst[2] = hi;
            if (lane == 0) ((float*)(ws + (tb ? WS_SV : WS_SU)))[row] = am * (1.f / 7.5f);
        }
    }
}

__device__ __forceinline__ float mod_at(const float* modp, int b, int n) {
    float s = 0.f;
#pragma unroll
    for (int kc = 0; kc < 8; ++kc) s += modp[(size_t)(kc * 8 + b) * 6144 + n];
    return s;
}

__device__ __forceinline__ void phase1(const Params& p, LAS unsigned char* lds, int G) {
    const int tid = threadIdx.x, lane = tid & 63, wave = __builtin_amdgcn_readfirstlane(tid >> 6);
    const float* modp = (const float*)(p.ws + WS_MODP);
    LAS float* gs = (LAS float*)lds; LAS float* sh = gs + 1024;
    bf16* H = (bf16*)p.out;
    for (int tile = blockIdx.x; tile < T / 256; tile += G) {
        const int b = tile / 32;
        __syncthreads();
        for (int k = tid; k < 1024; k += NTHR) { gs[k] = p.npm[k] * (1.f + mod_at(modp, b, 1024 + k)); sh[k] = mod_at(modp, b, k); }
        __syncthreads();
        for (int rr = 0; rr < 32; ++rr) {
            const size_t row = (size_t)tile * 256 + wave * 32 + rr;
            const f32x4* xr = (const f32x4*)(p.x + row * 1024) + lane;
            f32x4 v[4]; float s = 0.f;
#pragma unroll
            for (int j = 0; j < 4; ++j) { v[j] = xr[64 * j]; s += (v[j].x * v[j].x + v[j].y * v[j].y) + (v[j].z * v[j].z + v[j].w * v[j].w); }
            const float rstd = __builtin_amdgcn_rsqf(wave_sum(s) * (1.f / 1024.f) + 1e-6f);
            u32x2* o8 = (u32x2*)(H + row * 1024) + lane;
#pragma unroll
            for (int j = 0; j < 4; ++j) { const int k = 256 * j + 4 * lane; const f32x4 g4 = *(const LAS f32x4*)(gs + k), s4 = *(const LAS f32x4*)(sh + k);
                u32x2 w; w.x = pk2(v[j].x * rstd * g4.x + s4.x, v[j].y * rstd * g4.y + s4.y); w.y = pk2(v[j].z * rstd * g4.z + s4.z, v[j].w * rstd * g4.w + s4.w);
                o8[64 * j] = w; }
        }
    }
}

typedef short bf16x8_t __attribute__((ext_vector_type(8)));
template <bool FINAL>
__device__ __forceinline__ void phase_lru(const Params& p, LAS unsigned char* lds, int G) {
    const int tid = threadIdx.x, lane = tid & 63, wave = __builtin_amdgcn_readfirstlane(tid >> 6), q4 = lane >> 4, c16 = lane & 15;
    constexpr int PQ = 136;
    LAS bf16* XC = (LAS bf16*)lds;
    LAS bf16* HB = XC + 64 * PQ;
    LAS float* CW = (LAS float*)(HB + 64 * PQ);
    const bf16* XL = (const bf16*)(p.ws + WS_XLXG); const bf16* LruB = (const bf16*)(p.ws + WS_LRUB);
    const bf16* XG = (const bf16*)(p.ws + WS_XLXG) + 1024; const bf16* GB = (const bf16*)(p.ws + WS_GAGB) + 1024; bf16* GA = (bf16*)(p.ws + WS_GAGB);
    const bf16* O = (const bf16*)(p.ws + WS_QKV) + 1024; const bf16* R = (const bf16*)(p.ws + WS_R); const float* SS = (const float*)(p.ws + WS_SS);
    f32x2* CAR = (f32x2*)(p.ws + WS_LRUC);
    const int c8 = tid & 15, tr = tid >> 4;
    for (int it = blockIdx.x; it < 8 * 8 * 4; it += G) {
        const int sg = it & 3, n = (it >> 2) & 7, b = it >> 5;
        const int chc = n * 128 + c8 * 8;
        const int chm = n * 128 + wave * 16 + c16;
        __syncthreads();
        for (int i = tid; i < 768; i += NTHR) { const int q = i >> 7, c = i & 127; CW[i] = q < 4 ? p.conv_w[q * 1024 + n * 128 + c] : (q == 4 ? p.conv_b[n * 128 + c] : p.gla_norm[n * 128 + c]); }
        const float ba = p.lba[chm], bx = p.lbx[chm], sp = -8.f * softplus_f(-p.lam[chm]);
        bf16x8_t wf[2][4];
        { const int np = n < 6 ? n : 6, half = n - np;
#pragma unroll
          for (int g = 0; g < 2; ++g)
#pragma unroll
              for (int ks = 0; ks < 4; ++ks) wf[g][ks] = *(const bf16x8_t*)(LruB + (size_t)n * 65536 + (size_t)(g * 128 + wave * 16 + c16) * 256 + half * 128 + ks * 32 + q4 * 8); }
        float hc = 0.f, aseg = 1.f;
        if (FINAL) { for (int s = 0; s < sg; ++s) { const f32x2 c = CAR[(size_t)((b * 8 + n) * 4 + s) * 128 + wave * 16 + c16]; hc = c.x * hc + c.y; } }
        const size_t tseg = (size_t)b * SEQ + sg * 2048;
        u32x4 xr[5];
#define LRU_LOADX(t0_) do { _Pragma("unroll") for (int _k = 0; _k < 5; ++_k) { const long _t = (long)(t0_) + 2 * tr + _k - 3; \
            xr[_k] = (_t < (long)b * SEQ) ? (u32x4){0u, 0u, 0u, 0u} : *(const u32x4*)(XL + (size_t)_t * 2048 + chc); } } while (0)
        LRU_LOADX(tseg);
        __syncthreads();
#pragma unroll 1
        for (int tl = 0; tl < 32; ++tl) {
            const size_t t0 = tseg + tl * 64;
            { float xv[5][8];
#pragma unroll
              for (int k = 0; k < 5; ++k) { xv[k][0] = bflo(xr[k].x); xv[k][1] = bfhi(xr[k].x); xv[k][2] = bflo(xr[k].y); xv[k][3] = bfhi(xr[k].y); xv[k][4] = bflo(xr[k].z); xv[k][5] = bfhi(xr[k].z); xv[k][6] = bflo(xr[k].w); xv[k][7] = bfhi(xr[k].w); }
              float cw[5][8];
#pragma unroll
              for (int q = 0; q < 5; ++q) { const f32x4 w0 = *(const LAS f32x4*)(CW + q * 128 + c8 * 8), w1 = *(const LAS f32x4*)(CW + q * 128 + c8 * 8 + 4);
                  cw[q][0] = w0.x; cw[q][1] = w0.y; cw[q][2] = w0.z; cw[q][3] = w0.w; cw[q][4] = w1.x; cw[q][5] = w1.y; cw[q][6] = w1.z; cw[q][7] = w1.w; }
#pragma unroll
              for (int i2 = 0; i2 < 2; ++i2) { float o[8];
#pragma unroll
                  for (int j = 0; j < 8; ++j) o[j] = cw[4][j] + cw[0][j] * xv[i2][j] + cw[1][j] * xv[i2 + 1][j] + cw[2][j] * xv[i2 + 2][j] + cw[3][j] * xv[i2 + 3][j];
                  *(LAS u32x4*)(XC + (2 * tr + i2) * PQ + c8 * 8) = (u32x4){pk2(o[0], o[1]), pk2(o[2], o[3]), pk2(o[4], o[5]), pk2(o[6], o[7])}; } }
            u32x4 mxg[2], mgb[2], mo[2], mr[2], mga[2]; float mss[2];
            if (FINAL) {
#pragma unroll
                for (int i2 = 0; i2 < 2; ++i2) { const size_t t = t0 + 2 * tr + i2;
                    mxg[i2] = *(const u32x4*)(XG + t * 2048 + chc); mgb[i2] = *(const u32x4*)(GB + t * 2048 + chc); mo[i2] = *(const u32x4*)(O + t * 2048 + chc);
                    mr[i2] = *(const u32x4*)(R + t * 1024 + chc); mga[i2] = *(const u32x4*)(GA + t * 2048 + chc); mss[i2] = SS[t * 4 + (chc >> 8)]; } }
            if (tl + 1 < 32) LRU_LOADX(t0 + 64);
            __syncthreads();
            pg8::f32x4 acc[4][2];
#pragma unroll
            for (int tt = 0; tt < 4; ++tt) { acc[tt][0] = (pg8::f32x4){0.f, 0.f, 0.f, 0.f}; acc[tt][1] = (pg8::f32x4){0.f, 0.f, 0.f, 0.f}; }
#pragma unroll
            for (int ks = 0; ks < 4; ++ks)
#pragma unroll
                for (int tt = 0; tt < 4; ++tt) { const bf16x8_t a = *(const LAS bf16x8_t*)(XC + (tt * 16 + c16) * PQ + ks * 32 + q4 * 8);
                    acc[tt][0] = __builtin_amdgcn_mfma_f32_16x16x32_bf16(a, wf[0][ks], acc[tt][0], 0, 0, 0);
                    acc[tt][1] = __builtin_amdgcn_mfma_f32_16x16x32_bf16(a, wf[1][ks], acc[tt][1], 0, 0, 0); }
#pragma unroll
            for (int tt = 0; tt < 4; ++tt) {
                float av[4], uv[4];
#pragma unroll
                for (int j = 0; j < 4; ++j) { const float xc = bf2f(XC[(tt * 16 + q4 * 4 + j) * PQ + wave * 16 + c16]);
                    const float gr = sigmoid_f(acc[tt][0][j] + ba), gi = sigmoid_f(acc[tt][1][j] + bx);
                    const float a = __expf(sp * gr); av[j] = a; uv[j] = __builtin_amdgcn_sqrtf(fmaxf(1.f - a * a, 0.f)) * gi * xc; }
                float A4 = av[0], H4 = uv[0];
#pragma unroll
                for (int j = 1; j < 4; ++j) { H4 = av[j] * H4 + uv[j]; A4 *= av[j]; }
                float Ai = A4, Hi = H4;
                { const float Ap = __shfl_up(Ai, 16), Hp = __shfl_up(Hi, 16); if (q4 >= 1) { Hi = Hp * Ai + Hi; Ai = Ap * Ai; } }
                { const float Ap = __shfl_up(Ai, 32), Hp = __shfl_up(Hi, 32); if (q4 >= 2) { Hi = Hp * Ai + Hi; Ai = Ap * Ai; } }
                float Ae = __shfl_up(Ai, 16), He = __shfl_up(Hi, 16); if (q4 == 0) { Ae = 1.f; He = 0.f; }
                float h = hc * Ae + He;
                const float At = __shfl(Ai, 48 + c16), Ht = __shfl(Hi, 48 + c16);
                if (FINAL) {
#pragma unroll
                    for (int j = 0; j < 4; ++j) { h = av[j] * h + uv[j]; HB[(tt * 16 + q4 * 4 + j) * PQ + wave * 16 + c16] = (bf16)f2bf(h); } }
                hc = hc * At + Ht; aseg *= At;
            }
            __syncthreads();
            if (FINAL) {
#pragma unroll
                for (int i2 = 0; i2 < 2; ++i2) { const size_t t = t0 + 2 * tr + i2;
                    const u32x4 hw = *(const LAS u32x4*)(HB + (2 * tr + i2) * PQ + c8 * 8);
                    const float rstd = __builtin_amdgcn_rsqf(mss[i2] * (1.f / 256.f) + 1e-6f);
                    const unsigned hwv[4] = {hw.x, hw.y, hw.z, hw.w}, xgv[4] = {mxg[i2].x, mxg[i2].y, mxg[i2].z, mxg[i2].w}, gbv[4] = {mgb[i2].x, mgb[i2].y, mgb[i2].z, mgb[i2].w};
                    const unsigned ov[4] = {mo[i2].x, mo[i2].y, mo[i2].z, mo[i2].w}, rv[4] = {mr[i2].x, mr[i2].y, mr[i2].z, mr[i2].w}, gav[4] = {mga[i2].x, mga[i2].y, mga[i2].z, mga[i2].w};
                    unsigned ow[4];
                    const f32x4 g0 = *(const LAS f32x4*)(CW + 640 + c8 * 8), g1 = *(const LAS f32x4*)(CW + 640 + c8 * 8 + 4);
                    const float gn[8] = {g0.x, g0.y, g0.z, g0.w, g1.x, g1.y, g1.z, g1.w};
#pragma unroll
                    for (int q = 0; q < 4; ++q) {
                        const float m0 = sigmoid_f(bflo(gav[q])) * (bflo(ov[q]) * rstd * gn[2 * q] * silu_f(bflo(rv[q]))) + sigmoid_f(bflo(gbv[q])) * (bflo(hwv[q]) * gelu_f(bflo(xgv[q])));
                        const float m1 = sigmoid_f(bfhi(gav[q])) * (bfhi(ov[q]) * rstd * gn[2 * q + 1] * silu_f(bfhi(rv[q]))) + sigmoid_f(bfhi(gbv[q])) * (bfhi(hwv[q]) * gelu_f(bfhi(xgv[q])));
                        ow[q] = pk2(m0, m1); }
                    *(u32x4*)(GA + t * 2048 + chc) = (u32x4){ow[0], ow[1], ow[2], ow[3]}; }
            }
        }
#undef LRU_LOADX
        if (!FINAL) { if (q4 == 0) CAR[(size_t)((b * 8 + n) * 4 + sg) * 128 + wave * 16 + c16] = (f32x2){aseg, hc}; }
        __syncthreads();
    }
}

__device__ __forceinline__ void phase_gla_prep(const Params& p, LAS unsigned char* lds, int G) {
    const int tid = threadIdx.x;
    LAS float* segt = (LAS float*)lds;
    bf16* QKV = (bf16*)(p.ws + WS_QKV); const bf16* AL = (const bf16*)(p.ws + WS_ALOW); float* DK = (float*)(p.ws + WS_DK);
    const int kp = tid & 127, seg = tid >> 7;
    for (int it = blockIdx.x; it < 8 * 128 * 4; it += G) {
        const int h = it & 3, ch = (it >> 2) & 127, b = it >> 9;
        float wa[16];
#pragma unroll
        for (int r = 0; r < 16; ++r) wa[r] = p.w_alpha[r * 512 + h * 128 + kp];
        const float balpha = p.b_alpha[h * 128 + kp];
        const size_t t0 = (size_t)b * SEQ + ch * 64 + seg * 16;
        float qv[16], kv[16];
#pragma unroll
        for (int i = 0; i < 16; ++i) { qv[i] = bf2f(QKV[(t0 + i) * 2048 + h * 128 + kp]); kv[i] = bf2f(QKV[(t0 + i) * 2048 + 512 + h * 128 + kp]); }
        float cl[16]; float run = 0.f;
#pragma unroll
        for (int i = 0; i < 16; ++i) { const size_t t = t0 + i;
            const u32x4 a0 = *(const u32x4*)(AL + t * 16), a1 = *(const u32x4*)(AL + t * 16 + 8);
            float z = balpha;
            z += bflo(a0.x) * wa[0] + bfhi(a0.x) * wa[1] + bflo(a0.y) * wa[2] + bfhi(a0.y) * wa[3] + bflo(a0.z) * wa[4] + bfhi(a0.z) * wa[5] + bflo(a0.w) * wa[6] + bfhi(a0.w) * wa[7];
            z += bflo(a1.x) * wa[8] + bfhi(a1.x) * wa[9] + bflo(a1.y) * wa[10] + bfhi(a1.y) * wa[11] + bflo(a1.z) * wa[12] + bfhi(a1.z) * wa[13] + bflo(a1.w) * wa[14] + bfhi(a1.w) * wa[15];
            const float ls = fminf(z, 0.f) - __logf(1.f + __expf(-fabsf(z)));
            run += ls * (1.f / 16.f); cl[i] = run; }
        __syncthreads();
        segt[seg * 128 + kp] = run;
        __syncthreads();
        float off = 0.f, tot = 0.f;
#pragma unroll
        for (int s = 0; s < 4; ++s) { const float v = segt[s * 128 + kp]; tot += v; if (s < seg) off += v; }
        if (seg == 0) DK[(size_t)(b * 128 + ch) * 512 + h * 128 + kp] = __expf(tot);
#pragma unroll
        for (int i = 0; i < 16; ++i) { const float cum = cl[i] + off;
            QKV[(t0 + i) * 2048 + h * 128 + kp] = (bf16)f2bf(qv[i] * 0.08838834764831845f * __expf(cum));
            QKV[(t0 + i) * 2048 + 512 + h * 128 + kp] = (bf16)f2bf(kv[i] * __expf(-cum)); }
    }
}
__device__ __forceinline__ void phase_gla_seq(const Params& p, LAS unsigned char* lds, int G) {
    const int tid = threadIdx.x, lane = tid & 63, wave = __builtin_amdgcn_readfirstlane(tid >> 6), q4 = lane >> 4, c16 = lane & 15;
    constexpr int PQ = 136, PS = 72;
    LAS bf16* Qs = (LAS bf16*)lds;
    LAS bf16* Kd = Qs + 64 * PQ;
    LAS bf16* KdT = Kd + 64 * PQ;
    LAS bf16* VT = KdT + 128 * PS;
    LAS bf16* Pm = VT + 32 * PS;
    LAS bf16* ST = Pm + 64 * PS;
    LAS float* dk = (LAS float*)(ST + 32 * PQ);
    const bf16* QKV = (const bf16*)(p.ws + WS_QKV); bf16* VO = (bf16*)(p.ws + WS_QKV); const float* DK = (const float*)(p.ws + WS_DK); float* SS = (float*)(p.ws + WS_SS);
    const int kp = tid & 127, seg = tid >> 7;
    const int vv = tid & 31, sg = tid >> 5;
    const int r0 = tid >> 4, cc = (tid & 15) * 8;
    for (int it = blockIdx.x; it < 8 * 4 * 8; it += G) {
        const int v8 = it & 7, h = (it >> 3) & 3, b = it >> 5;
        pg8::f32x4 sacc[2] = {(pg8::f32x4){0.f, 0.f, 0.f, 0.f}, (pg8::f32x4){0.f, 0.f, 0.f, 0.f}};
        __syncthreads();
        for (int i = tid; i < 32 * PQ / 2; i += NTHR) ((LAS unsigned*)ST)[i] = 0u;
        u32x4 rq[2], rk[2]; unsigned rkt[8], rv[2]; float rdk = 0.f;
#define GLA_LOAD(chn) do { const size_t _t0 = (size_t)b * SEQ + (size_t)(chn) * 64; \
            _Pragma("unroll") for (int _j = 0; _j < 2; ++_j) { rq[_j] = *(const u32x4*)(QKV + (_t0 + r0 + 32 * _j) * 2048 + h * 128 + cc); rk[_j] = *(const u32x4*)(QKV + (_t0 + r0 + 32 * _j) * 2048 + 512 + h * 128 + cc); } \
            _Pragma("unroll") for (int _i = 0; _i < 8; ++_i) { const unsigned _lo = QKV[(_t0 + seg * 16 + 2 * _i) * 2048 + 512 + h * 128 + kp], _hi = QKV[(_t0 + seg * 16 + 2 * _i + 1) * 2048 + 512 + h * 128 + kp]; rkt[_i] = _lo | (_hi << 16); } \
            _Pragma("unroll") for (int _i = 0; _i < 2; ++_i) { const unsigned _lo = QKV[(_t0 + sg * 4 + 2 * _i) * 2048 + 1024 + h * 256 + v8 * 32 + vv], _hi = QKV[(_t0 + sg * 4 + 2 * _i + 1) * 2048 + 1024 + h * 256 + v8 * 32 + vv]; rv[_i] = _lo | (_hi << 16); } \
            if (tid < 128) rdk = DK[(size_t)(b * 128 + (chn)) * 512 + h * 128 + tid]; } while (0)
        GLA_LOAD(0);
#pragma unroll 1
        for (int ch = 0; ch < SEQ / 64; ++ch) {
            const size_t t0 = (size_t)b * SEQ + ch * 64;
#pragma unroll
            for (int j = 0; j < 2; ++j) { *(LAS u32x4*)(Qs + (r0 + 32 * j) * PQ + cc) = rq[j]; *(LAS u32x4*)(Kd + (r0 + 32 * j) * PQ + cc) = rk[j]; }
            *(LAS u32x4*)(KdT + kp * PS + seg * 16) = (u32x4){rkt[0], rkt[1], rkt[2], rkt[3]};
            *(LAS u32x4*)(KdT + kp * PS + seg * 16 + 8) = (u32x4){rkt[4], rkt[5], rkt[6], rkt[7]};
            *(LAS u32x2*)(VT + vv * PS + sg * 4) = (u32x2){rv[0], rv[1]};
            if (tid < 128) dk[tid] = rdk;
            if (ch + 1 < SEQ / 64) GLA_LOAD(ch + 1);
            __syncthreads();
            { const int tt = wave & 3;
#pragma unroll
              for (int i2 = 0; i2 < 2; ++i2) { const int ts = (wave >> 2) * 2 + i2;
                  pg8::f32x4 acc = (pg8::f32x4){0.f, 0.f, 0.f, 0.f};
                  if (ts <= tt) {
#pragma unroll
                      for (int ks = 0; ks < 4; ++ks) { const bf16x8_t a = *(const LAS bf16x8_t*)(Kd + (ts * 16 + c16) * PQ + ks * 32 + q4 * 8), bb = *(const LAS bf16x8_t*)(Qs + (tt * 16 + c16) * PQ + ks * 32 + q4 * 8);
                          acc = __builtin_amdgcn_mfma_f32_16x16x32_bf16(a, bb, acc, 0, 0, 0); }
                      const int tg = tt * 16 + c16, sgl = ts * 16 + q4 * 4;
#pragma unroll
                      for (int j = 0; j < 4; ++j) if (sgl + j > tg) acc[j] = 0.f;
                  }
                  *(LAS u32x2*)(Pm + (tt * 16 + c16) * PS + ts * 16 + q4 * 4) = (u32x2){pk2(acc[0], acc[1]), pk2(acc[2], acc[3])}; } }
            __syncthreads();
            { const int tt = wave & 3, tv = wave >> 2;
              pg8::f32x4 oacc = (pg8::f32x4){0.f, 0.f, 0.f, 0.f};
#pragma unroll
              for (int ks = 0; ks < 2; ++ks) { const bf16x8_t bb = *(const LAS bf16x8_t*)(Pm + (tt * 16 + c16) * PS + ks * 32 + q4 * 8), a = *(const LAS bf16x8_t*)(VT + (tv * 16 + c16) * PS + ks * 32 + q4 * 8);
                  oacc = __builtin_amdgcn_mfma_f32_16x16x32_bf16(a, bb, oacc, 0, 0, 0); }
#pragma unroll
              for (int ks = 0; ks < 4; ++ks) { const bf16x8_t bb = *(const LAS bf16x8_t*)(Qs + (tt * 16 + c16) * PQ + ks * 32 + q4 * 8), a = *(const LAS bf16x8_t*)(ST + (tv * 16 + c16) * PQ + ks * 32 + q4 * 8);
                  oacc = __builtin_amdgcn_mfma_f32_16x16x32_bf16(a, bb, oacc, 0, 0, 0); }
              *(u32x2*)(VO + (t0 + tt * 16 + c16) * 2048 + 1024 + h * 256 + v8 * 32 + tv * 16 + q4 * 4) = (u32x2){pk2(oacc[0], oacc[1]), pk2(oacc[2], oacc[3])};
              float sq = (oacc[0] * oacc[0] + oacc[1] * oacc[1]) + (oacc[2] * oacc[2] + oacc[3] * oacc[3]);
              sq += __shfl_xor(sq, 16); sq += __shfl_xor(sq, 32);
              if (q4 == 0) atomicAdd(SS + (t0 + tt * 16 + c16) * 4 + h, sq); }
#pragma unroll
            for (int ks = 0; ks < 2; ++ks) { const bf16x8_t a = *(const LAS bf16x8_t*)(KdT + (wave * 16 + c16) * PS + ks * 32 + q4 * 8);
#pragma unroll
                for (int tv = 0; tv < 2; ++tv) { const bf16x8_t bb = *(const LAS bf16x8_t*)(VT + (tv * 16 + c16) * PS + ks * 32 + q4 * 8);
                    sacc[tv] = __builtin_amdgcn_mfma_f32_16x16x32_bf16(a, bb, sacc[tv], 0, 0, 0); } }
            { const pg8::f32x4 d4 = *(const LAS pg8::f32x4*)(dk + wave * 16 + q4 * 4);
#pragma unroll
              for (int tv = 0; tv < 2; ++tv) sacc[tv] = sacc[tv] * d4; }
            __syncthreads();
#pragma unroll
            for (int tv = 0; tv < 2; ++tv) *(LAS u32x2*)(ST + (tv * 16 + c16) * PQ + wave * 16 + q4 * 4) = (u32x2){pk2(sacc[tv][0], sacc[tv][1]), pk2(sacc[tv][2], sacc[tv][3])};
        }
#undef GLA_LOAD
    }
}

__device__ __forceinline__ void phase_norm2(const Params& p, LAS unsigned char* lds, int G) {
    const int tid = threadIdx.x, lane = tid & 63, wave = __builtin_amdgcn_readfirstlane(tid >> 6);
    const float* modp = (const float*)(p.ws + WS_MODP);
    LAS float* g1 = (LAS float*)lds; LAS float* gs = g1 + 1024; LAS float* sh = gs + 1024;
    const bf16* Y = (const bf16*)(p.ws + WS_Y); bf16* H2 = (bf16*)(p.ws + WS_H2);
    for (int tile = blockIdx.x; tile < T / 256; tile += G) {
        const int b = tile / 32;
        __syncthreads();
        for (int k = tid; k < 1024; k += NTHR) { g1[k] = mod_at(modp, b, 2048 + k) * p.npo[k]; gs[k] = p.npf[k] * (1.f + mod_at(modp, b, 4096 + k)); sh[k] = mod_at(modp, b, 3072 + k); }
        __syncthreads();
        for (int rr = 0; rr < 32; ++rr) {
            const size_t row = (size_t)tile * 256 + wave * 32 + rr;
            const f32x4* xr = (const f32x4*)(p.x + row * 1024) + lane; const u32x2* yr = (const u32x2*)(Y + row * 1024) + lane;
            f32x4 xv[4], yv[4]; float s = 0.f;
#pragma unroll
            for (int j = 0; j < 4; ++j) { xv[j] = xr[64 * j]; const u32x2 yw = yr[64 * j]; yv[j] = (f32x4){bflo(yw.x), bfhi(yw.x), bflo(yw.y), bfhi(yw.y)};
                s += (yv[j].x * yv[j].x + yv[j].y * yv[j].y) + (yv[j].z * yv[j].z + yv[j].w * yv[j].w); }
            const float rstd = __builtin_amdgcn_rsqf(wave_sum(s) * (1.f / 1024.f) + 1e-6f);
            float s2 = 0.f;
            f32x4* orow = (f32x4*)(p.out + row * 1024) + lane;
#pragma unroll
            for (int j = 0; j < 4; ++j) { const int k = 256 * j + 4 * lane; const f32x4 g4 = *(const LAS f32x4*)(g1 + k);
                xv[j] = xv[j] + yv[j] * rstd * g4; orow[64 * j] = xv[j];
                s2 += (xv[j].x * xv[j].x + xv[j].y * xv[j].y) + (xv[j].z * xv[j].z + xv[j].w * xv[j].w); }
            const float rstd2 = __builtin_amdgcn_rsqf(wave_sum(s2) * (1.f / 1024.f) + 1e-6f);
            u32x2* o8 = (u32x2*)(H2 + row * 1024) + lane;
#pragma unroll
            for (int j = 0; j < 4; ++j) { const int k = 256 * j + 4 * lane; const f32x4 g4 = *(const LAS f32x4*)(gs + k), s4 = *(const LAS f32x4*)(sh + k);
                u32x2 w; w.x = pk2(xv[j].x * rstd2 * g4.x + s4.x, xv[j].y * rstd2 * g4.y + s4.y); w.y = pk2(xv[j].z * rstd2 * g4.z + s4.z, xv[j].w * rstd2 * g4.w + s4.w);
                o8[64 * j] = w; }
        }
    }
}

__device__ __forceinline__ unsigned h16_key(unsigned b) { return (b & 0x8000u) ? (~b & 0xffffu) : (b | 0x8000u); }
__device__ __forceinline__ float h16_key_val(unsigned s) { const unsigned b = (s & 0x8000u) ? (s & 0x7fffu) : (~s & 0xffffu); return (float)__builtin_bit_cast(_Float16, (unsigned short)b); }
template <bool ASC> __device__ __forceinline__ void sort16(unsigned (&k)[16]) {
#pragma unroll
    for (int size = 2; size <= 16; size <<= 1)
#pragma unroll
        for (int stride = size >> 1; stride > 0; stride >>= 1)
#pragma unroll
            for (int i = 0; i < 16; ++i) { const int j = i ^ stride; if (j > i) { const bool up = ((i & size) == 0) == ASC; const unsigned lo = min(k[i], k[j]), hi = max(k[i], k[j]); k[i] = up ? lo : hi; k[j] = up ? hi : lo; } }
}
__device__ __forceinline__ void merge16_desc(unsigned (&k)[16]) {
#pragma unroll
    for (int stride = 8; stride > 0; stride >>= 1)
#pragma unroll
        for (int i = 0; i < 16; ++i) { const int j = i ^ stride; if (j > i) { const unsigned lo = min(k[i], k[j]), hi = max(k[i], k[j]); k[i] = hi; k[j] = lo; } }
}
__device__ __forceinline__ void top16_merge(unsigned (&top)[16], unsigned (&grp)[16]) {
    sort16<true>(grp);
#pragma unroll
    for (int i = 0; i < 16; ++i) top[i] = max(top[i], grp[i]);
    merge16_desc(top);
}
__device__ __forceinline__ void keys16(unsigned (&k)[16], const u32x4 w0, const u32x4 w1, int n0) {
    const unsigned ww[8] = {w0.x, w0.y, w0.z, w0.w, w1.x, w1.y, w1.z, w1.w};
#pragma unroll
    for (int q = 0; q < 8; ++q) { k[2 * q] = (h16_key(ww[q] & 0xffffu) << 16) | (unsigned)(127 - (n0 + 2 * q)); k[2 * q + 1] = (h16_key(ww[q] >> 16) << 16) | (unsigned)(127 - (n0 + 2 * q + 1)); }
}
__device__ __forceinline__ void phase_topk(const Params& p, LAS unsigned char* lds, int G) {
    const int tid = threadIdx.x;
    const unsigned short* SC = (const unsigned short*)(p.ws + WS_SC); unsigned* TK = (unsigned*)(p.ws + WS_TOPK); float* TK2 = (float*)(p.ws + WS_TOPK2);
    const float* SU = (const float*)(p.ws + WS_SU); const float* SV = (const float*)(p.ws + WS_SV);
    LAS unsigned* my = (LAS unsigned*)lds + tid * 33;
    for (int blk = blockIdx.x; blk < T * 8 / NTHR; blk += G) {
        const int item = blk * NTHR + tid, t = item >> 3, h = item & 7;
        const u32x4* src = (const u32x4*)(SC + (size_t)t * 2048 + h * 256);
        unsigned topA[16], topB[16];
        keys16(topA, src[0], src[1], 0); sort16<false>(topA);
#pragma unroll 1
        for (int g = 1; g < 8; ++g) { unsigned grp[16]; keys16(grp, src[2 * g], src[2 * g + 1], 16 * g); top16_merge(topA, grp); }
        keys16(topB, src[16], src[17], 0); sort16<false>(topB);
#pragma unroll 1
        for (int g = 1; g < 8; ++g) { unsigned grp[16]; keys16(grp, src[16 + 2 * g], src[17 + 2 * g], 16 * g); top16_merge(topB, grp); }
        float fa[16], fb[16];
#pragma unroll
        for (int j = 0; j < 16; ++j) { fa[j] = h16_key_val(topA[j] >> 16); fb[j] = h16_key_val(topB[j] >> 16); my[j] = 127u - (topA[j] & 127u); my[16 + j] = 127u - (topB[j] & 127u); }
        unsigned ct[16];
#pragma unroll
        for (int g = 0; g < 4; ++g) { unsigned grp[16];
#pragma unroll
            for (int s = 0; s < 16; ++s) grp[s] = 0u;
            { int slot = 0;
#pragma unroll
              for (int i = 0; i < 16; ++i)
#pragma unroll
                  for (int j = 0; j < 16; ++j) if ((i + 1) * (j + 1) <= 16) { if ((slot >> 4) == g) {
                      const float s = fa[i] + fb[j]; unsigned u = __builtin_bit_cast(unsigned, s); u ^= (u >> 31) ? 0xffffffffu : 0x80000000u;
                      grp[slot & 15] = (u & 0xffffff00u) | (unsigned)(255 - (i * 16 + j)); } ++slot; } }
            if (g == 0) { sort16<false>(grp);
#pragma unroll
                for (int s = 0; s < 16; ++s) ct[s] = grp[s]; }
            else top16_merge(ct, grp); }
        float val[16], mx, sum = 0.f;
#pragma unroll
        for (int m = 0; m < 16; ++m) { unsigned u = ct[m] & 0xffffff00u; u ^= (u >> 31) ? 0x80000000u : 0xffffffffu; val[m] = __builtin_bit_cast(float, u); }
        mx = val[0];
#pragma unroll
        for (int m = 0; m < 16; ++m) { val[m] = __expf(val[m] - mx); sum += val[m]; }
        const float inv = 1.f / sum;
        LDS_WAIT();
        unsigned outw[16]; float outs[16];
#pragma unroll
        for (int m = 0; m < 16; ++m) { const unsigned pos = 255u - (ct[m] & 255u), i = pos >> 4, j = pos & 15u;
            const unsigned e = my[i] * 128u + my[16 + j];
            outw[m] = (e << 16) | f2bf(val[m] * inv * SV[e]); outs[m] = SU[e]; }
        u32x4* dst = (u32x4*)(TK + (size_t)item * 16); f32x4* dst2 = (f32x4*)(TK2 + (size_t)item * 16);
#pragma unroll
        for (int q = 0; q < 4; ++q) { dst[q] = (u32x4){outw[4 * q], outw[4 * q + 1], outw[4 * q + 2], outw[4 * q + 3]}; dst2[q] = (f32x4){outs[4 * q], outs[4 * q + 1], outs[4 * q + 2], outs[4 * q + 3]}; }
    }
}

typedef unsigned u32x3 __attribute__((ext_vector_type(3)));
typedef unsigned u32x6 __attribute__((ext_vector_type(6)));
typedef float f32x32 __attribute__((ext_vector_type(32)));
__device__ __forceinline__ float rdlane(float v, int l) { return __builtin_bit_cast(float, __builtin_amdgcn_readlane(__builtin_bit_cast(int, v), l)); }
__device__ __forceinline__ f32x32 fp6x2(u32x3 a, u32x3 b) { const u32x6 s = {a.x, a.y, a.z, b.x, b.y, b.z}; return __builtin_amdgcn_cvt_scalef32_pk32_f32_fp6(s, 1.0f); }
__device__ __forceinline__ void phase_gather(const Params& p, LAS unsigned char* lds, int G) {
    const int tid = threadIdx.x, lane = tid & 63, wave = __builtin_amdgcn_readfirstlane(tid >> 6);
    const float* modp = (const float*)(p.ws + WS_MODP);
    LAS float* g2 = (LAS float*)lds;
    const bf16* H2 = (const bf16*)(p.ws + WS_H2); const unsigned* TK = (const unsigned*)(p.ws + WS_TOPK); const float* TK2 = (const float*)(p.ws + WS_TOPK2);
    const unsigned char* U6 = p.ws + WS_U; const unsigned char* V6 = p.ws + WS_V;
    for (int tile = blockIdx.x; tile < T / 256; tile += G) {
        const int b = tile / 32;
        __syncthreads();
        for (int k = tid; k < 1024; k += NTHR) g2[k] = mod_at(modp, b, 5120 + k) * p.npof[k];
        __syncthreads();
#pragma unroll 1
        for (int rr = 0; rr < 32; ++rr) {
            const size_t row = (size_t)tile * 256 + wave * 32 + rr;
            float xt[16];
            { const u32x4 a = *(const u32x4*)(H2 + row * 1024 + lane * 16), c = *(const u32x4*)(H2 + row * 1024 + lane * 16 + 8);
              xt[0] = bflo(a.x); xt[1] = bfhi(a.x); xt[2] = bflo(a.y); xt[3] = bfhi(a.y); xt[4] = bflo(a.z); xt[5] = bfhi(a.z); xt[6] = bflo(a.w); xt[7] = bfhi(a.w);
              xt[8] = bflo(c.x); xt[9] = bfhi(c.x); xt[10] = bflo(c.y); xt[11] = bfhi(c.y); xt[12] = bflo(c.z); xt[13] = bfhi(c.z); xt[14] = bflo(c.w); xt[15] = bfhi(c.w); }
            float acc[16];
#pragma unroll
            for (int j = 0; j < 16; ++j) acc[j] = 0.f;
#pragma unroll 1
            for (int hh = 0; hh < 16; ++hh) {
                const u32x4* ra = (const u32x4*)(TK + row * 128 + hh * 8);
                const u32x4 w0 = ra[0], w1 = ra[1];
                const unsigned ww[8] = {w0.x, w0.y, w0.z, w0.w, w1.x, w1.y, w1.z, w1.w};
                u32x6 up[4], vp[4];
#pragma unroll
                for (int m = 0; m < 8; ++m) { const size_t eo = (size_t)((unsigned)__builtin_amdgcn_readfirstlane((int)ww[m]) >> 16) * 768 + lane * 12;
                    const u32x3 a = *(const u32x3*)(U6 + eo), c = *(const u32x3*)(V6 + eo);
                    if (m & 1) { up[m >> 1][3] = a.x; up[m >> 1][4] = a.y; up[m >> 1][5] = a.z; vp[m >> 1][3] = c.x; vp[m >> 1][4] = c.y; vp[m >> 1][5] = c.z; }
                    else { up[m >> 1][0] = a.x; up[m >> 1][1] = a.y; up[m >> 1][2] = a.z; vp[m >> 1][0] = c.x; vp[m >> 1][1] = c.y; vp[m >> 1][2] = c.z; } }
                const unsigned wa = TK[row * 128 + hh * 8 + (lane >> 3)]; const float su = TK2[row * 128 + hh * 8 + (lane >> 3)];
                float pd[8];
#pragma unroll
                for (int m = 0; m < 8; m += 2) { const f32x32 f = __builtin_amdgcn_cvt_scalef32_pk32_f32_fp6(up[m >> 1], 1.0f);
                    float s0 = 0.f, s1 = 0.f;
#pragma unroll
                    for (int j = 0; j < 16; ++j) { s0 += xt[j] * f[j]; s1 += xt[j] * f[16 + j]; }
                    pd[m] = s0; pd[m + 1] = s1; __builtin_amdgcn_sched_barrier(0); }
#pragma unroll
                for (int j = 0; j < 4; ++j) { const bool up_ = (lane & 32) != 0; const float keep = up_ ? pd[j + 4] : pd[j], send = up_ ? pd[j] : pd[j + 4]; pd[j] = keep + __shfl_xor(send, 32); }
#pragma unroll
                for (int j = 0; j < 2; ++j) { const bool up_ = (lane & 16) != 0; const float keep = up_ ? pd[j + 2] : pd[j], send = up_ ? pd[j] : pd[j + 2]; pd[j] = keep + __shfl_xor(send, 16); }
                { const bool up_ = (lane & 8) != 0; const float keep = up_ ? pd[1] : pd[0], send = up_ ? pd[0] : pd[1]; pd[0] = keep + __shfl_xor(send, 8); }
                float d = pd[0]; d += __shfl_xor(d, 4); d += __shfl_xor(d, 2); d += __shfl_xor(d, 1);
                const float coef = bflo(wa) * gelu_f(su * d);
#pragma unroll
                for (int m = 0; m < 8; m += 2) { const f32x32 f = __builtin_amdgcn_cvt_scalef32_pk32_f32_fp6(vp[m >> 1], 1.0f); const float c0 = rdlane(coef, 8 * m), c1 = rdlane(coef, 8 * m + 8);
#pragma unroll
                    for (int j = 0; j < 16; ++j) acc[j] += c0 * f[j] + c1 * f[16 + j];
                    __builtin_amdgcn_sched_barrier(0); }
            }
            float s = 0.f;
#pragma unroll
            for (int j = 0; j < 16; ++j) s += acc[j] * acc[j];
            const float rstd = __builtin_amdgcn_rsqf(wave_sum(s) * (1.f / 1024.f) + 1e-6f);
            float* orow = p.out + row * 1024 + lane * 16;
#pragma unroll
            for (int q = 0; q < 4; ++q) { f32x4 o = *(const f32x4*)(orow + 4 * q); const f32x4 ga = *(const LAS f32x4*)(g2 + lane * 16 + 4 * q);
                o.x += ga.x * acc[4 * q] * rstd; o.y += ga.y * acc[4 * q + 1] * rstd; o.z += ga.z * acc[4 * q + 2] * rstd; o.w += ga.w * acc[4 * q + 3] * rstd;
                *(f32x4*)(orow + 4 * q) = o; }
        }
    }
}

#define XB_TMO      128
#define XB_XCNT(j)  (256  + 64 * (j))
#define XB_XSUB(j)  (1280 + 64 * (j))
#define XB_XGEN(j)  (2304 + 64 * (j))
#define XB_TOP      3328
#define XB_TOPGEN   3392
#define XCD_BAR_WORDS 3456
#define XB_SPIN_CAP (1u << 18)

__device__ __forceinline__ unsigned xb_ld(unsigned* p)              { return __hip_atomic_load(p, __ATOMIC_RELAXED, __HIP_MEMORY_SCOPE_AGENT); }
__device__ __forceinline__ unsigned xb_add(unsigned* p, unsigned v) { return __hip_atomic_fetch_add(p, v, __ATOMIC_RELAXED, __HIP_MEMORY_SCOPE_AGENT); }
__device__ __forceinline__ unsigned xb_xcc_id() { return (unsigned)__builtin_amdgcn_s_getreg((3 << 11) | 20) & 0xFu; }
#define XB_SPIN(cond, bar) do { unsigned _sp = 0; while (cond) { __builtin_amdgcn_s_sleep(1); \
    if ((++_sp & 255u) == 0u) { if (xb_ld(&(bar)[XB_TMO])) break; if (_sp > XB_SPIN_CAP) { atomicAdd(&(bar)[XB_TMO], 1u); break; } } } } while (0)

struct XcdBarrier {
    unsigned* bar; unsigned x;
    volatile LAS unsigned* st;
};

__device__ __forceinline__ XcdBarrier xcd_barrier_post(unsigned* bar, volatile LAS unsigned* st) {
    XcdBarrier b; b.bar = bar; b.x = xb_xcc_id(); b.st = st;
    if (threadIdx.x == 0) (void)xb_add(&bar[XB_XCNT(b.x)], 1u);
    return b;
}
__device__ __forceinline__ void xcd_barrier_complete(unsigned* bar, unsigned x, unsigned& nloc, unsigned& nx) {
    const unsigned G = gridDim.x * gridDim.y * gridDim.z;
    unsigned sum, cnt, mine, sp = 0u;
    for (;;) {
        sum = 0u; cnt = 0u; mine = 0u;
#pragma unroll
        for (unsigned j = 0; j < 16; ++j) { const unsigned c = xb_ld(&bar[XB_XCNT(j)]); sum += c; cnt += (c > 0u) ? 1u : 0u; mine = (j == x) ? c : mine; }
        if (sum == G) break;
        __builtin_amdgcn_s_sleep(1);
        if ((++sp & 255u) == 0u) { if (xb_ld(&bar[XB_TMO])) break; if (sp > XB_SPIN_CAP) { atomicAdd(&bar[XB_TMO], 1u); break; } }
    }
    nloc = mine > 0u ? mine : 1u; nx = cnt > 0u ? cnt : 1u;
}

__device__ __forceinline__ void xcd_barrier(const XcdBarrier& b) {
    asm volatile("s_waitcnt vmcnt(0)" ::: "memory");
    __syncthreads();
    if (threadIdx.x == 0) {
        unsigned* bar = b.bar;
        __builtin_amdgcn_s_waitcnt(0);
        unsigned nloc = b.st[0], nx = b.st[1];
        if (nloc == 0u) { xcd_barrier_complete(bar, b.x, nloc, nx); b.st[0] = nloc; b.st[1] = nx; }
        const unsigned old = xb_add(&bar[XB_XSUB(b.x)], 1u);
        const unsigned gen = old / nloc;
        if (old + 1u == (gen + 1u) * nloc) {
            __builtin_amdgcn_fence(__ATOMIC_RELEASE, "agent");
            asm volatile("s_waitcnt vmcnt(0)" ::: "memory");
            const unsigned og = xb_add(&bar[XB_TOP], 1u);
            const unsigned tg = og / nx;
            if (og + 1u == (tg + 1u) * nx) xb_add(&bar[XB_TOPGEN], 1u);
            else XB_SPIN(xb_ld(&bar[XB_TOPGEN]) == tg, bar);
            __builtin_amdgcn_fence(__ATOMIC_ACQUIRE, "agent");
            xb_add(&bar[XB_XGEN(b.x)], 1u);
            asm volatile("s_waitcnt vmcnt(0)" ::: "memory");
        } else {
            XB_SPIN(xb_ld(&bar[XB_XGEN(b.x)]) == gen, bar);
            __builtin_amdgcn_fence(__ATOMIC_ACQUIRE, "agent");
            asm volatile("s_waitcnt vmcnt(0)" ::: "memory");
        }
    }
    __syncthreads();
}


template <int PH>
__device__ __forceinline__ void run_phase(const Params& p, LAS unsigned char* lds, int G) {
    unsigned char* ws = p.ws;
    if constexpr (PH == 0) phase0(p, lds, G);
    else if constexpr (PH == 1) {
        { pg8::Gemm g{(const bf16*)(ws + WS_WQB), (const bf16*)(ws + WS_SUBK), 1024, 2048, 256, 2048}; pg8::StaticOrder S; S.init(1024, 2048, G, (int)blockIdx.x);
          EpiTrans E{(bf16*)(ws + WS_WQ), 1024}; pg8::gemm_phase<EpiTrans, pg8::StaticOrder, true, true, 2, 256, 2048>(lds, g, S, E); }
        __syncthreads();
        phase1(p, lds, G); }
    else if constexpr (PH == 2) { pg8::Gemm g{(const bf16*)p.out, (const bf16*)(ws + WS_WIN), T, NPAD, 1024, 1024}; pg8::StaticOrder S; S.init(T, NPAD, G, (int)blockIdx.x);
        EpiSeg E{ws}; pg8::gemm_phase<EpiSeg, pg8::StaticOrder, true, true, 0, 1024, 1024>(lds, g, S, E); }
    else if constexpr (PH == 3) { phase_gla_prep(p, lds, G); __syncthreads(); phase_lru<false>(p, lds, G); }
    else if constexpr (PH == 4) phase_gla_seq(p, lds, G);
    else if constexpr (PH == 5) phase_lru<true>(p, lds, G);
    else if constexpr (PH == 6) { pg8::Gemm g{(const bf16*)(ws + WS_GAGB), (const bf16*)(ws + WS_WOUT), T, 1024, 1024, 2048}; pg8::StaticOrder S; S.init(T, 1024, G, (int)blockIdx.x);
        EpiPlain E{(bf16*)(ws + WS_Y), 1024}; pg8::gemm_phase<EpiPlain, pg8::StaticOrder, true, true, 0, 1024, 2048>(lds, g, S, E); }
    else if constexpr (PH == 7) phase_norm2(p, lds, G);
    else if constexpr (PH == 8) {
        pg8::Gemm g{(const bf16*)(ws + WS_H2), (const bf16*)(ws + WS_WQ), T, 2048, 1024, 1024}; pg8::StaticOrder S; S.init(T, 2048, G, (int)blockIdx.x);
        EpiF16 E{(unsigned short*)(ws + WS_SC), 2048}; pg8::gemm_phase<EpiF16, pg8::StaticOrder, true, true, 0, 1024, 1024>(lds, g, S, E); }
    else if constexpr (PH == 9) phase_topk(p, lds, G);
    else if constexpr (PH == 10) phase_gather(p, lds, G);
}
template <int PH>
__global__ void __launch_bounds__(NTHR, 2) k_phase(Params p) {
    extern __shared__ __attribute__((aligned(16))) unsigned char lds_raw[];
    run_phase<PH>(p, (LAS unsigned char*)lds_raw, (int)gridDim.x);
}
constexpr int LDS_BAR_OFF = LDS_BYTES - 16;
template <int PH>
__device__ __forceinline__ void run_from(const Params& p, LAS unsigned char* lds, int G, const XcdBarrier& bar) {
#if PROBE_PH >= 0
    unsigned long long pt0 = 0; if constexpr (PH == PROBE_PH) pt0 = __builtin_amdgcn_s_memrealtime();
#endif
    run_phase<PH>(p, lds, G);
    if constexpr (PH + 1 < N_PHASES) {
        if constexpr (PH == 0) cg::this_grid().sync();
        else xcd_barrier(bar);
    }
#if PROBE_PH >= 0
    if constexpr (PH == PROBE_PH) { const unsigned long long pt1 = __builtin_amdgcn_s_memrealtime(), span = pt1 - pt0;
        while (__builtin_amdgcn_s_memrealtime() - pt1 < (unsigned long long)PROBE_MULT * span) __builtin_amdgcn_s_sleep(8); }
#endif
    if constexpr (PH + 1 < N_PHASES) run_from<PH + 1>(p, lds, G, bar);
}
__global__ void __launch_bounds__(NTHR, 2) k_mega(Params p) {
    extern __shared__ __attribute__((aligned(16))) unsigned char lds_raw[];
    LAS unsigned char* lds = (LAS unsigned char*)lds_raw;
    if (threadIdx.x < 4) ((LAS unsigned*)(lds + LDS_BAR_OFF))[threadIdx.x] = 0u;
    __syncthreads();
    const XcdBarrier bar = xcd_barrier_post((unsigned*)(p.ws + WS_CTL), (volatile LAS unsigned*)(lds + LDS_BAR_OFF));
    run_from<0>(p, lds, (int)gridDim.x, bar);
}

extern "C" void kernel_launch(void* const* d_in, const int* in_sizes, int n_in, void* d_out, int out_size, void* d_ws, size_t ws_size, hipStream_t stream) {
    static int grid = 0;
    if (grid == 0) {
        if (n_in != 24 || in_sizes[0] != T * DM || out_size != T * DM || ws_size < WS_END) {
            fprintf(stderr, "kernel_launch: unexpected shapes: n_in %d in0 %d out %d ws %zu\n", n_in, n_in > 0 ? in_sizes[0] : -1, out_size, ws_size); grid = -1; return; }
        int dev = 0, cus = 0, per_cu = 0;
        if (hipGetDevice(&dev) != hipSuccess || hipDeviceGetAttribute(&cus, hipDeviceAttributeMultiprocessorCount, dev) != hipSuccess) { grid = -1; return; }
        if (hipFuncSetAttribute((const void*)k_mega, hipFuncAttributeMaxDynamicSharedMemorySize, LDS_BYTES) != hipSuccess) { fprintf(stderr, "kernel_launch: hipFuncSetAttribute failed\n"); grid = -1; return; }
        if (hipOccupancyMaxActiveBlocksPerMultiprocessor(&per_cu, (const void*)k_mega, NTHR, LDS_BYTES) != hipSuccess || per_cu < 1) { fprintf(stderr, "kernel_launch: occupancy query says %d blocks per CU\n", per_cu); grid = -1; return; }
        (void)hipGetLastError();
        grid = cus;
    }
    if (grid < 0) return;
    Params p{};
    const float** pp = (const float**)&p;
    for (int i = 0; i < 24; ++i) pp[i] = (const float*)d_in[i];
    p.out = (float*)d_out; p.ws = (unsigned char*)d_ws;
    if (hipMemsetAsync((char*)d_ws + WS_CTL, 0, 65536, stream) != hipSuccess) { fprintf(stderr, "kernel_launch: hipMemsetAsync failed\n"); return; }
    void* args[] = {&p};
    hipError_t e = hipLaunchCooperativeKernel((const void*)k_mega, dim3(grid), dim3(NTHR), args, LDS_BYTES, stream);
    if (e != hipSuccess) fprintf(stderr, "kernel_launch: cooperative launch failed: %s (grid %d)\n", hipGetErrorString(e), grid);
}
```

```cpp
#include <hip/hip_runtime.h>
#include <hip/hip_cooperative_groups.h>
#include <cstdio>
#include <cstdint>
#include <utility>
namespace cg = cooperative_groups;

namespace pg8 {
#define PG8_LAS __attribute__((address_space(3)))
typedef unsigned short bf16_t;
typedef short bf16x8 __attribute__((ext_vector_type(8)));
typedef float f32x4 __attribute__((ext_vector_type(4)));
typedef unsigned u32x4 __attribute__((ext_vector_type(4)));
constexpr int BM = 256, BK = 64, HALF = 128, HTB = HALF * BK * 2  , STAGE_BYTES = 8 * HTB, NXCD = 8, WGM = 8;

__host__ __device__ __forceinline__ int lds_byte(int r, int c) { const int st = (r >> 4) * 2 + (c >> 5), rr = r & 15, cc = c & 31, ob = rr * 64 + cc * 2; return st * 1024 + (ob ^ (((ob >> 9) & 1) << 5)); }
__host__ __device__ __forceinline__ void stage_rc(int b, int& R, int& C) { const int st = b / 1024, sb = b % 1024, swz = sb ^ (((sb >> 9) & 1) << 5); R = (st >> 1) * 16 + swz / 64; C = (st & 1) * 32 + (swz % 64) / 2; }
__host__ __device__ __forceinline__ int perm32(int rho) { const int n = rho >> 4, i = rho & 15; return 8 * (i >> 2) + 4 * n + (i & 3); }

struct Unit { int pm, pn; };
struct Gemm { const bf16_t* A; const bf16_t* Bt; int M, N, K, lda; };
template <int AMODE> __device__ __forceinline__ size_t a_off_bytes(const Gemm& g, const Unit& u) {
    const int ac = AMODE == 0 ? 0 : (AMODE == 1 ? 128 * (u.pn < 6 ? u.pn : 6) : 256 * u.pn);
    return ((size_t)u.pm * BM * (size_t)g.lda + (size_t)ac) * 2;
}

struct StaticOrder {
    int nM, nN, nwg, G, c;
    __host__ __device__ void init(int M, int N, int G_, int c_) { nM = M / BM; nN = N / BM; nwg = nM * nN; G = G_; c = c_; }
    __host__ __device__ bool next(int i, Unit& u) const {
        const long L = (long)i * G + c; if (L >= nwg) return false;
        int wgid = (int)L; { const int q = nwg / NXCD, r = nwg % NXCD, xcd = wgid % NXCD, off = wgid / NXCD; wgid = (xcd < r ? xcd * (q + 1) : r * (q + 1) + (xcd - r) * q) + off; }
        const int nig = WGM * nN, gid = wgid / nig, fm = gid * WGM, gsz = (nM - fm) < WGM ? (nM - fm) : WGM;
        u.pm = fm + ((wgid % nig) % gsz); u.pn = (wgid % nig) / gsz; return true;
    }
    __device__ __forceinline__ void a_ready(const Unit&) const {}
    __device__ __forceinline__ void done(const Unit&) const {}
};

__device__ __forceinline__ unsigned cvt_pk_bf16(float lo, float hi) { unsigned r; asm volatile("v_cvt_pk_bf16_f32 %0, %1, %2" : "=v"(r) : "v"(lo), "v"(hi)); return r; }

template <class Epi, class Sched, bool ALIGN_EPI = false, bool SP2 = false, int AMODE = 0, int KC = 0, int LDAC = 0>
__device__ __forceinline__ void gemm_phase(PG8_LAS unsigned char* lds, const Gemm g, const Sched& S, const Epi& E) {
    const int tid = threadIdx.x, wid = __builtin_amdgcn_readfirstlane(tid >> 6), lane = tid & 63, wr = wid >> 2, wc = wid & 3, fr = lane & 15, fq = lane >> 4;
    const int K = KC ? KC : g.K, nt = K / BK; const int lda = LDAC ? LDAC : g.lda;
    unsigned voffA[2], voffB[2];
#pragma unroll
    for (int i = 0; i < 2; ++i) { int R, C; stage_rc(tid * 16 + i * 8192, R, C); const int Rb = Epi::PERM ? ((R & ~31) + perm32(R & 31)) : R;
        voffA[i] = (unsigned)(R * lda + C) * 2u; voffB[i] = (unsigned)(Rb * K + C) * 2u; }
    const size_t kstep = (size_t)(BK * 2);
    const size_t hstepA = (size_t)HALF * lda * 2;
    const size_t hstepB = (size_t)HALF * K * 2;
    const size_t tstepB = 2 * hstepB;
    const unsigned ldsw = (unsigned)wid * 1024u;
    const int aoff = lds_byte(wr * 64 + fr, fq * 8), boff = lds_byte(wc * 32 + fr, fq * 8);
#define PG8_SA(b, h) (((b) * 2 + (h)) * HTB)
#define PG8_SB(b, h) ((4 + (b) * 2 + (h)) * HTB)
#define PG8_STAGE(bufoff, gbase, voff) do { _Pragma("unroll") for (int _i = 0; _i < 2; ++_i) \
        __builtin_amdgcn_global_load_lds((const unsigned*)((const char*)(gbase) + (voff)[_i]), (PG8_LAS unsigned*)(lds + (bufoff) + ldsw + _i * 8192), 16, 0, 0); } while (0)
#define PG8_LDA(dst, b, h) do { _Pragma("unroll") for (int m = 0; m < 4; ++m) _Pragma("unroll") for (int k = 0; k < 2; ++k) dst[m][k] = *(const PG8_LAS bf16x8*)(lds + PG8_SA(b, h) + aoff + m * 2048 + k * 1024); } while (0)
#define PG8_LDB(dst, b, h) do { _Pragma("unroll") for (int n = 0; n < 2; ++n) _Pragma("unroll") for (int k = 0; k < 2; ++k) dst[n][k] = *(const PG8_LAS bf16x8*)(lds + PG8_SB(b, h) + boff + n * 2048 + k * 1024); } while (0)
#define PG8_MMA(ai, bj, At, Bt) do { __builtin_amdgcn_s_setprio(1); _Pragma("unroll") for (int m = 0; m < 4; ++m) _Pragma("unroll") for (int n = 0; n < 2; ++n) _Pragma("unroll") for (int k = 0; k < 2; ++k) \
        acc[ai][bj][m][n] = __builtin_amdgcn_mfma_f32_16x16x32_bf16(Bt[n][k], At[m][k], acc[ai][bj][m][n], 0, 0, 0); __builtin_amdgcn_s_setprio(0); } while (0)
#define PG8_WAIT_V(n) asm volatile("s_waitcnt vmcnt(" #n ")" ::: "memory")
#define PG8_WAIT_L(n) asm volatile("s_waitcnt lgkmcnt(" #n ")" ::: "memory")
#define PG8_BAR __builtin_amdgcn_s_barrier()
#define PG8_SCHED __builtin_amdgcn_sched_barrier(0)
    Unit cur, nxt; int ui = 0;
    if (!S.next(0, cur)) return;
    f32x4 acc[2][2][4][2];
#pragma unroll
    for (int a = 0; a < 2; ++a)
#pragma unroll
        for (int b = 0; b < 2; ++b)
#pragma unroll
            for (int m = 0; m < 4; ++m)
#pragma unroll
                for (int n = 0; n < 2; ++n) acc[a][b][m][n] = (f32x4){0.f, 0.f, 0.f, 0.f};
    bf16x8 At[4][2], B0[2][2], B1[2][2];
    const char* cA = (const char*)g.A + a_off_bytes<AMODE>(g, cur); const char* cB = (const char*)g.Bt + (size_t)cur.pn * tstepB;
    S.a_ready(cur);
    if constexpr (SP2) {
        PG8_STAGE(PG8_SB(0, 0), cB, voffB); PG8_STAGE(PG8_SB(0, 1), cB + hstepB, voffB); PG8_STAGE(PG8_SA(0, 0), cA, voffA); PG8_STAGE(PG8_SA(0, 1), cA + hstepA, voffA);
        if (wr == 1) PG8_BAR;
        PG8_WAIT_V(2); PG8_BAR;
        PG8_STAGE(PG8_SB(1, 0), cB + kstep, voffB); PG8_STAGE(PG8_SA(1, 0), cA + kstep, voffA); PG8_STAGE(PG8_SB(1, 1), cB + hstepB + kstep, voffB);
        PG8_WAIT_V(6); PG8_BAR;
    } else {
        PG8_STAGE(PG8_SB(0, 0), cB, voffB); PG8_STAGE(PG8_SA(0, 0), cA, voffA); PG8_STAGE(PG8_SB(0, 1), cB + hstepB, voffB); PG8_STAGE(PG8_SA(0, 1), cA + hstepA, voffA);
        if (wr == 1) PG8_BAR;
        PG8_WAIT_V(4); PG8_BAR;
        PG8_STAGE(PG8_SB(1, 0), cB + kstep, voffB); PG8_STAGE(PG8_SA(1, 0), cA + kstep, voffA); PG8_STAGE(PG8_SB(1, 1), cB + hstepB + kstep, voffB);
        PG8_WAIT_V(6); PG8_BAR;
    }
    for (;;) {
        const bool has_next = S.next(ui + 1, nxt);
        const char* nA = has_next ? (const char*)g.A + a_off_bytes<AMODE>(g, nxt) : cA; const char* nB = has_next ? (const char*)g.Bt + (size_t)nxt.pn * tstepB : cB;
#pragma unroll 1
        for (int t = 0; t < nt; t += 2) {
            const bool last = (t == nt - 2);
            const char* a1 = cA + (size_t)(t + 1) * kstep;
            const char* a2 = last ? nA : cA + (size_t)(t + 2) * kstep; const char* b2 = last ? nB : cB + (size_t)(t + 2) * kstep;
            const char* a3 = a2 + kstep; const char* b3 = b2 + kstep;
            if (last && has_next) S.a_ready(nxt);
            if constexpr (SP2) {
            PG8_LDB(B0, 0, 0); PG8_LDB(B1, 0, 1); PG8_SCHED; PG8_LDA(At, 0, 0); PG8_STAGE(PG8_SA(1, 1), a1 + hstepA, voffA);
            PG8_WAIT_V(8); PG8_WAIT_L(0); PG8_BAR; PG8_MMA(0, 0, At, B0); PG8_MMA(0, 1, At, B1); PG8_BAR; PG8_SCHED;
            PG8_LDA(At, 0, 1); PG8_STAGE(PG8_SB(0, 0), b2, voffB); PG8_STAGE(PG8_SB(0, 1), b2 + hstepB, voffB); PG8_STAGE(PG8_SA(0, 0), a2, voffA);
            PG8_WAIT_V(8); PG8_WAIT_L(0); PG8_BAR; PG8_MMA(1, 0, At, B0); PG8_MMA(1, 1, At, B1); PG8_BAR; PG8_SCHED;
            PG8_LDB(B0, 1, 0); PG8_LDB(B1, 1, 1); PG8_SCHED; PG8_LDA(At, 1, 0); PG8_STAGE(PG8_SA(0, 1), a2 + hstepA, voffA);
            PG8_WAIT_V(8); PG8_WAIT_L(0); PG8_BAR; PG8_MMA(0, 0, At, B0); PG8_MMA(0, 1, At, B1); PG8_BAR; PG8_SCHED;
            PG8_LDA(At, 1, 1); PG8_STAGE(PG8_SB(1, 0), b3, voffB); PG8_STAGE(PG8_SB(1, 1), b3 + hstepB, voffB); PG8_STAGE(PG8_SA(1, 0), a3, voffA);
            PG8_WAIT_V(8); PG8_WAIT_L(0); PG8_BAR; PG8_MMA(1, 0, At, B0); PG8_MMA(1, 1, At, B1); PG8_BAR; PG8_SCHED;
            } else {
            PG8_LDB(B0, 0, 0); PG8_SCHED; PG8_LDA(At, 0, 0); PG8_STAGE(PG8_SA(1, 1), a1 + hstepA, voffA);
            PG8_WAIT_L(8); PG8_BAR; PG8_WAIT_L(0); PG8_MMA(0, 0, At, B0); PG8_BAR; PG8_SCHED;
            PG8_LDB(B1, 0, 1); PG8_STAGE(PG8_SB(0, 0), b2, voffB);
            PG8_BAR; PG8_WAIT_L(0); PG8_MMA(0, 1, At, B1); PG8_BAR;
            PG8_LDA(At, 0, 1); PG8_STAGE(PG8_SA(0, 0), a2, voffA);
            PG8_BAR; PG8_WAIT_L(0); PG8_MMA(1, 0, At, B0); PG8_BAR; PG8_SCHED;
            PG8_STAGE(PG8_SB(0, 1), b2 + hstepB, voffB);
            PG8_WAIT_V(6); PG8_BAR; PG8_MMA(1, 1, At, B1); PG8_BAR;
            PG8_LDB(B0, 1, 0); PG8_SCHED; PG8_LDA(At, 1, 0); PG8_STAGE(PG8_SA(0, 1), a2 + hstepA, voffA);
            PG8_WAIT_L(8); PG8_BAR; PG8_WAIT_L(0); PG8_MMA(0, 0, At, B0); PG8_BAR; PG8_SCHED;
            PG8_LDB(B1, 1, 1); PG8_STAGE(PG8_SB(1, 0), b3, voffB);
            PG8_BAR; PG8_WAIT_L(0); PG8_MMA(0, 1, At, B1); PG8_BAR;
            PG8_LDA(At, 1, 1); PG8_STAGE(PG8_SA(1, 0), a3, voffA);
            PG8_BAR; PG8_WAIT_L(0); PG8_MMA(1, 0, At, B0); PG8_BAR; PG8_SCHED;
            PG8_STAGE(PG8_SB(1, 1), b3 + hstepB, voffB);
            PG8_WAIT_V(6); PG8_BAR; PG8_MMA(1, 1, At, B1); PG8_BAR;
            }
        }
        if constexpr (ALIGN_EPI) { if (wr == 0) PG8_BAR; }
        E(acc, cur, wr, wc, fr, fq); S.done(cur);
        if (!has_next) break;
#pragma unroll
        for (int a = 0; a < 2; ++a)
#pragma unroll
            for (int b = 0; b < 2; ++b)
#pragma unroll
                for (int m = 0; m < 4; ++m)
#pragma unroll
                    for (int n = 0; n < 2; ++n) acc[a][b][m][n] = (f32x4){0.f, 0.f, 0.f, 0.f};
        cur = nxt; cA = nA; cB = nB; ++ui;
        if constexpr (ALIGN_EPI) { if (wr == 1) PG8_BAR; }
    }
    PG8_WAIT_V(0);
    if constexpr (!ALIGN_EPI) { if (wr == 0) PG8_BAR; }
    PG8_BAR;
#undef PG8_SA
#undef PG8_SB
#undef PG8_STAGE
#undef PG8_LDA
#undef PG8_LDB
#undef PG8_MMA
#undef PG8_WAIT_V
#undef PG8_WAIT_L
#undef PG8_BAR
#undef PG8_SCHED
}
}

constexpr int NB = 8, SEQ = 8192, DM = 1024, T = NB * SEQ;
constexpr int NPAD = 7424;
constexpr int NWAVES = 8, NTHR = 512;
constexpr int LDS_BYTES = 147456;
constexpr int N_PHASES = 10;
#define PROBE_PH -1
#define PROBE_MULT 3

constexpr size_t MiB = 1ull << 20;
constexpr size_t WS_CTL = 0;
constexpr size_t WS_MODP = 1 * MiB;
constexpr size_t WS_WIN = 3 * MiB;
constexpr size_t WS_WOUT = 18 * MiB;
constexpr size_t WS_WQ = 20 * MiB;
constexpr size_t WS_WQB = 480 * MiB;
constexpr size_t WS_LRUB = 24 * MiB;
constexpr size_t WS_SUBK = 25 * MiB;
constexpr size_t WS_LRUC = 26 * MiB;
constexpr size_t WS_U = 32 * MiB;
constexpr size_t WS_V = 48 * MiB;
constexpr size_t WS_SU = 64 * MiB;
constexpr size_t WS_SV = 65 * MiB;
constexpr size_t WS_SS = 30 * MiB;
constexpr size_t WS_DK = 66 * MiB;
constexpr size_t WS_QKV = 96 * MiB;
constexpr size_t WS_R = 352 * MiB;
constexpr size_t WS_XLXG = 480 * MiB;
constexpr size_t WS_GAGB = 736 * MiB;
constexpr size_t WS_ALOW = 992 * MiB;
constexpr size_t WS_END = 994 * MiB;
constexpr size_t WS_Y = WS_QKV;
constexpr size_t WS_H2 = WS_QKV + 128 * MiB;
constexpr size_t WS_QRY = WS_XLXG;
constexpr size_t WS_SC = WS_GAGB;
constexpr size_t WS_TOPK = WS_R;
constexpr size_t WS_TOPK2 = WS_R + 32 * MiB;

#define LAS __attribute__((address_space(3)))
typedef unsigned short bf16;
typedef float f32x4 __attribute__((ext_vector_type(4)));
typedef float f32x2 __attribute__((ext_vector_type(2)));
typedef unsigned u32x4 __attribute__((ext_vector_type(4)));
typedef unsigned u32x2 __attribute__((ext_vector_type(2)));

struct Params {
    const float *x, *c, *w_ada, *b_ada, *npm, *npo, *w_in, *w_alpha, *b_alpha, *gla_norm, *conv_w, *conv_b,
        *lwa, *lba, *lwx, *lbx, *lam, *w_out, *npf, *npof, *wq, *subk, *pu, *pv;
    float* out; unsigned char* ws;
    int ph_lo, ph_hi;
};

__device__ __forceinline__ unsigned f2bf(float f) { unsigned u = __builtin_bit_cast(unsigned, f); return (u + 0x7fffu + ((u >> 16) & 1u)) >> 16; }
__device__ __forceinline__ unsigned pk2(float lo, float hi) { return f2bf(lo) | (f2bf(hi) << 16); }
__device__ __forceinline__ float bflo(unsigned u) { return __builtin_bit_cast(float, u << 16); }
__device__ __forceinline__ float bfhi(unsigned u) { return __builtin_bit_cast(float, u & 0xffff0000u); }
__device__ __forceinline__ float bf2f(bf16 h) { return __builtin_bit_cast(float, (unsigned)h << 16); }
__device__ __forceinline__ float sigmoid_f(float x) { return __builtin_amdgcn_rcpf(1.f + __expf(-x)); }
__device__ __forceinline__ float silu_f(float x) { return x * __builtin_amdgcn_rcpf(1.f + __expf(-x)); }
__device__ __forceinline__ float gelu_f(float x) { const float u = 0.7978845608028654f * (x + 0.044715f * x * x * x); return x * __builtin_amdgcn_rcpf(1.f + __expf(-2.f * u)); }
__device__ __forceinline__ float softplus_f(float x) { return fmaxf(x, 0.f) + log1pf(__expf(-fabsf(x))); }
__device__ __forceinline__ float wave_sum(float v) {
#pragma unroll
    for (int o = 1; o < 64; o <<= 1) v += __shfl_xor(v, o);
    return v;
}
#define LDS_WAIT() asm volatile("s_waitcnt lgkmcnt(0)" ::: "memory")

struct EpiSeg {
    static constexpr bool PERM = true;
    unsigned char* ws;
    __device__ __forceinline__ void operator()(const pg8::f32x4 (&acc)[2][2][4][2], const pg8::Unit& u, int wr, int wc, int fr, int fq) const {
        const int pn = u.pn; bf16* base; int ldc, colt;
        if (pn < 8) { base = (bf16*)(ws + WS_QKV); ldc = 2048; colt = pn * 256; }
        else if (pn < 12) { base = (bf16*)(ws + WS_R); ldc = 1024; colt = (pn - 8) * 256; }
        else if (pn < 20) { base = (bf16*)(ws + WS_XLXG); ldc = 2048; colt = (pn - 12) * 256; }
        else if (pn < 28) { base = (bf16*)(ws + WS_GAGB); ldc = 2048; colt = (pn - 20) * 256; }
        else { base = (bf16*)(ws + WS_ALOW); ldc = 16; colt = 0; }
        const int row0 = u.pm * 256 + wr * 64 + fr, col0 = colt + wc * 32 + 8 * fq;
        const bool tail = (pn == 28);
#pragma unroll
        for (int ai = 0; ai < 2; ++ai)
#pragma unroll
            for (int m = 0; m < 4; ++m) { bf16* rowp = base + (size_t)(row0 + ai * 128 + m * 16) * ldc + col0;
#pragma unroll
                for (int bj = 0; bj < 2; ++bj) { const pg8::f32x4 v0 = acc[ai][bj][m][0], v1 = acc[ai][bj][m][1];
                    u32x4 w; w.x = pg8::cvt_pk_bf16(v0[0], v0[1]); w.y = pg8::cvt_pk_bf16(v0[2], v0[3]); w.z = pg8::cvt_pk_bf16(v1[0], v1[1]); w.w = pg8::cvt_pk_bf16(v1[2], v1[3]);
                    if (!tail || (bj == 0 && wc == 0 && fq < 2)) *(u32x4*)(rowp + bj * 128) = w; } }
    }
};
struct EpiPlain {
    static constexpr bool PERM = true;
    bf16* O; int ldc;
    __device__ __forceinline__ void operator()(const pg8::f32x4 (&acc)[2][2][4][2], const pg8::Unit& u, int wr, int wc, int fr, int fq) const {
        const int row0 = u.pm * 256 + wr * 64 + fr, col0 = u.pn * 256 + wc * 32 + 8 * fq;
#pragma unroll
        for (int ai = 0; ai < 2; ++ai)
#pragma unroll
            for (int m = 0; m < 4; ++m) { bf16* rowp = O + (size_t)(row0 + ai * 128 + m * 16) * ldc + col0;
#pragma unroll
                for (int bj = 0; bj < 2; ++bj) { const pg8::f32x4 v0 = acc[ai][bj][m][0], v1 = acc[ai][bj][m][1];
                    u32x4 w; w.x = pg8::cvt_pk_bf16(v0[0], v0[1]); w.y = pg8::cvt_pk_bf16(v0[2], v0[3]); w.z = pg8::cvt_pk_bf16(v1[0], v1[1]); w.w = pg8::cvt_pk_bf16(v1[2], v1[3]);
                    *(u32x4*)(rowp + bj * 128) = w; } }
    }
};
typedef _Float16 h16x2 __attribute__((ext_vector_type(2)));
__device__ __forceinline__ unsigned pkh(float a, float b) { return __builtin_bit_cast(unsigned, __builtin_amdgcn_cvt_pkrtz(a, b)); }
struct EpiF16 {
    static constexpr bool PERM = true;
    unsigned short* O; int ldc;
    __device__ __forceinline__ void operator()(const pg8::f32x4 (&acc)[2][2][4][2], const pg8::Unit& u, int wr, int wc, int fr, int fq) const {
        const int row0 = u.pm * 256 + wr * 64 + fr, col0 = u.pn * 256 + wc * 32 + 8 * fq;
#pragma unroll
        for (int ai = 0; ai < 2; ++ai)
#pragma unroll
            for (int m = 0; m < 4; ++m) { unsigned short* rowp = O + (size_t)(row0 + ai * 128 + m * 16) * ldc + col0;
#pragma unroll
                for (int bj = 0; bj < 2; ++bj) { const pg8::f32x4 v0 = acc[ai][bj][m][0], v1 = acc[ai][bj][m][1];
                    u32x4 w; w.x = pkh(v0[0], v0[1]); w.y = pkh(v0[2], v0[3]); w.z = pkh(v1[0], v1[1]); w.w = pkh(v1[2], v1[3]);
                    *(u32x4*)(rowp + bj * 128) = w; } }
    }
};
struct EpiTrans {
    static constexpr bool PERM = true;
    bf16* O; int ldc;
    __device__ __forceinline__ void operator()(const pg8::f32x4 (&acc)[2][2][4][2], const pg8::Unit& u, int wr, int wc, int fr, int fq) const {
        const int row0 = u.pm * 256 + wr * 64 + fr, col0 = u.pn * 256 + wc * 32 + 8 * fq;
#pragma unroll
        for (int ai = 0; ai < 2; ++ai)
#pragma unroll
            for (int m = 0; m < 4; ++m) { const int row = row0 + ai * 128 + m * 16;
#pragma unroll
                for (int bj = 0; bj < 2; ++bj)
#pragma unroll
                    for (int n = 0; n < 2; ++n)
#pragma unroll
                        for (int e = 0; e < 4; ++e) O[(size_t)(col0 + bj * 128 + 4 * n + e) * ldc + row] = (bf16)f2bf(acc[ai][bj][m][n][e]); }
    }
};

__device__ __forceinline__ void p0_transpose_item(const float* W, int ldw, int k0, int n0, int nvalid, bf16* WT, int ldk, int row0, int kc0, LAS float* scr, int lane) {
#pragma unroll 8
    for (int i = 0; i < 32; ++i) { const int kk = 2 * i + (lane >> 5), cc = lane & 31; scr[kk * 33 + cc] = (cc < nvalid) ? W[(size_t)(k0 + kk) * ldw + n0 + cc] : 0.f; }
    LDS_WAIT(); asm volatile("" ::: "memory");
    const int c = lane & 7;
#pragma unroll
    for (int j = 0; j < 4; ++j) { const int n = (lane >> 3) + 8 * j; const LAS float* s = scr + (8 * c) * 33 + n;
        u32x4 o; o.x = pk2(s[0 * 33], s[1 * 33]); o.y = pk2(s[2 * 33], s[3 * 33]); o.z = pk2(s[4 * 33], s[5 * 33]); o.w = pk2(s[6 * 33], s[7 * 33]);
        *(u32x4*)(WT + (size_t)(row0 + n) * ldk + kc0 + k0 + 8 * c) = o; }
    LDS_WAIT(); asm volatile("" ::: "memory");
}
__device__ __forceinline__ void phase0(const Params& p, LAS unsigned char* lds, int G) {
    const int tid = threadIdx.x, lane = tid & 63, wave = __builtin_amdgcn_readfirstlane(tid >> 6);
    unsigned char* ws = p.ws;
    {
        LAS float* sc = (LAS float*)lds;
        LAS float* red = (LAS float*)(lds + 4096);
        float* modp = (float*)(ws + WS_MODP);
        for (int it = blockIdx.x; it < 24 * 8; it += G) {
            const int nb = it % 24, kc = it / 24;
            for (int i = tid; i < 1024; i += NTHR) { const int b = i >> 7, k = i & 127; sc[i] = silu_f(p.c[b * 1024 + kc * 128 + k]); }
            __syncthreads();
            const int col = tid & 255, kh = tid >> 8;
            float acc[8];
#pragma unroll
            for (int b = 0; b < 8; ++b) acc[b] = 0.f;
            const float* wp = p.w_ada + (size_t)(kc * 128 + kh * 64) * 6144 + nb * 256 + col;
#pragma unroll 8
            for (int kk = 0; kk < 64; ++kk) { const float w = wp[(size_t)kk * 6144];
#pragma unroll
                for (int b = 0; b < 8; ++b) acc[b] += sc[b * 128 + kh * 64 + kk] * w; }
            if (kh == 1) {
#pragma unroll
                for (int b = 0; b < 8; ++b) red[b * 256 + col] = acc[b]; }
            __syncthreads();
            if (kh == 0) { const int n = nb * 256 + col; const float bias = (kc == 0) ? p.b_ada[n] : 0.f;
#pragma unroll
                for (int b = 0; b < 8; ++b) modp[(size_t)(kc * 8 + b) * 6144 + n] = acc[b] + red[b * 256 + col] + bias; }
            __syncthreads();
        }
    }
    for (int i = blockIdx.x * NTHR + tid; i < T * 4 / 4; i += G * NTHR) ((f32x4*)(ws + WS_SS))[i] = (f32x4){0.f, 0.f, 0.f, 0.f};
    LAS float* scr = (LAS float*)(lds + 16384 + wave * 8448);
    const int gw = blockIdx.x * NWAVES + wave, NGW = G * NWAVES;
    bf16* WinT = (bf16*)(ws + WS_WIN); bf16* WoutT = (bf16*)(ws + WS_WOUT);
    bf16* LruB = (bf16*)(ws + WS_LRUB); bf16* SubK = (bf16*)(ws + WS_SUBK);
    constexpr int I_IN = 16 * (NPAD / 32), I_OUT = 16 * 32, I_Q = 2048, I_LRU = 16 * 8, I_SUB = 2048, I_TAB = 2 * 16384;
    constexpr int NIT = I_IN + I_OUT + I_Q + I_LRU + I_SUB + I_TAB;
    for (int it = gw; it < NIT; it += NGW) {
        int r = it;
        if (r < I_IN) { const int nb = r % (NPAD / 32), kb = r / (NPAD / 32), nq = nb * 32; int n0, nv;
            if (nq < 3072) { n0 = nq; nv = 32; } else if (nq < 7168) { n0 = nq + 16; nv = 32; } else if (nq == 7168) { n0 = 3072; nv = 16; } else { n0 = 0; nv = 0; }
            p0_transpose_item(p.w_in, 7184, kb * 64, n0, nv, WinT, 1024, nq, 0, scr, lane); continue; } r -= I_IN;
        if (r < I_OUT) { const int nb = r % 32, kb = r / 32; p0_transpose_item(p.w_out, 1024, kb * 64, nb * 32, 32, WoutT, 1024, nb * 32, 0, scr, lane); continue; } r -= I_OUT;
        if (r < I_Q) {
            const float* src = p.wq + (size_t)r * 1024; bf16* dst = (bf16*)(ws + WS_WQB) + (size_t)r * 1024;
#pragma unroll
            for (int j = 0; j < 2; ++j) { const f32x4 a = *(const f32x4*)(src + j * 512 + lane * 8), b = *(const f32x4*)(src + j * 512 + lane * 8 + 4);
                u32x4 o; o.x = pk2(a.x, a.y); o.y = pk2(a.z, a.w); o.z = pk2(b.x, b.y); o.w = pk2(b.z, b.w);
                *(u32x4*)(dst + j * 512 + lane * 8) = o; }
            continue; } r -= I_Q;
        if (r < I_LRU) {
            const int mat = r >> 3, sub = r & 7, g = mat >> 3, n = mat & 7, kb = sub >> 2, nb = sub & 3;
            const int np = n < 6 ? n : 6, half = n - np;
            const float* W = (g ? p.lwx : p.lwa) + (size_t)n * 128 * 128;
            bf16* dst = LruB + (size_t)n * 256 * 256;
            p0_transpose_item(W, 128, kb * 64, nb * 32, 32, dst, 256, g * 128 + nb * 32, half * 128, scr, lane);
            p0_transpose_item(W, 128, kb * 64, 0, 0, dst, 256, g * 128 + nb * 32, (1 - half) * 128, scr, lane);
            continue; } r -= I_LRU;
        if (r < I_SUB) {
            const int h = r >> 8, pp = (r >> 7) & 1, n = r & 127;
            const float* src = p.subk + (size_t)r * 128; bf16* dst = SubK + ((size_t)h * 256 + pp * 128 + n) * 256;
            const f32x2 v = *(const f32x2*)(src + 2 * lane);
            *(unsigned*)(dst + pp * 128 + 2 * lane) = pk2(v.x, v.y);
            *(unsigned*)(dst + (1 - pp) * 128 + 2 * lane) = 0u;
            continue; } r -= I_SUB;
        {
            const int tb = r >> 14, row = r & 16383;
            const float* src = (tb ? p.pv : p.pu) + (size_t)row * 1024 + lane * 16;
            f32x4 v[4]; float am = 0.f;
#pragma unroll
            for (int j = 0; j < 4; ++j) { v[j] = *(const f32x4*)(src + 4 * j); am = fmaxf(am, fmaxf(fmaxf(fabsf(v[j].x), fabsf(v[j].y)), fmaxf(fabsf(v[j].z), fabsf(v[j].w)))); }
#pragma unroll
            for (int o = 1; o < 64; o <<= 1) am = fmaxf(am, __shfl_xor(am, o));
            const float inv = am > 0.f ? 7.5f / am : 0.f;
            unsigned long long lo = 0ull; unsigned hi = 0u;
#pragma unroll
            for (int j = 0; j < 16; ++j) { const float x = v[j >> 2][j & 3] * inv, a = fabsf(x);
                unsigned code = a < 1.f ? (unsigned)__builtin_rintf(a * 8.f) : (a < 2.f ? 8u + (unsigned)__builtin_rintf((a - 1.f) * 8.f) : (a < 4.f ? 16u + (unsigned)__builtin_rintf((a - 2.f) * 4.f) : 24u + (unsigned)__builtin_rintf((a - 4.f) * 2.f)));
                code = code > 31u ? 31u : code; code |= (x < 0.f) ? 32u : 0u;
                const int bit = 6 * j;
                if (bit + 6 <= 64) lo |= (unsigned long long)code << bit;
                else if (bit >= 64) hi |= code << (bit - 64);
                else { lo |= (unsigned long long)code << bit; hi |= code >> (64 - bit); } }
            unsigned* dst = (unsigned*)(ws + (tb ? WS_V : WS_U) + (size_t)row * 768 + lane * 12);
            dst[0] = (unsigned)lo; dst[1] = (unsigned)(lo >> 32); dst[2] = hi;
            if (lane == 0) ((float*)(ws + (tb ? WS_SV : WS_SU)))[row] = am * (1.f / 7.5f);
        }
    }
}

__device__ __forceinline__ float mod_at(const float* modp, int b, int n) {
    float s = 0.f;
#pragma unroll
    for (int kc = 0; kc < 8; ++kc) s += modp[(size_t)(kc * 8 + b) * 6144 + n];
    return s;
}

__device__ __forceinline__ void phase1(const Params& p, LAS unsigned char* lds, int G) {
    const int tid = threadIdx.x, lane = tid & 63, wave = __builtin_amdgcn_readfirstlane(tid >> 6);
    const float* modp = (const float*)(p.ws + WS_MODP);
    LAS float* gs = (LAS float*)lds; LAS float* sh = gs + 1024;
    bf16* H = (bf16*)p.out;
    for (int tile = blockIdx.x; tile < T / 256; tile += G) {
        const int b = tile / 32;
        __syncthreads();
        for (int k = tid; k < 1024; k += NTHR) { gs[k] = p.npm[k] * (1.f + mod_at(modp, b, 1024 + k)); sh[k] = mod_at(modp, b, k); }
        __syncthreads();
        for (int rr = 0; rr < 32; ++rr) {
            const size_t row = (size_t)tile * 256 + wave * 32 + rr;
            const f32x4* xr = (const f32x4*)(p.x + row * 1024) + lane;
            f32x4 v[4]; float s = 0.f;
#pragma unroll
            for (int j = 0; j < 4; ++j) { v[j] = xr[64 * j]; s += (v[j].x * v[j].x + v[j].y * v[j].y) + (v[j].z * v[j].z + v[j].w * v[j].w); }
            const float rstd = __builtin_amdgcn_rsqf(wave_sum(s) * (1.f / 1024.f) + 1e-6f);
            u32x2* o8 = (u32x2*)(H + row * 1024) + lane;
#pragma unroll
            for (int j = 0; j < 4; ++j) { const int k = 256 * j + 4 * lane; const f32x4 g4 = *(const LAS f32x4*)(gs + k), s4 = *(const LAS f32x4*)(sh + k);
                u32x2 w; w.x = pk2(v[j].x * rstd * g4.x + s4.x, v[j].y * rstd * g4.y + s4.y); w.y = pk2(v[j].z * rstd * g4.z + s4.z, v[j].w * rstd * g4.w + s4.w);
                o8[64 * j] = w; }
        }
    }
}

typedef short bf16x8_t __attribute__((ext_vector_type(8)));
template <bool FINAL>
__device__ __forceinline__ void phase_lru(const Params& p, LAS unsigned char* lds, int G) {
    const int tid = threadIdx.x, lane = tid & 63, wave = __builtin_amdgcn_readfirstlane(tid >> 6), q4 = lane >> 4, c16 = lane & 15;
    constexpr int PQ = 136;
    LAS bf16* XC = (LAS bf16*)lds;
    LAS bf16* HB = XC + 64 * PQ;
    LAS float* CW = (LAS float*)(HB + 64 * PQ);
    const bf16* XL = (const bf16*)(p.ws + WS_XLXG); const bf16* LruB = (const bf16*)(p.ws + WS_LRUB);
    const bf16* XG = (const bf16*)(p.ws + WS_XLXG) + 1024; const bf16* GB = (const bf16*)(p.ws + WS_GAGB) + 1024; bf16* GA = (bf16*)(p.ws + WS_GAGB);
    const bf16* O = (const bf16*)(p.ws + WS_QKV) + 1024; const bf16* R = (const bf16*)(p.ws + WS_R); const float* SS = (const float*)(p.ws + WS_SS);
    f32x2* CAR = (f32x2*)(p.ws + WS_LRUC);
    const int c8 = tid & 15, tr = tid >> 4;
    for (int it = blockIdx.x; it < 8 * 8 * 4; it += G) {
        const int sg = it & 3, n = (it >> 2) & 7, b = it >> 5;
        const int chc = n * 128 + c8 * 8;
        const int chm = n * 128 + wave * 16 + c16;
        __syncthreads();
        for (int i = tid; i < 768; i += NTHR) { const int q = i >> 7, c = i & 127; CW[i] = q < 4 ? p.conv_w[q * 1024 + n * 128 + c] : (q == 4 ? p.conv_b[n * 128 + c] : p.gla_norm[n * 128 + c]); }
        const float ba = p.lba[chm], bx = p.lbx[chm], sp = -8.f * softplus_f(-p.lam[chm]);
        bf16x8_t wf[2][4];
        { const int np = n < 6 ? n : 6, half = n - np;
#pragma unroll
          for (int g = 0; g < 2; ++g)
#pragma unroll
              for (int ks = 0; ks < 4; ++ks) wf[g][ks] = *(const bf16x8_t*)(LruB + (size_t)n * 65536 + (size_t)(g * 128 + wave * 16 + c16) * 256 + half * 128 + ks * 32 + q4 * 8); }
        float hc = 0.f, aseg = 1.f;
        if (FINAL) { for (int s = 0; s < sg; ++s) { const f32x2 c = CAR[(size_t)((b * 8 + n) * 4 + s) * 128 + wave * 16 + c16]; hc = c.x * hc + c.y; } }
        const size_t tseg = (size_t)b * SEQ + sg * 2048;
        u32x4 xr[5];
#define LRU_LOADX(t0_) do { _Pragma("unroll") for (int _k = 0; _k < 5; ++_k) { const long _t = (long)(t0_) + 2 * tr + _k - 3; \
            xr[_k] = (_t < (long)b * SEQ) ? (u32x4){0u, 0u, 0u, 0u} : *(const u32x4*)(XL + (size_t)_t * 2048 + chc); } } while (0)
        LRU_LOADX(tseg);
        __syncthreads();
#pragma unroll 1
        for (int tl = 0; tl < 32; ++tl) {
            const size_t t0 = tseg + tl * 64;
            { float xv[5][8];
#pragma unroll
              for (int k = 0; k < 5; ++k) { xv[k][0] = bflo(xr[k].x); xv[k][1] = bfhi(xr[k].x); xv[k][2] = bflo(xr[k].y); xv[k][3] = bfhi(xr[k].y); xv[k][4] = bflo(xr[k].z); xv[k][5] = bfhi(xr[k].z); xv[k][6] = bflo(xr[k].w); xv[k][7] = bfhi(xr[k].w); }
              float cw[5][8];
#pragma unroll
              for (int q = 0; q < 5; ++q) { const f32x4 w0 = *(const LAS f32x4*)(CW + q * 128 + c8 * 8), w1 = *(const LAS f32x4*)(CW + q * 128 + c8 * 8 + 4);
                  cw[q][0] = w0.x; cw[q][1] = w0.y; cw[q][2] = w0.z; cw[q][3] = w0.w; cw[q][4] = w1.x; cw[q][5] = w1.y; cw[q][6] = w1.z; cw[q][7] = w1.w; }
#pragma unroll
              for (int i2 = 0; i2 < 2; ++i2) { float o[8];
#pragma unroll
                  for (int j = 0; j < 8; ++j) o[j] = cw[4][j] + cw[0][j] * xv[i2][j] + cw[1][j] * xv[i2 + 1][j] + cw[2][j] * xv[i2 + 2][j] + cw[3][j] * xv[i2 + 3][j];
                  *(LAS u32x4*)(XC + (2 * tr + i2) * PQ + c8 * 8) = (u32x4){pk2(o[0], o[1]), pk2(o[2], o[3]), pk2(o[4], o[5]), pk2(o[6], o[7])}; } }
            u32x4 mxg[2], mgb[2], mo[2], mr[2], mga[2]; float mss[2];
            if (FINAL) {
#pragma unroll
                for (int i2 = 0; i2 < 2; ++i2) { const size_t t = t0 + 2 * tr + i2;
                    mxg[i2] = *(const u32x4*)(XG + t * 2048 + chc); mgb[i2] = *(const u32x4*)(GB + t * 2048 + chc); mo[i2] = *(const u32x4*)(O + t * 2048 + chc);
                    mr[i2] = *(const u32x4*)(R + t * 1024 + chc); mga[i2] = *(const u32x4*)(GA + t * 2048 + chc); mss[i2] = SS[t * 4 + (chc >> 8)]; } }
            if (tl + 1 < 32) LRU_LOADX(t0 + 64);
            __syncthreads();
            pg8::f32x4 acc[4][2];
#pragma unroll
            for (int tt = 0; tt < 4; ++tt) { acc[tt][0] = (pg8::f32x4){0.f, 0.f, 0.f, 0.f}; acc[tt][1] = (pg8::f32x4){0.f, 0.f, 0.f, 0.f}; }
#pragma unroll
            for (int ks = 0; ks < 4; ++ks)
#pragma unroll
                for (int tt = 0; tt < 4; ++tt) { const bf16x8_t a = *(const LAS bf16x8_t*)(XC + (tt * 16 + c16) * PQ + ks * 32 + q4 * 8);
                    acc[tt][0] = __builtin_amdgcn_mfma_f32_16x16x32_bf16(a, wf[0][ks], acc[tt][0], 0, 0, 0);
                    acc[tt][1] = __builtin_amdgcn_mfma_f32_16x16x32_bf16(a, wf[1][ks], acc[tt][1], 0, 0, 0); }
#pragma unroll
            for (int tt = 0; tt < 4; ++tt) {
                float av[4], uv[4];
#pragma unroll
                for (int j = 0; j < 4; ++j) { const float xc = bf2f(XC[(tt * 16 + q4 * 4 + j) * PQ + wave * 16 + c16]);
                    const float gr = sigmoid_f(acc[tt][0][j] + ba), gi = sigmoid_f(acc[tt][1][j] + bx);
                    const float a = __expf(sp * gr); av[j] = a; uv[j] = __builtin_amdgcn_sqrtf(fmaxf(1.f - a * a, 0.f)) * gi * xc; }
                float A4 = av[0], H4 = uv[0];
#pragma unroll
                for (int j = 1; j < 4; ++j) { H4 = av[j] * H4 + uv[j]; A4 *= av[j]; }
                float Ai = A4, Hi = H4;
                { const float Ap = __shfl_up(Ai, 16), Hp = __shfl_up(Hi, 16); if (q4 >= 1) { Hi = Hp * Ai + Hi; Ai = Ap * Ai; } }
                { const float Ap = __shfl_up(Ai, 32), Hp = __shfl_up(Hi, 32); if (q4 >= 2) { Hi = Hp * Ai + Hi; Ai = Ap * Ai; } }
                float Ae = __shfl_up(Ai, 16), He = __shfl_up(Hi, 16); if (q4 == 0) { Ae = 1.f; He = 0.f; }
                float h = hc * Ae + He;
                const float At = __shfl(Ai, 48 + c16), Ht = __shfl(Hi, 48 + c16);
                if (FINAL) {
#pragma unroll
                    for (int j = 0; j < 4; ++j) { h = av[j] * h + uv[j]; HB[(tt * 16 + q4 * 4 + j) * PQ + wave * 16 + c16] = (bf16)f2bf(h); } }
                hc = hc * At + Ht; aseg *= At;
            }
            __syncthreads();
            if (FINAL) {
#pragma unroll
                for (int i2 = 0; i2 < 2; ++i2) { const size_t t = t0 + 2 * tr + i2;
                    const u32x4 hw = *(const LAS u32x4*)(HB + (2 * tr + i2) * PQ + c8 * 8);
                    const float rstd = __builtin_amdgcn_rsqf(mss[i2] * (1.f / 256.f) + 1e-6f);
                    const unsigned hwv[4] = {hw.x, hw.y, hw.z, hw.w}, xgv[4] = {mxg[i2].x, mxg[i2].y, mxg[i2].z, mxg[i2].w}, gbv[4] = {mgb[i2].x, mgb[i2].y, mgb[i2].z, mgb[i2].w};
                    const unsigned ov[4] = {mo[i2].x, mo[i2].y, mo[i2].z, mo[i2].w}, rv[4] = {mr[i2].x, mr[i2].y, mr[i2].z, mr[i2].w}, gav[4] = {mga[i2].x, mga[i2].y, mga[i2].z, mga[i2].w};
                    unsigned ow[4];
                    const f32x4 g0 = *(const LAS f32x4*)(CW + 640 + c8 * 8), g1 = *(const LAS f32x4*)(CW + 640 + c8 * 8 + 4);
                    const float gn[8] = {g0.x, g0.y, g0.z, g0.w, g1.x, g1.y, g1.z, g1.w};
#pragma unroll
                    for (int q = 0; q < 4; ++q) {
                        const float m0 = sigmoid_f(bflo(gav[q])) * (bflo(ov[q]) * rstd * gn[2 * q] * silu_f(bflo(rv[q]))) + sigmoid_f(bflo(gbv[q])) * (bflo(hwv[q]) * gelu_f(bflo(xgv[q])));
                        const float m1 = sigmoid_f(bfhi(gav[q])) * (bfhi(ov[q]) * rstd * gn[2 * q + 1] * silu_f(bfhi(rv[q]))) + sigmoid_f(bfhi(gbv[q])) * (bfhi(hwv[q]) * gelu_f(bfhi(xgv[q])));
                        ow[q] = pk2(m0, m1); }
                    *(u32x4*)(GA + t * 2048 + chc) = (u32x4){ow[0], ow[1], ow[2], ow[3]}; }
            }
        }
#undef LRU_LOADX
        if (!FINAL) { if (q4 == 0) CAR[(size_t)((b * 8 + n) * 4 + sg) * 128 + wave * 16 + c16] = (f32x2){aseg, hc}; }
        __syncthreads();
    }
}

__device__ __forceinline__ void phase_gla_prep(const Params& p, LAS unsigned char* lds, int G) {
    const int tid = threadIdx.x;
    LAS float* segt = (LAS float*)lds;
    bf16* QKV = (bf16*)(p.ws + WS_QKV); const bf16* AL = (const bf16*)(p.ws + WS_ALOW); float* DK = (float*)(p.ws + WS_DK);
    const int kp = tid & 127, seg = tid >> 7;
    for (int it = blockIdx.x; it < 8 * 128 * 4; it += G) {
        const int h = it & 3, ch = (it >> 2) & 127, b = it >> 9;
        float wa[16];
#pragma unroll
        for (int r = 0; r < 16; ++r) wa[r] = p.w_alpha[r * 512 + h * 128 + kp];
        const float balpha = p.b_alpha[h * 128 + kp];
        const size_t t0 = (size_t)b * SEQ + ch * 64 + seg * 16;
        float qv[16], kv[16];
#pragma unroll
        for (int i = 0; i < 16; ++i) { qv[i] = bf2f(QKV[(t0 + i) * 2048 + h * 128 + kp]); kv[i] = bf2f(QKV[(t0 + i) * 2048 + 512 + h * 128 + kp]); }
        float cl[16]; float run = 0.f;
#pragma unroll
        for (int i = 0; i < 16; ++i) { const size_t t = t0 + i;
            const u32x4 a0 = *(const u32x4*)(AL + t * 16), a1 = *(const u32x4*)(AL + t * 16 + 8);
            float z = balpha;
            z += bflo(a0.x) * wa[0] + bfhi(a0.x) * wa[1] + bflo(a0.y) * wa[2] + bfhi(a0.y) * wa[3] + bflo(a0.z) * wa[4] + bfhi(a0.z) * wa[5] + bflo(a0.w) * wa[6] + bfhi(a0.w) * wa[7];
            z += bflo(a1.x) * wa[8] + bfhi(a1.x) * wa[9] + bflo(a1.y) * wa[10] + bfhi(a1.y) * wa[11] + bflo(a1.z) * wa[12] + bfhi(a1.z) * wa[13] + bflo(a1.w) * wa[14] + bfhi(a1.w) * wa[15];
            const float ls = fminf(z, 0.f) - __logf(1.f + __expf(-fabsf(z)));
            run += ls * (1.f / 16.f); cl[i] = run; }
        __syncthreads();
        segt[seg * 128 + kp] = run;
        __syncthreads();
        float off = 0.f, tot = 0.f;
#pragma unroll
        for (int s = 0; s < 4; ++s) { const float v = segt[s * 128 + kp]; tot += v; if (s < seg) off += v; }
        if (seg == 0) DK[(size_t)(b * 128 + ch) * 512 + h * 128 + kp] = __expf(tot);
#pragma unroll
        for (int i = 0; i < 16; ++i) { const float cum = cl[i] + off;
            QKV[(t0 + i) * 2048 + h * 128 + kp] = (bf16)f2bf(qv[i] * 0.08838834764831845f * __expf(cum));
            QKV[(t0 + i) * 2048 + 512 + h * 128 + kp] = (bf16)f2bf(kv[i] * __expf(-cum)); }
    }
}
__device__ __forceinline__ void phase_gla_seq(const Params& p, LAS unsigned char* lds, int G) {
    const int tid = threadIdx.x, lane = tid & 63, wave = __builtin_amdgcn_readfirstlane(tid >> 6), q4 = lane >> 4, c16 = lane & 15;
    constexpr int PQ = 136, PS = 72;
    LAS bf16* Qs = (LAS bf16*)lds;
    LAS bf16* Kd = Qs + 64 * PQ;
    LAS bf16* KdT = Kd + 64 * PQ;
    LAS bf16* VT = KdT + 128 * PS;
    LAS bf16* Pm = VT + 32 * PS;
    LAS bf16* ST = Pm + 64 * PS;
    LAS float* dk = (LAS float*)(ST + 32 * PQ);
    const bf16* QKV = (const bf16*)(p.ws + WS_QKV); bf16* VO = (bf16*)(p.ws + WS_QKV); const float* DK = (const float*)(p.ws + WS_DK); float* SS = (float*)(p.ws + WS_SS);
    const int kp = tid & 127, seg = tid >> 7;
    const int vv = tid & 31, sg = tid >> 5;
    const int r0 = tid >> 4, cc = (tid & 15) * 8;
    for (int it = blockIdx.x; it < 8 * 4 * 8; it += G) {
        const int v8 = it & 7, h = (it >> 3) & 3, b = it >> 5;
        pg8::f32x4 sacc[2] = {(pg8::f32x4){0.f, 0.f, 0.f, 0.f}, (pg8::f32x4){0.f, 0.f, 0.f, 0.f}};
        __syncthreads();
        for (int i = tid; i < 32 * PQ / 2; i += NTHR) ((LAS unsigned*)ST)[i] = 0u;
        u32x4 rq[2], rk[2]; unsigned rkt[8], rv[2]; float rdk = 0.f;
#define GLA_LOAD(chn) do { const size_t _t0 = (size_t)b * SEQ + (size_t)(chn) * 64; \
            _Pragma("unroll") for (int _j = 0; _j < 2; ++_j) { rq[_j] = *(const u32x4*)(QKV + (_t0 + r0 + 32 * _j) * 2048 + h * 128 + cc); rk[_j] = *(const u32x4*)(QKV + (_t0 + r0 + 32 * _j) * 2048 + 512 + h * 128 + cc); } \
            _Pragma("unroll") for (int _i = 0; _i < 8; ++_i) { const unsigned _lo = QKV[(_t0 + seg * 16 + 2 * _i) * 2048 + 512 + h * 128 + kp], _hi = QKV[(_t0 + seg * 16 + 2 * _i + 1) * 2048 + 512 + h * 128 + kp]; rkt[_i] = _lo | (_hi << 16); } \
            _Pragma("unroll") for (int _i = 0; _i < 2; ++_i) { const unsigned _lo = QKV[(_t0 + sg * 4 + 2 * _i) * 2048 + 1024 + h * 256 + v8 * 32 + vv], _hi = QKV[(_t0 + sg * 4 + 2 * _i + 1) * 2048 + 1024 + h * 256 + v8 * 32 + vv]; rv[_i] = _lo | (_hi << 16); } \
            if (tid < 128) rdk = DK[(size_t)(b * 128 + (chn)) * 512 + h * 128 + tid]; } while (0)
        GLA_LOAD(0);
#pragma unroll 1
        for (int ch = 0; ch < SEQ / 64; ++ch) {
            const size_t t0 = (size_t)b * SEQ + ch * 64;
#pragma unroll
            for (int j = 0; j < 2; ++j) { *(LAS u32x4*)(Qs + (r0 + 32 * j) * PQ + cc) = rq[j]; *(LAS u32x4*)(Kd + (r0 + 32 * j) * PQ + cc) = rk[j]; }
            *(LAS u32x4*)(KdT + kp * PS + seg * 16) = (u32x4){rkt[0], rkt[1], rkt[2], rkt[3]};
            *(LAS u32x4*)(KdT + kp * PS + seg * 16 + 8) = (u32x4){rkt[4], rkt[5], rkt[6], rkt[7]};
            *(LAS u32x2*)(VT + vv * PS + sg * 4) = (u32x2){rv[0], rv[1]};
            if (tid < 128) dk[tid] = rdk;
            if (ch + 1 < SEQ / 64) GLA_LOAD(ch + 1);
            __syncthreads();
            { const int tt = wave & 3;
#pragma unroll
              for (int i2 = 0; i2 < 2; ++i2) { const int ts = (wave >> 2) * 2 + i2;
                  pg8::f32x4 acc = (pg8::f32x4){0.f, 0.f, 0.f, 0.f};
                  if (ts <= tt) {
#pragma unroll
                      for (int ks = 0; ks < 4; ++ks) { const bf16x8_t a = *(const LAS bf16x8_t*)(Kd + (ts * 16 + c16) * PQ + ks * 32 + q4 * 8), bb = *(const LAS bf16x8_t*)(Qs + (tt * 16 + c16) * PQ + ks * 32 + q4 * 8);
                          acc = __builtin_amdgcn_mfma_f32_16x16x32_bf16(a, bb, acc, 0, 0, 0); }
                      const int tg = tt * 16 + c16, sgl = ts * 16 + q4 * 4;
#pragma unroll
                      for (int j = 0; j < 4; ++j) if (sgl + j > tg) acc[j] = 0.f;
                  }
                  *(LAS u32x2*)(Pm + (tt * 16 + c16) * PS + ts * 16 + q4 * 4) = (u32x2){pk2(acc[0], acc[1]), pk2(acc[2], acc[3])}; } }
            __syncthreads();
            { const int tt = wave & 3, tv = wave >> 2;
              pg8::f32x4 oacc = (pg8::f32x4){0.f, 0.f, 0.f, 0.f};
#pragma unroll
              for (int ks = 0; ks < 2; ++ks) { const bf16x8_t bb = *(const LAS bf16x8_t*)(Pm + (tt * 16 + c16) * PS + ks * 32 + q4 * 8), a = *(const LAS bf16x8_t*)(VT + (tv * 16 + c16) * PS + ks * 32 + q4 * 8);
                  oacc = __builtin_amdgcn_mfma_f32_16x16x32_bf16(a, bb, oacc, 0, 0, 0); }
#pragma unroll
              for (int ks = 0; ks < 4; ++ks) { const bf16x8_t bb = *(const LAS bf16x8_t*)(Qs + (tt * 16 + c16) * PQ + ks * 32 + q4 * 8), a = *(const LAS bf16x8_t*)(ST + (tv * 16 + c16) * PQ + ks * 32 + q4 * 8);
                  oacc = __builtin_amdgcn_mfma_f32_16x16x32_bf16(a, bb, oacc, 0, 0, 0); }
              *(u32x2*)(VO + (t0 + tt * 16 + c16) * 2048 + 1024 + h * 256 + v8 * 32 + tv * 16 + q4 * 4) = (u32x2){pk2(oacc[0], oacc[1]), pk2(oacc[2], oacc[3])};
              float sq = (oacc[0] * oacc[0] + oacc[1] * oacc[1]) + (oacc[2] * oacc[2] + oacc[3] * oacc[3]);
              sq += __shfl_xor(sq, 16); sq += __shfl_xor(sq, 32);
              if (q4 == 0) atomicAdd(SS + (t0 + tt * 16 + c16) * 4 + h, sq); }
#pragma unroll
            for (int ks = 0; ks < 2; ++ks) { const bf16x8_t a = *(const LAS bf16x8_t*)(KdT + (wave * 16 + c16) * PS + ks * 32 + q4 * 8);
#pragma unroll
                for (int tv = 0; tv < 2; ++tv) { const bf16x8_t bb = *(const LAS bf16x8_t*)(VT + (tv * 16 + c16) * PS + ks * 32 + q4 * 8);
                    sacc[tv] = __builtin_amdgcn_mfma_f32_16x16x32_bf16(a, bb, sacc[tv], 0, 0, 0); } }
            { const pg8::f32x4 d4 = *(const LAS pg8::f32x4*)(dk + wave * 16 + q4 * 4);
#pragma unroll
              for (int tv = 0; tv < 2; ++tv) sacc[tv] = sacc[tv] * d4; }
            __syncthreads();
#pragma unroll
            for (int tv = 0; tv < 2; ++tv) *(LAS u32x2*)(ST + (tv * 16 + c16) * PQ + wave * 16 + q4 * 4) = (u32x2){pk2(sacc[tv][0], sacc[tv][1]), pk2(sacc[tv][2], sacc[tv][3])};
        }
#undef GLA_LOAD
    }
}

__device__ __forceinline__ void phase_norm2(const Params& p, LAS unsigned char* lds, int G) {
    const int tid = threadIdx.x, lane = tid & 63, wave = __builtin_amdgcn_readfirstlane(tid >> 6);
    const float* modp = (const float*)(p.ws + WS_MODP);
    LAS float* g1 = (LAS float*)lds; LAS float* gs = g1 + 1024; LAS float* sh = gs + 1024;
    const bf16* Y = (const bf16*)(p.ws + WS_Y); bf16* H2 = (bf16*)(p.ws + WS_H2);
    for (int tile = blockIdx.x; tile < T / 256; tile += G) {
        const int b = tile / 32;
        __syncthreads();
        for (int k = tid; k < 1024; k += NTHR) { g1[k] = mod_at(modp, b, 2048 + k) * p.npo[k]; gs[k] = p.npf[k] * (1.f + mod_at(modp, b, 4096 + k)); sh[k] = mod_at(modp, b, 3072 + k); }
        __syncthreads();
        for (int rr = 0; rr < 32; ++rr) {
            const size_t row = (size_t)tile * 256 + wave * 32 + rr;
            const f32x4* xr = (const f32x4*)(p.x + row * 1024) + lane; const u32x2* yr = (const u32x2*)(Y + row * 1024) + lane;
            f32x4 xv[4], yv[4]; float s = 0.f;
#pragma unroll
            for (int j = 0; j < 4; ++j) { xv[j] = xr[64 * j]; const u32x2 yw = yr[64 * j]; yv[j] = (f32x4){bflo(yw.x), bfhi(yw.x), bflo(yw.y), bfhi(yw.y)};
                s += (yv[j].x * yv[j].x + yv[j].y * yv[j].y) + (yv[j].z * yv[j].z + yv[j].w * yv[j].w); }
            const float rstd = __builtin_amdgcn_rsqf(wave_sum(s) * (1.f / 1024.f) + 1e-6f);
            float s2 = 0.f;
            f32x4* orow = (f32x4*)(p.out + row * 1024) + lane;
#pragma unroll
            for (int j = 0; j < 4; ++j) { const int k = 256 * j + 4 * lane; const f32x4 g4 = *(const LAS f32x4*)(g1 + k);
                xv[j] = xv[j] + yv[j] * rstd * g4; orow[64 * j] = xv[j];
                s2 += (xv[j].x * xv[j].x + xv[j].y * xv[j].y) + (xv[j].z * xv[j].z + xv[j].w * xv[j].w); }
            const float rstd2 = __builtin_amdgcn_rsqf(wave_sum(s2) * (1.f / 1024.f) + 1e-6f);
            u32x2* o8 = (u32x2*)(H2 + row * 1024) + lane;
#pragma unroll
            for (int j = 0; j < 4; ++j) { const int k = 256 * j + 4 * lane; const f32x4 g4 = *(const LAS f32x4*)(gs + k), s4 = *(const LAS f32x4*)(sh + k);
                u32x2 w; w.x = pk2(xv[j].x * rstd2 * g4.x + s4.x, xv[j].y * rstd2 * g4.y + s4.y); w.y = pk2(xv[j].z * rstd2 * g4.z + s4.z, xv[j].w * rstd2 * g4.w + s4.w);
                o8[64 * j] = w; }
        }
    }
}

__device__ __forceinline__ unsigned h16_key(unsigned b) { return (b & 0x8000u) ? (~b & 0xffffu) : (b | 0x8000u); }
__device__ __forceinline__ float h16_key_val(unsigned s) { const unsigned b = (s & 0x8000u) ? (s & 0x7fffu) : (~s & 0xffffu); return (float)__builtin_bit_cast(_Float16, (unsigned short)b); }
template <bool ASC> __device__ __forceinline__ void sort16(unsigned (&k)[16]) {
#pragma unroll
    for (int size = 2; size <= 16; size <<= 1)
#pragma unroll
        for (int stride = size >> 1; stride > 0; stride >>= 1)
#pragma unroll
            for (int i = 0; i < 16; ++i) { const int j = i ^ stride; if (j > i) { const bool up = ((i & size) == 0) == ASC; const unsigned lo = min(k[i], k[j]), hi = max(k[i], k[j]); k[i] = up ? lo : hi; k[j] = up ? hi : lo; } }
}
__device__ __forceinline__ void merge16_desc(unsigned (&k)[16]) {
#pragma unroll
    for (int stride = 8; stride > 0; stride >>= 1)
#pragma unroll
        for (int i = 0; i < 16; ++i) { const int j = i ^ stride; if (j > i) { const unsigned lo = min(k[i], k[j]), hi = max(k[i], k[j]); k[i] = hi; k[j] = lo; } }
}
__device__ __forceinline__ void top16_merge(unsigned (&top)[16], unsigned (&grp)[16]) {
    sort16<true>(grp);
#pragma unroll
    for (int i = 0; i < 16; ++i) top[i] = max(top[i], grp[i]);
    merge16_desc(top);
}
__device__ __forceinline__ void keys16(unsigned (&k)[16], const u32x4 w0, const u32x4 w1, int n0) {
    const unsigned ww[8] = {w0.x, w0.y, w0.z, w0.w, w1.x, w1.y, w1.z, w1.w};
#pragma unroll
    for (int q = 0; q < 8; ++q) { k[2 * q] = (h16_key(ww[q] & 0xffffu) << 16) | (unsigned)(127 - (n0 + 2 * q)); k[2 * q + 1] = (h16_key(ww[q] >> 16) << 16) | (unsigned)(127 - (n0 + 2 * q + 1)); }
}
__device__ __forceinline__ void topk_item(const unsigned short* SC, const float* SU, const float* SV, int t, int h, volatile LAS unsigned* my, unsigned (&outw)[16], float (&outs)[16]) {
    const u32x4* src = (const u32x4*)(SC + (size_t)t * 2048 + h * 256);
    unsigned topA[16], topB[16];
    keys16(topA, src[0], src[1], 0); sort16<false>(topA);
#pragma unroll 1
    for (int g = 1; g < 8; ++g) { unsigned grp[16]; keys16(grp, src[2 * g], src[2 * g + 1], 16 * g); top16_merge(topA, grp); }
    keys16(topB, src[16], src[17], 0); sort16<false>(topB);
#pragma unroll 1
    for (int g = 1; g < 8; ++g) { unsigned grp[16]; keys16(grp, src[16 + 2 * g], src[17 + 2 * g], 16 * g); top16_merge(topB, grp); }
    float fa[16], fb[16];
#pragma unroll
    for (int j = 0; j < 16; ++j) { fa[j] = h16_key_val(topA[j] >> 16); fb[j] = h16_key_val(topB[j] >> 16); my[j] = 127u - (topA[j] & 127u); my[16 + j] = 127u - (topB[j] & 127u); }
    unsigned ct[16];
#pragma unroll
    for (int g = 0; g < 4; ++g) { unsigned grp[16];
#pragma unroll
        for (int s = 0; s < 16; ++s) grp[s] = 0u;
        { int slot = 0;
#pragma unroll
          for (int i = 0; i < 16; ++i)
#pragma unroll
              for (int j = 0; j < 16; ++j) if ((i + 1) * (j + 1) <= 16) { if ((slot >> 4) == g) {
                  const float s = fa[i] + fb[j]; unsigned u = __builtin_bit_cast(unsigned, s); u ^= (u >> 31) ? 0xffffffffu : 0x80000000u;
                  grp[slot & 15] = (u & 0xffffff00u) | (unsigned)(255 - (i * 16 + j)); } ++slot; } }
        if (g == 0) { sort16<false>(grp);
#pragma unroll
            for (int s = 0; s < 16; ++s) ct[s] = grp[s]; }
        else top16_merge(ct, grp); }
    float val[16], mx, sum = 0.f;
#pragma unroll
    for (int m = 0; m < 16; ++m) { unsigned u = ct[m] & 0xffffff00u; u ^= (u >> 31) ? 0x80000000u : 0xffffffffu; val[m] = __builtin_bit_cast(float, u); }
    mx = val[0];
#pragma unroll
    for (int m = 0; m < 16; ++m) { val[m] = __expf(val[m] - mx); sum += val[m]; }
    const float inv = 1.f / sum;
    LDS_WAIT();
#pragma unroll
    for (int m = 0; m < 16; ++m) { const unsigned pos = 255u - (ct[m] & 255u), i = pos >> 4, j = pos & 15u;
        const unsigned e = my[i] * 128u + my[16 + j];
        outw[m] = (e << 16) | f2bf(val[m] * inv * SV[e]); outs[m] = SU[e]; }
}

typedef unsigned u32x3 __attribute__((ext_vector_type(3)));
typedef unsigned u32x6 __attribute__((ext_vector_type(6)));
typedef float f32x32 __attribute__((ext_vector_type(32)));
__device__ __forceinline__ float rdlane(float v, int l) { return __builtin_bit_cast(float, __builtin_amdgcn_readlane(__builtin_bit_cast(int, v), l)); }
__device__ __forceinline__ f32x32 fp6x2(u32x3 a, u32x3 b) { const u32x6 s = {a.x, a.y, a.z, b.x, b.y, b.z}; return __builtin_amdgcn_cvt_scalef32_pk32_f32_fp6(s, 1.0f); }
__device__ __forceinline__ void phase_gather(const Params& p, LAS unsigned char* lds, int G) {
    const int tid = threadIdx.x, lane = tid & 63, wave = __builtin_amdgcn_readfirstlane(tid >> 6);
    const float* modp = (const float*)(p.ws + WS_MODP);
    LAS float* g2 = (LAS float*)lds;
    const bf16* H2 = (const bf16*)(p.ws + WS_H2);
    const unsigned short* SC = (const unsigned short*)(p.ws + WS_SC); const float* SU = (const float*)(p.ws + WS_SU); const float* SV = (const float*)(p.ws + WS_SV);
    volatile LAS unsigned* RT = (volatile LAS unsigned*)(lds + 4096 + wave * 16640); volatile LAS float* RS = (volatile LAS float*)(RT + 1024);
    volatile LAS unsigned* myscr = RT + 2048 + lane * 33;
    const unsigned char* U6 = p.ws + WS_U; const unsigned char* V6 = p.ws + WS_V;
    for (int tile = blockIdx.x; tile < T / 256; tile += G) {
        const int b = tile / 32;
        __syncthreads();
        for (int k = tid; k < 1024; k += NTHR) g2[k] = mod_at(modp, b, 5120 + k) * p.npof[k];
        __syncthreads();
#pragma unroll 1
        for (int rr = 0; rr < 32; ++rr) {
            const size_t row = (size_t)tile * 256 + wave * 32 + rr;
            if ((rr & 7) == 0) {
                unsigned ow[16]; float os[16];
                __builtin_amdgcn_wave_barrier();
                topk_item(SC, SU, SV, (int)(row + (lane >> 3)), lane & 7, myscr, ow, os);
#pragma unroll
                for (int m = 0; m < 16; ++m) { RT[(lane >> 3) * 128 + (lane & 7) * 16 + m] = ow[m]; RS[(lane >> 3) * 128 + (lane & 7) * 16 + m] = os[m]; }
                asm volatile("s_waitcnt lgkmcnt(0)" ::: "memory"); __builtin_amdgcn_wave_barrier();
            }
            const int tl = rr & 7;
            float xt[16];
            { const u32x4 a = *(const u32x4*)(H2 + row * 1024 + lane * 16), c = *(const u32x4*)(H2 + row * 1024 + lane * 16 + 8);
              xt[0] = bflo(a.x); xt[1] = bfhi(a.x); xt[2] = bflo(a.y); xt[3] = bfhi(a.y); xt[4] = bflo(a.z); xt[5] = bfhi(a.z); xt[6] = bflo(a.w); xt[7] = bfhi(a.w);
              xt[8] = bflo(c.x); xt[9] = bfhi(c.x); xt[10] = bflo(c.y); xt[11] = bfhi(c.y); xt[12] = bflo(c.z); xt[13] = bfhi(c.z); xt[14] = bflo(c.w); xt[15] = bfhi(c.w); }
            float acc[16];
#pragma unroll
            for (int j = 0; j < 16; ++j) acc[j] = 0.f;
#pragma unroll 1
            for (int hh = 0; hh < 16; ++hh) {
                unsigned ww[8];
#pragma unroll
                for (int m = 0; m < 8; ++m) ww[m] = RT[tl * 128 + hh * 8 + m];
                u32x6 up[4], vp[4];
#pragma unroll
                for (int m = 0; m < 8; ++m) { const size_t eo = (size_t)((unsigned)__builtin_amdgcn_readfirstlane((int)ww[m]) >> 16) * 768 + lane * 12;
                    const u32x3 a = *(const u32x3*)(U6 + eo), c = *(const u32x3*)(V6 + eo);
                    if (m & 1) { up[m >> 1][3] = a.x; up[m >> 1][4] = a.y; up[m >> 1][5] = a.z; vp[m >> 1][3] = c.x; vp[m >> 1][4] = c.y; vp[m >> 1][5] = c.z; }
                    else { up[m >> 1][0] = a.x; up[m >> 1][1] = a.y; up[m >> 1][2] = a.z; vp[m >> 1][0] = c.x; vp[m >> 1][1] = c.y; vp[m >> 1][2] = c.z; } }
                const unsigned wa = RT[tl * 128 + hh * 8 + (lane >> 3)]; const float su = RS[tl * 128 + hh * 8 + (lane >> 3)];
                float pd[8];
#pragma unroll
                for (int m = 0; m < 8; m += 2) { const f32x32 f = __builtin_amdgcn_cvt_scalef32_pk32_f32_fp6(up[m >> 1], 1.0f);
                    float s0 = 0.f, s1 = 0.f;
#pragma unroll
                    for (int j = 0; j < 16; ++j) { s0 += xt[j] * f[j]; s1 += xt[j] * f[16 + j]; }
                    pd[m] = s0; pd[m + 1] = s1; __builtin_amdgcn_sched_barrier(0); }
#pragma unroll
                for (int j = 0; j < 4; ++j) { const bool up_ = (lane & 32) != 0; const float keep = up_ ? pd[j + 4] : pd[j], send = up_ ? pd[j] : pd[j + 4]; pd[j] = keep + __shfl_xor(send, 32); }
#pragma unroll
                for (int j = 0; j < 2; ++j) { const bool up_ = (lane & 16) != 0; const float keep = up_ ? pd[j + 2] : pd[j], send = up_ ? pd[j] : pd[j + 2]; pd[j] = keep + __shfl_xor(send, 16); }
                { const bool up_ = (lane & 8) != 0; const float keep = up_ ? pd[1] : pd[0], send = up_ ? pd[0] : pd[1]; pd[0] = keep + __shfl_xor(send, 8); }
                float d = pd[0]; d += __shfl_xor(d, 4); d += __shfl_xor(d, 2); d += __shfl_xor(d, 1);
                const float coef = bflo(wa) * gelu_f(su * d);
#pragma unroll
                for (int m = 0; m < 8; m += 2) { const f32x32 f = __builtin_amdgcn_cvt_scalef32_pk32_f32_fp6(vp[m >> 1], 1.0f); const float c0 = rdlane(coef, 8 * m), c1 = rdlane(coef, 8 * m + 8);
#pragma unroll
                    for (int j = 0; j < 16; ++j) acc[j] += c0 * f[j] + c1 * f[16 + j];
                    __builtin_amdgcn_sched_barrier(0); }
            }
            float s = 0.f;
#pragma unroll
            for (int j = 0; j < 16; ++j) s += acc[j] * acc[j];
            const float rstd = __builtin_amdgcn_rsqf(wave_sum(s) * (1.f / 1024.f) + 1e-6f);
            float* orow = p.out + row * 1024 + lane * 16;
#pragma unroll
            for (int q = 0; q < 4; ++q) { f32x4 o = *(const f32x4*)(orow + 4 * q); const f32x4 ga = *(const LAS f32x4*)(g2 + lane * 16 + 4 * q);
                o.x += ga.x * acc[4 * q] * rstd; o.y += ga.y * acc[4 * q + 1] * rstd; o.z += ga.z * acc[4 * q + 2] * rstd; o.w += ga.w * acc[4 * q + 3] * rstd;
                *(f32x4*)(orow + 4 * q) = o; }
        }
    }
}

#define XB_TMO      128
#define XB_XCNT(j)  (256  + 64 * (j))
#define XB_XSUB(j)  (1280 + 64 * (j))
#define XB_XGEN(j)  (2304 + 64 * (j))
#define XB_TOP      3328
#define XB_TOPGEN   3392
#define XCD_BAR_WORDS 3456
#define XB_SPIN_CAP (1u << 18)

__device__ __forceinline__ unsigned xb_ld(unsigned* p)              { return __hip_atomic_load(p, __ATOMIC_RELAXED, __HIP_MEMORY_SCOPE_AGENT); }
__device__ __forceinline__ unsigned xb_add(unsigned* p, unsigned v) { return __hip_atomic_fetch_add(p, v, __ATOMIC_RELAXED, __HIP_MEMORY_SCOPE_AGENT); }
__device__ __forceinline__ unsigned xb_xcc_id() { return (unsigned)__builtin_amdgcn_s_getreg((3 << 11) | 20) & 0xFu; }
#define XB_SPIN(cond, bar) do { unsigned _sp = 0; while (cond) { __builtin_amdgcn_s_sleep(1); \
    if ((++_sp & 255u) == 0u) { if (xb_ld(&(bar)[XB_TMO])) break; if (_sp > XB_SPIN_CAP) { atomicAdd(&(bar)[XB_TMO], 1u); break; } } } } while (0)

struct XcdBarrier {
    unsigned* bar; unsigned x;
    volatile LAS unsigned* st;
};

__device__ __forceinline__ XcdBarrier xcd_barrier_post(unsigned* bar, volatile LAS unsigned* st) {
    XcdBarrier b; b.bar = bar; b.x = xb_xcc_id(); b.st = st;
    if (threadIdx.x == 0) (void)xb_add(&bar[XB_XCNT(b.x)], 1u);
    return b;
}
__device__ __forceinline__ void xcd_barrier_complete(unsigned* bar, unsigned x, unsigned& nloc, unsigned& nx) {
    const unsigned G = gridDim.x * gridDim.y * gridDim.z;
    unsigned sum, cnt, mine, sp = 0u;
    for (;;) {
        sum = 0u; cnt = 0u; mine = 0u;
#pragma unroll
        for (unsigned j = 0; j < 16; ++j) { const unsigned c = xb_ld(&bar[XB_XCNT(j)]); sum += c; cnt += (c > 0u) ? 1u : 0u; mine = (j == x) ? c : mine; }
        if (sum == G) break;
        __builtin_amdgcn_s_sleep(1);
        if ((++sp & 255u) == 0u) { if (xb_ld(&bar[XB_TMO])) break; if (sp > XB_SPIN_CAP) { atomicAdd(&bar[XB_TMO], 1u); break; } }
    }
    nloc = mine > 0u ? mine : 1u; nx = cnt > 0u ? cnt : 1u;
}

__device__ __forceinline__ void xcd_barrier(const XcdBarrier& b) {
    asm volatile("s_waitcnt vmcnt(0)" ::: "memory");
    __syncthreads();
    if (threadIdx.x == 0) {
        unsigned* bar = b.bar;
        __builtin_amdgcn_s_waitcnt(0);
        unsigned nloc = b.st[0], nx = b.st[1];
        if (nloc == 0u) { xcd_barrier_complete(bar, b.x, nloc, nx); b.st[0] = nloc; b.st[1] = nx; }
        const unsigned old = xb_add(&bar[XB_XSUB(b.x)], 1u);
        const unsigned gen = old / nloc;
        if (old + 1u == (gen + 1u) * nloc) {
            __builtin_amdgcn_fence(__ATOMIC_RELEASE, "agent");
            asm volatile("s_waitcnt vmcnt(0)" ::: "memory");
            const unsigned og = xb_add(&bar[XB_TOP], 1u);
            const unsigned tg = og / nx;
            if (og + 1u == (tg + 1u) * nx) xb_add(&bar[XB_TOPGEN], 1u);
            else XB_SPIN(xb_ld(&bar[XB_TOPGEN]) == tg, bar);
            __builtin_amdgcn_fence(__ATOMIC_ACQUIRE, "agent");
            xb_add(&bar[XB_XGEN(b.x)], 1u);
            asm volatile("s_waitcnt vmcnt(0)" ::: "memory");
        } else {
            XB_SPIN(xb_ld(&bar[XB_XGEN(b.x)]) == gen, bar);
            __builtin_amdgcn_fence(__ATOMIC_ACQUIRE, "agent");
            asm volatile("s_waitcnt vmcnt(0)" ::: "memory");
        }
    }
    __syncthreads();
}


template <int PH>
__device__ __forceinline__ void run_phase(const Params& p, LAS unsigned char* lds, int G) {
    unsigned char* ws = p.ws;
    if constexpr (PH == 0) phase0(p, lds, G);
    else if constexpr (PH == 1) {
        { pg8::Gemm g{(const bf16*)(ws + WS_WQB), (const bf16*)(ws + WS_SUBK), 1024, 2048, 256, 2048}; pg8::StaticOrder S; S.init(1024, 2048, G, (int)blockIdx.x);
          EpiTrans E{(bf16*)(ws + WS_WQ), 1024}; pg8::gemm_phase<EpiTrans, pg8::StaticOrder, true, true, 2, 256, 2048>(lds, g, S, E); }
        __syncthreads();
        phase1(p, lds, G); }
    else if constexpr (PH == 2) { pg8::Gemm g{(const bf16*)p.out, (const bf16*)(ws + WS_WIN), T, NPAD, 1024, 1024}; pg8::StaticOrder S; S.init(T, NPAD, G, (int)blockIdx.x);
        EpiSeg E{ws}; pg8::gemm_phase<EpiSeg, pg8::StaticOrder, true, true, 0, 1024, 1024>(lds, g, S, E); }
    else if constexpr (PH == 3) { phase_gla_prep(p, lds, G); __syncthreads(); phase_lru<false>(p, lds, G); }
    else if constexpr (PH == 4) phase_gla_seq(p, lds, G);
    else if constexpr (PH == 5) phase_lru<true>(p, lds, G);
    else if constexpr (PH == 6) { pg8::Gemm g{(const bf16*)(ws + WS_GAGB), (const bf16*)(ws + WS_WOUT), T, 1024, 1024, 2048}; pg8::StaticOrder S; S.init(T, 1024, G, (int)blockIdx.x);
        EpiPlain E{(bf16*)(ws + WS_Y), 1024}; pg8::gemm_phase<EpiPlain, pg8::StaticOrder, true, true, 0, 1024, 2048>(lds, g, S, E); }
    else if constexpr (PH == 7) phase_norm2(p, lds, G);
    else if constexpr (PH == 8) {
        pg8::Gemm g{(const bf16*)(ws + WS_H2), (const bf16*)(ws + WS_WQ), T, 2048, 1024, 1024}; pg8::StaticOrder S; S.init(T, 2048, G, (int)blockIdx.x);
        EpiF16 E{(unsigned short*)(ws + WS_SC), 2048}; pg8::gemm_phase<EpiF16, pg8::StaticOrder, true, true, 0, 1024, 1024>(lds, g, S, E); }
    else if constexpr (PH == 9) phase_gather(p, lds, G);
}
template <int PH>
__global__ void __launch_bounds__(NTHR, 2) k_phase(Params p) {
    extern __shared__ __attribute__((aligned(16))) unsigned char lds_raw[];
    run_phase<PH>(p, (LAS unsigned char*)lds_raw, (int)gridDim.x);
}
constexpr int LDS_BAR_OFF = LDS_BYTES - 16;
template <int PH>
__device__ __forceinline__ void run_from(const Params& p, LAS unsigned char* lds, int G, const XcdBarrier& bar) {
#if PROBE_PH >= 0
    unsigned long long pt0 = 0; if constexpr (PH == PROBE_PH) pt0 = __builtin_amdgcn_s_memrealtime();
#endif
    run_phase<PH>(p, lds, G);
    if constexpr (PH + 1 < N_PHASES) {
        if constexpr (PH == 0) cg::this_grid().sync();
        else xcd_barrier(bar);
    }
#if PROBE_PH >= 0
    if constexpr (PH == PROBE_PH) { const unsigned long long pt1 = __builtin_amdgcn_s_memrealtime(), span = pt1 - pt0;
        while (__builtin_amdgcn_s_memrealtime() - pt1 < (unsigned long long)PROBE_MULT * span) __builtin_amdgcn_s_sleep(8); }
#endif
    if constexpr (PH + 1 < N_PHASES) run_from<PH + 1>(p, lds, G, bar);
}
__global__ void __launch_bounds__(NTHR, 2) k_mega(Params p) {
    extern __shared__ __attribute__((aligned(16))) unsigned char lds_raw[];
    LAS unsigned char* lds = (LAS unsigned char*)lds_raw;
    if (threadIdx.x < 4) ((LAS unsigned*)(lds + LDS_BAR_OFF))[threadIdx.x] = 0u;
    __syncthreads();
    const XcdBarrier bar = xcd_barrier_post((unsigned*)(p.ws + WS_CTL), (volatile LAS unsigned*)(lds + LDS_BAR_OFF));
    run_from<0>(p, lds, (int)gridDim.x, bar);
}

extern "C" void kernel_launch(void* const* d_in, const int* in_sizes, int n_in, void* d_out, int out_size, void* d_ws, size_t ws_size, hipStream_t stream) {
    static int grid = 0;
    if (grid == 0) {
        if (n_in != 24 || in_sizes[0] != T * DM || out_size != T * DM || ws_size < WS_END) {
            fprintf(stderr, "kernel_launch: unexpected shapes: n_in %d in0 %d out %d ws %zu\n", n_in, n_in > 0 ? in_sizes[0] : -1, out_size, ws_size); grid = -1; return; }
        int dev = 0, cus = 0, per_cu = 0;
        if (hipGetDevice(&dev) != hipSuccess || hipDeviceGetAttribute(&cus, hipDeviceAttributeMultiprocessorCount, dev) != hipSuccess) { grid = -1; return; }
        if (hipFuncSetAttribute((const void*)k_mega, hipFuncAttributeMaxDynamicSharedMemorySize, LDS_BYTES) != hipSuccess) { fprintf(stderr, "kernel_launch: hipFuncSetAttribute failed\n"); grid = -1; return; }
        if (hipOccupancyMaxActiveBlocksPerMultiprocessor(&per_cu, (const void*)k_mega, NTHR, LDS_BYTES) != hipSuccess || per_cu < 1) { fprintf(stderr, "kernel_launch: occupancy query says %d blocks per CU\n", per_cu); grid = -1; return; }
        (void)hipGetLastError();
        grid = cus;
    }
    if (grid < 0) return;
    Params p{};
    const float** pp = (const float**)&p;
    for (int i = 0; i < 24; ++i) pp[i] = (const float*)d_in[i];
    p.out = (float*)d_out; p.ws = (unsigned char*)d_ws;
    if (hipMemsetAsync((char*)d_ws + WS_CTL, 0, 65536, stream) != hipSuccess) { fprintf(stderr, "kernel_launch: hipMemsetAsync failed\n"); return; }
    void* args[] = {&p};
    hipError_t e = hipLaunchCooperativeKernel((const void*)k_mega, dim3(grid), dim3(NTHR), args, LDS_BYTES, stream);
    if (e != hipSuccess) fprintf(stderr, "kernel_launch: cooperative launch failed: %s (grid %d)\n", hipGetErrorString(e), grid);
}
```

```cpp
#include <hip/hip_runtime.h>
#include <hip/hip_cooperative_groups.h>
#include <cstdio>
#include <cstdint>
#include <utility>
namespace cg = cooperative_groups;

namespace pg8 {
#define PG8_LAS __attribute__((address_space(3)))
typedef unsigned short bf16_t;
typedef short bf16x8 __attribute__((ext_vector_type(8)));
typedef float f32x4 __attribute__((ext_vector_type(4)));
typedef unsigned u32x4 __attribute__((ext_vector_type(4)));
constexpr int BM = 256, BK = 64, HALF = 128, HTB = HALF * BK * 2  , STAGE_BYTES = 8 * HTB, NXCD = 8, WGM = 8;

__host__ __device__ __forceinline__ int lds_byte(int r, int c) { const int st = (r >> 4) * 2 + (c >> 5), rr = r & 15, cc = c & 31, ob = rr * 64 + cc * 2; return st * 1024 + (ob ^ (((ob >> 9) & 1) << 5)); }
__host__ __device__ __forceinline__ void stage_rc(int b, int& R, int& C) { const int st = b / 1024, sb = b % 1024, swz = sb ^ (((sb >> 9) & 1) << 5); R = (st >> 1) * 16 + swz / 64; C = (st & 1) * 32 + (swz % 64) / 2; }
__host__ __device__ __forceinline__ int perm32(int rho) { const int n = rho >> 4, i = rho & 15; return 8 * (i >> 2) + 4 * n + (i & 3); }

struct Unit { int pm, pn; };
struct Gemm { const bf16_t* A; const bf16_t* Bt; int M, N, K, lda; };
template <int AMODE> __device__ __forceinline__ size_t a_off_bytes(const Gemm& g, const Unit& u) {
    const int ac = AMODE == 0 ? 0 : (AMODE == 1 ? 128 * (u.pn < 6 ? u.pn : 6) : 256 * u.pn);
    return ((size_t)u.pm * BM * (size_t)g.lda + (size_t)ac) * 2;
}

struct StaticOrder {
    int nM, nN, nwg, G, c;
    __host__ __device__ void init(int M, int N, int G_, int c_) { nM = M / BM; nN = N / BM; nwg = nM * nN; G = G_; c = c_; }
    __host__ __device__ bool next(int i, Unit& u) const {
        const long L = (long)i * G + c; if (L >= nwg) return false;
        int wgid = (int)L; { const int q = nwg / NXCD, r = nwg % NXCD, xcd = wgid % NXCD, off = wgid / NXCD; wgid = (xcd < r ? xcd * (q + 1) : r * (q + 1) + (xcd - r) * q) + off; }
        const int nig = WGM * nN, gid = wgid / nig, fm = gid * WGM, gsz = (nM - fm) < WGM ? (nM - fm) : WGM;
        u.pm = fm + ((wgid % nig) % gsz); u.pn = (wgid % nig) / gsz; return true;
    }
    __device__ __forceinline__ void a_ready(const Unit&) const {}
    __device__ __forceinline__ void done(const Unit&) const {}
};

__device__ __forceinline__ unsigned cvt_pk_bf16(float lo, float hi) { unsigned r; asm volatile("v_cvt_pk_bf16_f32 %0, %1, %2" : "=v"(r) : "v"(lo), "v"(hi)); return r; }

template <class Epi, class Sched, bool ALIGN_EPI = false, bool SP2 = false, int AMODE = 0, int KC = 0, int LDAC = 0>
__device__ __forceinline__ void gemm_phase(PG8_LAS unsigned char* lds, const Gemm g, const Sched& S, const Epi& E) {
    const int tid = threadIdx.x, wid = __builtin_amdgcn_readfirstlane(tid >> 6), lane = tid & 63, wr = wid >> 2, wc = wid & 3, fr = lane & 15, fq = lane >> 4;
    const int K = KC ? KC : g.K, nt = K / BK; const int lda = LDAC ? LDAC : g.lda;
    unsigned voffA[2], voffB[2];
#pragma unroll
    for (int i = 0; i < 2; ++i) { int R, C; stage_rc(tid * 16 + i * 8192, R, C); const int Rb = Epi::PERM ? ((R & ~31) + perm32(R & 31)) : R;
        voffA[i] = (unsigned)(R * lda + C) * 2u; voffB[i] = (unsigned)(Rb * K + C) * 2u; }
    const size_t kstep = (size_t)(BK * 2);
    const size_t hstepA = (size_t)HALF * lda * 2;
    const size_t hstepB = (size_t)HALF * K * 2;
    const size_t tstepB = 2 * hstepB;
    const unsigned ldsw = (unsigned)wid * 1024u;
    const int aoff = lds_byte(wr * 64 + fr, fq * 8), boff = lds_byte(wc * 32 + fr, fq * 8);
#define PG8_SA(b, h) (((b) * 2 + (h)) * HTB)
#define PG8_SB(b, h) ((4 + (b) * 2 + (h)) * HTB)
#define PG8_STAGE(bufoff, gbase, voff) do { _Pragma("unroll") for (int _i = 0; _i < 2; ++_i) \
        __builtin_amdgcn_global_load_lds((const unsigned*)((const char*)(gbase) + (voff)[_i]), (PG8_LAS unsigned*)(lds + (bufoff) + ldsw + _i * 8192), 16, 0, 0); } while (0)
#define PG8_LDA(dst, b, h) do { _Pragma("unroll") for (int m = 0; m < 4; ++m) _Pragma("unroll") for (int k = 0; k < 2; ++k) dst[m][k] = *(const PG8_LAS bf16x8*)(lds + PG8_SA(b, h) + aoff + m * 2048 + k * 1024); } while (0)
#define PG8_LDB(dst, b, h) do { _Pragma("unroll") for (int n = 0; n < 2; ++n) _Pragma("unroll") for (int k = 0; k < 2; ++k) dst[n][k] = *(const PG8_LAS bf16x8*)(lds + PG8_SB(b, h) + boff + n * 2048 + k * 1024); } while (0)
#define PG8_MMA(ai, bj, At, Bt) do { __builtin_amdgcn_s_setprio(1); _Pragma("unroll") for (int m = 0; m < 4; ++m) _Pragma("unroll") for (int n = 0; n < 2; ++n) _Pragma("unroll") for (int k = 0; k < 2; ++k) \
        acc[ai][bj][m][n] = __builtin_amdgcn_mfma_f32_16x16x32_bf16(Bt[n][k], At[m][k], acc[ai][bj][m][n], 0, 0, 0); __builtin_amdgcn_s_setprio(0); } while (0)
#define PG8_WAIT_V(n) asm volatile("s_waitcnt vmcnt(" #n ")" ::: "memory")
#define PG8_WAIT_L(n) asm volatile("s_waitcnt lgkmcnt(" #n ")" ::: "memory")
#define PG8_BAR __builtin_amdgcn_s_barrier()
#define PG8_SCHED __builtin_amdgcn_sched_barrier(0)
    Unit cur, nxt; int ui = 0;
    if (!S.next(0, cur)) return;
    f32x4 acc[2][2][4][2];
#pragma unroll
    for (int a = 0; a < 2; ++a)
#pragma unroll
        for (int b = 0; b < 2; ++b)
#pragma unroll
            for (int m = 0; m < 4; ++m)
#pragma unroll
                for (int n = 0; n < 2; ++n) acc[a][b][m][n] = (f32x4){0.f, 0.f, 0.f, 0.f};
    bf16x8 At[4][2], B0[2][2], B1[2][2];
    const char* cA = (const char*)g.A + a_off_bytes<AMODE>(g, cur); const char* cB = (const char*)g.Bt + (size_t)cur.pn * tstepB;
    S.a_ready(cur);
    if constexpr (SP2) {
        PG8_STAGE(PG8_SB(0, 0), cB, voffB); PG8_STAGE(PG8_SB(0, 1), cB + hstepB, voffB); PG8_STAGE(PG8_SA(0, 0), cA, voffA); PG8_STAGE(PG8_SA(0, 1), cA + hstepA, voffA);
        if (wr == 1) PG8_BAR;
        PG8_WAIT_V(2); PG8_BAR;
        PG8_STAGE(PG8_SB(1, 0), cB + kstep, voffB); PG8_STAGE(PG8_SA(1, 0), cA + kstep, voffA); PG8_STAGE(PG8_SB(1, 1), cB + hstepB + kstep, voffB);
        PG8_WAIT_V(6); PG8_BAR;
    } else {
        PG8_STAGE(PG8_SB(0, 0), cB, voffB); PG8_STAGE(PG8_SA(0, 0), cA, voffA); PG8_STAGE(PG8_SB(0, 1), cB + hstepB, voffB); PG8_STAGE(PG8_SA(0, 1), cA + hstepA, voffA);
        if (wr == 1) PG8_BAR;
        PG8_WAIT_V(4); PG8_BAR;
        PG8_STAGE(PG8_SB(1, 0), cB + kstep, voffB); PG8_STAGE(PG8_SA(1, 0), cA + kstep, voffA); PG8_STAGE(PG8_SB(1, 1), cB + hstepB + kstep, voffB);
        PG8_WAIT_V(6); PG8_BAR;
    }
    for (;;) {
        const bool has_next = S.next(ui + 1, nxt);
        const char* nA = has_next ? (const char*)g.A + a_off_bytes<AMODE>(g, nxt) : cA; const char* nB = has_next ? (const char*)g.Bt + (size_t)nxt.pn * tstepB : cB;
#pragma unroll 1
        for (int t = 0; t < nt; t += 2) {
            const bool last = (t == nt - 2);
            const char* a1 = cA + (size_t)(t + 1) * kstep;
            const char* a2 = last ? nA : cA + (size_t)(t + 2) * kstep; const char* b2 = last ? nB : cB + (size_t)(t + 2) * kstep;
            const char* a3 = a2 + kstep; const char* b3 = b2 + kstep;
            if (last && has_next) S.a_ready(nxt);
            if constexpr (SP2) {
            PG8_LDB(B0, 0, 0); PG8_LDB(B1, 0, 1); PG8_SCHED; PG8_LDA(At, 0, 0); PG8_STAGE(PG8_SA(1, 1), a1 + hstepA, voffA);
            PG8_WAIT_V(8); PG8_WAIT_L(0); PG8_BAR; PG8_MMA(0, 0, At, B0); PG8_MMA(0, 1, At, B1); PG8_BAR; PG8_SCHED;
            PG8_LDA(At, 0, 1); PG8_STAGE(PG8_SB(0, 0), b2, voffB); PG8_STAGE(PG8_SB(0, 1), b2 + hstepB, voffB); PG8_STAGE(PG8_SA(0, 0), a2, voffA);
            PG8_WAIT_V(8); PG8_WAIT_L(0); PG8_BAR; PG8_MMA(1, 0, At, B0); PG8_MMA(1, 1, At, B1); PG8_BAR; PG8_SCHED;
            PG8_LDB(B0, 1, 0); PG8_LDB(B1, 1, 1); PG8_SCHED; PG8_LDA(At, 1, 0); PG8_STAGE(PG8_SA(0, 1), a2 + hstepA, voffA);
            PG8_WAIT_V(8); PG8_WAIT_L(0); PG8_BAR; PG8_MMA(0, 0, At, B0); PG8_MMA(0, 1, At, B1); PG8_BAR; PG8_SCHED;
            PG8_LDA(At, 1, 1); PG8_STAGE(PG8_SB(1, 0), b3, voffB); PG8_STAGE(PG8_SB(1, 1), b3 + hstepB, voffB); PG8_STAGE(PG8_SA(1, 0), a3, voffA);
            PG8_WAIT_V(8); PG8_WAIT_L(0); PG8_BAR; PG8_MMA(1, 0, At, B0); PG8_MMA(1, 1, At, B1); PG8_BAR; PG8_SCHED;
            } else {
            PG8_LDB(B0, 0, 0); PG8_SCHED; PG8_LDA(At, 0, 0); PG8_STAGE(PG8_SA(1, 1), a1 + hstepA, voffA);
            PG8_WAIT_L(8); PG8_BAR; PG8_WAIT_L(0); PG8_MMA(0, 0, At, B0); PG8_BAR; PG8_SCHED;
            PG8_LDB(B1, 0, 1); PG8_STAGE(PG8_SB(0, 0), b2, voffB);
            PG8_BAR; PG8_WAIT_L(0); PG8_MMA(0, 1, At, B1); PG8_BAR;
            PG8_LDA(At, 0, 1); PG8_STAGE(PG8_SA(0, 0), a2, voffA);
            PG8_BAR; PG8_WAIT_L(0); PG8_MMA(1, 0, At, B0); PG8_BAR; PG8_SCHED;
            PG8_STAGE(PG8_SB(0, 1), b2 + hstepB, voffB);
            PG8_WAIT_V(6); PG8_BAR; PG8_MMA(1, 1, At, B1); PG8_BAR;
            PG8_LDB(B0, 1, 0); PG8_SCHED; PG8_LDA(At, 1, 0); PG8_STAGE(PG8_SA(0, 1), a2 + hstepA, voffA);
            PG8_WAIT_L(8); PG8_BAR; PG8_WAIT_L(0); PG8_MMA(0, 0, At, B0); PG8_BAR; PG8_SCHED;
            PG8_LDB(B1, 1, 1); PG8_STAGE(PG8_SB(1, 0), b3, voffB);
            PG8_BAR; PG8_WAIT_L(0); PG8_MMA(0, 1, At, B1); PG8_BAR;
            PG8_LDA(At, 1, 1); PG8_STAGE(PG8_SA(1, 0), a3, voffA);
            PG8_BAR; PG8_WAIT_L(0); PG8_MMA(1, 0, At, B0); PG8_BAR; PG8_SCHED;
            PG8_STAGE(PG8_SB(1, 1), b3 + hstepB, voffB);
            PG8_WAIT_V(6); PG8_BAR; PG8_MMA(1, 1, At, B1); PG8_BAR;
            }
        }
        if constexpr (ALIGN_EPI) { if (wr == 0) PG8_BAR; }
        E(acc, cur, wr, wc, fr, fq); S.done(cur);
        if (!has_next) break;
#pragma unroll
        for (int a = 0; a < 2; ++a)
#pragma unroll
            for (int b = 0; b < 2; ++b)
#pragma unroll
                for (int m = 0; m < 4; ++m)
#pragma unroll
                    for (int n = 0; n < 2; ++n) acc[a][b][m][n] = (f32x4){0.f, 0.f, 0.f, 0.f};
        cur = nxt; cA = nA; cB = nB; ++ui;
        if constexpr (ALIGN_EPI) { if (wr == 1) PG8_BAR; }
    }
    PG8_WAIT_V(0);
    if constexpr (!ALIGN_EPI) { if (wr == 0) PG8_BAR; }
    PG8_BAR;
#undef PG8_SA
#undef PG8_SB
#undef PG8_STAGE
#undef PG8_LDA
#undef PG8_LDB
#undef PG8_MMA
#undef PG8_WAIT_V
#undef PG8_WAIT_L
#undef PG8_BAR
#undef PG8_SCHED
}
}

constexpr int NB = 8, SEQ = 8192, DM = 1024, T = NB * SEQ;
constexpr int NPAD = 7424;
constexpr int NWAVES = 8, NTHR = 512;
constexpr int LDS_BYTES = 147456;
constexpr int N_PHASES = 10;
#define PROBE_PH -1
#define PROBE_MULT 3

constexpr size_t MiB = 1ull << 20;
constexpr size_t WS_CTL = 0;
constexpr size_t WS_MODP = 1 * MiB;
constexpr size_t WS_WIN = 3 * MiB;
constexpr size_t WS_WOUT = 18 * MiB;
constexpr size_t WS_WQ = 20 * MiB;
constexpr size_t WS_WQB = 480 * MiB;
constexpr size_t WS_LRUB = 24 * MiB;
constexpr size_t WS_SUBK = 25 * MiB;
constexpr size_t WS_LRUC = 26 * MiB;
constexpr size_t WS_U = 32 * MiB;
constexpr size_t WS_V = 48 * MiB;
constexpr size_t WS_SU = 64 * MiB;
constexpr size_t WS_SV = 65 * MiB;
constexpr size_t WS_SS = 30 * MiB;
constexpr size_t WS_DK = 66 * MiB;
constexpr size_t WS_QKV = 96 * MiB;
constexpr size_t WS_R = 352 * MiB;
constexpr size_t WS_XLXG = 480 * MiB;
constexpr size_t WS_GAGB = 736 * MiB;
constexpr size_t WS_ALOW = 992 * MiB;
constexpr size_t WS_END = 994 * MiB;
constexpr size_t WS_Y = WS_QKV;
constexpr size_t WS_H2 = WS_QKV + 128 * MiB;
constexpr size_t WS_QRY = WS_XLXG;
constexpr size_t WS_SC = WS_GAGB;
constexpr size_t WS_TOPK = WS_R;
constexpr size_t WS_TOPK2 = WS_R + 32 * MiB;

#define LAS __attribute__((address_space(3)))
typedef unsigned short bf16;
typedef float f32x4 __attribute__((ext_vector_type(4)));
typedef float f32x2 __attribute__((ext_vector_type(2)));
typedef unsigned u32x4 __attribute__((ext_vector_type(4)));
typedef unsigned u32x2 __attribute__((ext_vector_type(2)));

struct Params {
    const float *x, *c, *w_ada, *b_ada, *npm, *npo, *w_in, *w_alpha, *b_alpha, *gla_norm, *conv_w, *conv_b,
        *lwa, *lba, *lwx, *lbx, *lam, *w_out, *npf, *npof, *wq, *subk, *pu, *pv;
    float* out; unsigned char* ws;
    int ph_lo, ph_hi;
};

__device__ __forceinline__ unsigned f2bf(float f) { unsigned u = __builtin_bit_cast(unsigned, f); return (u + 0x7fffu + ((u >> 16) & 1u)) >> 16; }
__device__ __forceinline__ unsigned pk2(float lo, float hi) { return f2bf(lo) | (f2bf(hi) << 16); }
__device__ __forceinline__ float bflo(unsigned u) { return __builtin_bit_cast(float, u << 16); }
__device__ __forceinline__ float bfhi(unsigned u) { return __builtin_bit_cast(float, u & 0xffff0000u); }
__device__ __forceinline__ float bf2f(bf16 h) { return __builtin_bit_cast(float, (unsigned)h << 16); }
__device__ __forceinline__ float sigmoid_f(float x) { return __builtin_amdgcn_rcpf(1.f + __expf(-x)); }
__device__ __forceinline__ float silu_f(float x) { return x * __builtin_amdgcn_rcpf(1.f + __expf(-x)); }
__device__ __forceinline__ float gelu_f(float x) { const float u = 0.7978845608028654f * (x + 0.044715f * x * x * x); return x * __builtin_amdgcn_rcpf(1.f + __expf(-2.f * u)); }
__device__ __forceinline__ float softplus_f(float x) { return fmaxf(x, 0.f) + log1pf(__expf(-fabsf(x))); }
__device__ __forceinline__ float wave_sum(float v) {
#pragma unroll
    for (int o = 1; o < 64; o <<= 1) v += __shfl_xor(v, o);
    return v;
}
#define LDS_WAIT() asm volatile("s_waitcnt lgkmcnt(0)" ::: "memory")

struct EpiSeg {
    static constexpr bool PERM = true;
    unsigned char* ws;
    __device__ __forceinline__ void operator()(const pg8::f32x4 (&acc)[2][2][4][2], const pg8::Unit& u, int wr, int wc, int fr, int fq) const {
        const int pn = u.pn; bf16* base; int ldc, colt;
        if (pn < 8) { base = (bf16*)(ws + WS_QKV); ldc = 2048; colt = pn * 256; }
        else if (pn < 12) { base = (bf16*)(ws + WS_R); ldc = 1024; colt = (pn - 8) * 256; }
        else if (pn < 20) { base = (bf16*)(ws + WS_XLXG); ldc = 2048; colt = (pn - 12) * 256; }
        else if (pn < 28) { base = (bf16*)(ws + WS_GAGB); ldc = 2048; colt = (pn - 20) * 256; }
        else { base = (bf16*)(ws + WS_ALOW); ldc = 16; colt = 0; }
        const int row0 = u.pm * 256 + wr * 64 + fr, col0 = colt + wc * 32 + 8 * fq;
        const bool tail = (pn == 28);
#pragma unroll
        for (int ai = 0; ai < 2; ++ai)
#pragma unroll
            for (int m = 0; m < 4; ++m) { bf16* rowp = base + (size_t)(row0 + ai * 128 + m * 16) * ldc + col0;
#pragma unroll
                for (int bj = 0; bj < 2; ++bj) { const pg8::f32x4 v0 = acc[ai][bj][m][0], v1 = acc[ai][bj][m][1];
                    u32x4 w; w.x = pg8::cvt_pk_bf16(v0[0], v0[1]); w.y = pg8::cvt_pk_bf16(v0[2], v0[3]); w.z = pg8::cvt_pk_bf16(v1[0], v1[1]); w.w = pg8::cvt_pk_bf16(v1[2], v1[3]);
                    if (!tail || (bj == 0 && wc == 0 && fq < 2)) *(u32x4*)(rowp + bj * 128) = w; } }
    }
};
struct EpiPlain {
    static constexpr bool PERM = true;
    bf16* O; int ldc;
    __device__ __forceinline__ void operator()(const pg8::f32x4 (&acc)[2][2][4][2], const pg8::Unit& u, int wr, int wc, int fr, int fq) const {
        const int row0 = u.pm * 256 + wr * 64 + fr, col0 = u.pn * 256 + wc * 32 + 8 * fq;
#pragma unroll
        for (int ai = 0; ai < 2; ++ai)
#pragma unroll
            for (int m = 0; m < 4; ++m) { bf16* rowp = O + (size_t)(row0 + ai * 128 + m * 16) * ldc + col0;
#pragma unroll
                for (int bj = 0; bj < 2; ++bj) { const pg8::f32x4 v0 = acc[ai][bj][m][0], v1 = acc[ai][bj][m][1];
                    u32x4 w; w.x = pg8::cvt_pk_bf16(v0[0], v0[1]); w.y = pg8::cvt_pk_bf16(v0[2], v0[3]); w.z = pg8::cvt_pk_bf16(v1[0], v1[1]); w.w = pg8::cvt_pk_bf16(v1[2], v1[3]);
                    *(u32x4*)(rowp + bj * 128) = w; } }
    }
};
typedef _Float16 h16x2 __attribute__((ext_vector_type(2)));
__device__ __forceinline__ unsigned pkh(float a, float b) { return __builtin_bit_cast(unsigned, __builtin_amdgcn_cvt_pkrtz(a, b)); }
struct EpiF16 {
    static constexpr bool PERM = true;
    unsigned short* O; int ldc;
    __device__ __forceinline__ void operator()(const pg8::f32x4 (&acc)[2][2][4][2], const pg8::Unit& u, int wr, int wc, int fr, int fq) const {
        const int row0 = u.pm * 256 + wr * 64 + fr, col0 = u.pn * 256 + wc * 32 + 8 * fq;
#pragma unroll
        for (int ai = 0; ai < 2; ++ai)
#pragma unroll
            for (int m = 0; m < 4; ++m) { unsigned short* rowp = O + (size_t)(row0 + ai * 128 + m * 16) * ldc + col0;
#pragma unroll
                for (int bj = 0; bj < 2; ++bj) { const pg8::f32x4 v0 = acc[ai][bj][m][0], v1 = acc[ai][bj][m][1];
                    u32x4 w; w.x = pkh(v0[0], v0[1]); w.y = pkh(v0[2], v0[3]); w.z = pkh(v1[0], v1[1]); w.w = pkh(v1[2], v1[3]);
                    *(u32x4*)(rowp + bj * 128) = w; } }
    }
};
struct EpiTrans {
    static constexpr bool PERM = true;
    bf16* O; int ldc;
    __device__ __forceinline__ void operator()(const pg8::f32x4 (&acc)[2][2][4][2], const pg8::Unit& u, int wr, int wc, int fr, int fq) const {
        const int row0 = u.pm * 256 + wr * 64 + fr, col0 = u.pn * 256 + wc * 32 + 8 * fq;
#pragma unroll
        for (int ai = 0; ai < 2; ++ai)
#pragma unroll
            for (int m = 0; m < 4; ++m) { const int row = row0 + ai * 128 + m * 16;
#pragma unroll
                for (int bj = 0; bj < 2; ++bj)
#pragma unroll
                    for (int n = 0; n < 2; ++n)
#pragma unroll
                        for (int e = 0; e < 4; ++e) O[(size_t)(col0 + bj * 128 + 4 * n + e) * ldc + row] = (bf16)f2bf(acc[ai][bj][m][n][e]); }
    }
};

__device__ __forceinline__ void p0_transpose_item(const float* W, int ldw, int k0, int n0, int nvalid, bf16* WT, int ldk, int row0, int kc0, LAS float* scr, int lane) {
#pragma unroll 8
    for (int i = 0; i < 32; ++i) { const int kk = 2 * i + (lane >> 5), cc = lane & 31; scr[kk * 33 + cc] = (cc < nvalid) ? W[(size_t)(k0 + kk) * ldw + n0 + cc] : 0.f; }
    LDS_WAIT(); asm volatile("" ::: "memory");
    const int c = lane & 7;
#pragma unroll
    for (int j = 0; j < 4; ++j) { const int n = (lane >> 3) + 8 * j; const LAS float* s = scr + (8 * c) * 33 + n;
        u32x4 o; o.x = pk2(s[0 * 33], s[1 * 33]); o.y = pk2(s[2 * 33], s[3 * 33]); o.z = pk2(s[4 * 33], s[5 * 33]); o.w = pk2(s[6 * 33], s[7 * 33]);
        *(u32x4*)(WT + (size_t)(row0 + n) * ldk + kc0 + k0 + 8 * c) = o; }
    LDS_WAIT(); asm volatile("" ::: "memory");
}
__device__ __forceinline__ void phase0(const Params& p, LAS unsigned char* lds, int G) {
    const int tid = threadIdx.x, lane = tid & 63, wave = __builtin_amdgcn_readfirstlane(tid >> 6);
    unsigned char* ws = p.ws;
    {
        LAS float* sc = (LAS float*)lds;
        LAS float* red = (LAS float*)(lds + 4096);
        float* modp = (float*)(ws + WS_MODP);
        for (int it = blockIdx.x; it < 24 * 8; it += G) {
            const int nb = it % 24, kc = it / 24;
            for (int i = tid; i < 1024; i += NTHR) { const int b = i >> 7, k = i & 127; sc[i] = silu_f(p.c[b * 1024 + kc * 128 + k]); }
            __syncthreads();
            const int col = tid & 255, kh = tid >> 8;
            float acc[8];
#pragma unroll
            for (int b = 0; b < 8; ++b) acc[b] = 0.f;
            const float* wp = p.w_ada + (size_t)(kc * 128 + kh * 64) * 6144 + nb * 256 + col;
#pragma unroll 8
            for (int kk = 0; kk < 64; ++kk) { const float w = wp[(size_t)kk * 6144];
#pragma unroll
                for (int b = 0; b < 8; ++b) acc[b] += sc[b * 128 + kh * 64 + kk] * w; }
            if (kh == 1) {
#pragma unroll
                for (int b = 0; b < 8; ++b) red[b * 256 + col] = acc[b]; }
            __syncthreads();
            if (kh == 0) { const int n = nb * 256 + col; const float bias = (kc == 0) ? p.b_ada[n] : 0.f;
#pragma unroll
                for (int b = 0; b < 8; ++b) modp[(size_t)(kc * 8 + b) * 6144 + n] = acc[b] + red[b * 256 + col] + bias; }
            __syncthreads();
        }
    }
    for (int i = blockIdx.x * NTHR + tid; i < T * 4 / 4; i += G * NTHR) ((f32x4*)(ws + WS_SS))[i] = (f32x4){0.f, 0.f, 0.f, 0.f};
    LAS float* scr = (LAS float*)(lds + 16384 + wave * 8448);
    const int gw = blockIdx.x * NWAVES + wave, NGW = G * NWAVES;
    bf16* WinT = (bf16*)(ws + WS_WIN); bf16* WoutT = (bf16*)(ws + WS_WOUT);
    bf16* LruB = (bf16*)(ws + WS_LRUB); bf16* SubK = (bf16*)(ws + WS_SUBK);
    constexpr int I_IN = 16 * (NPAD / 32), I_OUT = 16 * 32, I_Q = 2048, I_LRU = 16 * 8, I_SUB = 2048, I_TAB = 2 * 16384;
    constexpr int NIT = I_IN + I_OUT + I_Q + I_LRU + I_SUB + I_TAB;
    for (int it = gw; it < NIT; it += NGW) {
        int r = it;
        if (r < I_IN) { const int nb = r % (NPAD / 32), kb = r / (NPAD / 32), nq = nb * 32; int n0, nv;
            if (nq < 3072) { n0 = nq; nv = 32; } else if (nq < 7168) { n0 = nq + 16; nv = 32; } else if (nq == 7168) { n0 = 3072; nv = 16; } else { n0 = 0; nv = 0; }
            p0_transpose_item(p.w_in, 7184, kb * 64, n0, nv, WinT, 1024, nq, 0, scr, lane); continue; } r -= I_IN;
        if (r < I_OUT) { const int nb = r % 32, kb = r / 32; p0_transpose_item(p.w_out, 1024, kb * 64, nb * 32, 32, WoutT, 1024, nb * 32, 0, scr, lane); continue; } r -= I_OUT;
        if (r < I_Q) {
            const float* src = p.wq + (size_t)r * 1024; bf16* dst = (bf16*)(ws + WS_WQB) + (size_t)r * 1024;
#pragma unroll
            for (int j = 0; j < 2; ++j) { const f32x4 a = *(const f32x4*)(src + j * 512 + lane * 8), b = *(const f32x4*)(src + j * 512 + lane * 8 + 4);
                u32x4 o; o.x = pk2(a.x, a.y); o.y = pk2(a.z, a.w); o.z = pk2(b.x, b.y); o.w = pk2(b.z, b.w);
                *(u32x4*)(dst + j * 512 + lane * 8) = o; }
            continue; } r -= I_Q;
        if (r < I_LRU) {
            const int mat = r >> 3, sub = r & 7, g = mat >> 3, n = mat & 7, kb = sub >> 2, nb = sub & 3;
            const int np = n < 6 ? n : 6, half = n - np;
            const float* W = (g ? p.lwx : p.lwa) + (size_t)n * 128 * 128;
            bf16* dst = LruB + (size_t)n * 256 * 256;
            p0_transpose_item(W, 128, kb * 64, nb * 32, 32, dst, 256, g * 128 + nb * 32, half * 128, scr, lane);
            p0_transpose_item(W, 128, kb * 64, 0, 0, dst, 256, g * 128 + nb * 32, (1 - half) * 128, scr, lane);
            continue; } r -= I_LRU;
        if (r < I_SUB) {
            const int h = r >> 8, pp = (r >> 7) & 1, n = r & 127;
            const float* src = p.subk + (size_t)r * 128; bf16* dst = SubK + ((size_t)h * 256 + pp * 128 + n) * 256;
            const f32x2 v = *(const f32x2*)(src + 2 * lane);
            *(unsigned*)(dst + pp * 128 + 2 * lane) = pk2(v.x, v.y);
            *(unsigned*)(dst + (1 - pp) * 128 + 2 * lane) = 0u;
            continue; } r -= I_SUB;
        {
            const int tb = r >> 14, row = r & 16383;
            const float* src = (tb ? p.pv : p.pu) + (size_t)row * 1024 + lane * 16;
            f32x4 v[4]; float am = 0.f;
#pragma unroll
            for (int j = 0; j < 4; ++j) { v[j] = *(const f32x4*)(src + 4 * j); am = fmaxf(am, fmaxf(fmaxf(fabsf(v[j].x), fabsf(v[j].y)), fmaxf(fabsf(v[j].z), fabsf(v[j].w)))); }
#pragma unroll
            for (int o = 1; o < 64; o <<= 1) am = fmaxf(am, __shfl_xor(am, o));
            const float inv = am > 0.f ? 7.5f / am : 0.f;
            unsigned long long lo = 0ull; unsigned hi = 0u;
#pragma unroll
            for (int j = 0; j < 16; ++j) { const float x = v[j >> 2][j & 3] * inv, a = fabsf(x);
                unsigned code = a < 1.f ? (unsigned)__builtin_rintf(a * 8.f) : (a < 2.f ? 8u + (unsigned)__builtin_rintf((a - 1.f) * 8.f) : (a < 4.f ? 16u + (unsigned)__builtin_rintf((a - 2.f) * 4.f) : 24u + (unsigned)__builtin_rintf((a - 4.f) * 2.f)));
                code = code > 31u ? 31u : code; code |= (x < 0.f) ? 32u : 0u;
                const int bit = 6 * j;
                if (bit + 6 <= 64) lo |= (unsigned long long)code << bit;
                else if (bit >= 64) hi |= code << (bit - 64);
                else { lo |= (unsigned long long)code << bit; hi |= code >> (64 - bit); } }
            unsigned* dst = (unsigned*)(ws + (tb ? WS_V : WS_U) + (size_t)row * 768 + lane * 12);
            dst[0] = (unsigned)lo; dst[1] = (unsigned)(lo >> 32); dst[2] = hi;
            if (lane == 0) ((float*)(ws + (tb ? WS_SV : WS_SU)))[row] = am * (1.f / 7.5f);
        }
    }
}

__device__ __forceinline__ float mod_at(const float* modp, int b, int n) {
    float s = 0.f;
#pragma unroll
    for (int kc = 0; kc < 8; ++kc) s += modp[(size_t)(kc * 8 + b) * 6144 + n];
    return s;
}

__device__ __forceinline__ void phase1(const Params& p, LAS unsigned char* lds, int G) {
    const int tid = threadIdx.x, lane = tid & 63, wave = __builtin_amdgcn_readfirstlane(tid >> 6);
    const float* modp = (const float*)(p.ws + WS_MODP);
    LAS float* gs = (LAS float*)lds; LAS float* sh = gs + 1024;
    bf16* H = (bf16*)p.out;
    for (int tile = blockIdx.x; tile < T / 256; tile += G) {
        const int b = tile / 32;
        __syncthreads();
        for (int k = tid; k < 1024; k += NTHR) { gs[k] = p.npm[k] * (1.f + mod_at(modp, b, 1024 + k)); sh[k] = mod_at(modp, b, k); }
        __syncthreads();
        for (int rr = 0; rr < 32; ++rr) {
            const size_t row = (size_t)tile * 256 + wave * 32 + rr;
            const f32x4* xr = (const f32x4*)(p.x + row * 1024) + lane;
            f32x4 v[4]; float s = 0.f;
#pragma unroll
            for (int j = 0; j < 4; ++j) { v[j] = xr[64 * j]; s += (v[j].x * v[j].x + v[j].y * v[j].y) + (v[j].z * v[j].z + v[j].w * v[j].w); }
            const float rstd = __builtin_amdgcn_rsqf(wave_sum(s) * (1.f / 1024.f) + 1e-6f);
            u32x2* o8 = (u32x2*)(H + row * 1024) + lane;
#pragma unroll
            for (int j = 0; j < 4; ++j) { const int k = 256 * j + 4 * lane; const f32x4 g4 = *(const LAS f32x4*)(gs + k), s4 = *(const LAS f32x4*)(sh + k);
                u32x2 w; w.x = pk2(v[j].x * rstd * g4.x + s4.x, v[j].y * rstd * g4.y + s4.y); w.y = pk2(v[j].z * rstd * g4.z + s4.z, v[j].w * rstd * g4.w + s4.w);
                o8[64 * j] = w; }
        }
    }
}

typedef short bf16x8_t __attribute__((ext_vector_type(8)));
template <bool FINAL>
__device__ __forceinline__ void phase_lru(const Params& p, LAS unsigned char* lds, int G) {
    const int tid = threadIdx.x, lane = tid & 63, wave = __builtin_amdgcn_readfirstlane(tid >> 6), q4 = lane >> 4, c16 = lane & 15;
    constexpr int PQ = 136;
    LAS bf16* XC = (LAS bf16*)lds;
    LAS bf16* HB = XC + 64 * PQ;
    LAS float* CW = (LAS float*)(HB + 64 * PQ);
    const bf16* XL = (const bf16*)(p.ws + WS_XLXG); const bf16* LruB = (const bf16*)(p.ws + WS_LRUB);
    const bf16* XG = (const bf16*)(p.ws + WS_XLXG) + 1024; const bf16* GB = (const bf16*)(p.ws + WS_GAGB) + 1024; bf16* GA = (bf16*)(p.ws + WS_GAGB);
    const bf16* O = (const bf16*)(p.ws + WS_QKV) + 1024; const bf16* R = (const bf16*)(p.ws + WS_R); const float* SS = (const float*)(p.ws + WS_SS);
    f32x2* CAR = (f32x2*)(p.ws + WS_LRUC);
    const int c8 = tid & 15, tr = tid >> 4;
    for (int it = blockIdx.x; it < 8 * 8 * 4; it += G) {
        const int sg = it & 3, n = (it >> 2) & 7, b = it >> 5;
        const int chc = n * 128 + c8 * 8;
        const int chm = n * 128 + wave * 16 + c16;
        __syncthreads();
        for (int i = tid; i < 768; i += NTHR) { const int q = i >> 7, c = i & 127; CW[i] = q < 4 ? p.conv_w[q * 1024 + n * 128 + c] : (q == 4 ? p.conv_b[n * 128 + c] : p.gla_norm[n * 128 + c]); }
        const float ba = p.lba[chm], bx = p.lbx[chm], sp = -8.f * softplus_f(-p.lam[chm]);
        bf16x8_t wf[2][4];
        { const int np = n < 6 ? n : 6, half = n - np;
#pragma unroll
          for (int g = 0; g < 2; ++g)
#pragma unroll
              for (int ks = 0; ks < 4; ++ks) wf[g][ks] = *(const bf16x8_t*)(LruB + (size_t)n * 65536 + (size_t)(g * 128 + wave * 16 + c16) * 256 + half * 128 + ks * 32 + q4 * 8); }
        float hc = 0.f, aseg = 1.f;
        if (FINAL) { for (int s = 0; s < sg; ++s) { const f32x2 c = CAR[(size_t)((b * 8 + n) * 4 + s) * 128 + wave * 16 + c16]; hc = c.x * hc + c.y; } }
        const size_t tseg = (size_t)b * SEQ + sg * 2048;
        u32x4 xr[5];
#define LRU_LOADX(t0_) do { _Pragma("unroll") for (int _k = 0; _k < 5; ++_k) { const long _t = (long)(t0_) + 2 * tr + _k - 3; \
            xr[_k] = (_t < (long)b * SEQ) ? (u32x4){0u, 0u, 0u, 0u} : *(const u32x4*)(XL + (size_t)_t * 2048 + chc); } } while (0)
        LRU_LOADX(tseg);
        __syncthreads();
#pragma unroll 1
        for (int tl = 0; tl < 32; ++tl) {
            const size_t t0 = tseg + tl * 64;
            { float xv[5][8];
#pragma unroll
              for (int k = 0; k < 5; ++k) { xv[k][0] = bflo(xr[k].x); xv[k][1] = bfhi(xr[k].x); xv[k][2] = bflo(xr[k].y); xv[k][3] = bfhi(xr[k].y); xv[k][4] = bflo(xr[k].z); xv[k][5] = bfhi(xr[k].z); xv[k][6] = bflo(xr[k].w); xv[k][7] = bfhi(xr[k].w); }
              float cw[5][8];
#pragma unroll
              for (int q = 0; q < 5; ++q) { const f32x4 w0 = *(const LAS f32x4*)(CW + q * 128 + c8 * 8), w1 = *(const LAS f32x4*)(CW + q * 128 + c8 * 8 + 4);
                  cw[q][0] = w0.x; cw[q][1] = w0.y; cw[q][2] = w0.z; cw[q][3] = w0.w; cw[q][4] = w1.x; cw[q][5] = w1.y; cw[q][6] = w1.z; cw[q][7] = w1.w; }
#pragma unroll
              for (int i2 = 0; i2 < 2; ++i2) { float o[8];
#pragma unroll
                  for (int j = 0; j < 8; ++j) o[j] = cw[4][j] + cw[0][j] * xv[i2][j] + cw[1][j] * xv[i2 + 1][j] + cw[2][j] * xv[i2 + 2][j] + cw[3][j] * xv[i2 + 3][j];
                  *(LAS u32x4*)(XC + (2 * tr + i2) * PQ + c8 * 8) = (u32x4){pk2(o[0], o[1]), pk2(o[2], o[3]), pk2(o[4], o[5]), pk2(o[6], o[7])}; } }
            u32x4 mxg[2], mgb[2], mo[2], mr[2], mga[2]; float mss[2];
            if (FINAL) {
#pragma unroll
                for (int i2 = 0; i2 < 2; ++i2) { const size_t t = t0 + 2 * tr + i2;
                    mxg[i2] = *(const u32x4*)(XG + t * 2048 + chc); mgb[i2] = *(const u32x4*)(GB + t * 2048 + chc); mo[i2] = *(const u32x4*)(O + t * 2048 + chc);
                    mr[i2] = *(const u32x4*)(R + t * 1024 + chc); mga[i2] = *(const u32x4*)(GA + t * 2048 + chc); mss[i2] = SS[t * 4 + (chc >> 8)]; } }
            if (tl + 1 < 32) LRU_LOADX(t0 + 64);
            __syncthreads();
            pg8::f32x4 acc[4][2];
#pragma unroll
            for (int tt = 0; tt < 4; ++tt) { acc[tt][0] = (pg8::f32x4){0.f, 0.f, 0.f, 0.f}; acc[tt][1] = (pg8::f32x4){0.f, 0.f, 0.f, 0.f}; }
#pragma unroll
            for (int ks = 0; ks < 4; ++ks)
#pragma unroll
                for (int tt = 0; tt < 4; ++tt) { const bf16x8_t a = *(const LAS bf16x8_t*)(XC + (tt * 16 + c16) * PQ + ks * 32 + q4 * 8);
                    acc[tt][0] = __builtin_amdgcn_mfma_f32_16x16x32_bf16(a, wf[0][ks], acc[tt][0], 0, 0, 0);
                    acc[tt][1] = __builtin_amdgcn_mfma_f32_16x16x32_bf16(a, wf[1][ks], acc[tt][1], 0, 0, 0); }
#pragma unroll
            for (int tt = 0; tt < 4; ++tt) {
                float av[4], uv[4];
#pragma unroll
                for (int j = 0; j < 4; ++j) { const float xc = bf2f(XC[(tt * 16 + q4 * 4 + j) * PQ + wave * 16 + c16]);
                    const float gr = sigmoid_f(acc[tt][0][j] + ba), gi = sigmoid_f(acc[tt][1][j] + bx);
                    const float a = __expf(sp * gr); av[j] = a; uv[j] = __builtin_amdgcn_sqrtf(fmaxf(1.f - a * a, 0.f)) * gi * xc; }
                float A4 = av[0], H4 = uv[0];
#pragma unroll
                for (int j = 1; j < 4; ++j) { H4 = av[j] * H4 + uv[j]; A4 *= av[j]; }
                float Ai = A4, Hi = H4;
                { const float Ap = __shfl_up(Ai, 16), Hp = __shfl_up(Hi, 16); if (q4 >= 1) { Hi = Hp * Ai + Hi; Ai = Ap * Ai; } }
                { const float Ap = __shfl_up(Ai, 32), Hp = __shfl_up(Hi, 32); if (q4 >= 2) { Hi = Hp * Ai + Hi; Ai = Ap * Ai; } }
                float Ae = __shfl_up(Ai, 16), He = __shfl_up(Hi, 16); if (q4 == 0) { Ae = 1.f; He = 0.f; }
                float h = hc * Ae + He;
                const float At = __shfl(Ai, 48 + c16), Ht = __shfl(Hi, 48 + c16);
                if (FINAL) {
#pragma unroll
                    for (int j = 0; j < 4; ++j) { h = av[j] * h + uv[j]; HB[(tt * 16 + q4 * 4 + j) * PQ + wave * 16 + c16] = (bf16)f2bf(h); } }
                hc = hc * At + Ht; aseg *= At;
            }
            __syncthreads();
            if (FINAL) {
#pragma unroll
                for (int i2 = 0; i2 < 2; ++i2) { const size_t t = t0 + 2 * tr + i2;
                    const u32x4 hw = *(const LAS u32x4*)(HB + (2 * tr + i2) * PQ + c8 * 8);
                    const float rstd = __builtin_amdgcn_rsqf(mss[i2] * (1.f / 256.f) + 1e-6f);
                    const unsigned hwv[4] = {hw.x, hw.y, hw.z, hw.w}, xgv[4] = {mxg[i2].x, mxg[i2].y, mxg[i2].z, mxg[i2].w}, gbv[4] = {mgb[i2].x, mgb[i2].y, mgb[i2].z, mgb[i2].w};
                    const unsigned ov[4] = {mo[i2].x, mo[i2].y, mo[i2].z, mo[i2].w}, rv[4] = {mr[i2].x, mr[i2].y, mr[i2].z, mr[i2].w}, gav[4] = {mga[i2].x, mga[i2].y, mga[i2].z, mga[i2].w};
                    unsigned ow[4];
                    const f32x4 g0 = *(const LAS f32x4*)(CW + 640 + c8 * 8), g1 = *(const LAS f32x4*)(CW + 640 + c8 * 8 + 4);
                    const float gn[8] = {g0.x, g0.y, g0.z, g0.w, g1.x, g1.y, g1.z, g1.w};
#pragma unroll
                    for (int q = 0; q < 4; ++q) {
                        const float m0 = sigmoid_f(bflo(gav[q])) * (bflo(ov[q]) * rstd * gn[2 * q] * silu_f(bflo(rv[q]))) + sigmoid_f(bflo(gbv[q])) * (bflo(hwv[q]) * gelu_f(bflo(xgv[q])));
                        const float m1 = sigmoid_f(bfhi(gav[q])) * (bfhi(ov[q]) * rstd * gn[2 * q + 1] * silu_f(bfhi(rv[q]))) + sigmoid_f(bfhi(gbv[q])) * (bfhi(hwv[q]) * gelu_f(bfhi(xgv[q])));
                        ow[q] = pk2(m0, m1); }
                    *(u32x4*)(GA + t * 2048 + chc) = (u32x4){ow[0], ow[1], ow[2], ow[3]}; }
            }
        }
#undef LRU_LOADX
        if (!FINAL) { if (q4 == 0) CAR[(size_t)((b * 8 + n) * 4 + sg) * 128 + wave * 16 + c16] = (f32x2){aseg, hc}; }
        __syncthreads();
    }
}

__device__ __forceinline__ void phase_gla_prep(const Params& p, LAS unsigned char* lds, int G) {
    const int tid = threadIdx.x;
    LAS float* segt = (LAS float*)lds;
    bf16* QKV = (bf16*)(p.ws + WS_QKV); const bf16* AL = (const bf16*)(p.ws + WS_ALOW); float* DK = (float*)(p.ws + WS_DK);
    const int kp = tid & 127, seg = tid >> 7;
    for (int it = blockIdx.x; it < 8 * 128 * 4; it += G) {
        const int h = it & 3, ch = (it >> 2) & 127, b = it >> 9;
        float wa[16];
#pragma unroll
        for (int r = 0; r < 16; ++r) wa[r] = p.w_alpha[r * 512 + h * 128 + kp];
        const float balpha = p.b_alpha[h * 128 + kp];
        const size_t t0 = (size_t)b * SEQ + ch * 64 + seg * 16;
        float qv[16], kv[16];
#pragma unroll
        for (int i = 0; i < 16; ++i) { qv[i] = bf2f(QKV[(t0 + i) * 2048 + h * 128 + kp]); kv[i] = bf2f(QKV[(t0 + i) * 2048 + 512 + h * 128 + kp]); }
        float cl[16]; float run = 0.f;
#pragma unroll
        for (int i = 0; i < 16; ++i) { const size_t t = t0 + i;
            const u32x4 a0 = *(const u32x4*)(AL + t * 16), a1 = *(const u32x4*)(AL + t * 16 + 8);
            float z = balpha;
            z += bflo(a0.x) * wa[0] + bfhi(a0.x) * wa[1] + bflo(a0.y) * wa[2] + bfhi(a0.y) * wa[3] + bflo(a0.z) * wa[4] + bfhi(a0.z) * wa[5] + bflo(a0.w) * wa[6] + bfhi(a0.w) * wa[7];
            z += bflo(a1.x) * wa[8] + bfhi(a1.x) * wa[9] + bflo(a1.y) * wa[10] + bfhi(a1.y) * wa[11] + bflo(a1.z) * wa[12] + bfhi(a1.z) * wa[13] + bflo(a1.w) * wa[14] + bfhi(a1.w) * wa[15];
            const float ls = fminf(z, 0.f) - __logf(1.f + __expf(-fabsf(z)));
            run += ls * (1.f / 16.f); cl[i] = run; }
        __syncthreads();
        segt[seg * 128 + kp] = run;
        __syncthreads();
        float off = 0.f, tot = 0.f;
#pragma unroll
        for (int s = 0; s < 4; ++s) { const float v = segt[s * 128 + kp]; tot += v; if (s < seg) off += v; }
        if (seg == 0) DK[(size_t)(b * 128 + ch) * 512 + h * 128 + kp] = __expf(tot);
#pragma unroll
        for (int i = 0; i < 16; ++i) { const float cum = cl[i] + off;
            QKV[(t0 + i) * 2048 + h * 128 + kp] = (bf16)f2bf(qv[i] * 0.08838834764831845f * __expf(cum));
            QKV[(t0 + i) * 2048 + 512 + h * 128 + kp] = (bf16)f2bf(kv[i] * __expf(-cum)); }
    }
}
__device__ __forceinline__ bf16x8_t lds_col8(const LAS bf16* base, int pitch) {
    unsigned w[4];
#pragma unroll
    for (int i = 0; i < 4; ++i) w[i] = (unsigned)base[(2 * i) * pitch] | ((unsigned)base[(2 * i + 1) * pitch] << 16);
    return __builtin_bit_cast(bf16x8_t, (u32x4){w[0], w[1], w[2], w[3]});
}
__device__ __forceinline__ void phase_gla_seq(const Params& p, LAS unsigned char* lds, int G) {
    const int tid = threadIdx.x, lane = tid & 63, wave = __builtin_amdgcn_readfirstlane(tid >> 6), q4 = lane >> 4, c16 = lane & 15;
    constexpr int PQ = 136, PS = 72, PV = 34;
    LAS bf16* Qs = (LAS bf16*)lds;
    LAS bf16* Kd = Qs + 64 * PQ;
    LAS bf16* Vt = Kd + 64 * PQ;
    LAS bf16* Pm = Vt + 64 * PV + 64;
    LAS bf16* ST = Pm + 64 * PS;
    LAS float* dk = (LAS float*)(ST + 32 * PQ);
    const bf16* QKV = (const bf16*)(p.ws + WS_QKV); bf16* VO = (bf16*)(p.ws + WS_QKV); const float* DK = (const float*)(p.ws + WS_DK); float* SS = (float*)(p.ws + WS_SS);
    const int r0 = tid >> 4, cc = (tid & 15) * 8;
    const int vr = (tid >> 2) & 63, vc = (tid & 3) * 8;
    for (int it = blockIdx.x; it < 8 * 4 * 8; it += G) {
        const int v8 = it & 7, h = (it >> 3) & 3, b = it >> 5;
        pg8::f32x4 sacc[2] = {(pg8::f32x4){0.f, 0.f, 0.f, 0.f}, (pg8::f32x4){0.f, 0.f, 0.f, 0.f}};
        __syncthreads();
        for (int i = tid; i < 32 * PQ / 2; i += NTHR) ((LAS unsigned*)ST)[i] = 0u;
        u32x4 rq[2], rk[2], rv; float rdk = 0.f;
#define GLA_LOAD(chn) do { const size_t _t0 = (size_t)b * SEQ + (size_t)(chn) * 64; \
            _Pragma("unroll") for (int _j = 0; _j < 2; ++_j) { rq[_j] = *(const u32x4*)(QKV + (_t0 + r0 + 32 * _j) * 2048 + h * 128 + cc); rk[_j] = *(const u32x4*)(QKV + (_t0 + r0 + 32 * _j) * 2048 + 512 + h * 128 + cc); } \
            rv = *(const u32x4*)(QKV + (_t0 + vr) * 2048 + 1024 + h * 256 + v8 * 32 + vc); \
            rdk = DK[(size_t)(b * 128 + (chn)) * 512 + h * 128 + (tid & 127)]; } while (0)
        GLA_LOAD(0);
#pragma unroll 1
        for (int ch = 0; ch < SEQ / 64; ++ch) {
            const size_t t0 = (size_t)b * SEQ + ch * 64;
#pragma unroll
            for (int j = 0; j < 2; ++j) { *(LAS u32x4*)(Qs + (r0 + 32 * j) * PQ + cc) = rq[j]; *(LAS u32x4*)(Kd + (r0 + 32 * j) * PQ + cc) = rk[j]; }
            if (tid < 256) { LAS unsigned* vd = (LAS unsigned*)(Vt + vr * PV + vc); vd[0] = rv.x; vd[1] = rv.y; vd[2] = rv.z; vd[3] = rv.w; }
            if (tid < 128) dk[tid] = rdk;
            if (ch + 1 < SEQ / 64) GLA_LOAD(ch + 1);
            __syncthreads();
            { const int tt = wave & 3;
#pragma unroll
              for (int i2 = 0; i2 < 2; ++i2) { const int ts = (wave >> 2) * 2 + i2;
                  pg8::f32x4 acc = (pg8::f32x4){0.f, 0.f, 0.f, 0.f};
                  if (ts <= tt) {
#pragma unroll
                      for (int ks = 0; ks < 4; ++ks) { const bf16x8_t a = *(const LAS bf16x8_t*)(Kd + (ts * 16 + c16) * PQ + ks * 32 + q4 * 8), bb = *(const LAS bf16x8_t*)(Qs + (tt * 16 + c16) * PQ + ks * 32 + q4 * 8);
                          acc = __builtin_amdgcn_mfma_f32_16x16x32_bf16(a, bb, acc, 0, 0, 0); }
                      const int tg = tt * 16 + c16, sgl = ts * 16 + q4 * 4;
#pragma unroll
                      for (int j = 0; j < 4; ++j) if (sgl + j > tg) acc[j] = 0.f;
                  }
                  *(LAS u32x2*)(Pm + (tt * 16 + c16) * PS + ts * 16 + q4 * 4) = (u32x2){pk2(acc[0], acc[1]), pk2(acc[2], acc[3])}; } }
            bf16x8_t vf[2][2], kf[2];
#pragma unroll
            for (int ks = 0; ks < 2; ++ks) { kf[ks] = lds_col8(Kd + (ks * 32 + q4 * 8) * PQ + wave * 16 + c16, PQ);
#pragma unroll
                for (int tv = 0; tv < 2; ++tv) vf[tv][ks] = lds_col8(Vt + (ks * 32 + q4 * 8) * PV + tv * 16 + c16, PV); }
            __syncthreads();
            { const int tt = wave & 3, tv = wave >> 2;
              pg8::f32x4 oacc = (pg8::f32x4){0.f, 0.f, 0.f, 0.f};
#pragma unroll
              for (int ks = 0; ks < 2; ++ks) { const bf16x8_t bb = *(const LAS bf16x8_t*)(Pm + (tt * 16 + c16) * PS + ks * 32 + q4 * 8);
                  oacc = __builtin_amdgcn_mfma_f32_16x16x32_bf16(tv ? vf[1][ks] : vf[0][ks], bb, oacc, 0, 0, 0); }
#pragma unroll
              for (int ks = 0; ks < 4; ++ks) { const bf16x8_t bb = *(const LAS bf16x8_t*)(Qs + (tt * 16 + c16) * PQ + ks * 32 + q4 * 8), a = *(const LAS bf16x8_t*)(ST + (tv * 16 + c16) * PQ + ks * 32 + q4 * 8);
                  oacc = __builtin_amdgcn_mfma_f32_16x16x32_bf16(a, bb, oacc, 0, 0, 0); }
              *(u32x2*)(VO + (t0 + tt * 16 + c16) * 2048 + 1024 + h * 256 + v8 * 32 + tv * 16 + q4 * 4) = (u32x2){pk2(oacc[0], oacc[1]), pk2(oacc[2], oacc[3])};
              float sq = (oacc[0] * oacc[0] + oacc[1] * oacc[1]) + (oacc[2] * oacc[2] + oacc[3] * oacc[3]);
              sq += __shfl_xor(sq, 16); sq += __shfl_xor(sq, 32);
              if (q4 == 0) atomicAdd(SS + (t0 + tt * 16 + c16) * 4 + h, sq); }
#pragma unroll
            for (int ks = 0; ks < 2; ++ks)
#pragma unroll
                for (int tv = 0; tv < 2; ++tv) sacc[tv] = __builtin_amdgcn_mfma_f32_16x16x32_bf16(kf[ks], vf[tv][ks], sacc[tv], 0, 0, 0);
            { const pg8::f32x4 d4 = *(const LAS pg8::f32x4*)(dk + wave * 16 + q4 * 4);
#pragma unroll
              for (int tv = 0; tv < 2; ++tv) sacc[tv] = sacc[tv] * d4; }
            __syncthreads();
#pragma unroll
            for (int tv = 0; tv < 2; ++tv) *(LAS u32x2*)(ST + (tv * 16 + c16) * PQ + wave * 16 + q4 * 4) = (u32x2){pk2(sacc[tv][0], sacc[tv][1]), pk2(sacc[tv][2], sacc[tv][3])};
        }
#undef GLA_LOAD
    }
}

__device__ __forceinline__ void phase_norm2(const Params& p, LAS unsigned char* lds, int G) {
    const int tid = threadIdx.x, lane = tid & 63, wave = __builtin_amdgcn_readfirstlane(tid >> 6);
    const float* modp = (const float*)(p.ws + WS_MODP);
    LAS float* g1 = (LAS float*)lds; LAS float* gs = g1 + 1024; LAS float* sh = gs + 1024;
    const bf16* Y = (const bf16*)(p.ws + WS_Y); bf16* H2 = (bf16*)(p.ws + WS_H2);
    for (int tile = blockIdx.x; tile < T / 256; tile += G) {
        const int b = tile / 32;
        __syncthreads();
        for (int k = tid; k < 1024; k += NTHR) { g1[k] = mod_at(modp, b, 2048 + k) * p.npo[k]; gs[k] = p.npf[k] * (1.f + mod_at(modp, b, 4096 + k)); sh[k] = mod_at(modp, b, 3072 + k); }
        __syncthreads();
        for (int rr = 0; rr < 32; ++rr) {
            const size_t row = (size_t)tile * 256 + wave * 32 + rr;
            const f32x4* xr = (const f32x4*)(p.x + row * 1024) + lane; const u32x2* yr = (const u32x2*)(Y + row * 1024) + lane;
            f32x4 xv[4], yv[4]; float s = 0.f;
#pragma unroll
            for (int j = 0; j < 4; ++j) { xv[j] = xr[64 * j]; const u32x2 yw = yr[64 * j]; yv[j] = (f32x4){bflo(yw.x), bfhi(yw.x), bflo(yw.y), bfhi(yw.y)};
                s += (yv[j].x * yv[j].x + yv[j].y * yv[j].y) + (yv[j].z * yv[j].z + yv[j].w * yv[j].w); }
            const float rstd = __builtin_amdgcn_rsqf(wave_sum(s) * (1.f / 1024.f) + 1e-6f);
            float s2 = 0.f;
            f32x4* orow = (f32x4*)(p.out + row * 1024) + lane;
#pragma unroll
            for (int j = 0; j < 4; ++j) { const int k = 256 * j + 4 * lane; const f32x4 g4 = *(const LAS f32x4*)(g1 + k);
                xv[j] = xv[j] + yv[j] * rstd * g4; orow[64 * j] = xv[j];
                s2 += (xv[j].x * xv[j].x + xv[j].y * xv[j].y) + (xv[j].z * xv[j].z + xv[j].w * xv[j].w); }
            const float rstd2 = __builtin_amdgcn_rsqf(wave_sum(s2) * (1.f / 1024.f) + 1e-6f);
            u32x2* o8 = (u32x2*)(H2 + row * 1024) + lane;
#pragma unroll
            for (int j = 0; j < 4; ++j) { const int k = 256 * j + 4 * lane; const f32x4 g4 = *(const LAS f32x4*)(gs + k), s4 = *(const LAS f32x4*)(sh + k);
                u32x2 w; w.x = pk2(xv[j].x * rstd2 * g4.x + s4.x, xv[j].y * rstd2 * g4.y + s4.y); w.y = pk2(xv[j].z * rstd2 * g4.z + s4.z, xv[j].w * rstd2 * g4.w + s4.w);
                o8[64 * j] = w; }
        }
    }
}

__device__ __forceinline__ unsigned h16_key(unsigned b) { return (b & 0x8000u) ? (~b & 0xffffu) : (b | 0x8000u); }
__device__ __forceinline__ float h16_key_val(unsigned s) { const unsigned b = (s & 0x8000u) ? (s & 0x7fffu) : (~s & 0xffffu); return (float)__builtin_bit_cast(_Float16, (unsigned short)b); }
template <bool ASC> __device__ __forceinline__ void sort16(unsigned (&k)[16]) {
#pragma unroll
    for (int size = 2; size <= 16; size <<= 1)
#pragma unroll
        for (int stride = size >> 1; stride > 0; stride >>= 1)
#pragma unroll
            for (int i = 0; i < 16; ++i) { const int j = i ^ stride; if (j > i) { const bool up = ((i & size) == 0) == ASC; const unsigned lo = min(k[i], k[j]), hi = max(k[i], k[j]); k[i] = up ? lo : hi; k[j] = up ? hi : lo; } }
}
__device__ __forceinline__ void merge16_desc(unsigned (&k)[16]) {
#pragma unroll
    for (int stride = 8; stride > 0; stride >>= 1)
#pragma unroll
        for (int i = 0; i < 16; ++i) { const int j = i ^ stride; if (j > i) { const unsigned lo = min(k[i], k[j]), hi = max(k[i], k[j]); k[i] = hi; k[j] = lo; } }
}
__device__ __forceinline__ void top16_merge(unsigned (&top)[16], unsigned (&grp)[16]) {
    sort16<true>(grp);
#pragma unroll
    for (int i = 0; i < 16; ++i) top[i] = max(top[i], grp[i]);
    merge16_desc(top);
}
__device__ __forceinline__ void keys16(unsigned (&k)[16], const u32x4 w0, const u32x4 w1, int n0) {
    const unsigned ww[8] = {w0.x, w0.y, w0.z, w0.w, w1.x, w1.y, w1.z, w1.w};
#pragma unroll
    for (int q = 0; q < 8; ++q) { k[2 * q] = (h16_key(ww[q] & 0xffffu) << 16) | (unsigned)(127 - (n0 + 2 * q)); k[2 * q + 1] = (h16_key(ww[q] >> 16) << 16) | (unsigned)(127 - (n0 + 2 * q + 1)); }
}
__device__ __forceinline__ void topk_item(const unsigned short* SC, const float* SU, const float* SV, int t, int h, volatile LAS unsigned* my, unsigned (&outw)[16], float (&outs)[16]) {
    const u32x4* src = (const u32x4*)(SC + (size_t)t * 2048 + h * 256);
    unsigned topA[16], topB[16];
    keys16(topA, src[0], src[1], 0); sort16<false>(topA);
#pragma unroll 1
    for (int g = 1; g < 8; ++g) { unsigned grp[16]; keys16(grp, src[2 * g], src[2 * g + 1], 16 * g); top16_merge(topA, grp); }
    keys16(topB, src[16], src[17], 0); sort16<false>(topB);
#pragma unroll 1
    for (int g = 1; g < 8; ++g) { unsigned grp[16]; keys16(grp, src[16 + 2 * g], src[17 + 2 * g], 16 * g); top16_merge(topB, grp); }
    float fa[16], fb[16];
#pragma unroll
    for (int j = 0; j < 16; ++j) { fa[j] = h16_key_val(topA[j] >> 16); fb[j] = h16_key_val(topB[j] >> 16); my[j] = 127u - (topA[j] & 127u); my[16 + j] = 127u - (topB[j] & 127u); }
    unsigned ct[16];
#pragma unroll
    for (int g = 0; g < 4; ++g) { unsigned grp[16];
#pragma unroll
        for (int s = 0; s < 16; ++s) grp[s] = 0u;
        { int slot = 0;
#pragma unroll
          for (int i = 0; i < 16; ++i)
#pragma unroll
              for (int j = 0; j < 16; ++j) if ((i + 1) * (j + 1) <= 16) { if ((slot >> 4) == g) {
                  const float s = fa[i] + fb[j]; unsigned u = __builtin_bit_cast(unsigned, s); u ^= (u >> 31) ? 0xffffffffu : 0x80000000u;
                  grp[slot & 15] = (u & 0xffffff00u) | (unsigned)(255 - (i * 16 + j)); } ++slot; } }
        if (g == 0) { sort16<false>(grp);
#pragma unroll
            for (int s = 0; s < 16; ++s) ct[s] = grp[s]; }
        else top16_merge(ct, grp); }
    float val[16], mx, sum = 0.f;
#pragma unroll
    for (int m = 0; m < 16; ++m) { unsigned u = ct[m] & 0xffffff00u; u ^= (u >> 31) ? 0x80000000u : 0xffffffffu; val[m] = __builtin_bit_cast(float, u); }
    mx = val[0];
#pragma unroll
    for (int m = 0; m < 16; ++m) { val[m] = __expf(val[m] - mx); sum += val[m]; }
    const float inv = 1.f / sum;
    LDS_WAIT();
#pragma unroll
    for (int m = 0; m < 16; ++m) { const unsigned pos = 255u - (ct[m] & 255u), i = pos >> 4, j = pos & 15u;
        const unsigned e = my[i] * 128u + my[16 + j];
        outw[m] = (e << 16) | f2bf(val[m] * inv * SV[e]); outs[m] = SU[e]; }
}

typedef unsigned u32x3 __attribute__((ext_vector_type(3)));
typedef unsigned u32x6 __attribute__((ext_vector_type(6)));
typedef float f32x32 __attribute__((ext_vector_type(32)));
__device__ __forceinline__ float rdlane(float v, int l) { return __builtin_bit_cast(float, __builtin_amdgcn_readlane(__builtin_bit_cast(int, v), l)); }
__device__ __forceinline__ f32x32 fp6x2(u32x3 a, u32x3 b) { const u32x6 s = {a.x, a.y, a.z, b.x, b.y, b.z}; return __builtin_amdgcn_cvt_scalef32_pk32_f32_fp6(s, 1.0f); }
__device__ __forceinline__ void phase_gather(const Params& p, LAS unsigned char* lds, int G) {
    const int tid = threadIdx.x, lane = tid & 63, wave = __builtin_amdgcn_readfirstlane(tid >> 6);
    const float* modp = (const float*)(p.ws + WS_MODP);
    LAS float* g2 = (LAS float*)lds;
    const bf16* H2 = (const bf16*)(p.ws + WS_H2);
    const unsigned short* SC = (const unsigned short*)(p.ws + WS_SC); const float* SU = (const float*)(p.ws + WS_SU); const float* SV = (const float*)(p.ws + WS_SV);
    volatile LAS unsigned* RT = (volatile LAS unsigned*)(lds + 4096 + wave * 16640); volatile LAS float* RS = (volatile LAS float*)(RT + 1024);
    volatile LAS unsigned* myscr = RT + 2048 + lane * 33;
    const unsigned char* U6 = p.ws + WS_U; const unsigned char* V6 = p.ws + WS_V;
    for (int tile = blockIdx.x; tile < T / 256; tile += G) {
        const int b = tile / 32;
        __syncthreads();
        for (int k = tid; k < 1024; k += NTHR) g2[k] = mod_at(modp, b, 5120 + k) * p.npof[k];
        __syncthreads();
#pragma unroll 1
        for (int rr = 0; rr < 32; ++rr) {
            const size_t row = (size_t)tile * 256 + wave * 32 + rr;
            if ((rr & 7) == 0) {
                unsigned ow[16]; float os[16];
                __builtin_amdgcn_wave_barrier();
                topk_item(SC, SU, SV, (int)(row + (lane >> 3)), lane & 7, myscr, ow, os);
#pragma unroll
                for (int m = 0; m < 16; ++m) { RT[(lane >> 3) * 128 + (lane & 7) * 16 + m] = ow[m]; RS[(lane >> 3) * 128 + (lane & 7) * 16 + m] = os[m]; }
                asm volatile("s_waitcnt lgkmcnt(0)" ::: "memory"); __builtin_amdgcn_wave_barrier();
            }
            const int tl = rr & 7;
            float xt[16];
            { const u32x4 a = *(const u32x4*)(H2 + row * 1024 + lane * 16), c = *(const u32x4*)(H2 + row * 1024 + lane * 16 + 8);
              xt[0] = bflo(a.x); xt[1] = bfhi(a.x); xt[2] = bflo(a.y); xt[3] = bfhi(a.y); xt[4] = bflo(a.z); xt[5] = bfhi(a.z); xt[6] = bflo(a.w); xt[7] = bfhi(a.w);
              xt[8] = bflo(c.x); xt[9] = bfhi(c.x); xt[10] = bflo(c.y); xt[11] = bfhi(c.y); xt[12] = bflo(c.z); xt[13] = bfhi(c.z); xt[14] = bflo(c.w); xt[15] = bfhi(c.w); }
            float acc[16];
#pragma unroll
            for (int j = 0; j < 16; ++j) acc[j] = 0.f;
#pragma unroll 1
            for (int hh = 0; hh < 16; ++hh) {
                unsigned ww[8];
#pragma unroll
                for (int m = 0; m < 8; ++m) ww[m] = RT[tl * 128 + hh * 8 + m];
                u32x6 up[4], vp[4];
#pragma unroll
                for (int m = 0; m < 8; ++m) { const size_t eo = (size_t)((unsigned)__builtin_amdgcn_readfirstlane((int)ww[m]) >> 16) * 768 + lane * 12;
                    const u32x3 a = *(const u32x3*)(U6 + eo), c = *(const u32x3*)(V6 + eo);
                    if (m & 1) { up[m >> 1][3] = a.x; up[m >> 1][4] = a.y; up[m >> 1][5] = a.z; vp[m >> 1][3] = c.x; vp[m >> 1][4] = c.y; vp[m >> 1][5] = c.z; }
                    else { up[m >> 1][0] = a.x; up[m >> 1][1] = a.y; up[m >> 1][2] = a.z; vp[m >> 1][0] = c.x; vp[m >> 1][1] = c.y; vp[m >> 1][2] = c.z; } }
                const unsigned wa = RT[tl * 128 + hh * 8 + (lane >> 3)]; const float su = RS[tl * 128 + hh * 8 + (lane >> 3)];
                float pd[8];
#pragma unroll
                for (int m = 0; m < 8; m += 2) { const f32x32 f = __builtin_amdgcn_cvt_scalef32_pk32_f32_fp6(up[m >> 1], 1.0f);
                    float s0 = 0.f, s1 = 0.f;
#pragma unroll
                    for (int j = 0; j < 16; ++j) { s0 += xt[j] * f[j]; s1 += xt[j] * f[16 + j]; }
                    pd[m] = s0; pd[m + 1] = s1; __builtin_amdgcn_sched_barrier(0); }
#pragma unroll
                for (int j = 0; j < 4; ++j) { const bool up_ = (lane & 32) != 0; const float keep = up_ ? pd[j + 4] : pd[j], send = up_ ? pd[j] : pd[j + 4]; pd[j] = keep + __shfl_xor(send, 32); }
#pragma unroll
                for (int j = 0; j < 2; ++j) { const bool up_ = (lane & 16) != 0; const float keep = up_ ? pd[j + 2] : pd[j], send = up_ ? pd[j] : pd[j + 2]; pd[j] = keep + __shfl_xor(send, 16); }
                { const bool up_ = (lane & 8) != 0; const float keep = up_ ? pd[1] : pd[0], send = up_ ? pd[0] : pd[1]; pd[0] = keep + __shfl_xor(send, 8); }
                float d = pd[0]; d += __shfl_xor(d, 4); d += __shfl_xor(d, 2); d += __shfl_xor(d, 1);
                const float coef = bflo(wa) * gelu_f(su * d);
#pragma unroll
                for (int m = 0; m < 8; m += 2) { const f32x32 f = __builtin_amdgcn_cvt_scalef32_pk32_f32_fp6(vp[m >> 1], 1.0f); const float c0 = rdlane(coef, 8 * m), c1 = rdlane(coef, 8 * m + 8);
#pragma unroll
                    for (int j = 0; j < 16; ++j) acc[j] += c0 * f[j] + c1 * f[16 + j];
                    __builtin_amdgcn_sched_barrier(0); }
            }
            float s = 0.f;
#pragma unroll
            for (int j = 0; j < 16; ++j) s += acc[j] * acc[j];
            const float rstd = __builtin_amdgcn_rsqf(wave_sum(s) * (1.f / 1024.f) + 1e-6f);
            float* orow = p.out + row * 1024 + lane * 16;
#pragma unroll
            for (int q = 0; q < 4; ++q) { f32x4 o = *(const f32x4*)(orow + 4 * q); const f32x4 ga = *(const LAS f32x4*)(g2 + lane * 16 + 4 * q);
                o.x += ga.x * acc[4 * q] * rstd; o.y += ga.y * acc[4 * q + 1] * rstd; o.z += ga.z * acc[4 * q + 2] * rstd; o.w += ga.w * acc[4 * q + 3] * rstd;
                *(f32x4*)(orow + 4 * q) = o; }
        }
    }
}

#define XB_TMO      128
#define XB_XCNT(j)  (256  + 64 * (j))
#define XB_XSUB(j)  (1280 + 64 * (j))
#define XB_XGEN(j)  (2304 + 64 * (j))
#define XB_TOP      3328
#define XB_TOPGEN   3392
#define XCD_BAR_WORDS 3456
#define XB_SPIN_CAP (1u << 18)

__device__ __forceinline__ unsigned xb_ld(unsigned* p)              { return __hip_atomic_load(p, __ATOMIC_RELAXED, __HIP_MEMORY_SCOPE_AGENT); }
__device__ __forceinline__ unsigned xb_add(unsigned* p, unsigned v) { return __hip_atomic_fetch_add(p, v, __ATOMIC_RELAXED, __HIP_MEMORY_SCOPE_AGENT); }
__device__ __forceinline__ unsigned xb_xcc_id() { return (unsigned)__builtin_amdgcn_s_getreg((3 << 11) | 20) & 0xFu; }
#define XB_SPIN(cond, bar) do { unsigned _sp = 0; while (cond) { __builtin_amdgcn_s_sleep(1); \
    if ((++_sp & 255u) == 0u) { if (xb_ld(&(bar)[XB_TMO])) break; if (_sp > XB_SPIN_CAP) { atomicAdd(&(bar)[XB_TMO], 1u); break; } } } } while (0)

struct XcdBarrier {
    unsigned* bar; unsigned x;
    volatile LAS unsigned* st;
};

__device__ __forceinline__ XcdBarrier xcd_barrier_post(unsigned* bar, volatile LAS unsigned* st) {
    XcdBarrier b; b.bar = bar; b.x = xb_xcc_id(); b.st = st;
    if (threadIdx.x == 0) (void)xb_add(&bar[XB_XCNT(b.x)], 1u);
    return b;
}
__device__ __forceinline__ void xcd_barrier_complete(unsigned* bar, unsigned x, unsigned& nloc, unsigned& nx) {
    const unsigned G = gridDim.x * gridDim.y * gridDim.z;
    unsigned sum, cnt, mine, sp = 0u;
    for (;;) {
        sum = 0u; cnt = 0u; mine = 0u;
#pragma unroll
        for (unsigned j = 0; j < 16; ++j) { const unsigned c = xb_ld(&bar[XB_XCNT(j)]); sum += c; cnt += (c > 0u) ? 1u : 0u; mine = (j == x) ? c : mine; }
        if (sum == G) break;
        __builtin_amdgcn_s_sleep(1);
        if ((++sp & 255u) == 0u) { if (xb_ld(&bar[XB_TMO])) break; if (sp > XB_SPIN_CAP) { atomicAdd(&bar[XB_TMO], 1u); break; } }
    }
    nloc = mine > 0u ? mine : 1u; nx = cnt > 0u ? cnt : 1u;
}

__device__ __forceinline__ void xcd_barrier(const XcdBarrier& b) {
    asm volatile("s_waitcnt vmcnt(0)" ::: "memory");
    __syncthreads();
    if (threadIdx.x == 0) {
        unsigned* bar = b.bar;
        __builtin_amdgcn_s_waitcnt(0);
        unsigned nloc = b.st[0], nx = b.st[1];
        if (nloc == 0u) { xcd_barrier_complete(bar, b.x, nloc, nx); b.st[0] = nloc; b.st[1] = nx; }
        const unsigned old = xb_add(&bar[XB_XSUB(b.x)], 1u);
        const unsigned gen = old / nloc;
        if (old + 1u == (gen + 1u) * nloc) {
            __builtin_amdgcn_fence(__ATOMIC_RELEASE, "agent");
            asm volatile("s_waitcnt vmcnt(0)" ::: "memory");
            const unsigned og = xb_add(&bar[XB_TOP], 1u);
            const unsigned tg = og / nx;
            if (og + 1u == (tg + 1u) * nx) xb_add(&bar[XB_TOPGEN], 1u);
            else XB_SPIN(xb_ld(&bar[XB_TOPGEN]) == tg, bar);
            __builtin_amdgcn_fence(__ATOMIC_ACQUIRE, "agent");
            xb_add(&bar[XB_XGEN(b.x)], 1u);
            asm volatile("s_waitcnt vmcnt(0)" ::: "memory");
        } else {
            XB_SPIN(xb_ld(&bar[XB_XGEN(b.x)]) == gen, bar);
            __builtin_amdgcn_fence(__ATOMIC_ACQUIRE, "agent");
            asm volatile("s_waitcnt vmcnt(0)" ::: "memory");
        }
    }
    __syncthreads();
}


template <int PH>
__device__ __forceinline__ void run_phase(const Params& p, LAS unsigned char* lds, int G) {
    unsigned char* ws = p.ws;
    if constexpr (PH == 0) phase0(p, lds, G);
    else if constexpr (PH == 1) {
        { pg8::Gemm g{(const bf16*)(ws + WS_WQB), (const bf16*)(ws + WS_SUBK), 1024, 2048, 256, 2048}; pg8::StaticOrder S; S.init(1024, 2048, G, (int)blockIdx.x);
          EpiTrans E{(bf16*)(ws + WS_WQ), 1024}; pg8::gemm_phase<EpiTrans, pg8::StaticOrder, true, true, 2, 256, 2048>(lds, g, S, E); }
        __syncthreads();
        phase1(p, lds, G); }
    else if constexpr (PH == 2) { pg8::Gemm g{(const bf16*)p.out, (const bf16*)(ws + WS_WIN), T, NPAD, 1024, 1024}; pg8::StaticOrder S; S.init(T, NPAD, G, (int)blockIdx.x);
        EpiSeg E{ws}; pg8::gemm_phase<EpiSeg, pg8::StaticOrder, true, true, 0, 1024, 1024>(lds, g, S, E); }
    else if constexpr (PH == 3) { phase_gla_prep(p, lds, G); __syncthreads(); phase_lru<false>(p, lds, G); }
    else if constexpr (PH == 4) phase_gla_seq(p, lds, G);
    else if constexpr (PH == 5) phase_lru<true>(p, lds, G);
    else if constexpr (PH == 6) { pg8::Gemm g{(const bf16*)(ws + WS_GAGB), (const bf16*)(ws + WS_WOUT), T, 1024, 1024, 2048}; pg8::StaticOrder S; S.init(T, 1024, G, (int)blockIdx.x);
        EpiPlain E{(bf16*)(ws + WS_Y), 1024}; pg8::gemm_phase<EpiPlain, pg8::StaticOrder, true, true, 0, 1024, 2048>(lds, g, S, E); }
    else if constexpr (PH == 7) phase_norm2(p, lds, G);
    else if constexpr (PH == 8) {
        pg8::Gemm g{(const bf16*)(ws + WS_H2), (const bf16*)(ws + WS_WQ), T, 2048, 1024, 1024}; pg8::StaticOrder S; S.init(T, 2048, G, (int)blockIdx.x);
        EpiF16 E{(unsigned short*)(ws + WS_SC), 2048}; pg8::gemm_phase<EpiF16, pg8::StaticOrder, true, true, 0, 1024, 1024>(lds, g, S, E); }
    else if constexpr (PH == 9) phase_gather(p, lds, G);
}
template <int PH>
__global__ void __launch_bounds__(NTHR, 2) k_phase(Params p) {
    extern __shared__ __attribute__((aligned(16))) unsigned char lds_raw[];
    run_phase<PH>(p, (LAS unsigned char*)lds_raw, (int)gridDim.x);
}
constexpr int LDS_BAR_OFF = LDS_BYTES - 16;
template <int PH>
__device__ __forceinline__ void run_from(const Params& p, LAS unsigned char* lds, int G, const XcdBarrier& bar) {
#if PROBE_PH >= 0
    unsigned long long pt0 = 0; if constexpr (PH == PROBE_PH) pt0 = __builtin_amdgcn_s_memrealtime();
#endif
    run_phase<PH>(p, lds, G);
    if constexpr (PH + 1 < N_PHASES) {
        if constexpr (PH == 0) cg::this_grid().sync();
        else xcd_barrier(bar);
    }
#if PROBE_PH >= 0
    if constexpr (PH == PROBE_PH) { const unsigned long long pt1 = __builtin_amdgcn_s_memrealtime(), span = pt1 - pt0;
        while (__builtin_amdgcn_s_memrealtime() - pt1 < (unsigned long long)PROBE_MULT * span) __builtin_amdgcn_s_sleep(8); }
#endif
    if constexpr (PH + 1 < N_PHASES) run_from<PH + 1>(p, lds, G, bar);
}
__global__ void __launch_bounds__(NTHR, 2) k_mega(Params p) {
    extern __shared__ __attribute__((aligned(16))) unsigned char lds_raw[];
    LAS unsigned char* lds = (LAS unsigned char*)lds_raw;
    if (threadIdx.x < 4) ((LAS unsigned*)(lds + LDS_BAR_OFF))[threadIdx.x] = 0u;
    __syncthreads();
    const XcdBarrier bar = xcd_barrier_post((unsigned*)(p.ws + WS_CTL), (volatile LAS unsigned*)(lds + LDS_BAR_OFF));
    run_from<0>(p, lds, (int)gridDim.x, bar);
}

extern "C" void kernel_launch(void* const* d_in, const int* in_sizes, int n_in, void* d_out, int out_size, void* d_ws, size_t ws_size, hipStream_t stream) {
    static int grid = 0;
    if (grid == 0) {
        if (n_in != 24 || in_sizes[0] != T * DM || out_size != T * DM || ws_size < WS_END) {
            fprintf(stderr, "kernel_launch: unexpected shapes: n_in %d in0 %d out %d ws %zu\n", n_in, n_in > 0 ? in_sizes[0] : -1, out_size, ws_size); grid = -1; return; }
        int dev = 0, cus = 0, per_cu = 0;
        if (hipGetDevice(&dev) != hipSuccess || hipDeviceGetAttribute(&cus, hipDeviceAttributeMultiprocessorCount, dev) != hipSuccess) { grid = -1; return; }
        if (hipFuncSetAttribute((const void*)k_mega, hipFuncAttributeMaxDynamicSharedMemorySize, LDS_BYTES) != hipSuccess) { fprintf(stderr, "kernel_launch: hipFuncSetAttribute failed\n"); grid = -1; return; }
        if (hipOccupancyMaxActiveBlocksPerMultiprocessor(&per_cu, (const void*)k_mega, NTHR, LDS_BYTES) != hipSuccess || per_cu < 1) { fprintf(stderr, "kernel_launch: occupancy query says %d blocks per CU\n", per_cu); grid = -1; return; }
        (void)hipGetLastError();
        grid = cus;
    }
    if (grid < 0) return;
    Params p{};
    const float** pp = (const float**)&p;
    for (int i = 0; i < 24; ++i) pp[i] = (const float*)d_in[i];
    p.out = (float*)d_out; p.ws = (unsigned char*)d_ws;
    if (hipMemsetAsync((char*)d_ws + WS_CTL, 0, 65536, stream) != hipSuccess) { fprintf(stderr, "kernel_launch: hipMemsetAsync failed\n"); return; }
    void* args[] = {&p};
    hipError_t e = hipLaunchCooperativeKernel((const void*)k_mega, dim3(grid), dim3(NTHR), args, LDS_BYTES, stream);
    if (e != hipSuccess) fprintf(stderr, "kernel_launch: cooperative launch failed: %s (grid %d)\n", hipGetErrorString(e), grid);
}
```

```cpp
#include <hip/hip_runtime.h>
#include <hip/hip_cooperative_groups.h>
#include <cstdio>
#include <cstdint>
#include <utility>
namespace cg = cooperative_groups;

namespace pg8 {
#define PG8_LAS __attribute__((address_space(3)))
typedef unsigned short bf16_t;
typedef short bf16x8 __attribute__((ext_vector_type(8)));
typedef float f32x4 __attribute__((ext_vector_type(4)));
typedef unsigned u32x4 __attribute__((ext_vector_type(4)));
constexpr int BM = 256, BK = 64, HALF = 128, HTB = HALF * BK * 2  , STAGE_BYTES = 8 * HTB, NXCD = 8, WGM = 8;

__host__ __device__ __forceinline__ int lds_byte(int r, int c) { const int st = (r >> 4) * 2 + (c >> 5), rr = r & 15, cc = c & 31, ob = rr * 64 + cc * 2; return st * 1024 + (ob ^ (((ob >> 9) & 1) << 5)); }
__host__ __device__ __forceinline__ void stage_rc(int b, int& R, int& C) { const int st = b / 1024, sb = b % 1024, swz = sb ^ (((sb >> 9) & 1) << 5); R = (st >> 1) * 16 + swz / 64; C = (st & 1) * 32 + (swz % 64) / 2; }
__host__ __device__ __forceinline__ int perm32(int rho) { const int n = rho >> 4, i = rho & 15; return 8 * (i >> 2) + 4 * n + (i & 3); }

struct Unit { int pm, pn; };
struct Gemm { const bf16_t* A; const bf16_t* Bt; int M, N, K, lda; };
template <int AMODE> __device__ __forceinline__ size_t a_off_bytes(const Gemm& g, const Unit& u) {
    const int ac = AMODE == 0 ? 0 : (AMODE == 1 ? 128 * (u.pn < 6 ? u.pn : 6) : 256 * u.pn);
    return ((size_t)u.pm * BM * (size_t)g.lda + (size_t)ac) * 2;
}

struct StaticOrder {
    int nM, nN, nwg, G, c;
    __host__ __device__ void init(int M, int N, int G_, int c_) { nM = M / BM; nN = N / BM; nwg = nM * nN; G = G_; c = c_; }
    __host__ __device__ bool next(int i, Unit& u) const {
        const long L = (long)i * G + c; if (L >= nwg) return false;
        int wgid = (int)L; { const int q = nwg / NXCD, r = nwg % NXCD, xcd = wgid % NXCD, off = wgid / NXCD; wgid = (xcd < r ? xcd * (q + 1) : r * (q + 1) + (xcd - r) * q) + off; }
        const int nig = WGM * nN, gid = wgid / nig, fm = gid * WGM, gsz = (nM - fm) < WGM ? (nM - fm) : WGM;
        u.pm = fm + ((wgid % nig) % gsz); u.pn = (wgid % nig) / gsz; return true;
    }
    __device__ __forceinline__ void a_ready(const Unit&) const {}
    __device__ __forceinline__ void done(const Unit&) const {}
};

__device__ __forceinline__ unsigned cvt_pk_bf16(float lo, float hi) { unsigned r; asm volatile("v_cvt_pk_bf16_f32 %0, %1, %2" : "=v"(r) : "v"(lo), "v"(hi)); return r; }

template <class Epi, class Sched, bool ALIGN_EPI = false, bool SP2 = false, int AMODE = 0, int KC = 0, int LDAC = 0>
__device__ __forceinline__ void gemm_phase(PG8_LAS unsigned char* lds, const Gemm g, const Sched& S, const Epi& E) {
    const int tid = threadIdx.x, wid = __builtin_amdgcn_readfirstlane(tid >> 6), lane = tid & 63, wr = wid >> 2, wc = wid & 3, fr = lane & 15, fq = lane >> 4;
    const int K = KC ? KC : g.K, nt = K / BK; const int lda = LDAC ? LDAC : g.lda;
    unsigned voffA[2], voffB[2];
#pragma unroll
    for (int i = 0; i < 2; ++i) { int R, C; stage_rc(tid * 16 + i * 8192, R, C); const int Rb = Epi::PERM ? ((R & ~31) + perm32(R & 31)) : R;
        voffA[i] = (unsigned)(R * lda + C) * 2u; voffB[i] = (unsigned)(Rb * K + C) * 2u; }
    const size_t kstep = (size_t)(BK * 2);
    const size_t hstepA = (size_t)HALF * lda * 2;
    const size_t hstepB = (size_t)HALF * K * 2;
    const size_t tstepB = 2 * hstepB;
    const unsigned ldsw = (unsigned)wid * 1024u;
    const int aoff = lds_byte(wr * 64 + fr, fq * 8), boff = lds_byte(wc * 32 + fr, fq * 8);
#define PG8_SA(b, h) (((b) * 2 + (h)) * HTB)
#define PG8_SB(b, h) ((4 + (b) * 2 + (h)) * HTB)
#define PG8_STAGE(bufoff, gbase, voff) do { _Pragma("unroll") for (int _i = 0; _i < 2; ++_i) \
        __builtin_amdgcn_global_load_lds((const unsigned*)((const char*)(gbase) + (voff)[_i]), (PG8_LAS unsigned*)(lds + (bufoff) + ldsw + _i * 8192), 16, 0, 0); } while (0)
#define PG8_LDA(dst, b, h) do { _Pragma("unroll") for (int m = 0; m < 4; ++m) _Pragma("unroll") for (int k = 0; k < 2; ++k) dst[m][k] = *(const PG8_LAS bf16x8*)(lds + PG8_SA(b, h) + aoff + m * 2048 + k * 1024); } while (0)
#define PG8_LDB(dst, b, h) do { _Pragma("unroll") for (int n = 0; n < 2; ++n) _Pragma("unroll") for (int k = 0; k < 2; ++k) dst[n][k] = *(const PG8_LAS bf16x8*)(lds + PG8_SB(b, h) + boff + n * 2048 + k * 1024); } while (0)
#define PG8_MMA(ai, bj, At, Bt) do { __builtin_amdgcn_s_setprio(1); _Pragma("unroll") for (int m = 0; m < 4; ++m) _Pragma("unroll") for (int n = 0; n < 2; ++n) _Pragma("unroll") for (int k = 0; k < 2; ++k) \
        acc[ai][bj][m][n] = __builtin_amdgcn_mfma_f32_16x16x32_bf16(Bt[n][k], At[m][k], acc[ai][bj][m][n], 0, 0, 0); __builtin_amdgcn_s_setprio(0); } while (0)
#define PG8_WAIT_V(n) asm volatile("s_waitcnt vmcnt(" #n ")" ::: "memory")
#define PG8_WAIT_L(n) asm volatile("s_waitcnt lgkmcnt(" #n ")" ::: "memory")
#define PG8_BAR __builtin_amdgcn_s_barrier()
#define PG8_SCHED __builtin_amdgcn_sched_barrier(0)
    Unit cur, nxt; int ui = 0;
    if (!S.next(0, cur)) return;
    f32x4 acc[2][2][4][2];
#pragma unroll
    for (int a = 0; a < 2; ++a)
#pragma unroll
        for (int b = 0; b < 2; ++b)
#pragma unroll
            for (int m = 0; m < 4; ++m)
#pragma unroll
                for (int n = 0; n < 2; ++n) acc[a][b][m][n] = (f32x4){0.f, 0.f, 0.f, 0.f};
    bf16x8 At[4][2], B0[2][2], B1[2][2];
    const char* cA = (const char*)g.A + a_off_bytes<AMODE>(g, cur); const char* cB = (const char*)g.Bt + (size_t)cur.pn * tstepB;
    S.a_ready(cur);
    if constexpr (SP2) {
        PG8_STAGE(PG8_SB(0, 0), cB, voffB); PG8_STAGE(PG8_SB(0, 1), cB + hstepB, voffB); PG8_STAGE(PG8_SA(0, 0), cA, voffA); PG8_STAGE(PG8_SA(0, 1), cA + hstepA, voffA);
        if (wr == 1) PG8_BAR;
        PG8_WAIT_V(2); PG8_BAR;
        PG8_STAGE(PG8_SB(1, 0), cB + kstep, voffB); PG8_STAGE(PG8_SA(1, 0), cA + kstep, voffA); PG8_STAGE(PG8_SB(1, 1), cB + hstepB + kstep, voffB);
        PG8_WAIT_V(6); PG8_BAR;
    } else {
        PG8_STAGE(PG8_SB(0, 0), cB, voffB); PG8_STAGE(PG8_SA(0, 0), cA, voffA); PG8_STAGE(PG8_SB(0, 1), cB + hstepB, voffB); PG8_STAGE(PG8_SA(0, 1), cA + hstepA, voffA);
        if (wr == 1) PG8_BAR;
        PG8_WAIT_V(4); PG8_BAR;
        PG8_STAGE(PG8_SB(1, 0), cB + kstep, voffB); PG8_STAGE(PG8_SA(1, 0), cA + kstep, voffA); PG8_STAGE(PG8_SB(1, 1), cB + hstepB + kstep, voffB);
        PG8_WAIT_V(6); PG8_BAR;
    }
    for (;;) {
        const bool has_next = S.next(ui + 1, nxt);
        const char* nA = has_next ? (const char*)g.A + a_off_bytes<AMODE>(g, nxt) : cA; const char* nB = has_next ? (const char*)g.Bt + (size_t)nxt.pn * tstepB : cB;
#pragma unroll 1
        for (int t = 0; t < nt; t += 2) {
            const bool last = (t == nt - 2);
            const char* a1 = cA + (size_t)(t + 1) * kstep;
            const char* a2 = last ? nA : cA + (size_t)(t + 2) * kstep; const char* b2 = last ? nB : cB + (size_t)(t + 2) * kstep;
            const char* a3 = a2 + kstep; const char* b3 = b2 + kstep;
            if (last && has_next) S.a_ready(nxt);
            if constexpr (SP2) {
            PG8_LDB(B0, 0, 0); PG8_LDB(B1, 0, 1); PG8_SCHED; PG8_LDA(At, 0, 0); PG8_STAGE(PG8_SA(1, 1), a1 + hstepA, voffA);
            PG8_WAIT_V(8); PG8_WAIT_L(0); PG8_BAR; PG8_MMA(0, 0, At, B0); PG8_MMA(0, 1, At, B1); PG8_BAR; PG8_SCHED;
            PG8_LDA(At, 0, 1); PG8_STAGE(PG8_SB(0, 0), b2, voffB); PG8_STAGE(PG8_SB(0, 1), b2 + hstepB, voffB); PG8_STAGE(PG8_SA(0, 0), a2, voffA);
            PG8_WAIT_V(8); PG8_WAIT_L(0); PG8_BAR; PG8_MMA(1, 0, At, B0); PG8_MMA(1, 1, At, B1); PG8_BAR; PG8_SCHED;
            PG8_LDB(B0, 1, 0); PG8_LDB(B1, 1, 1); PG8_SCHED; PG8_LDA(At, 1, 0); PG8_STAGE(PG8_SA(0, 1), a2 + hstepA, voffA);
            PG8_WAIT_V(8); PG8_WAIT_L(0); PG8_BAR; PG8_MMA(0, 0, At, B0); PG8_MMA(0, 1, At, B1); PG8_BAR; PG8_SCHED;
            PG8_LDA(At, 1, 1); PG8_STAGE(PG8_SB(1, 0), b3, voffB); PG8_STAGE(PG8_SB(1, 1), b3 + hstepB, voffB); PG8_STAGE(PG8_SA(1, 0), a3, voffA);
            PG8_WAIT_V(8); PG8_WAIT_L(0); PG8_BAR; PG8_MMA(1, 0, At, B0); PG8_MMA(1, 1, At, B1); PG8_BAR; PG8_SCHED;
            } else {
            PG8_LDB(B0, 0, 0); PG8_SCHED; PG8_LDA(At, 0, 0); PG8_STAGE(PG8_SA(1, 1), a1 + hstepA, voffA);
            PG8_WAIT_L(8); PG8_BAR; PG8_WAIT_L(0); PG8_MMA(0, 0, At, B0); PG8_BAR; PG8_SCHED;
            PG8_LDB(B1, 0, 1); PG8_STAGE(PG8_SB(0, 0), b2, voffB);
            PG8_BAR; PG8_WAIT_L(0); PG8_MMA(0, 1, At, B1); PG8_BAR;
            PG8_LDA(At, 0, 1); PG8_STAGE(PG8_SA(0, 0), a2, voffA);
            PG8_BAR; PG8_WAIT_L(0); PG8_MMA(1, 0, At, B0); PG8_BAR; PG8_SCHED;
            PG8_STAGE(PG8_SB(0, 1), b2 + hstepB, voffB);
            PG8_WAIT_V(6); PG8_BAR; PG8_MMA(1, 1, At, B1); PG8_BAR;
            PG8_LDB(B0, 1, 0); PG8_SCHED; PG8_LDA(At, 1, 0); PG8_STAGE(PG8_SA(0, 1), a2 + hstepA, voffA);
            PG8_WAIT_L(8); PG8_BAR; PG8_WAIT_L(0); PG8_MMA(0, 0, At, B0); PG8_BAR; PG8_SCHED;
            PG8_LDB(B1, 1, 1); PG8_STAGE(PG8_SB(1, 0), b3, voffB);
            PG8_BAR; PG8_WAIT_L(0); PG8_MMA(0, 1, At, B1); PG8_BAR;
            PG8_LDA(At, 1, 1); PG8_STAGE(PG8_SA(1, 0), a3, voffA);
            PG8_BAR; PG8_WAIT_L(0); PG8_MMA(1, 0, At, B0); PG8_BAR; PG8_SCHED;
            PG8_STAGE(PG8_SB(1, 1), b3 + hstepB, voffB);
            PG8_WAIT_V(6); PG8_BAR; PG8_MMA(1, 1, At, B1); PG8_BAR;
            }
        }
        if constexpr (ALIGN_EPI) { if (wr == 0) PG8_BAR; }
        E(acc, cur, wr, wc, fr, fq); S.done(cur);
        if (!has_next) break;
#pragma unroll
        for (int a = 0; a < 2; ++a)
#pragma unroll
            for (int b = 0; b < 2; ++b)
#pragma unroll
                for (int m = 0; m < 4; ++m)
#pragma unroll
                    for (int n = 0; n < 2; ++n) acc[a][b][m][n] = (f32x4){0.f, 0.f, 0.f, 0.f};
        cur = nxt; cA = nA; cB = nB; ++ui;
        if constexpr (ALIGN_EPI) { if (wr == 1) PG8_BAR; }
    }
    PG8_WAIT_V(0);
    if constexpr (!ALIGN_EPI) { if (wr == 0) PG8_BAR; }
    PG8_BAR;
#undef PG8_SA
#undef PG8_SB
#undef PG8_STAGE
#undef PG8_LDA
#undef PG8_LDB
#undef PG8_MMA
#undef PG8_WAIT_V
#undef PG8_WAIT_L
#undef PG8_BAR
#undef PG8_SCHED
}
}

constexpr int NB = 8, SEQ = 8192, DM = 1024, T = NB * SEQ;
constexpr int NPAD = 7424;
constexpr int NWAVES = 8, NTHR = 512;
constexpr int LDS_BYTES = 147456;
constexpr int N_PHASES = 10;
#define PROBE_PH -1
#define PROBE_MULT 3

constexpr size_t MiB = 1ull << 20;
constexpr size_t WS_CTL = 0;
constexpr size_t WS_MODP = 1 * MiB;
constexpr size_t WS_WIN = 3 * MiB;
constexpr size_t WS_WOUT = 18 * MiB;
constexpr size_t WS_WQ = 20 * MiB;
constexpr size_t WS_WQB = 480 * MiB;
constexpr size_t WS_LRUB = 24 * MiB;
constexpr size_t WS_SUBK = 25 * MiB;
constexpr size_t WS_LRUC = 26 * MiB;
constexpr size_t WS_U = 32 * MiB;
constexpr size_t WS_V = 48 * MiB;
constexpr size_t WS_SU = 64 * MiB;
constexpr size_t WS_SV = 65 * MiB;
constexpr size_t WS_SS = 30 * MiB;
constexpr size_t WS_DK = 66 * MiB;
constexpr size_t WS_QKV = 96 * MiB;
constexpr size_t WS_R = 352 * MiB;
constexpr size_t WS_XLXG = 480 * MiB;
constexpr size_t WS_GAGB = 736 * MiB;
constexpr size_t WS_ALOW = 992 * MiB;
constexpr size_t WS_END = 994 * MiB;
constexpr size_t WS_Y = WS_QKV;
constexpr size_t WS_H2 = WS_QKV + 128 * MiB;
constexpr size_t WS_QRY = WS_XLXG;
constexpr size_t WS_SC = WS_GAGB;
constexpr size_t WS_TOPK = WS_R;
constexpr size_t WS_TOPK2 = WS_R + 32 * MiB;

#define LAS __attribute__((address_space(3)))
typedef unsigned short bf16;
typedef float f32x4 __attribute__((ext_vector_type(4)));
typedef float f32x2 __attribute__((ext_vector_type(2)));
typedef unsigned u32x4 __attribute__((ext_vector_type(4)));
typedef unsigned u32x2 __attribute__((ext_vector_type(2)));

struct Params {
    const float *x, *c, *w_ada, *b_ada, *npm, *npo, *w_in, *w_alpha, *b_alpha, *gla_norm, *conv_w, *conv_b,
        *lwa, *lba, *lwx, *lbx, *lam, *w_out, *npf, *npof, *wq, *subk, *pu, *pv;
    float* out; unsigned char* ws;
    int ph_lo, ph_hi;
};

__device__ __forceinline__ unsigned pk2(float lo, float hi) { unsigned r; asm("v_cvt_pk_bf16_f32 %0, %1, %2" : "=v"(r) : "v"(lo), "v"(hi)); return r; }
__device__ __forceinline__ unsigned f2bf(float f) { return pk2(f, f) & 0xffffu; }
__device__ __forceinline__ float bflo(unsigned u) { return __builtin_bit_cast(float, u << 16); }
__device__ __forceinline__ float bfhi(unsigned u) { return __builtin_bit_cast(float, u & 0xffff0000u); }
__device__ __forceinline__ float bf2f(bf16 h) { return __builtin_bit_cast(float, (unsigned)h << 16); }
__device__ __forceinline__ float sigmoid_f(float x) { return __builtin_amdgcn_rcpf(1.f + __expf(-x)); }
__device__ __forceinline__ float silu_f(float x) { return x * __builtin_amdgcn_rcpf(1.f + __expf(-x)); }
__device__ __forceinline__ float gelu_f(float x) { const float u = 0.7978845608028654f * (x + 0.044715f * x * x * x); return x * __builtin_amdgcn_rcpf(1.f + __expf(-2.f * u)); }
__device__ __forceinline__ float softplus_f(float x) { return fmaxf(x, 0.f) + log1pf(__expf(-fabsf(x))); }
__device__ __forceinline__ float wave_sum(float v) {
#pragma unroll
    for (int o = 1; o < 64; o <<= 1) v += __shfl_xor(v, o);
    return v;
}
__device__ __forceinline__ float merge2(float ga, float on, float r, float gb, float hl, float xg) {
    const float u = 0.7978845608028654f * (xg + 0.044715f * xg * xg * xg);
    const float d1 = (1.f + __expf(-ga)) * (1.f + __expf(-r)), d2 = (1.f + __expf(-gb)) * (1.f + __expf(-2.f * u));
    return on * r * __builtin_amdgcn_rcpf(d1) + hl * xg * __builtin_amdgcn_rcpf(d2);
}
#define LDS_WAIT() asm volatile("s_waitcnt lgkmcnt(0)" ::: "memory")

struct EpiSeg {
    static constexpr bool PERM = true;
    unsigned char* ws;
    __device__ __forceinline__ void operator()(const pg8::f32x4 (&acc)[2][2][4][2], const pg8::Unit& u, int wr, int wc, int fr, int fq) const {
        const int pn = u.pn; bf16* base; int ldc, colt;
        if (pn < 8) { base = (bf16*)(ws + WS_QKV); ldc = 2048; colt = pn * 256; }
        else if (pn < 12) { base = (bf16*)(ws + WS_R); ldc = 1024; colt = (pn - 8) * 256; }
        else if (pn < 20) { base = (bf16*)(ws + WS_XLXG); ldc = 2048; colt = (pn - 12) * 256; }
        else if (pn < 28) { base = (bf16*)(ws + WS_GAGB); ldc = 2048; colt = (pn - 20) * 256; }
        else { base = (bf16*)(ws + WS_ALOW); ldc = 16; colt = 0; }
        const int row0 = u.pm * 256 + wr * 64 + fr, col0 = colt + wc * 32 + 8 * fq;
        const bool tail = (pn == 28);
#pragma unroll
        for (int ai = 0; ai < 2; ++ai)
#pragma unroll
            for (int m = 0; m < 4; ++m) { bf16* rowp = base + (size_t)(row0 + ai * 128 + m * 16) * ldc + col0;
#pragma unroll
                for (int bj = 0; bj < 2; ++bj) { const pg8::f32x4 v0 = acc[ai][bj][m][0], v1 = acc[ai][bj][m][1];
                    u32x4 w; w.x = pg8::cvt_pk_bf16(v0[0], v0[1]); w.y = pg8::cvt_pk_bf16(v0[2], v0[3]); w.z = pg8::cvt_pk_bf16(v1[0], v1[1]); w.w = pg8::cvt_pk_bf16(v1[2], v1[3]);
                    if (!tail || (bj == 0 && wc == 0 && fq < 2)) *(u32x4*)(rowp + bj * 128) = w; } }
    }
};
struct EpiPlain {
    static constexpr bool PERM = true;
    bf16* O; int ldc;
    __device__ __forceinline__ void operator()(const pg8::f32x4 (&acc)[2][2][4][2], const pg8::Unit& u, int wr, int wc, int fr, int fq) const {
        const int row0 = u.pm * 256 + wr * 64 + fr, col0 = u.pn * 256 + wc * 32 + 8 * fq;
#pragma unroll
        for (int ai = 0; ai < 2; ++ai)
#pragma unroll
            for (int m = 0; m < 4; ++m) { bf16* rowp = O + (size_t)(row0 + ai * 128 + m * 16) * ldc + col0;
#pragma unroll
                for (int bj = 0; bj < 2; ++bj) { const pg8::f32x4 v0 = acc[ai][bj][m][0], v1 = acc[ai][bj][m][1];
                    u32x4 w; w.x = pg8::cvt_pk_bf16(v0[0], v0[1]); w.y = pg8::cvt_pk_bf16(v0[2], v0[3]); w.z = pg8::cvt_pk_bf16(v1[0], v1[1]); w.w = pg8::cvt_pk_bf16(v1[2], v1[3]);
                    *(u32x4*)(rowp + bj * 128) = w; } }
    }
};
typedef _Float16 h16x2 __attribute__((ext_vector_type(2)));
__device__ __forceinline__ unsigned pkh(float a, float b) { return __builtin_bit_cast(unsigned, __builtin_amdgcn_cvt_pkrtz(a, b)); }
struct EpiF16 {
    static constexpr bool PERM = true;
    unsigned short* O; int ldc;
    __device__ __forceinline__ void operator()(const pg8::f32x4 (&acc)[2][2][4][2], const pg8::Unit& u, int wr, int wc, int fr, int fq) const {
        const int row0 = u.pm * 256 + wr * 64 + fr, col0 = u.pn * 256 + wc * 32 + 8 * fq;
#pragma unroll
        for (int ai = 0; ai < 2; ++ai)
#pragma unroll
            for (int m = 0; m < 4; ++m) { unsigned short* rowp = O + (size_t)(row0 + ai * 128 + m * 16) * ldc + col0;
#pragma unroll
                for (int bj = 0; bj < 2; ++bj) { const pg8::f32x4 v0 = acc[ai][bj][m][0], v1 = acc[ai][bj][m][1];
                    u32x4 w; w.x = pkh(v0[0], v0[1]); w.y = pkh(v0[2], v0[3]); w.z = pkh(v1[0], v1[1]); w.w = pkh(v1[2], v1[3]);
                    *(u32x4*)(rowp + bj * 128) = w; } }
    }
};
struct EpiTrans {
    static constexpr bool PERM = true;
    bf16* O; int ldc;
    __device__ __forceinline__ void operator()(const pg8::f32x4 (&acc)[2][2][4][2], const pg8::Unit& u, int wr, int wc, int fr, int fq) const {
        const int row0 = u.pm * 256 + wr * 64 + fr, col0 = u.pn * 256 + wc * 32 + 8 * fq;
#pragma unroll
        for (int ai = 0; ai < 2; ++ai)
#pragma unroll
            for (int m = 0; m < 4; ++m) { const int row = row0 + ai * 128 + m * 16;
#pragma unroll
                for (int bj = 0; bj < 2; ++bj)
#pragma unroll
                    for (int n = 0; n < 2; ++n)
#pragma unroll
                        for (int e = 0; e < 4; ++e) O[(size_t)(col0 + bj * 128 + 4 * n + e) * ldc + row] = (bf16)f2bf(acc[ai][bj][m][n][e]); }
    }
};

__device__ __forceinline__ void p0_transpose_item(const float* W, int ldw, int k0, int n0, int nvalid, bf16* WT, int ldk, int row0, int kc0, LAS float* scr, int lane) {
#pragma unroll 8
    for (int i = 0; i < 32; ++i) { const int kk = 2 * i + (lane >> 5), cc = lane & 31; scr[kk * 33 + cc] = (cc < nvalid) ? W[(size_t)(k0 + kk) * ldw + n0 + cc] : 0.f; }
    LDS_WAIT(); asm volatile("" ::: "memory");
    const int c = lane & 7;
#pragma unroll
    for (int j = 0; j < 4; ++j) { const int n = (lane >> 3) + 8 * j; const LAS float* s = scr + (8 * c) * 33 + n;
        u32x4 o; o.x = pk2(s[0 * 33], s[1 * 33]); o.y = pk2(s[2 * 33], s[3 * 33]); o.z = pk2(s[4 * 33], s[5 * 33]); o.w = pk2(s[6 * 33], s[7 * 33]);
        *(u32x4*)(WT + (size_t)(row0 + n) * ldk + kc0 + k0 + 8 * c) = o; }
    LDS_WAIT(); asm volatile("" ::: "memory");
}
__device__ __forceinline__ void phase0(const Params& p, LAS unsigned char* lds, int G) {
    const int tid = threadIdx.x, lane = tid & 63, wave = __builtin_amdgcn_readfirstlane(tid >> 6);
    unsigned char* ws = p.ws;
    {
        LAS float* sc = (LAS float*)lds;
        LAS float* red = (LAS float*)(lds + 4096);
        float* modp = (float*)(ws + WS_MODP);
        for (int it = blockIdx.x; it < 24 * 8; it += G) {
            const int nb = it % 24, kc = it / 24;
            for (int i = tid; i < 1024; i += NTHR) { const int b = i >> 7, k = i & 127; sc[i] = silu_f(p.c[b * 1024 + kc * 128 + k]); }
            __syncthreads();
            const int col = tid & 255, kh = tid >> 8;
            float acc[8];
#pragma unroll
            for (int b = 0; b < 8; ++b) acc[b] = 0.f;
            const float* wp = p.w_ada + (size_t)(kc * 128 + kh * 64) * 6144 + nb * 256 + col;
#pragma unroll 8
            for (int kk = 0; kk < 64; ++kk) { const float w = wp[(size_t)kk * 6144];
#pragma unroll
                for (int b = 0; b < 8; ++b) acc[b] += sc[b * 128 + kh * 64 + kk] * w; }
            if (kh == 1) {
#pragma unroll
                for (int b = 0; b < 8; ++b) red[b * 256 + col] = acc[b]; }
            __syncthreads();
            if (kh == 0) { const int n = nb * 256 + col; const float bias = (kc == 0) ? p.b_ada[n] : 0.f;
#pragma unroll
                for (int b = 0; b < 8; ++b) modp[(size_t)(kc * 8 + b) * 6144 + n] = acc[b] + red[b * 256 + col] + bias; }
            __syncthreads();
        }
    }
    for (int i = blockIdx.x * NTHR + tid; i < T * 4 / 4; i += G * NTHR) ((f32x4*)(ws + WS_SS))[i] = (f32x4){0.f, 0.f, 0.f, 0.f};
    LAS float* scr = (LAS float*)(lds + 16384 + wave * 8448);
    const int gw = blockIdx.x * NWAVES + wave, NGW = G * NWAVES;
    bf16* WinT = (bf16*)(ws + WS_WIN); bf16* WoutT = (bf16*)(ws + WS_WOUT);
    bf16* LruB = (bf16*)(ws + WS_LRUB); bf16* SubK = (bf16*)(ws + WS_SUBK);
    constexpr int I_IN = 16 * (NPAD / 32), I_OUT = 16 * 32, I_Q = 2048, I_LRU = 16 * 8, I_SUB = 2048, I_TAB = 2 * 16384;
    constexpr int NIT = I_IN + I_OUT + I_Q + I_LRU + I_SUB + I_TAB;
    for (int it = gw; it < NIT; it += NGW) {
        int r = it;
        if (r < I_IN) { const int nb = r % (NPAD / 32), kb = r / (NPAD / 32), nq = nb * 32; int n0, nv;
            if (nq < 3072) { n0 = nq; nv = 32; } else if (nq < 7168) { n0 = nq + 16; nv = 32; } else if (nq == 7168) { n0 = 3072; nv = 16; } else { n0 = 0; nv = 0; }
            p0_transpose_item(p.w_in, 7184, kb * 64, n0, nv, WinT, 1024, nq, 0, scr, lane); continue; } r -= I_IN;
        if (r < I_OUT) { const int nb = r % 32, kb = r / 32; p0_transpose_item(p.w_out, 1024, kb * 64, nb * 32, 32, WoutT, 1024, nb * 32, 0, scr, lane); continue; } r -= I_OUT;
        if (r < I_Q) {
            const float* src = p.wq + (size_t)r * 1024; bf16* dst = (bf16*)(ws + WS_WQB) + (size_t)r * 1024;
#pragma unroll
            for (int j = 0; j < 2; ++j) { const f32x4 a = *(const f32x4*)(src + j * 512 + lane * 8), b = *(const f32x4*)(src + j * 512 + lane * 8 + 4);
                u32x4 o; o.x = pk2(a.x, a.y); o.y = pk2(a.z, a.w); o.z = pk2(b.x, b.y); o.w = pk2(b.z, b.w);
                *(u32x4*)(dst + j * 512 + lane * 8) = o; }
            continue; } r -= I_Q;
        if (r < I_LRU) {
            const int mat = r >> 3, sub = r & 7, g = mat >> 3, n = mat & 7, kb = sub >> 2, nb = sub & 3;
            const int np = n < 6 ? n : 6, half = n - np;
            const float* W = (g ? p.lwx : p.lwa) + (size_t)n * 128 * 128;
            bf16* dst = LruB + (size_t)n * 256 * 256;
            p0_transpose_item(W, 128, kb * 64, nb * 32, 32, dst, 256, g * 128 + nb * 32, half * 128, scr, lane);
            p0_transpose_item(W, 128, kb * 64, 0, 0, dst, 256, g * 128 + nb * 32, (1 - half) * 128, scr, lane);
            continue; } r -= I_LRU;
        if (r < I_SUB) {
            const int h = r >> 8, pp = (r >> 7) & 1, n = r & 127;
            const float* src = p.subk + (size_t)r * 128; bf16* dst = SubK + ((size_t)h * 256 + pp * 128 + n) * 256;
            const f32x2 v = *(const f32x2*)(src + 2 * lane);
            *(unsigned*)(dst + pp * 128 + 2 * lane) = pk2(v.x, v.y);
            *(unsigned*)(dst + (1 - pp) * 128 + 2 * lane) = 0u;
            continue; } r -= I_SUB;
        {
            const int tb = r >> 14, row = r & 16383;
            const float* src = (tb ? p.pv : p.pu) + (size_t)row * 1024 + lane * 16;
            f32x4 v[4]; float am = 0.f;
#pragma unroll
            for (int j = 0; j < 4; ++j) { v[j] = *(const f32x4*)(src + 4 * j); am = fmaxf(am, fmaxf(fmaxf(fabsf(v[j].x), fabsf(v[j].y)), fmaxf(fabsf(v[j].z), fabsf(v[j].w)))); }
#pragma unroll
            for (int o = 1; o < 64; o <<= 1) am = fmaxf(am, __shfl_xor(am, o));
            const float inv = am > 0.f ? 7.5f / am : 0.f;
            unsigned long long lo = 0ull; unsigned hi = 0u;
#pragma unroll
            for (int j = 0; j < 16; ++j) { const float x = v[j >> 2][j & 3] * inv, a = fabsf(x);
                unsigned code = a < 1.f ? (unsigned)__builtin_rintf(a * 8.f) : (a < 2.f ? 8u + (unsigned)__builtin_rintf((a - 1.f) * 8.f) : (a < 4.f ? 16u + (unsigned)__builtin_rintf((a - 2.f) * 4.f) : 24u + (unsigned)__builtin_rintf((a - 4.f) * 2.f)));
                code = code > 31u ? 31u : code; code |= (x < 0.f) ? 32u : 0u;
                const int bit = 6 * j;
                if (bit + 6 <= 64) lo |= (unsigned long long)code << bit;
                else if (bit >= 64) hi |= code << (bit - 64);
                else { lo |= (unsigned long long)code << bit; hi |= code >> (64 - bit); } }
            unsigned* dst = (unsigned*)(ws + (tb ? WS_V : WS_U) + (size_t)row * 768 + lane * 12);
            dst[0] = (unsigned)lo; dst[1] = (unsigned)(lo >> 32); dst[2] = hi;
            if (lane == 0) ((float*)(ws + (tb ? WS_SV : WS_SU)))[row] = am * (1.f / 7.5f);
        }
    }
}

__device__ __forceinline__ float mod_at(const float* modp, int b, int n) {
    float s = 0.f;
#pragma unroll
    for (int kc = 0; kc < 8; ++kc) s += modp[(size_t)(kc * 8 + b) * 6144 + n];
    return s;
}

__device__ __forceinline__ void phase1(const Params& p, LAS unsigned char* lds, int G) {
    const int tid = threadIdx.x, lane = tid & 63, wave = __builtin_amdgcn_readfirstlane(tid >> 6);
    const float* modp = (const float*)(p.ws + WS_MODP);
    LAS float* gs = (LAS float*)lds; LAS float* sh = gs + 1024;
    bf16* H = (bf16*)p.out;
    for (int tile = blockIdx.x; tile < T / 256; tile += G) {
        const int b = tile / 32;
        __syncthreads();
        for (int k = tid; k < 1024; k += NTHR) { gs[k] = p.npm[k] * (1.f + mod_at(modp, b, 1024 + k)); sh[k] = mod_at(modp, b, k); }
        __syncthreads();
        for (int rr = 0; rr < 32; ++rr) {
            const size_t row = (size_t)tile * 256 + wave * 32 + rr;
            const f32x4* xr = (const f32x4*)(p.x + row * 1024) + lane;
            f32x4 v[4]; float s = 0.f;
#pragma unroll
            for (int j = 0; j < 4; ++j) { v[j] = xr[64 * j]; s += (v[j].x * v[j].x + v[j].y * v[j].y) + (v[j].z * v[j].z + v[j].w * v[j].w); }
            const float rstd = __builtin_amdgcn_rsqf(wave_sum(s) * (1.f / 1024.f) + 1e-6f);
            u32x2* o8 = (u32x2*)(H + row * 1024) + lane;
#pragma unroll
            for (int j = 0; j < 4; ++j) { const int k = 256 * j + 4 * lane; const f32x4 g4 = *(const LAS f32x4*)(gs + k), s4 = *(const LAS f32x4*)(sh + k);
                u32x2 w; w.x = pk2(v[j].x * rstd * g4.x + s4.x, v[j].y * rstd * g4.y + s4.y); w.y = pk2(v[j].z * rstd * g4.z + s4.z, v[j].w * rstd * g4.w + s4.w);
                o8[64 * j] = w; }
        }
    }
}

typedef short bf16x8_t __attribute__((ext_vector_type(8)));
template <bool FINAL>
__device__ __forceinline__ void phase_lru(const Params& p, LAS unsigned char* lds, int G) {
    const int tid = threadIdx.x, lane = tid & 63, wave = __builtin_amdgcn_readfirstlane(tid >> 6), q4 = lane >> 4, c16 = lane & 15;
    constexpr int PQ = 136;
    LAS bf16* XC = (LAS bf16*)lds;
    LAS bf16* HB = XC + 64 * PQ;
    LAS float* CW = (LAS float*)(HB + 64 * PQ);
    const bf16* XL = (const bf16*)(p.ws + WS_XLXG); const bf16* LruB = (const bf16*)(p.ws + WS_LRUB);
    const bf16* XG = (const bf16*)(p.ws + WS_XLXG) + 1024; const bf16* GB = (const bf16*)(p.ws + WS_GAGB) + 1024; bf16* GA = (bf16*)(p.ws + WS_GAGB);
    const bf16* O = (const bf16*)(p.ws + WS_QKV) + 1024; const bf16* R = (const bf16*)(p.ws + WS_R); const float* SS = (const float*)(p.ws + WS_SS);
    f32x2* CAR = (f32x2*)(p.ws + WS_LRUC);
    const int c8 = tid & 15, tr = tid >> 4;
    for (int it = blockIdx.x; it < 8 * 8 * 4; it += G) {
        const int sg = it & 3, n = (it >> 2) & 7, b = it >> 5;
        const int chc = n * 128 + c8 * 8;
        const int chm = n * 128 + wave * 16 + c16;
        __syncthreads();
        for (int i = tid; i < 768; i += NTHR) { const int q = i >> 7, c = i & 127; CW[i] = q < 4 ? p.conv_w[q * 1024 + n * 128 + c] : (q == 4 ? p.conv_b[n * 128 + c] : p.gla_norm[n * 128 + c]); }
        const float ba = p.lba[chm], bx = p.lbx[chm], sp = -8.f * softplus_f(-p.lam[chm]);
        bf16x8_t wf[2][4];
        { const int np = n < 6 ? n : 6, half = n - np;
#pragma unroll
          for (int g = 0; g < 2; ++g)
#pragma unroll
              for (int ks = 0; ks < 4; ++ks) wf[g][ks] = *(const bf16x8_t*)(LruB + (size_t)n * 65536 + (size_t)(g * 128 + wave * 16 + c16) * 256 + half * 128 + ks * 32 + q4 * 8); }
        float hc = 0.f, aseg = 1.f;
        if (FINAL) { for (int s = 0; s < sg; ++s) { const f32x2 c = CAR[(size_t)((b * 8 + n) * 4 + s) * 128 + wave * 16 + c16]; hc = c.x * hc + c.y; } }
        const size_t tseg = (size_t)b * SEQ + sg * 2048;
        u32x4 xr[5];
#define LRU_LOADX(t0_) do { _Pragma("unroll") for (int _k = 0; _k < 5; ++_k) { const long _t = (long)(t0_) + 2 * tr + _k - 3; \
            xr[_k] = (_t < (long)b * SEQ) ? (u32x4){0u, 0u, 0u, 0u} : *(const u32x4*)(XL + (size_t)_t * 2048 + chc); } } while (0)
        LRU_LOADX(tseg);
        __syncthreads();
#pragma unroll 1
        for (int tl = 0; tl < 32; ++tl) {
            const size_t t0 = tseg + tl * 64;
            { float xv[5][8];
#pragma unroll
              for (int k = 0; k < 5; ++k) { xv[k][0] = bflo(xr[k].x); xv[k][1] = bfhi(xr[k].x); xv[k][2] = bflo(xr[k].y); xv[k][3] = bfhi(xr[k].y); xv[k][4] = bflo(xr[k].z); xv[k][5] = bfhi(xr[k].z); xv[k][6] = bflo(xr[k].w); xv[k][7] = bfhi(xr[k].w); }
              float cw[5][8];
#pragma unroll
              for (int q = 0; q < 5; ++q) { const f32x4 w0 = *(const LAS f32x4*)(CW + q * 128 + c8 * 8), w1 = *(const LAS f32x4*)(CW + q * 128 + c8 * 8 + 4);
                  cw[q][0] = w0.x; cw[q][1] = w0.y; cw[q][2] = w0.z; cw[q][3] = w0.w; cw[q][4] = w1.x; cw[q][5] = w1.y; cw[q][6] = w1.z; cw[q][7] = w1.w; }
#pragma unroll
              for (int i2 = 0; i2 < 2; ++i2) { float o[8];
#pragma unroll
                  for (int j = 0; j < 8; ++j) o[j] = cw[4][j] + cw[0][j] * xv[i2][j] + cw[1][j] * xv[i2 + 1][j] + cw[2][j] * xv[i2 + 2][j] + cw[3][j] * xv[i2 + 3][j];
                  *(LAS u32x4*)(XC + (2 * tr + i2) * PQ + c8 * 8) = (u32x4){pk2(o[0], o[1]), pk2(o[2], o[3]), pk2(o[4], o[5]), pk2(o[6], o[7])}; } }
            u32x4 mxg[2], mgb[2], mo[2], mr[2], mga[2]; float mss[2];
            if (FINAL) {
#pragma unroll
                for (int i2 = 0; i2 < 2; ++i2) { const size_t t = t0 + 2 * tr + i2;
                    mxg[i2] = *(const u32x4*)(XG + t * 2048 + chc); mgb[i2] = *(const u32x4*)(GB + t * 2048 + chc); mo[i2] = *(const u32x4*)(O + t * 2048 + chc);
                    mr[i2] = *(const u32x4*)(R + t * 1024 + chc); mga[i2] = *(const u32x4*)(GA + t * 2048 + chc); mss[i2] = SS[t * 4 + (chc >> 8)]; } }
            if (tl + 1 < 32) LRU_LOADX(t0 + 64);
            __syncthreads();
            pg8::f32x4 acc[4][2];
#pragma unroll
            for (int tt = 0; tt < 4; ++tt) { acc[tt][0] = (pg8::f32x4){0.f, 0.f, 0.f, 0.f}; acc[tt][1] = (pg8::f32x4){0.f, 0.f, 0.f, 0.f}; }
#pragma unroll
            for (int ks = 0; ks < 4; ++ks)
#pragma unroll
                for (int tt = 0; tt < 4; ++tt) { const bf16x8_t a = *(const LAS bf16x8_t*)(XC + (tt * 16 + c16) * PQ + ks * 32 + q4 * 8);
                    acc[tt][0] = __builtin_amdgcn_mfma_f32_16x16x32_bf16(a, wf[0][ks], acc[tt][0], 0, 0, 0);
                    acc[tt][1] = __builtin_amdgcn_mfma_f32_16x16x32_bf16(a, wf[1][ks], acc[tt][1], 0, 0, 0); }
#pragma unroll
            for (int tt = 0; tt < 4; ++tt) {
                float av[4], uv[4];
#pragma unroll
                for (int j = 0; j < 4; ++j) { const float xc = bf2f(XC[(tt * 16 + q4 * 4 + j) * PQ + wave * 16 + c16]);
                    const float gr = sigmoid_f(acc[tt][0][j] + ba), gi = sigmoid_f(acc[tt][1][j] + bx);
                    const float a = __expf(sp * gr); av[j] = a; uv[j] = __builtin_amdgcn_sqrtf(fmaxf(1.f - a * a, 0.f)) * gi * xc; }
                float A4 = av[0], H4 = uv[0];
#pragma unroll
                for (int j = 1; j < 4; ++j) { H4 = av[j] * H4 + uv[j]; A4 *= av[j]; }
                float Ai = A4, Hi = H4;
                { const float Ap = __shfl_up(Ai, 16), Hp = __shfl_up(Hi, 16); if (q4 >= 1) { Hi = Hp * Ai + Hi; Ai = Ap * Ai; } }
                { const float Ap = __shfl_up(Ai, 32), Hp = __shfl_up(Hi, 32); if (q4 >= 2) { Hi = Hp * Ai + Hi; Ai = Ap * Ai; } }
                float Ae = __shfl_up(Ai, 16), He = __shfl_up(Hi, 16); if (q4 == 0) { Ae = 1.f; He = 0.f; }
                float h = hc * Ae + He;
                const float At = __shfl(Ai, 48 + c16), Ht = __shfl(Hi, 48 + c16);
                if (FINAL) {
#pragma unroll
                    for (int j = 0; j < 4; ++j) { h = av[j] * h + uv[j]; HB[(tt * 16 + q4 * 4 + j) * PQ + wave * 16 + c16] = (bf16)f2bf(h); } }
                hc = hc * At + Ht; aseg *= At;
            }
            __syncthreads();
            if (FINAL) {
#pragma unroll
                for (int i2 = 0; i2 < 2; ++i2) { const size_t t = t0 + 2 * tr + i2;
                    const u32x4 hw = *(const LAS u32x4*)(HB + (2 * tr + i2) * PQ + c8 * 8);
                    const float rstd = __builtin_amdgcn_rsqf(mss[i2] * (1.f / 256.f) + 1e-6f);
                    const unsigned hwv[4] = {hw.x, hw.y, hw.z, hw.w}, xgv[4] = {mxg[i2].x, mxg[i2].y, mxg[i2].z, mxg[i2].w}, gbv[4] = {mgb[i2].x, mgb[i2].y, mgb[i2].z, mgb[i2].w};
                    const unsigned ov[4] = {mo[i2].x, mo[i2].y, mo[i2].z, mo[i2].w}, rv[4] = {mr[i2].x, mr[i2].y, mr[i2].z, mr[i2].w}, gav[4] = {mga[i2].x, mga[i2].y, mga[i2].z, mga[i2].w};
                    unsigned ow[4];
                    const f32x4 g0 = *(const LAS f32x4*)(CW + 640 + c8 * 8), g1 = *(const LAS f32x4*)(CW + 640 + c8 * 8 + 4);
                    const float gn[8] = {g0.x, g0.y, g0.z, g0.w, g1.x, g1.y, g1.z, g1.w};
#pragma unroll
                    for (int q = 0; q < 4; ++q) {
                        const float m0 = merge2(bflo(gav[q]), bflo(ov[q]) * rstd * gn[2 * q], bflo(rv[q]), bflo(gbv[q]), bflo(hwv[q]), bflo(xgv[q]));
                        const float m1 = merge2(bfhi(gav[q]), bfhi(ov[q]) * rstd * gn[2 * q + 1], bfhi(rv[q]), bfhi(gbv[q]), bfhi(hwv[q]), bfhi(xgv[q]));
                        ow[q] = pk2(m0, m1); }
                    *(u32x4*)(GA + t * 2048 + chc) = (u32x4){ow[0], ow[1], ow[2], ow[3]}; }
            }
        }
#undef LRU_LOADX
        if (!FINAL) { if (q4 == 0) CAR[(size_t)((b * 8 + n) * 4 + sg) * 128 + wave * 16 + c16] = (f32x2){aseg, hc}; }
        __syncthreads();
    }
}

__device__ __forceinline__ void phase_gla_prep(const Params& p, LAS unsigned char* lds, int G) {
    const int tid = threadIdx.x;
    LAS float* segt = (LAS float*)lds;
    bf16* QKV = (bf16*)(p.ws + WS_QKV); const bf16* AL = (const bf16*)(p.ws + WS_ALOW); float* DK = (float*)(p.ws + WS_DK);
    const int kp = tid & 127, seg = tid >> 7;
    for (int it = blockIdx.x; it < 8 * 128 * 4; it += G) {
        const int h = it & 3, ch = (it >> 2) & 127, b = it >> 9;
        float wa[16];
#pragma unroll
        for (int r = 0; r < 16; ++r) wa[r] = p.w_alpha[r * 512 + h * 128 + kp];
        const float balpha = p.b_alpha[h * 128 + kp];
        const size_t t0 = (size_t)b * SEQ + ch * 64 + seg * 16;
        float qv[16], kv[16];
#pragma unroll
        for (int i = 0; i < 16; ++i) { qv[i] = bf2f(QKV[(t0 + i) * 2048 + h * 128 + kp]); kv[i] = bf2f(QKV[(t0 + i) * 2048 + 512 + h * 128 + kp]); }
        float cl[16]; float run = 0.f;
#pragma unroll
        for (int i = 0; i < 16; ++i) { const size_t t = t0 + i;
            const u32x4 a0 = *(const u32x4*)(AL + t * 16), a1 = *(const u32x4*)(AL + t * 16 + 8);
            float z = balpha;
            z += bflo(a0.x) * wa[0] + bfhi(a0.x) * wa[1] + bflo(a0.y) * wa[2] + bfhi(a0.y) * wa[3] + bflo(a0.z) * wa[4] + bfhi(a0.z) * wa[5] + bflo(a0.w) * wa[6] + bfhi(a0.w) * wa[7];
            z += bflo(a1.x) * wa[8] + bfhi(a1.x) * wa[9] + bflo(a1.y) * wa[10] + bfhi(a1.y) * wa[11] + bflo(a1.z) * wa[12] + bfhi(a1.z) * wa[13] + bflo(a1.w) * wa[14] + bfhi(a1.w) * wa[15];
            const float ls = fminf(z, 0.f) - __logf(1.f + __expf(-fabsf(z)));
            run += ls * (1.f / 16.f); cl[i] = run; }
        __syncthreads();
        segt[seg * 128 + kp] = run;
        __syncthreads();
        float off = 0.f, tot = 0.f;
#pragma unroll
        for (int s = 0; s < 4; ++s) { const float v = segt[s * 128 + kp]; tot += v; if (s < seg) off += v; }
        if (seg == 0) DK[(size_t)(b * 128 + ch) * 512 + h * 128 + kp] = __expf(tot);
#pragma unroll
        for (int i = 0; i < 16; ++i) { const float cum = cl[i] + off;
            QKV[(t0 + i) * 2048 + h * 128 + kp] = (bf16)f2bf(qv[i] * 0.08838834764831845f * __expf(cum));
            QKV[(t0 + i) * 2048 + 512 + h * 128 + kp] = (bf16)f2bf(kv[i] * __expf(-cum)); }
    }
}
__device__ __forceinline__ bf16x8_t lds_col8(const LAS bf16* base, int pitch) {
    unsigned w[4];
#pragma unroll
    for (int i = 0; i < 4; ++i) w[i] = (unsigned)base[(2 * i) * pitch] | ((unsigned)base[(2 * i + 1) * pitch] << 16);
    return __builtin_bit_cast(bf16x8_t, (u32x4){w[0], w[1], w[2], w[3]});
}
__device__ __forceinline__ void phase_gla_seq(const Params& p, LAS unsigned char* lds, int G) {
    const int tid = threadIdx.x, lane = tid & 63, wave = __builtin_amdgcn_readfirstlane(tid >> 6), q4 = lane >> 4, c16 = lane & 15;
    constexpr int PQ = 136, PS = 72, PV = 34;
    LAS bf16* Qs = (LAS bf16*)lds;
    LAS bf16* Kd = Qs + 64 * PQ;
    LAS bf16* Vt = Kd + 64 * PQ;
    LAS bf16* Pm = Vt + 64 * PV + 64;
    LAS bf16* ST = Pm + 64 * PS;
    LAS float* dk = (LAS float*)(ST + 32 * PQ);
    const bf16* QKV = (const bf16*)(p.ws + WS_QKV); bf16* VO = (bf16*)(p.ws + WS_QKV); const float* DK = (const float*)(p.ws + WS_DK); float* SS = (float*)(p.ws + WS_SS);
    const int r0 = tid >> 4, cc = (tid & 15) * 8;
    const int vr = (tid >> 2) & 63, vc = (tid & 3) * 8;
    for (int it = blockIdx.x; it < 8 * 4 * 8; it += G) {
        const int v8 = it & 7, h = (it >> 3) & 3, b = it >> 5;
        pg8::f32x4 sacc[2] = {(pg8::f32x4){0.f, 0.f, 0.f, 0.f}, (pg8::f32x4){0.f, 0.f, 0.f, 0.f}};
        __syncthreads();
        for (int i = tid; i < 32 * PQ / 2; i += NTHR) ((LAS unsigned*)ST)[i] = 0u;
        u32x4 rq[2], rk[2], rv; float rdk = 0.f;
#define GLA_LOAD(chn) do { const size_t _t0 = (size_t)b * SEQ + (size_t)(chn) * 64; \
            _Pragma("unroll") for (int _j = 0; _j < 2; ++_j) { rq[_j] = *(const u32x4*)(QKV + (_t0 + r0 + 32 * _j) * 2048 + h * 128 + cc); rk[_j] = *(const u32x4*)(QKV + (_t0 + r0 + 32 * _j) * 2048 + 512 + h * 128 + cc); } \
            rv = *(const u32x4*)(QKV + (_t0 + vr) * 2048 + 1024 + h * 256 + v8 * 32 + vc); \
            rdk = DK[(size_t)(b * 128 + (chn)) * 512 + h * 128 + (tid & 127)]; } while (0)
        GLA_LOAD(0);
#pragma unroll 1
        for (int ch = 0; ch < SEQ / 64; ++ch) {
            const size_t t0 = (size_t)b * SEQ + ch * 64;
#pragma unroll
            for (int j = 0; j < 2; ++j) { *(LAS u32x4*)(Qs + (r0 + 32 * j) * PQ + cc) = rq[j]; *(LAS u32x4*)(Kd + (r0 + 32 * j) * PQ + cc) = rk[j]; }
            if (tid < 256) { LAS unsigned* vd = (LAS unsigned*)(Vt + vr * PV + vc); vd[0] = rv.x; vd[1] = rv.y; vd[2] = rv.z; vd[3] = rv.w; }
            if (tid < 128) dk[tid] = rdk;
            if (ch + 1 < SEQ / 64) GLA_LOAD(ch + 1);
            __syncthreads();
            { const int tt = wave & 3;
#pragma unroll
              for (int i2 = 0; i2 < 2; ++i2) { const int ts = (wave >> 2) * 2 + i2;
                  pg8::f32x4 acc = (pg8::f32x4){0.f, 0.f, 0.f, 0.f};
                  if (ts <= tt) {
#pragma unroll
                      for (int ks = 0; ks < 4; ++ks) { const bf16x8_t a = *(const LAS bf16x8_t*)(Kd + (ts * 16 + c16) * PQ + ks * 32 + q4 * 8), bb = *(const LAS bf16x8_t*)(Qs + (tt * 16 + c16) * PQ + ks * 32 + q4 * 8);
                          acc = __builtin_amdgcn_mfma_f32_16x16x32_bf16(a, bb, acc, 0, 0, 0); }
                      const int tg = tt * 16 + c16, sgl = ts * 16 + q4 * 4;
#pragma unroll
                      for (int j = 0; j < 4; ++j) if (sgl + j > tg) acc[j] = 0.f;
                  }
                  *(LAS u32x2*)(Pm + (tt * 16 + c16) * PS + ts * 16 + q4 * 4) = (u32x2){pk2(acc[0], acc[1]), pk2(acc[2], acc[3])}; } }
            bf16x8_t vf[2][2], kf[2];
#pragma unroll
            for (int ks = 0; ks < 2; ++ks) { kf[ks] = lds_col8(Kd + (ks * 32 + q4 * 8) * PQ + wave * 16 + c16, PQ);
#pragma unroll
                for (int tv = 0; tv < 2; ++tv) vf[tv][ks] = lds_col8(Vt + (ks * 32 + q4 * 8) * PV + tv * 16 + c16, PV); }
            __syncthreads();
            { const int tt = wave & 3, tv = wave >> 2;
              pg8::f32x4 oacc = (pg8::f32x4){0.f, 0.f, 0.f, 0.f};
#pragma unroll
              for (int ks = 0; ks < 2; ++ks) { const bf16x8_t bb = *(const LAS bf16x8_t*)(Pm + (tt * 16 + c16) * PS + ks * 32 + q4 * 8);
                  oacc = __builtin_amdgcn_mfma_f32_16x16x32_bf16(tv ? vf[1][ks] : vf[0][ks], bb, oacc, 0, 0, 0); }
#pragma unroll
              for (int ks = 0; ks < 4; ++ks) { const bf16x8_t bb = *(const LAS bf16x8_t*)(Qs + (tt * 16 + c16) * PQ + ks * 32 + q4 * 8), a = *(const LAS bf16x8_t*)(ST + (tv * 16 + c16) * PQ + ks * 32 + q4 * 8);
                  oacc = __builtin_amdgcn_mfma_f32_16x16x32_bf16(a, bb, oacc, 0, 0, 0); }
              *(u32x2*)(VO + (t0 + tt * 16 + c16) * 2048 + 1024 + h * 256 + v8 * 32 + tv * 16 + q4 * 4) = (u32x2){pk2(oacc[0], oacc[1]), pk2(oacc[2], oacc[3])};
              float sq = (oacc[0] * oacc[0] + oacc[1] * oacc[1]) + (oacc[2] * oacc[2] + oacc[3] * oacc[3]);
              sq += __shfl_xor(sq, 16); sq += __shfl_xor(sq, 32);
              if (q4 == 0) atomicAdd(SS + (t0 + tt * 16 + c16) * 4 + h, sq); }
#pragma unroll
            for (int ks = 0; ks < 2; ++ks)
#pragma unroll
                for (int tv = 0; tv < 2; ++tv) sacc[tv] = __builtin_amdgcn_mfma_f32_16x16x32_bf16(kf[ks], vf[tv][ks], sacc[tv], 0, 0, 0);
            { const pg8::f32x4 d4 = *(const LAS pg8::f32x4*)(dk + wave * 16 + q4 * 4);
#pragma unroll
              for (int tv = 0; tv < 2; ++tv) sacc[tv] = sacc[tv] * d4; }
            __syncthreads();
#pragma unroll
            for (int tv = 0; tv < 2; ++tv) *(LAS u32x2*)(ST + (tv * 16 + c16) * PQ + wave * 16 + q4 * 4) = (u32x2){pk2(sacc[tv][0], sacc[tv][1]), pk2(sacc[tv][2], sacc[tv][3])};
        }
#undef GLA_LOAD
    }
}

__device__ __forceinline__ void phase_norm2(const Params& p, LAS unsigned char* lds, int G) {
    const int tid = threadIdx.x, lane = tid & 63, wave = __builtin_amdgcn_readfirstlane(tid >> 6);
    const float* modp = (const float*)(p.ws + WS_MODP);
    LAS float* g1 = (LAS float*)lds; LAS float* gs = g1 + 1024; LAS float* sh = gs + 1024;
    const bf16* Y = (const bf16*)(p.ws + WS_Y); bf16* H2 = (bf16*)(p.ws + WS_H2);
    for (int tile = blockIdx.x; tile < T / 256; tile += G) {
        const int b = tile / 32;
        __syncthreads();
        for (int k = tid; k < 1024; k += NTHR) { g1[k] = mod_at(modp, b, 2048 + k) * p.npo[k]; gs[k] = p.npf[k] * (1.f + mod_at(modp, b, 4096 + k)); sh[k] = mod_at(modp, b, 3072 + k); }
        __syncthreads();
        for (int rr = 0; rr < 32; ++rr) {
            const size_t row = (size_t)tile * 256 + wave * 32 + rr;
            const f32x4* xr = (const f32x4*)(p.x + row * 1024) + lane; const u32x2* yr = (const u32x2*)(Y + row * 1024) + lane;
            f32x4 xv[4], yv[4]; float s = 0.f;
#pragma unroll
            for (int j = 0; j < 4; ++j) { xv[j] = xr[64 * j]; const u32x2 yw = yr[64 * j]; yv[j] = (f32x4){bflo(yw.x), bfhi(yw.x), bflo(yw.y), bfhi(yw.y)};
                s += (yv[j].x * yv[j].x + yv[j].y * yv[j].y) + (yv[j].z * yv[j].z + yv[j].w * yv[j].w); }
            const float rstd = __builtin_amdgcn_rsqf(wave_sum(s) * (1.f / 1024.f) + 1e-6f);
            float s2 = 0.f;
            f32x4* orow = (f32x4*)(p.out + row * 1024) + lane;
#pragma unroll
            for (int j = 0; j < 4; ++j) { const int k = 256 * j + 4 * lane; const f32x4 g4 = *(const LAS f32x4*)(g1 + k);
                xv[j] = xv[j] + yv[j] * rstd * g4; orow[64 * j] = xv[j];
                s2 += (xv[j].x * xv[j].x + xv[j].y * xv[j].y) + (xv[j].z * xv[j].z + xv[j].w * xv[j].w); }
            const float rstd2 = __builtin_amdgcn_rsqf(wave_sum(s2) * (1.f / 1024.f) + 1e-6f);
            u32x2* o8 = (u32x2*)(H2 + row * 1024) + lane;
#pragma unroll
            for (int j = 0; j < 4; ++j) { const int k = 256 * j + 4 * lane; const f32x4 g4 = *(const LAS f32x4*)(gs + k), s4 = *(const LAS f32x4*)(sh + k);
                u32x2 w; w.x = pk2(xv[j].x * rstd2 * g4.x + s4.x, xv[j].y * rstd2 * g4.y + s4.y); w.y = pk2(xv[j].z * rstd2 * g4.z + s4.z, xv[j].w * rstd2 * g4.w + s4.w);
                o8[64 * j] = w; }
        }
    }
}

__device__ __forceinline__ unsigned h16_key(unsigned b) { return (b & 0x8000u) ? (~b & 0xffffu) : (b | 0x8000u); }
__device__ __forceinline__ float h16_key_val(unsigned s) { const unsigned b = (s & 0x8000u) ? (s & 0x7fffu) : (~s & 0xffffu); return (float)__builtin_bit_cast(_Float16, (unsigned short)b); }
template <bool ASC> __device__ __forceinline__ void sort16(unsigned (&k)[16]) {
#pragma unroll
    for (int size = 2; size <= 16; size <<= 1)
#pragma unroll
        for (int stride = size >> 1; stride > 0; stride >>= 1)
#pragma unroll
            for (int i = 0; i < 16; ++i) { const int j = i ^ stride; if (j > i) { const bool up = ((i & size) == 0) == ASC; const unsigned lo = min(k[i], k[j]), hi = max(k[i], k[j]); k[i] = up ? lo : hi; k[j] = up ? hi : lo; } }
}
__device__ __forceinline__ void merge16_desc(unsigned (&k)[16]) {
#pragma unroll
    for (int stride = 8; stride > 0; stride >>= 1)
#pragma unroll
        for (int i = 0; i < 16; ++i) { const int j = i ^ stride; if (j > i) { const unsigned lo = min(k[i], k[j]), hi = max(k[i], k[j]); k[i] = hi; k[j] = lo; } }
}
__device__ __forceinline__ void top16_merge(unsigned (&top)[16], unsigned (&grp)[16]) {
    sort16<true>(grp);
#pragma unroll
    for (int i = 0; i < 16; ++i) top[i] = max(top[i], grp[i]);
    merge16_desc(top);
}
__device__ __forceinline__ void keys16(unsigned (&k)[16], const u32x4 w0, const u32x4 w1, int n0) {
    const unsigned ww[8] = {w0.x, w0.y, w0.z, w0.w, w1.x, w1.y, w1.z, w1.w};
#pragma unroll
    for (int q = 0; q < 8; ++q) { k[2 * q] = (h16_key(ww[q] & 0xffffu) << 16) | (unsigned)(127 - (n0 + 2 * q)); k[2 * q + 1] = (h16_key(ww[q] >> 16) << 16) | (unsigned)(127 - (n0 + 2 * q + 1)); }
}
__device__ __forceinline__ void topk_item(const unsigned short* SC, const float* SU, const float* SV, int t, int h, volatile LAS unsigned* my, unsigned (&outw)[16], float (&outs)[16]) {
    const u32x4* src = (const u32x4*)(SC + (size_t)t * 2048 + h * 256);
    unsigned topA[16], topB[16];
    keys16(topA, src[0], src[1], 0); sort16<false>(topA);
#pragma unroll 1
    for (int g = 1; g < 8; ++g) { unsigned grp[16]; keys16(grp, src[2 * g], src[2 * g + 1], 16 * g); top16_merge(topA, grp); }
    keys16(topB, src[16], src[17], 0); sort16<false>(topB);
#pragma unroll 1
    for (int g = 1; g < 8; ++g) { unsigned grp[16]; keys16(grp, src[16 + 2 * g], src[17 + 2 * g], 16 * g); top16_merge(topB, grp); }
    float fa[16], fb[16];
#pragma unroll
    for (int j = 0; j < 16; ++j) { fa[j] = h16_key_val(topA[j] >> 16); fb[j] = h16_key_val(topB[j] >> 16); my[j] = 127u - (topA[j] & 127u); my[16 + j] = 127u - (topB[j] & 127u); }
    unsigned ct[16];
#pragma unroll
    for (int g = 0; g < 4; ++g) { unsigned grp[16];
#pragma unroll
        for (int s = 0; s < 16; ++s) grp[s] = 0u;
        { int slot = 0;
#pragma unroll
          for (int i = 0; i < 16; ++i)
#pragma unroll
              for (int j = 0; j < 16; ++j) if ((i + 1) * (j + 1) <= 16) { if ((slot >> 4) == g) {
                  const float s = fa[i] + fb[j]; unsigned u = __builtin_bit_cast(unsigned, s); u ^= (u >> 31) ? 0xffffffffu : 0x80000000u;
                  grp[slot & 15] = (u & 0xffffff00u) | (unsigned)(255 - (i * 16 + j)); } ++slot; } }
        if (g == 0) { sort16<false>(grp);
#pragma unroll
            for (int s = 0; s < 16; ++s) ct[s] = grp[s]; }
        else top16_merge(ct, grp); }
    float val[16], mx, sum = 0.f;
#pragma unroll
    for (int m = 0; m < 16; ++m) { unsigned u = ct[m] & 0xffffff00u; u ^= (u >> 31) ? 0x80000000u : 0xffffffffu; val[m] = __builtin_bit_cast(float, u); }
    mx = val[0];
#pragma unroll
    for (int m = 0; m < 16; ++m) { val[m] = __expf(val[m] - mx); sum += val[m]; }
    const float inv = 1.f / sum;
    LDS_WAIT();
#pragma unroll
    for (int m = 0; m < 16; ++m) { const unsigned pos = 255u - (ct[m] & 255u), i = pos >> 4, j = pos & 15u;
        const unsigned e = my[i] * 128u + my[16 + j];
        outw[m] = (e << 16) | f2bf(val[m] * inv * SV[e]); outs[m] = SU[e]; }
}

typedef unsigned u32x3 __attribute__((ext_vector_type(3)));
typedef unsigned u32x6 __attribute__((ext_vector_type(6)));
typedef float f32x32 __attribute__((ext_vector_type(32)));
__device__ __forceinline__ float rdlane(float v, int l) { return __builtin_bit_cast(float, __builtin_amdgcn_readlane(__builtin_bit_cast(int, v), l)); }
__device__ __forceinline__ f32x32 fp6x2(u32x3 a, u32x3 b) { const u32x6 s = {a.x, a.y, a.z, b.x, b.y, b.z}; return __builtin_amdgcn_cvt_scalef32_pk32_f32_fp6(s, 1.0f); }
__device__ __forceinline__ void phase_gather(const Params& p, LAS unsigned char* lds, int G) {
    const int tid = threadIdx.x, lane = tid & 63, wave = __builtin_amdgcn_readfirstlane(tid >> 6);
    const float* modp = (const float*)(p.ws + WS_MODP);
    LAS float* g2 = (LAS float*)lds;
    const bf16* H2 = (const bf16*)(p.ws + WS_H2);
    const unsigned short* SC = (const unsigned short*)(p.ws + WS_SC); const float* SU = (const float*)(p.ws + WS_SU); const float* SV = (const float*)(p.ws + WS_SV);
    volatile LAS unsigned* RT = (volatile LAS unsigned*)(lds + 4096 + wave * 16640); volatile LAS float* RS = (volatile LAS float*)(RT + 1024);
    volatile LAS unsigned* myscr = RT + 2048 + lane * 33;
    const unsigned char* U6 = p.ws + WS_U; const unsigned char* V6 = p.ws + WS_V;
    for (int tile = blockIdx.x; tile < T / 256; tile += G) {
        const int b = tile / 32;
        __syncthreads();
        for (int k = tid; k < 1024; k += NTHR) g2[k] = mod_at(modp, b, 5120 + k) * p.npof[k];
        __syncthreads();
#pragma unroll 1
        for (int rr = 0; rr < 32; ++rr) {
            const size_t row = (size_t)tile * 256 + wave * 32 + rr;
            if ((rr & 7) == 0) {
                unsigned ow[16]; float os[16];
                __builtin_amdgcn_wave_barrier();
                topk_item(SC, SU, SV, (int)(row + (lane >> 3)), lane & 7, myscr, ow, os);
#pragma unroll
                for (int m = 0; m < 16; ++m) { RT[(lane >> 3) * 128 + (lane & 7) * 16 + m] = ow[m]; RS[(lane >> 3) * 128 + (lane & 7) * 16 + m] = os[m]; }
                asm volatile("s_waitcnt lgkmcnt(0)" ::: "memory"); __builtin_amdgcn_wave_barrier();
            }
            const int tl = rr & 7;
            float xt[16];
            { const u32x4 a = *(const u32x4*)(H2 + row * 1024 + lane * 16), c = *(const u32x4*)(H2 + row * 1024 + lane * 16 + 8);
              xt[0] = bflo(a.x); xt[1] = bfhi(a.x); xt[2] = bflo(a.y); xt[3] = bfhi(a.y); xt[4] = bflo(a.z); xt[5] = bfhi(a.z); xt[6] = bflo(a.w); xt[7] = bfhi(a.w);
              xt[8] = bflo(c.x); xt[9] = bfhi(c.x); xt[10] = bflo(c.y); xt[11] = bfhi(c.y); xt[12] = bflo(c.z); xt[13] = bfhi(c.z); xt[14] = bflo(c.w); xt[15] = bfhi(c.w); }
            float acc[16];
#pragma unroll
            for (int j = 0; j < 16; ++j) acc[j] = 0.f;
#pragma unroll 1
            for (int hh = 0; hh < 16; ++hh) {
                unsigned ww[8];
#pragma unroll
                for (int m = 0; m < 8; ++m) ww[m] = RT[tl * 128 + hh * 8 + m];
                u32x6 up[4], vp[4];
#pragma unroll
                for (int m = 0; m < 8; ++m) { const size_t eo = (size_t)((unsigned)__builtin_amdgcn_readfirstlane((int)ww[m]) >> 16) * 768 + lane * 12;
                    const u32x3 a = *(const u32x3*)(U6 + eo), c = *(const u32x3*)(V6 + eo);
                    if (m & 1) { up[m >> 1][3] = a.x; up[m >> 1][4] = a.y; up[m >> 1][5] = a.z; vp[m >> 1][3] = c.x; vp[m >> 1][4] = c.y; vp[m >> 1][5] = c.z; }
                    else { up[m >> 1][0] = a.x; up[m >> 1][1] = a.y; up[m >> 1][2] = a.z; vp[m >> 1][0] = c.x; vp[m >> 1][1] = c.y; vp[m >> 1][2] = c.z; } }
                const unsigned wa = RT[tl * 128 + hh * 8 + (lane >> 3)]; const float su = RS[tl * 128 + hh * 8 + (lane >> 3)];
                float pd[8];
#pragma unroll
                for (int m = 0; m < 8; m += 2) { const f32x32 f = __builtin_amdgcn_cvt_scalef32_pk32_f32_fp6(up[m >> 1], 1.0f);
                    float s0 = 0.f, s1 = 0.f;
#pragma unroll
                    for (int j = 0; j < 16; ++j) { s0 += xt[j] * f[j]; s1 += xt[j] * f[16 + j]; }
                    pd[m] = s0; pd[m + 1] = s1; __builtin_amdgcn_sched_barrier(0); }
#pragma unroll
                for (int j = 0; j < 4; ++j) { const bool up_ = (lane & 32) != 0; const float keep = up_ ? pd[j + 4] : pd[j], send = up_ ? pd[j] : pd[j + 4]; pd[j] = keep + __shfl_xor(send, 32); }
#pragma unroll
                for (int j = 0; j < 2; ++j) { const bool up_ = (lane & 16) != 0; const float keep = up_ ? pd[j + 2] : pd[j], send = up_ ? pd[j] : pd[j + 2]; pd[j] = keep + __shfl_xor(send, 16); }
                { const bool up_ = (lane & 8) != 0; const float keep = up_ ? pd[1] : pd[0], send = up_ ? pd[0] : pd[1]; pd[0] = keep + __shfl_xor(send, 8); }
                float d = pd[0]; d += __shfl_xor(d, 4); d += __shfl_xor(d, 2); d += __shfl_xor(d, 1);
                const float coef = bflo(wa) * gelu_f(su * d);
#pragma unroll
                for (int m = 0; m < 8; m += 2) { const f32x32 f = __builtin_amdgcn_cvt_scalef32_pk32_f32_fp6(vp[m >> 1], 1.0f); const float c0 = rdlane(coef, 8 * m), c1 = rdlane(coef, 8 * m + 8);
#pragma unroll
                    for (int j = 0; j < 16; ++j) acc[j] += c0 * f[j] + c1 * f[16 + j];
                    __builtin_amdgcn_sched_barrier(0); }
            }
            float s = 0.f;
#pragma unroll
            for (int j = 0; j < 16; ++j) s += acc[j] * acc[j];
            const float rstd = __builtin_amdgcn_rsqf(wave_sum(s) * (1.f / 1024.f) + 1e-6f);
            float* orow = p.out + row * 1024 + lane * 16;
#pragma unroll
            for (int q = 0; q < 4; ++q) { f32x4 o = *(const f32x4*)(orow + 4 * q); const f32x4 ga = *(const LAS f32x4*)(g2 + lane * 16 + 4 * q);
                o.x += ga.x * acc[4 * q] * rstd; o.y += ga.y * acc[4 * q + 1] * rstd; o.z += ga.z * acc[4 * q + 2] * rstd; o.w += ga.w * acc[4 * q + 3] * rstd;
                *(f32x4*)(orow + 4 * q) = o; }
        }
    }
}

#define XB_TMO      128
#define XB_XCNT(j)  (256  + 64 * (j))
#define XB_XSUB(j)  (1280 + 64 * (j))
#define XB_XGEN(j)  (2304 + 64 * (j))
#define XB_TOP      3328
#define XB_TOPGEN   3392
#define XCD_BAR_WORDS 3456
#define XB_SPIN_CAP (1u << 18)

__device__ __forceinline__ unsigned xb_ld(unsigned* p)              { return __hip_atomic_load(p, __ATOMIC_RELAXED, __HIP_MEMORY_SCOPE_AGENT); }
__device__ __forceinline__ unsigned xb_add(unsigned* p, unsigned v) { return __hip_atomic_fetch_add(p, v, __ATOMIC_RELAXED, __HIP_MEMORY_SCOPE_AGENT); }
__device__ __forceinline__ unsigned xb_xcc_id() { return (unsigned)__builtin_amdgcn_s_getreg((3 << 11) | 20) & 0xFu; }
#define XB_SPIN(cond, bar) do { unsigned _sp = 0; while (cond) { __builtin_amdgcn_s_sleep(1); \
    if ((++_sp & 255u) == 0u) { if (xb_ld(&(bar)[XB_TMO])) break; if (_sp > XB_SPIN_CAP) { atomicAdd(&(bar)[XB_TMO], 1u); break; } } } } while (0)

struct XcdBarrier {
    unsigned* bar; unsigned x;
    volatile LAS unsigned* st;
};

__device__ __forceinline__ XcdBarrier xcd_barrier_post(unsigned* bar, volatile LAS unsigned* st) {
    XcdBarrier b; b.bar = bar; b.x = xb_xcc_id(); b.st = st;
    if (threadIdx.x == 0) (void)xb_add(&bar[XB_XCNT(b.x)], 1u);
    return b;
}
__device__ __forceinline__ void xcd_barrier_complete(unsigned* bar, unsigned x, unsigned& nloc, unsigned& nx) {
    const unsigned G = gridDim.x * gridDim.y * gridDim.z;
    unsigned sum, cnt, mine, sp = 0u;
    for (;;) {
        sum = 0u; cnt = 0u; mine = 0u;
#pragma unroll
        for (unsigned j = 0; j < 16; ++j) { const unsigned c = xb_ld(&bar[XB_XCNT(j)]); sum += c; cnt += (c > 0u) ? 1u : 0u; mine = (j == x) ? c : mine; }
        if (sum == G) break;
        __builtin_amdgcn_s_sleep(1);
        if ((++sp & 255u) == 0u) { if (xb_ld(&bar[XB_TMO])) break; if (sp > XB_SPIN_CAP) { atomicAdd(&bar[XB_TMO], 1u); break; } }
    }
    nloc = mine > 0u ? mine : 1u; nx = cnt > 0u ? cnt : 1u;
}

__device__ __forceinline__ void xcd_barrier(const XcdBarrier& b) {
    asm volatile("s_waitcnt vmcnt(0)" ::: "memory");
    __syncthreads();
    if (threadIdx.x == 0) {
        unsigned* bar = b.bar;
        __builtin_amdgcn_s_waitcnt(0);
        unsigned nloc = b.st[0], nx = b.st[1];
        if (nloc == 0u) { xcd_barrier_complete(bar, b.x, nloc, nx); b.st[0] = nloc; b.st[1] = nx; }
        const unsigned old = xb_add(&bar[XB_XSUB(b.x)], 1u);
        const unsigned gen = old / nloc;
        if (old + 1u == (gen + 1u) * nloc) {
            __builtin_amdgcn_fence(__ATOMIC_RELEASE, "agent");
            asm volatile("s_waitcnt vmcnt(0)" ::: "memory");
            const unsigned og = xb_add(&bar[XB_TOP], 1u);
            const unsigned tg = og / nx;
            if (og + 1u == (tg + 1u) * nx) xb_add(&bar[XB_TOPGEN], 1u);
            else XB_SPIN(xb_ld(&bar[XB_TOPGEN]) == tg, bar);
            __builtin_amdgcn_fence(__ATOMIC_ACQUIRE, "agent");
            xb_add(&bar[XB_XGEN(b.x)], 1u);
            asm volatile("s_waitcnt vmcnt(0)" ::: "memory");
        } else {
            XB_SPIN(xb_ld(&bar[XB_XGEN(b.x)]) == gen, bar);
            __builtin_amdgcn_fence(__ATOMIC_ACQUIRE, "agent");
            asm volatile("s_waitcnt vmcnt(0)" ::: "memory");
        }
    }
    __syncthreads();
}


template <int PH>
__device__ __forceinline__ void run_phase(const Params& p, LAS unsigned char* lds, int G) {
    unsigned char* ws = p.ws;
    if constexpr (PH == 0) phase0(p, lds, G);
    else if constexpr (PH == 1) {
        { pg8::Gemm g{(const bf16*)(ws + WS_WQB), (const bf16*)(ws + WS_SUBK), 1024, 2048, 256, 2048}; pg8::StaticOrder S; S.init(1024, 2048, G, (int)blockIdx.x);
          EpiTrans E{(bf16*)(ws + WS_WQ), 1024}; pg8::gemm_phase<EpiTrans, pg8::StaticOrder, true, true, 2, 256, 2048>(lds, g, S, E); }
        __syncthreads();
        phase1(p, lds, G); }
    else if constexpr (PH == 2) { pg8::Gemm g{(const bf16*)p.out, (const bf16*)(ws + WS_WIN), T, NPAD, 1024, 1024}; pg8::StaticOrder S; S.init(T, NPAD, G, (int)blockIdx.x);
        EpiSeg E{ws}; pg8::gemm_phase<EpiSeg, pg8::StaticOrder, true, true, 0, 1024, 1024>(lds, g, S, E); }
    else if constexpr (PH == 3) { phase_gla_prep(p, lds, G); __syncthreads(); phase_lru<false>(p, lds, G); }
    else if constexpr (PH == 4) phase_gla_seq(p, lds, G);
    else if constexpr (PH == 5) phase_lru<true>(p, lds, G);
    else if constexpr (PH == 6) { pg8::Gemm g{(const bf16*)(ws + WS_GAGB), (const bf16*)(ws + WS_WOUT), T, 1024, 1024, 2048}; pg8::StaticOrder S; S.init(T, 1024, G, (int)blockIdx.x);
        EpiPlain E{(bf16*)(ws + WS_Y), 1024}; pg8::gemm_phase<EpiPlain, pg8::StaticOrder, true, true, 0, 1024, 2048>(lds, g, S, E); }
    else if constexpr (PH == 7) phase_norm2(p, lds, G);
    else if constexpr (PH == 8) {
        pg8::Gemm g{(const bf16*)(ws + WS_H2), (const bf16*)(ws + WS_WQ), T, 2048, 1024, 1024}; pg8::StaticOrder S; S.init(T, 2048, G, (int)blockIdx.x);
        EpiF16 E{(unsigned short*)(ws + WS_SC), 2048}; pg8::gemm_phase<EpiF16, pg8::StaticOrder, true, true, 0, 1024, 1024>(lds, g, S, E); }
    else if constexpr (PH == 9) phase_gather(p, lds, G);
}
template <int PH>
__global__ void __launch_bounds__(NTHR, 2) k_phase(Params p) {
    extern __shared__ __attribute__((aligned(16))) unsigned char lds_raw[];
    run_phase<PH>(p, (LAS unsigned char*)lds_raw, (int)gridDim.x);
}
constexpr int LDS_BAR_OFF = LDS_BYTES - 16;
template <int PH>
__device__ __forceinline__ void run_from(const Params& p, LAS unsigned char* lds, int G, const XcdBarrier& bar) {
#if PROBE_PH >= 0
    unsigned long long pt0 = 0; if constexpr (PH == PROBE_PH) pt0 = __builtin_amdgcn_s_memrealtime();
#endif
    run_phase<PH>(p, lds, G);
    if constexpr (PH + 1 < N_PHASES) {
        if constexpr (PH == 0) cg::this_grid().sync();
        else xcd_barrier(bar);
    }
#if PROBE_PH >= 0
    if constexpr (PH == PROBE_PH) { const unsigned long long pt1 = __builtin_amdgcn_s_memrealtime(), span = pt1 - pt0;
        while (__builtin_amdgcn_s_memrealtime() - pt1 < (unsigned long long)PROBE_MULT * span) __builtin_amdgcn_s_sleep(8); }
#endif
    if constexpr (PH + 1 < N_PHASES) run_from<PH + 1>(p, lds, G, bar);
}
__global__ void __launch_bounds__(NTHR, 2) k_mega(Params p) {
    extern __shared__ __attribute__((aligned(16))) unsigned char lds_raw[];
    LAS unsigned char* lds = (LAS unsigned char*)lds_raw;
    if (threadIdx.x < 4) ((LAS unsigned*)(lds + LDS_BAR_OFF))[threadIdx.x] = 0u;
    __syncthreads();
    const XcdBarrier bar = xcd_barrier_post((unsigned*)(p.ws + WS_CTL), (volatile LAS unsigned*)(lds + LDS_BAR_OFF));
    run_from<0>(p, lds, (int)gridDim.x, bar);
}

extern "C" void kernel_launch(void* const* d_in, const int* in_sizes, int n_in, void* d_out, int out_size, void* d_ws, size_t ws_size, hipStream_t stream) {
    static int grid = 0;
    if (grid == 0) {
        if (n_in != 24 || in_sizes[0] != T * DM || out_size != T * DM || ws_size < WS_END) {
            fprintf(stderr, "kernel_launch: unexpected shapes: n_in %d in0 %d out %d ws %zu\n", n_in, n_in > 0 ? in_sizes[0] : -1, out_size, ws_size); grid = -1; return; }
        int dev = 0, cus = 0, per_cu = 0;
        if (hipGetDevice(&dev) != hipSuccess || hipDeviceGetAttribute(&cus, hipDeviceAttributeMultiprocessorCount, dev) != hipSuccess) { grid = -1; return; }
        if (hipFuncSetAttribute((const void*)k_mega, hipFuncAttributeMaxDynamicSharedMemorySize, LDS_BYTES) != hipSuccess) { fprintf(stderr, "kernel_launch: hipFuncSetAttribute failed\n"); grid = -1; return; }
        if (hipOccupancyMaxActiveBlocksPerMultiprocessor(&per_cu, (const void*)k_mega, NTHR, LDS_BYTES) != hipSuccess || per_cu < 1) { fprintf(stderr, "kernel_launch: occupancy query says %d blocks per CU\n", per_cu); grid = -1; return; }
        (void)hipGetLastError();
        grid = cus;
    }
    if (grid < 0) return;
    Params p{};
    const float** pp = (const float**)&p;
    for (int i = 0; i < 24; ++i) pp[i] = (const float*)d_in[i];
    p.out = (float*)d_out; p.ws = (unsigned char*)d_ws;
    if (hipMemsetAsync((char*)d_ws + WS_CTL, 0, 65536, stream) != hipSuccess) { fprintf(stderr, "kernel_launch: hipMemsetAsync failed\n"); return; }
    void* args[] = {&p};
    hipError_t e = hipLaunchCooperativeKernel((const void*)k_mega, dim3(grid), dim3(NTHR), args, LDS_BYTES, stream);
    if (e != hipSuccess) fprintf(stderr, "kernel_launch: cooperative launch failed: %s (grid %d)\n", hipGetErrorString(e), grid);
}
```

```cpp
#include <hip/hip_runtime.h>
#include <hip/hip_cooperative_groups.h>
#include <cstdio>
#include <cstdint>
#include <utility>
namespace cg = cooperative_groups;

namespace pg8 {
#define PG8_LAS __attribute__((address_space(3)))
typedef unsigned short bf16_t;
typedef short bf16x8 __attribute__((ext_vector_type(8)));
typedef float f32x4 __attribute__((ext_vector_type(4)));
typedef unsigned u32x4 __attribute__((ext_vector_type(4)));
constexpr int BM = 256, BK = 64, HALF = 128, HTB = HALF * BK * 2  , STAGE_BYTES = 8 * HTB, NXCD = 8, WGM = 8;

__host__ __device__ __forceinline__ int lds_byte(int r, int c) { const int st = (r >> 4) * 2 + (c >> 5), rr = r & 15, cc = c & 31, ob = rr * 64 + cc * 2; return st * 1024 + (ob ^ (((ob >> 9) & 1) << 5)); }
__host__ __device__ __forceinline__ void stage_rc(int b, int& R, int& C) { const int st = b / 1024, sb = b % 1024, swz = sb ^ (((sb >> 9) & 1) << 5); R = (st >> 1) * 16 + swz / 64; C = (st & 1) * 32 + (swz % 64) / 2; }
__host__ __device__ __forceinline__ int perm32(int rho) { const int n = rho >> 4, i = rho & 15; return 8 * (i >> 2) + 4 * n + (i & 3); }

struct Unit { int pm, pn; };
struct Gemm { const bf16_t* A; const bf16_t* Bt; int M, N, K, lda; };
template <int AMODE> __device__ __forceinline__ size_t a_off_bytes(const Gemm& g, const Unit& u) {
    const int ac = AMODE == 0 ? 0 : (AMODE == 1 ? 128 * (u.pn < 6 ? u.pn : 6) : 256 * u.pn);
    return ((size_t)u.pm * BM * (size_t)g.lda + (size_t)ac) * 2;
}

struct StaticOrder {
    int nM, nN, nwg, G, c;
    __host__ __device__ void init(int M, int N, int G_, int c_) { nM = M / BM; nN = N / BM; nwg = nM * nN; G = G_; c = c_; }
    __host__ __device__ bool next(int i, Unit& u) const {
        const long L = (long)i * G + c; if (L >= nwg) return false;
        int wgid = (int)L; { const int q = nwg / NXCD, r = nwg % NXCD, xcd = wgid % NXCD, off = wgid / NXCD; wgid = (xcd < r ? xcd * (q + 1) : r * (q + 1) + (xcd - r) * q) + off; }
        const int nig = WGM * nN, gid = wgid / nig, fm = gid * WGM, gsz = (nM - fm) < WGM ? (nM - fm) : WGM;
        u.pm = fm + ((wgid % nig) % gsz); u.pn = (wgid % nig) / gsz; return true;
    }
    __device__ __forceinline__ void a_ready(const Unit&) const {}
    __device__ __forceinline__ void done(const Unit&) const {}
};

__device__ __forceinline__ unsigned cvt_pk_bf16(float lo, float hi) { unsigned r; asm volatile("v_cvt_pk_bf16_f32 %0, %1, %2" : "=v"(r) : "v"(lo), "v"(hi)); return r; }

template <class Epi, class Sched, bool ALIGN_EPI = false, bool SP2 = false, int AMODE = 0, int KC = 0, int LDAC = 0>
__device__ __forceinline__ void gemm_phase(PG8_LAS unsigned char* lds, const Gemm g, const Sched& S, const Epi& E) {
    const int tid = threadIdx.x, wid = __builtin_amdgcn_readfirstlane(tid >> 6), lane = tid & 63, wr = wid >> 2, wc = wid & 3, fr = lane & 15, fq = lane >> 4;
    const int K = KC ? KC : g.K, nt = K / BK; const int lda = LDAC ? LDAC : g.lda;
    unsigned voffA[2], voffB[2];
#pragma unroll
    for (int i = 0; i < 2; ++i) { int R, C; stage_rc(tid * 16 + i * 8192, R, C); const int Rb = Epi::PERM ? ((R & ~31) + perm32(R & 31)) : R;
        voffA[i] = (unsigned)(R * lda + C) * 2u; voffB[i] = (unsigned)(Rb * K + C) * 2u; }
    const size_t kstep = (size_t)(BK * 2);
    const size_t hstepA = (size_t)HALF * lda * 2;
    const size_t hstepB = (size_t)HALF * K * 2;
    const size_t tstepB = 2 * hstepB;
    const unsigned ldsw = (unsigned)wid * 1024u;
    const int aoff = lds_byte(wr * 64 + fr, fq * 8), boff = lds_byte(wc * 32 + fr, fq * 8);
#define PG8_SA(b, h) (((b) * 2 + (h)) * HTB)
#define PG8_SB(b, h) ((4 + (b) * 2 + (h)) * HTB)
#define PG8_STAGE(bufoff, gbase, voff) do { _Pragma("unroll") for (int _i = 0; _i < 2; ++_i) \
        __builtin_amdgcn_global_load_lds((const unsigned*)((const char*)(gbase) + (voff)[_i]), (PG8_LAS unsigned*)(lds + (bufoff) + ldsw + _i * 8192), 16, 0, 0); } while (0)
#define PG8_LDA(dst, b, h) do { _Pragma("unroll") for (int m = 0; m < 4; ++m) _Pragma("unroll") for (int k = 0; k < 2; ++k) dst[m][k] = *(const PG8_LAS bf16x8*)(lds + PG8_SA(b, h) + aoff + m * 2048 + k * 1024); } while (0)
#define PG8_LDB(dst, b, h) do { _Pragma("unroll") for (int n = 0; n < 2; ++n) _Pragma("unroll") for (int k = 0; k < 2; ++k) dst[n][k] = *(const PG8_LAS bf16x8*)(lds + PG8_SB(b, h) + boff + n * 2048 + k * 1024); } while (0)
#define PG8_MMA(ai, bj, At, Bt) do { __builtin_amdgcn_s_setprio(1); _Pragma("unroll") for (int m = 0; m < 4; ++m) _Pragma("unroll") for (int n = 0; n < 2; ++n) _Pragma("unroll") for (int k = 0; k < 2; ++k) \
        acc[ai][bj][m][n] = __builtin_amdgcn_mfma_f32_16x16x32_bf16(Bt[n][k], At[m][k], acc[ai][bj][m][n], 0, 0, 0); __builtin_amdgcn_s_setprio(0); } while (0)
#define PG8_WAIT_V(n) asm volatile("s_waitcnt vmcnt(" #n ")" ::: "memory")
#define PG8_WAIT_L(n) asm volatile("s_waitcnt lgkmcnt(" #n ")" ::: "memory")
#define PG8_BAR __builtin_amdgcn_s_barrier()
#define PG8_SCHED __builtin_amdgcn_sched_barrier(0)
    Unit cur, nxt; int ui = 0;
    if (!S.next(0, cur)) return;
    f32x4 acc[2][2][4][2];
#pragma unroll
    for (int a = 0; a < 2; ++a)
#pragma unroll
        for (int b = 0; b < 2; ++b)
#pragma unroll
            for (int m = 0; m < 4; ++m)
#pragma unroll
                for (int n = 0; n < 2; ++n) acc[a][b][m][n] = (f32x4){0.f, 0.f, 0.f, 0.f};
    bf16x8 At[4][2], B0[2][2], B1[2][2];
    const char* cA = (const char*)g.A + a_off_bytes<AMODE>(g, cur); const char* cB = (const char*)g.Bt + (size_t)cur.pn * tstepB;
    S.a_ready(cur);
    if constexpr (SP2) {
        PG8_STAGE(PG8_SB(0, 0), cB, voffB); PG8_STAGE(PG8_SB(0, 1), cB + hstepB, voffB); PG8_STAGE(PG8_SA(0, 0), cA, voffA); PG8_STAGE(PG8_SA(0, 1), cA + hstepA, voffA);
        if (wr == 1) PG8_BAR;
        PG8_WAIT_V(2); PG8_BAR;
        PG8_STAGE(PG8_SB(1, 0), cB + kstep, voffB); PG8_STAGE(PG8_SA(1, 0), cA + kstep, voffA); PG8_STAGE(PG8_SB(1, 1), cB + hstepB + kstep, voffB);
        PG8_WAIT_V(6); PG8_BAR;
    } else {
        PG8_STAGE(PG8_SB(0, 0), cB, voffB); PG8_STAGE(PG8_SA(0, 0), cA, voffA); PG8_STAGE(PG8_SB(0, 1), cB + hstepB, voffB); PG8_STAGE(PG8_SA(0, 1), cA + hstepA, voffA);
        if (wr == 1) PG8_BAR;
        PG8_WAIT_V(4); PG8_BAR;
        PG8_STAGE(PG8_SB(1, 0), cB + kstep, voffB); PG8_STAGE(PG8_SA(1, 0), cA + kstep, voffA); PG8_STAGE(PG8_SB(1, 1), cB + hstepB + kstep, voffB);
        PG8_WAIT_V(6); PG8_BAR;
    }
    for (;;) {
        const bool has_next = S.next(ui + 1, nxt);
        const char* nA = has_next ? (const char*)g.A + a_off_bytes<AMODE>(g, nxt) : cA; const char* nB = has_next ? (const char*)g.Bt + (size_t)nxt.pn * tstepB : cB;
#pragma unroll 1
        for (int t = 0; t < nt; t += 2) {
            const bool last = (t == nt - 2);
            const char* a1 = cA + (size_t)(t + 1) * kstep;
            const char* a2 = last ? nA : cA + (size_t)(t + 2) * kstep; const char* b2 = last ? nB : cB + (size_t)(t + 2) * kstep;
            const char* a3 = a2 + kstep; const char* b3 = b2 + kstep;
            if (last && has_next) S.a_ready(nxt);
            if constexpr (SP2) {
            PG8_LDB(B0, 0, 0); PG8_LDB(B1, 0, 1); PG8_SCHED; PG8_LDA(At, 0, 0); PG8_STAGE(PG8_SA(1, 1), a1 + hstepA, voffA);
            PG8_WAIT_V(8); PG8_WAIT_L(0); PG8_BAR; PG8_MMA(0, 0, At, B0); PG8_MMA(0, 1, At, B1); PG8_BAR; PG8_SCHED;
            PG8_LDA(At, 0, 1); PG8_STAGE(PG8_SB(0, 0), b2, voffB); PG8_STAGE(PG8_SB(0, 1), b2 + hstepB, voffB); PG8_STAGE(PG8_SA(0, 0), a2, voffA);
            PG8_WAIT_V(8); PG8_WAIT_L(0); PG8_BAR; PG8_MMA(1, 0, At, B0); PG8_MMA(1, 1, At, B1); PG8_BAR; PG8_SCHED;
            PG8_LDB(B0, 1, 0); PG8_LDB(B1, 1, 1); PG8_SCHED; PG8_LDA(At, 1, 0); PG8_STAGE(PG8_SA(0, 1), a2 + hstepA, voffA);
            PG8_WAIT_V(8); PG8_WAIT_L(0); PG8_BAR; PG8_MMA(0, 0, At, B0); PG8_MMA(0, 1, At, B1); PG8_BAR; PG8_SCHED;
            PG8_LDA(At, 1, 1); PG8_STAGE(PG8_SB(1, 0), b3, voffB); PG8_STAGE(PG8_SB(1, 1), b3 + hstepB, voffB); PG8_STAGE(PG8_SA(1, 0), a3, voffA);
            PG8_WAIT_V(8); PG8_WAIT_L(0); PG8_BAR; PG8_MMA(1, 0, At, B0); PG8_MMA(1, 1, At, B1); PG8_BAR; PG8_SCHED;
            } else {
            PG8_LDB(B0, 0, 0); PG8_SCHED; PG8_LDA(At, 0, 0); PG8_STAGE(PG8_SA(1, 1), a1 + hstepA, voffA);
            PG8_WAIT_L(8); PG8_BAR; PG8_WAIT_L(0); PG8_MMA(0, 0, At, B0); PG8_BAR; PG8_SCHED;
            PG8_LDB(B1, 0, 1); PG8_STAGE(PG8_SB(0, 0), b2, voffB);
            PG8_BAR; PG8_WAIT_L(0); PG8_MMA(0, 1, At, B1); PG8_BAR;
            PG8_LDA(At, 0, 1); PG8_STAGE(PG8_SA(0, 0), a2, voffA);
            PG8_BAR; PG8_WAIT_L(0); PG8_MMA(1, 0, At, B0); PG8_BAR; PG8_SCHED;
            PG8_STAGE(PG8_SB(0, 1), b2 + hstepB, voffB);
            PG8_WAIT_V(6); PG8_BAR; PG8_MMA(1, 1, At, B1); PG8_BAR;
            PG8_LDB(B0, 1, 0); PG8_SCHED; PG8_LDA(At, 1, 0); PG8_STAGE(PG8_SA(0, 1), a2 + hstepA, voffA);
            PG8_WAIT_L(8); PG8_BAR; PG8_WAIT_L(0); PG8_MMA(0, 0, At, B0); PG8_BAR; PG8_SCHED;
            PG8_LDB(B1, 1, 1); PG8_STAGE(PG8_SB(1, 0), b3, voffB);
            PG8_BAR; PG8_WAIT_L(0); PG8_MMA(0, 1, At, B1); PG8_BAR;
            PG8_LDA(At, 1, 1); PG8_STAGE(PG8_SA(1, 0), a3, voffA);
            PG8_BAR; PG8_WAIT_L(0); PG8_MMA(1, 0, At, B0); PG8_BAR; PG8_SCHED;
            PG8_STAGE(PG8_SB(1, 1), b3 + hstepB, voffB);
            PG8_WAIT_V(6); PG8_BAR; PG8_MMA(1, 1, At, B1); PG8_BAR;
            }
        }
        if constexpr (ALIGN_EPI) { if (wr == 0) PG8_BAR; }
        E(acc, cur, wr, wc, fr, fq); S.done(cur);
        if (!has_next) break;
#pragma unroll
        for (int a = 0; a < 2; ++a)
#pragma unroll
            for (int b = 0; b < 2; ++b)
#pragma unroll
                for (int m = 0; m < 4; ++m)
#pragma unroll
                    for (int n = 0; n < 2; ++n) acc[a][b][m][n] = (f32x4){0.f, 0.f, 0.f, 0.f};
        cur = nxt; cA = nA; cB = nB; ++ui;
        if constexpr (ALIGN_EPI) { if (wr == 1) PG8_BAR; }
    }
    PG8_WAIT_V(0);
    if constexpr (!ALIGN_EPI) { if (wr == 0) PG8_BAR; }
    PG8_BAR;
#undef PG8_SA
#undef PG8_SB
#undef PG8_STAGE
#undef PG8_LDA
#undef PG8_LDB
#undef PG8_MMA
#undef PG8_WAIT_V
#undef PG8_WAIT_L
#undef PG8_BAR
#undef PG8_SCHED
}
}

constexpr int NB = 8, SEQ = 8192, DM = 1024, T = NB * SEQ;
constexpr int NPAD = 7424;
constexpr int NWAVES = 8, NTHR = 512;
constexpr int LDS_BYTES = 147456;
constexpr int N_PHASES = 10;
#define PROBE_PH -1
#define PROBE_MULT 3

constexpr size_t MiB = 1ull << 20;
constexpr size_t WS_CTL = 0;
constexpr size_t WS_MODP = 1 * MiB;
constexpr size_t WS_WIN = 3 * MiB;
constexpr size_t WS_WOUT = 18 * MiB;
constexpr size_t WS_WQ = 20 * MiB;
constexpr size_t WS_WQB = 480 * MiB;
constexpr size_t WS_LRUB = 24 * MiB;
constexpr size_t WS_SUBK = 25 * MiB;
constexpr size_t WS_LRUC = 26 * MiB;
constexpr size_t WS_U = 32 * MiB;
constexpr size_t WS_V = 48 * MiB;
constexpr size_t WS_SU = 64 * MiB;
constexpr size_t WS_SV = 65 * MiB;
constexpr size_t WS_SS = 30 * MiB;
constexpr size_t WS_DK = 66 * MiB;
constexpr size_t WS_QKV = 96 * MiB;
constexpr size_t WS_R = 352 * MiB;
constexpr size_t WS_XLXG = 480 * MiB;
constexpr size_t WS_GAGB = 736 * MiB;
constexpr size_t WS_ALOW = 992 * MiB;
constexpr size_t WS_END = 994 * MiB;
constexpr size_t WS_Y = WS_QKV;
constexpr size_t WS_H2 = WS_QKV + 128 * MiB;
constexpr size_t WS_QRY = WS_XLXG;
constexpr size_t WS_SC = WS_GAGB;
constexpr size_t WS_TOPK = WS_R;
constexpr size_t WS_TOPK2 = WS_R + 32 * MiB;

#define LAS __attribute__((address_space(3)))
typedef unsigned short bf16;
typedef float f32x4 __attribute__((ext_vector_type(4)));
typedef float f32x2 __attribute__((ext_vector_type(2)));
typedef unsigned u32x4 __attribute__((ext_vector_type(4)));
typedef unsigned u32x2 __attribute__((ext_vector_type(2)));

struct Params {
    const float *x, *c, *w_ada, *b_ada, *npm, *npo, *w_in, *w_alpha, *b_alpha, *gla_norm, *conv_w, *conv_b,
        *lwa, *lba, *lwx, *lbx, *lam, *w_out, *npf, *npof, *wq, *subk, *pu, *pv;
    float* out; unsigned char* ws;
    int ph_lo, ph_hi;
};

__device__ __forceinline__ unsigned pk2(float lo, float hi) { unsigned r; asm("v_cvt_pk_bf16_f32 %0, %1, %2" : "=v"(r) : "v"(lo), "v"(hi)); return r; }
__device__ __forceinline__ unsigned f2bf(float f) { return pk2(f, f) & 0xffffu; }
__device__ __forceinline__ float bflo(unsigned u) { return __builtin_bit_cast(float, u << 16); }
__device__ __forceinline__ float bfhi(unsigned u) { return __builtin_bit_cast(float, u & 0xffff0000u); }
__device__ __forceinline__ float bf2f(bf16 h) { return __builtin_bit_cast(float, (unsigned)h << 16); }
__device__ __forceinline__ float sigmoid_f(float x) { return __builtin_amdgcn_rcpf(1.f + __expf(-x)); }
__device__ __forceinline__ float silu_f(float x) { return x * __builtin_amdgcn_rcpf(1.f + __expf(-x)); }
__device__ __forceinline__ float gelu_f(float x) { const float u = 0.7978845608028654f * (x + 0.044715f * x * x * x); return x * __builtin_amdgcn_rcpf(1.f + __expf(-2.f * u)); }
__device__ __forceinline__ float softplus_f(float x) { return fmaxf(x, 0.f) + log1pf(__expf(-fabsf(x))); }
__device__ __forceinline__ float wave_sum(float v) {
#pragma unroll
    for (int o = 1; o < 64; o <<= 1) v += __shfl_xor(v, o);
    return v;
}
__device__ __forceinline__ float merge2(float ga, float on, float r, float gb, float hl, float xg) {
    const float u = 0.7978845608028654f * (xg + 0.044715f * xg * xg * xg);
    const float d1 = (1.f + __expf(-ga)) * (1.f + __expf(-r)), d2 = (1.f + __expf(-gb)) * (1.f + __expf(-2.f * u));
    return on * r * __builtin_amdgcn_rcpf(d1) + hl * xg * __builtin_amdgcn_rcpf(d2);
}
#define LDS_WAIT() asm volatile("s_waitcnt lgkmcnt(0)" ::: "memory")

struct EpiSeg {
    static constexpr bool PERM = true;
    unsigned char* ws;
    __device__ __forceinline__ void operator()(const pg8::f32x4 (&acc)[2][2][4][2], const pg8::Unit& u, int wr, int wc, int fr, int fq) const {
        const int pn = u.pn; bf16* base; int ldc, colt;
        if (pn < 8) { base = (bf16*)(ws + WS_QKV); ldc = 2048; colt = pn * 256; }
        else if (pn < 12) { base = (bf16*)(ws + WS_R); ldc = 1024; colt = (pn - 8) * 256; }
        else if (pn < 20) { base = (bf16*)(ws + WS_XLXG); ldc = 2048; colt = (pn - 12) * 256; }
        else if (pn < 28) { base = (bf16*)(ws + WS_GAGB); ldc = 2048; colt = (pn - 20) * 256; }
        else { base = (bf16*)(ws + WS_ALOW); ldc = 16; colt = 0; }
        const int row0 = u.pm * 256 + wr * 64 + fr, col0 = colt + wc * 32 + 8 * fq;
        const bool tail = (pn == 28);
#pragma unroll
        for (int ai = 0; ai < 2; ++ai)
#pragma unroll
            for (int m = 0; m < 4; ++m) { bf16* rowp = base + (size_t)(row0 + ai * 128 + m * 16) * ldc + col0;
#pragma unroll
                for (int bj = 0; bj < 2; ++bj) { const pg8::f32x4 v0 = acc[ai][bj][m][0], v1 = acc[ai][bj][m][1];
                    u32x4 w; w.x = pg8::cvt_pk_bf16(v0[0], v0[1]); w.y = pg8::cvt_pk_bf16(v0[2], v0[3]); w.z = pg8::cvt_pk_bf16(v1[0], v1[1]); w.w = pg8::cvt_pk_bf16(v1[2], v1[3]);
                    if (!tail || (bj == 0 && wc == 0 && fq < 2)) *(u32x4*)(rowp + bj * 128) = w; } }
    }
};
struct EpiPlain {
    static constexpr bool PERM = true;
    bf16* O; int ldc;
    __device__ __forceinline__ void operator()(const pg8::f32x4 (&acc)[2][2][4][2], const pg8::Unit& u, int wr, int wc, int fr, int fq) const {
        const int row0 = u.pm * 256 + wr * 64 + fr, col0 = u.pn * 256 + wc * 32 + 8 * fq;
#pragma unroll
        for (int ai = 0; ai < 2; ++ai)
#pragma unroll
            for (int m = 0; m < 4; ++m) { bf16* rowp = O + (size_t)(row0 + ai * 128 + m * 16) * ldc + col0;
#pragma unroll
                for (int bj = 0; bj < 2; ++bj) { const pg8::f32x4 v0 = acc[ai][bj][m][0], v1 = acc[ai][bj][m][1];
                    u32x4 w; w.x = pg8::cvt_pk_bf16(v0[0], v0[1]); w.y = pg8::cvt_pk_bf16(v0[2], v0[3]); w.z = pg8::cvt_pk_bf16(v1[0], v1[1]); w.w = pg8::cvt_pk_bf16(v1[2], v1[3]);
                    *(u32x4*)(rowp + bj * 128) = w; } }
    }
};
typedef _Float16 h16x2 __attribute__((ext_vector_type(2)));
__device__ __forceinline__ unsigned pkh(float a, float b) { return __builtin_bit_cast(unsigned, __builtin_amdgcn_cvt_pkrtz(a, b)); }
struct EpiF16 {
    static constexpr bool PERM = true;
    unsigned short* O; int ldc;
    __device__ __forceinline__ void operator()(const pg8::f32x4 (&acc)[2][2][4][2], const pg8::Unit& u, int wr, int wc, int fr, int fq) const {
        const int row0 = u.pm * 256 + wr * 64 + fr, col0 = u.pn * 256 + wc * 32 + 8 * fq;
#pragma unroll
        for (int ai = 0; ai < 2; ++ai)
#pragma unroll
            for (int m = 0; m < 4; ++m) { unsigned short* rowp = O + (size_t)(row0 + ai * 128 + m * 16) * ldc + col0;
#pragma unroll
                for (int bj = 0; bj < 2; ++bj) { const pg8::f32x4 v0 = acc[ai][bj][m][0], v1 = acc[ai][bj][m][1];
                    u32x4 w; w.x = pkh(v0[0], v0[1]); w.y = pkh(v0[2], v0[3]); w.z = pkh(v1[0], v1[1]); w.w = pkh(v1[2], v1[3]);
                    *(u32x4*)(rowp + bj * 128) = w; } }
    }
};
struct EpiTrans {
    static constexpr bool PERM = true;
    bf16* O; int ldc;
    __device__ __forceinline__ void operator()(const pg8::f32x4 (&acc)[2][2][4][2], const pg8::Unit& u, int wr, int wc, int fr, int fq) const {
        const int row0 = u.pm * 256 + wr * 64 + fr, col0 = u.pn * 256 + wc * 32 + 8 * fq;
#pragma unroll
        for (int ai = 0; ai < 2; ++ai)
#pragma unroll
            for (int m = 0; m < 4; ++m) { const int row = row0 + ai * 128 + m * 16;
#pragma unroll
                for (int bj = 0; bj < 2; ++bj)
#pragma unroll
                    for (int n = 0; n < 2; ++n)
#pragma unroll
                        for (int e = 0; e < 4; ++e) O[(size_t)(col0 + bj * 128 + 4 * n + e) * ldc + row] = (bf16)f2bf(acc[ai][bj][m][n][e]); }
    }
};

__device__ __forceinline__ void p0_transpose_item(const float* W, int ldw, int k0, int n0, int nvalid, bf16* WT, int ldk, int row0, int kc0, LAS float* scr, int lane) {
#pragma unroll 8
    for (int i = 0; i < 32; ++i) { const int kk = 2 * i + (lane >> 5), cc = lane & 31; scr[kk * 33 + cc] = (cc < nvalid) ? W[(size_t)(k0 + kk) * ldw + n0 + cc] : 0.f; }
    LDS_WAIT(); asm volatile("" ::: "memory");
    const int c = lane & 7;
#pragma unroll
    for (int j = 0; j < 4; ++j) { const int n = (lane >> 3) + 8 * j; const LAS float* s = scr + (8 * c) * 33 + n;
        u32x4 o; o.x = pk2(s[0 * 33], s[1 * 33]); o.y = pk2(s[2 * 33], s[3 * 33]); o.z = pk2(s[4 * 33], s[5 * 33]); o.w = pk2(s[6 * 33], s[7 * 33]);
        *(u32x4*)(WT + (size_t)(row0 + n) * ldk + kc0 + k0 + 8 * c) = o; }
    LDS_WAIT(); asm volatile("" ::: "memory");
}
__device__ __forceinline__ void phase0(const Params& p, LAS unsigned char* lds, int G) {
    const int tid = threadIdx.x, lane = tid & 63, wave = __builtin_amdgcn_readfirstlane(tid >> 6);
    unsigned char* ws = p.ws;
    {
        LAS float* sc = (LAS float*)lds;
        LAS float* red = (LAS float*)(lds + 4096);
        float* modp = (float*)(ws + WS_MODP);
        for (int it = blockIdx.x; it < 24 * 8; it += G) {
            const int nb = it % 24, kc = it / 24;
            for (int i = tid; i < 1024; i += NTHR) { const int b = i >> 7, k = i & 127; sc[i] = silu_f(p.c[b * 1024 + kc * 128 + k]); }
            __syncthreads();
            const int col = tid & 255, kh = tid >> 8;
            float acc[8];
#pragma unroll
            for (int b = 0; b < 8; ++b) acc[b] = 0.f;
            const float* wp = p.w_ada + (size_t)(kc * 128 + kh * 64) * 6144 + nb * 256 + col;
#pragma unroll 8
            for (int kk = 0; kk < 64; ++kk) { const float w = wp[(size_t)kk * 6144];
#pragma unroll
                for (int b = 0; b < 8; ++b) acc[b] += sc[b * 128 + kh * 64 + kk] * w; }
            if (kh == 1) {
#pragma unroll
                for (int b = 0; b < 8; ++b) red[b * 256 + col] = acc[b]; }
            __syncthreads();
            if (kh == 0) { const int n = nb * 256 + col; const float bias = (kc == 0) ? p.b_ada[n] : 0.f;
#pragma unroll
                for (int b = 0; b < 8; ++b) modp[(size_t)(kc * 8 + b) * 6144 + n] = acc[b] + red[b * 256 + col] + bias; }
            __syncthreads();
        }
    }
    for (int i = blockIdx.x * NTHR + tid; i < T * 4 / 4; i += G * NTHR) ((f32x4*)(ws + WS_SS))[i] = (f32x4){0.f, 0.f, 0.f, 0.f};
    LAS float* scr = (LAS float*)(lds + 16384 + wave * 8448);
    const int gw = blockIdx.x * NWAVES + wave, NGW = G * NWAVES;
    bf16* WinT = (bf16*)(ws + WS_WIN); bf16* WoutT = (bf16*)(ws + WS_WOUT);
    bf16* LruB = (bf16*)(ws + WS_LRUB); bf16* SubK = (bf16*)(ws + WS_SUBK);
    constexpr int I_IN = 16 * (NPAD / 32), I_OUT = 16 * 32, I_Q = 2048, I_LRU = 16 * 8, I_SUB = 2048, I_TAB = 2 * 16384;
    constexpr int NIT = I_IN + I_OUT + I_Q + I_LRU + I_SUB + I_TAB;
    for (int it = gw; it < NIT; it += NGW) {
        int r = it;
        if (r < I_IN) { const int nb = r % (NPAD / 32), kb = r / (NPAD / 32), nq = nb * 32; int n0, nv;
            if (nq < 3072) { n0 = nq; nv = 32; } else if (nq < 7168) { n0 = nq + 16; nv = 32; } else if (nq == 7168) { n0 = 3072; nv = 16; } else { n0 = 0; nv = 0; }
            p0_transpose_item(p.w_in, 7184, kb * 64, n0, nv, WinT, 1024, nq, 0, scr, lane); continue; } r -= I_IN;
        if (r < I_OUT) { const int nb = r % 32, kb = r / 32; p0_transpose_item(p.w_out, 1024, kb * 64, nb * 32, 32, WoutT, 1024, nb * 32, 0, scr, lane); continue; } r -= I_OUT;
        if (r < I_Q) {
            const float* src = p.wq + (size_t)r * 1024; bf16* dst = (bf16*)(ws + WS_WQB) + (size_t)r * 1024;
#pragma unroll
            for (int j = 0; j < 2; ++j) { const f32x4 a = *(const f32x4*)(src + j * 512 + lane * 8), b = *(const f32x4*)(src + j * 512 + lane * 8 + 4);
                u32x4 o; o.x = pk2(a.x, a.y); o.y = pk2(a.z, a.w); o.z = pk2(b.x, b.y); o.w = pk2(b.z, b.w);
                *(u32x4*)(dst + j * 512 + lane * 8) = o; }
            continue; } r -= I_Q;
        if (r < I_LRU) {
            const int mat = r >> 3, sub = r & 7, g = mat >> 3, n = mat & 7, kb = sub >> 2, nb = sub & 3;
            const int np = n < 6 ? n : 6, half = n - np;
            const float* W = (g ? p.lwx : p.lwa) + (size_t)n * 128 * 128;
            bf16* dst = LruB + (size_t)n * 256 * 256;
            p0_transpose_item(W, 128, kb * 64, nb * 32, 32, dst, 256, g * 128 + nb * 32, half * 128, scr, lane);
            p0_transpose_item(W, 128, kb * 64, 0, 0, dst, 256, g * 128 + nb * 32, (1 - half) * 128, scr, lane);
            continue; } r -= I_LRU;
        if (r < I_SUB) {
            const int h = r >> 8, pp = (r >> 7) & 1, n = r & 127;
            const float* src = p.subk + (size_t)r * 128; bf16* dst = SubK + ((size_t)h * 256 + pp * 128 + n) * 256;
            const f32x2 v = *(const f32x2*)(src + 2 * lane);
            *(unsigned*)(dst + pp * 128 + 2 * lane) = pk2(v.x, v.y);
            *(unsigned*)(dst + (1 - pp) * 128 + 2 * lane) = 0u;
            continue; } r -= I_SUB;
        {
            const int tb = r >> 14, row = r & 16383;
            const float* src = (tb ? p.pv : p.pu) + (size_t)row * 1024 + lane * 16;
            f32x4 v[4]; float am = 0.f;
#pragma unroll
            for (int j = 0; j < 4; ++j) { v[j] = *(const f32x4*)(src + 4 * j); am = fmaxf(am, fmaxf(fmaxf(fabsf(v[j].x), fabsf(v[j].y)), fmaxf(fabsf(v[j].z), fabsf(v[j].w)))); }
#pragma unroll
            for (int o = 1; o < 64; o <<= 1) am = fmaxf(am, __shfl_xor(am, o));
            const float inv = am > 0.f ? 7.5f / am : 0.f;
            unsigned long long lo = 0ull; unsigned hi = 0u;
#pragma unroll
            for (int j = 0; j < 16; ++j) { const float x = v[j >> 2][j & 3] * inv, a = fabsf(x);
                unsigned code = a < 1.f ? (unsigned)__builtin_rintf(a * 8.f) : (a < 2.f ? 8u + (unsigned)__builtin_rintf((a - 1.f) * 8.f) : (a < 4.f ? 16u + (unsigned)__builtin_rintf((a - 2.f) * 4.f) : 24u + (unsigned)__builtin_rintf((a - 4.f) * 2.f)));
                code = code > 31u ? 31u : code; code |= (x < 0.f) ? 32u : 0u;
                const int bit = 6 * j;
                if (bit + 6 <= 64) lo |= (unsigned long long)code << bit;
                else if (bit >= 64) hi |= code << (bit - 64);
                else { lo |= (unsigned long long)code << bit; hi |= code >> (64 - bit); } }
            unsigned* dst = (unsigned*)(ws + (tb ? WS_V : WS_U) + (size_t)row * 768 + lane * 12);
            dst[0] = (unsigned)lo; dst[1] = (unsigned)(lo >> 32); dst[2] = hi;
            if (lane == 0) ((float*)(ws + (tb ? WS_SV : WS_SU)))[row] = am * (1.f / 7.5f);
        }
    }
}

__device__ __forceinline__ float mod_at(const float* modp, int b, int n) {
    float s = 0.f;
#pragma unroll
    for (int kc = 0; kc < 8; ++kc) s += modp[(size_t)(kc * 8 + b) * 6144 + n];
    return s;
}

__device__ __forceinline__ void phase1(const Params& p, LAS unsigned char* lds, int G) {
    const int tid = threadIdx.x, lane = tid & 63, wave = __builtin_amdgcn_readfirstlane(tid >> 6);
    const float* modp = (const float*)(p.ws + WS_MODP);
    LAS float* gs = (LAS float*)lds; LAS float* sh = gs + 1024;
    bf16* H = (bf16*)p.out;
    for (int tile = blockIdx.x; tile < T / 256; tile += G) {
        const int b = tile / 32;
        __syncthreads();
        for (int k = tid; k < 1024; k += NTHR) { gs[k] = p.npm[k] * (1.f + mod_at(modp, b, 1024 + k)); sh[k] = mod_at(modp, b, k); }
        __syncthreads();
        for (int rr = 0; rr < 32; ++rr) {
            const size_t row = (size_t)tile * 256 + wave * 32 + rr;
            const f32x4* xr = (const f32x4*)(p.x + row * 1024) + lane;
            f32x4 v[4]; float s = 0.f;
#pragma unroll
            for (int j = 0; j < 4; ++j) { v[j] = xr[64 * j]; s += (v[j].x * v[j].x + v[j].y * v[j].y) + (v[j].z * v[j].z + v[j].w * v[j].w); }
            const float rstd = __builtin_amdgcn_rsqf(wave_sum(s) * (1.f / 1024.f) + 1e-6f);
            u32x2* o8 = (u32x2*)(H + row * 1024) + lane;
#pragma unroll
            for (int j = 0; j < 4; ++j) { const int k = 256 * j + 4 * lane; const f32x4 g4 = *(const LAS f32x4*)(gs + k), s4 = *(const LAS f32x4*)(sh + k);
                u32x2 w; w.x = pk2(v[j].x * rstd * g4.x + s4.x, v[j].y * rstd * g4.y + s4.y); w.y = pk2(v[j].z * rstd * g4.z + s4.z, v[j].w * rstd * g4.w + s4.w);
                o8[64 * j] = w; }
        }
    }
}

typedef short bf16x8_t __attribute__((ext_vector_type(8)));
template <bool FINAL>
__device__ __forceinline__ void phase_lru(const Params& p, LAS unsigned char* lds, int G) {
    const int tid = threadIdx.x, lane = tid & 63, wave = __builtin_amdgcn_readfirstlane(tid >> 6), q4 = lane >> 4, c16 = lane & 15;
    constexpr int PQ = 136;
    LAS bf16* XC = (LAS bf16*)lds;
    LAS bf16* HB = XC + 64 * PQ;
    LAS float* CW = (LAS float*)(HB + 64 * PQ);
    const bf16* XL = (const bf16*)(p.ws + WS_XLXG); const bf16* LruB = (const bf16*)(p.ws + WS_LRUB);
    const bf16* XG = (const bf16*)(p.ws + WS_XLXG) + 1024; const bf16* GB = (const bf16*)(p.ws + WS_GAGB) + 1024; bf16* GA = (bf16*)(p.ws + WS_GAGB);
    const bf16* O = (const bf16*)(p.ws + WS_QKV) + 1024; const bf16* R = (const bf16*)(p.ws + WS_R); const float* SS = (const float*)(p.ws + WS_SS);
    f32x2* CAR = (f32x2*)(p.ws + WS_LRUC);
    const int c8 = tid & 15, tr = tid >> 4;
    for (int it = blockIdx.x; it < 8 * 8 * 4; it += G) {
        const int sg = it & 3, n = (it >> 2) & 7, b = it >> 5;
        const int chc = n * 128 + c8 * 8;
        const int chm = n * 128 + wave * 16 + c16;
        __syncthreads();
        for (int i = tid; i < 768; i += NTHR) { const int q = i >> 7, c = i & 127; CW[i] = q < 4 ? p.conv_w[q * 1024 + n * 128 + c] : (q == 4 ? p.conv_b[n * 128 + c] : p.gla_norm[n * 128 + c]); }
        const float ba = p.lba[chm], bx = p.lbx[chm], sp = -8.f * softplus_f(-p.lam[chm]);
        bf16x8_t wf[2][4];
        { const int np = n < 6 ? n : 6, half = n - np;
#pragma unroll
          for (int g = 0; g < 2; ++g)
#pragma unroll
              for (int ks = 0; ks < 4; ++ks) wf[g][ks] = *(const bf16x8_t*)(LruB + (size_t)n * 65536 + (size_t)(g * 128 + wave * 16 + c16) * 256 + half * 128 + ks * 32 + q4 * 8); }
        float hc = 0.f, aseg = 1.f;
        if (FINAL) { for (int s = 0; s < 4 * sg; ++s) { const f32x2 c = CAR[(size_t)((b * 8 + n) * 12 + s) * 128 + wave * 16 + c16]; hc = c.x * hc + c.y; } }
        constexpr int NTL = FINAL ? 32 : 24;
        const size_t tseg = (size_t)b * SEQ + (size_t)sg * (NTL * 64);
        u32x4 xr[5];
#define LRU_LOADX(t0_) do { _Pragma("unroll") for (int _k = 0; _k < 5; ++_k) { const long _t = (long)(t0_) + 2 * tr + _k - 3; \
            xr[_k] = (_t < (long)b * SEQ) ? (u32x4){0u, 0u, 0u, 0u} : *(const u32x4*)(XL + (size_t)_t * 2048 + chc); } } while (0)
        LRU_LOADX(tseg);
        __syncthreads();
#pragma unroll 1
        for (int tl = 0; tl < NTL; ++tl) {
            const size_t t0 = tseg + tl * 64;
            { float xv[5][8];
#pragma unroll
              for (int k = 0; k < 5; ++k) { xv[k][0] = bflo(xr[k].x); xv[k][1] = bfhi(xr[k].x); xv[k][2] = bflo(xr[k].y); xv[k][3] = bfhi(xr[k].y); xv[k][4] = bflo(xr[k].z); xv[k][5] = bfhi(xr[k].z); xv[k][6] = bflo(xr[k].w); xv[k][7] = bfhi(xr[k].w); }
              float cw[5][8];
#pragma unroll
              for (int q = 0; q < 5; ++q) { const f32x4 w0 = *(const LAS f32x4*)(CW + q * 128 + c8 * 8), w1 = *(const LAS f32x4*)(CW + q * 128 + c8 * 8 + 4);
                  cw[q][0] = w0.x; cw[q][1] = w0.y; cw[q][2] = w0.z; cw[q][3] = w0.w; cw[q][4] = w1.x; cw[q][5] = w1.y; cw[q][6] = w1.z; cw[q][7] = w1.w; }
#pragma unroll
              for (int i2 = 0; i2 < 2; ++i2) { float o[8];
#pragma unroll
                  for (int j = 0; j < 8; ++j) o[j] = cw[4][j] + cw[0][j] * xv[i2][j] + cw[1][j] * xv[i2 + 1][j] + cw[2][j] * xv[i2 + 2][j] + cw[3][j] * xv[i2 + 3][j];
                  *(LAS u32x4*)(XC + (2 * tr + i2) * PQ + c8 * 8) = (u32x4){pk2(o[0], o[1]), pk2(o[2], o[3]), pk2(o[4], o[5]), pk2(o[6], o[7])}; } }
            u32x4 mxg[2], mgb[2], mo[2], mr[2], mga[2]; float mss[2];
            if (FINAL) {
#pragma unroll
                for (int i2 = 0; i2 < 2; ++i2) { const size_t t = t0 + 2 * tr + i2;
                    mxg[i2] = *(const u32x4*)(XG + t * 2048 + chc); mgb[i2] = *(const u32x4*)(GB + t * 2048 + chc); mo[i2] = *(const u32x4*)(O + t * 2048 + chc);
                    mr[i2] = *(const u32x4*)(R + t * 1024 + chc); mga[i2] = *(const u32x4*)(GA + t * 2048 + chc); mss[i2] = SS[t * 4 + (chc >> 8)]; } }
            if (tl + 1 < NTL) LRU_LOADX(t0 + 64);
            __syncthreads();
            pg8::f32x4 acc[4][2];
#pragma unroll
            for (int tt = 0; tt < 4; ++tt) { acc[tt][0] = (pg8::f32x4){0.f, 0.f, 0.f, 0.f}; acc[tt][1] = (pg8::f32x4){0.f, 0.f, 0.f, 0.f}; }
#pragma unroll
            for (int ks = 0; ks < 4; ++ks)
#pragma unroll
                for (int tt = 0; tt < 4; ++tt) { const bf16x8_t a = *(const LAS bf16x8_t*)(XC + (tt * 16 + c16) * PQ + ks * 32 + q4 * 8);
                    acc[tt][0] = __builtin_amdgcn_mfma_f32_16x16x32_bf16(a, wf[0][ks], acc[tt][0], 0, 0, 0);
                    acc[tt][1] = __builtin_amdgcn_mfma_f32_16x16x32_bf16(a, wf[1][ks], acc[tt][1], 0, 0, 0); }
#pragma unroll
            for (int tt = 0; tt < 4; ++tt) {
                float av[4], uv[4];
#pragma unroll
                for (int j = 0; j < 4; ++j) { const float xc = bf2f(XC[(tt * 16 + q4 * 4 + j) * PQ + wave * 16 + c16]);
                    const float gr = sigmoid_f(acc[tt][0][j] + ba), gi = sigmoid_f(acc[tt][1][j] + bx);
                    const float a = __expf(sp * gr); av[j] = a; uv[j] = __builtin_amdgcn_sqrtf(fmaxf(1.f - a * a, 0.f)) * gi * xc; }
                float A4 = av[0], H4 = uv[0];
#pragma unroll
                for (int j = 1; j < 4; ++j) { H4 = av[j] * H4 + uv[j]; A4 *= av[j]; }
                float Ai = A4, Hi = H4;
                { const float Ap = __shfl_up(Ai, 16), Hp = __shfl_up(Hi, 16); if (q4 >= 1) { Hi = Hp * Ai + Hi; Ai = Ap * Ai; } }
                { const float Ap = __shfl_up(Ai, 32), Hp = __shfl_up(Hi, 32); if (q4 >= 2) { Hi = Hp * Ai + Hi; Ai = Ap * Ai; } }
                float Ae = __shfl_up(Ai, 16), He = __shfl_up(Hi, 16); if (q4 == 0) { Ae = 1.f; He = 0.f; }
                float h = hc * Ae + He;
                const float At = __shfl(Ai, 48 + c16), Ht = __shfl(Hi, 48 + c16);
                if (FINAL) {
#pragma unroll
                    for (int j = 0; j < 4; ++j) { h = av[j] * h + uv[j]; HB[(tt * 16 + q4 * 4 + j) * PQ + wave * 16 + c16] = (bf16)f2bf(h); } }
                hc = hc * At + Ht; aseg *= At;
            }
            if (!FINAL && (tl & 7) == 7) {
                if (q4 == 0) CAR[(size_t)((b * 8 + n) * 12 + sg * 3 + (tl >> 3)) * 128 + wave * 16 + c16] = (f32x2){aseg, hc};
                hc = 0.f; aseg = 1.f; }
            __syncthreads();
            if (FINAL) {
#pragma unroll
                for (int i2 = 0; i2 < 2; ++i2) { const size_t t = t0 + 2 * tr + i2;
                    const u32x4 hw = *(const LAS u32x4*)(HB + (2 * tr + i2) * PQ + c8 * 8);
                    const float rstd = __builtin_amdgcn_rsqf(mss[i2] * (1.f / 256.f) + 1e-6f);
                    const unsigned hwv[4] = {hw.x, hw.y, hw.z, hw.w}, xgv[4] = {mxg[i2].x, mxg[i2].y, mxg[i2].z, mxg[i2].w}, gbv[4] = {mgb[i2].x, mgb[i2].y, mgb[i2].z, mgb[i2].w};
                    const unsigned ov[4] = {mo[i2].x, mo[i2].y, mo[i2].z, mo[i2].w}, rv[4] = {mr[i2].x, mr[i2].y, mr[i2].z, mr[i2].w}, gav[4] = {mga[i2].x, mga[i2].y, mga[i2].z, mga[i2].w};
                    unsigned ow[4];
                    const f32x4 g0 = *(const LAS f32x4*)(CW + 640 + c8 * 8), g1 = *(const LAS f32x4*)(CW + 640 + c8 * 8 + 4);
                    const float gn[8] = {g0.x, g0.y, g0.z, g0.w, g1.x, g1.y, g1.z, g1.w};
#pragma unroll
                    for (int q = 0; q < 4; ++q) {
                        const float m0 = merge2(bflo(gav[q]), bflo(ov[q]) * rstd * gn[2 * q], bflo(rv[q]), bflo(gbv[q]), bflo(hwv[q]), bflo(xgv[q]));
                        const float m1 = merge2(bfhi(gav[q]), bfhi(ov[q]) * rstd * gn[2 * q + 1], bfhi(rv[q]), bfhi(gbv[q]), bfhi(hwv[q]), bfhi(xgv[q]));
                        ow[q] = pk2(m0, m1); }
                    *(u32x4*)(GA + t * 2048 + chc) = (u32x4){ow[0], ow[1], ow[2], ow[3]}; }
            }
        }
#undef LRU_LOADX
        __syncthreads();
    }
}

__device__ __forceinline__ void phase_gla_prep(const Params& p, LAS unsigned char* lds, int G) {
    const int tid = threadIdx.x;
    LAS float* segt = (LAS float*)lds;
    bf16* QKV = (bf16*)(p.ws + WS_QKV); const bf16* AL = (const bf16*)(p.ws + WS_ALOW); float* DK = (float*)(p.ws + WS_DK);
    const int kp = tid & 127, seg = tid >> 7;
    for (int it = blockIdx.x; it < 8 * 128 * 4; it += G) {
        const int h = it & 3, ch = (it >> 2) & 127, b = it >> 9;
        float wa[16];
#pragma unroll
        for (int r = 0; r < 16; ++r) wa[r] = p.w_alpha[r * 512 + h * 128 + kp];
        const float balpha = p.b_alpha[h * 128 + kp];
        const size_t t0 = (size_t)b * SEQ + ch * 64 + seg * 16;
        float qv[16], kv[16];
#pragma unroll
        for (int i = 0; i < 16; ++i) { qv[i] = bf2f(QKV[(t0 + i) * 2048 + h * 128 + kp]); kv[i] = bf2f(QKV[(t0 + i) * 2048 + 512 + h * 128 + kp]); }
        float cl[16]; float run = 0.f;
#pragma unroll
        for (int i = 0; i < 16; ++i) { const size_t t = t0 + i;
            const u32x4 a0 = *(const u32x4*)(AL + t * 16), a1 = *(const u32x4*)(AL + t * 16 + 8);
            float z = balpha;
            z += bflo(a0.x) * wa[0] + bfhi(a0.x) * wa[1] + bflo(a0.y) * wa[2] + bfhi(a0.y) * wa[3] + bflo(a0.z) * wa[4] + bfhi(a0.z) * wa[5] + bflo(a0.w) * wa[6] + bfhi(a0.w) * wa[7];
            z += bflo(a1.x) * wa[8] + bfhi(a1.x) * wa[9] + bflo(a1.y) * wa[10] + bfhi(a1.y) * wa[11] + bflo(a1.z) * wa[12] + bfhi(a1.z) * wa[13] + bflo(a1.w) * wa[14] + bfhi(a1.w) * wa[15];
            const float ls = fminf(z, 0.f) - __logf(1.f + __expf(-fabsf(z)));
            run += ls * (1.f / 16.f); cl[i] = run; }
        __syncthreads();
        segt[seg * 128 + kp] = run;
        __syncthreads();
        float off = 0.f, tot = 0.f;
#pragma unroll
        for (int s = 0; s < 4; ++s) { const float v = segt[s * 128 + kp]; tot += v; if (s < seg) off += v; }
        if (seg == 0) DK[(size_t)(b * 128 + ch) * 512 + h * 128 + kp] = __expf(tot);
#pragma unroll
        for (int i = 0; i < 16; ++i) { const float cum = cl[i] + off;
            QKV[(t0 + i) * 2048 + h * 128 + kp] = (bf16)f2bf(qv[i] * 0.08838834764831845f * __expf(cum));
            QKV[(t0 + i) * 2048 + 512 + h * 128 + kp] = (bf16)f2bf(kv[i] * __expf(-cum)); }
    }
}
__device__ __forceinline__ bf16x8_t lds_col8(const LAS bf16* base, int pitch) {
    unsigned w[4];
#pragma unroll
    for (int i = 0; i < 4; ++i) w[i] = (unsigned)base[(2 * i) * pitch] | ((unsigned)base[(2 * i + 1) * pitch] << 16);
    return __builtin_bit_cast(bf16x8_t, (u32x4){w[0], w[1], w[2], w[3]});
}
__device__ __forceinline__ void phase_gla_seq(const Params& p, LAS unsigned char* lds, int G) {
    const int tid = threadIdx.x, lane = tid & 63, wave = __builtin_amdgcn_readfirstlane(tid >> 6), q4 = lane >> 4, c16 = lane & 15;
    constexpr int PQ = 136, PS = 72, PV = 34;
    LAS bf16* Qs = (LAS bf16*)lds;
    LAS bf16* Kd = Qs + 64 * PQ;
    LAS bf16* Vt = Kd + 64 * PQ;
    LAS bf16* Pm = Vt + 64 * PV + 64;
    LAS bf16* ST = Pm + 64 * PS;
    LAS float* dk = (LAS float*)(ST + 32 * PQ);
    const bf16* QKV = (const bf16*)(p.ws + WS_QKV); bf16* VO = (bf16*)(p.ws + WS_QKV); const float* DK = (const float*)(p.ws + WS_DK); float* SS = (float*)(p.ws + WS_SS);
    const int r0 = tid >> 4, cc = (tid & 15) * 8;
    const int vr = (tid >> 2) & 63, vc = (tid & 3) * 8;
    for (int it = blockIdx.x; it < 8 * 4 * 8; it += G) {
        const int v8 = it & 7, h = (it >> 3) & 3, b = it >> 5;
        pg8::f32x4 sacc[2] = {(pg8::f32x4){0.f, 0.f, 0.f, 0.f}, (pg8::f32x4){0.f, 0.f, 0.f, 0.f}};
        __syncthreads();
        for (int i = tid; i < 32 * PQ / 2; i += NTHR) ((LAS unsigned*)ST)[i] = 0u;
        u32x4 rq[2], rk[2], rv; float rdk = 0.f;
#define GLA_LOAD(chn) do { const size_t _t0 = (size_t)b * SEQ + (size_t)(chn) * 64; \
            _Pragma("unroll") for (int _j = 0; _j < 2; ++_j) { rq[_j] = *(const u32x4*)(QKV + (_t0 + r0 + 32 * _j) * 2048 + h * 128 + cc); rk[_j] = *(const u32x4*)(QKV + (_t0 + r0 + 32 * _j) * 2048 + 512 + h * 128 + cc); } \
            rv = *(const u32x4*)(QKV + (_t0 + vr) * 2048 + 1024 + h * 256 + v8 * 32 + vc); \
            rdk = DK[(size_t)(b * 128 + (chn)) * 512 + h * 128 + (tid & 127)]; } while (0)
        GLA_LOAD(0);
#pragma unroll 1
        for (int ch = 0; ch < SEQ / 64; ++ch) {
            const size_t t0 = (size_t)b * SEQ + ch * 64;
#pragma unroll
            for (int j = 0; j < 2; ++j) { *(LAS u32x4*)(Qs + (r0 + 32 * j) * PQ + cc) = rq[j]; *(LAS u32x4*)(Kd + (r0 + 32 * j) * PQ + cc) = rk[j]; }
            if (tid < 256) { LAS unsigned* vd = (LAS unsigned*)(Vt + vr * PV + vc); vd[0] = rv.x; vd[1] = rv.y; vd[2] = rv.z; vd[3] = rv.w; }
            if (tid < 128) dk[tid] = rdk;
            if (ch + 1 < SEQ / 64) GLA_LOAD(ch + 1);
            __syncthreads();
            { const int tt = wave & 3;
#pragma unroll
              for (int i2 = 0; i2 < 2; ++i2) { const int ts = (wave >> 2) * 2 + i2;
                  pg8::f32x4 acc = (pg8::f32x4){0.f, 0.f, 0.f, 0.f};
                  if (ts <= tt) {
#pragma unroll
                      for (int ks = 0; ks < 4; ++ks) { const bf16x8_t a = *(const LAS bf16x8_t*)(Kd + (ts * 16 + c16) * PQ + ks * 32 + q4 * 8), bb = *(const LAS bf16x8_t*)(Qs + (tt * 16 + c16) * PQ + ks * 32 + q4 * 8);
                          acc = __builtin_amdgcn_mfma_f32_16x16x32_bf16(a, bb, acc, 0, 0, 0); }
                      const int tg = tt * 16 + c16, sgl = ts * 16 + q4 * 4;
#pragma unroll
                      for (int j = 0; j < 4; ++j) if (sgl + j > tg) acc[j] = 0.f;
                  }
                  *(LAS u32x2*)(Pm + (tt * 16 + c16) * PS + ts * 16 + q4 * 4) = (u32x2){pk2(acc[0], acc[1]), pk2(acc[2], acc[3])}; } }
            bf16x8_t vf[2][2], kf[2];
#pragma unroll
            for (int ks = 0; ks < 2; ++ks) { kf[ks] = lds_col8(Kd + (ks * 32 + q4 * 8) * PQ + wave * 16 + c16, PQ);
#pragma unroll
                for (int tv = 0; tv < 2; ++tv) vf[tv][ks] = lds_col8(Vt + (ks * 32 + q4 * 8) * PV + tv * 16 + c16, PV); }
            __syncthreads();
            { const int tt = wave & 3, tv = wave >> 2;
              pg8::f32x4 oacc = (pg8::f32x4){0.f, 0.f, 0.f, 0.f};
#pragma unroll
              for (int ks = 0; ks < 2; ++ks) { const bf16x8_t bb = *(const LAS bf16x8_t*)(Pm + (tt * 16 + c16) * PS + ks * 32 + q4 * 8);
                  oacc = __builtin_amdgcn_mfma_f32_16x16x32_bf16(tv ? vf[1][ks] : vf[0][ks], bb, oacc, 0, 0, 0); }
#pragma unroll
              for (int ks = 0; ks < 4; ++ks) { const bf16x8_t bb = *(const LAS bf16x8_t*)(Qs + (tt * 16 + c16) * PQ + ks * 32 + q4 * 8), a = *(const LAS bf16x8_t*)(ST + (tv * 16 + c16) * PQ + ks * 32 + q4 * 8);
                  oacc = __builtin_amdgcn_mfma_f32_16x16x32_bf16(a, bb, oacc, 0, 0, 0); }
              *(u32x2*)(VO + (t0 + tt * 16 + c16) * 2048 + 1024 + h * 256 + v8 * 32 + tv * 16 + q4 * 4) = (u32x2){pk2(oacc[0], oacc[1]), pk2(oacc[2], oacc[3])};
              float sq = (oacc[0] * oacc[0] + oacc[1] * oacc[1]) + (oacc[2] * oacc[2] + oacc[3] * oacc[3]);
              sq += __shfl_xor(sq, 16); sq += __shfl_xor(sq, 32);
              if (q4 == 0) atomicAdd(SS + (t0 + tt * 16 + c16) * 4 + h, sq); }
#pragma unroll
            for (int ks = 0; ks < 2; ++ks)
#pragma unroll
                for (int tv = 0; tv < 2; ++tv) sacc[tv] = __builtin_amdgcn_mfma_f32_16x16x32_bf16(kf[ks], vf[tv][ks], sacc[tv], 0, 0, 0);
            { const pg8::f32x4 d4 = *(const LAS pg8::f32x4*)(dk + wave * 16 + q4 * 4);
#pragma unroll
              for (int tv = 0; tv < 2; ++tv) sacc[tv] = sacc[tv] * d4; }
            __syncthreads();
#pragma unroll
            for (int tv = 0; tv < 2; ++tv) *(LAS u32x2*)(ST + (tv * 16 + c16) * PQ + wave * 16 + q4 * 4) = (u32x2){pk2(sacc[tv][0], sacc[tv][1]), pk2(sacc[tv][2], sacc[tv][3])};
        }
#undef GLA_LOAD
    }
}

__device__ __forceinline__ void phase_norm2(const Params& p, LAS unsigned char* lds, int G) {
    const int tid = threadIdx.x, lane = tid & 63, wave = __builtin_amdgcn_readfirstlane(tid >> 6);
    const float* modp = (const float*)(p.ws + WS_MODP);
    LAS float* g1 = (LAS float*)lds; LAS float* gs = g1 + 1024; LAS float* sh = gs + 1024;
    const bf16* Y = (const bf16*)(p.ws + WS_Y); bf16* H2 = (bf16*)(p.ws + WS_H2);
    for (int tile = blockIdx.x; tile < T / 256; tile += G) {
        const int b = tile / 32;
        __syncthreads();
        for (int k = tid; k < 1024; k += NTHR) { g1[k] = mod_at(modp, b, 2048 + k) * p.npo[k]; gs[k] = p.npf[k] * (1.f + mod_at(modp, b, 4096 + k)); sh[k] = mod_at(modp, b, 3072 + k); }
        __syncthreads();
        for (int rr = 0; rr < 32; ++rr) {
            const size_t row = (size_t)tile * 256 + wave * 32 + rr;
            const f32x4* xr = (const f32x4*)(p.x + row * 1024) + lane; const u32x2* yr = (const u32x2*)(Y + row * 1024) + lane;
            f32x4 xv[4], yv[4]; float s = 0.f;
#pragma unroll
            for (int j = 0; j < 4; ++j) { xv[j] = xr[64 * j]; const u32x2 yw = yr[64 * j]; yv[j] = (f32x4){bflo(yw.x), bfhi(yw.x), bflo(yw.y), bfhi(yw.y)};
                s += (yv[j].x * yv[j].x + yv[j].y * yv[j].y) + (yv[j].z * yv[j].z + yv[j].w * yv[j].w); }
            const float rstd = __builtin_amdgcn_rsqf(wave_sum(s) * (1.f / 1024.f) + 1e-6f);
            float s2 = 0.f;
            f32x4* orow = (f32x4*)(p.out + row * 1024) + lane;
#pragma unroll
            for (int j = 0; j < 4; ++j) { const int k = 256 * j + 4 * lane; const f32x4 g4 = *(const LAS f32x4*)(g1 + k);
                xv[j] = xv[j] + yv[j] * rstd * g4; orow[64 * j] = xv[j];
                s2 += (xv[j].x * xv[j].x + xv[j].y * xv[j].y) + (xv[j].z * xv[j].z + xv[j].w * xv[j].w); }
            const float rstd2 = __builtin_amdgcn_rsqf(wave_sum(s2) * (1.f / 1024.f) + 1e-6f);
            u32x2* o8 = (u32x2*)(H2 + row * 1024) + lane;
#pragma unroll
            for (int j = 0; j < 4; ++j) { const int k = 256 * j + 4 * lane; const f32x4 g4 = *(const LAS f32x4*)(gs + k), s4 = *(const LAS f32x4*)(sh + k);
                u32x2 w; w.x = pk2(xv[j].x * rstd2 * g4.x + s4.x, xv[j].y * rstd2 * g4.y + s4.y); w.y = pk2(xv[j].z * rstd2 * g4.z + s4.z, xv[j].w * rstd2 * g4.w + s4.w);
                o8[64 * j] = w; }
        }
    }
}

__device__ __forceinline__ unsigned h16_key(unsigned b) { return (b & 0x8000u) ? (~b & 0xffffu) : (b | 0x8000u); }
__device__ __forceinline__ float h16_key_val(unsigned s) { const unsigned b = (s & 0x8000u) ? (s & 0x7fffu) : (~s & 0xffffu); return (float)__builtin_bit_cast(_Float16, (unsigned short)b); }
template <bool ASC> __device__ __forceinline__ void sort16(unsigned (&k)[16]) {
#pragma unroll
    for (int size = 2; size <= 16; size <<= 1)
#pragma unroll
        for (int stride = size >> 1; stride > 0; stride >>= 1)
#pragma unroll
            for (int i = 0; i < 16; ++i) { const int j = i ^ stride; if (j > i) { const bool up = ((i & size) == 0) == ASC; const unsigned lo = min(k[i], k[j]), hi = max(k[i], k[j]); k[i] = up ? lo : hi; k[j] = up ? hi : lo; } }
}
__device__ __forceinline__ void merge16_desc(unsigned (&k)[16]) {
#pragma unroll
    for (int stride = 8; stride > 0; stride >>= 1)
#pragma unroll
        for (int i = 0; i < 16; ++i) { const int j = i ^ stride; if (j > i) { const unsigned lo = min(k[i], k[j]), hi = max(k[i], k[j]); k[i] = hi; k[j] = lo; } }
}
__device__ __forceinline__ void top16_merge(unsigned (&top)[16], unsigned (&grp)[16]) {
    sort16<true>(grp);
#pragma unroll
    for (int i = 0; i < 16; ++i) top[i] = max(top[i], grp[i]);
    merge16_desc(top);
}
__device__ __forceinline__ void keys16(unsigned (&k)[16], const u32x4 w0, const u32x4 w1, int n0) {
    const unsigned ww[8] = {w0.x, w0.y, w0.z, w0.w, w1.x, w1.y, w1.z, w1.w};
#pragma unroll
    for (int q = 0; q < 8; ++q) { k[2 * q] = (h16_key(ww[q] & 0xffffu) << 16) | (unsigned)(127 - (n0 + 2 * q)); k[2 * q + 1] = (h16_key(ww[q] >> 16) << 16) | (unsigned)(127 - (n0 + 2 * q + 1)); }
}
__device__ __forceinline__ void topk_item(const unsigned short* SC, const float* SU, const float* SV, int t, int h, volatile LAS unsigned* my, unsigned (&outw)[16], float (&outs)[16]) {
    const u32x4* src = (const u32x4*)(SC + (size_t)t * 2048 + h * 256);
    unsigned topA[16], topB[16];
    keys16(topA, src[0], src[1], 0); sort16<false>(topA);
#pragma unroll 1
    for (int g = 1; g < 8; ++g) { unsigned grp[16]; keys16(grp, src[2 * g], src[2 * g + 1], 16 * g); top16_merge(topA, grp); }
    keys16(topB, src[16], src[17], 0); sort16<false>(topB);
#pragma unroll 1
    for (int g = 1; g < 8; ++g) { unsigned grp[16]; keys16(grp, src[16 + 2 * g], src[17 + 2 * g], 16 * g); top16_merge(topB, grp); }
    float fa[16], fb[16];
#pragma unroll
    for (int j = 0; j < 16; ++j) { fa[j] = h16_key_val(topA[j] >> 16); fb[j] = h16_key_val(topB[j] >> 16); my[j] = 127u - (topA[j] & 127u); my[16 + j] = 127u - (topB[j] & 127u); }
    unsigned ct[16];
#pragma unroll
    for (int g = 0; g < 4; ++g) { unsigned grp[16];
#pragma unroll
        for (int s = 0; s < 16; ++s) grp[s] = 0u;
        { int slot = 0;
#pragma unroll
          for (int i = 0; i < 16; ++i)
#pragma unroll
              for (int j = 0; j < 16; ++j) if ((i + 1) * (j + 1) <= 16) { if ((slot >> 4) == g) {
                  const float s = fa[i] + fb[j]; unsigned u = __builtin_bit_cast(unsigned, s); u ^= (u >> 31) ? 0xffffffffu : 0x80000000u;
                  grp[slot & 15] = (u & 0xffffff00u) | (unsigned)(255 - (i * 16 + j)); } ++slot; } }
        if (g == 0) { sort16<false>(grp);
#pragma unroll
            for (int s = 0; s < 16; ++s) ct[s] = grp[s]; }
        else top16_merge(ct, grp); }
    float val[16], mx, sum = 0.f;
#pragma unroll
    for (int m = 0; m < 16; ++m) { unsigned u = ct[m] & 0xffffff00u; u ^= (u >> 31) ? 0x80000000u : 0xffffffffu; val[m] = __builtin_bit_cast(float, u); }
    mx = val[0];
#pragma unroll
    for (int m = 0; m < 16; ++m) { val[m] = __expf(val[m] - mx); sum += val[m]; }
    const float inv = 1.f / sum;
    LDS_WAIT();
#pragma unroll
    for (int m = 0; m < 16; ++m) { const unsigned pos = 255u - (ct[m] & 255u), i = pos >> 4, j = pos & 15u;
        const unsigned e = my[i] * 128u + my[16 + j];
        outw[m] = (e << 16) | f2bf(val[m] * inv * SV[e]); outs[m] = SU[e]; }
}

typedef unsigned u32x3 __attribute__((ext_vector_type(3)));
typedef unsigned u32x6 __attribute__((ext_vector_type(6)));
typedef float f32x32 __attribute__((ext_vector_type(32)));
__device__ __forceinline__ float rdlane(float v, int l) { return __builtin_bit_cast(float, __builtin_amdgcn_readlane(__builtin_bit_cast(int, v), l)); }
__device__ __forceinline__ f32x32 fp6x2(u32x3 a, u32x3 b) { const u32x6 s = {a.x, a.y, a.z, b.x, b.y, b.z}; return __builtin_amdgcn_cvt_scalef32_pk32_f32_fp6(s, 1.0f); }
__device__ __forceinline__ void phase_gather(const Params& p, LAS unsigned char* lds, int G) {
    const int tid = threadIdx.x, lane = tid & 63, wave = __builtin_amdgcn_readfirstlane(tid >> 6);
    const float* modp = (const float*)(p.ws + WS_MODP);
    LAS float* g2 = (LAS float*)lds;
    const bf16* H2 = (const bf16*)(p.ws + WS_H2);
    const unsigned short* SC = (const unsigned short*)(p.ws + WS_SC); const float* SU = (const float*)(p.ws + WS_SU); const float* SV = (const float*)(p.ws + WS_SV);
    volatile LAS unsigned* RT = (volatile LAS unsigned*)(lds + 4096 + wave * 16640); volatile LAS float* RS = (volatile LAS float*)(RT + 1024);
    volatile LAS unsigned* myscr = RT + 2048 + lane * 33;
    const unsigned char* U6 = p.ws + WS_U; const unsigned char* V6 = p.ws + WS_V;
    for (int tile = blockIdx.x; tile < T / 256; tile += G) {
        const int b = tile / 32;
        __syncthreads();
        for (int k = tid; k < 1024; k += NTHR) g2[k] = mod_at(modp, b, 5120 + k) * p.npof[k];
        __syncthreads();
#pragma unroll 1
        for (int rr = 0; rr < 32; ++rr) {
            const size_t row = (size_t)tile * 256 + wave * 32 + rr;
            if ((rr & 7) == 0) {
                unsigned ow[16]; float os[16];
                __builtin_amdgcn_wave_barrier();
                topk_item(SC, SU, SV, (int)(row + (lane >> 3)), lane & 7, myscr, ow, os);
#pragma unroll
                for (int m = 0; m < 16; ++m) { RT[(lane >> 3) * 128 + (lane & 7) * 16 + m] = ow[m]; RS[(lane >> 3) * 128 + (lane & 7) * 16 + m] = os[m]; }
                asm volatile("s_waitcnt lgkmcnt(0)" ::: "memory"); __builtin_amdgcn_wave_barrier();
            }
            const int tl = rr & 7;
            float xt[16];
            { const u32x4 a = *(const u32x4*)(H2 + row * 1024 + lane * 16), c = *(const u32x4*)(H2 + row * 1024 + lane * 16 + 8);
              xt[0] = bflo(a.x); xt[1] = bfhi(a.x); xt[2] = bflo(a.y); xt[3] = bfhi(a.y); xt[4] = bflo(a.z); xt[5] = bfhi(a.z); xt[6] = bflo(a.w); xt[7] = bfhi(a.w);
              xt[8] = bflo(c.x); xt[9] = bfhi(c.x); xt[10] = bflo(c.y); xt[11] = bfhi(c.y); xt[12] = bflo(c.z); xt[13] = bfhi(c.z); xt[14] = bflo(c.w); xt[15] = bfhi(c.w); }
            float acc[16];
#pragma unroll
            for (int j = 0; j < 16; ++j) acc[j] = 0.f;
#pragma unroll 1
            for (int hh = 0; hh < 16; ++hh) {
                unsigned ww[8];
#pragma unroll
                for (int m = 0; m < 8; ++m) ww[m] = RT[tl * 128 + hh * 8 + m];
                u32x6 up[4], vp[4];
#pragma unroll
                for (int m = 0; m < 8; ++m) { const size_t eo = (size_t)((unsigned)__builtin_amdgcn_readfirstlane((int)ww[m]) >> 16) * 768 + lane * 12;
                    const u32x3 a = *(const u32x3*)(U6 + eo), c = *(const u32x3*)(V6 + eo);
                    if (m & 1) { up[m >> 1][3] = a.x; up[m >> 1][4] = a.y; up[m >> 1][5] = a.z; vp[m >> 1][3] = c.x; vp[m >> 1][4] = c.y; vp[m >> 1][5] = c.z; }
                    else { up[m >> 1][0] = a.x; up[m >> 1][1] = a.y; up[m >> 1][2] = a.z; vp[m >> 1][0] = c.x; vp[m >> 1][1] = c.y; vp[m >> 1][2] = c.z; } }
                const unsigned wa = RT[tl * 128 + hh * 8 + (lane >> 3)]; const float su = RS[tl * 128 + hh * 8 + (lane >> 3)];
                float pd[8];
#pragma unroll
                for (int m = 0; m < 8; m += 2) { const f32x32 f = __builtin_amdgcn_cvt_scalef32_pk32_f32_fp6(up[m >> 1], 1.0f);
                    float s0 = 0.f, s1 = 0.f;
#pragma unroll
                    for (int j = 0; j < 16; ++j) { s0 += xt[j] * f[j]; s1 += xt[j] * f[16 + j]; }
                    pd[m] = s0; pd[m + 1] = s1; __builtin_amdgcn_sched_barrier(0); }
#pragma unroll
                for (int j = 0; j < 4; ++j) { const bool up_ = (lane & 32) != 0; const float keep = up_ ? pd[j + 4] : pd[j], send = up_ ? pd[j] : pd[j + 4]; pd[j] = keep + __shfl_xor(send, 32); }
#pragma unroll
                for (int j = 0; j < 2; ++j) { const bool up_ = (lane & 16) != 0; const float keep = up_ ? pd[j + 2] : pd[j], send = up_ ? pd[j] : pd[j + 2]; pd[j] = keep + __shfl_xor(send, 16); }
                { const bool up_ = (lane & 8) != 0; const float keep = up_ ? pd[1] : pd[0], send = up_ ? pd[0] : pd[1]; pd[0] = keep + __shfl_xor(send, 8); }
                float d = pd[0]; d += __shfl_xor(d, 4); d += __shfl_xor(d, 2); d += __shfl_xor(d, 1);
                const float coef = bflo(wa) * gelu_f(su * d);
#pragma unroll
                for (int m = 0; m < 8; m += 2) { const f32x32 f = __builtin_amdgcn_cvt_scalef32_pk32_f32_fp6(vp[m >> 1], 1.0f); const float c0 = rdlane(coef, 8 * m), c1 = rdlane(coef, 8 * m + 8);
#pragma unroll
                    for (int j = 0; j < 16; ++j) acc[j] += c0 * f[j] + c1 * f[16 + j];
                    __builtin_amdgcn_sched_barrier(0); }
            }
            float s = 0.f;
#pragma unroll
            for (int j = 0; j < 16; ++j) s += acc[j] * acc[j];
            const float rstd = __builtin_amdgcn_rsqf(wave_sum(s) * (1.f / 1024.f) + 1e-6f);
            float* orow = p.out + row * 1024 + lane * 16;
#pragma unroll
            for (int q = 0; q < 4; ++q) { f32x4 o = *(const f32x4*)(orow + 4 * q); const f32x4 ga = *(const LAS f32x4*)(g2 + lane * 16 + 4 * q);
                o.x += ga.x * acc[4 * q] * rstd; o.y += ga.y * acc[4 * q + 1] * rstd; o.z += ga.z * acc[4 * q + 2] * rstd; o.w += ga.w * acc[4 * q + 3] * rstd;
                *(f32x4*)(orow + 4 * q) = o; }
        }
    }
}

#define XB_TMO      128
#define XB_XCNT(j)  (256  + 64 * (j))
#define XB_XSUB(j)  (1280 + 64 * (j))
#define XB_XGEN(j)  (2304 + 64 * (j))
#define XB_TOP      3328
#define XB_TOPGEN   3392
#define XCD_BAR_WORDS 3456
#define XB_SPIN_CAP (1u << 18)

__device__ __forceinline__ unsigned xb_ld(unsigned* p)              { return __hip_atomic_load(p, __ATOMIC_RELAXED, __HIP_MEMORY_SCOPE_AGENT); }
__device__ __forceinline__ unsigned xb_add(unsigned* p, unsigned v) { return __hip_atomic_fetch_add(p, v, __ATOMIC_RELAXED, __HIP_MEMORY_SCOPE_AGENT); }
__device__ __forceinline__ unsigned xb_xcc_id() { return (unsigned)__builtin_amdgcn_s_getreg((3 << 11) | 20) & 0xFu; }
#define XB_SPIN(cond, bar) do { unsigned _sp = 0; while (cond) { __builtin_amdgcn_s_sleep(1); \
    if ((++_sp & 255u) == 0u) { if (xb_ld(&(bar)[XB_TMO])) break; if (_sp > XB_SPIN_CAP) { atomicAdd(&(bar)[XB_TMO], 1u); break; } } } } while (0)

struct XcdBarrier {
    unsigned* bar; unsigned x;
    volatile LAS unsigned* st;
};

__device__ __forceinline__ XcdBarrier xcd_barrier_post(unsigned* bar, volatile LAS unsigned* st) {
    XcdBarrier b; b.bar = bar; b.x = xb_xcc_id(); b.st = st;
    if (threadIdx.x == 0) (void)xb_add(&bar[XB_XCNT(b.x)], 1u);
    return b;
}
__device__ __forceinline__ void xcd_barrier_complete(unsigned* bar, unsigned x, unsigned& nloc, unsigned& nx) {
    const unsigned G = gridDim.x * gridDim.y * gridDim.z;
    unsigned sum, cnt, mine, sp = 0u;
    for (;;) {
        sum = 0u; cnt = 0u; mine = 0u;
#pragma unroll
        for (unsigned j = 0; j < 16; ++j) { const unsigned c = xb_ld(&bar[XB_XCNT(j)]); sum += c; cnt += (c > 0u) ? 1u : 0u; mine = (j == x) ? c : mine; }
        if (sum == G) break;
        __builtin_amdgcn_s_sleep(1);
        if ((++sp & 255u) == 0u) { if (xb_ld(&bar[XB_TMO])) break; if (sp > XB_SPIN_CAP) { atomicAdd(&bar[XB_TMO], 1u); break; } }
    }
    nloc = mine > 0u ? mine : 1u; nx = cnt > 0u ? cnt : 1u;
}

__device__ __forceinline__ void xcd_barrier(const XcdBarrier& b) {
    asm volatile("s_waitcnt vmcnt(0)" ::: "memory");
    __syncthreads();
    if (threadIdx.x == 0) {
        unsigned* bar = b.bar;
        __builtin_amdgcn_s_waitcnt(0);
        unsigned nloc = b.st[0], nx = b.st[1];
        if (nloc == 0u) { xcd_barrier_complete(bar, b.x, nloc, nx); b.st[0] = nloc; b.st[1] = nx; }
        const unsigned old = xb_add(&bar[XB_XSUB(b.x)], 1u);
        const unsigned gen = old / nloc;
        if (old + 1u == (gen + 1u) * nloc) {
            __builtin_amdgcn_fence(__ATOMIC_RELEASE, "agent");
            asm volatile("s_waitcnt vmcnt(0)" ::: "memory");
            const unsigned og = xb_add(&bar[XB_TOP], 1u);
            const unsigned tg = og / nx;
            if (og + 1u == (tg + 1u) * nx) xb_add(&bar[XB_TOPGEN], 1u);
            else XB_SPIN(xb_ld(&bar[XB_TOPGEN]) == tg, bar);
            __builtin_amdgcn_fence(__ATOMIC_ACQUIRE, "agent");
            xb_add(&bar[XB_XGEN(b.x)], 1u);
            asm volatile("s_waitcnt vmcnt(0)" ::: "memory");
        } else {
            XB_SPIN(xb_ld(&bar[XB_XGEN(b.x)]) == gen, bar);
            __builtin_amdgcn_fence(__ATOMIC_ACQUIRE, "agent");
            asm volatile("s_waitcnt vmcnt(0)" ::: "memory");
        }
    }
    __syncthreads();
}


template <int PH>
__device__ __forceinline__ void run_phase(const Params& p, LAS unsigned char* lds, int G) {
    unsigned char* ws = p.ws;
    if constexpr (PH == 0) phase0(p, lds, G);
    else if constexpr (PH == 1) {
        { pg8::Gemm g{(const bf16*)(ws + WS_WQB), (const bf16*)(ws + WS_SUBK), 1024, 2048, 256, 2048}; pg8::StaticOrder S; S.init(1024, 2048, G, (int)blockIdx.x);
          EpiTrans E{(bf16*)(ws + WS_WQ), 1024}; pg8::gemm_phase<EpiTrans, pg8::StaticOrder, true, true, 2, 256, 2048>(lds, g, S, E); }
        __syncthreads();
        phase1(p, lds, G); }
    else if constexpr (PH == 2) { pg8::Gemm g{(const bf16*)p.out, (const bf16*)(ws + WS_WIN), T, NPAD, 1024, 1024}; pg8::StaticOrder S; S.init(T, NPAD, G, (int)blockIdx.x);
        EpiSeg E{ws}; pg8::gemm_phase<EpiSeg, pg8::StaticOrder, true, true, 0, 1024, 1024>(lds, g, S, E); }
    else if constexpr (PH == 3) { phase_gla_prep(p, lds, G); __syncthreads(); phase_lru<false>(p, lds, G); }
    else if constexpr (PH == 4) phase_gla_seq(p, lds, G);
    else if constexpr (PH == 5) phase_lru<true>(p, lds, G);
    else if constexpr (PH == 6) { pg8::Gemm g{(const bf16*)(ws + WS_GAGB), (const bf16*)(ws + WS_WOUT), T, 1024, 1024, 2048}; pg8::StaticOrder S; S.init(T, 1024, G, (int)blockIdx.x);
        EpiPlain E{(bf16*)(ws + WS_Y), 1024}; pg8::gemm_phase<EpiPlain, pg8::StaticOrder, true, true, 0, 1024, 2048>(lds, g, S, E); }
    else if constexpr (PH == 7) phase_norm2(p, lds, G);
    else if constexpr (PH == 8) {
        pg8::Gemm g{(const bf16*)(ws + WS_H2), (const bf16*)(ws + WS_WQ), T, 2048, 1024, 1024}; pg8::StaticOrder S; S.init(T, 2048, G, (int)blockIdx.x);
        EpiF16 E{(unsigned short*)(ws + WS_SC), 2048}; pg8::gemm_phase<EpiF16, pg8::StaticOrder, true, true, 0, 1024, 1024>(lds, g, S, E); }
    else if constexpr (PH == 9) phase_gather(p, lds, G);
}
template <int PH>
__global__ void __launch_bounds__(NTHR, 2) k_phase(Params p) {
    extern __shared__ __attribute__((aligned(16))) unsigned char lds_raw[];
    run_phase<PH>(p, (LAS unsigned char*)lds_raw, (int)gridDim.x);
}
constexpr int LDS_BAR_OFF = LDS_BYTES - 16;
template <int PH>
__device__ __forceinline__ void run_from(const Params& p, LAS unsigned char* lds, int G, const XcdBarrier& bar) {
#if PROBE_PH >= 0
    unsigned long long pt0 = 0; if constexpr (PH == PROBE_PH) pt0 = __builtin_amdgcn_s_memrealtime();
#endif
    run_phase<PH>(p, lds, G);
    if constexpr (PH + 1 < N_PHASES) {
        if constexpr (PH == 0) cg::this_grid().sync();
        else xcd_barrier(bar);
    }
#if PROBE_PH >= 0
    if constexpr (PH == PROBE_PH) { const unsigned long long pt1 = __builtin_amdgcn_s_memrealtime(), span = pt1 - pt0;
        while (__builtin_amdgcn_s_memrealtime() - pt1 < (unsigned long long)PROBE_MULT * span) __builtin_amdgcn_s_sleep(8); }
#endif
    if constexpr (PH + 1 < N_PHASES) run_from<PH + 1>(p, lds, G, bar);
}
__global__ void __launch_bounds__(NTHR, 2) k_mega(Params p) {
    extern __shared__ __attribute__((aligned(16))) unsigned char lds_raw[];
    LAS unsigned char* lds = (LAS unsigned char*)lds_raw;
    if (threadIdx.x < 4) ((LAS unsigned*)(lds + LDS_BAR_OFF))[threadIdx.x] = 0u;
    __syncthreads();
    const XcdBarrier bar = xcd_barrier_post((unsigned*)(p.ws + WS_CTL), (volatile LAS unsigned*)(lds + LDS_BAR_OFF));
    run_from<0>(p, lds, (int)gridDim.x, bar);
}

extern "C" void kernel_launch(void* const* d_in, const int* in_sizes, int n_in, void* d_out, int out_size, void* d_ws, size_t ws_size, hipStream_t stream) {
    static int grid = 0;
    if (grid == 0) {
        if (n_in != 24 || in_sizes[0] != T * DM || out_size != T * DM || ws_size < WS_END) {
            fprintf(stderr, "kernel_launch: unexpected shapes: n_in %d in0 %d out %d ws %zu\n", n_in, n_in > 0 ? in_sizes[0] : -1, out_size, ws_size); grid = -1; return; }
        int dev = 0, cus = 0, per_cu = 0;
        if (hipGetDevice(&dev) != hipSuccess || hipDeviceGetAttribute(&cus, hipDeviceAttributeMultiprocessorCount, dev) != hipSuccess) { grid = -1; return; }
        if (hipFuncSetAttribute((const void*)k_mega, hipFuncAttributeMaxDynamicSharedMemorySize, LDS_BYTES) != hipSuccess) { fprintf(stderr, "kernel_launch: hipFuncSetAttribute failed\n"); grid = -1; return; }
        if (hipOccupancyMaxActiveBlocksPerMultiprocessor(&per_cu, (const void*)k_mega, NTHR, LDS_BYTES) != hipSuccess || per_cu < 1) { fprintf(stderr, "kernel_launch: occupancy query says %d blocks per CU\n", per_cu); grid = -1; return; }
        (void)hipGetLastError();
        grid = cus;
    }
    if (grid < 0) return;
    Params p{};
    const float** pp = (const float**)&p;
    for (int i = 0; i < 24; ++i) pp[i] = (const float*)d_in[i];
    p.out = (float*)d_out; p.ws = (unsigned char*)d_ws;
    if (hipMemsetAsync((char*)d_ws + WS_CTL, 0, 65536, stream) != hipSuccess) { fprintf(stderr, "kernel_launch: hipMemsetAsync failed\n"); return; }
    void* args[] = {&p};
    hipError_t e = hipLaunchCooperativeKernel((const void*)k_mega, dim3(grid), dim3(NTHR), args, LDS_BYTES, stream);
    if (e != hipSuccess) fprintf(stderr, "kernel_launch: cooperative launch failed: %s (grid %d)\n", hipGetErrorString(e), grid);
}
```

```cpp
#include <hip/hip_runtime.h>
#include <hip/hip_cooperative_groups.h>
#include <cstdio>
#include <cstdint>
#include <utility>
namespace cg = cooperative_groups;

namespace pg8 {
#define PG8_LAS __attribute__((address_space(3)))
typedef unsigned short bf16_t;
typedef short bf16x8 __attribute__((ext_vector_type(8)));
typedef float f32x4 __attribute__((ext_vector_type(4)));
typedef unsigned u32x4 __attribute__((ext_vector_type(4)));
constexpr int BM = 256, BK = 64, HALF = 128, HTB = HALF * BK * 2  , STAGE_BYTES = 8 * HTB, NXCD = 8;

__host__ __device__ __forceinline__ int lds_byte(int r, int c) { const int st = (r >> 4) * 2 + (c >> 5), rr = r & 15, cc = c & 31, ob = rr * 64 + cc * 2; return st * 1024 + (ob ^ (((ob >> 9) & 1) << 5)); }
__host__ __device__ __forceinline__ void stage_rc(int b, int& R, int& C) { const int st = b / 1024, sb = b % 1024, swz = sb ^ (((sb >> 9) & 1) << 5); R = (st >> 1) * 16 + swz / 64; C = (st & 1) * 32 + (swz % 64) / 2; }
__host__ __device__ __forceinline__ int perm32(int rho) { const int n = rho >> 4, i = rho & 15; return 8 * (i >> 2) + 4 * n + (i & 3); }

struct Unit { int pm, pn; };
struct Gemm { const bf16_t* A; const bf16_t* Bt; int M, N, K, lda; };
template <int AMODE> __device__ __forceinline__ size_t a_off_bytes(const Gemm& g, const Unit& u) {
    const int ac = AMODE == 0 ? 0 : (AMODE == 1 ? 128 * (u.pn < 6 ? u.pn : 6) : 256 * u.pn);
    return ((size_t)u.pm * BM * (size_t)g.lda + (size_t)ac) * 2;
}

struct StaticOrder {
    int nM, nN, nwg, G, c, WGM;
    __host__ __device__ void init(int M, int N, int G_, int c_, int wgm = 4) { nM = M / BM; nN = N / BM; nwg = nM * nN; G = G_; c = c_; WGM = wgm; }
    __host__ __device__ bool next(int i, Unit& u) const {
        const long L = (long)i * G + c; if (L >= nwg) return false;
        int wgid = (int)L; { const int q = nwg / NXCD, r = nwg % NXCD, xcd = wgid % NXCD, off = wgid / NXCD; wgid = (xcd < r ? xcd * (q + 1) : r * (q + 1) + (xcd - r) * q) + off; }
        const int nig = WGM * nN, gid = wgid / nig, fm = gid * WGM, gsz = (nM - fm) < WGM ? (nM - fm) : WGM;
        u.pm = fm + ((wgid % nig) % gsz); u.pn = (wgid % nig) / gsz; return true;
    }
    __device__ __forceinline__ void a_ready(const Unit&) const {}
    __device__ __forceinline__ void done(const Unit&) const {}
};

__device__ __forceinline__ unsigned cvt_pk_bf16(float lo, float hi) { unsigned r; asm volatile("v_cvt_pk_bf16_f32 %0, %1, %2" : "=v"(r) : "v"(lo), "v"(hi)); return r; }

template <class Epi, class Sched, bool ALIGN_EPI = false, bool SP2 = false, int AMODE = 0, int KC = 0, int LDAC = 0>
__device__ __forceinline__ void gemm_phase(PG8_LAS unsigned char* lds, const Gemm g, const Sched& S, const Epi& E) {
    const int tid = threadIdx.x, wid = __builtin_amdgcn_readfirstlane(tid >> 6), lane = tid & 63, wr = wid >> 2, wc = wid & 3, fr = lane & 15, fq = lane >> 4;
    const int K = KC ? KC : g.K, nt = K / BK; const int lda = LDAC ? LDAC : g.lda;
    unsigned voffA[2], voffB[2];
#pragma unroll
    for (int i = 0; i < 2; ++i) { int R, C; stage_rc(tid * 16 + i * 8192, R, C); const int Rb = Epi::PERM ? ((R & ~31) + perm32(R & 31)) : R;
        voffA[i] = (unsigned)(R * lda + C) * 2u; voffB[i] = (unsigned)(Rb * K + C) * 2u; }
    const size_t kstep = (size_t)(BK * 2);
    const size_t hstepA = (size_t)HALF * lda * 2;
    const size_t hstepB = (size_t)HALF * K * 2;
    const size_t tstepB = 2 * hstepB;
    const unsigned ldsw = (unsigned)wid * 1024u;
    const int aoff = lds_byte(wr * 64 + fr, fq * 8), boff = lds_byte(wc * 32 + fr, fq * 8);
#define PG8_SA(b, h) (((b) * 2 + (h)) * HTB)
#define PG8_SB(b, h) ((4 + (b) * 2 + (h)) * HTB)
#define PG8_STAGE(bufoff, gbase, voff) do { _Pragma("unroll") for (int _i = 0; _i < 2; ++_i) \
        __builtin_amdgcn_global_load_lds((const unsigned*)((const char*)(gbase) + (voff)[_i]), (PG8_LAS unsigned*)(lds + (bufoff) + ldsw + _i * 8192), 16, 0, 0); } while (0)
#define PG8_LDA(dst, b, h) do { _Pragma("unroll") for (int m = 0; m < 4; ++m) _Pragma("unroll") for (int k = 0; k < 2; ++k) dst[m][k] = *(const PG8_LAS bf16x8*)(lds + PG8_SA(b, h) + aoff + m * 2048 + k * 1024); } while (0)
#define PG8_LDB(dst, b, h) do { _Pragma("unroll") for (int n = 0; n < 2; ++n) _Pragma("unroll") for (int k = 0; k < 2; ++k) dst[n][k] = *(const PG8_LAS bf16x8*)(lds + PG8_SB(b, h) + boff + n * 2048 + k * 1024); } while (0)
#define PG8_MMA(ai, bj, At, Bt) do { __builtin_amdgcn_s_setprio(1); _Pragma("unroll") for (int m = 0; m < 4; ++m) _Pragma("unroll") for (int n = 0; n < 2; ++n) _Pragma("unroll") for (int k = 0; k < 2; ++k) \
        acc[ai][bj][m][n] = __builtin_amdgcn_mfma_f32_16x16x32_bf16(Bt[n][k], At[m][k], acc[ai][bj][m][n], 0, 0, 0); __builtin_amdgcn_s_setprio(0); } while (0)
#define PG8_WAIT_V(n) asm volatile("s_waitcnt vmcnt(" #n ")" ::: "memory")
#define PG8_WAIT_L(n) asm volatile("s_waitcnt lgkmcnt(" #n ")" ::: "memory")
#define PG8_BAR __builtin_amdgcn_s_barrier()
#define PG8_SCHED __builtin_amdgcn_sched_barrier(0)
    Unit cur, nxt; int ui = 0;
    if (!S.next(0, cur)) return;
    f32x4 acc[2][2][4][2];
#pragma unroll
    for (int a = 0; a < 2; ++a)
#pragma unroll
        for (int b = 0; b < 2; ++b)
#pragma unroll
            for (int m = 0; m < 4; ++m)
#pragma unroll
                for (int n = 0; n < 2; ++n) acc[a][b][m][n] = (f32x4){0.f, 0.f, 0.f, 0.f};
    bf16x8 At[4][2], B0[2][2], B1[2][2];
    const char* cA = (const char*)g.A + a_off_bytes<AMODE>(g, cur); const char* cB = (const char*)g.Bt + (size_t)cur.pn * tstepB;
    S.a_ready(cur);
    if constexpr (SP2) {
        PG8_STAGE(PG8_SB(0, 0), cB, voffB); PG8_STAGE(PG8_SB(0, 1), cB + hstepB, voffB); PG8_STAGE(PG8_SA(0, 0), cA, voffA); PG8_STAGE(PG8_SA(0, 1), cA + hstepA, voffA);
        if (wr == 1) PG8_BAR;
        PG8_WAIT_V(2); PG8_BAR;
        PG8_STAGE(PG8_SB(1, 0), cB + kstep, voffB); PG8_STAGE(PG8_SA(1, 0), cA + kstep, voffA); PG8_STAGE(PG8_SB(1, 1), cB + hstepB + kstep, voffB);
        PG8_WAIT_V(6); PG8_BAR;
    } else {
        PG8_STAGE(PG8_SB(0, 0), cB, voffB); PG8_STAGE(PG8_SA(0, 0), cA, voffA); PG8_STAGE(PG8_SB(0, 1), cB + hstepB, voffB); PG8_STAGE(PG8_SA(0, 1), cA + hstepA, voffA);
        if (wr == 1) PG8_BAR;
        PG8_WAIT_V(4); PG8_BAR;
        PG8_STAGE(PG8_SB(1, 0), cB + kstep, voffB); PG8_STAGE(PG8_SA(1, 0), cA + kstep, voffA); PG8_STAGE(PG8_SB(1, 1), cB + hstepB + kstep, voffB);
        PG8_WAIT_V(6); PG8_BAR;
    }
    for (;;) {
        const bool has_next = S.next(ui + 1, nxt);
        const char* nA = has_next ? (const char*)g.A + a_off_bytes<AMODE>(g, nxt) : cA; const char* nB = has_next ? (const char*)g.Bt + (size_t)nxt.pn * tstepB : cB;
#pragma unroll 1
        for (int t = 0; t < nt; t += 2) {
            const bool last = (t == nt - 2);
            const char* a1 = cA + (size_t)(t + 1) * kstep;
            const char* a2 = last ? nA : cA + (size_t)(t + 2) * kstep; const char* b2 = last ? nB : cB + (size_t)(t + 2) * kstep;
            const char* a3 = a2 + kstep; const char* b3 = b2 + kstep;
            if (last && has_next) S.a_ready(nxt);
            if constexpr (SP2) {
            PG8_LDB(B0, 0, 0); PG8_LDB(B1, 0, 1); PG8_SCHED; PG8_LDA(At, 0, 0); PG8_STAGE(PG8_SA(1, 1), a1 + hstepA, voffA);
            PG8_WAIT_V(8); PG8_WAIT_L(0); PG8_BAR; PG8_MMA(0, 0, At, B0); PG8_MMA(0, 1, At, B1); PG8_BAR; PG8_SCHED;
            PG8_LDA(At, 0, 1); PG8_STAGE(PG8_SB(0, 0), b2, voffB); PG8_STAGE(PG8_SB(0, 1), b2 + hstepB, voffB); PG8_STAGE(PG8_SA(0, 0), a2, voffA);
            PG8_WAIT_V(8); PG8_WAIT_L(0); PG8_BAR; PG8_MMA(1, 0, At, B0); PG8_MMA(1, 1, At, B1); PG8_BAR; PG8_SCHED;
            PG8_LDB(B0, 1, 0); PG8_LDB(B1, 1, 1); PG8_SCHED; PG8_LDA(At, 1, 0); PG8_STAGE(PG8_SA(0, 1), a2 + hstepA, voffA);
            PG8_WAIT_V(8); PG8_WAIT_L(0); PG8_BAR; PG8_MMA(0, 0, At, B0); PG8_MMA(0, 1, At, B1); PG8_BAR; PG8_SCHED;
            PG8_LDA(At, 1, 1); PG8_STAGE(PG8_SB(1, 0), b3, voffB); PG8_STAGE(PG8_SB(1, 1), b3 + hstepB, voffB); PG8_STAGE(PG8_SA(1, 0), a3, voffA);
            PG8_WAIT_V(8); PG8_WAIT_L(0); PG8_BAR; PG8_MMA(1, 0, At, B0); PG8_MMA(1, 1, At, B1); PG8_BAR; PG8_SCHED;
            } else {
            PG8_LDB(B0, 0, 0); PG8_SCHED; PG8_LDA(At, 0, 0); PG8_STAGE(PG8_SA(1, 1), a1 + hstepA, voffA);
            PG8_WAIT_L(8); PG8_BAR; PG8_WAIT_L(0); PG8_MMA(0, 0, At, B0); PG8_BAR; PG8_SCHED;
            PG8_LDB(B1, 0, 1); PG8_STAGE(PG8_SB(0, 0), b2, voffB);
            PG8_BAR; PG8_WAIT_L(0); PG8_MMA(0, 1, At, B1); PG8_BAR;
            PG8_LDA(At, 0, 1); PG8_STAGE(PG8_SA(0, 0), a2, voffA);
            PG8_BAR; PG8_WAIT_L(0); PG8_MMA(1, 0, At, B0); PG8_BAR; PG8_SCHED;
            PG8_STAGE(PG8_SB(0, 1), b2 + hstepB, voffB);
            PG8_WAIT_V(6); PG8_BAR; PG8_MMA(1, 1, At, B1); PG8_BAR;
            PG8_LDB(B0, 1, 0); PG8_SCHED; PG8_LDA(At, 1, 0); PG8_STAGE(PG8_SA(0, 1), a2 + hstepA, voffA);
            PG8_WAIT_L(8); PG8_BAR; PG8_WAIT_L(0); PG8_MMA(0, 0, At, B0); PG8_BAR; PG8_SCHED;
            PG8_LDB(B1, 1, 1); PG8_STAGE(PG8_SB(1, 0), b3, voffB);
            PG8_BAR; PG8_WAIT_L(0); PG8_MMA(0, 1, At, B1); PG8_BAR;
            PG8_LDA(At, 1, 1); PG8_STAGE(PG8_SA(1, 0), a3, voffA);
            PG8_BAR; PG8_WAIT_L(0); PG8_MMA(1, 0, At, B0); PG8_BAR; PG8_SCHED;
            PG8_STAGE(PG8_SB(1, 1), b3 + hstepB, voffB);
            PG8_WAIT_V(6); PG8_BAR; PG8_MMA(1, 1, At, B1); PG8_BAR;
            }
        }
        if constexpr (ALIGN_EPI) { if (wr == 0) PG8_BAR; }
        E(acc, cur, wr, wc, fr, fq); S.done(cur);
        if (!has_next) break;
#pragma unroll
        for (int a = 0; a < 2; ++a)
#pragma unroll
            for (int b = 0; b < 2; ++b)
#pragma unroll
                for (int m = 0; m < 4; ++m)
#pragma unroll
                    for (int n = 0; n < 2; ++n) acc[a][b][m][n] = (f32x4){0.f, 0.f, 0.f, 0.f};
        cur = nxt; cA = nA; cB = nB; ++ui;
        if constexpr (ALIGN_EPI) { if (wr == 1) PG8_BAR; }
    }
    PG8_WAIT_V(0);
    if constexpr (!ALIGN_EPI) { if (wr == 0) PG8_BAR; }
    PG8_BAR;
#undef PG8_SA
#undef PG8_SB
#undef PG8_STAGE
#undef PG8_LDA
#undef PG8_LDB
#undef PG8_MMA
#undef PG8_WAIT_V
#undef PG8_WAIT_L
#undef PG8_BAR
#undef PG8_SCHED
}
}

constexpr int NB = 8, SEQ = 8192, DM = 1024, T = NB * SEQ;
constexpr int NPAD = 7424;
constexpr int NWAVES = 8, NTHR = 512;
constexpr int LDS_BYTES = 147456;
constexpr int N_PHASES = 10;
#define PROBE_PH -1
#define PROBE_MULT 3

constexpr size_t MiB = 1ull << 20;
constexpr size_t WS_CTL = 0;
constexpr size_t WS_MODP = 1 * MiB;
constexpr size_t WS_WIN = 3 * MiB;
constexpr size_t WS_WOUT = 18 * MiB;
constexpr size_t WS_WQ = 20 * MiB;
constexpr size_t WS_WQB = 480 * MiB;
constexpr size_t WS_LRUB = 24 * MiB;
constexpr size_t WS_SUBK = 25 * MiB;
constexpr size_t WS_LRUC = 26 * MiB;
constexpr size_t WS_U = 32 * MiB;
constexpr size_t WS_V = 48 * MiB;
constexpr size_t WS_SU = 64 * MiB;
constexpr size_t WS_SV = 65 * MiB;
constexpr size_t WS_SS = 30 * MiB;
constexpr size_t WS_DK = 66 * MiB;
constexpr size_t WS_QKV = 96 * MiB;
constexpr size_t WS_R = 352 * MiB;
constexpr size_t WS_XLXG = 480 * MiB;
constexpr size_t WS_GAGB = 736 * MiB;
constexpr size_t WS_ALOW = 992 * MiB;
constexpr size_t WS_END = 994 * MiB;
constexpr size_t WS_Y = WS_QKV;
constexpr size_t WS_H2 = WS_QKV + 128 * MiB;
constexpr size_t WS_QRY = WS_XLXG;
constexpr size_t WS_SC = WS_GAGB;
constexpr size_t WS_TOPK = WS_R;
constexpr size_t WS_TOPK2 = WS_R + 32 * MiB;

#define LAS __attribute__((address_space(3)))
typedef unsigned short bf16;
typedef float f32x4 __attribute__((ext_vector_type(4)));
typedef float f32x2 __attribute__((ext_vector_type(2)));
typedef unsigned u32x4 __attribute__((ext_vector_type(4)));
typedef unsigned u32x2 __attribute__((ext_vector_type(2)));

struct Params {
    const float *x, *c, *w_ada, *b_ada, *npm, *npo, *w_in, *w_alpha, *b_alpha, *gla_norm, *conv_w, *conv_b,
        *lwa, *lba, *lwx, *lbx, *lam, *w_out, *npf, *npof, *wq, *subk, *pu, *pv;
    float* out; unsigned char* ws;
    int ph_lo, ph_hi;
};

__device__ __forceinline__ unsigned pk2(float lo, float hi) { unsigned r; asm("v_cvt_pk_bf16_f32 %0, %1, %2" : "=v"(r) : "v"(lo), "v"(hi)); return r; }
__device__ __forceinline__ unsigned f2bf(float f) { return pk2(f, f) & 0xffffu; }
__device__ __forceinline__ float bflo(unsigned u) { return __builtin_bit_cast(float, u << 16); }
__device__ __forceinline__ float bfhi(unsigned u) { return __builtin_bit_cast(float, u & 0xffff0000u); }
__device__ __forceinline__ float bf2f(bf16 h) { return __builtin_bit_cast(float, (unsigned)h << 16); }
__device__ __forceinline__ float sigmoid_f(float x) { return __builtin_amdgcn_rcpf(1.f + __expf(-x)); }
__device__ __forceinline__ float silu_f(float x) { return x * __builtin_amdgcn_rcpf(1.f + __expf(-x)); }
__device__ __forceinline__ float gelu_f(float x) { const float u = 0.7978845608028654f * (x + 0.044715f * x * x * x); return x * __builtin_amdgcn_rcpf(1.f + __expf(-2.f * u)); }
__device__ __forceinline__ float softplus_f(float x) { return fmaxf(x, 0.f) + log1pf(__expf(-fabsf(x))); }
__device__ __forceinline__ float wave_sum(float v) {
#pragma unroll
    for (int o = 1; o < 64; o <<= 1) v += __shfl_xor(v, o);
    return v;
}
__device__ __forceinline__ float merge2(float ga, float on, float r, float gb, float hl, float xg) {
    const float u = 0.7978845608028654f * (xg + 0.044715f * xg * xg * xg);
    const float d1 = (1.f + __expf(-ga)) * (1.f + __expf(-r)), d2 = (1.f + __expf(-gb)) * (1.f + __expf(-2.f * u));
    return on * r * __builtin_amdgcn_rcpf(d1) + hl * xg * __builtin_amdgcn_rcpf(d2);
}
#define LDS_WAIT() asm volatile("s_waitcnt lgkmcnt(0)" ::: "memory")

struct EpiSeg {
    static constexpr bool PERM = true;
    unsigned char* ws;
    __device__ __forceinline__ void operator()(const pg8::f32x4 (&acc)[2][2][4][2], const pg8::Unit& u, int wr, int wc, int fr, int fq) const {
        const int pn = u.pn; bf16* base; int ldc, colt;
        if (pn < 8) { base = (bf16*)(ws + WS_QKV); ldc = 2048; colt = pn * 256; }
        else if (pn < 12) { base = (bf16*)(ws + WS_R); ldc = 1024; colt = (pn - 8) * 256; }
        else if (pn < 20) { base = (bf16*)(ws + WS_XLXG); ldc = 2048; colt = (pn - 12) * 256; }
        else if (pn < 28) { base = (bf16*)(ws + WS_GAGB); ldc = 2048; colt = (pn - 20) * 256; }
        else { base = (bf16*)(ws + WS_ALOW); ldc = 16; colt = 0; }
        const int row0 = u.pm * 256 + wr * 64 + fr, col0 = colt + wc * 32 + 8 * fq;
        const bool tail = (pn == 28);
#pragma unroll
        for (int ai = 0; ai < 2; ++ai)
#pragma unroll
            for (int m = 0; m < 4; ++m) { bf16* rowp = base + (size_t)(row0 + ai * 128 + m * 16) * ldc + col0;
#pragma unroll
                for (int bj = 0; bj < 2; ++bj) { const pg8::f32x4 v0 = acc[ai][bj][m][0], v1 = acc[ai][bj][m][1];
                    u32x4 w; w.x = pg8::cvt_pk_bf16(v0[0], v0[1]); w.y = pg8::cvt_pk_bf16(v0[2], v0[3]); w.z = pg8::cvt_pk_bf16(v1[0], v1[1]); w.w = pg8::cvt_pk_bf16(v1[2], v1[3]);
                    if (!tail || (bj == 0 && wc == 0 && fq < 2)) *(u32x4*)(rowp + bj * 128) = w; } }
    }
};
struct EpiPlain {
    static constexpr bool PERM = true;
    bf16* O; int ldc;
    __device__ __forceinline__ void operator()(const pg8::f32x4 (&acc)[2][2][4][2], const pg8::Unit& u, int wr, int wc, int fr, int fq) const {
        const int row0 = u.pm * 256 + wr * 64 + fr, col0 = u.pn * 256 + wc * 32 + 8 * fq;
#pragma unroll
        for (int ai = 0; ai < 2; ++ai)
#pragma unroll
            for (int m = 0; m < 4; ++m) { bf16* rowp = O + (size_t)(row0 + ai * 128 + m * 16) * ldc + col0;
#pragma unroll
                for (int bj = 0; bj < 2; ++bj) { const pg8::f32x4 v0 = acc[ai][bj][m][0], v1 = acc[ai][bj][m][1];
                    u32x4 w; w.x = pg8::cvt_pk_bf16(v0[0], v0[1]); w.y = pg8::cvt_pk_bf16(v0[2], v0[3]); w.z = pg8::cvt_pk_bf16(v1[0], v1[1]); w.w = pg8::cvt_pk_bf16(v1[2], v1[3]);
                    *(u32x4*)(rowp + bj * 128) = w; } }
    }
};
typedef _Float16 h16x2 __attribute__((ext_vector_type(2)));
__device__ __forceinline__ unsigned pkh(float a, float b) { return __builtin_bit_cast(unsigned, __builtin_amdgcn_cvt_pkrtz(a, b)); }
struct EpiF16 {
    static constexpr bool PERM = true;
    unsigned short* O; int ldc;
    __device__ __forceinline__ void operator()(const pg8::f32x4 (&acc)[2][2][4][2], const pg8::Unit& u, int wr, int wc, int fr, int fq) const {
        const int row0 = u.pm * 256 + wr * 64 + fr, col0 = u.pn * 256 + wc * 32 + 8 * fq;
#pragma unroll
        for (int ai = 0; ai < 2; ++ai)
#pragma unroll
            for (int m = 0; m < 4; ++m) { unsigned short* rowp = O + (size_t)(row0 + ai * 128 + m * 16) * ldc + col0;
#pragma unroll
                for (int bj = 0; bj < 2; ++bj) { const pg8::f32x4 v0 = acc[ai][bj][m][0], v1 = acc[ai][bj][m][1];
                    u32x4 w; w.x = pkh(v0[0], v0[1]); w.y = pkh(v0[2], v0[3]); w.z = pkh(v1[0], v1[1]); w.w = pkh(v1[2], v1[3]);
                    *(u32x4*)(rowp + bj * 128) = w; } }
    }
};
struct EpiTrans {
    static constexpr bool PERM = true;
    bf16* O; int ldc;
    __device__ __forceinline__ void operator()(const pg8::f32x4 (&acc)[2][2][4][2], const pg8::Unit& u, int wr, int wc, int fr, int fq) const {
        const int row0 = u.pm * 256 + wr * 64 + fr, col0 = u.pn * 256 + wc * 32 + 8 * fq;
#pragma unroll
        for (int ai = 0; ai < 2; ++ai)
#pragma unroll
            for (int m = 0; m < 4; ++m) { const int row = row0 + ai * 128 + m * 16;
#pragma unroll
                for (int bj = 0; bj < 2; ++bj)
#pragma unroll
                    for (int n = 0; n < 2; ++n)
#pragma unroll
                        for (int e = 0; e < 4; ++e) O[(size_t)(col0 + bj * 128 + 4 * n + e) * ldc + row] = (bf16)f2bf(acc[ai][bj][m][n][e]); }
    }
};

__device__ __forceinline__ void p0_transpose_item(const float* W, int ldw, int k0, int n0, int nvalid, bf16* WT, int ldk, int row0, int kc0, LAS float* scr, int lane) {
#pragma unroll 8
    for (int i = 0; i < 32; ++i) { const int kk = 2 * i + (lane >> 5), cc = lane & 31; scr[kk * 33 + cc] = (cc < nvalid) ? W[(size_t)(k0 + kk) * ldw + n0 + cc] : 0.f; }
    LDS_WAIT(); asm volatile("" ::: "memory");
    const int c = lane & 7;
#pragma unroll
    for (int j = 0; j < 4; ++j) { const int n = (lane >> 3) + 8 * j; const LAS float* s = scr + (8 * c) * 33 + n;
        u32x4 o; o.x = pk2(s[0 * 33], s[1 * 33]); o.y = pk2(s[2 * 33], s[3 * 33]); o.z = pk2(s[4 * 33], s[5 * 33]); o.w = pk2(s[6 * 33], s[7 * 33]);
        *(u32x4*)(WT + (size_t)(row0 + n) * ldk + kc0 + k0 + 8 * c) = o; }
    LDS_WAIT(); asm volatile("" ::: "memory");
}
__device__ __forceinline__ void phase0(const Params& p, LAS unsigned char* lds, int G) {
    const int tid = threadIdx.x, lane = tid & 63, wave = __builtin_amdgcn_readfirstlane(tid >> 6);
    unsigned char* ws = p.ws;
    {
        LAS float* sc = (LAS float*)lds;
        LAS float* red = (LAS float*)(lds + 4096);
        float* modp = (float*)(ws + WS_MODP);
        for (int it = blockIdx.x; it < 24 * 8; it += G) {
            const int nb = it % 24, kc = it / 24;
            for (int i = tid; i < 1024; i += NTHR) { const int b = i >> 7, k = i & 127; sc[i] = silu_f(p.c[b * 1024 + kc * 128 + k]); }
            __syncthreads();
            const int col = tid & 255, kh = tid >> 8;
            float acc[8];
#pragma unroll
            for (int b = 0; b < 8; ++b) acc[b] = 0.f;
            const float* wp = p.w_ada + (size_t)(kc * 128 + kh * 64) * 6144 + nb * 256 + col;
#pragma unroll 8
            for (int kk = 0; kk < 64; ++kk) { const float w = wp[(size_t)kk * 6144];
#pragma unroll
                for (int b = 0; b < 8; ++b) acc[b] += sc[b * 128 + kh * 64 + kk] * w; }
            if (kh == 1) {
#pragma unroll
                for (int b = 0; b < 8; ++b) red[b * 256 + col] = acc[b]; }
            __syncthreads();
            if (kh == 0) { const int n = nb * 256 + col; const float bias = (kc == 0) ? p.b_ada[n] : 0.f;
#pragma unroll
                for (int b = 0; b < 8; ++b) modp[(size_t)(kc * 8 + b) * 6144 + n] = acc[b] + red[b * 256 + col] + bias; }
            __syncthreads();
        }
    }
    for (int i = blockIdx.x * NTHR + tid; i < T * 4 / 4; i += G * NTHR) ((f32x4*)(ws + WS_SS))[i] = (f32x4){0.f, 0.f, 0.f, 0.f};
    LAS float* scr = (LAS float*)(lds + 16384 + wave * 8448);
    const int gw = blockIdx.x * NWAVES + wave, NGW = G * NWAVES;
    bf16* WinT = (bf16*)(ws + WS_WIN); bf16* WoutT = (bf16*)(ws + WS_WOUT);
    bf16* LruB = (bf16*)(ws + WS_LRUB); bf16* SubK = (bf16*)(ws + WS_SUBK);
    constexpr int I_IN = 16 * (NPAD / 32), I_OUT = 16 * 32, I_Q = 2048, I_LRU = 16 * 8, I_SUB = 2048;
    constexpr int NIT = I_IN + I_OUT + I_Q + I_LRU + I_SUB;
    for (int it = gw; it < NIT; it += NGW) {
        int r = it;
        if (r < I_IN) { const int nb = r % (NPAD / 32), kb = r / (NPAD / 32), nq = nb * 32; int n0, nv;
            if (nq < 3072) { n0 = nq; nv = 32; } else if (nq < 7168) { n0 = nq + 16; nv = 32; } else if (nq == 7168) { n0 = 3072; nv = 16; } else { n0 = 0; nv = 0; }
            p0_transpose_item(p.w_in, 7184, kb * 64, n0, nv, WinT, 1024, nq, 0, scr, lane); continue; } r -= I_IN;
        if (r < I_OUT) { const int nb = r % 32, kb = r / 32; p0_transpose_item(p.w_out, 1024, kb * 64, nb * 32, 32, WoutT, 1024, nb * 32, 0, scr, lane); continue; } r -= I_OUT;
        if (r < I_Q) {
            const float* src = p.wq + (size_t)r * 1024; bf16* dst = (bf16*)(ws + WS_WQB) + (size_t)r * 1024;
#pragma unroll
            for (int j = 0; j < 2; ++j) { const f32x4 a = *(const f32x4*)(src + j * 512 + lane * 8), b = *(const f32x4*)(src + j * 512 + lane * 8 + 4);
                u32x4 o; o.x = pk2(a.x, a.y); o.y = pk2(a.z, a.w); o.z = pk2(b.x, b.y); o.w = pk2(b.z, b.w);
                *(u32x4*)(dst + j * 512 + lane * 8) = o; }
            continue; } r -= I_Q;
        if (r < I_LRU) {
            const int mat = r >> 3, sub = r & 7, g = mat >> 3, n = mat & 7, kb = sub >> 2, nb = sub & 3;
            const int np = n < 6 ? n : 6, half = n - np;
            const float* W = (g ? p.lwx : p.lwa) + (size_t)n * 128 * 128;
            bf16* dst = LruB + (size_t)n * 256 * 256;
            p0_transpose_item(W, 128, kb * 64, nb * 32, 32, dst, 256, g * 128 + nb * 32, half * 128, scr, lane);
            p0_transpose_item(W, 128, kb * 64, 0, 0, dst, 256, g * 128 + nb * 32, (1 - half) * 128, scr, lane);
            continue; } r -= I_LRU;
        if (r < I_SUB) {
            const int h = r >> 8, pp = (r >> 7) & 1, n = r & 127;
            const float* src = p.subk + (size_t)r * 128; bf16* dst = SubK + ((size_t)h * 256 + pp * 128 + n) * 256;
            const f32x2 v = *(const f32x2*)(src + 2 * lane);
            *(unsigned*)(dst + pp * 128 + 2 * lane) = pk2(v.x, v.y);
            *(unsigned*)(dst + (1 - pp) * 128 + 2 * lane) = 0u;
            continue; } r -= I_SUB;
    }
}

__device__ __forceinline__ void convert_tables(const Params& p, int gw, int ngw, int lane) {
    unsigned char* ws = p.ws;
    for (int r = gw; r < 2 * 16384; r += ngw) {
        {
            const int tb = r >> 14, row = r & 16383;
            const float* src = (tb ? p.pv : p.pu) + (size_t)row * 1024 + lane * 16;
            f32x4 v[4]; float am = 0.f;
#pragma unroll
            for (int j = 0; j < 4; ++j) { v[j] = *(const f32x4*)(src + 4 * j); am = fmaxf(am, fmaxf(fmaxf(fabsf(v[j].x), fabsf(v[j].y)), fmaxf(fabsf(v[j].z), fabsf(v[j].w)))); }
#pragma unroll
            for (int o = 1; o < 64; o <<= 1) am = fmaxf(am, __shfl_xor(am, o));
            const float inv = am > 0.f ? 7.5f / am : 0.f;
            unsigned long long lo = 0ull; unsigned hi = 0u;
#pragma unroll
            for (int j = 0; j < 16; ++j) { const float x = v[j >> 2][j & 3] * inv, a = fabsf(x);
                unsigned code = a < 1.f ? (unsigned)__builtin_rintf(a * 8.f) : (a < 2.f ? 8u + (unsigned)__builtin_rintf((a - 1.f) * 8.f) : (a < 4.f ? 16u + (unsigned)__builtin_rintf((a - 2.f) * 4.f) : 24u + (unsigned)__builtin_rintf((a - 4.f) * 2.f)));
                code = code > 31u ? 31u : code; code |= (x < 0.f) ? 32u : 0u;
                const int bit = 6 * j;
                if (bit + 6 <= 64) lo |= (unsigned long long)code << bit;
                else if (bit >= 64) hi |= code << (bit - 64);
                else { lo |= (unsigned long long)code << bit; hi |= code >> (64 - bit); } }
            unsigned* dst = (unsigned*)(ws + (tb ? WS_V : WS_U) + (size_t)row * 768 + lane * 12);
            dst[0] = (unsigned)lo; dst[1] = (unsigned)(lo >> 32); dst[2] = hi;
            if (lane == 0) ((float*)(ws + (tb ? WS_SV : WS_SU)))[row] = am * (1.f / 7.5f);
        }
    }
}

__device__ __forceinline__ float mod_at(const float* modp, int b, int n) {
    float s = 0.f;
#pragma unroll
    for (int kc = 0; kc < 8; ++kc) s += modp[(size_t)(kc * 8 + b) * 6144 + n];
    return s;
}

__device__ __forceinline__ void phase1(const Params& p, LAS unsigned char* lds, int G) {
    const int tid = threadIdx.x, lane = tid & 63, wave = __builtin_amdgcn_readfirstlane(tid >> 6);
    const float* modp = (const float*)(p.ws + WS_MODP);
    LAS float* gs = (LAS float*)lds; LAS float* sh = gs + 1024;
    bf16* H = (bf16*)p.out;
    for (int tile = blockIdx.x; tile < T / 256; tile += G) {
        const int b = tile / 32;
        __syncthreads();
        for (int k = tid; k < 1024; k += NTHR) { gs[k] = p.npm[k] * (1.f + mod_at(modp, b, 1024 + k)); sh[k] = mod_at(modp, b, k); }
        __syncthreads();
        for (int rr = 0; rr < 32; ++rr) {
            const size_t row = (size_t)tile * 256 + rr * 8 + wave;
            const f32x4* xr = (const f32x4*)(p.x + row * 1024) + lane;
            f32x4 v[4]; float s = 0.f;
#pragma unroll
            for (int j = 0; j < 4; ++j) { v[j] = xr[64 * j]; s += (v[j].x * v[j].x + v[j].y * v[j].y) + (v[j].z * v[j].z + v[j].w * v[j].w); }
            const float rstd = __builtin_amdgcn_rsqf(wave_sum(s) * (1.f / 1024.f) + 1e-6f);
            u32x2* o8 = (u32x2*)(H + row * 1024) + lane;
#pragma unroll
            for (int j = 0; j < 4; ++j) { const int k = 256 * j + 4 * lane; const f32x4 g4 = *(const LAS f32x4*)(gs + k), s4 = *(const LAS f32x4*)(sh + k);
                u32x2 w; w.x = pk2(v[j].x * rstd * g4.x + s4.x, v[j].y * rstd * g4.y + s4.y); w.y = pk2(v[j].z * rstd * g4.z + s4.z, v[j].w * rstd * g4.w + s4.w);
                o8[64 * j] = w; }
        }
    }
}

typedef short bf16x8_t __attribute__((ext_vector_type(8)));
template <bool FINAL>
__device__ __forceinline__ void phase_lru(const Params& p, LAS unsigned char* lds, int G) {
    const int tid = threadIdx.x, lane = tid & 63, wave = __builtin_amdgcn_readfirstlane(tid >> 6), q4 = lane >> 4, c16 = lane & 15;
    constexpr int PQ = 136;
    LAS bf16* XC = (LAS bf16*)lds;
    LAS bf16* HB = XC + 64 * PQ;
    LAS float* CW = (LAS float*)(HB + 64 * PQ);
    const bf16* XL = (const bf16*)(p.ws + WS_XLXG); const bf16* LruB = (const bf16*)(p.ws + WS_LRUB);
    const bf16* XG = (const bf16*)(p.ws + WS_XLXG) + 1024; const bf16* GB = (const bf16*)(p.ws + WS_GAGB) + 1024; bf16* GA = (bf16*)(p.ws + WS_GAGB);
    const bf16* O = (const bf16*)(p.ws + WS_QKV) + 1024; const bf16* R = (const bf16*)(p.ws + WS_R); const float* SS = (const float*)(p.ws + WS_SS);
    f32x2* CAR = (f32x2*)(p.ws + WS_LRUC);
    const int c8 = tid & 15, tr = tid >> 4;
    for (int it = blockIdx.x; it < 8 * 8 * 4; it += G) {
        const int sg = it & 3, n = (it >> 2) & 7, b = it >> 5;
        const int chc = n * 128 + c8 * 8;
        const int chm = n * 128 + wave * 16 + c16;
        __syncthreads();
        for (int i = tid; i < 768; i += NTHR) { const int q = i >> 7, c = i & 127; CW[i] = q < 4 ? p.conv_w[q * 1024 + n * 128 + c] : (q == 4 ? p.conv_b[n * 128 + c] : p.gla_norm[n * 128 + c]); }
        const float ba = p.lba[chm], bx = p.lbx[chm], sp = -8.f * softplus_f(-p.lam[chm]);
        bf16x8_t wf[2][4];
        { const int np = n < 6 ? n : 6, half = n - np;
#pragma unroll
          for (int g = 0; g < 2; ++g)
#pragma unroll
              for (int ks = 0; ks < 4; ++ks) wf[g][ks] = *(const bf16x8_t*)(LruB + (size_t)n * 65536 + (size_t)(g * 128 + wave * 16 + c16) * 256 + half * 128 + ks * 32 + q4 * 8); }
        float hc = 0.f, aseg = 1.f;
        if (FINAL) { for (int s = 0; s < 4 * sg; ++s) { const f32x2 c = CAR[(size_t)((b * 8 + n) * 12 + s) * 128 + wave * 16 + c16]; hc = c.x * hc + c.y; } }
        constexpr int NTL = FINAL ? 32 : 24;
        const size_t tseg = (size_t)b * SEQ + (size_t)sg * (NTL * 64);
        u32x4 xr[5];
#define LRU_LOADX(t0_) do { _Pragma("unroll") for (int _k = 0; _k < 5; ++_k) { const long _t = (long)(t0_) + 2 * tr + _k - 3; \
            xr[_k] = (_t < (long)b * SEQ) ? (u32x4){0u, 0u, 0u, 0u} : *(const u32x4*)(XL + (size_t)_t * 2048 + chc); } } while (0)
        LRU_LOADX(tseg);
        __syncthreads();
#pragma unroll 1
        for (int tl = 0; tl < NTL; ++tl) {
            const size_t t0 = tseg + tl * 64;
            { float xv[5][8];
#pragma unroll
              for (int k = 0; k < 5; ++k) { xv[k][0] = bflo(xr[k].x); xv[k][1] = bfhi(xr[k].x); xv[k][2] = bflo(xr[k].y); xv[k][3] = bfhi(xr[k].y); xv[k][4] = bflo(xr[k].z); xv[k][5] = bfhi(xr[k].z); xv[k][6] = bflo(xr[k].w); xv[k][7] = bfhi(xr[k].w); }
              float cw[5][8];
#pragma unroll
              for (int q = 0; q < 5; ++q) { const f32x4 w0 = *(const LAS f32x4*)(CW + q * 128 + c8 * 8), w1 = *(const LAS f32x4*)(CW + q * 128 + c8 * 8 + 4);
                  cw[q][0] = w0.x; cw[q][1] = w0.y; cw[q][2] = w0.z; cw[q][3] = w0.w; cw[q][4] = w1.x; cw[q][5] = w1.y; cw[q][6] = w1.z; cw[q][7] = w1.w; }
#pragma unroll
              for (int i2 = 0; i2 < 2; ++i2) { float o[8];
#pragma unroll
                  for (int j = 0; j < 8; ++j) o[j] = cw[4][j] + cw[0][j] * xv[i2][j] + cw[1][j] * xv[i2 + 1][j] + cw[2][j] * xv[i2 + 2][j] + cw[3][j] * xv[i2 + 3][j];
                  *(LAS u32x4*)(XC + (2 * tr + i2) * PQ + c8 * 8) = (u32x4){pk2(o[0], o[1]), pk2(o[2], o[3]), pk2(o[4], o[5]), pk2(o[6], o[7])}; } }
            u32x4 mxg[2], mgb[2], mo[2], mr[2], mga[2]; float mss[2];
            if (FINAL) {
#pragma unroll
                for (int i2 = 0; i2 < 2; ++i2) { const size_t t = t0 + 2 * tr + i2;
                    mxg[i2] = *(const u32x4*)(XG + t * 2048 + chc); mgb[i2] = *(const u32x4*)(GB + t * 2048 + chc); mo[i2] = *(const u32x4*)(O + t * 2048 + chc);
                    mr[i2] = *(const u32x4*)(R + t * 1024 + chc); mga[i2] = *(const u32x4*)(GA + t * 2048 + chc); mss[i2] = SS[t * 4 + (chc >> 8)]; } }
            if (tl + 1 < NTL) LRU_LOADX(t0 + 64);
            __syncthreads();
            pg8::f32x4 acc[4][2];
#pragma unroll
            for (int tt = 0; tt < 4; ++tt) { acc[tt][0] = (pg8::f32x4){0.f, 0.f, 0.f, 0.f}; acc[tt][1] = (pg8::f32x4){0.f, 0.f, 0.f, 0.f}; }
#pragma unroll
            for (int ks = 0; ks < 4; ++ks)
#pragma unroll
                for (int tt = 0; tt < 4; ++tt) { const bf16x8_t a = *(const LAS bf16x8_t*)(XC + (tt * 16 + c16) * PQ + ks * 32 + q4 * 8);
                    acc[tt][0] = __builtin_amdgcn_mfma_f32_16x16x32_bf16(a, wf[0][ks], acc[tt][0], 0, 0, 0);
                    acc[tt][1] = __builtin_amdgcn_mfma_f32_16x16x32_bf16(a, wf[1][ks], acc[tt][1], 0, 0, 0); }
#pragma unroll
            for (int tt = 0; tt < 4; ++tt) {
                float av[4], uv[4];
#pragma unroll
                for (int j = 0; j < 4; ++j) { const float xc = bf2f(XC[(tt * 16 + q4 * 4 + j) * PQ + wave * 16 + c16]);
                    const float gr = sigmoid_f(acc[tt][0][j] + ba), gi = sigmoid_f(acc[tt][1][j] + bx);
                    const float a = __expf(sp * gr); av[j] = a; uv[j] = __builtin_amdgcn_sqrtf(fmaxf(1.f - a * a, 0.f)) * gi * xc; }
                float A4 = av[0], H4 = uv[0];
#pragma unroll
                for (int j = 1; j < 4; ++j) { H4 = av[j] * H4 + uv[j]; A4 *= av[j]; }
                float Ai = A4, Hi = H4;
                { const float Ap = __shfl_up(Ai, 16), Hp = __shfl_up(Hi, 16); if (q4 >= 1) { Hi = Hp * Ai + Hi; Ai = Ap * Ai; } }
                { const float Ap = __shfl_up(Ai, 32), Hp = __shfl_up(Hi, 32); if (q4 >= 2) { Hi = Hp * Ai + Hi; Ai = Ap * Ai; } }
                float Ae = __shfl_up(Ai, 16), He = __shfl_up(Hi, 16); if (q4 == 0) { Ae = 1.f; He = 0.f; }
                float h = hc * Ae + He;
                const float At = __shfl(Ai, 48 + c16), Ht = __shfl(Hi, 48 + c16);
                if (FINAL) {
#pragma unroll
                    for (int j = 0; j < 4; ++j) { h = av[j] * h + uv[j]; HB[(tt * 16 + q4 * 4 + j) * PQ + wave * 16 + c16] = (bf16)f2bf(h); } }
                hc = hc * At + Ht; aseg *= At;
            }
            if (!FINAL && (tl & 7) == 7) {
                if (q4 == 0) CAR[(size_t)((b * 8 + n) * 12 + sg * 3 + (tl >> 3)) * 128 + wave * 16 + c16] = (f32x2){aseg, hc};
                hc = 0.f; aseg = 1.f; }
            __syncthreads();
            if (FINAL) {
#pragma unroll
                for (int i2 = 0; i2 < 2; ++i2) { const size_t t = t0 + 2 * tr + i2;
                    const u32x4 hw = *(const LAS u32x4*)(HB + (2 * tr + i2) * PQ + c8 * 8);
                    const float rstd = __builtin_amdgcn_rsqf(mss[i2] * (1.f / 256.f) + 1e-6f);
                    const unsigned hwv[4] = {hw.x, hw.y, hw.z, hw.w}, xgv[4] = {mxg[i2].x, mxg[i2].y, mxg[i2].z, mxg[i2].w}, gbv[4] = {mgb[i2].x, mgb[i2].y, mgb[i2].z, mgb[i2].w};
                    const unsigned ov[4] = {mo[i2].x, mo[i2].y, mo[i2].z, mo[i2].w}, rv[4] = {mr[i2].x, mr[i2].y, mr[i2].z, mr[i2].w}, gav[4] = {mga[i2].x, mga[i2].y, mga[i2].z, mga[i2].w};
                    unsigned ow[4];
                    const f32x4 g0 = *(const LAS f32x4*)(CW + 640 + c8 * 8), g1 = *(const LAS f32x4*)(CW + 640 + c8 * 8 + 4);
                    const float gn[8] = {g0.x, g0.y, g0.z, g0.w, g1.x, g1.y, g1.z, g1.w};
#pragma unroll
                    for (int q = 0; q < 4; ++q) {
                        const float m0 = merge2(bflo(gav[q]), bflo(ov[q]) * rstd * gn[2 * q], bflo(rv[q]), bflo(gbv[q]), bflo(hwv[q]), bflo(xgv[q]));
                        const float m1 = merge2(bfhi(gav[q]), bfhi(ov[q]) * rstd * gn[2 * q + 1], bfhi(rv[q]), bfhi(gbv[q]), bfhi(hwv[q]), bfhi(xgv[q]));
                        ow[q] = pk2(m0, m1); }
                    *(u32x4*)(GA + t * 2048 + chc) = (u32x4){ow[0], ow[1], ow[2], ow[3]}; }
            }
        }
#undef LRU_LOADX
        __syncthreads();
    }
}

__device__ __forceinline__ void phase_gla_prep(const Params& p, LAS unsigned char* lds, int G) {
    const int tid = threadIdx.x;
    LAS float* segt = (LAS float*)lds;
    bf16* QKV = (bf16*)(p.ws + WS_QKV); const bf16* AL = (const bf16*)(p.ws + WS_ALOW); float* DK = (float*)(p.ws + WS_DK);
    const int kp = tid & 127, seg = tid >> 7;
    for (int it = blockIdx.x; it < 8 * 128 * 4; it += G) {
        const int h = it & 3, ch = (it >> 2) & 127, b = it >> 9;
        float wa[16];
#pragma unroll
        for (int r = 0; r < 16; ++r) wa[r] = p.w_alpha[r * 512 + h * 128 + kp];
        const float balpha = p.b_alpha[h * 128 + kp];
        const size_t t0 = (size_t)b * SEQ + ch * 64 + seg * 16;
        float qv[16], kv[16];
#pragma unroll
        for (int i = 0; i < 16; ++i) { qv[i] = bf2f(QKV[(t0 + i) * 2048 + h * 128 + kp]); kv[i] = bf2f(QKV[(t0 + i) * 2048 + 512 + h * 128 + kp]); }
        float cl[16]; float run = 0.f;
#pragma unroll
        for (int i = 0; i < 16; ++i) { const size_t t = t0 + i;
            const u32x4 a0 = *(const u32x4*)(AL + t * 16), a1 = *(const u32x4*)(AL + t * 16 + 8);
            float z = balpha;
            z += bflo(a0.x) * wa[0] + bfhi(a0.x) * wa[1] + bflo(a0.y) * wa[2] + bfhi(a0.y) * wa[3] + bflo(a0.z) * wa[4] + bfhi(a0.z) * wa[5] + bflo(a0.w) * wa[6] + bfhi(a0.w) * wa[7];
            z += bflo(a1.x) * wa[8] + bfhi(a1.x) * wa[9] + bflo(a1.y) * wa[10] + bfhi(a1.y) * wa[11] + bflo(a1.z) * wa[12] + bfhi(a1.z) * wa[13] + bflo(a1.w) * wa[14] + bfhi(a1.w) * wa[15];
            const float ls = fminf(z, 0.f) - __logf(1.f + __expf(-fabsf(z)));
            run += ls * (1.f / 16.f); cl[i] = run; }
        __syncthreads();
        segt[seg * 128 + kp] = run;
        __syncthreads();
        float off = 0.f, tot = 0.f;
#pragma unroll
        for (int s = 0; s < 4; ++s) { const float v = segt[s * 128 + kp]; tot += v; if (s < seg) off += v; }
        if (seg == 0) DK[(size_t)(b * 128 + ch) * 512 + h * 128 + kp] = __expf(tot);
#pragma unroll
        for (int i = 0; i < 16; ++i) { const float cum = cl[i] + off;
            QKV[(t0 + i) * 2048 + h * 128 + kp] = (bf16)f2bf(qv[i] * 0.08838834764831845f * __expf(cum));
            QKV[(t0 + i) * 2048 + 512 + h * 128 + kp] = (bf16)f2bf(kv[i] * __expf(-cum)); }
    }
}
__device__ __forceinline__ bf16x8_t lds_col8(const LAS bf16* base, int pitch) {
    unsigned w[4];
#pragma unroll
    for (int i = 0; i < 4; ++i) w[i] = (unsigned)base[(2 * i) * pitch] | ((unsigned)base[(2 * i + 1) * pitch] << 16);
    return __builtin_bit_cast(bf16x8_t, (u32x4){w[0], w[1], w[2], w[3]});
}
__device__ __forceinline__ void phase_gla_seq(const Params& p, LAS unsigned char* lds, int G) {
    const int tid = threadIdx.x, lane = tid & 63, wave = __builtin_amdgcn_readfirstlane(tid >> 6), q4 = lane >> 4, c16 = lane & 15;
    constexpr int PQ = 136, PS = 72, PV = 34;
    LAS bf16* Qs = (LAS bf16*)lds;
    LAS bf16* Kd = Qs + 64 * PQ;
    LAS bf16* Vt = Kd + 64 * PQ;
    LAS bf16* Pm = Vt + 64 * PV + 64;
    LAS bf16* ST = Pm + 64 * PS;
    LAS float* dk = (LAS float*)(ST + 32 * PQ);
    const bf16* QKV = (const bf16*)(p.ws + WS_QKV); bf16* VO = (bf16*)(p.ws + WS_QKV); const float* DK = (const float*)(p.ws + WS_DK); float* SS = (float*)(p.ws + WS_SS);
    const int r0 = tid >> 4, cc = (tid & 15) * 8;
    const int vr = (tid >> 2) & 63, vc = (tid & 3) * 8;
    for (int it = blockIdx.x; it < 8 * 4 * 8; it += G) {
        const int xg_ = it & 7, jg_ = it >> 3, bh = xg_ * 4 + (jg_ >> 3), v8 = jg_ & 7, h = bh & 3, b = bh >> 2;
        pg8::f32x4 sacc[2] = {(pg8::f32x4){0.f, 0.f, 0.f, 0.f}, (pg8::f32x4){0.f, 0.f, 0.f, 0.f}};
        __syncthreads();
        for (int i = tid; i < 32 * PQ / 2; i += NTHR) ((LAS unsigned*)ST)[i] = 0u;
        u32x4 rq[2], rk[2], rv; float rdk = 0.f;
#define GLA_LOAD(chn) do { const size_t _t0 = (size_t)b * SEQ + (size_t)(chn) * 64; \
            _Pragma("unroll") for (int _j = 0; _j < 2; ++_j) { rq[_j] = *(const u32x4*)(QKV + (_t0 + r0 + 32 * _j) * 2048 + h * 128 + cc); rk[_j] = *(const u32x4*)(QKV + (_t0 + r0 + 32 * _j) * 2048 + 512 + h * 128 + cc); } \
            rv = *(const u32x4*)(QKV + (_t0 + vr) * 2048 + 1024 + h * 256 + v8 * 32 + vc); \
            rdk = DK[(size_t)(b * 128 + (chn)) * 512 + h * 128 + (tid & 127)]; } while (0)
        GLA_LOAD(0);
#pragma unroll 1
        for (int ch = 0; ch < SEQ / 64; ++ch) {
            const size_t t0 = (size_t)b * SEQ + ch * 64;
#pragma unroll
            for (int j = 0; j < 2; ++j) { *(LAS u32x4*)(Qs + (r0 + 32 * j) * PQ + cc) = rq[j]; *(LAS u32x4*)(Kd + (r0 + 32 * j) * PQ + cc) = rk[j]; }
            if (tid < 256) { LAS unsigned* vd = (LAS unsigned*)(Vt + vr * PV + vc); vd[0] = rv.x; vd[1] = rv.y; vd[2] = rv.z; vd[3] = rv.w; }
            if (tid < 128) dk[tid] = rdk;
            if (ch + 1 < SEQ / 64) GLA_LOAD(ch + 1);
            __syncthreads();
            { const int tt = wave & 3;
#pragma unroll
              for (int i2 = 0; i2 < 2; ++i2) { const int ts = (wave >> 2) * 2 + i2;
                  pg8::f32x4 acc = (pg8::f32x4){0.f, 0.f, 0.f, 0.f};
                  if (ts <= tt) {
#pragma unroll
                      for (int ks = 0; ks < 4; ++ks) { const bf16x8_t a = *(const LAS bf16x8_t*)(Kd + (ts * 16 + c16) * PQ + ks * 32 + q4 * 8), bb = *(const LAS bf16x8_t*)(Qs + (tt * 16 + c16) * PQ + ks * 32 + q4 * 8);
                          acc = __builtin_amdgcn_mfma_f32_16x16x32_bf16(a, bb, acc, 0, 0, 0); }
                      const int tg = tt * 16 + c16, sgl = ts * 16 + q4 * 4;
#pragma unroll
                      for (int j = 0; j < 4; ++j) if (sgl + j > tg) acc[j] = 0.f;
                  }
                  *(LAS u32x2*)(Pm + (tt * 16 + c16) * PS + ts * 16 + q4 * 4) = (u32x2){pk2(acc[0], acc[1]), pk2(acc[2], acc[3])}; } }
            bf16x8_t vf[2][2], kf[2];
#pragma unroll
            for (int ks = 0; ks < 2; ++ks) { kf[ks] = lds_col8(Kd + (ks * 32 + q4 * 8) * PQ + wave * 16 + c16, PQ);
#pragma unroll
                for (int tv = 0; tv < 2; ++tv) vf[tv][ks] = lds_col8(Vt + (ks * 32 + q4 * 8) * PV + tv * 16 + c16, PV); }
            __syncthreads();
            { const int tt = wave & 3, tv = wave >> 2;
              pg8::f32x4 oacc = (pg8::f32x4){0.f, 0.f, 0.f, 0.f};
#pragma unroll
              for (int ks = 0; ks < 2; ++ks) { const bf16x8_t bb = *(const LAS bf16x8_t*)(Pm + (tt * 16 + c16) * PS + ks * 32 + q4 * 8);
                  oacc = __builtin_amdgcn_mfma_f32_16x16x32_bf16(tv ? vf[1][ks] : vf[0][ks], bb, oacc, 0, 0, 0); }
#pragma unroll
              for (int ks = 0; ks < 4; ++ks) { const bf16x8_t bb = *(const LAS bf16x8_t*)(Qs + (tt * 16 + c16) * PQ + ks * 32 + q4 * 8), a = *(const LAS bf16x8_t*)(ST + (tv * 16 + c16) * PQ + ks * 32 + q4 * 8);
                  oacc = __builtin_amdgcn_mfma_f32_16x16x32_bf16(a, bb, oacc, 0, 0, 0); }
              *(u32x2*)(VO + (t0 + tt * 16 + c16) * 2048 + 1024 + h * 256 + v8 * 32 + tv * 16 + q4 * 4) = (u32x2){pk2(oacc[0], oacc[1]), pk2(oacc[2], oacc[3])};
              float sq = (oacc[0] * oacc[0] + oacc[1] * oacc[1]) + (oacc[2] * oacc[2] + oacc[3] * oacc[3]);
              sq += __shfl_xor(sq, 16); sq += __shfl_xor(sq, 32);
              if (q4 == 0) atomicAdd(SS + (t0 + tt * 16 + c16) * 4 + h, sq); }
#pragma unroll
            for (int ks = 0; ks < 2; ++ks)
#pragma unroll
                for (int tv = 0; tv < 2; ++tv) sacc[tv] = __builtin_amdgcn_mfma_f32_16x16x32_bf16(kf[ks], vf[tv][ks], sacc[tv], 0, 0, 0);
            { const pg8::f32x4 d4 = *(const LAS pg8::f32x4*)(dk + wave * 16 + q4 * 4);
#pragma unroll
              for (int tv = 0; tv < 2; ++tv) sacc[tv] = sacc[tv] * d4; }
            __syncthreads();
#pragma unroll
            for (int tv = 0; tv < 2; ++tv) *(LAS u32x2*)(ST + (tv * 16 + c16) * PQ + wave * 16 + q4 * 4) = (u32x2){pk2(sacc[tv][0], sacc[tv][1]), pk2(sacc[tv][2], sacc[tv][3])};
        }
#undef GLA_LOAD
    }
}

__device__ __forceinline__ void phase_norm2(const Params& p, LAS unsigned char* lds, int G) {
    const int tid = threadIdx.x, lane = tid & 63, wave = __builtin_amdgcn_readfirstlane(tid >> 6);
    const float* modp = (const float*)(p.ws + WS_MODP);
    LAS float* g1 = (LAS float*)lds; LAS float* gs = g1 + 1024; LAS float* sh = gs + 1024;
    const bf16* Y = (const bf16*)(p.ws + WS_Y); bf16* H2 = (bf16*)(p.ws + WS_H2);
    for (int tile = blockIdx.x; tile < T / 256; tile += G) {
        const int b = tile / 32;
        __syncthreads();
        for (int k = tid; k < 1024; k += NTHR) { g1[k] = mod_at(modp, b, 2048 + k) * p.npo[k]; gs[k] = p.npf[k] * (1.f + mod_at(modp, b, 4096 + k)); sh[k] = mod_at(modp, b, 3072 + k); }
        __syncthreads();
        for (int rr = 0; rr < 32; ++rr) {
            const size_t row = (size_t)tile * 256 + rr * 8 + wave;
            const f32x4* xr = (const f32x4*)(p.x + row * 1024) + lane; const u32x2* yr = (const u32x2*)(Y + row * 1024) + lane;
            f32x4 xv[4], yv[4]; float s = 0.f;
#pragma unroll
            for (int j = 0; j < 4; ++j) { xv[j] = xr[64 * j]; const u32x2 yw = yr[64 * j]; yv[j] = (f32x4){bflo(yw.x), bfhi(yw.x), bflo(yw.y), bfhi(yw.y)};
                s += (yv[j].x * yv[j].x + yv[j].y * yv[j].y) + (yv[j].z * yv[j].z + yv[j].w * yv[j].w); }
            const float rstd = __builtin_amdgcn_rsqf(wave_sum(s) * (1.f / 1024.f) + 1e-6f);
            float s2 = 0.f;
            f32x4* orow = (f32x4*)(p.out + row * 1024) + lane;
#pragma unroll
            for (int j = 0; j < 4; ++j) { const int k = 256 * j + 4 * lane; const f32x4 g4 = *(const LAS f32x4*)(g1 + k);
                xv[j] = xv[j] + yv[j] * rstd * g4; orow[64 * j] = xv[j];
                s2 += (xv[j].x * xv[j].x + xv[j].y * xv[j].y) + (xv[j].z * xv[j].z + xv[j].w * xv[j].w); }
            const float rstd2 = __builtin_amdgcn_rsqf(wave_sum(s2) * (1.f / 1024.f) + 1e-6f);
            u32x2* o8 = (u32x2*)(H2 + row * 1024) + lane;
#pragma unroll
            for (int j = 0; j < 4; ++j) { const int k = 256 * j + 4 * lane; const f32x4 g4 = *(const LAS f32x4*)(gs + k), s4 = *(const LAS f32x4*)(sh + k);
                u32x2 w; w.x = pk2(xv[j].x * rstd2 * g4.x + s4.x, xv[j].y * rstd2 * g4.y + s4.y); w.y = pk2(xv[j].z * rstd2 * g4.z + s4.z, xv[j].w * rstd2 * g4.w + s4.w);
                o8[64 * j] = w; }
        }
    }
}

__device__ __forceinline__ unsigned h16_key(unsigned b) { return (b & 0x8000u) ? (~b & 0xffffu) : (b | 0x8000u); }
__device__ __forceinline__ float h16_key_val(unsigned s) { const unsigned b = (s & 0x8000u) ? (s & 0x7fffu) : (~s & 0xffffu); return (float)__builtin_bit_cast(_Float16, (unsigned short)b); }
template <bool ASC> __device__ __forceinline__ void sort16(unsigned (&k)[16]) {
#pragma unroll
    for (int size = 2; size <= 16; size <<= 1)
#pragma unroll
        for (int stride = size >> 1; stride > 0; stride >>= 1)
#pragma unroll
            for (int i = 0; i < 16; ++i) { const int j = i ^ stride; if (j > i) { const bool up = ((i & size) == 0) == ASC; const unsigned lo = min(k[i], k[j]), hi = max(k[i], k[j]); k[i] = up ? lo : hi; k[j] = up ? hi : lo; } }
}
__device__ __forceinline__ void merge16_desc(unsigned (&k)[16]) {
#pragma unroll
    for (int stride = 8; stride > 0; stride >>= 1)
#pragma unroll
        for (int i = 0; i < 16; ++i) { const int j = i ^ stride; if (j > i) { const unsigned lo = min(k[i], k[j]), hi = max(k[i], k[j]); k[i] = hi; k[j] = lo; } }
}
__device__ __forceinline__ void top16_merge(unsigned (&top)[16], unsigned (&grp)[16]) {
    sort16<true>(grp);
#pragma unroll
    for (int i = 0; i < 16; ++i) top[i] = max(top[i], grp[i]);
    merge16_desc(top);
}
__device__ __forceinline__ void keys16(unsigned (&k)[16], const u32x4 w0, const u32x4 w1, int n0) {
    const unsigned ww[8] = {w0.x, w0.y, w0.z, w0.w, w1.x, w1.y, w1.z, w1.w};
#pragma unroll
    for (int q = 0; q < 8; ++q) { k[2 * q] = (h16_key(ww[q] & 0xffffu) << 16) | (unsigned)(127 - (n0 + 2 * q)); k[2 * q + 1] = (h16_key(ww[q] >> 16) << 16) | (unsigned)(127 - (n0 + 2 * q + 1)); }
}
__device__ __forceinline__ void topk_item(const unsigned short* SC, const float* SU, const float* SV, int t, int h, volatile LAS unsigned* my, unsigned (&outw)[16], float (&outs)[16]) {
    const u32x4* src = (const u32x4*)(SC + (size_t)t * 2048 + h * 256);
    unsigned topA[16], topB[16];
    keys16(topA, src[0], src[1], 0); sort16<false>(topA);
#pragma unroll 1
    for (int g = 1; g < 8; ++g) { unsigned grp[16]; keys16(grp, src[2 * g], src[2 * g + 1], 16 * g); top16_merge(topA, grp); }
    keys16(topB, src[16], src[17], 0); sort16<false>(topB);
#pragma unroll 1
    for (int g = 1; g < 8; ++g) { unsigned grp[16]; keys16(grp, src[16 + 2 * g], src[17 + 2 * g], 16 * g); top16_merge(topB, grp); }
    float fa[16], fb[16];
#pragma unroll
    for (int j = 0; j < 16; ++j) { fa[j] = h16_key_val(topA[j] >> 16); fb[j] = h16_key_val(topB[j] >> 16); my[j] = 127u - (topA[j] & 127u); my[16 + j] = 127u - (topB[j] & 127u); }
    unsigned ct[16];
#pragma unroll
    for (int g = 0; g < 4; ++g) { unsigned grp[16];
#pragma unroll
        for (int s = 0; s < 16; ++s) grp[s] = 0u;
        { int slot = 0;
#pragma unroll
          for (int i = 0; i < 16; ++i)
#pragma unroll
              for (int j = 0; j < 16; ++j) if ((i + 1) * (j + 1) <= 16) { if ((slot >> 4) == g) {
                  const float s = fa[i] + fb[j]; unsigned u = __builtin_bit_cast(unsigned, s); u ^= (u >> 31) ? 0xffffffffu : 0x80000000u;
                  grp[slot & 15] = (u & 0xffffff00u) | (unsigned)(255 - (i * 16 + j)); } ++slot; } }
        if (g == 0) { sort16<false>(grp);
#pragma unroll
            for (int s = 0; s < 16; ++s) ct[s] = grp[s]; }
        else top16_merge(ct, grp); }
    float val[16], mx, sum = 0.f;
#pragma unroll
    for (int m = 0; m < 16; ++m) { unsigned u = ct[m] & 0xffffff00u; u ^= (u >> 31) ? 0x80000000u : 0xffffffffu; val[m] = __builtin_bit_cast(float, u); }
    mx = val[0];
#pragma unroll
    for (int m = 0; m < 16; ++m) { val[m] = __expf(val[m] - mx); sum += val[m]; }
    const float inv = 1.f / sum;
    LDS_WAIT();
#pragma unroll
    for (int m = 0; m < 16; ++m) { const unsigned pos = 255u - (ct[m] & 255u), i = pos >> 4, j = pos & 15u;
        const unsigned e = my[i] * 128u + my[16 + j];
        outw[m] = (e << 16) | f2bf(val[m] * inv * SV[e]); outs[m] = SU[e]; }
}

typedef unsigned u32x3 __attribute__((ext_vector_type(3)));
typedef unsigned u32x6 __attribute__((ext_vector_type(6)));
typedef float f32x32 __attribute__((ext_vector_type(32)));
__device__ __forceinline__ float rdlane(float v, int l) { return __builtin_bit_cast(float, __builtin_amdgcn_readlane(__builtin_bit_cast(int, v), l)); }
__device__ __forceinline__ f32x32 fp6x2(u32x3 a, u32x3 b) { const u32x6 s = {a.x, a.y, a.z, b.x, b.y, b.z}; return __builtin_amdgcn_cvt_scalef32_pk32_f32_fp6(s, 1.0f); }
__device__ __forceinline__ void phase_gather(const Params& p, LAS unsigned char* lds, int G) {
    const int tid = threadIdx.x, lane = tid & 63, wave = __builtin_amdgcn_readfirstlane(tid >> 6);
    const float* modp = (const float*)(p.ws + WS_MODP);
    LAS float* g2 = (LAS float*)lds;
    const bf16* H2 = (const bf16*)(p.ws + WS_H2);
    const unsigned short* SC = (const unsigned short*)(p.ws + WS_SC); const float* SU = (const float*)(p.ws + WS_SU); const float* SV = (const float*)(p.ws + WS_SV);
    volatile LAS unsigned* RT = (volatile LAS unsigned*)(lds + 4096 + wave * 16640); volatile LAS float* RS = (volatile LAS float*)(RT + 1024);
    volatile LAS unsigned* myscr = RT + 2048 + lane * 33;
    const unsigned char* U6 = p.ws + WS_U; const unsigned char* V6 = p.ws + WS_V;
    for (int tile = blockIdx.x; tile < T / 256; tile += G) {
        const int b = tile / 32;
        __syncthreads();
        for (int k = tid; k < 1024; k += NTHR) g2[k] = mod_at(modp, b, 5120 + k) * p.npof[k];
        __syncthreads();
#pragma unroll 1
        for (int rr = 0; rr < 32; ++rr) {
            const size_t row = (size_t)tile * 256 + wave * 32 + rr;
            if ((rr & 7) == 0) {
                unsigned ow[16]; float os[16];
                __builtin_amdgcn_wave_barrier();
                topk_item(SC, SU, SV, (int)(row + (lane >> 3)), lane & 7, myscr, ow, os);
#pragma unroll
                for (int m = 0; m < 16; ++m) { RT[(lane >> 3) * 128 + (lane & 7) * 16 + m] = ow[m]; RS[(lane >> 3) * 128 + (lane & 7) * 16 + m] = os[m]; }
                asm volatile("s_waitcnt lgkmcnt(0)" ::: "memory"); __builtin_amdgcn_wave_barrier();
            }
            const int tl = rr & 7;
            float xt[16];
            { const u32x4 a = *(const u32x4*)(H2 + row * 1024 + lane * 16), c = *(const u32x4*)(H2 + row * 1024 + lane * 16 + 8);
              xt[0] = bflo(a.x); xt[1] = bfhi(a.x); xt[2] = bflo(a.y); xt[3] = bfhi(a.y); xt[4] = bflo(a.z); xt[5] = bfhi(a.z); xt[6] = bflo(a.w); xt[7] = bfhi(a.w);
              xt[8] = bflo(c.x); xt[9] = bfhi(c.x); xt[10] = bflo(c.y); xt[11] = bfhi(c.y); xt[12] = bflo(c.z); xt[13] = bfhi(c.z); xt[14] = bflo(c.w); xt[15] = bfhi(c.w); }
            float acc[16];
#pragma unroll
            for (int j = 0; j < 16; ++j) acc[j] = 0.f;
#pragma unroll 1
            for (int hh = 0; hh < 16; ++hh) {
                unsigned ww[8];
#pragma unroll
                for (int m = 0; m < 8; ++m) ww[m] = RT[tl * 128 + hh * 8 + m];
                u32x6 up[4], vp[4];
#pragma unroll
                for (int m = 0; m < 8; ++m) { const size_t eo = (size_t)((unsigned)__builtin_amdgcn_readfirstlane((int)ww[m]) >> 16) * 768 + lane * 12;
                    const u32x3 a = *(const u32x3*)(U6 + eo), c = *(const u32x3*)(V6 + eo);
                    if (m & 1) { up[m >> 1][3] = a.x; up[m >> 1][4] = a.y; up[m >> 1][5] = a.z; vp[m >> 1][3] = c.x; vp[m >> 1][4] = c.y; vp[m >> 1][5] = c.z; }
                    else { up[m >> 1][0] = a.x; up[m >> 1][1] = a.y; up[m >> 1][2] = a.z; vp[m >> 1][0] = c.x; vp[m >> 1][1] = c.y; vp[m >> 1][2] = c.z; } }
                const unsigned wa = RT[tl * 128 + hh * 8 + (lane >> 3)]; const float su = RS[tl * 128 + hh * 8 + (lane >> 3)];
                float pd[8];
#pragma unroll
                for (int m = 0; m < 8; m += 2) { const f32x32 f = __builtin_amdgcn_cvt_scalef32_pk32_f32_fp6(up[m >> 1], 1.0f);
                    float s0 = 0.f, s1 = 0.f;
#pragma unroll
                    for (int j = 0; j < 16; ++j) { s0 += xt[j] * f[j]; s1 += xt[j] * f[16 + j]; }
                    pd[m] = s0; pd[m + 1] = s1; __builtin_amdgcn_sched_barrier(0); }
#pragma unroll
                for (int j = 0; j < 4; ++j) { const bool up_ = (lane & 32) != 0; const float keep = up_ ? pd[j + 4] : pd[j], send = up_ ? pd[j] : pd[j + 4]; pd[j] = keep + __shfl_xor(send, 32); }
#pragma unroll
                for (int j = 0; j < 2; ++j) { const bool up_ = (lane & 16) != 0; const float keep = up_ ? pd[j + 2] : pd[j], send = up_ ? pd[j] : pd[j + 2]; pd[j] = keep + __shfl_xor(send, 16); }
                { const bool up_ = (lane & 8) != 0; const float keep = up_ ? pd[1] : pd[0], send = up_ ? pd[0] : pd[1]; pd[0] = keep + __shfl_xor(send, 8); }
                float d = pd[0]; d += __shfl_xor(d, 4); d += __shfl_xor(d, 2); d += __shfl_xor(d, 1);
                const float coef = bflo(wa) * gelu_f(su * d);
#pragma unroll
                for (int m = 0; m < 8; m += 2) { const f32x32 f = __builtin_amdgcn_cvt_scalef32_pk32_f32_fp6(vp[m >> 1], 1.0f); const float c0 = rdlane(coef, 8 * m), c1 = rdlane(coef, 8 * m + 8);
#pragma unroll
                    for (int j = 0; j < 16; ++j) acc[j] += c0 * f[j] + c1 * f[16 + j];
                    __builtin_amdgcn_sched_barrier(0); }
            }
            float s = 0.f;
#pragma unroll
            for (int j = 0; j < 16; ++j) s += acc[j] * acc[j];
            const float rstd = __builtin_amdgcn_rsqf(wave_sum(s) * (1.f / 1024.f) + 1e-6f);
            float* orow = p.out + row * 1024 + lane * 16;
#pragma unroll
            for (int q = 0; q < 4; ++q) { f32x4 o = *(const f32x4*)(orow + 4 * q); const f32x4 ga = *(const LAS f32x4*)(g2 + lane * 16 + 4 * q);
                o.x += ga.x * acc[4 * q] * rstd; o.y += ga.y * acc[4 * q + 1] * rstd; o.z += ga.z * acc[4 * q + 2] * rstd; o.w += ga.w * acc[4 * q + 3] * rstd;
                *(f32x4*)(orow + 4 * q) = o; }
        }
    }
}

#define XB_TMO      128
#define XB_XCNT(j)  (256  + 64 * (j))
#define XB_XSUB(j)  (1280 + 64 * (j))
#define XB_XGEN(j)  (2304 + 64 * (j))
#define XB_TOP      3328
#define XB_TOPGEN   3392
#define XCD_BAR_WORDS 3456
#define XB_SPIN_CAP (1u << 18)

__device__ __forceinline__ unsigned xb_ld(unsigned* p)              { return __hip_atomic_load(p, __ATOMIC_RELAXED, __HIP_MEMORY_SCOPE_AGENT); }
__device__ __forceinline__ unsigned xb_add(unsigned* p, unsigned v) { return __hip_atomic_fetch_add(p, v, __ATOMIC_RELAXED, __HIP_MEMORY_SCOPE_AGENT); }
__device__ __forceinline__ unsigned xb_xcc_id() { return (unsigned)__builtin_amdgcn_s_getreg((3 << 11) | 20) & 0xFu; }
#define XB_SPIN(cond, bar) do { unsigned _sp = 0; while (cond) { __builtin_amdgcn_s_sleep(1); \
    if ((++_sp & 255u) == 0u) { if (xb_ld(&(bar)[XB_TMO])) break; if (_sp > XB_SPIN_CAP) { atomicAdd(&(bar)[XB_TMO], 1u); break; } } } } while (0)

struct XcdBarrier {
    unsigned* bar; unsigned x;
    volatile LAS unsigned* st;
};

__device__ __forceinline__ XcdBarrier xcd_barrier_post(unsigned* bar, volatile LAS unsigned* st) {
    XcdBarrier b; b.bar = bar; b.x = xb_xcc_id(); b.st = st;
    if (threadIdx.x == 0) (void)xb_add(&bar[XB_XCNT(b.x)], 1u);
    return b;
}
__device__ __forceinline__ void xcd_barrier_complete(unsigned* bar, unsigned x, unsigned& nloc, unsigned& nx) {
    const unsigned G = gridDim.x * gridDim.y * gridDim.z;
    unsigned sum, cnt, mine, sp = 0u;
    for (;;) {
        sum = 0u; cnt = 0u; mine = 0u;
#pragma unroll
        for (unsigned j = 0; j < 16; ++j) { const unsigned c = xb_ld(&bar[XB_XCNT(j)]); sum += c; cnt += (c > 0u) ? 1u : 0u; mine = (j == x) ? c : mine; }
        if (sum == G) break;
        __builtin_amdgcn_s_sleep(1);
        if ((++sp & 255u) == 0u) { if (xb_ld(&bar[XB_TMO])) break; if (sp > XB_SPIN_CAP) { atomicAdd(&bar[XB_TMO], 1u); break; } }
    }
    nloc = mine > 0u ? mine : 1u; nx = cnt > 0u ? cnt : 1u;
}

__device__ __forceinline__ void xcd_barrier(const XcdBarrier& b) {
    asm volatile("s_waitcnt vmcnt(0)" ::: "memory");
    __syncthreads();
    if (threadIdx.x == 0) {
        unsigned* bar = b.bar;
        __builtin_amdgcn_s_waitcnt(0);
        unsigned nloc = b.st[0], nx = b.st[1];
        if (nloc == 0u) { xcd_barrier_complete(bar, b.x, nloc, nx); b.st[0] = nloc; b.st[1] = nx; }
        const unsigned old = xb_add(&bar[XB_XSUB(b.x)], 1u);
        const unsigned gen = old / nloc;
        if (old + 1u == (gen + 1u) * nloc) {
            __builtin_amdgcn_fence(__ATOMIC_RELEASE, "agent");
            asm volatile("s_waitcnt vmcnt(0)" ::: "memory");
            const unsigned og = xb_add(&bar[XB_TOP], 1u);
            const unsigned tg = og / nx;
            if (og + 1u == (tg + 1u) * nx) xb_add(&bar[XB_TOPGEN], 1u);
            else XB_SPIN(xb_ld(&bar[XB_TOPGEN]) == tg, bar);
            __builtin_amdgcn_fence(__ATOMIC_ACQUIRE, "agent");
            xb_add(&bar[XB_XGEN(b.x)], 1u);
            asm volatile("s_waitcnt vmcnt(0)" ::: "memory");
        } else {
            XB_SPIN(xb_ld(&bar[XB_XGEN(b.x)]) == gen, bar);
            __builtin_amdgcn_fence(__ATOMIC_ACQUIRE, "agent");
            asm volatile("s_waitcnt vmcnt(0)" ::: "memory");
        }
    }
    __syncthreads();
}


template <int PH>
__device__ __forceinline__ void run_phase(const Params& p, LAS unsigned char* lds, int G) {
    unsigned char* ws = p.ws;
    if constexpr (PH == 0) phase0(p, lds, G);
    else if constexpr (PH == 1) {
        { pg8::Gemm g{(const bf16*)(ws + WS_WQB), (const bf16*)(ws + WS_SUBK), 1024, 2048, 256, 2048}; pg8::StaticOrder S; S.init(1024, 2048, G, (int)blockIdx.x);
          EpiTrans E{(bf16*)(ws + WS_WQ), 1024}; pg8::gemm_phase<EpiTrans, pg8::StaticOrder, true, true, 2, 256, 2048>(lds, g, S, E);
          const int nb = (G > 32) ? G - 32 : G, bi = (G > 32) ? (int)blockIdx.x - 32 : (int)blockIdx.x;
          if (bi >= 0) convert_tables(p, bi * NWAVES + (int)__builtin_amdgcn_readfirstlane(threadIdx.x >> 6), nb * NWAVES, threadIdx.x & 63); }
        __syncthreads();
        phase1(p, lds, G); }
    else if constexpr (PH == 2) { pg8::Gemm g{(const bf16*)p.out, (const bf16*)(ws + WS_WIN), T, NPAD, 1024, 1024}; pg8::StaticOrder S; S.init(T, NPAD, G, (int)blockIdx.x);
        EpiSeg E{ws}; pg8::gemm_phase<EpiSeg, pg8::StaticOrder, true, true, 0, 1024, 1024>(lds, g, S, E); }
    else if constexpr (PH == 3) { phase_gla_prep(p, lds, G); __syncthreads(); phase_lru<false>(p, lds, G); }
    else if constexpr (PH == 4) phase_gla_seq(p, lds, G);
    else if constexpr (PH == 5) phase_lru<true>(p, lds, G);
    else if constexpr (PH == 6) { pg8::Gemm g{(const bf16*)(ws + WS_GAGB), (const bf16*)(ws + WS_WOUT), T, 1024, 1024, 2048}; pg8::StaticOrder S; S.init(T, 1024, G, (int)blockIdx.x);
        EpiPlain E{(bf16*)(ws + WS_Y), 1024}; pg8::gemm_phase<EpiPlain, pg8::StaticOrder, true, true, 0, 1024, 2048>(lds, g, S, E); }
    else if constexpr (PH == 7) phase_norm2(p, lds, G);
    else if constexpr (PH == 8) {
        pg8::Gemm g{(const bf16*)(ws + WS_H2), (const bf16*)(ws + WS_WQ), T, 2048, 1024, 1024}; pg8::StaticOrder S; S.init(T, 2048, G, (int)blockIdx.x);
        EpiF16 E{(unsigned short*)(ws + WS_SC), 2048}; pg8::gemm_phase<EpiF16, pg8::StaticOrder, true, true, 0, 1024, 1024>(lds, g, S, E); }
    else if constexpr (PH == 9) phase_gather(p, lds, G);
}
template <int PH>
__global__ void __launch_bounds__(NTHR, 2) k_phase(Params p) {
    extern __shared__ __attribute__((aligned(16))) unsigned char lds_raw[];
    run_phase<PH>(p, (LAS unsigned char*)lds_raw, (int)gridDim.x);
}
constexpr int LDS_BAR_OFF = LDS_BYTES - 16;
template <int PH>
__device__ __forceinline__ void run_from(const Params& p, LAS unsigned char* lds, int G, const XcdBarrier& bar) {
#if PROBE_PH >= 0
    unsigned long long pt0 = 0; if constexpr (PH == PROBE_PH) pt0 = __builtin_amdgcn_s_memrealtime();
#endif
    run_phase<PH>(p, lds, G);
    if constexpr (PH + 1 < N_PHASES) {
        if constexpr (PH == 0) cg::this_grid().sync();
        else xcd_barrier(bar);
    }
#if PROBE_PH >= 0
    if constexpr (PH == PROBE_PH) { const unsigned long long pt1 = __builtin_amdgcn_s_memrealtime(), span = pt1 - pt0;
        while (__builtin_amdgcn_s_memrealtime() - pt1 < (unsigned long long)PROBE_MULT * span) __builtin_amdgcn_s_sleep(8); }
#endif
    if constexpr (PH + 1 < N_PHASES) run_from<PH + 1>(p, lds, G, bar);
}
__global__ void __launch_bounds__(NTHR, 2) k_mega(Params p) {
    extern __shared__ __attribute__((aligned(16))) unsigned char lds_raw[];
    LAS unsigned char* lds = (LAS unsigned char*)lds_raw;
    if (threadIdx.x < 4) ((LAS unsigned*)(lds + LDS_BAR_OFF))[threadIdx.x] = 0u;
    __syncthreads();
    const XcdBarrier bar = xcd_barrier_post((unsigned*)(p.ws + WS_CTL), (volatile LAS unsigned*)(lds + LDS_BAR_OFF));
    run_from<0>(p, lds, (int)gridDim.x, bar);
}

extern "C" void kernel_launch(void* const* d_in, const int* in_sizes, int n_in, void* d_out, int out_size, void* d_ws, size_t ws_size, hipStream_t stream) {
    static int grid = 0;
    if (grid == 0) {
        if (n_in != 24 || in_sizes[0] != T * DM || out_size != T * DM || ws_size < WS_END) {
            fprintf(stderr, "kernel_launch: unexpected shapes: n_in %d in0 %d out %d ws %zu\n", n_in, n_in > 0 ? in_sizes[0] : -1, out_size, ws_size); grid = -1; return; }
        int dev = 0, cus = 0, per_cu = 0;
        if (hipGetDevice(&dev) != hipSuccess || hipDeviceGetAttribute(&cus, hipDeviceAttributeMultiprocessorCount, dev) != hipSuccess) { grid = -1; return; }
        if (hipFuncSetAttribute((const void*)k_mega, hipFuncAttributeMaxDynamicSharedMemorySize, LDS_BYTES) != hipSuccess) { fprintf(stderr, "kernel_launch: hipFuncSetAttribute failed\n"); grid = -1; return; }
        if (hipOccupancyMaxActiveBlocksPerMultiprocessor(&per_cu, (const void*)k_mega, NTHR, LDS_BYTES) != hipSuccess || per_cu < 1) { fprintf(stderr, "kernel_launch: occupancy query says %d blocks per CU\n", per_cu); grid = -1; return; }
        (void)hipGetLastError();
        grid = cus;
    }
    if (grid < 0) return;
    Params p{};
    const float** pp = (const float**)&p;
    for (int i = 0; i < 24; ++i) pp[i] = (const float*)d_in[i];
    p.out = (float*)d_out; p.ws = (unsigned char*)d_ws;
    if (hipMemsetAsync((char*)d_ws + WS_CTL, 0, 65536, stream) != hipSuccess) { fprintf(stderr, "kernel_launch: hipMemsetAsync failed\n"); return; }
    void* args[] = {&p};
    hipError_t e = hipLaunchCooperativeKernel((const void*)k_mega, dim3(grid), dim3(NTHR), args, LDS_BYTES, stream);
    if (e != hipSuccess) fprintf(stderr, "kernel_launch: cooperative launch failed: %s (grid %d)\n", hipGetErrorString(e), grid);
}
```

```cpp
#include <hip/hip_runtime.h>
#include <hip/hip_cooperative_groups.h>
#include <cstdio>
#include <cstdint>
#include <utility>
namespace cg = cooperative_groups;

namespace pg8 {
#define PG8_LAS __attribute__((address_space(3)))
typedef unsigned short bf16_t;
typedef short bf16x8 __attribute__((ext_vector_type(8)));
typedef float f32x4 __attribute__((ext_vector_type(4)));
typedef unsigned u32x4 __attribute__((ext_vector_type(4)));
constexpr int BM = 256, BK = 64, HALF = 128, HTB = HALF * BK * 2  , STAGE_BYTES = 8 * HTB, NXCD = 8;

__host__ __device__ __forceinline__ int lds_byte(int r, int c) { const int st = (r >> 4) * 2 + (c >> 5), rr = r & 15, cc = c & 31, ob = rr * 64 + cc * 2; return st * 1024 + (ob ^ (((ob >> 9) & 1) << 5)); }
__host__ __device__ __forceinline__ void stage_rc(int b, int& R, int& C) { const int st = b / 1024, sb = b % 1024, swz = sb ^ (((sb >> 9) & 1) << 5); R = (st >> 1) * 16 + swz / 64; C = (st & 1) * 32 + (swz % 64) / 2; }
__host__ __device__ __forceinline__ int perm32(int rho) { const int n = rho >> 4, i = rho & 15; return 8 * (i >> 2) + 4 * n + (i & 3); }

struct Unit { int pm, pn; };
struct Gemm { const bf16_t* A; const bf16_t* Bt; int M, N, K, lda; };
template <int AMODE> __device__ __forceinline__ size_t a_off_bytes(const Gemm& g, const Unit& u) {
    const int ac = AMODE == 0 ? 0 : (AMODE == 1 ? 128 * (u.pn < 6 ? u.pn : 6) : 256 * u.pn);
    return ((size_t)u.pm * BM * (size_t)g.lda + (size_t)ac) * 2;
}

struct StaticOrder {
    int nM, nN, nwg, G, c, WGM;
    __host__ __device__ void init(int M, int N, int G_, int c_, int wgm = 4) { nM = M / BM; nN = N / BM; nwg = nM * nN; G = G_; c = c_; WGM = wgm; }
    __host__ __device__ bool next(int i, Unit& u) const {
        const long L = (long)i * G + c; if (L >= nwg) return false;
        int wgid = (int)L; { const int q = nwg / NXCD, r = nwg % NXCD, xcd = wgid % NXCD, off = wgid / NXCD; wgid = (xcd < r ? xcd * (q + 1) : r * (q + 1) + (xcd - r) * q) + off; }
        const int nig = WGM * nN, gid = wgid / nig, fm = gid * WGM, gsz = (nM - fm) < WGM ? (nM - fm) : WGM;
        u.pm = fm + ((wgid % nig) % gsz); u.pn = (wgid % nig) / gsz; return true;
    }
    __device__ __forceinline__ void a_ready(const Unit&) const {}
    __device__ __forceinline__ void done(const Unit&) const {}
};

__device__ __forceinline__ unsigned cvt_pk_bf16(float lo, float hi) { unsigned r; asm volatile("v_cvt_pk_bf16_f32 %0, %1, %2" : "=v"(r) : "v"(lo), "v"(hi)); return r; }

template <class Epi, class Sched, bool ALIGN_EPI = false, bool SP2 = false, int AMODE = 0, int KC = 0, int LDAC = 0>
__device__ __forceinline__ void gemm_phase(PG8_LAS unsigned char* lds, const Gemm g, const Sched& S, const Epi& E) {
    const int tid = threadIdx.x, wid = __builtin_amdgcn_readfirstlane(tid >> 6), lane = tid & 63, wr = wid >> 2, wc = wid & 3, fr = lane & 15, fq = lane >> 4;
    const int K = KC ? KC : g.K, nt = K / BK; const int lda = LDAC ? LDAC : g.lda;
    unsigned voffA[2], voffB[2];
#pragma unroll
    for (int i = 0; i < 2; ++i) { int R, C; stage_rc(tid * 16 + i * 8192, R, C); const int Rb = Epi::PERM ? ((R & ~31) + perm32(R & 31)) : R;
        voffA[i] = (unsigned)(R * lda + C) * 2u; voffB[i] = (unsigned)(Rb * K + C) * 2u; }
    const size_t kstep = (size_t)(BK * 2);
    const size_t hstepA = (size_t)HALF * lda * 2;
    const size_t hstepB = (size_t)HALF * K * 2;
    const size_t tstepB = 2 * hstepB;
    const unsigned ldsw = (unsigned)wid * 1024u;
    const int aoff = lds_byte(wr * 64 + fr, fq * 8), boff = lds_byte(wc * 32 + fr, fq * 8);
#define PG8_SA(b, h) (((b) * 2 + (h)) * HTB)
#define PG8_SB(b, h) ((4 + (b) * 2 + (h)) * HTB)
#define PG8_STAGE(bufoff, gbase, voff) do { _Pragma("unroll") for (int _i = 0; _i < 2; ++_i) \
        __builtin_amdgcn_global_load_lds((const unsigned*)((const char*)(gbase) + (voff)[_i]), (PG8_LAS unsigned*)(lds + (bufoff) + ldsw + _i * 8192), 16, 0, 0); } while (0)
#define PG8_LDA(dst, b, h) do { _Pragma("unroll") for (int m = 0; m < 4; ++m) _Pragma("unroll") for (int k = 0; k < 2; ++k) dst[m][k] = *(const PG8_LAS bf16x8*)(lds + PG8_SA(b, h) + aoff + m * 2048 + k * 1024); } while (0)
#define PG8_LDB(dst, b, h) do { _Pragma("unroll") for (int n = 0; n < 2; ++n) _Pragma("unroll") for (int k = 0; k < 2; ++k) dst[n][k] = *(const PG8_LAS bf16x8*)(lds + PG8_SB(b, h) + boff + n * 2048 + k * 1024); } while (0)
#define PG8_MMA(ai, bj, At, Bt) do { __builtin_amdgcn_s_setprio(1); _Pragma("unroll") for (int m = 0; m < 4; ++m) _Pragma("unroll") for (int n = 0; n < 2; ++n) _Pragma("unroll") for (int k = 0; k < 2; ++k) \
        acc[ai][bj][m][n] = __builtin_amdgcn_mfma_f32_16x16x32_bf16(Bt[n][k], At[m][k], acc[ai][bj][m][n], 0, 0, 0); __builtin_amdgcn_s_setprio(0); } while (0)
#define PG8_WAIT_V(n) asm volatile("s_waitcnt vmcnt(" #n ")" ::: "memory")
#define PG8_WAIT_L(n) asm volatile("s_waitcnt lgkmcnt(" #n ")" ::: "memory")
#define PG8_BAR __builtin_amdgcn_s_barrier()
#define PG8_SCHED __builtin_amdgcn_sched_barrier(0)
    Unit cur, nxt; int ui = 0;
    if (!S.next(0, cur)) return;
    f32x4 acc[2][2][4][2];
#pragma unroll
    for (int a = 0; a < 2; ++a)
#pragma unroll
        for (int b = 0; b < 2; ++b)
#pragma unroll
            for (int m = 0; m < 4; ++m)
#pragma unroll
                for (int n = 0; n < 2; ++n) acc[a][b][m][n] = (f32x4){0.f, 0.f, 0.f, 0.f};
    bf16x8 At[4][2], B0[2][2], B1[2][2];
    const char* cA = (const char*)g.A + a_off_bytes<AMODE>(g, cur); const char* cB = (const char*)g.Bt + (size_t)cur.pn * tstepB;
    S.a_ready(cur);
    if constexpr (SP2) {
        PG8_STAGE(PG8_SB(0, 0), cB, voffB); PG8_STAGE(PG8_SB(0, 1), cB + hstepB, voffB); PG8_STAGE(PG8_SA(0, 0), cA, voffA); PG8_STAGE(PG8_SA(0, 1), cA + hstepA, voffA);
        if (wr == 1) PG8_BAR;
        PG8_WAIT_V(2); PG8_BAR;
        PG8_STAGE(PG8_SB(1, 0), cB + kstep, voffB); PG8_STAGE(PG8_SA(1, 0), cA + kstep, voffA); PG8_STAGE(PG8_SB(1, 1), cB + hstepB + kstep, voffB);
        PG8_WAIT_V(6); PG8_BAR;
    } else {
        PG8_STAGE(PG8_SB(0, 0), cB, voffB); PG8_STAGE(PG8_SA(0, 0), cA, voffA); PG8_STAGE(PG8_SB(0, 1), cB + hstepB, voffB); PG8_STAGE(PG8_SA(0, 1), cA + hstepA, voffA);
        if (wr == 1) PG8_BAR;
        PG8_WAIT_V(4); PG8_BAR;
        PG8_STAGE(PG8_SB(1, 0), cB + kstep, voffB); PG8_STAGE(PG8_SA(1, 0), cA + kstep, voffA); PG8_STAGE(PG8_SB(1, 1), cB + hstepB + kstep, voffB);
        PG8_WAIT_V(6); PG8_BAR;
    }
    for (;;) {
        const bool has_next = S.next(ui + 1, nxt);
        const char* nA = has_next ? (const char*)g.A + a_off_bytes<AMODE>(g, nxt) : cA; const char* nB = has_next ? (const char*)g.Bt + (size_t)nxt.pn * tstepB : cB;
#pragma unroll 1
        for (int t = 0; t < nt; t += 2) {
            const bool last = (t == nt - 2);
            const char* a1 = cA + (size_t)(t + 1) * kstep;
            const char* a2 = last ? nA : cA + (size_t)(t + 2) * kstep; const char* b2 = last ? nB : cB + (size_t)(t + 2) * kstep;
            const char* a3 = a2 + kstep; const char* b3 = b2 + kstep;
            if (last && has_next) S.a_ready(nxt);
            if constexpr (SP2) {
            PG8_LDB(B0, 0, 0); PG8_LDB(B1, 0, 1); PG8_SCHED; PG8_LDA(At, 0, 0); PG8_STAGE(PG8_SA(1, 1), a1 + hstepA, voffA);
            PG8_WAIT_V(8); PG8_WAIT_L(0); PG8_BAR; PG8_MMA(0, 0, At, B0); PG8_MMA(0, 1, At, B1); PG8_BAR; PG8_SCHED;
            PG8_LDA(At, 0, 1); PG8_STAGE(PG8_SB(0, 0), b2, voffB); PG8_STAGE(PG8_SB(0, 1), b2 + hstepB, voffB); PG8_STAGE(PG8_SA(0, 0), a2, voffA);
            PG8_WAIT_V(8); PG8_WAIT_L(0); PG8_BAR; PG8_MMA(1, 0, At, B0); PG8_MMA(1, 1, At, B1); PG8_BAR; PG8_SCHED;
            PG8_LDB(B0, 1, 0); PG8_LDB(B1, 1, 1); PG8_SCHED; PG8_LDA(At, 1, 0); PG8_STAGE(PG8_SA(0, 1), a2 + hstepA, voffA);
            PG8_WAIT_V(8); PG8_WAIT_L(0); PG8_BAR; PG8_MMA(0, 0, At, B0); PG8_MMA(0, 1, At, B1); PG8_BAR; PG8_SCHED;
            PG8_LDA(At, 1, 1); PG8_STAGE(PG8_SB(1, 0), b3, voffB); PG8_STAGE(PG8_SB(1, 1), b3 + hstepB, voffB); PG8_STAGE(PG8_SA(1, 0), a3, voffA);
            PG8_WAIT_V(8); PG8_WAIT_L(0); PG8_BAR; PG8_MMA(1, 0, At, B0); PG8_MMA(1, 1, At, B1); PG8_BAR; PG8_SCHED;
            } else {
            PG8_LDB(B0, 0, 0); PG8_SCHED; PG8_LDA(At, 0, 0); PG8_STAGE(PG8_SA(1, 1), a1 + hstepA, voffA);
            PG8_WAIT_L(8); PG8_BAR; PG8_WAIT_L(0); PG8_MMA(0, 0, At, B0); PG8_BAR; PG8_SCHED;
            PG8_LDB(B1, 0, 1); PG8_STAGE(PG8_SB(0, 0), b2, voffB);
            PG8_BAR; PG8_WAIT_L(0); PG8_MMA(0, 1, At, B1); PG8_BAR;
            PG8_LDA(At, 0, 1); PG8_STAGE(PG8_SA(0, 0), a2, voffA);
            PG8_BAR; PG8_WAIT_L(0); PG8_MMA(1, 0, At, B0); PG8_BAR; PG8_SCHED;
            PG8_STAGE(PG8_SB(0, 1), b2 + hstepB, voffB);
            PG8_WAIT_V(6); PG8_BAR; PG8_MMA(1, 1, At, B1); PG8_BAR;
            PG8_LDB(B0, 1, 0); PG8_SCHED; PG8_LDA(At, 1, 0); PG8_STAGE(PG8_SA(0, 1), a2 + hstepA, voffA);
            PG8_WAIT_L(8); PG8_BAR; PG8_WAIT_L(0); PG8_MMA(0, 0, At, B0); PG8_BAR; PG8_SCHED;
            PG8_LDB(B1, 1, 1); PG8_STAGE(PG8_SB(1, 0), b3, voffB);
            PG8_BAR; PG8_WAIT_L(0); PG8_MMA(0, 1, At, B1); PG8_BAR;
            PG8_LDA(At, 1, 1); PG8_STAGE(PG8_SA(1, 0), a3, voffA);
            PG8_BAR; PG8_WAIT_L(0); PG8_MMA(1, 0, At, B0); PG8_BAR; PG8_SCHED;
            PG8_STAGE(PG8_SB(1, 1), b3 + hstepB, voffB);
            PG8_WAIT_V(6); PG8_BAR; PG8_MMA(1, 1, At, B1); PG8_BAR;
            }
        }
        if constexpr (ALIGN_EPI) { if (wr == 0) PG8_BAR; }
        E(acc, cur, wr, wc, fr, fq); S.done(cur);
        if (!has_next) break;
#pragma unroll
        for (int a = 0; a < 2; ++a)
#pragma unroll
            for (int b = 0; b < 2; ++b)
#pragma unroll
                for (int m = 0; m < 4; ++m)
#pragma unroll
                    for (int n = 0; n < 2; ++n) acc[a][b][m][n] = (f32x4){0.f, 0.f, 0.f, 0.f};
        cur = nxt; cA = nA; cB = nB; ++ui;
        if constexpr (ALIGN_EPI) { if (wr == 1) PG8_BAR; }
    }
    PG8_WAIT_V(0);
    if constexpr (!ALIGN_EPI) { if (wr == 0) PG8_BAR; }
    PG8_BAR;
#undef PG8_SA
#undef PG8_SB
#undef PG8_STAGE
#undef PG8_LDA
#undef PG8_LDB
#undef PG8_MMA
#undef PG8_WAIT_V
#undef PG8_WAIT_L
#undef PG8_BAR
#undef PG8_SCHED
}
}

constexpr int NB = 8, SEQ = 8192, DM = 1024, T = NB * SEQ;
constexpr int NPAD = 7424;
constexpr int NWAVES = 8, NTHR = 512;
constexpr int LDS_BYTES = 147456;
constexpr int N_PHASES = 10;
#define PROBE_PH -1
#define PROBE_MULT 3

constexpr size_t MiB = 1ull << 20;
constexpr size_t WS_CTL = 0;
constexpr size_t WS_MODP = 1 * MiB;
constexpr size_t WS_WIN = 3 * MiB;
constexpr size_t WS_WOUT = 18 * MiB;
constexpr size_t WS_WQ = 20 * MiB;
constexpr size_t WS_WQB = 480 * MiB;
constexpr size_t WS_LRUB = 24 * MiB;
constexpr size_t WS_SUBK = 25 * MiB;
constexpr size_t WS_LRUC = 26 * MiB;
constexpr size_t WS_U = 32 * MiB;
constexpr size_t WS_V = 48 * MiB;
constexpr size_t WS_SU = 64 * MiB;
constexpr size_t WS_SV = 65 * MiB;
constexpr size_t WS_SS = 30 * MiB;
constexpr size_t WS_DK = 66 * MiB;
constexpr size_t WS_QKV = 96 * MiB;
constexpr size_t WS_R = 352 * MiB;
constexpr size_t WS_XLXG = 480 * MiB;
constexpr size_t WS_GAGB = 736 * MiB;
constexpr size_t WS_ALOW = 992 * MiB;
constexpr size_t WS_END = 994 * MiB;
constexpr size_t WS_Y = WS_QKV;
constexpr size_t WS_H2 = WS_QKV + 128 * MiB;
constexpr size_t WS_QRY = WS_XLXG;
constexpr size_t WS_SC = WS_GAGB;
constexpr size_t WS_TOPK = WS_R;
constexpr size_t WS_TOPK2 = WS_R + 32 * MiB;

#define LAS __attribute__((address_space(3)))
typedef unsigned short bf16;
typedef float f32x4 __attribute__((ext_vector_type(4)));
typedef float f32x2 __attribute__((ext_vector_type(2)));
typedef unsigned u32x4 __attribute__((ext_vector_type(4)));
typedef unsigned u32x2 __attribute__((ext_vector_type(2)));

struct Params {
    const float *x, *c, *w_ada, *b_ada, *npm, *npo, *w_in, *w_alpha, *b_alpha, *gla_norm, *conv_w, *conv_b,
        *lwa, *lba, *lwx, *lbx, *lam, *w_out, *npf, *npof, *wq, *subk, *pu, *pv;
    float* out; unsigned char* ws;
    int ph_lo, ph_hi;
};

__device__ __forceinline__ unsigned pk2(float lo, float hi) { unsigned r; asm("v_cvt_pk_bf16_f32 %0, %1, %2" : "=v"(r) : "v"(lo), "v"(hi)); return r; }
__device__ __forceinline__ unsigned f2bf(float f) { return pk2(f, f) & 0xffffu; }
__device__ __forceinline__ float bflo(unsigned u) { return __builtin_bit_cast(float, u << 16); }
__device__ __forceinline__ float bfhi(unsigned u) { return __builtin_bit_cast(float, u & 0xffff0000u); }
__device__ __forceinline__ float bf2f(bf16 h) { return __builtin_bit_cast(float, (unsigned)h << 16); }
__device__ __forceinline__ float sigmoid_f(float x) { return __builtin_amdgcn_rcpf(1.f + __expf(-x)); }
__device__ __forceinline__ float silu_f(float x) { return x * __builtin_amdgcn_rcpf(1.f + __expf(-x)); }
__device__ __forceinline__ float gelu_f(float x) { const float u = 0.7978845608028654f * (x + 0.044715f * x * x * x); return x * __builtin_amdgcn_rcpf(1.f + __expf(-2.f * u)); }
__device__ __forceinline__ float softplus_f(float x) { return fmaxf(x, 0.f) + log1pf(__expf(-fabsf(x))); }
__device__ __forceinline__ float wave_sum(float v) {
#pragma unroll
    for (int o = 1; o < 64; o <<= 1) v += __shfl_xor(v, o);
    return v;
}
__device__ __forceinline__ float merge2(float ga, float on, float r, float gb, float hl, float xg) {
    const float u = 0.7978845608028654f * (xg + 0.044715f * xg * xg * xg);
    const float d1 = (1.f + __expf(-ga)) * (1.f + __expf(-r)), d2 = (1.f + __expf(-gb)) * (1.f + __expf(-2.f * u));
    return on * r * __builtin_amdgcn_rcpf(d1) + hl * xg * __builtin_amdgcn_rcpf(d2);
}
#define LDS_WAIT() asm volatile("s_waitcnt lgkmcnt(0)" ::: "memory")

struct EpiSeg {
    static constexpr bool PERM = true;
    unsigned char* ws;
    __device__ __forceinline__ void operator()(const pg8::f32x4 (&acc)[2][2][4][2], const pg8::Unit& u, int wr, int wc, int fr, int fq) const {
        const int pn = u.pn; bf16* base; int ldc, colt;
        if (pn < 8) { base = (bf16*)(ws + WS_QKV); ldc = 2048; colt = pn * 256; }
        else if (pn < 12) { base = (bf16*)(ws + WS_R); ldc = 1024; colt = (pn - 8) * 256; }
        else if (pn < 20) { base = (bf16*)(ws + WS_XLXG); ldc = 2048; colt = (pn - 12) * 256; }
        else if (pn < 28) { base = (bf16*)(ws + WS_GAGB); ldc = 2048; colt = (pn - 20) * 256; }
        else { base = (bf16*)(ws + WS_ALOW); ldc = 16; colt = 0; }
        const int row0 = u.pm * 256 + wr * 64 + fr, col0 = colt + wc * 32 + 8 * fq;
        const bool tail = (pn == 28);
#pragma unroll
        for (int ai = 0; ai < 2; ++ai)
#pragma unroll
            for (int m = 0; m < 4; ++m) { bf16* rowp = base + (size_t)(row0 + ai * 128 + m * 16) * ldc + col0;
#pragma unroll
                for (int bj = 0; bj < 2; ++bj) { const pg8::f32x4 v0 = acc[ai][bj][m][0], v1 = acc[ai][bj][m][1];
                    u32x4 w; w.x = pg8::cvt_pk_bf16(v0[0], v0[1]); w.y = pg8::cvt_pk_bf16(v0[2], v0[3]); w.z = pg8::cvt_pk_bf16(v1[0], v1[1]); w.w = pg8::cvt_pk_bf16(v1[2], v1[3]);
                    if (!tail || (bj == 0 && wc == 0 && fq < 2)) *(u32x4*)(rowp + bj * 128) = w; } }
    }
};
struct EpiPlain {
    static constexpr bool PERM = true;
    bf16* O; int ldc;
    __device__ __forceinline__ void operator()(const pg8::f32x4 (&acc)[2][2][4][2], const pg8::Unit& u, int wr, int wc, int fr, int fq) const {
        const int row0 = u.pm * 256 + wr * 64 + fr, col0 = u.pn * 256 + wc * 32 + 8 * fq;
#pragma unroll
        for (int ai = 0; ai < 2; ++ai)
#pragma unroll
            for (int m = 0; m < 4; ++m) { bf16* rowp = O + (size_t)(row0 + ai * 128 + m * 16) * ldc + col0;
#pragma unroll
                for (int bj = 0; bj < 2; ++bj) { const pg8::f32x4 v0 = acc[ai][bj][m][0], v1 = acc[ai][bj][m][1];
                    u32x4 w; w.x = pg8::cvt_pk_bf16(v0[0], v0[1]); w.y = pg8::cvt_pk_bf16(v0[2], v0[3]); w.z = pg8::cvt_pk_bf16(v1[0], v1[1]); w.w = pg8::cvt_pk_bf16(v1[2], v1[3]);
                    *(u32x4*)(rowp + bj * 128) = w; } }
    }
};
typedef _Float16 h16x2 __attribute__((ext_vector_type(2)));
__device__ __forceinline__ unsigned pkh(float a, float b) { return __builtin_bit_cast(unsigned, __builtin_amdgcn_cvt_pkrtz(a, b)); }
struct EpiF16 {
    static constexpr bool PERM = true;
    unsigned short* O; int ldc;
    __device__ __forceinline__ void operator()(const pg8::f32x4 (&acc)[2][2][4][2], const pg8::Unit& u, int wr, int wc, int fr, int fq) const {
        const int row0 = u.pm * 256 + wr * 64 + fr, col0 = u.pn * 256 + wc * 32 + 8 * fq;
#pragma unroll
        for (int ai = 0; ai < 2; ++ai)
#pragma unroll
            for (int m = 0; m < 4; ++m) { unsigned short* rowp = O + (size_t)(row0 + ai * 128 + m * 16) * ldc + col0;
#pragma unroll
                for (int bj = 0; bj < 2; ++bj) { const pg8::f32x4 v0 = acc[ai][bj][m][0], v1 = acc[ai][bj][m][1];
                    u32x4 w; w.x = pkh(v0[0], v0[1]); w.y = pkh(v0[2], v0[3]); w.z = pkh(v1[0], v1[1]); w.w = pkh(v1[2], v1[3]);
                    *(u32x4*)(rowp + bj * 128) = w; } }
    }
};
struct EpiTrans {
    static constexpr bool PERM = true;
    bf16* O; int ldc;
    __device__ __forceinline__ void operator()(const pg8::f32x4 (&acc)[2][2][4][2], const pg8::Unit& u, int wr, int wc, int fr, int fq) const {
        const int row0 = u.pm * 256 + wr * 64 + fr, col0 = u.pn * 256 + wc * 32 + 8 * fq;
#pragma unroll
        for (int ai = 0; ai < 2; ++ai)
#pragma unroll
            for (int m = 0; m < 4; ++m) { const int row = row0 + ai * 128 + m * 16;
#pragma unroll
                for (int bj = 0; bj < 2; ++bj)
#pragma unroll
                    for (int n = 0; n < 2; ++n)
#pragma unroll
                        for (int e = 0; e < 4; ++e) O[(size_t)(col0 + bj * 128 + 4 * n + e) * ldc + row] = (bf16)f2bf(acc[ai][bj][m][n][e]); }
    }
};

__device__ __forceinline__ void p0_transpose_item(const float* W, int ldw, int k0, int n0, int nvalid, bf16* WT, int ldk, int row0, int kc0, LAS float* scr, int lane) {
#pragma unroll 8
    for (int i = 0; i < 32; ++i) { const int kk = 2 * i + (lane >> 5), cc = lane & 31; scr[kk * 33 + cc] = (cc < nvalid) ? W[(size_t)(k0 + kk) * ldw + n0 + cc] : 0.f; }
    LDS_WAIT(); asm volatile("" ::: "memory");
    const int c = lane & 7;
#pragma unroll
    for (int j = 0; j < 4; ++j) { const int n = (lane >> 3) + 8 * j; const LAS float* s = scr + (8 * c) * 33 + n;
        u32x4 o; o.x = pk2(s[0 * 33], s[1 * 33]); o.y = pk2(s[2 * 33], s[3 * 33]); o.z = pk2(s[4 * 33], s[5 * 33]); o.w = pk2(s[6 * 33], s[7 * 33]);
        *(u32x4*)(WT + (size_t)(row0 + n) * ldk + kc0 + k0 + 8 * c) = o; }
    LDS_WAIT(); asm volatile("" ::: "memory");
}
__device__ __forceinline__ void phase0(const Params& p, LAS unsigned char* lds, int G) {
    const int tid = threadIdx.x, lane = tid & 63, wave = __builtin_amdgcn_readfirstlane(tid >> 6);
    unsigned char* ws = p.ws;
    {
        LAS float* sc = (LAS float*)lds;
        LAS float* red = (LAS float*)(lds + 4096);
        float* modp = (float*)(ws + WS_MODP);
        for (int it = blockIdx.x; it < 24 * 8; it += G) {
            const int nb = it % 24, kc = it / 24;
            for (int i = tid; i < 1024; i += NTHR) { const int b = i >> 7, k = i & 127; sc[i] = silu_f(p.c[b * 1024 + kc * 128 + k]); }
            __syncthreads();
            const int col = tid & 255, kh = tid >> 8;
            float acc[8];
#pragma unroll
            for (int b = 0; b < 8; ++b) acc[b] = 0.f;
            const float* wp = p.w_ada + (size_t)(kc * 128 + kh * 64) * 6144 + nb * 256 + col;
#pragma unroll 8
            for (int kk = 0; kk < 64; ++kk) { const float w = wp[(size_t)kk * 6144];
#pragma unroll
                for (int b = 0; b < 8; ++b) acc[b] += sc[b * 128 + kh * 64 + kk] * w; }
            if (kh == 1) {
#pragma unroll
                for (int b = 0; b < 8; ++b) red[b * 256 + col] = acc[b]; }
            __syncthreads();
            if (kh == 0) { const int n = nb * 256 + col; const float bias = (kc == 0) ? p.b_ada[n] : 0.f;
#pragma unroll
                for (int b = 0; b < 8; ++b) modp[(size_t)(kc * 8 + b) * 6144 + n] = acc[b] + red[b * 256 + col] + bias; }
            __syncthreads();
        }
    }
    for (int i = blockIdx.x * NTHR + tid; i < T * 4 / 4; i += G * NTHR) ((f32x4*)(ws + WS_SS))[i] = (f32x4){0.f, 0.f, 0.f, 0.f};
    LAS float* scr = (LAS float*)(lds + 16384 + wave * 8448);
    const int gw = blockIdx.x * NWAVES + wave, NGW = G * NWAVES;
    bf16* WinT = (bf16*)(ws + WS_WIN); bf16* WoutT = (bf16*)(ws + WS_WOUT);
    bf16* LruB = (bf16*)(ws + WS_LRUB); bf16* SubK = (bf16*)(ws + WS_SUBK);
    constexpr int I_IN = 16 * (NPAD / 32), I_OUT = 16 * 32, I_Q = 2048, I_LRU = 16 * 8, I_SUB = 2048;
    constexpr int NIT = I_IN + I_OUT + I_Q + I_LRU + I_SUB;
    for (int it = gw; it < NIT; it += NGW) {
        int r = it;
        if (r < I_IN) { const int nb = r % (NPAD / 32), kb = r / (NPAD / 32), nq = nb * 32; int n0, nv;
            if (nq < 3072) { n0 = nq; nv = 32; } else if (nq < 7168) { n0 = nq + 16; nv = 32; } else if (nq == 7168) { n0 = 3072; nv = 16; } else { n0 = 0; nv = 0; }
            p0_transpose_item(p.w_in, 7184, kb * 64, n0, nv, WinT, 1024, nq, 0, scr, lane); continue; } r -= I_IN;
        if (r < I_OUT) { const int nb = r % 32, kb = r / 32; p0_transpose_item(p.w_out, 1024, kb * 64, nb * 32, 32, WoutT, 1024, nb * 32, 0, scr, lane); continue; } r -= I_OUT;
        if (r < I_Q) {
            const float* src = p.wq + (size_t)r * 1024; bf16* dst = (bf16*)(ws + WS_WQB) + (size_t)r * 1024;
#pragma unroll
            for (int j = 0; j < 2; ++j) { const f32x4 a = *(const f32x4*)(src + j * 512 + lane * 8), b = *(const f32x4*)(src + j * 512 + lane * 8 + 4);
                u32x4 o; o.x = pk2(a.x, a.y); o.y = pk2(a.z, a.w); o.z = pk2(b.x, b.y); o.w = pk2(b.z, b.w);
                *(u32x4*)(dst + j * 512 + lane * 8) = o; }
            continue; } r -= I_Q;
        if (r < I_LRU) {
            const int mat = r >> 3, sub = r & 7, g = mat >> 3, n = mat & 7, kb = sub >> 2, nb = sub & 3;
            const int np = n < 6 ? n : 6, half = n - np;
            const float* W = (g ? p.lwx : p.lwa) + (size_t)n * 128 * 128;
            bf16* dst = LruB + (size_t)n * 256 * 256;
            p0_transpose_item(W, 128, kb * 64, nb * 32, 32, dst, 256, g * 128 + nb * 32, half * 128, scr, lane);
            p0_transpose_item(W, 128, kb * 64, 0, 0, dst, 256, g * 128 + nb * 32, (1 - half) * 128, scr, lane);
            continue; } r -= I_LRU;
        if (r < I_SUB) {
            const int h = r >> 8, pp = (r >> 7) & 1, n = r & 127;
            const float* src = p.subk + (size_t)r * 128; bf16* dst = SubK + ((size_t)h * 256 + pp * 128 + n) * 256;
            const f32x2 v = *(const f32x2*)(src + 2 * lane);
            *(unsigned*)(dst + pp * 128 + 2 * lane) = pk2(v.x, v.y);
            *(unsigned*)(dst + (1 - pp) * 128 + 2 * lane) = 0u;
            continue; } r -= I_SUB;
    }
}

__device__ __forceinline__ void fp6_row_store(const Params& p, int r, const f32x4 (&v)[4], int lane) {
    unsigned char* ws = p.ws; const int tb = r >> 14, row = r & 16383;
    float am = 0.f;
#pragma unroll
    for (int j = 0; j < 4; ++j) am = fmaxf(am, fmaxf(fmaxf(fabsf(v[j].x), fabsf(v[j].y)), fmaxf(fabsf(v[j].z), fabsf(v[j].w))));
#pragma unroll
    for (int o = 1; o < 64; o <<= 1) am = fmaxf(am, __shfl_xor(am, o));
    const float inv = am > 0.f ? 7.5f / am : 0.f;
    unsigned long long lo = 0ull; unsigned hi = 0u;
#pragma unroll
    for (int j = 0; j < 16; ++j) { const float x = v[j >> 2][j & 3] * inv, a = fabsf(x);
        unsigned code = a < 1.f ? (unsigned)__builtin_rintf(a * 8.f) : (a < 2.f ? 8u + (unsigned)__builtin_rintf((a - 1.f) * 8.f) : (a < 4.f ? 16u + (unsigned)__builtin_rintf((a - 2.f) * 4.f) : 24u + (unsigned)__builtin_rintf((a - 4.f) * 2.f)));
        code = code > 31u ? 31u : code; code |= (x < 0.f) ? 32u : 0u;
        const int bit = 6 * j;
        if (bit + 6 <= 64) lo |= (unsigned long long)code << bit;
        else if (bit >= 64) hi |= code << (bit - 64);
        else { lo |= (unsigned long long)code << bit; hi |= code >> (64 - bit); } }
    unsigned* dst = (unsigned*)(ws + (tb ? WS_V : WS_U) + (size_t)row * 768 + lane * 12);
    dst[0] = (unsigned)lo; dst[1] = (unsigned)(lo >> 32); dst[2] = hi;
    if (lane == 0) ((float*)(ws + (tb ? WS_SV : WS_SU)))[row] = am * (1.f / 7.5f);
}
__device__ __forceinline__ void convert_tables(const Params& p, int gw, int ngw, int lane) {
    for (int r = gw; r < 2 * 16384; r += 2 * ngw) {
        const int r2 = r + ngw; const bool has2 = r2 < 2 * 16384; const int r2c = has2 ? r2 : r;
        const float* s1 = ((r >> 14) ? p.pv : p.pu) + (size_t)(r & 16383) * 1024 + lane * 16;
        const float* s2 = ((r2c >> 14) ? p.pv : p.pu) + (size_t)(r2c & 16383) * 1024 + lane * 16;
        f32x4 v1[4], v2[4];
#pragma unroll
        for (int j = 0; j < 4; ++j) { v1[j] = *(const f32x4*)(s1 + 4 * j); v2[j] = *(const f32x4*)(s2 + 4 * j); }
        fp6_row_store(p, r, v1, lane);
        if (has2) fp6_row_store(p, r2, v2, lane);
    }
}

__device__ __forceinline__ float mod_at(const float* modp, int b, int n) {
    float s = 0.f;
#pragma unroll
    for (int kc = 0; kc < 8; ++kc) s += modp[(size_t)(kc * 8 + b) * 6144 + n];
    return s;
}

__device__ __forceinline__ void phase1(const Params& p, LAS unsigned char* lds, int G) {
    const int tid = threadIdx.x, lane = tid & 63, wave = __builtin_amdgcn_readfirstlane(tid >> 6);
    const float* modp = (const float*)(p.ws + WS_MODP);
    LAS float* gs = (LAS float*)lds; LAS float* sh = gs + 1024;
    bf16* H = (bf16*)p.out;
    for (int tile = blockIdx.x; tile < T / 256; tile += G) {
        const int b = tile / 32;
        __syncthreads();
        for (int k = tid; k < 1024; k += NTHR) { gs[k] = p.npm[k] * (1.f + mod_at(modp, b, 1024 + k)); sh[k] = mod_at(modp, b, k); }
        __syncthreads();
        for (int rr = 0; rr < 32; ++rr) {
            const size_t row = (size_t)tile * 256 + rr * 8 + wave;
            const f32x4* xr = (const f32x4*)(p.x + row * 1024) + lane;
            f32x4 v[4]; float s = 0.f;
#pragma unroll
            for (int j = 0; j < 4; ++j) { v[j] = xr[64 * j]; s += (v[j].x * v[j].x + v[j].y * v[j].y) + (v[j].z * v[j].z + v[j].w * v[j].w); }
            const float rstd = __builtin_amdgcn_rsqf(wave_sum(s) * (1.f / 1024.f) + 1e-6f);
            u32x2* o8 = (u32x2*)(H + row * 1024) + lane;
#pragma unroll
            for (int j = 0; j < 4; ++j) { const int k = 256 * j + 4 * lane; const f32x4 g4 = *(const LAS f32x4*)(gs + k), s4 = *(const LAS f32x4*)(sh + k);
                u32x2 w; w.x = pk2(v[j].x * rstd * g4.x + s4.x, v[j].y * rstd * g4.y + s4.y); w.y = pk2(v[j].z * rstd * g4.z + s4.z, v[j].w * rstd * g4.w + s4.w);
                o8[64 * j] = w; }
        }
    }
}

typedef short bf16x8_t __attribute__((ext_vector_type(8)));
template <bool FINAL>
__device__ __forceinline__ void phase_lru(const Params& p, LAS unsigned char* lds, int G) {
    const int tid = threadIdx.x, lane = tid & 63, wave = __builtin_amdgcn_readfirstlane(tid >> 6), q4 = lane >> 4, c16 = lane & 15;
    constexpr int PQ = 136;
    LAS bf16* XC = (LAS bf16*)lds;
    LAS bf16* HB = XC + 64 * PQ;
    LAS float* CW = (LAS float*)(HB + 64 * PQ);
    const bf16* XL = (const bf16*)(p.ws + WS_XLXG); const bf16* LruB = (const bf16*)(p.ws + WS_LRUB);
    const bf16* XG = (const bf16*)(p.ws + WS_XLXG) + 1024; const bf16* GB = (const bf16*)(p.ws + WS_GAGB) + 1024; bf16* GA = (bf16*)(p.ws + WS_GAGB);
    const bf16* O = (const bf16*)(p.ws + WS_QKV) + 1024; const bf16* R = (const bf16*)(p.ws + WS_R); const float* SS = (const float*)(p.ws + WS_SS);
    f32x2* CAR = (f32x2*)(p.ws + WS_LRUC);
    const int c8 = tid & 15, tr = tid >> 4;
    for (int it = blockIdx.x; it < 8 * 8 * 4; it += G) {
        const int sg = it & 3, n = (it >> 2) & 7, b = it >> 5;
        const int chc = n * 128 + c8 * 8;
        const int chm = n * 128 + wave * 16 + c16;
        __syncthreads();
        for (int i = tid; i < 768; i += NTHR) { const int q = i >> 7, c = i & 127; CW[i] = q < 4 ? p.conv_w[q * 1024 + n * 128 + c] : (q == 4 ? p.conv_b[n * 128 + c] : p.gla_norm[n * 128 + c]); }
        const float ba = p.lba[chm], bx = p.lbx[chm], sp = -8.f * softplus_f(-p.lam[chm]);
        bf16x8_t wf[2][4];
        { const int np = n < 6 ? n : 6, half = n - np;
#pragma unroll
          for (int g = 0; g < 2; ++g)
#pragma unroll
              for (int ks = 0; ks < 4; ++ks) wf[g][ks] = *(const bf16x8_t*)(LruB + (size_t)n * 65536 + (size_t)(g * 128 + wave * 16 + c16) * 256 + half * 128 + ks * 32 + q4 * 8); }
        float hc = 0.f, aseg = 1.f;
        if (FINAL) { for (int s = 0; s < 4 * sg; ++s) { const f32x2 c = CAR[(size_t)((b * 8 + n) * 12 + s) * 128 + wave * 16 + c16]; hc = c.x * hc + c.y; } }
        constexpr int NTL = FINAL ? 32 : 24;
        const size_t tseg = (size_t)b * SEQ + (size_t)sg * (NTL * 64);
        u32x4 xr[5];
#define LRU_LOADX(t0_) do { _Pragma("unroll") for (int _k = 0; _k < 5; ++_k) { const long _t = (long)(t0_) + 2 * tr + _k - 3; \
            xr[_k] = (_t < (long)b * SEQ) ? (u32x4){0u, 0u, 0u, 0u} : *(const u32x4*)(XL + (size_t)_t * 2048 + chc); } } while (0)
        LRU_LOADX(tseg);
        __syncthreads();
#pragma unroll 1
        for (int tl = 0; tl < NTL; ++tl) {
            const size_t t0 = tseg + tl * 64;
            { float xv[5][8];
#pragma unroll
              for (int k = 0; k < 5; ++k) { xv[k][0] = bflo(xr[k].x); xv[k][1] = bfhi(xr[k].x); xv[k][2] = bflo(xr[k].y); xv[k][3] = bfhi(xr[k].y); xv[k][4] = bflo(xr[k].z); xv[k][5] = bfhi(xr[k].z); xv[k][6] = bflo(xr[k].w); xv[k][7] = bfhi(xr[k].w); }
              float cw[5][8];
#pragma unroll
              for (int q = 0; q < 5; ++q) { const f32x4 w0 = *(const LAS f32x4*)(CW + q * 128 + c8 * 8), w1 = *(const LAS f32x4*)(CW + q * 128 + c8 * 8 + 4);
                  cw[q][0] = w0.x; cw[q][1] = w0.y; cw[q][2] = w0.z; cw[q][3] = w0.w; cw[q][4] = w1.x; cw[q][5] = w1.y; cw[q][6] = w1.z; cw[q][7] = w1.w; }
#pragma unroll
              for (int i2 = 0; i2 < 2; ++i2) { float o[8];
#pragma unroll
                  for (int j = 0; j < 8; ++j) o[j] = cw[4][j] + cw[0][j] * xv[i2][j] + cw[1][j] * xv[i2 + 1][j] + cw[2][j] * xv[i2 + 2][j] + cw[3][j] * xv[i2 + 3][j];
                  *(LAS u32x4*)(XC + (2 * tr + i2) * PQ + c8 * 8) = (u32x4){pk2(o[0], o[1]), pk2(o[2], o[3]), pk2(o[4], o[5]), pk2(o[6], o[7])}; } }
            u32x4 mxg[2], mgb[2], mo[2], mr[2], mga[2]; float mss[2];
            if (FINAL) {
#pragma unroll
                for (int i2 = 0; i2 < 2; ++i2) { const size_t t = t0 + 2 * tr + i2;
                    mxg[i2] = *(const u32x4*)(XG + t * 2048 + chc); mgb[i2] = *(const u32x4*)(GB + t * 2048 + chc); mo[i2] = *(const u32x4*)(O + t * 2048 + chc);
                    mr[i2] = *(const u32x4*)(R + t * 1024 + chc); mga[i2] = *(const u32x4*)(GA + t * 2048 + chc); mss[i2] = SS[t * 4 + (chc >> 8)]; } }
            if (tl + 1 < NTL) LRU_LOADX(t0 + 64);
            __syncthreads();
            pg8::f32x4 acc[4][2];
#pragma unroll
            for (int tt = 0; tt < 4; ++tt) { acc[tt][0] = (pg8::f32x4){0.f, 0.f, 0.f, 0.f}; acc[tt][1] = (pg8::f32x4){0.f, 0.f, 0.f, 0.f}; }
#pragma unroll
            for (int ks = 0; ks < 4; ++ks)
#pragma unroll
                for (int tt = 0; tt < 4; ++tt) { const bf16x8_t a = *(const LAS bf16x8_t*)(XC + (tt * 16 + c16) * PQ + ks * 32 + q4 * 8);
                    acc[tt][0] = __builtin_amdgcn_mfma_f32_16x16x32_bf16(a, wf[0][ks], acc[tt][0], 0, 0, 0);
                    acc[tt][1] = __builtin_amdgcn_mfma_f32_16x16x32_bf16(a, wf[1][ks], acc[tt][1], 0, 0, 0); }
#pragma unroll
            for (int tt = 0; tt < 4; ++tt) {
                float av[4], uv[4];
#pragma unroll
                for (int j = 0; j < 4; ++j) { const float xc = bf2f(XC[(tt * 16 + q4 * 4 + j) * PQ + wave * 16 + c16]);
                    const float gr = sigmoid_f(acc[tt][0][j] + ba), gi = sigmoid_f(acc[tt][1][j] + bx);
                    const float a = __expf(sp * gr); av[j] = a; uv[j] = __builtin_amdgcn_sqrtf(fmaxf(1.f - a * a, 0.f)) * gi * xc; }
                float A4 = av[0], H4 = uv[0];
#pragma unroll
                for (int j = 1; j < 4; ++j) { H4 = av[j] * H4 + uv[j]; A4 *= av[j]; }
                float Ai = A4, Hi = H4;
                { const float Ap = __shfl_up(Ai, 16), Hp = __shfl_up(Hi, 16); if (q4 >= 1) { Hi = Hp * Ai + Hi; Ai = Ap * Ai; } }
                { const float Ap = __shfl_up(Ai, 32), Hp = __shfl_up(Hi, 32); if (q4 >= 2) { Hi = Hp * Ai + Hi; Ai = Ap * Ai; } }
                float Ae = __shfl_up(Ai, 16), He = __shfl_up(Hi, 16); if (q4 == 0) { Ae = 1.f; He = 0.f; }
                float h = hc * Ae + He;
                const float At = __shfl(Ai, 48 + c16), Ht = __shfl(Hi, 48 + c16);
                if (FINAL) {
#pragma unroll
                    for (int j = 0; j < 4; ++j) { h = av[j] * h + uv[j]; HB[(tt * 16 + q4 * 4 + j) * PQ + wave * 16 + c16] = (bf16)f2bf(h); } }
                hc = hc * At + Ht; aseg *= At;
            }
            if (!FINAL && (tl & 7) == 7) {
                if (q4 == 0) CAR[(size_t)((b * 8 + n) * 12 + sg * 3 + (tl >> 3)) * 128 + wave * 16 + c16] = (f32x2){aseg, hc};
                hc = 0.f; aseg = 1.f; }
            __syncthreads();
            if (FINAL) {
#pragma unroll
                for (int i2 = 0; i2 < 2; ++i2) { const size_t t = t0 + 2 * tr + i2;
                    const u32x4 hw = *(const LAS u32x4*)(HB + (2 * tr + i2) * PQ + c8 * 8);
                    const float rstd = __builtin_amdgcn_rsqf(mss[i2] * (1.f / 256.f) + 1e-6f);
                    const unsigned hwv[4] = {hw.x, hw.y, hw.z, hw.w}, xgv[4] = {mxg[i2].x, mxg[i2].y, mxg[i2].z, mxg[i2].w}, gbv[4] = {mgb[i2].x, mgb[i2].y, mgb[i2].z, mgb[i2].w};
                    const unsigned ov[4] = {mo[i2].x, mo[i2].y, mo[i2].z, mo[i2].w}, rv[4] = {mr[i2].x, mr[i2].y, mr[i2].z, mr[i2].w}, gav[4] = {mga[i2].x, mga[i2].y, mga[i2].z, mga[i2].w};
                    unsigned ow[4];
                    const f32x4 g0 = *(const LAS f32x4*)(CW + 640 + c8 * 8), g1 = *(const LAS f32x4*)(CW + 640 + c8 * 8 + 4);
                    const float gn[8] = {g0.x, g0.y, g0.z, g0.w, g1.x, g1.y, g1.z, g1.w};
#pragma unroll
                    for (int q = 0; q < 4; ++q) {
                        const float m0 = merge2(bflo(gav[q]), bflo(ov[q]) * rstd * gn[2 * q], bflo(rv[q]), bflo(gbv[q]), bflo(hwv[q]), bflo(xgv[q]));
                        const float m1 = merge2(bfhi(gav[q]), bfhi(ov[q]) * rstd * gn[2 * q + 1], bfhi(rv[q]), bfhi(gbv[q]), bfhi(hwv[q]), bfhi(xgv[q]));
                        ow[q] = pk2(m0, m1); }
                    *(u32x4*)(GA + t * 2048 + chc) = (u32x4){ow[0], ow[1], ow[2], ow[3]}; }
            }
        }
#undef LRU_LOADX
        __syncthreads();
    }
}

__device__ __forceinline__ void phase_gla_prep(const Params& p, LAS unsigned char* lds, int G) {
    const int tid = threadIdx.x;
    LAS float* segt = (LAS float*)lds;
    bf16* QKV = (bf16*)(p.ws + WS_QKV); const bf16* AL = (const bf16*)(p.ws + WS_ALOW); float* DK = (float*)(p.ws + WS_DK);
    const int kp = tid & 127, seg = tid >> 7;
    for (int it = blockIdx.x; it < 8 * 128 * 4; it += G) {
        const int h = it & 3, ch = (it >> 2) & 127, b = it >> 9;
        float wa[16];
#pragma unroll
        for (int r = 0; r < 16; ++r) wa[r] = p.w_alpha[r * 512 + h * 128 + kp];
        const float balpha = p.b_alpha[h * 128 + kp];
        const size_t t0 = (size_t)b * SEQ + ch * 64 + seg * 16;
        float qv[16], kv[16];
#pragma unroll
        for (int i = 0; i < 16; ++i) { qv[i] = bf2f(QKV[(t0 + i) * 2048 + h * 128 + kp]); kv[i] = bf2f(QKV[(t0 + i) * 2048 + 512 + h * 128 + kp]); }
        float cl[16]; float run = 0.f;
#pragma unroll
        for (int i = 0; i < 16; ++i) { const size_t t = t0 + i;
            const u32x4 a0 = *(const u32x4*)(AL + t * 16), a1 = *(const u32x4*)(AL + t * 16 + 8);
            float z = balpha;
            z += bflo(a0.x) * wa[0] + bfhi(a0.x) * wa[1] + bflo(a0.y) * wa[2] + bfhi(a0.y) * wa[3] + bflo(a0.z) * wa[4] + bfhi(a0.z) * wa[5] + bflo(a0.w) * wa[6] + bfhi(a0.w) * wa[7];
            z += bflo(a1.x) * wa[8] + bfhi(a1.x) * wa[9] + bflo(a1.y) * wa[10] + bfhi(a1.y) * wa[11] + bflo(a1.z) * wa[12] + bfhi(a1.z) * wa[13] + bflo(a1.w) * wa[14] + bfhi(a1.w) * wa[15];
            const float ls = fminf(z, 0.f) - __logf(1.f + __expf(-fabsf(z)));
            run += ls * (1.f / 16.f); cl[i] = run; }
        __syncthreads();
        segt[seg * 128 + kp] = run;
        __syncthreads();
        float off = 0.f, tot = 0.f;
#pragma unroll
        for (int s = 0; s < 4; ++s) { const float v = segt[s * 128 + kp]; tot += v; if (s < seg) off += v; }
        if (seg == 0) DK[(size_t)(b * 128 + ch) * 512 + h * 128 + kp] = __expf(tot);
#pragma unroll
        for (int i = 0; i < 16; ++i) { const float cum = cl[i] + off;
            QKV[(t0 + i) * 2048 + h * 128 + kp] = (bf16)f2bf(qv[i] * 0.08838834764831845f * __expf(cum));
            QKV[(t0 + i) * 2048 + 512 + h * 128 + kp] = (bf16)f2bf(kv[i] * __expf(-cum)); }
    }
}
__device__ __forceinline__ bf16x8_t lds_col8(const LAS bf16* base, int pitch) {
    unsigned w[4];
#pragma unroll
    for (int i = 0; i < 4; ++i) w[i] = (unsigned)base[(2 * i) * pitch] | ((unsigned)base[(2 * i + 1) * pitch] << 16);
    return __builtin_bit_cast(bf16x8_t, (u32x4){w[0], w[1], w[2], w[3]});
}
__device__ __forceinline__ void phase_gla_seq(const Params& p, LAS unsigned char* lds, int G) {
    const int tid = threadIdx.x, lane = tid & 63, wave = __builtin_amdgcn_readfirstlane(tid >> 6), q4 = lane >> 4, c16 = lane & 15;
    constexpr int PQ = 136, PS = 72, PV = 34;
    LAS bf16* Qs = (LAS bf16*)lds;
    LAS bf16* Kd = Qs + 64 * PQ;
    LAS bf16* Vt = Kd + 64 * PQ;
    LAS bf16* Pm = Vt + 64 * PV + 64;
    LAS bf16* ST = Pm + 64 * PS;
    LAS float* dk = (LAS float*)(ST + 32 * PQ);
    const bf16* QKV = (const bf16*)(p.ws + WS_QKV); bf16* VO = (bf16*)(p.ws + WS_QKV); const float* DK = (const float*)(p.ws + WS_DK); float* SS = (float*)(p.ws + WS_SS);
    const int r0 = tid >> 4, cc = (tid & 15) * 8;
    const int vr = (tid >> 2) & 63, vc = (tid & 3) * 8;
    for (int it = blockIdx.x; it < 8 * 4 * 8; it += G) {
        const int xg_ = it & 7, jg_ = it >> 3, bh = xg_ * 4 + (jg_ >> 3), v8 = jg_ & 7, h = bh & 3, b = bh >> 2;
        pg8::f32x4 sacc[2] = {(pg8::f32x4){0.f, 0.f, 0.f, 0.f}, (pg8::f32x4){0.f, 0.f, 0.f, 0.f}};
        __syncthreads();
        for (int i = tid; i < 32 * PQ / 2; i += NTHR) ((LAS unsigned*)ST)[i] = 0u;
        u32x4 rq[2], rk[2], rv; float rdk = 0.f;
#define GLA_LOAD(chn) do { const size_t _t0 = (size_t)b * SEQ + (size_t)(chn) * 64; \
            _Pragma("unroll") for (int _j = 0; _j < 2; ++_j) { rq[_j] = *(const u32x4*)(QKV + (_t0 + r0 + 32 * _j) * 2048 + h * 128 + cc); rk[_j] = *(const u32x4*)(QKV + (_t0 + r0 + 32 * _j) * 2048 + 512 + h * 128 + cc); } \
            rv = *(const u32x4*)(QKV + (_t0 + vr) * 2048 + 1024 + h * 256 + v8 * 32 + vc); \
            rdk = DK[(size_t)(b * 128 + (chn)) * 512 + h * 128 + (tid & 127)]; } while (0)
        GLA_LOAD(0);
#pragma unroll 1
        for (int ch = 0; ch < SEQ / 64; ++ch) {
            const size_t t0 = (size_t)b * SEQ + ch * 64;
#pragma unroll
            for (int j = 0; j < 2; ++j) { *(LAS u32x4*)(Qs + (r0 + 32 * j) * PQ + cc) = rq[j]; *(LAS u32x4*)(Kd + (r0 + 32 * j) * PQ + cc) = rk[j]; }
            if (tid < 256) { LAS unsigned* vd = (LAS unsigned*)(Vt + vr * PV + vc); vd[0] = rv.x; vd[1] = rv.y; vd[2] = rv.z; vd[3] = rv.w; }
            if (tid < 128) dk[tid] = rdk;
            if (ch + 1 < SEQ / 64) GLA_LOAD(ch + 1);
            __syncthreads();
            { const int tt = wave & 3;
#pragma unroll
              for (int i2 = 0; i2 < 2; ++i2) { const int ts = (wave >> 2) * 2 + i2;
                  pg8::f32x4 acc = (pg8::f32x4){0.f, 0.f, 0.f, 0.f};
                  if (ts <= tt) {
#pragma unroll
                      for (int ks = 0; ks < 4; ++ks) { const bf16x8_t a = *(const LAS bf16x8_t*)(Kd + (ts * 16 + c16) * PQ + ks * 32 + q4 * 8), bb = *(const LAS bf16x8_t*)(Qs + (tt * 16 + c16) * PQ + ks * 32 + q4 * 8);
                          acc = __builtin_amdgcn_mfma_f32_16x16x32_bf16(a, bb, acc, 0, 0, 0); }
                      const int tg = tt * 16 + c16, sgl = ts * 16 + q4 * 4;
#pragma unroll
                      for (int j = 0; j < 4; ++j) if (sgl + j > tg) acc[j] = 0.f;
                  }
                  *(LAS u32x2*)(Pm + (tt * 16 + c16) * PS + ts * 16 + q4 * 4) = (u32x2){pk2(acc[0], acc[1]), pk2(acc[2], acc[3])}; } }
            bf16x8_t vf[2][2], kf[2];
#pragma unroll
            for (int ks = 0; ks < 2; ++ks) { kf[ks] = lds_col8(Kd + (ks * 32 + q4 * 8) * PQ + wave * 16 + c16, PQ);
#pragma unroll
                for (int tv = 0; tv < 2; ++tv) vf[tv][ks] = lds_col8(Vt + (ks * 32 + q4 * 8) * PV + tv * 16 + c16, PV); }
            __syncthreads();
            { const int tt = wave & 3, tv = wave >> 2;
              pg8::f32x4 oacc = (pg8::f32x4){0.f, 0.f, 0.f, 0.f};
#pragma unroll
              for (int ks = 0; ks < 2; ++ks) { const bf16x8_t bb = *(const LAS bf16x8_t*)(Pm + (tt * 16 + c16) * PS + ks * 32 + q4 * 8);
                  oacc = __builtin_amdgcn_mfma_f32_16x16x32_bf16(tv ? vf[1][ks] : vf[0][ks], bb, oacc, 0, 0, 0); }
#pragma unroll
              for (int ks = 0; ks < 4; ++ks) { const bf16x8_t bb = *(const LAS bf16x8_t*)(Qs + (tt * 16 + c16) * PQ + ks * 32 + q4 * 8), a = *(const LAS bf16x8_t*)(ST + (tv * 16 + c16) * PQ + ks * 32 + q4 * 8);
                  oacc = __builtin_amdgcn_mfma_f32_16x16x32_bf16(a, bb, oacc, 0, 0, 0); }
              *(u32x2*)(VO + (t0 + tt * 16 + c16) * 2048 + 1024 + h * 256 + v8 * 32 + tv * 16 + q4 * 4) = (u32x2){pk2(oacc[0], oacc[1]), pk2(oacc[2], oacc[3])};
              float sq = (oacc[0] * oacc[0] + oacc[1] * oacc[1]) + (oacc[2] * oacc[2] + oacc[3] * oacc[3]);
              sq += __shfl_xor(sq, 16); sq += __shfl_xor(sq, 32);
              if (q4 == 0) atomicAdd(SS + (t0 + tt * 16 + c16) * 4 + h, sq); }
#pragma unroll
            for (int ks = 0; ks < 2; ++ks)
#pragma unroll
                for (int tv = 0; tv < 2; ++tv) sacc[tv] = __builtin_amdgcn_mfma_f32_16x16x32_bf16(kf[ks], vf[tv][ks], sacc[tv], 0, 0, 0);
            { const pg8::f32x4 d4 = *(const LAS pg8::f32x4*)(dk + wave * 16 + q4 * 4);
#pragma unroll
              for (int tv = 0; tv < 2; ++tv) sacc[tv] = sacc[tv] * d4; }
            __syncthreads();
#pragma unroll
            for (int tv = 0; tv < 2; ++tv) *(LAS u32x2*)(ST + (tv * 16 + c16) * PQ + wave * 16 + q4 * 4) = (u32x2){pk2(sacc[tv][0], sacc[tv][1]), pk2(sacc[tv][2], sacc[tv][3])};
        }
#undef GLA_LOAD
    }
}

__device__ __forceinline__ void phase_norm2(const Params& p, LAS unsigned char* lds, int G) {
    const int tid = threadIdx.x, lane = tid & 63, wave = __builtin_amdgcn_readfirstlane(tid >> 6);
    const float* modp = (const float*)(p.ws + WS_MODP);
    LAS float* g1 = (LAS float*)lds; LAS float* gs = g1 + 1024; LAS float* sh = gs + 1024;
    const bf16* Y = (const bf16*)(p.ws + WS_Y); bf16* H2 = (bf16*)(p.ws + WS_H2);
    for (int tile = blockIdx.x; tile < T / 256; tile += G) {
        const int b = tile / 32;
        __syncthreads();
        for (int k = tid; k < 1024; k += NTHR) { g1[k] = mod_at(modp, b, 2048 + k) * p.npo[k]; gs[k] = p.npf[k] * (1.f + mod_at(modp, b, 4096 + k)); sh[k] = mod_at(modp, b, 3072 + k); }
        __syncthreads();
        for (int rr = 0; rr < 32; ++rr) {
            const size_t row = (size_t)tile * 256 + rr * 8 + wave;
            const f32x4* xr = (const f32x4*)(p.x + row * 1024) + lane; const u32x2* yr = (const u32x2*)(Y + row * 1024) + lane;
            f32x4 xv[4], yv[4]; float s = 0.f;
#pragma unroll
            for (int j = 0; j < 4; ++j) { xv[j] = xr[64 * j]; const u32x2 yw = yr[64 * j]; yv[j] = (f32x4){bflo(yw.x), bfhi(yw.x), bflo(yw.y), bfhi(yw.y)};
                s += (yv[j].x * yv[j].x + yv[j].y * yv[j].y) + (yv[j].z * yv[j].z + yv[j].w * yv[j].w); }
            const float rstd = __builtin_amdgcn_rsqf(wave_sum(s) * (1.f / 1024.f) + 1e-6f);
            float s2 = 0.f;
            f32x4* orow = (f32x4*)(p.out + row * 1024) + lane;
#pragma unroll
            for (int j = 0; j < 4; ++j) { const int k = 256 * j + 4 * lane; const f32x4 g4 = *(const LAS f32x4*)(g1 + k);
                xv[j] = xv[j] + yv[j] * rstd * g4; orow[64 * j] = xv[j];
                s2 += (xv[j].x * xv[j].x + xv[j].y * xv[j].y) + (xv[j].z * xv[j].z + xv[j].w * xv[j].w); }
            const float rstd2 = __builtin_amdgcn_rsqf(wave_sum(s2) * (1.f / 1024.f) + 1e-6f);
            u32x2* o8 = (u32x2*)(H2 + row * 1024) + lane;
#pragma unroll
            for (int j = 0; j < 4; ++j) { const int k = 256 * j + 4 * lane; const f32x4 g4 = *(const LAS f32x4*)(gs + k), s4 = *(const LAS f32x4*)(sh + k);
                u32x2 w; w.x = pk2(xv[j].x * rstd2 * g4.x + s4.x, xv[j].y * rstd2 * g4.y + s4.y); w.y = pk2(xv[j].z * rstd2 * g4.z + s4.z, xv[j].w * rstd2 * g4.w + s4.w);
                o8[64 * j] = w; }
        }
    }
}

__device__ __forceinline__ unsigned h16_key(unsigned b) { return (b & 0x8000u) ? (~b & 0xffffu) : (b | 0x8000u); }
__device__ __forceinline__ float h16_key_val(unsigned s) { const unsigned b = (s & 0x8000u) ? (s & 0x7fffu) : (~s & 0xffffu); return (float)__builtin_bit_cast(_Float16, (unsigned short)b); }
template <bool ASC> __device__ __forceinline__ void sort16(unsigned (&k)[16]) {
#pragma unroll
    for (int size = 2; size <= 16; size <<= 1)
#pragma unroll
        for (int stride = size >> 1; stride > 0; stride >>= 1)
#pragma unroll
            for (int i = 0; i < 16; ++i) { const int j = i ^ stride; if (j > i) { const bool up = ((i & size) == 0) == ASC; const unsigned lo = min(k[i], k[j]), hi = max(k[i], k[j]); k[i] = up ? lo : hi; k[j] = up ? hi : lo; } }
}
__device__ __forceinline__ void merge16_desc(unsigned (&k)[16]) {
#pragma unroll
    for (int stride = 8; stride > 0; stride >>= 1)
#pragma unroll
        for (int i = 0; i < 16; ++i) { const int j = i ^ stride; if (j > i) { const unsigned lo = min(k[i], k[j]), hi = max(k[i], k[j]); k[i] = hi; k[j] = lo; } }
}
__device__ __forceinline__ void top16_merge(unsigned (&top)[16], unsigned (&grp)[16]) {
    sort16<true>(grp);
#pragma unroll
    for (int i = 0; i < 16; ++i) top[i] = max(top[i], grp[i]);
    merge16_desc(top);
}
__device__ __forceinline__ void keys16(unsigned (&k)[16], const u32x4 w0, const u32x4 w1, int n0) {
    const unsigned ww[8] = {w0.x, w0.y, w0.z, w0.w, w1.x, w1.y, w1.z, w1.w};
#pragma unroll
    for (int q = 0; q < 8; ++q) { k[2 * q] = (h16_key(ww[q] & 0xffffu) << 16) | (unsigned)(127 - (n0 + 2 * q)); k[2 * q + 1] = (h16_key(ww[q] >> 16) << 16) | (unsigned)(127 - (n0 + 2 * q + 1)); }
}
__device__ __forceinline__ void topk_item(const unsigned short* SC, const float* SU, const float* SV, int t, int h, volatile LAS unsigned* my, unsigned (&outw)[16], float (&outs)[16]) {
    const u32x4* src = (const u32x4*)(SC + (size_t)t * 2048 + h * 256);
    unsigned topA[16], topB[16];
    keys16(topA, src[0], src[1], 0); sort16<false>(topA);
#pragma unroll 1
    for (int g = 1; g < 8; ++g) { unsigned grp[16]; keys16(grp, src[2 * g], src[2 * g + 1], 16 * g); top16_merge(topA, grp); }
    keys16(topB, src[16], src[17], 0); sort16<false>(topB);
#pragma unroll 1
    for (int g = 1; g < 8; ++g) { unsigned grp[16]; keys16(grp, src[16 + 2 * g], src[17 + 2 * g], 16 * g); top16_merge(topB, grp); }
    float fa[16], fb[16];
#pragma unroll
    for (int j = 0; j < 16; ++j) { fa[j] = h16_key_val(topA[j] >> 16); fb[j] = h16_key_val(topB[j] >> 16); my[j] = 127u - (topA[j] & 127u); my[16 + j] = 127u - (topB[j] & 127u); }
    unsigned ct[16];
#pragma unroll
    for (int g = 0; g < 4; ++g) { unsigned grp[16];
#pragma unroll
        for (int s = 0; s < 16; ++s) grp[s] = 0u;
        { int slot = 0;
#pragma unroll
          for (int i = 0; i < 16; ++i)
#pragma unroll
              for (int j = 0; j < 16; ++j) if ((i + 1) * (j + 1) <= 16) { if ((slot >> 4) == g) {
                  const float s = fa[i] + fb[j]; unsigned u = __builtin_bit_cast(unsigned, s); u ^= (u >> 31) ? 0xffffffffu : 0x80000000u;
                  grp[slot & 15] = (u & 0xffffff00u) | (unsigned)(255 - (i * 16 + j)); } ++slot; } }
        if (g == 0) { sort16<false>(grp);
#pragma unroll
            for (int s = 0; s < 16; ++s) ct[s] = grp[s]; }
        else top16_merge(ct, grp); }
    float val[16], mx, sum = 0.f;
#pragma unroll
    for (int m = 0; m < 16; ++m) { unsigned u = ct[m] & 0xffffff00u; u ^= (u >> 31) ? 0x80000000u : 0xffffffffu; val[m] = __builtin_bit_cast(float, u); }
    mx = val[0];
#pragma unroll
    for (int m = 0; m < 16; ++m) { val[m] = __expf(val[m] - mx); sum += val[m]; }
    const float inv = 1.f / sum;
    LDS_WAIT();
#pragma unroll
    for (int m = 0; m < 16; ++m) { const unsigned pos = 255u - (ct[m] & 255u), i = pos >> 4, j = pos & 15u;
        const unsigned e = my[i] * 128u + my[16 + j];
        outw[m] = (e << 16) | f2bf(val[m] * inv * SV[e]); outs[m] = SU[e]; }
}

typedef unsigned u32x3 __attribute__((ext_vector_type(3)));
typedef unsigned u32x6 __attribute__((ext_vector_type(6)));
typedef float f32x32 __attribute__((ext_vector_type(32)));
__device__ __forceinline__ float rdlane(float v, int l) { return __builtin_bit_cast(float, __builtin_amdgcn_readlane(__builtin_bit_cast(int, v), l)); }
__device__ __forceinline__ f32x32 fp6x2(u32x3 a, u32x3 b) { const u32x6 s = {a.x, a.y, a.z, b.x, b.y, b.z}; return __builtin_amdgcn_cvt_scalef32_pk32_f32_fp6(s, 1.0f); }
__device__ __forceinline__ void phase_gather(const Params& p, LAS unsigned char* lds, int G) {
    const int tid = threadIdx.x, lane = tid & 63, wave = __builtin_amdgcn_readfirstlane(tid >> 6);
    const float* modp = (const float*)(p.ws + WS_MODP);
    LAS float* g2 = (LAS float*)lds;
    const bf16* H2 = (const bf16*)(p.ws + WS_H2);
    const unsigned short* SC = (const unsigned short*)(p.ws + WS_SC); const float* SU = (const float*)(p.ws + WS_SU); const float* SV = (const float*)(p.ws + WS_SV);
    volatile LAS unsigned* RT = (volatile LAS unsigned*)(lds + 4096 + wave * 16640); volatile LAS float* RS = (volatile LAS float*)(RT + 1024);
    volatile LAS unsigned* myscr = RT + 2048 + lane * 33;
    const unsigned char* U6 = p.ws + WS_U; const unsigned char* V6 = p.ws + WS_V;
    for (int tile = blockIdx.x; tile < T / 256; tile += G) {
        const int b = tile / 32;
        __syncthreads();
        for (int k = tid; k < 1024; k += NTHR) g2[k] = mod_at(modp, b, 5120 + k) * p.npof[k];
        __syncthreads();
#pragma unroll 1
        for (int rr = 0; rr < 32; ++rr) {
            const size_t row = (size_t)tile * 256 + wave * 32 + rr;
            if ((rr & 7) == 0) {
                unsigned ow[16]; float os[16];
                __builtin_amdgcn_wave_barrier();
                topk_item(SC, SU, SV, (int)(row + (lane >> 3)), lane & 7, myscr, ow, os);
#pragma unroll
                for (int m = 0; m < 16; ++m) { RT[(lane >> 3) * 128 + (lane & 7) * 16 + m] = ow[m]; RS[(lane >> 3) * 128 + (lane & 7) * 16 + m] = os[m]; }
                asm volatile("s_waitcnt lgkmcnt(0)" ::: "memory"); __builtin_amdgcn_wave_barrier();
            }
            const int tl = rr & 7;
            float xt[16];
            { const u32x4 a = *(const u32x4*)(H2 + row * 1024 + lane * 16), c = *(const u32x4*)(H2 + row * 1024 + lane * 16 + 8);
              xt[0] = bflo(a.x); xt[1] = bfhi(a.x); xt[2] = bflo(a.y); xt[3] = bfhi(a.y); xt[4] = bflo(a.z); xt[5] = bfhi(a.z); xt[6] = bflo(a.w); xt[7] = bfhi(a.w);
              xt[8] = bflo(c.x); xt[9] = bfhi(c.x); xt[10] = bflo(c.y); xt[11] = bfhi(c.y); xt[12] = bflo(c.z); xt[13] = bfhi(c.z); xt[14] = bflo(c.w); xt[15] = bfhi(c.w); }
            float acc[16];
#pragma unroll
            for (int j = 0; j < 16; ++j) acc[j] = 0.f;
#pragma unroll 1
            for (int hh = 0; hh < 16; ++hh) {
                unsigned ww[8];
#pragma unroll
                for (int m = 0; m < 8; ++m) ww[m] = RT[tl * 128 + hh * 8 + m];
                u32x6 up[4], vp[4];
#pragma unroll
                for (int m = 0; m < 8; ++m) { const size_t eo = (size_t)((unsigned)__builtin_amdgcn_readfirstlane((int)ww[m]) >> 16) * 768 + lane * 12;
                    const u32x3 a = *(const u32x3*)(U6 + eo), c = *(const u32x3*)(V6 + eo);
                    if (m & 1) { up[m >> 1][3] = a.x; up[m >> 1][4] = a.y; up[m >> 1][5] = a.z; vp[m >> 1][3] = c.x; vp[m >> 1][4] = c.y; vp[m >> 1][5] = c.z; }
                    else { up[m >> 1][0] = a.x; up[m >> 1][1] = a.y; up[m >> 1][2] = a.z; vp[m >> 1][0] = c.x; vp[m >> 1][1] = c.y; vp[m >> 1][2] = c.z; } }
                const unsigned wa = RT[tl * 128 + hh * 8 + (lane >> 3)]; const float su = RS[tl * 128 + hh * 8 + (lane >> 3)];
                float pd[8];
#pragma unroll
                for (int m = 0; m < 8; m += 2) { const f32x32 f = __builtin_amdgcn_cvt_scalef32_pk32_f32_fp6(up[m >> 1], 1.0f);
                    float s0 = 0.f, s1 = 0.f;
#pragma unroll
                    for (int j = 0; j < 16; ++j) { s0 += xt[j] * f[j]; s1 += xt[j] * f[16 + j]; }
                    pd[m] = s0; pd[m + 1] = s1; __builtin_amdgcn_sched_barrier(0); }
#pragma unroll
                for (int j = 0; j < 4; ++j) { const bool up_ = (lane & 32) != 0; const float keep = up_ ? pd[j + 4] : pd[j], send = up_ ? pd[j] : pd[j + 4]; pd[j] = keep + __shfl_xor(send, 32); }
#pragma unroll
                for (int j = 0; j < 2; ++j) { const bool up_ = (lane & 16) != 0; const float keep = up_ ? pd[j + 2] : pd[j], send = up_ ? pd[j] : pd[j + 2]; pd[j] = keep + __shfl_xor(send, 16); }
                { const bool up_ = (lane & 8) != 0; const float keep = up_ ? pd[1] : pd[0], send = up_ ? pd[0] : pd[1]; pd[0] = keep + __shfl_xor(send, 8); }
                float d = pd[0]; d += __shfl_xor(d, 4); d += __shfl_xor(d, 2); d += __shfl_xor(d, 1);
                const float coef = bflo(wa) * gelu_f(su * d);
#pragma unroll
                for (int m = 0; m < 8; m += 2) { const f32x32 f = __builtin_amdgcn_cvt_scalef32_pk32_f32_fp6(vp[m >> 1], 1.0f); const float c0 = rdlane(coef, 8 * m), c1 = rdlane(coef, 8 * m + 8);
#pragma unroll
                    for (int j = 0; j < 16; ++j) acc[j] += c0 * f[j] + c1 * f[16 + j];
                    __builtin_amdgcn_sched_barrier(0); }
            }
            float s = 0.f;
#pragma unroll
            for (int j = 0; j < 16; ++j) s += acc[j] * acc[j];
            const float rstd = __builtin_amdgcn_rsqf(wave_sum(s) * (1.f / 1024.f) + 1e-6f);
            float* orow = p.out + row * 1024 + lane * 16;
#pragma unroll
            for (int q = 0; q < 4; ++q) { f32x4 o = *(const f32x4*)(orow + 4 * q); const f32x4 ga = *(const LAS f32x4*)(g2 + lane * 16 + 4 * q);
                o.x += ga.x * acc[4 * q] * rstd; o.y += ga.y * acc[4 * q + 1] * rstd; o.z += ga.z * acc[4 * q + 2] * rstd; o.w += ga.w * acc[4 * q + 3] * rstd;
                *(f32x4*)(orow + 4 * q) = o; }
        }
    }
}

#define XB_TMO      128
#define XB_XCNT(j)  (256  + 64 * (j))
#define XB_XSUB(j)  (1280 + 64 * (j))
#define XB_XGEN(j)  (2304 + 64 * (j))
#define XB_TOP      3328
#define XB_TOPGEN   3392
#define XCD_BAR_WORDS 3456
#define XB_SPIN_CAP (1u << 18)

__device__ __forceinline__ unsigned xb_ld(unsigned* p)              { return __hip_atomic_load(p, __ATOMIC_RELAXED, __HIP_MEMORY_SCOPE_AGENT); }
__device__ __forceinline__ unsigned xb_add(unsigned* p, unsigned v) { return __hip_atomic_fetch_add(p, v, __ATOMIC_RELAXED, __HIP_MEMORY_SCOPE_AGENT); }
__device__ __forceinline__ unsigned xb_xcc_id() { return (unsigned)__builtin_amdgcn_s_getreg((3 << 11) | 20) & 0xFu; }
#define XB_SPIN(cond, bar) do { unsigned _sp = 0; while (cond) { __builtin_amdgcn_s_sleep(1); \
    if ((++_sp & 255u) == 0u) { if (xb_ld(&(bar)[XB_TMO])) break; if (_sp > XB_SPIN_CAP) { atomicAdd(&(bar)[XB_TMO], 1u); break; } } } } while (0)

struct XcdBarrier {
    unsigned* bar; unsigned x;
    volatile LAS unsigned* st;
};

__device__ __forceinline__ XcdBarrier xcd_barrier_post(unsigned* bar, volatile LAS unsigned* st) {
    XcdBarrier b; b.bar = bar; b.x = xb_xcc_id(); b.st = st;
    if (threadIdx.x == 0) (void)xb_add(&bar[XB_XCNT(b.x)], 1u);
    return b;
}
__device__ __forceinline__ void xcd_barrier_complete(unsigned* bar, unsigned x, unsigned& nloc, unsigned& nx) {
    const unsigned G = gridDim.x * gridDim.y * gridDim.z;
    unsigned sum, cnt, mine, sp = 0u;
    for (;;) {
        sum = 0u; cnt = 0u; mine = 0u;
#pragma unroll
        for (unsigned j = 0; j < 16; ++j) { const unsigned c = xb_ld(&bar[XB_XCNT(j)]); sum += c; cnt += (c > 0u) ? 1u : 0u; mine = (j == x) ? c : mine; }
        if (sum == G) break;
        __builtin_amdgcn_s_sleep(1);
        if ((++sp & 255u) == 0u) { if (xb_ld(&bar[XB_TMO])) break; if (sp > XB_SPIN_CAP) { atomicAdd(&bar[XB_TMO], 1u); break; } }
    }
    nloc = mine > 0u ? mine : 1u; nx = cnt > 0u ? cnt : 1u;
}

__device__ __forceinline__ void xcd_barrier(const XcdBarrier& b) {
    asm volatile("s_waitcnt vmcnt(0)" ::: "memory");
    __syncthreads();
    if (threadIdx.x == 0) {
        unsigned* bar = b.bar;
        __builtin_amdgcn_s_waitcnt(0);
        unsigned nloc = b.st[0], nx = b.st[1];
        if (nloc == 0u) { xcd_barrier_complete(bar, b.x, nloc, nx); b.st[0] = nloc; b.st[1] = nx; }
        const unsigned old = xb_add(&bar[XB_XSUB(b.x)], 1u);
        const unsigned gen = old / nloc;
        if (old + 1u == (gen + 1u) * nloc) {
            __builtin_amdgcn_fence(__ATOMIC_RELEASE, "agent");
            asm volatile("s_waitcnt vmcnt(0)" ::: "memory");
            const unsigned og = xb_add(&bar[XB_TOP], 1u);
            const unsigned tg = og / nx;
            if (og + 1u == (tg + 1u) * nx) xb_add(&bar[XB_TOPGEN], 1u);
            else XB_SPIN(xb_ld(&bar[XB_TOPGEN]) == tg, bar);
            __builtin_amdgcn_fence(__ATOMIC_ACQUIRE, "agent");
            xb_add(&bar[XB_XGEN(b.x)], 1u);
            asm volatile("s_waitcnt vmcnt(0)" ::: "memory");
        } else {
            XB_SPIN(xb_ld(&bar[XB_XGEN(b.x)]) == gen, bar);
            __builtin_amdgcn_fence(__ATOMIC_ACQUIRE, "agent");
            asm volatile("s_waitcnt vmcnt(0)" ::: "memory");
        }
    }
    __syncthreads();
}


template <int PH>
__device__ __forceinline__ void run_phase(const Params& p, LAS unsigned char* lds, int G) {
    unsigned char* ws = p.ws;
    if constexpr (PH == 0) phase0(p, lds, G);
    else if constexpr (PH == 1) {
        { pg8::Gemm g{(const bf16*)(ws + WS_WQB), (const bf16*)(ws + WS_SUBK), 1024, 2048, 256, 2048}; pg8::StaticOrder S; S.init(1024, 2048, G, (int)blockIdx.x);
          EpiTrans E{(bf16*)(ws + WS_WQ), 1024}; pg8::gemm_phase<EpiTrans, pg8::StaticOrder, true, true, 2, 256, 2048>(lds, g, S, E);
          const int nb = (G > 32) ? G - 32 : G, bi = (G > 32) ? (int)blockIdx.x - 32 : (int)blockIdx.x;
          if (bi >= 0) convert_tables(p, bi * NWAVES + (int)__builtin_amdgcn_readfirstlane(threadIdx.x >> 6), nb * NWAVES, threadIdx.x & 63); }
        __syncthreads();
        phase1(p, lds, G); }
    else if constexpr (PH == 2) { pg8::Gemm g{(const bf16*)p.out, (const bf16*)(ws + WS_WIN), T, NPAD, 1024, 1024}; pg8::StaticOrder S; S.init(T, NPAD, G, (int)blockIdx.x);
        EpiSeg E{ws}; pg8::gemm_phase<EpiSeg, pg8::StaticOrder, true, true, 0, 1024, 1024>(lds, g, S, E); }
    else if constexpr (PH == 3) { phase_gla_prep(p, lds, G); __syncthreads(); phase_lru<false>(p, lds, G); }
    else if constexpr (PH == 4) phase_gla_seq(p, lds, G);
    else if constexpr (PH == 5) phase_lru<true>(p, lds, G);
    else if constexpr (PH == 6) { pg8::Gemm g{(const bf16*)(ws + WS_GAGB), (const bf16*)(ws + WS_WOUT), T, 1024, 1024, 2048}; pg8::StaticOrder S; S.init(T, 1024, G, (int)blockIdx.x);
        EpiPlain E{(bf16*)(ws + WS_Y), 1024}; pg8::gemm_phase<EpiPlain, pg8::StaticOrder, true, true, 0, 1024, 2048>(lds, g, S, E); }
    else if constexpr (PH == 7) phase_norm2(p, lds, G);
    else if constexpr (PH == 8) {
        pg8::Gemm g{(const bf16*)(ws + WS_H2), (const bf16*)(ws + WS_WQ), T, 2048, 1024, 1024}; pg8::StaticOrder S; S.init(T, 2048, G, (int)blockIdx.x);
        EpiF16 E{(unsigned short*)(ws + WS_SC), 2048}; pg8::gemm_phase<EpiF16, pg8::StaticOrder, true, true, 0, 1024, 1024>(lds, g, S, E); }
    else if constexpr (PH == 9) phase_gather(p, lds, G);
}
template <int PH>
__global__ void __launch_bounds__(NTHR, 2) k_phase(Params p) {
    extern __shared__ __attribute__((aligned(16))) unsigned char lds_raw[];
    run_phase<PH>(p, (LAS unsigned char*)lds_raw, (int)gridDim.x);
}
constexpr int LDS_BAR_OFF = LDS_BYTES - 16;
template <int PH>
__device__ __forceinline__ void run_from(const Params& p, LAS unsigned char* lds, int G, const XcdBarrier& bar) {
#if PROBE_PH >= 0
    unsigned long long pt0 = 0; if constexpr (PH == PROBE_PH) pt0 = __builtin_amdgcn_s_memrealtime();
#endif
    run_phase<PH>(p, lds, G);
    if constexpr (PH + 1 < N_PHASES) {
        if constexpr (PH == 0) cg::this_grid().sync();
        else xcd_barrier(bar);
    }
#if PROBE_PH >= 0
    if constexpr (PH == PROBE_PH) { const unsigned long long pt1 = __builtin_amdgcn_s_memrealtime(), span = pt1 - pt0;
        while (__builtin_amdgcn_s_memrealtime() - pt1 < (unsigned long long)PROBE_MULT * span) __builtin_amdgcn_s_sleep(8); }
#endif
    if constexpr (PH + 1 < N_PHASES) run_from<PH + 1>(p, lds, G, bar);
}
__global__ void __launch_bounds__(NTHR, 2) k_mega(Params p) {
    extern __shared__ __attribute__((aligned(16))) unsigned char lds_raw[];
    LAS unsigned char* lds = (LAS unsigned char*)lds_raw;
    if (threadIdx.x < 4) ((LAS unsigned*)(lds + LDS_BAR_OFF))[threadIdx.x] = 0u;
    __syncthreads();
    const XcdBarrier bar = xcd_barrier_post((unsigned*)(p.ws + WS_CTL), (volatile LAS unsigned*)(lds + LDS_BAR_OFF));
    run_from<0>(p, lds, (int)gridDim.x, bar);
}

extern "C" void kernel_launch(void* const* d_in, const int* in_sizes, int n_in, void* d_out, int out_size, void* d_ws, size_t ws_size, hipStream_t stream) {
    static int grid = 0;
    if (grid == 0) {
        if (n_in != 24 || in_sizes[0] != T * DM || out_size != T * DM || ws_size < WS_END) {
            fprintf(stderr, "kernel_launch: unexpected shapes: n_in %d in0 %d out %d ws %zu\n", n_in, n_in > 0 ? in_sizes[0] : -1, out_size, ws_size); grid = -1; return; }
        int dev = 0, cus = 0, per_cu = 0;
        if (hipGetDevice(&dev) != hipSuccess || hipDeviceGetAttribute(&cus, hipDeviceAttributeMultiprocessorCount, dev) != hipSuccess) { grid = -1; return; }
        if (hipFuncSetAttribute((const void*)k_mega, hipFuncAttributeMaxDynamicSharedMemorySize, LDS_BYTES) != hipSuccess) { fprintf(stderr, "kernel_launch: hipFuncSetAttribute failed\n"); grid = -1; return; }
        if (hipOccupancyMaxActiveBlocksPerMultiprocessor(&per_cu, (const void*)k_mega, NTHR, LDS_BYTES) != hipSuccess || per_cu < 1) { fprintf(stderr, "kernel_launch: occupancy query says %d blocks per CU\n", per_cu); grid = -1; return; }
        (void)hipGetLastError();
        grid = cus;
    }
    if (grid < 0) return;
    Params p{};
    const float** pp = (const float**)&p;
    for (int i = 0; i < 24; ++i) pp[i] = (const float*)d_in[i];
    p.out = (float*)d_out; p.ws = (unsigned char*)d_ws;
    if (hipMemsetAsync((char*)d_ws + WS_CTL, 0, 65536, stream) != hipSuccess) { fprintf(stderr, "kernel_launch: hipMemsetAsync failed\n"); return; }
    void* args[] = {&p};
    hipError_t e = hipLaunchCooperativeKernel((const void*)k_mega, dim3(grid), dim3(NTHR), args, LDS_BYTES, stream);
    if (e != hipSuccess) fprintf(stderr, "kernel_launch: cooperative launch failed: %s (grid %d)\n", hipGetErrorString(e), grid);
}
```

```cpp
#include <hip/hip_runtime.h>
#include <hip/hip_cooperative_groups.h>
#include <cstdio>
#include <cstdint>
#include <utility>
namespace cg = cooperative_groups;

namespace pg8 {
#define PG8_LAS __attribute__((address_space(3)))
typedef unsigned short bf16_t;
typedef short bf16x8 __attribute__((ext_vector_type(8)));
typedef float f32x4 __attribute__((ext_vector_type(4)));
typedef unsigned u32x4 __attribute__((ext_vector_type(4)));
constexpr int BM = 256, BK = 64, HALF = 128, HTB = HALF * BK * 2  , STAGE_BYTES = 8 * HTB, NXCD = 8;

__host__ __device__ __forceinline__ int lds_byte(int r, int c) { const int st = (r >> 4) * 2 + (c >> 5), rr = r & 15, cc = c & 31, ob = rr * 64 + cc * 2; return st * 1024 + (ob ^ (((ob >> 9) & 1) << 5)); }
__host__ __device__ __forceinline__ void stage_rc(int b, int& R, int& C) { const int st = b / 1024, sb = b % 1024, swz = sb ^ (((sb >> 9) & 1) << 5); R = (st >> 1) * 16 + swz / 64; C = (st & 1) * 32 + (swz % 64) / 2; }
__host__ __device__ __forceinline__ int perm32(int rho) { const int n = rho >> 4, i = rho & 15; return 8 * (i >> 2) + 4 * n + (i & 3); }

struct Unit { int pm, pn; };
struct Gemm { const bf16_t* A; const bf16_t* Bt; int M, N, K, lda; };
template <int AMODE> __device__ __forceinline__ size_t a_off_bytes(const Gemm& g, const Unit& u) {
    const int ac = AMODE == 0 ? 0 : (AMODE == 1 ? 128 * (u.pn < 6 ? u.pn : 6) : 256 * u.pn);
    return ((size_t)u.pm * BM * (size_t)g.lda + (size_t)ac) * 2;
}

struct StaticOrder {
    int nM, nN, nwg, G, c, WGM;
    __host__ __device__ void init(int M, int N, int G_, int c_, int wgm = 4) { nM = M / BM; nN = N / BM; nwg = nM * nN; G = G_; c = c_; WGM = wgm; }
    __host__ __device__ bool next(int i, Unit& u) const {
        const long L = (long)i * G + c; if (L >= nwg) return false;
        int wgid = (int)L; { const int q = nwg / NXCD, r = nwg % NXCD, xcd = wgid % NXCD, off = wgid / NXCD; wgid = (xcd < r ? xcd * (q + 1) : r * (q + 1) + (xcd - r) * q) + off; }
        const int nig = WGM * nN, gid = wgid / nig, fm = gid * WGM, gsz = (nM - fm) < WGM ? (nM - fm) : WGM;
        u.pm = fm + ((wgid % nig) % gsz); u.pn = (wgid % nig) / gsz; return true;
    }
    __device__ __forceinline__ void a_ready(const Unit&) const {}
    __device__ __forceinline__ void done(const Unit&) const {}
};

typedef int i32x8 __attribute__((ext_vector_type(8)));
typedef int i32x4v __attribute__((ext_vector_type(4)));
__device__ __forceinline__ i32x8 cat8(bf16x8 a, bf16x8 b) { const i32x4v x = __builtin_bit_cast(i32x4v, a), y = __builtin_bit_cast(i32x4v, b); return __builtin_shufflevector(x, y, 0, 1, 2, 3, 4, 5, 6, 7); }
__device__ __forceinline__ unsigned cvt_pk_bf16(float lo, float hi) { unsigned r; asm volatile("v_cvt_pk_bf16_f32 %0, %1, %2" : "=v"(r) : "v"(lo), "v"(hi)); return r; }

template <class Epi, class Sched, bool ALIGN_EPI = false, bool SP2 = false, int AMODE = 0, int KC = 0, int LDAC = 0, bool FP8 = false>
__device__ __forceinline__ void gemm_phase(PG8_LAS unsigned char* lds, const Gemm g, const Sched& S, const Epi& E) {
    const int tid = threadIdx.x, wid = __builtin_amdgcn_readfirstlane(tid >> 6), lane = tid & 63, wr = wid >> 2, wc = wid & 3, fr = lane & 15, fq = lane >> 4;
    const int K = KC ? KC : g.K, nt = K / BK; const int lda = LDAC ? LDAC : g.lda;
    unsigned voffA[2], voffB[2];
#pragma unroll
    for (int i = 0; i < 2; ++i) { int R, C; stage_rc(tid * 16 + i * 8192, R, C); const int Rb = Epi::PERM ? ((R & ~31) + perm32(R & 31)) : R;
        voffA[i] = (unsigned)(R * lda + C) * 2u; voffB[i] = (unsigned)(Rb * K + C) * 2u; }
    const size_t kstep = (size_t)(BK * 2);
    const size_t hstepA = (size_t)HALF * lda * 2;
    const size_t hstepB = (size_t)HALF * K * 2;
    const size_t tstepB = 2 * hstepB;
    const unsigned ldsw = (unsigned)wid * 1024u;
    const int aoff = FP8 ? lds_byte(wr * 64 + fr, fq * 16) : lds_byte(wr * 64 + fr, fq * 8), boff = FP8 ? lds_byte(wc * 32 + fr, fq * 16) : lds_byte(wc * 32 + fr, fq * 8);
    constexpr int KOFF = FP8 ? 16 : 1024;
    const int sc1 = 0x7f7f7f7f;
#define PG8_SA(b, h) (((b) * 2 + (h)) * HTB)
#define PG8_SB(b, h) ((4 + (b) * 2 + (h)) * HTB)
#define PG8_STAGE(bufoff, gbase, voff) do { _Pragma("unroll") for (int _i = 0; _i < 2; ++_i) \
        __builtin_amdgcn_global_load_lds((const unsigned*)((const char*)(gbase) + (voff)[_i]), (PG8_LAS unsigned*)(lds + (bufoff) + ldsw + _i * 8192), 16, 0, 0); } while (0)
#define PG8_LDA(dst, b, h) do { _Pragma("unroll") for (int m = 0; m < 4; ++m) _Pragma("unroll") for (int k = 0; k < 2; ++k) dst[m][k] = *(const PG8_LAS bf16x8*)(lds + PG8_SA(b, h) + aoff + m * 2048 + k * KOFF); } while (0)
#define PG8_LDB(dst, b, h) do { _Pragma("unroll") for (int n = 0; n < 2; ++n) _Pragma("unroll") for (int k = 0; k < 2; ++k) dst[n][k] = *(const PG8_LAS bf16x8*)(lds + PG8_SB(b, h) + boff + n * 2048 + k * KOFF); } while (0)
#define PG8_MMA(ai, bj, At, Bt) do { __builtin_amdgcn_s_setprio(1); _Pragma("unroll") for (int m = 0; m < 4; ++m) _Pragma("unroll") for (int n = 0; n < 2; ++n) { \
        if constexpr (FP8) asm volatile("v_mfma_scale_f32_16x16x128_f8f6f4 %0, %1, %2, %0, %3, %3 op_sel_hi:[0,0,0]" : "+v"(acc[ai][bj][m][n]) : "v"(cat8(Bt[n][0], Bt[n][1])), "v"(cat8(At[m][0], At[m][1])), "v"(sc1)); \
        else { _Pragma("unroll") for (int k = 0; k < 2; ++k) acc[ai][bj][m][n] = __builtin_amdgcn_mfma_f32_16x16x32_bf16(Bt[n][k], At[m][k], acc[ai][bj][m][n], 0, 0, 0); } } __builtin_amdgcn_s_setprio(0); } while (0)
#define PG8_WAIT_V(n) asm volatile("s_waitcnt vmcnt(" #n ")" ::: "memory")
#define PG8_WAIT_L(n) asm volatile("s_waitcnt lgkmcnt(" #n ")" ::: "memory")
#define PG8_BAR __builtin_amdgcn_s_barrier()
#define PG8_SCHED __builtin_amdgcn_sched_barrier(0)
    Unit cur, nxt; int ui = 0;
    if (!S.next(0, cur)) return;
    f32x4 acc[2][2][4][2];
#pragma unroll
    for (int a = 0; a < 2; ++a)
#pragma unroll
        for (int b = 0; b < 2; ++b)
#pragma unroll
            for (int m = 0; m < 4; ++m)
#pragma unroll
                for (int n = 0; n < 2; ++n) acc[a][b][m][n] = (f32x4){0.f, 0.f, 0.f, 0.f};
    bf16x8 At[4][2], B0[2][2], B1[2][2];
    const char* cA = (const char*)g.A + a_off_bytes<AMODE>(g, cur); const char* cB = (const char*)g.Bt + (size_t)cur.pn * tstepB;
    S.a_ready(cur);
    if constexpr (SP2) {
        PG8_STAGE(PG8_SB(0, 0), cB, voffB); PG8_STAGE(PG8_SB(0, 1), cB + hstepB, voffB); PG8_STAGE(PG8_SA(0, 0), cA, voffA); PG8_STAGE(PG8_SA(0, 1), cA + hstepA, voffA);
        if (wr == 1) PG8_BAR;
        PG8_WAIT_V(2); PG8_BAR;
        PG8_STAGE(PG8_SB(1, 0), cB + kstep, voffB); PG8_STAGE(PG8_SA(1, 0), cA + kstep, voffA); PG8_STAGE(PG8_SB(1, 1), cB + hstepB + kstep, voffB);
        PG8_WAIT_V(6); PG8_BAR;
    } else {
        PG8_STAGE(PG8_SB(0, 0), cB, voffB); PG8_STAGE(PG8_SA(0, 0), cA, voffA); PG8_STAGE(PG8_SB(0, 1), cB + hstepB, voffB); PG8_STAGE(PG8_SA(0, 1), cA + hstepA, voffA);
        if (wr == 1) PG8_BAR;
        PG8_WAIT_V(4); PG8_BAR;
        PG8_STAGE(PG8_SB(1, 0), cB + kstep, voffB); PG8_STAGE(PG8_SA(1, 0), cA + kstep, voffA); PG8_STAGE(PG8_SB(1, 1), cB + hstepB + kstep, voffB);
        PG8_WAIT_V(6); PG8_BAR;
    }
    for (;;) {
        const bool has_next = S.next(ui + 1, nxt);
        const char* nA = has_next ? (const char*)g.A + a_off_bytes<AMODE>(g, nxt) : cA; const char* nB = has_next ? (const char*)g.Bt + (size_t)nxt.pn * tstepB : cB;
#pragma unroll 1
        for (int t = 0; t < nt; t += 2) {
            const bool last = (t == nt - 2);
            const char* a1 = cA + (size_t)(t + 1) * kstep;
            const char* a2 = last ? nA : cA + (size_t)(t + 2) * kstep; const char* b2 = last ? nB : cB + (size_t)(t + 2) * kstep;
            const char* a3 = a2 + kstep; const char* b3 = b2 + kstep;
            if (last && has_next) S.a_ready(nxt);
            if constexpr (SP2) {
            PG8_LDB(B0, 0, 0); PG8_LDB(B1, 0, 1); PG8_SCHED; PG8_LDA(At, 0, 0); PG8_STAGE(PG8_SA(1, 1), a1 + hstepA, voffA);
            PG8_WAIT_V(8); PG8_WAIT_L(0); PG8_BAR; PG8_MMA(0, 0, At, B0); PG8_MMA(0, 1, At, B1); PG8_BAR; PG8_SCHED;
            PG8_LDA(At, 0, 1); PG8_STAGE(PG8_SB(0, 0), b2, voffB); PG8_STAGE(PG8_SB(0, 1), b2 + hstepB, voffB); PG8_STAGE(PG8_SA(0, 0), a2, voffA);
            PG8_WAIT_V(8); PG8_WAIT_L(0); PG8_BAR; PG8_MMA(1, 0, At, B0); PG8_MMA(1, 1, At, B1); PG8_BAR; PG8_SCHED;
            PG8_LDB(B0, 1, 0); PG8_LDB(B1, 1, 1); PG8_SCHED; PG8_LDA(At, 1, 0); PG8_STAGE(PG8_SA(0, 1), a2 + hstepA, voffA);
            PG8_WAIT_V(8); PG8_WAIT_L(0); PG8_BAR; PG8_MMA(0, 0, At, B0); PG8_MMA(0, 1, At, B1); PG8_BAR; PG8_SCHED;
            PG8_LDA(At, 1, 1); PG8_STAGE(PG8_SB(1, 0), b3, voffB); PG8_STAGE(PG8_SB(1, 1), b3 + hstepB, voffB); PG8_STAGE(PG8_SA(1, 0), a3, voffA);
            PG8_WAIT_V(8); PG8_WAIT_L(0); PG8_BAR; PG8_MMA(1, 0, At, B0); PG8_MMA(1, 1, At, B1); PG8_BAR; PG8_SCHED;
            } else {
            PG8_LDB(B0, 0, 0); PG8_SCHED; PG8_LDA(At, 0, 0); PG8_STAGE(PG8_SA(1, 1), a1 + hstepA, voffA);
            PG8_WAIT_L(8); PG8_BAR; PG8_WAIT_L(0); PG8_MMA(0, 0, At, B0); PG8_BAR; PG8_SCHED;
            PG8_LDB(B1, 0, 1); PG8_STAGE(PG8_SB(0, 0), b2, voffB);
            PG8_BAR; PG8_WAIT_L(0); PG8_MMA(0, 1, At, B1); PG8_BAR;
            PG8_LDA(At, 0, 1); PG8_STAGE(PG8_SA(0, 0), a2, voffA);
            PG8_BAR; PG8_WAIT_L(0); PG8_MMA(1, 0, At, B0); PG8_BAR; PG8_SCHED;
            PG8_STAGE(PG8_SB(0, 1), b2 + hstepB, voffB);
            PG8_WAIT_V(6); PG8_BAR; PG8_MMA(1, 1, At, B1); PG8_BAR;
            PG8_LDB(B0, 1, 0); PG8_SCHED; PG8_LDA(At, 1, 0); PG8_STAGE(PG8_SA(0, 1), a2 + hstepA, voffA);
            PG8_WAIT_L(8); PG8_BAR; PG8_WAIT_L(0); PG8_MMA(0, 0, At, B0); PG8_BAR; PG8_SCHED;
            PG8_LDB(B1, 1, 1); PG8_STAGE(PG8_SB(1, 0), b3, voffB);
            PG8_BAR; PG8_WAIT_L(0); PG8_MMA(0, 1, At, B1); PG8_BAR;
            PG8_LDA(At, 1, 1); PG8_STAGE(PG8_SA(1, 0), a3, voffA);
            PG8_BAR; PG8_WAIT_L(0); PG8_MMA(1, 0, At, B0); PG8_BAR; PG8_SCHED;
            PG8_STAGE(PG8_SB(1, 1), b3 + hstepB, voffB);
            PG8_WAIT_V(6); PG8_BAR; PG8_MMA(1, 1, At, B1); PG8_BAR;
            }
        }
        if constexpr (ALIGN_EPI) { if (wr == 0) PG8_BAR; }
        if constexpr (FP8) asm volatile("s_nop 15\n\ts_nop 15" ::: "memory");
        E(acc, cur, wr, wc, fr, fq); S.done(cur);
        if (!has_next) break;
#pragma unroll
        for (int a = 0; a < 2; ++a)
#pragma unroll
            for (int b = 0; b < 2; ++b)
#pragma unroll
                for (int m = 0; m < 4; ++m)
#pragma unroll
                    for (int n = 0; n < 2; ++n) acc[a][b][m][n] = (f32x4){0.f, 0.f, 0.f, 0.f};
        cur = nxt; cA = nA; cB = nB; ++ui;
        if constexpr (ALIGN_EPI) { if (wr == 1) PG8_BAR; }
    }
    PG8_WAIT_V(0);
    if constexpr (!ALIGN_EPI) { if (wr == 0) PG8_BAR; }
    PG8_BAR;
#undef PG8_SA
#undef PG8_SB
#undef PG8_STAGE
#undef PG8_LDA
#undef PG8_LDB
#undef PG8_MMA
#undef PG8_WAIT_V
#undef PG8_WAIT_L
#undef PG8_BAR
#undef PG8_SCHED
}
}

constexpr int NB = 8, SEQ = 8192, DM = 1024, T = NB * SEQ;
constexpr int NPAD = 7424;
constexpr int NWAVES = 8, NTHR = 512;
constexpr int LDS_BYTES = 147456;
constexpr int N_PHASES = 10;
#define PROBE_PH -1
#define PROBE_MULT 3

constexpr size_t MiB = 1ull << 20;
constexpr size_t WS_CTL = 0;
constexpr size_t WS_MODP = 1 * MiB;
constexpr size_t WS_WIN = 3 * MiB;
constexpr size_t WS_WOUT = 18 * MiB;
constexpr size_t WS_WQ = 20 * MiB;
constexpr size_t WS_WQB = 480 * MiB;
constexpr size_t WS_LRUB = 24 * MiB;
constexpr size_t WS_SUBK = 25 * MiB;
constexpr size_t WS_LRUC = 26 * MiB;
constexpr size_t WS_U = 32 * MiB;
constexpr size_t WS_V = 48 * MiB;
constexpr size_t WS_SU = 64 * MiB;
constexpr size_t WS_SV = 65 * MiB;
constexpr size_t WS_SS = 30 * MiB;
constexpr size_t WS_DK = 66 * MiB;
constexpr size_t WS_QKV = 96 * MiB;
constexpr size_t WS_R = 352 * MiB;
constexpr size_t WS_XLXG = 480 * MiB;
constexpr size_t WS_GAGB = 736 * MiB;
constexpr size_t WS_ALOW = 992 * MiB;
constexpr size_t WS_END = 994 * MiB;
constexpr size_t WS_Y = WS_QKV;
constexpr size_t WS_H2 = WS_QKV + 128 * MiB;
constexpr size_t WS_QRY = WS_XLXG;
constexpr size_t WS_SC = WS_GAGB;
constexpr size_t WS_TOPK = WS_R;
constexpr size_t WS_TOPK2 = WS_R + 32 * MiB;

#define LAS __attribute__((address_space(3)))
typedef unsigned short bf16;
typedef float f32x4 __attribute__((ext_vector_type(4)));
typedef float f32x2 __attribute__((ext_vector_type(2)));
typedef unsigned u32x4 __attribute__((ext_vector_type(4)));
typedef unsigned u32x2 __attribute__((ext_vector_type(2)));

struct Params {
    const float *x, *c, *w_ada, *b_ada, *npm, *npo, *w_in, *w_alpha, *b_alpha, *gla_norm, *conv_w, *conv_b,
        *lwa, *lba, *lwx, *lbx, *lam, *w_out, *npf, *npof, *wq, *subk, *pu, *pv;
    float* out; unsigned char* ws;
    int ph_lo, ph_hi;
};

__device__ __forceinline__ unsigned pk2(float lo, float hi) { unsigned r; asm("v_cvt_pk_bf16_f32 %0, %1, %2" : "=v"(r) : "v"(lo), "v"(hi)); return r; }
__device__ __forceinline__ unsigned f2bf(float f) { return pk2(f, f) & 0xffffu; }
__device__ __forceinline__ float bflo(unsigned u) { return __builtin_bit_cast(float, u << 16); }
__device__ __forceinline__ float bfhi(unsigned u) { return __builtin_bit_cast(float, u & 0xffff0000u); }
__device__ __forceinline__ float bf2f(bf16 h) { return __builtin_bit_cast(float, (unsigned)h << 16); }
__device__ __forceinline__ float sigmoid_f(float x) { return __builtin_amdgcn_rcpf(1.f + __expf(-x)); }
__device__ __forceinline__ float silu_f(float x) { return x * __builtin_amdgcn_rcpf(1.f + __expf(-x)); }
__device__ __forceinline__ float gelu_f(float x) { const float u = 0.7978845608028654f * (x + 0.044715f * x * x * x); return x * __builtin_amdgcn_rcpf(1.f + __expf(-2.f * u)); }
__device__ __forceinline__ float softplus_f(float x) { return fmaxf(x, 0.f) + log1pf(__expf(-fabsf(x))); }
__device__ __forceinline__ float wave_sum(float v) {
#pragma unroll
    for (int o = 1; o < 64; o <<= 1) v += __shfl_xor(v, o);
    return v;
}
__device__ __forceinline__ float merge2(float ga, float on, float r, float gb, float hl, float xg) {
    const float u = 0.7978845608028654f * (xg + 0.044715f * xg * xg * xg);
    const float d1 = (1.f + __expf(-ga)) * (1.f + __expf(-r)), d2 = (1.f + __expf(-gb)) * (1.f + __expf(-2.f * u));
    return on * r * __builtin_amdgcn_rcpf(d1) + hl * xg * __builtin_amdgcn_rcpf(d2);
}
constexpr float W8_SCALE = 32.f, W8_INV = 1.f / 32.f;
__device__ __forceinline__ unsigned pk_fp8x4(float a, float b, float c, float d) { int r = __builtin_amdgcn_cvt_pk_fp8_f32(a, b, 0, false); r = __builtin_amdgcn_cvt_pk_fp8_f32(c, d, r, true); return (unsigned)r; }
#define LDS_WAIT() asm volatile("s_waitcnt lgkmcnt(0)" ::: "memory")

struct EpiSeg {
    static constexpr bool PERM = true;
    unsigned char* ws;
    __device__ __forceinline__ void operator()(const pg8::f32x4 (&acc)[2][2][4][2], const pg8::Unit& u, int wr, int wc, int fr, int fq) const {
        const int pn = u.pn; bf16* base; int ldc, colt;
        if (pn < 8) { base = (bf16*)(ws + WS_QKV); ldc = 2048; colt = pn * 256; }
        else if (pn < 12) { base = (bf16*)(ws + WS_R); ldc = 1024; colt = (pn - 8) * 256; }
        else if (pn < 20) { base = (bf16*)(ws + WS_XLXG); ldc = 2048; colt = (pn - 12) * 256; }
        else if (pn < 28) { base = (bf16*)(ws + WS_GAGB); ldc = 2048; colt = (pn - 20) * 256; }
        else { base = (bf16*)(ws + WS_ALOW); ldc = 16; colt = 0; }
        const int row0 = u.pm * 256 + wr * 64 + fr, col0 = colt + wc * 32 + 8 * fq;
        const bool tail = (pn == 28);
#pragma unroll
        for (int ai = 0; ai < 2; ++ai)
#pragma unroll
            for (int m = 0; m < 4; ++m) { bf16* rowp = base + (size_t)(row0 + ai * 128 + m * 16) * ldc + col0;
#pragma unroll
                for (int bj = 0; bj < 2; ++bj) { const pg8::f32x4 v0 = acc[ai][bj][m][0] * W8_INV, v1 = acc[ai][bj][m][1] * W8_INV;
                    u32x4 w; w.x = pg8::cvt_pk_bf16(v0[0], v0[1]); w.y = pg8::cvt_pk_bf16(v0[2], v0[3]); w.z = pg8::cvt_pk_bf16(v1[0], v1[1]); w.w = pg8::cvt_pk_bf16(v1[2], v1[3]);
                    if (!tail || (bj == 0 && wc == 0 && fq < 2)) *(u32x4*)(rowp + bj * 128) = w; } }
    }
};
struct EpiPlain {
    static constexpr bool PERM = true;
    bf16* O; int ldc;
    __device__ __forceinline__ void operator()(const pg8::f32x4 (&acc)[2][2][4][2], const pg8::Unit& u, int wr, int wc, int fr, int fq) const {
        const int row0 = u.pm * 256 + wr * 64 + fr, col0 = u.pn * 256 + wc * 32 + 8 * fq;
#pragma unroll
        for (int ai = 0; ai < 2; ++ai)
#pragma unroll
            for (int m = 0; m < 4; ++m) { bf16* rowp = O + (size_t)(row0 + ai * 128 + m * 16) * ldc + col0;
#pragma unroll
                for (int bj = 0; bj < 2; ++bj) { const pg8::f32x4 v0 = acc[ai][bj][m][0], v1 = acc[ai][bj][m][1];
                    u32x4 w; w.x = pg8::cvt_pk_bf16(v0[0], v0[1]); w.y = pg8::cvt_pk_bf16(v0[2], v0[3]); w.z = pg8::cvt_pk_bf16(v1[0], v1[1]); w.w = pg8::cvt_pk_bf16(v1[2], v1[3]);
                    *(u32x4*)(rowp + bj * 128) = w; } }
    }
};
typedef _Float16 h16x2 __attribute__((ext_vector_type(2)));
__device__ __forceinline__ unsigned pkh(float a, float b) { return __builtin_bit_cast(unsigned, __builtin_amdgcn_cvt_pkrtz(a, b)); }
struct EpiF16 {
    static constexpr bool PERM = true;
    unsigned short* O; int ldc;
    __device__ __forceinline__ void operator()(const pg8::f32x4 (&acc)[2][2][4][2], const pg8::Unit& u, int wr, int wc, int fr, int fq) const {
        const int row0 = u.pm * 256 + wr * 64 + fr, col0 = u.pn * 256 + wc * 32 + 8 * fq;
#pragma unroll
        for (int ai = 0; ai < 2; ++ai)
#pragma unroll
            for (int m = 0; m < 4; ++m) { unsigned short* rowp = O + (size_t)(row0 + ai * 128 + m * 16) * ldc + col0;
#pragma unroll
                for (int bj = 0; bj < 2; ++bj) { const pg8::f32x4 v0 = acc[ai][bj][m][0], v1 = acc[ai][bj][m][1];
                    u32x4 w; w.x = pkh(v0[0], v0[1]); w.y = pkh(v0[2], v0[3]); w.z = pkh(v1[0], v1[1]); w.w = pkh(v1[2], v1[3]);
                    *(u32x4*)(rowp + bj * 128) = w; } }
    }
};
struct EpiTrans {
    static constexpr bool PERM = true;
    bf16* O; int ldc;
    __device__ __forceinline__ void operator()(const pg8::f32x4 (&acc)[2][2][4][2], const pg8::Unit& u, int wr, int wc, int fr, int fq) const {
        const int row0 = u.pm * 256 + wr * 64 + fr, col0 = u.pn * 256 + wc * 32 + 8 * fq;
#pragma unroll
        for (int ai = 0; ai < 2; ++ai)
#pragma unroll
            for (int m = 0; m < 4; ++m) { const int row = row0 + ai * 128 + m * 16;
#pragma unroll
                for (int bj = 0; bj < 2; ++bj)
#pragma unroll
                    for (int n = 0; n < 2; ++n)
#pragma unroll
                        for (int e = 0; e < 4; ++e) O[(size_t)(col0 + bj * 128 + 4 * n + e) * ldc + row] = (bf16)f2bf(acc[ai][bj][m][n][e]); }
    }
};

__device__ __forceinline__ void p0_transpose_item(const float* W, int ldw, int k0, int n0, int nvalid, bf16* WT, int ldk, int row0, int kc0, LAS float* scr, int lane) {
#pragma unroll 8
    for (int i = 0; i < 32; ++i) { const int kk = 2 * i + (lane >> 5), cc = lane & 31; scr[kk * 33 + cc] = (cc < nvalid) ? W[(size_t)(k0 + kk) * ldw + n0 + cc] : 0.f; }
    LDS_WAIT(); asm volatile("" ::: "memory");
    const int c = lane & 7;
#pragma unroll
    for (int j = 0; j < 4; ++j) { const int n = (lane >> 3) + 8 * j; const LAS float* s = scr + (8 * c) * 33 + n;
        u32x4 o; o.x = pk2(s[0 * 33], s[1 * 33]); o.y = pk2(s[2 * 33], s[3 * 33]); o.z = pk2(s[4 * 33], s[5 * 33]); o.w = pk2(s[6 * 33], s[7 * 33]);
        *(u32x4*)(WT + (size_t)(row0 + n) * ldk + kc0 + k0 + 8 * c) = o; }
    LDS_WAIT(); asm volatile("" ::: "memory");
}
__device__ __forceinline__ void p0_transpose_item_fp8(const float* W, int ldw, int k0, int n0, int nvalid, unsigned char* WT8, int ldk, int row0, LAS float* scr, int lane) {
#pragma unroll 8
    for (int i = 0; i < 32; ++i) { const int kk = 2 * i + (lane >> 5), cc = lane & 31; scr[kk * 33 + cc] = (cc < nvalid) ? W[(size_t)(k0 + kk) * ldw + n0 + cc] * W8_SCALE : 0.f; }
    LDS_WAIT(); asm volatile("" ::: "memory");
    const int c = lane & 3;
#pragma unroll
    for (int j = 0; j < 2; ++j) { const int n = (lane >> 2) + 16 * j; const LAS float* s = scr + (16 * c) * 33 + n;
        u32x4 o; o.x = pk_fp8x4(s[0 * 33], s[1 * 33], s[2 * 33], s[3 * 33]); o.y = pk_fp8x4(s[4 * 33], s[5 * 33], s[6 * 33], s[7 * 33]);
        o.z = pk_fp8x4(s[8 * 33], s[9 * 33], s[10 * 33], s[11 * 33]); o.w = pk_fp8x4(s[12 * 33], s[13 * 33], s[14 * 33], s[15 * 33]);
        *(u32x4*)(WT8 + (size_t)(row0 + n) * ldk + k0 + 16 * c) = o; }
    LDS_WAIT(); asm volatile("" ::: "memory");
}
__device__ __forceinline__ void phase0(const Params& p, LAS unsigned char* lds, int G) {
    const int tid = threadIdx.x, lane = tid & 63, wave = __builtin_amdgcn_readfirstlane(tid >> 6);
    unsigned char* ws = p.ws;
    {
        LAS float* sc = (LAS float*)lds;
        LAS float* red = (LAS float*)(lds + 4096);
        float* modp = (float*)(ws + WS_MODP);
        for (int it = blockIdx.x; it < 24 * 8; it += G) {
            const int nb = it % 24, kc = it / 24;
            for (int i = tid; i < 1024; i += NTHR) { const int b = i >> 7, k = i & 127; sc[i] = silu_f(p.c[b * 1024 + kc * 128 + k]); }
            __syncthreads();
            const int col = tid & 255, kh = tid >> 8;
            float acc[8];
#pragma unroll
            for (int b = 0; b < 8; ++b) acc[b] = 0.f;
            const float* wp = p.w_ada + (size_t)(kc * 128 + kh * 64) * 6144 + nb * 256 + col;
#pragma unroll 8
            for (int kk = 0; kk < 64; ++kk) { const float w = wp[(size_t)kk * 6144];
#pragma unroll
                for (int b = 0; b < 8; ++b) acc[b] += sc[b * 128 + kh * 64 + kk] * w; }
            if (kh == 1) {
#pragma unroll
                for (int b = 0; b < 8; ++b) red[b * 256 + col] = acc[b]; }
            __syncthreads();
            if (kh == 0) { const int n = nb * 256 + col; const float bias = (kc == 0) ? p.b_ada[n] : 0.f;
#pragma unroll
                for (int b = 0; b < 8; ++b) modp[(size_t)(kc * 8 + b) * 6144 + n] = acc[b] + red[b * 256 + col] + bias; }
            __syncthreads();
        }
    }
    for (int i = blockIdx.x * NTHR + tid; i < T * 4 / 4; i += G * NTHR) ((f32x4*)(ws + WS_SS))[i] = (f32x4){0.f, 0.f, 0.f, 0.f};
    LAS float* scr = (LAS float*)(lds + 16384 + wave * 8448);
    const int gw = blockIdx.x * NWAVES + wave, NGW = G * NWAVES;
    bf16* WinT = (bf16*)(ws + WS_WIN); bf16* WoutT = (bf16*)(ws + WS_WOUT);
    bf16* LruB = (bf16*)(ws + WS_LRUB); bf16* SubK = (bf16*)(ws + WS_SUBK);
    constexpr int I_IN = 16 * (NPAD / 32), I_OUT = 16 * 32, I_Q = 2048, I_LRU = 16 * 8, I_SUB = 2048, I_TAB = 2 * 16384;
    constexpr int NIT = I_IN + I_OUT + I_Q + I_LRU + I_SUB + I_TAB;
    for (int it = gw; it < NIT; it += NGW) {
        int r = it;
        if (r < I_IN) { const int nb = r % (NPAD / 32), kb = r / (NPAD / 32), nq = nb * 32; int n0, nv;
            if (nq < 3072) { n0 = nq; nv = 32; } else if (nq < 7168) { n0 = nq + 16; nv = 32; } else if (nq == 7168) { n0 = 3072; nv = 16; } else { n0 = 0; nv = 0; }
            p0_transpose_item_fp8(p.w_in, 7184, kb * 64, n0, nv, (unsigned char*)WinT, 1024, nq, scr, lane); continue; } r -= I_IN;
        if (r < I_OUT) { const int nb = r % 32, kb = r / 32; p0_transpose_item(p.w_out, 1024, kb * 64, nb * 32, 32, WoutT, 1024, nb * 32, 0, scr, lane); continue; } r -= I_OUT;
        if (r < I_Q) {
            const float* src = p.wq + (size_t)r * 1024; bf16* dst = (bf16*)(ws + WS_WQB) + (size_t)r * 1024;
#pragma unroll
            for (int j = 0; j < 2; ++j) { const f32x4 a = *(const f32x4*)(src + j * 512 + lane * 8), b = *(const f32x4*)(src + j * 512 + lane * 8 + 4);
                u32x4 o; o.x = pk2(a.x, a.y); o.y = pk2(a.z, a.w); o.z = pk2(b.x, b.y); o.w = pk2(b.z, b.w);
                *(u32x4*)(dst + j * 512 + lane * 8) = o; }
            continue; } r -= I_Q;
        if (r < I_LRU) {
            const int mat = r >> 3, sub = r & 7, g = mat >> 3, n = mat & 7, kb = sub >> 2, nb = sub & 3;
            const int np = n < 6 ? n : 6, half = n - np;
            const float* W = (g ? p.lwx : p.lwa) + (size_t)n * 128 * 128;
            bf16* dst = LruB + (size_t)n * 256 * 256;
            p0_transpose_item(W, 128, kb * 64, nb * 32, 32, dst, 256, g * 128 + nb * 32, half * 128, scr, lane);
            p0_transpose_item(W, 128, kb * 64, 0, 0, dst, 256, g * 128 + nb * 32, (1 - half) * 128, scr, lane);
            continue; } r -= I_LRU;
        if (r < I_SUB) {
            const int h = r >> 8, pp = (r >> 7) & 1, n = r & 127;
            const float* src = p.subk + (size_t)r * 128; bf16* dst = SubK + ((size_t)h * 256 + pp * 128 + n) * 256;
            const f32x2 v = *(const f32x2*)(src + 2 * lane);
            *(unsigned*)(dst + pp * 128 + 2 * lane) = pk2(v.x, v.y);
            *(unsigned*)(dst + (1 - pp) * 128 + 2 * lane) = 0u;
            continue; } r -= I_SUB;
        {
            const int tb = r >> 14, row = r & 16383;
            const float* src = (tb ? p.pv : p.pu) + (size_t)row * 1024 + lane * 16;
            f32x4 v[4]; float am = 0.f;
#pragma unroll
            for (int j = 0; j < 4; ++j) { v[j] = *(const f32x4*)(src + 4 * j); am = fmaxf(am, fmaxf(fmaxf(fabsf(v[j].x), fabsf(v[j].y)), fmaxf(fabsf(v[j].z), fabsf(v[j].w)))); }
#pragma unroll
            for (int o = 1; o < 64; o <<= 1) am = fmaxf(am, __shfl_xor(am, o));
            const float inv = am > 0.f ? 7.5f / am : 0.f;
            unsigned long long lo = 0ull; unsigned hi = 0u;
#pragma unroll
            for (int j = 0; j < 16; ++j) { const float x = v[j >> 2][j & 3] * inv, a = fabsf(x);
                unsigned code = a < 1.f ? (unsigned)__builtin_rintf(a * 8.f) : (a < 2.f ? 8u + (unsigned)__builtin_rintf((a - 1.f) * 8.f) : (a < 4.f ? 16u + (unsigned)__builtin_rintf((a - 2.f) * 4.f) : 24u + (unsigned)__builtin_rintf((a - 4.f) * 2.f)));
                code = code > 31u ? 31u : code; code |= (x < 0.f) ? 32u : 0u;
                const int bit = 6 * j;
                if (bit + 6 <= 64) lo |= (unsigned long long)code << bit;
                else if (bit >= 64) hi |= code << (bit - 64);
                else { lo |= (unsigned long long)code << bit; hi |= code >> (64 - bit); } }
            unsigned* dst = (unsigned*)(ws + (tb ? WS_V : WS_U) + (size_t)row * 768 + lane * 12);
            dst[0] = (unsigned)lo; dst[1] = (unsigned)(lo >> 32); dst[2] = hi;
            if (lane == 0) ((float*)(ws + (tb ? WS_SV : WS_SU)))[row] = am * (1.f / 7.5f);
        }
    }
}

__device__ __forceinline__ float mod_at(const float* modp, int b, int n) {
    float s = 0.f;
#pragma unroll
    for (int kc = 0; kc < 8; ++kc) s += modp[(size_t)(kc * 8 + b) * 6144 + n];
    return s;
}

__device__ __forceinline__ void phase1(const Params& p, LAS unsigned char* lds, int G) {
    const int tid = threadIdx.x, lane = tid & 63, wave = __builtin_amdgcn_readfirstlane(tid >> 6);
    const float* modp = (const float*)(p.ws + WS_MODP);
    LAS float* gs = (LAS float*)lds; LAS float* sh = gs + 1024;
    bf16* H = (bf16*)p.out;
    for (int tile = blockIdx.x; tile < T / 256; tile += G) {
        const int b = tile / 32;
        __syncthreads();
        for (int k = tid; k < 1024; k += NTHR) { gs[k] = p.npm[k] * (1.f + mod_at(modp, b, 1024 + k)); sh[k] = mod_at(modp, b, k); }
        __syncthreads();
        for (int rr = 0; rr < 32; ++rr) {
            const size_t row = (size_t)tile * 256 + rr * 8 + wave;
            const f32x4* xr = (const f32x4*)(p.x + row * 1024) + lane;
            f32x4 v[4]; float s = 0.f;
#pragma unroll
            for (int j = 0; j < 4; ++j) { v[j] = xr[64 * j]; s += (v[j].x * v[j].x + v[j].y * v[j].y) + (v[j].z * v[j].z + v[j].w * v[j].w); }
            const float rstd = __builtin_amdgcn_rsqf(wave_sum(s) * (1.f / 1024.f) + 1e-6f);
            unsigned* o8 = (unsigned*)((unsigned char*)H + row * 1024) + lane;
#pragma unroll
            for (int j = 0; j < 4; ++j) { const int k = 256 * j + 4 * lane; const f32x4 g4 = *(const LAS f32x4*)(gs + k), s4 = *(const LAS f32x4*)(sh + k);
                o8[64 * j] = pk_fp8x4(v[j].x * rstd * g4.x + s4.x, v[j].y * rstd * g4.y + s4.y, v[j].z * rstd * g4.z + s4.z, v[j].w * rstd * g4.w + s4.w); }
        }
    }
}

typedef short bf16x8_t __attribute__((ext_vector_type(8)));
template <bool FINAL>
__device__ __forceinline__ void phase_lru(const Params& p, LAS unsigned char* lds, int G) {
    const int tid = threadIdx.x, lane = tid & 63, wave = __builtin_amdgcn_readfirstlane(tid >> 6), q4 = lane >> 4, c16 = lane & 15;
    constexpr int PQ = 136;
    LAS bf16* XC = (LAS bf16*)lds;
    LAS bf16* HB = XC + 64 * PQ;
    LAS float* CW = (LAS float*)(HB + 64 * PQ);
    const bf16* XL = (const bf16*)(p.ws + WS_XLXG); const bf16* LruB = (const bf16*)(p.ws + WS_LRUB);
    const bf16* XG = (const bf16*)(p.ws + WS_XLXG) + 1024; const bf16* GB = (const bf16*)(p.ws + WS_GAGB) + 1024; bf16* GA = (bf16*)(p.ws + WS_GAGB);
    const bf16* O = (const bf16*)(p.ws + WS_QKV) + 1024; const bf16* R = (const bf16*)(p.ws + WS_R); const float* SS = (const float*)(p.ws + WS_SS);
    f32x2* CAR = (f32x2*)(p.ws + WS_LRUC);
    const int c8 = tid & 15, tr = tid >> 4;
    for (int it = blockIdx.x; it < 8 * 8 * 4; it += G) {
        const int sg = it & 3, n = (it >> 2) & 7, b = it >> 5;
        const int chc = n * 128 + c8 * 8;
        const int chm = n * 128 + wave * 16 + c16;
        __syncthreads();
        for (int i = tid; i < 768; i += NTHR) { const int q = i >> 7, c = i & 127; CW[i] = q < 4 ? p.conv_w[q * 1024 + n * 128 + c] : (q == 4 ? p.conv_b[n * 128 + c] : p.gla_norm[n * 128 + c]); }
        const float ba = p.lba[chm], bx = p.lbx[chm], sp = -8.f * softplus_f(-p.lam[chm]);
        bf16x8_t wf[2][4];
        { const int np = n < 6 ? n : 6, half = n - np;
#pragma unroll
          for (int g = 0; g < 2; ++g)
#pragma unroll
              for (int ks = 0; ks < 4; ++ks) wf[g][ks] = *(const bf16x8_t*)(LruB + (size_t)n * 65536 + (size_t)(g * 128 + wave * 16 + c16) * 256 + half * 128 + ks * 32 + q4 * 8); }
        float hc = 0.f, aseg = 1.f;
        if (FINAL) { for (int s = 0; s < 4 * sg; ++s) { const f32x2 c = CAR[(size_t)((b * 8 + n) * 12 + s) * 128 + wave * 16 + c16]; hc = c.x * hc + c.y; } }
        constexpr int NTL = FINAL ? 32 : 24;
        const size_t tseg = (size_t)b * SEQ + (size_t)sg * (NTL * 64);
        u32x4 xr[5];
#define LRU_LOADX(t0_) do { _Pragma("unroll") for (int _k = 0; _k < 5; ++_k) { const long _t = (long)(t0_) + 2 * tr + _k - 3; \
            xr[_k] = (_t < (long)b * SEQ) ? (u32x4){0u, 0u, 0u, 0u} : *(const u32x4*)(XL + (size_t)_t * 2048 + chc); } } while (0)
        LRU_LOADX(tseg);
        __syncthreads();
#pragma unroll 1
        for (int tl = 0; tl < NTL; ++tl) {
            const size_t t0 = tseg + tl * 64;
            { float xv[5][8];
#pragma unroll
              for (int k = 0; k < 5; ++k) { xv[k][0] = bflo(xr[k].x); xv[k][1] = bfhi(xr[k].x); xv[k][2] = bflo(xr[k].y); xv[k][3] = bfhi(xr[k].y); xv[k][4] = bflo(xr[k].z); xv[k][5] = bfhi(xr[k].z); xv[k][6] = bflo(xr[k].w); xv[k][7] = bfhi(xr[k].w); }
              float cw[5][8];
#pragma unroll
              for (int q = 0; q < 5; ++q) { const f32x4 w0 = *(const LAS f32x4*)(CW + q * 128 + c8 * 8), w1 = *(const LAS f32x4*)(CW + q * 128 + c8 * 8 + 4);
                  cw[q][0] = w0.x; cw[q][1] = w0.y; cw[q][2] = w0.z; cw[q][3] = w0.w; cw[q][4] = w1.x; cw[q][5] = w1.y; cw[q][6] = w1.z; cw[q][7] = w1.w; }
#pragma unroll
              for (int i2 = 0; i2 < 2; ++i2) { float o[8];
#pragma unroll
                  for (int j = 0; j < 8; ++j) o[j] = cw[4][j] + cw[0][j] * xv[i2][j] + cw[1][j] * xv[i2 + 1][j] + cw[2][j] * xv[i2 + 2][j] + cw[3][j] * xv[i2 + 3][j];
                  *(LAS u32x4*)(XC + (2 * tr + i2) * PQ + c8 * 8) = (u32x4){pk2(o[0], o[1]), pk2(o[2], o[3]), pk2(o[4], o[5]), pk2(o[6], o[7])}; } }
            u32x4 mxg[2], mgb[2], mo[2], mr[2], mga[2]; float mss[2];
            if (FINAL) {
#pragma unroll
                for (int i2 = 0; i2 < 2; ++i2) { const size_t t = t0 + 2 * tr + i2;
                    mxg[i2] = *(const u32x4*)(XG + t * 2048 + chc); mgb[i2] = *(const u32x4*)(GB + t * 2048 + chc); mo[i2] = *(const u32x4*)(O + t * 2048 + chc);
                    mr[i2] = *(const u32x4*)(R + t * 1024 + chc); mga[i2] = *(const u32x4*)(GA + t * 2048 + chc); mss[i2] = SS[t * 4 + (chc >> 8)]; } }
            if (tl + 1 < NTL) LRU_LOADX(t0 + 64);
            __syncthreads();
            pg8::f32x4 acc[4][2];
#pragma unroll
            for (int tt = 0; tt < 4; ++tt) { acc[tt][0] = (pg8::f32x4){0.f, 0.f, 0.f, 0.f}; acc[tt][1] = (pg8::f32x4){0.f, 0.f, 0.f, 0.f}; }
#pragma unroll
            for (int ks = 0; ks < 4; ++ks)
#pragma unroll
                for (int tt = 0; tt < 4; ++tt) { const bf16x8_t a = *(const LAS bf16x8_t*)(XC + (tt * 16 + c16) * PQ + ks * 32 + q4 * 8);
                    acc[tt][0] = __builtin_amdgcn_mfma_f32_16x16x32_bf16(a, wf[0][ks], acc[tt][0], 0, 0, 0);
                    acc[tt][1] = __builtin_amdgcn_mfma_f32_16x16x32_bf16(a, wf[1][ks], acc[tt][1], 0, 0, 0); }
#pragma unroll
            for (int tt = 0; tt < 4; ++tt) {
                float av[4], uv[4];
#pragma unroll
                for (int j = 0; j < 4; ++j) { const float xc = bf2f(XC[(tt * 16 + q4 * 4 + j) * PQ + wave * 16 + c16]);
                    const float gr = sigmoid_f(acc[tt][0][j] + ba), gi = sigmoid_f(acc[tt][1][j] + bx);
                    const float a = __expf(sp * gr); av[j] = a; uv[j] = __builtin_amdgcn_sqrtf(fmaxf(1.f - a * a, 0.f)) * gi * xc; }
                float A4 = av[0], H4 = uv[0];
#pragma unroll
                for (int j = 1; j < 4; ++j) { H4 = av[j] * H4 + uv[j]; A4 *= av[j]; }
                float Ai = A4, Hi = H4;
                { const float Ap = __shfl_up(Ai, 16), Hp = __shfl_up(Hi, 16); if (q4 >= 1) { Hi = Hp * Ai + Hi; Ai = Ap * Ai; } }
                { const float Ap = __shfl_up(Ai, 32), Hp = __shfl_up(Hi, 32); if (q4 >= 2) { Hi = Hp * Ai + Hi; Ai = Ap * Ai; } }
                float Ae = __shfl_up(Ai, 16), He = __shfl_up(Hi, 16); if (q4 == 0) { Ae = 1.f; He = 0.f; }
                float h = hc * Ae + He;
                const float At = __shfl(Ai, 48 + c16), Ht = __shfl(Hi, 48 + c16);
                if (FINAL) {
#pragma unroll
                    for (int j = 0; j < 4; ++j) { h = av[j] * h + uv[j]; HB[(tt * 16 + q4 * 4 + j) * PQ + wave * 16 + c16] = (bf16)f2bf(h); } }
                hc = hc * At + Ht; aseg *= At;
            }
            if (!FINAL && (tl & 7) == 7) {
                if (q4 == 0) CAR[(size_t)((b * 8 + n) * 12 + sg * 3 + (tl >> 3)) * 128 + wave * 16 + c16] = (f32x2){aseg, hc};
                hc = 0.f; aseg = 1.f; }
            __syncthreads();
            if (FINAL) {
#pragma unroll
                for (int i2 = 0; i2 < 2; ++i2) { const size_t t = t0 + 2 * tr + i2;
                    const u32x4 hw = *(const LAS u32x4*)(HB + (2 * tr + i2) * PQ + c8 * 8);
                    const float rstd = __builtin_amdgcn_rsqf(mss[i2] * (1.f / 256.f) + 1e-6f);
                    const unsigned hwv[4] = {hw.x, hw.y, hw.z, hw.w}, xgv[4] = {mxg[i2].x, mxg[i2].y, mxg[i2].z, mxg[i2].w}, gbv[4] = {mgb[i2].x, mgb[i2].y, mgb[i2].z, mgb[i2].w};
                    const unsigned ov[4] = {mo[i2].x, mo[i2].y, mo[i2].z, mo[i2].w}, rv[4] = {mr[i2].x, mr[i2].y, mr[i2].z, mr[i2].w}, gav[4] = {mga[i2].x, mga[i2].y, mga[i2].z, mga[i2].w};
                    unsigned ow[4];
                    const f32x4 g0 = *(const LAS f32x4*)(CW + 640 + c8 * 8), g1 = *(const LAS f32x4*)(CW + 640 + c8 * 8 + 4);
                    const float gn[8] = {g0.x, g0.y, g0.z, g0.w, g1.x, g1.y, g1.z, g1.w};
#pragma unroll
                    for (int q = 0; q < 4; ++q) {
                        const float m0 = merge2(bflo(gav[q]), bflo(ov[q]) * rstd * gn[2 * q], bflo(rv[q]), bflo(gbv[q]), bflo(hwv[q]), bflo(xgv[q]));
                        const float m1 = merge2(bfhi(gav[q]), bfhi(ov[q]) * rstd * gn[2 * q + 1], bfhi(rv[q]), bfhi(gbv[q]), bfhi(hwv[q]), bfhi(xgv[q]));
                        ow[q] = pk2(m0, m1); }
                    *(u32x4*)(GA + t * 2048 + chc) = (u32x4){ow[0], ow[1], ow[2], ow[3]}; }
            }
        }
#undef LRU_LOADX
        __syncthreads();
    }
}

__device__ __forceinline__ void phase_gla_prep(const Params& p, LAS unsigned char* lds, int G) {
    const int tid = threadIdx.x;
    LAS float* segt = (LAS float*)lds;
    bf16* QKV = (bf16*)(p.ws + WS_QKV); const bf16* AL = (const bf16*)(p.ws + WS_ALOW); float* DK = (float*)(p.ws + WS_DK);
    const int kp = tid & 127, seg = tid >> 7;
    for (int it = blockIdx.x; it < 8 * 128 * 4; it += G) {
        const int h = it & 3, ch = (it >> 2) & 127, b = it >> 9;
        float wa[16];
#pragma unroll
        for (int r = 0; r < 16; ++r) wa[r] = p.w_alpha[r * 512 + h * 128 + kp];
        const float balpha = p.b_alpha[h * 128 + kp];
        const size_t t0 = (size_t)b * SEQ + ch * 64 + seg * 16;
        float qv[16], kv[16];
#pragma unroll
        for (int i = 0; i < 16; ++i) { qv[i] = bf2f(QKV[(t0 + i) * 2048 + h * 128 + kp]); kv[i] = bf2f(QKV[(t0 + i) * 2048 + 512 + h * 128 + kp]); }
        float cl[16]; float run = 0.f;
#pragma unroll
        for (int i = 0; i < 16; ++i) { const size_t t = t0 + i;
            const u32x4 a0 = *(const u32x4*)(AL + t * 16), a1 = *(const u32x4*)(AL + t * 16 + 8);
            float z = balpha;
            z += bflo(a0.x) * wa[0] + bfhi(a0.x) * wa[1] + bflo(a0.y) * wa[2] + bfhi(a0.y) * wa[3] + bflo(a0.z) * wa[4] + bfhi(a0.z) * wa[5] + bflo(a0.w) * wa[6] + bfhi(a0.w) * wa[7];
            z += bflo(a1.x) * wa[8] + bfhi(a1.x) * wa[9] + bflo(a1.y) * wa[10] + bfhi(a1.y) * wa[11] + bflo(a1.z) * wa[12] + bfhi(a1.z) * wa[13] + bflo(a1.w) * wa[14] + bfhi(a1.w) * wa[15];
            const float ls = fminf(z, 0.f) - __logf(1.f + __expf(-fabsf(z)));
            run += ls * (1.f / 16.f); cl[i] = run; }
        __syncthreads();
        segt[seg * 128 + kp] = run;
        __syncthreads();
        float off = 0.f, tot = 0.f;
#pragma unroll
        for (int s = 0; s < 4; ++s) { const float v = segt[s * 128 + kp]; tot += v; if (s < seg) off += v; }
        if (seg == 0) DK[(size_t)(b * 128 + ch) * 512 + h * 128 + kp] = __expf(tot);
#pragma unroll
        for (int i = 0; i < 16; ++i) { const float cum = cl[i] + off;
            QKV[(t0 + i) * 2048 + h * 128 + kp] = (bf16)f2bf(qv[i] * 0.08838834764831845f * __expf(cum));
            QKV[(t0 + i) * 2048 + 512 + h * 128 + kp] = (bf16)f2bf(kv[i] * __expf(-cum)); }
    }
}
__device__ __forceinline__ bf16x8_t lds_col8(const LAS bf16* base, int pitch) {
    unsigned w[4];
#pragma unroll
    for (int i = 0; i < 4; ++i) w[i] = (unsigned)base[(2 * i) * pitch] | ((unsigned)base[(2 * i + 1) * pitch] << 16);
    return __builtin_bit_cast(bf16x8_t, (u32x4){w[0], w[1], w[2], w[3]});
}
__device__ __forceinline__ void phase_gla_seq(const Params& p, LAS unsigned char* lds, int G) {
    const int tid = threadIdx.x, lane = tid & 63, wave = __builtin_amdgcn_readfirstlane(tid >> 6), q4 = lane >> 4, c16 = lane & 15;
    constexpr int PQ = 136, PS = 72, PV = 34;
    LAS bf16* Qs = (LAS bf16*)lds;
    LAS bf16* Kd = Qs + 64 * PQ;
    LAS bf16* Vt = Kd + 64 * PQ;
    LAS bf16* Pm = Vt + 64 * PV + 64;
    LAS bf16* ST = Pm + 64 * PS;
    LAS float* dk = (LAS float*)(ST + 32 * PQ);
    const bf16* QKV = (const bf16*)(p.ws + WS_QKV); bf16* VO = (bf16*)(p.ws + WS_QKV); const float* DK = (const float*)(p.ws + WS_DK); float* SS = (float*)(p.ws + WS_SS);
    const int r0 = tid >> 4, cc = (tid & 15) * 8;
    const int vr = (tid >> 2) & 63, vc = (tid & 3) * 8;
    for (int it = blockIdx.x; it < 8 * 4 * 8; it += G) {
        const int xg_ = it & 7, jg_ = it >> 3, bh = xg_ * 4 + (jg_ >> 3), v8 = jg_ & 7, h = bh & 3, b = bh >> 2;
        pg8::f32x4 sacc[2] = {(pg8::f32x4){0.f, 0.f, 0.f, 0.f}, (pg8::f32x4){0.f, 0.f, 0.f, 0.f}};
        __syncthreads();
        for (int i = tid; i < 32 * PQ / 2; i += NTHR) ((LAS unsigned*)ST)[i] = 0u;
        u32x4 rq[2], rk[2], rv; float rdk = 0.f;
#define GLA_LOAD(chn) do { const size_t _t0 = (size_t)b * SEQ + (size_t)(chn) * 64; \
            _Pragma("unroll") for (int _j = 0; _j < 2; ++_j) { rq[_j] = *(const u32x4*)(QKV + (_t0 + r0 + 32 * _j) * 2048 + h * 128 + cc); rk[_j] = *(const u32x4*)(QKV + (_t0 + r0 + 32 * _j) * 2048 + 512 + h * 128 + cc); } \
            rv = *(const u32x4*)(QKV + (_t0 + vr) * 2048 + 1024 + h * 256 + v8 * 32 + vc); \
            rdk = DK[(size_t)(b * 128 + (chn)) * 512 + h * 128 + (tid & 127)]; } while (0)
        GLA_LOAD(0);
#pragma unroll 1
        for (int ch = 0; ch < SEQ / 64; ++ch) {
            const size_t t0 = (size_t)b * SEQ + ch * 64;
#pragma unroll
            for (int j = 0; j < 2; ++j) { *(LAS u32x4*)(Qs + (r0 + 32 * j) * PQ + cc) = rq[j]; *(LAS u32x4*)(Kd + (r0 + 32 * j) * PQ + cc) = rk[j]; }
            if (tid < 256) { LAS unsigned* vd = (LAS unsigned*)(Vt + vr * PV + vc); vd[0] = rv.x; vd[1] = rv.y; vd[2] = rv.z; vd[3] = rv.w; }
            if (tid < 128) dk[tid] = rdk;
            if (ch + 1 < SEQ / 64) GLA_LOAD(ch + 1);
            __syncthreads();
            { const int tt = wave & 3;
#pragma unroll
              for (int i2 = 0; i2 < 2; ++i2) { const int ts = (wave >> 2) * 2 + i2;
                  pg8::f32x4 acc = (pg8::f32x4){0.f, 0.f, 0.f, 0.f};
                  if (ts <= tt) {
#pragma unroll
                      for (int ks = 0; ks < 4; ++ks) { const bf16x8_t a = *(const LAS bf16x8_t*)(Kd + (ts * 16 + c16) * PQ + ks * 32 + q4 * 8), bb = *(const LAS bf16x8_t*)(Qs + (tt * 16 + c16) * PQ + ks * 32 + q4 * 8);
                          acc = __builtin_amdgcn_mfma_f32_16x16x32_bf16(a, bb, acc, 0, 0, 0); }
                      const int tg = tt * 16 + c16, sgl = ts * 16 + q4 * 4;
#pragma unroll
                      for (int j = 0; j < 4; ++j) if (sgl + j > tg) acc[j] = 0.f;
                  }
                  *(LAS u32x2*)(Pm + (tt * 16 + c16) * PS + ts * 16 + q4 * 4) = (u32x2){pk2(acc[0], acc[1]), pk2(acc[2], acc[3])}; } }
            bf16x8_t vf[2][2], kf[2];
#pragma unroll
            for (int ks = 0; ks < 2; ++ks) { kf[ks] = lds_col8(Kd + (ks * 32 + q4 * 8) * PQ + wave * 16 + c16, PQ);
#pragma unroll
                for (int tv = 0; tv < 2; ++tv) vf[tv][ks] = lds_col8(Vt + (ks * 32 + q4 * 8) * PV + tv * 16 + c16, PV); }
            __syncthreads();
            { const int tt = wave & 3, tv = wave >> 2;
              pg8::f32x4 oacc = (pg8::f32x4){0.f, 0.f, 0.f, 0.f};
#pragma unroll
              for (int ks = 0; ks < 2; ++ks) { const bf16x8_t bb = *(const LAS bf16x8_t*)(Pm + (tt * 16 + c16) * PS + ks * 32 + q4 * 8);
                  oacc = __builtin_amdgcn_mfma_f32_16x16x32_bf16(tv ? vf[1][ks] : vf[0][ks], bb, oacc, 0, 0, 0); }
#pragma unroll
              for (int ks = 0; ks < 4; ++ks) { const bf16x8_t bb = *(const LAS bf16x8_t*)(Qs + (tt * 16 + c16) * PQ + ks * 32 + q4 * 8), a = *(const LAS bf16x8_t*)(ST + (tv * 16 + c16) * PQ + ks * 32 + q4 * 8);
                  oacc = __builtin_amdgcn_mfma_f32_16x16x32_bf16(a, bb, oacc, 0, 0, 0); }
              *(u32x2*)(VO + (t0 + tt * 16 + c16) * 2048 + 1024 + h * 256 + v8 * 32 + tv * 16 + q4 * 4) = (u32x2){pk2(oacc[0], oacc[1]), pk2(oacc[2], oacc[3])};
              float sq = (oacc[0] * oacc[0] + oacc[1] * oacc[1]) + (oacc[2] * oacc[2] + oacc[3] * oacc[3]);
              sq += __shfl_xor(sq, 16); sq += __shfl_xor(sq, 32);
              if (q4 == 0) atomicAdd(SS + (t0 + tt * 16 + c16) * 4 + h, sq); }
#pragma unroll
            for (int ks = 0; ks < 2; ++ks)
#pragma unroll
                for (int tv = 0; tv < 2; ++tv) sacc[tv] = __builtin_amdgcn_mfma_f32_16x16x32_bf16(kf[ks], vf[tv][ks], sacc[tv], 0, 0, 0);
            { const pg8::f32x4 d4 = *(const LAS pg8::f32x4*)(dk + wave * 16 + q4 * 4);
#pragma unroll
              for (int tv = 0; tv < 2; ++tv) sacc[tv] = sacc[tv] * d4; }
            __syncthreads();
#pragma unroll
            for (int tv = 0; tv < 2; ++tv) *(LAS u32x2*)(ST + (tv * 16 + c16) * PQ + wave * 16 + q4 * 4) = (u32x2){pk2(sacc[tv][0], sacc[tv][1]), pk2(sacc[tv][2], sacc[tv][3])};
        }
#undef GLA_LOAD
    }
}

__device__ __forceinline__ void phase_norm2(const Params& p, LAS unsigned char* lds, int G) {
    const int tid = threadIdx.x, lane = tid & 63, wave = __builtin_amdgcn_readfirstlane(tid >> 6);
    const float* modp = (const float*)(p.ws + WS_MODP);
    LAS float* g1 = (LAS float*)lds; LAS float* gs = g1 + 1024; LAS float* sh = gs + 1024;
    const bf16* Y = (const bf16*)(p.ws + WS_Y); bf16* H2 = (bf16*)(p.ws + WS_H2);
    for (int tile = blockIdx.x; tile < T / 256; tile += G) {
        const int b = tile / 32;
        __syncthreads();
        for (int k = tid; k < 1024; k += NTHR) { g1[k] = mod_at(modp, b, 2048 + k) * p.npo[k]; gs[k] = p.npf[k] * (1.f + mod_at(modp, b, 4096 + k)); sh[k] = mod_at(modp, b, 3072 + k); }
        __syncthreads();
        for (int rr = 0; rr < 32; ++rr) {
            const size_t row = (size_t)tile * 256 + rr * 8 + wave;
            const f32x4* xr = (const f32x4*)(p.x + row * 1024) + lane; const u32x2* yr = (const u32x2*)(Y + row * 1024) + lane;
            f32x4 xv[4], yv[4]; float s = 0.f;
#pragma unroll
            for (int j = 0; j < 4; ++j) { xv[j] = xr[64 * j]; const u32x2 yw = yr[64 * j]; yv[j] = (f32x4){bflo(yw.x), bfhi(yw.x), bflo(yw.y), bfhi(yw.y)};
                s += (yv[j].x * yv[j].x + yv[j].y * yv[j].y) + (yv[j].z * yv[j].z + yv[j].w * yv[j].w); }
            const float rstd = __builtin_amdgcn_rsqf(wave_sum(s) * (1.f / 1024.f) + 1e-6f);
            float s2 = 0.f;
            f32x4* orow = (f32x4*)(p.out + row * 1024) + lane;
#pragma unroll
            for (int j = 0; j < 4; ++j) { const int k = 256 * j + 4 * lane; const f32x4 g4 = *(const LAS f32x4*)(g1 + k);
                xv[j] = xv[j] + yv[j] * rstd * g4; orow[64 * j] = xv[j];
                s2 += (xv[j].x * xv[j].x + xv[j].y * xv[j].y) + (xv[j].z * xv[j].z + xv[j].w * xv[j].w); }
            const float rstd2 = __builtin_amdgcn_rsqf(wave_sum(s2) * (1.f / 1024.f) + 1e-6f);
            u32x2* o8 = (u32x2*)(H2 + row * 1024) + lane;
#pragma unroll
            for (int j = 0; j < 4; ++j) { const int k = 256 * j + 4 * lane; const f32x4 g4 = *(const LAS f32x4*)(gs + k), s4 = *(const LAS f32x4*)(sh + k);
                u32x2 w; w.x = pk2(xv[j].x * rstd2 * g4.x + s4.x, xv[j].y * rstd2 * g4.y + s4.y); w.y = pk2(xv[j].z * rstd2 * g4.z + s4.z, xv[j].w * rstd2 * g4.w + s4.w);
                o8[64 * j] = w; }
        }
    }
}

__device__ __forceinline__ unsigned h16_key(unsigned b) { return (b & 0x8000u) ? (~b & 0xffffu) : (b | 0x8000u); }
__device__ __forceinline__ float h16_key_val(unsigned s) { const unsigned b = (s & 0x8000u) ? (s & 0x7fffu) : (~s & 0xffffu); return (float)__builtin_bit_cast(_Float16, (unsigned short)b); }
template <bool ASC> __device__ __forceinline__ void sort16(unsigned (&k)[16]) {
#pragma unroll
    for (int size = 2; size <= 16; size <<= 1)
#pragma unroll
        for (int stride = size >> 1; stride > 0; stride >>= 1)
#pragma unroll
            for (int i = 0; i < 16; ++i) { const int j = i ^ stride; if (j > i) { const bool up = ((i & size) == 0) == ASC; const unsigned lo = min(k[i], k[j]), hi = max(k[i], k[j]); k[i] = up ? lo : hi; k[j] = up ? hi : lo; } }
}
__device__ __forceinline__ void merge16_desc(unsigned (&k)[16]) {
#pragma unroll
    for (int stride = 8; stride > 0; stride >>= 1)
#pragma unroll
        for (int i = 0; i < 16; ++i) { const int j = i ^ stride; if (j > i) { const unsigned lo = min(k[i], k[j]), hi = max(k[i], k[j]); k[i] = hi; k[j] = lo; } }
}
__device__ __forceinline__ void top16_merge(unsigned (&top)[16], unsigned (&grp)[16]) {
    sort16<true>(grp);
#pragma unroll
    for (int i = 0; i < 16; ++i) top[i] = max(top[i], grp[i]);
    merge16_desc(top);
}
__device__ __forceinline__ void keys16(unsigned (&k)[16], const u32x4 w0, const u32x4 w1, int n0) {
    const unsigned ww[8] = {w0.x, w0.y, w0.z, w0.w, w1.x, w1.y, w1.z, w1.w};
#pragma unroll
    for (int q = 0; q < 8; ++q) { k[2 * q] = (h16_key(ww[q] & 0xffffu) << 16) | (unsigned)(127 - (n0 + 2 * q)); k[2 * q + 1] = (h16_key(ww[q] >> 16) << 16) | (unsigned)(127 - (n0 + 2 * q + 1)); }
}
__device__ __forceinline__ void topk_item(const unsigned short* SC, const float* SU, const float* SV, int t, int h, volatile LAS unsigned* my, unsigned (&outw)[16], float (&outs)[16]) {
    const u32x4* src = (const u32x4*)(SC + (size_t)t * 2048 + h * 256);
    unsigned topA[16], topB[16];
    keys16(topA, src[0], src[1], 0); sort16<false>(topA);
#pragma unroll 1
    for (int g = 1; g < 8; ++g) { unsigned grp[16]; keys16(grp, src[2 * g], src[2 * g + 1], 16 * g); top16_merge(topA, grp); }
    keys16(topB, src[16], src[17], 0); sort16<false>(topB);
#pragma unroll 1
    for (int g = 1; g < 8; ++g) { unsigned grp[16]; keys16(grp, src[16 + 2 * g], src[17 + 2 * g], 16 * g); top16_merge(topB, grp); }
    float fa[16], fb[16];
#pragma unroll
    for (int j = 0; j < 16; ++j) { fa[j] = h16_key_val(topA[j] >> 16); fb[j] = h16_key_val(topB[j] >> 16); my[j] = 127u - (topA[j] & 127u); my[16 + j] = 127u - (topB[j] & 127u); }
    unsigned ct[16];
#pragma unroll
    for (int g = 0; g < 4; ++g) { unsigned grp[16];
#pragma unroll
        for (int s = 0; s < 16; ++s) grp[s] = 0u;
        { int slot = 0;
#pragma unroll
          for (int i = 0; i < 16; ++i)
#pragma unroll
              for (int j = 0; j < 16; ++j) if ((i + 1) * (j + 1) <= 16) { if ((slot >> 4) == g) {
                  const float s = fa[i] + fb[j]; unsigned u = __builtin_bit_cast(unsigned, s); u ^= (u >> 31) ? 0xffffffffu : 0x80000000u;
                  grp[slot & 15] = (u & 0xffffff00u) | (unsigned)(255 - (i * 16 + j)); } ++slot; } }
        if (g == 0) { sort16<false>(grp);
#pragma unroll
            for (int s = 0; s < 16; ++s) ct[s] = grp[s]; }
        else top16_merge(ct, grp); }
    float val[16], mx, sum = 0.f;
#pragma unroll
    for (int m = 0; m < 16; ++m) { unsigned u = ct[m] & 0xffffff00u; u ^= (u >> 31) ? 0x80000000u : 0xffffffffu; val[m] = __builtin_bit_cast(float, u); }
    mx = val[0];
#pragma unroll
    for (int m = 0; m < 16; ++m) { val[m] = __expf(val[m] - mx); sum += val[m]; }
    const float inv = 1.f / sum;
    LDS_WAIT();
#pragma unroll
    for (int m = 0; m < 16; ++m) { const unsigned pos = 255u - (ct[m] & 255u), i = pos >> 4, j = pos & 15u;
        const unsigned e = my[i] * 128u + my[16 + j];
        outw[m] = (e << 16) | f2bf(val[m] * inv * SV[e]); outs[m] = SU[e]; }
}

typedef unsigned u32x3 __attribute__((ext_vector_type(3)));
typedef unsigned u32x6 __attribute__((ext_vector_type(6)));
typedef float f32x32 __attribute__((ext_vector_type(32)));
__device__ __forceinline__ float rdlane(float v, int l) { return __builtin_bit_cast(float, __builtin_amdgcn_readlane(__builtin_bit_cast(int, v), l)); }
__device__ __forceinline__ f32x32 fp6x2(u32x3 a, u32x3 b) { const u32x6 s = {a.x, a.y, a.z, b.x, b.y, b.z}; return __builtin_amdgcn_cvt_scalef32_pk32_f32_fp6(s, 1.0f); }
__device__ __forceinline__ void phase_gather(const Params& p, LAS unsigned char* lds, int G) {
    const int tid = threadIdx.x, lane = tid & 63, wave = __builtin_amdgcn_readfirstlane(tid >> 6);
    const float* modp = (const float*)(p.ws + WS_MODP);
    LAS float* g2 = (LAS float*)lds;
    const bf16* H2 = (const bf16*)(p.ws + WS_H2);
    const unsigned short* SC = (const unsigned short*)(p.ws + WS_SC); const float* SU = (const float*)(p.ws + WS_SU); const float* SV = (const float*)(p.ws + WS_SV);
    volatile LAS unsigned* RT = (volatile LAS unsigned*)(lds + 4096 + wave * 16640); volatile LAS float* RS = (volatile LAS float*)(RT + 1024);
    volatile LAS unsigned* myscr = RT + 2048 + lane * 33;
    const unsigned char* U6 = p.ws + WS_U; const unsigned char* V6 = p.ws + WS_V;
    for (int tile = blockIdx.x; tile < T / 256; tile += G) {
        const int b = tile / 32;
        __syncthreads();
        for (int k = tid; k < 1024; k += NTHR) g2[k] = mod_at(modp, b, 5120 + k) * p.npof[k];
        __syncthreads();
#pragma unroll 1
        for (int rr = 0; rr < 32; ++rr) {
            const size_t row = (size_t)tile * 256 + wave * 32 + rr;
            if ((rr & 7) == 0) {
                unsigned ow[16]; float os[16];
                __builtin_amdgcn_wave_barrier();
                topk_item(SC, SU, SV, (int)(row + (lane >> 3)), lane & 7, myscr, ow, os);
#pragma unroll
                for (int m = 0; m < 16; ++m) { RT[(lane >> 3) * 128 + (lane & 7) * 16 + m] = ow[m]; RS[(lane >> 3) * 128 + (lane & 7) * 16 + m] = os[m]; }
                asm volatile("s_waitcnt lgkmcnt(0)" ::: "memory"); __builtin_amdgcn_wave_barrier();
            }
            const int tl = rr & 7;
            float xt[16];
            { const u32x4 a = *(const u32x4*)(H2 + row * 1024 + lane * 16), c = *(const u32x4*)(H2 + row * 1024 + lane * 16 + 8);
              xt[0] = bflo(a.x); xt[1] = bfhi(a.x); xt[2] = bflo(a.y); xt[3] = bfhi(a.y); xt[4] = bflo(a.z); xt[5] = bfhi(a.z); xt[6] = bflo(a.w); xt[7] = bfhi(a.w);
              xt[8] = bflo(c.x); xt[9] = bfhi(c.x); xt[10] = bflo(c.y); xt[11] = bfhi(c.y); xt[12] = bflo(c.z); xt[13] = bfhi(c.z); xt[14] = bflo(c.w); xt[15] = bfhi(c.w); }
            float acc[16];
#pragma unroll
            for (int j = 0; j < 16; ++j) acc[j] = 0.f;
#pragma unroll 1
            for (int hh = 0; hh < 16; ++hh) {
                unsigned ww[8];
#pragma unroll
                for (int m = 0; m < 8; ++m) ww[m] = RT[tl * 128 + hh * 8 + m];
                u32x6 up[4], vp[4];
#pragma unroll
                for (int m = 0; m < 8; ++m) { const size_t eo = (size_t)((unsigned)__builtin_amdgcn_readfirstlane((int)ww[m]) >> 16) * 768 + lane * 12;
                    const u32x3 a = *(const u32x3*)(U6 + eo), c = *(const u32x3*)(V6 + eo);
                    if (m & 1) { up[m >> 1][3] = a.x; up[m >> 1][4] = a.y; up[m >> 1][5] = a.z; vp[m >> 1][3] = c.x; vp[m >> 1][4] = c.y; vp[m >> 1][5] = c.z; }
                    else { up[m >> 1][0] = a.x; up[m >> 1][1] = a.y; up[m >> 1][2] = a.z; vp[m >> 1][0] = c.x; vp[m >> 1][1] = c.y; vp[m >> 1][2] = c.z; } }
                const unsigned wa = RT[tl * 128 + hh * 8 + (lane >> 3)]; const float su = RS[tl * 128 + hh * 8 + (lane >> 3)];
                float pd[8];
#pragma unroll
                for (int m = 0; m < 8; m += 2) { const f32x32 f = __builtin_amdgcn_cvt_scalef32_pk32_f32_fp6(up[m >> 1], 1.0f);
                    float s0 = 0.f, s1 = 0.f;
#pragma unroll
                    for (int j = 0; j < 16; ++j) { s0 += xt[j] * f[j]; s1 += xt[j] * f[16 + j]; }
                    pd[m] = s0; pd[m + 1] = s1; __builtin_amdgcn_sched_barrier(0); }
#pragma unroll
                for (int j = 0; j < 4; ++j) { const bool up_ = (lane & 32) != 0; const float keep = up_ ? pd[j + 4] : pd[j], send = up_ ? pd[j] : pd[j + 4]; pd[j] = keep + __shfl_xor(send, 32); }
#pragma unroll
                for (int j = 0; j < 2; ++j) { const bool up_ = (lane & 16) != 0; const float keep = up_ ? pd[j + 2] : pd[j], send = up_ ? pd[j] : pd[j + 2]; pd[j] = keep + __shfl_xor(send, 16); }
                { const bool up_ = (lane & 8) != 0; const float keep = up_ ? pd[1] : pd[0], send = up_ ? pd[0] : pd[1]; pd[0] = keep + __shfl_xor(send, 8); }
                float d = pd[0]; d += __shfl_xor(d, 4); d += __shfl_xor(d, 2); d += __shfl_xor(d, 1);
                const float coef = bflo(wa) * gelu_f(su * d);
#pragma unroll
                for (int m = 0; m < 8; m += 2) { const f32x32 f = __builtin_amdgcn_cvt_scalef32_pk32_f32_fp6(vp[m >> 1], 1.0f); const float c0 = rdlane(coef, 8 * m), c1 = rdlane(coef, 8 * m + 8);
#pragma unroll
                    for (int j = 0; j < 16; ++j) acc[j] += c0 * f[j] + c1 * f[16 + j];
                    __builtin_amdgcn_sched_barrier(0); }
            }
            float s = 0.f;
#pragma unroll
            for (int j = 0; j < 16; ++j) s += acc[j] * acc[j];
            const float rstd = __builtin_amdgcn_rsqf(wave_sum(s) * (1.f / 1024.f) + 1e-6f);
            float* orow = p.out + row * 1024 + lane * 16;
#pragma unroll
            for (int q = 0; q < 4; ++q) { f32x4 o = *(const f32x4*)(orow + 4 * q); const f32x4 ga = *(const LAS f32x4*)(g2 + lane * 16 + 4 * q);
                o.x += ga.x * acc[4 * q] * rstd; o.y += ga.y * acc[4 * q + 1] * rstd; o.z += ga.z * acc[4 * q + 2] * rstd; o.w += ga.w * acc[4 * q + 3] * rstd;
                *(f32x4*)(orow + 4 * q) = o; }
        }
    }
}

#define XB_TMO      128
#define XB_XCNT(j)  (256  + 64 * (j))
#define XB_XSUB(j)  (1280 + 64 * (j))
#define XB_XGEN(j)  (2304 + 64 * (j))
#define XB_TOP      3328
#define XB_TOPGEN   3392
#define XCD_BAR_WORDS 3456
#define XB_SPIN_CAP (1u << 18)

__device__ __forceinline__ unsigned xb_ld(unsigned* p)              { return __hip_atomic_load(p, __ATOMIC_RELAXED, __HIP_MEMORY_SCOPE_AGENT); }
__device__ __forceinline__ unsigned xb_add(unsigned* p, unsigned v) { return __hip_atomic_fetch_add(p, v, __ATOMIC_RELAXED, __HIP_MEMORY_SCOPE_AGENT); }
__device__ __forceinline__ unsigned xb_xcc_id() { return (unsigned)__builtin_amdgcn_s_getreg((3 << 11) | 20) & 0xFu; }
#define XB_SPIN(cond, bar) do { unsigned _sp = 0; while (cond) { __builtin_amdgcn_s_sleep(1); \
    if ((++_sp & 255u) == 0u) { if (xb_ld(&(bar)[XB_TMO])) break; if (_sp > XB_SPIN_CAP) { atomicAdd(&(bar)[XB_TMO], 1u); break; } } } } while (0)

struct XcdBarrier {
    unsigned* bar; unsigned x;
    volatile LAS unsigned* st;
};

__device__ __forceinline__ XcdBarrier xcd_barrier_post(unsigned* bar, volatile LAS unsigned* st) {
    XcdBarrier b; b.bar = bar; b.x = xb_xcc_id(); b.st = st;
    if (threadIdx.x == 0) (void)xb_add(&bar[XB_XCNT(b.x)], 1u);
    return b;
}
__device__ __forceinline__ void xcd_barrier_complete(unsigned* bar, unsigned x, unsigned& nloc, unsigned& nx) {
    const unsigned G = gridDim.x * gridDim.y * gridDim.z;
    unsigned sum, cnt, mine, sp = 0u;
    for (;;) {
        sum = 0u; cnt = 0u; mine = 0u;
#pragma unroll
        for (unsigned j = 0; j < 16; ++j) { const unsigned c = xb_ld(&bar[XB_XCNT(j)]); sum += c; cnt += (c > 0u) ? 1u : 0u; mine = (j == x) ? c : mine; }
        if (sum == G) break;
        __builtin_amdgcn_s_sleep(1);
        if ((++sp & 255u) == 0u) { if (xb_ld(&bar[XB_TMO])) break; if (sp > XB_SPIN_CAP) { atomicAdd(&bar[XB_TMO], 1u); break; } }
    }
    nloc = mine > 0u ? mine : 1u; nx = cnt > 0u ? cnt : 1u;
}

__device__ __forceinline__ void xcd_barrier(const XcdBarrier& b) {
    asm volatile("s_waitcnt vmcnt(0)" ::: "memory");
    __syncthreads();
    if (threadIdx.x == 0) {
        unsigned* bar = b.bar;
        __builtin_amdgcn_s_waitcnt(0);
        unsigned nloc = b.st[0], nx = b.st[1];
        if (nloc == 0u) { xcd_barrier_complete(bar, b.x, nloc, nx); b.st[0] = nloc; b.st[1] = nx; }
        const unsigned old = xb_add(&bar[XB_XSUB(b.x)], 1u);
        const unsigned gen = old / nloc;
        if (old + 1u == (gen + 1u) * nloc) {
            __builtin_amdgcn_fence(__ATOMIC_RELEASE, "agent");
            asm volatile("s_waitcnt vmcnt(0)" ::: "memory");
            const unsigned og = xb_add(&bar[XB_TOP], 1u);
            const unsigned tg = og / nx;
            if (og + 1u == (tg + 1u) * nx) xb_add(&bar[XB_TOPGEN], 1u);
            else XB_SPIN(xb_ld(&bar[XB_TOPGEN]) == tg, bar);
            __builtin_amdgcn_fence(__ATOMIC_ACQUIRE, "agent");
            xb_add(&bar[XB_XGEN(b.x)], 1u);
            asm volatile("s_waitcnt vmcnt(0)" ::: "memory");
        } else {
            XB_SPIN(xb_ld(&bar[XB_XGEN(b.x)]) == gen, bar);
            __builtin_amdgcn_fence(__ATOMIC_ACQUIRE, "agent");
            asm volatile("s_waitcnt vmcnt(0)" ::: "memory");
        }
    }
    __syncthreads();
}


template <int PH>
__device__ __forceinline__ void run_phase(const Params& p, LAS unsigned char* lds, int G) {
    unsigned char* ws = p.ws;
    if constexpr (PH == 0) phase0(p, lds, G);
    else if constexpr (PH == 1) {
        { pg8::Gemm g{(const bf16*)(ws + WS_WQB), (const bf16*)(ws + WS_SUBK), 1024, 2048, 256, 2048}; pg8::StaticOrder S; S.init(1024, 2048, G, (int)blockIdx.x);
          EpiTrans E{(bf16*)(ws + WS_WQ), 1024}; pg8::gemm_phase<EpiTrans, pg8::StaticOrder, true, true, 2, 256, 2048>(lds, g, S, E); }
        __syncthreads();
        phase1(p, lds, G); }
    else if constexpr (PH == 2) { pg8::Gemm g{(const bf16*)p.out, (const bf16*)(ws + WS_WIN), T, NPAD, 512, 512}; pg8::StaticOrder S; S.init(T, NPAD, G, (int)blockIdx.x);
        EpiSeg E{ws}; pg8::gemm_phase<EpiSeg, pg8::StaticOrder, true, true, 0, 512, 512, true>(lds, g, S, E); }
    else if constexpr (PH == 3) { phase_gla_prep(p, lds, G); __syncthreads(); phase_lru<false>(p, lds, G); }
    else if constexpr (PH == 4) phase_gla_seq(p, lds, G);
    else if constexpr (PH == 5) phase_lru<true>(p, lds, G);
    else if constexpr (PH == 6) { pg8::Gemm g{(const bf16*)(ws + WS_GAGB), (const bf16*)(ws + WS_WOUT), T, 1024, 1024, 2048}; pg8::StaticOrder S; S.init(T, 1024, G, (int)blockIdx.x);
        EpiPlain E{(bf16*)(ws + WS_Y), 1024}; pg8::gemm_phase<EpiPlain, pg8::StaticOrder, true, true, 0, 1024, 2048>(lds, g, S, E); }
    else if constexpr (PH == 7) phase_norm2(p, lds, G);
    else if constexpr (PH == 8) {
        pg8::Gemm g{(const bf16*)(ws + WS_H2), (const bf16*)(ws + WS_WQ), T, 2048, 1024, 1024}; pg8::StaticOrder S; S.init(T, 2048, G, (int)blockIdx.x);
        EpiF16 E{(unsigned short*)(ws + WS_SC), 2048}; pg8::gemm_phase<EpiF16, pg8::StaticOrder, true, true, 0, 1024, 1024>(lds, g, S, E); }
    else if constexpr (PH == 9) phase_gather(p, lds, G);
}
template <int PH>
__global__ void __launch_bounds__(NTHR, 2) k_phase(Params p) {
    extern __shared__ __attribute__((aligned(16))) unsigned char lds_raw[];
    run_phase<PH>(p, (LAS unsigned char*)lds_raw, (int)gridDim.x);
}
constexpr int LDS_BAR_OFF = LDS_BYTES - 16;
template <int PH>
__device__ __forceinline__ void run_from(const Params& p, LAS unsigned char* lds, int G, const XcdBarrier& bar) {
#if PROBE_PH >= 0
    unsigned long long pt0 = 0; if constexpr (PH == PROBE_PH) pt0 = __builtin_amdgcn_s_memrealtime();
#endif
    run_phase<PH>(p, lds, G);
    if constexpr (PH + 1 < N_PHASES) {
        if constexpr (PH == 0) cg::this_grid().sync();
        else xcd_barrier(bar);
    }
#if PROBE_PH >= 0
    if constexpr (PH == PROBE_PH) { const unsigned long long pt1 = __builtin_amdgcn_s_memrealtime(), span = pt1 - pt0;
        while (__builtin_amdgcn_s_memrealtime() - pt1 < (unsigned long long)PROBE_MULT * span) __builtin_amdgcn_s_sleep(8); }
#endif
    if constexpr (PH + 1 < N_PHASES) run_from<PH + 1>(p, lds, G, bar);
}
__global__ void __launch_bounds__(NTHR, 2) k_mega(Params p) {
    extern __shared__ __attribute__((aligned(16))) unsigned char lds_raw[];
    LAS unsigned char* lds = (LAS unsigned char*)lds_raw;
    if (threadIdx.x < 4) ((LAS unsigned*)(lds + LDS_BAR_OFF))[threadIdx.x] = 0u;
    __syncthreads();
    const XcdBarrier bar = xcd_barrier_post((unsigned*)(p.ws + WS_CTL), (volatile LAS unsigned*)(lds + LDS_BAR_OFF));
    run_from<0>(p, lds, (int)gridDim.x, bar);
}

extern "C" void kernel_launch(void* const* d_in, const int* in_sizes, int n_in, void* d_out, int out_size, void* d_ws, size_t ws_size, hipStream_t stream) {
    static int grid = 0;
    if (grid == 0) {
        if (n_in != 24 || in_sizes[0] != T * DM || out_size != T * DM || ws_size < WS_END) {
            fprintf(stderr, "kernel_launch: unexpected shapes: n_in %d in0 %d out %d ws %zu\n", n_in, n_in > 0 ? in_sizes[0] : -1, out_size, ws_size); grid = -1; return; }
        int dev = 0, cus = 0, per_cu = 0;
        if (hipGetDevice(&dev) != hipSuccess || hipDeviceGetAttribute(&cus, hipDeviceAttributeMultiprocessorCount, dev) != hipSuccess) { grid = -1; return; }
        if (hipFuncSetAttribute((const void*)k_mega, hipFuncAttributeMaxDynamicSharedMemorySize, LDS_BYTES) != hipSuccess) { fprintf(stderr, "kernel_launch: hipFuncSetAttribute failed\n"); grid = -1; return; }
        if (hipOccupancyMaxActiveBlocksPerMultiprocessor(&per_cu, (const void*)k_mega, NTHR, LDS_BYTES) != hipSuccess || per_cu < 1) { fprintf(stderr, "kernel_launch: occupancy query says %d blocks per CU\n", per_cu); grid = -1; return; }
        (void)hipGetLastError();
        grid = cus;
    }
    if (grid < 0) return;
    Params p{};
    const float** pp = (const float**)&p;
    for (int i = 0; i < 24; ++i) pp[i] = (const float*)d_in[i];
    p.out = (float*)d_out; p.ws = (unsigned char*)d_ws;
    if (hipMemsetAsync((char*)d_ws + WS_CTL, 0, 65536, stream) != hipSuccess) { fprintf(stderr, "kernel_launch: hipMemsetAsync failed\n"); return; }
    void* args[] = {&p};
    hipError_t e = hipLaunchCooperativeKernel((const void*)k_mega, dim3(grid), dim3(NTHR), args, LDS_BYTES, stream);
    if (e != hipSuccess) fprintf(stderr, "kernel_launch: cooperative launch failed: %s (grid %d)\n", hipGetErrorString(e), grid);
}
```
